# Optimizing an MI355X kernel written in HIP

```python
import jax, jax.numpy as jnp
from jax import lax
import numpy as np

D_MODEL = 1024
BATCH = 2
SEQ = 8192
DEPTH = 1

HEAD_DIM = D_MODEL // 16
ATTN_HEADS = 8
ATTN_KV_HEADS = 2
ATTN_GROUP = ATTN_HEADS // ATTN_KV_HEADS
ATTN_WIDTH = ATTN_HEADS * HEAD_DIM
KV_WIDTH = ATTN_KV_HEADS * HEAD_DIM
WINDOW = 128
BLOCK = 128
ROPE_THETA = 10000.0
POOL_WINDOWS = (2, 4, 8, 16)
POOL_GROUPS = 4
POOL_WIDTH = D_MODEL - ATTN_WIDTH
POOL_CH = POOL_WIDTH // POOL_GROUPS
MIX_WIDTH = ATTN_WIDTH + POOL_WIDTH
IN_WIDTH = ATTN_WIDTH + 2 * KV_WIDTH + POOL_WIDTH
PEER_HEADS = 8
PEER_N_KEYS = 128
PEER_N_EXPERTS = PEER_N_KEYS * PEER_N_KEYS
PEER_TOPK = 16
PEER_QDIM = 256
PEER_HALF = PEER_QDIM // 2
PEER_CHUNK = 128
DEEPNORM_ALPHA = (2.0 * DEPTH) ** 0.25
DEEPNORM_BETA = (8.0 * DEPTH) ** -0.25
LN_EPS = 1e-5

kernel_name = "hybrid_swa_sink_pool_peer_deepnorm_adaln"


def layer_norm(x, g, b):
    x32 = x.astype(jnp.float32)
    mu = jnp.mean(x32, axis=-1, keepdims=True)
    var = jnp.mean(jnp.square(x32 - mu), axis=-1, keepdims=True)
    return ((x32 - mu) * lax.rsqrt(var + LN_EPS) * g + b).astype(x.dtype)


def rope(t, pos):
    half = t.shape[-1] // 2
    freqs = ROPE_THETA ** (-jnp.arange(half, dtype=jnp.float32) / half)
    ang = pos.astype(jnp.float32)[:, None] * freqs[None, :]
    cos = jnp.cos(ang)[None, :, None, :]
    sin = jnp.sin(ang)[None, :, None, :]
    t32 = t.astype(jnp.float32)
    t1, t2 = t32[..., :half], t32[..., half:]
    return jnp.concatenate([t1 * cos - t2 * sin, t2 * cos + t1 * sin], axis=-1).astype(t.dtype)


def sliding_window_gqa_with_sinks(q, k, v, sinks):
    B, S = q.shape[0], q.shape[1]
    nb = S // BLOCK
    qb = q.reshape(B, nb, BLOCK, ATTN_KV_HEADS, ATTN_GROUP, HEAD_DIM)
    kb = k.reshape(B, nb, BLOCK, ATTN_KV_HEADS, HEAD_DIM)
    vb = v.reshape(B, nb, BLOCK, ATTN_KV_HEADS, HEAD_DIM)
    kcat = jnp.concatenate([jnp.concatenate([jnp.zeros_like(kb[:, :1]), kb[:, :-1]], axis=1), kb], axis=2)
    vcat = jnp.concatenate([jnp.concatenate([jnp.zeros_like(vb[:, :1]), vb[:, :-1]], axis=1), vb], axis=2)
    s = jnp.einsum('bnqhgd,bnshd->bnhgqs', qb, kcat).astype(jnp.float32) * (HEAD_DIM ** -0.5)
    q_idx = jnp.arange(BLOCK)[:, None]
    s_idx = jnp.arange(2 * BLOCK)[None, :]
    rel = q_idx + BLOCK - s_idx
    band = (rel >= 0) & (rel < WINDOW)
    blk = jnp.arange(nb)[:, None, None]
    valid = band[None] & ((blk > 0) | (s_idx[None] >= BLOCK))
    s = jnp.where(valid[None, :, None, None], s, -1e30)
    sink_b = sinks.astype(jnp.float32).reshape(1, 1, ATTN_KV_HEADS, ATTN_GROUP, 1, 1)
    m = jnp.maximum(jnp.max(s, axis=-1, keepdims=True), sink_b)
    p = jnp.exp(s - m)
    denom = jnp.sum(p, axis=-1, keepdims=True) + jnp.exp(sink_b - m)
    probs = (p / denom).astype(v.dtype)
    o = jnp.einsum('bnhgqs,bnshd->bnqhgd', probs, vcat)
    return o.reshape(B, S, ATTN_WIDTH)


def multiscale_causal_pool(p, w_pool, pool_scale):
    B, S, _ = p.shape
    p32 = p.astype(jnp.float32).reshape(B, S, POOL_GROUPS, POOL_CH)
    cs = jnp.cumsum(p32, axis=1)
    t = jnp.arange(S)
    outs = []
    for gi, w in enumerate(POOL_WINDOWS):
        csg = cs[:, :, gi]
        lag = jnp.pad(csg, ((0, 0), (w, 0), (0, 0)))[:, :S]
        cnt = jnp.minimum(t + 1, w).astype(jnp.float32)[None, :, None]
        outs.append((csg - lag) / cnt - p32[:, :, gi])
    pooled = jnp.stack(outs, axis=2).astype(p.dtype)
    y = jnp.einsum('bsgc,gce->bsge', pooled, w_pool).reshape(B, S, POOL_WIDTH)
    return y * pool_scale


def peer_ffn(h, w_pq, peer_k1, peer_k2, peer_u, peer_v):
    B, S, D = h.shape
    q = (h @ w_pq).reshape(B, S, PEER_HEADS, 2, PEER_HALF)
    s1 = jnp.einsum('bshc,kc->bshk', q[..., 0, :], peer_k1).astype(jnp.float32)
    s2 = jnp.einsum('bshc,kc->bshk', q[..., 1, :], peer_k2).astype(jnp.float32)
    v1, i1 = lax.top_k(s1, PEER_TOPK)
    v2, i2 = lax.top_k(s2, PEER_TOPK)
    comb = (v1[..., :, None] + v2[..., None, :]).reshape(B, S, PEER_HEADS, PEER_TOPK * PEER_TOPK)
    vals, flat = lax.top_k(comb, PEER_TOPK)
    e = (jnp.take_along_axis(i1, flat // PEER_TOPK, axis=-1) * PEER_N_KEYS
         + jnp.take_along_axis(i2, flat % PEER_TOPK, axis=-1))
    g = jax.nn.softmax(vals, axis=-1).astype(h.dtype)
    n_chunks = (B * S) // PEER_CHUNK
    xs = h.reshape(n_chunks, PEER_CHUNK, D)
    es = e.reshape(n_chunks, PEER_CHUNK, PEER_HEADS * PEER_TOPK)
    gs = g.reshape(n_chunks, PEER_CHUNK, PEER_HEADS * PEER_TOPK)

    def expert_chunk(args):
        xc, ec, gc = args
        hid = jnp.einsum('td,tkd->tk', xc, peer_u[ec])
        act = jax.nn.gelu(hid, approximate=False) * gc
        return jnp.einsum('tk,tkd->td', act, peer_v[ec])

    out = lax.map(expert_chunk, (xs, es, gs))
    return out.reshape(B, S, D)


def setup_inputs(seed: int = 0) -> dict:
    key = jax.random.key(seed)
    ks = jax.random.split(key, 20)

    def nrm(k, shape, s):
        return jax.random.normal(k, shape, jnp.float32) * s

    col_scale = jnp.concatenate([
        jnp.ones((ATTN_WIDTH + KV_WIDTH,), jnp.float32),
        jnp.full((KV_WIDTH + POOL_WIDTH,), DEEPNORM_BETA, jnp.float32)])
    return {
        "x": nrm(ks[0], (BATCH, SEQ, D_MODEL), 1.0),
        "c": nrm(ks[1], (BATCH, D_MODEL), 1.0),
        "w_ada": nrm(ks[2], (DEPTH, D_MODEL, 6 * D_MODEL), 0.1 * D_MODEL ** -0.5),
        "b_ada": nrm(ks[3], (DEPTH, 6 * D_MODEL), 0.02),
        "w_in": nrm(ks[4], (DEPTH, D_MODEL, IN_WIDTH), D_MODEL ** -0.5) * col_scale,
        "attn_sinks": nrm(ks[5], (DEPTH, ATTN_HEADS), 1.0),
        "w_pool": nrm(ks[6], (DEPTH, POOL_GROUPS, POOL_CH, POOL_CH), POOL_CH ** -0.5),
        "pool_scale": 1.0 + nrm(ks[7], (DEPTH, POOL_WIDTH), 0.02),
        "w_out": nrm(ks[8], (DEPTH, MIX_WIDTH, D_MODEL), DEEPNORM_BETA * MIX_WIDTH ** -0.5),
        "ln1_g": 1.0 + nrm(ks[9], (DEPTH, D_MODEL), 0.02),
        "ln1_b": nrm(ks[10], (DEPTH, D_MODEL), 0.02),
        "w_pq": nrm(ks[11], (DEPTH, D_MODEL, PEER_HEADS * PEER_QDIM), D_MODEL ** -0.5),
        "peer_k1": nrm(ks[12], (DEPTH, PEER_N_KEYS, PEER_HALF), PEER_HALF ** -0.5),
        "peer_k2": nrm(ks[13], (DEPTH, PEER_N_KEYS, PEER_HALF), PEER_HALF ** -0.5),
        "peer_u": nrm(ks[14], (DEPTH, PEER_N_EXPERTS, D_MODEL), D_MODEL ** -0.5),
        "peer_v": nrm(ks[15], (DEPTH, PEER_N_EXPERTS, D_MODEL), DEEPNORM_BETA),
        "ln2_g": 1.0 + nrm(ks[16], (DEPTH, D_MODEL), 0.02),
        "ln2_b": nrm(ks[17], (DEPTH, D_MODEL), 0.02),
    }


def reference(x, c, w_ada, b_ada, w_in, attn_sinks, w_pool, pool_scale, w_out, ln1_g, ln1_b,
              w_pq, peer_k1, peer_k2, peer_u, peer_v, ln2_g, ln2_b):
    B, S, _ = x.shape
    pos = jnp.arange(S, dtype=jnp.int32)
    for l in range(DEPTH):
        mod = jax.nn.silu(c) @ w_ada[l] + b_ada[l]
        shift1, scale1, gate1, shift2, scale2, gate2 = [m[:, None, :] for m in jnp.split(mod, 6, axis=-1)]
        h = x * (1.0 + scale1) + shift1
        proj = h @ w_in[l]
        q = proj[..., :ATTN_WIDTH].reshape(B, S, ATTN_HEADS, HEAD_DIM)
        k = proj[..., ATTN_WIDTH:ATTN_WIDTH + KV_WIDTH].reshape(B, S, ATTN_KV_HEADS, HEAD_DIM)
        v = proj[..., ATTN_WIDTH + KV_WIDTH:ATTN_WIDTH + 2 * KV_WIDTH].reshape(B, S, ATTN_KV_HEADS, HEAD_DIM)
        p_in = proj[..., ATTN_WIDTH + 2 * KV_WIDTH:]
        attn = sliding_window_gqa_with_sinks(rope(q, pos), rope(k, pos), v, attn_sinks[l])
        pool = multiscale_causal_pool(p_in, w_pool[l], pool_scale[l])
        mix = jnp.concatenate([attn, pool], axis=-1) @ w_out[l]
        x = layer_norm(DEEPNORM_ALPHA * x + (1.0 + gate1) * mix, ln1_g[l], ln1_b[l])
        h2 = x * (1.0 + scale2) + shift2
        y = peer_ffn(h2, w_pq[l], peer_k1[l], peer_k2[l], peer_u[l], peer_v[l])
        x = layer_norm(DEEPNORM_ALPHA * x + (1.0 + gate2) * y, ln2_g[l], ln2_b[l])
    return x
```

```cpp
#include <hip/hip_runtime.h>
#include <cstdio>
#include <cstdint>
#include <cmath>
namespace pg8 {
#define PG8_LAS __attribute__((address_space(3)))
typedef unsigned short bf16_t;
typedef short bf16x8 __attribute__((ext_vector_type(8)));
typedef float f32x4 __attribute__((ext_vector_type(4)));
typedef unsigned u32x4 __attribute__((ext_vector_type(4)));
constexpr int BM = 256, BK = 64, HALF = 128, HTB = HALF * BK * 2  , STAGE_BYTES = 8 * HTB, NXCD = 8, WGM = 8;

__host__ __device__ __forceinline__ int lds_byte(int r, int c) { const int st = (r >> 4) * 2 + (c >> 5), rr = r & 15, cc = c & 31, ob = rr * 64 + cc * 2; return st * 1024 + (ob ^ (((ob >> 9) & 1) << 5)); }
__host__ __device__ __forceinline__ void stage_rc(int b, int& R, int& C) { const int st = b / 1024, sb = b % 1024, swz = sb ^ (((sb >> 9) & 1) << 5); R = (st >> 1) * 16 + swz / 64; C = (st & 1) * 32 + (swz % 64) / 2; }
__host__ __device__ __forceinline__ int perm32(int rho) { const int n = rho >> 4, i = rho & 15; return 8 * (i >> 2) + 4 * n + (i & 3); }

struct Unit { int pm, pn; };
struct Gemm { const bf16_t* A; const bf16_t* Bt; int M, N, K; };

struct StaticOrder {
    int nM, nN, nwg, G, c;
    __host__ __device__ void init(int M, int N, int G_, int c_) { nM = M / BM; nN = N / BM; nwg = nM * nN; G = G_; c = c_; }
    __host__ __device__ bool next(int i, Unit& u) const {
        const long L = (long)i * G + c; if (L >= nwg) return false;
        int wgid = (int)L; { const int q = nwg / NXCD, r = nwg % NXCD, xcd = wgid % NXCD, off = wgid / NXCD; wgid = (xcd < r ? xcd * (q + 1) : r * (q + 1) + (xcd - r) * q) + off; }
        const int nig = WGM * nN, gid = wgid / nig, fm = gid * WGM, gsz = (nM - fm) < WGM ? (nM - fm) : WGM;
        u.pm = fm + ((wgid % nig) % gsz); u.pn = (wgid % nig) / gsz; return true;
    }
    __device__ __forceinline__ void a_ready(const Unit&) const {}
    __device__ __forceinline__ void done(const Unit&) const {}
};

__device__ __forceinline__ unsigned cvt_pk_bf16(float lo, float hi) { unsigned r; asm volatile("v_cvt_pk_bf16_f32 %0, %1, %2" : "=v"(r) : "v"(lo), "v"(hi)); return r; }

struct EpiPlain {
    static constexpr bool PERM = true, AFTER_DRAIN = false;
    bf16_t* O; int ldc;
    __device__ __forceinline__ void operator()(const f32x4 (&acc)[2][2][4][2], const Unit& u, int wr, int wc, int fr, int fq) const {
        const int row0 = u.pm * BM + wr * 64 + fr; const int col0 = u.pn * BM + wc * 32 + 8 * fq;
#pragma unroll
        for (int ai = 0; ai < 2; ++ai)
#pragma unroll
            for (int m = 0; m < 4; ++m) { bf16_t* rowp = O + (size_t)(row0 + ai * HALF + m * 16) * ldc + col0;
#pragma unroll
                for (int bj = 0; bj < 2; ++bj) { const f32x4 v0 = acc[ai][bj][m][0], v1 = acc[ai][bj][m][1];
                    u32x4 w; w.x = cvt_pk_bf16(v0[0], v0[1]); w.y = cvt_pk_bf16(v0[2], v0[3]); w.z = cvt_pk_bf16(v1[0], v1[1]); w.w = cvt_pk_bf16(v1[2], v1[3]);
                    *(u32x4*)(rowp + bj * HALF) = w; } }
    }
};
struct EpiRope {
    static constexpr bool PERM = true, AFTER_DRAIN = false;
    bf16_t* O; int ldc; const float* rope; float qscale;
    __device__ __forceinline__ void operator()(const f32x4 (&acc)[2][2][4][2], const Unit& u, int wr, int wc, int fr, int fq) const {
        const int row0 = u.pm * BM + wr * 64 + fr; const int col0 = u.pn * BM + wc * 32 + 8 * fq;
#pragma unroll
        for (int ai = 0; ai < 2; ++ai)
#pragma unroll
            for (int m = 0; m < 4; ++m) { const int row = row0 + ai * HALF + m * 16; bf16_t* rowp = O + (size_t)row * ldc + col0; const int pos = row & 8191;
#pragma unroll
                for (int bj = 0; bj < 2; ++bj) { f32x4 v0 = acc[ai][bj][m][0], v1 = acc[ai][bj][m][1];
                    const int colt = u.pn * BM + bj * HALF;
                    if (colt < 640) {
                        const int c = col0 + bj * HALF, ib = (c & 63) >> 1;
                        const f32x4 cs0 = *(const f32x4*)(rope + ((size_t)pos * 32 + ib) * 2), cs1 = *(const f32x4*)(rope + ((size_t)pos * 32 + ib) * 2 + 4);
                        const float sc = colt < 512 ? qscale : 1.0f;
                        f32x4 r0, r1;
                        r0[0] = (v0[0] * cs0[0] - v0[1] * cs0[1]) * sc; r0[1] = (v0[1] * cs0[0] + v0[0] * cs0[1]) * sc;
                        r0[2] = (v0[2] * cs0[2] - v0[3] * cs0[3]) * sc; r0[3] = (v0[3] * cs0[2] + v0[2] * cs0[3]) * sc;
                        r1[0] = (v1[0] * cs1[0] - v1[1] * cs1[1]) * sc; r1[1] = (v1[1] * cs1[0] + v1[0] * cs1[1]) * sc;
                        r1[2] = (v1[2] * cs1[2] - v1[3] * cs1[3]) * sc; r1[3] = (v1[3] * cs1[2] + v1[2] * cs1[3]) * sc;
                        v0 = r0; v1 = r1;
                    }
                    u32x4 w; w.x = cvt_pk_bf16(v0[0], v0[1]); w.y = cvt_pk_bf16(v0[2], v0[3]); w.z = cvt_pk_bf16(v1[0], v1[1]); w.w = cvt_pk_bf16(v1[2], v1[3]);
                    *(u32x4*)(rowp + bj * HALF) = w; } }
    }
};

template <class Epi, class Sched, bool ALIGN_EPI = false, bool SP2 = false>
__device__ __forceinline__ void gemm_phase(PG8_LAS unsigned char* lds, const Gemm g, const Sched& S, const Epi& E) {
    const int tid = threadIdx.x, wid = __builtin_amdgcn_readfirstlane(tid >> 6), lane = tid & 63, wr = wid >> 2, wc = wid & 3, fr = lane & 15, fq = lane >> 4;
    const int K = g.K, nt = K / BK;
    unsigned voffA[2], voffB[2];
#pragma unroll
    for (int i = 0; i < 2; ++i) { int R, C; stage_rc(tid * 16 + i * 8192, R, C); const int Rb = Epi::PERM ? ((R & ~31) + perm32(R & 31)) : R;
        voffA[i] = (unsigned)(R * K + C) * 2u; voffB[i] = (unsigned)(Rb * K + C) * 2u; }
    const size_t kstep = (size_t)(BK * 2);
    const size_t hstep = (size_t)HALF * K * 2;
    const size_t tstep = 2 * hstep;
    const unsigned ldsw = (unsigned)wid * 1024u;
    const int aoff = lds_byte(wr * 64 + fr, fq * 8), boff = lds_byte(wc * 32 + fr, fq * 8);
#define PG8_SA(b, h) (((b) * 2 + (h)) * HTB)
#define PG8_SB(b, h) ((4 + (b) * 2 + (h)) * HTB)
#define PG8_STAGE(bufoff, gbase, voff) do { _Pragma("unroll") for (int _i = 0; _i < 2; ++_i) \
        __builtin_amdgcn_global_load_lds((const unsigned*)((const char*)(gbase) + (voff)[_i]), (PG8_LAS unsigned*)(lds + (bufoff) + ldsw + _i * 8192), 16, 0, 0); } while (0)
#define PG8_LDA(dst, b, h) do { _Pragma("unroll") for (int m = 0; m < 4; ++m) _Pragma("unroll") for (int k = 0; k < 2; ++k) dst[m][k] = *(const PG8_LAS bf16x8*)(lds + PG8_SA(b, h) + aoff + m * 2048 + k * 1024); } while (0)
#define PG8_LDB(dst, b, h) do { _Pragma("unroll") for (int n = 0; n < 2; ++n) _Pragma("unroll") for (int k = 0; k < 2; ++k) dst[n][k] = *(const PG8_LAS bf16x8*)(lds + PG8_SB(b, h) + boff + n * 2048 + k * 1024); } while (0)
#define PG8_MMA(ai, bj, At, Bt) do { __builtin_amdgcn_s_setprio(1); _Pragma("unroll") for (int m = 0; m < 4; ++m) _Pragma("unroll") for (int n = 0; n < 2; ++n) _Pragma("unroll") for (int k = 0; k < 2; ++k) \
        acc[ai][bj][m][n] = __builtin_amdgcn_mfma_f32_16x16x32_bf16(Bt[n][k], At[m][k], acc[ai][bj][m][n], 0, 0, 0); __builtin_amdgcn_s_setprio(0); } while (0)
#define PG8_WAIT_V(n) asm volatile("s_waitcnt vmcnt(" #n ")" ::: "memory")
#define PG8_WAIT_L(n) asm volatile("s_waitcnt lgkmcnt(" #n ")" ::: "memory")
#define PG8_BAR __builtin_amdgcn_s_barrier()
#define PG8_SCHED __builtin_amdgcn_sched_barrier(0)
    Unit cur, nxt; int ui = 0;
    if (!S.next(0, cur)) return;
    f32x4 acc[2][2][4][2];
#pragma unroll
    for (int a = 0; a < 2; ++a)
#pragma unroll
        for (int b = 0; b < 2; ++b)
#pragma unroll
            for (int m = 0; m < 4; ++m)
#pragma unroll
                for (int n = 0; n < 2; ++n) acc[a][b][m][n] = (f32x4){0.f, 0.f, 0.f, 0.f};
    bf16x8 At[4][2], B0[2][2], B1[2][2];
    const char* cA = (const char*)g.A + (size_t)cur.pm * tstep; const char* cB = (const char*)g.Bt + (size_t)cur.pn * tstep;
    S.a_ready(cur);
    if constexpr (SP2) {
        PG8_STAGE(PG8_SB(0, 0), cB, voffB); PG8_STAGE(PG8_SB(0, 1), cB + hstep, voffB); PG8_STAGE(PG8_SA(0, 0), cA, voffA); PG8_STAGE(PG8_SA(0, 1), cA + hstep, voffA);
        if (wr == 1) PG8_BAR;
        PG8_WAIT_V(2); PG8_BAR;
        PG8_STAGE(PG8_SB(1, 0), cB + kstep, voffB); PG8_STAGE(PG8_SA(1, 0), cA + kstep, voffA); PG8_STAGE(PG8_SB(1, 1), cB + hstep + kstep, voffB);
        PG8_WAIT_V(6); PG8_BAR;
    } else {
        PG8_STAGE(PG8_SB(0, 0), cB, voffB); PG8_STAGE(PG8_SA(0, 0), cA, voffA); PG8_STAGE(PG8_SB(0, 1), cB + hstep, voffB); PG8_STAGE(PG8_SA(0, 1), cA + hstep, voffA);
        if (wr == 1) PG8_BAR;
        PG8_WAIT_V(4); PG8_BAR;
        PG8_STAGE(PG8_SB(1, 0), cB + kstep, voffB); PG8_STAGE(PG8_SA(1, 0), cA + kstep, voffA); PG8_STAGE(PG8_SB(1, 1), cB + hstep + kstep, voffB);
        PG8_WAIT_V(6); PG8_BAR;
    }
    for (;;) {
        const bool has_next = S.next(ui + 1, nxt);
        const char* nA = has_next ? (const char*)g.A + (size_t)nxt.pm * tstep : cA; const char* nB = has_next ? (const char*)g.Bt + (size_t)nxt.pn * tstep : cB;
        for (int t = 0; t < nt; t += 2) {
            const bool last = (t == nt - 2);
            const char* a1 = cA + (size_t)(t + 1) * kstep;
            const char* a2 = last ? nA : cA + (size_t)(t + 2) * kstep; const char* b2 = last ? nB : cB + (size_t)(t + 2) * kstep;
            const char* a3 = a2 + kstep; const char* b3 = b2 + kstep;
            if (last && has_next) S.a_ready(nxt);
            if constexpr (SP2) {
            PG8_LDB(B0, 0, 0); PG8_LDB(B1, 0, 1); PG8_SCHED; PG8_LDA(At, 0, 0); PG8_STAGE(PG8_SA(1, 1), a1 + hstep, voffA);
            PG8_WAIT_V(8); PG8_WAIT_L(0); PG8_BAR; PG8_MMA(0, 0, At, B0); PG8_MMA(0, 1, At, B1); PG8_BAR; PG8_SCHED;
            PG8_LDA(At, 0, 1); PG8_STAGE(PG8_SB(0, 0), b2, voffB); PG8_STAGE(PG8_SB(0, 1), b2 + hstep, voffB); PG8_STAGE(PG8_SA(0, 0), a2, voffA);
            PG8_WAIT_V(8); PG8_WAIT_L(0); PG8_BAR; PG8_MMA(1, 0, At, B0); PG8_MMA(1, 1, At, B1); PG8_BAR; PG8_SCHED;
            PG8_LDB(B0, 1, 0); PG8_LDB(B1, 1, 1); PG8_SCHED; PG8_LDA(At, 1, 0); PG8_STAGE(PG8_SA(0, 1), a2 + hstep, voffA);
            PG8_WAIT_V(8); PG8_WAIT_L(0); PG8_BAR; PG8_MMA(0, 0, At, B0); PG8_MMA(0, 1, At, B1); PG8_BAR; PG8_SCHED;
            PG8_LDA(At, 1, 1); PG8_STAGE(PG8_SB(1, 0), b3, voffB); PG8_STAGE(PG8_SB(1, 1), b3 + hstep, voffB); PG8_STAGE(PG8_SA(1, 0), a3, voffA);
            PG8_WAIT_V(8); PG8_WAIT_L(0); PG8_BAR; PG8_MMA(1, 0, At, B0); PG8_MMA(1, 1, At, B1); PG8_BAR; PG8_SCHED;
            } else {
            PG8_LDB(B0, 0, 0); PG8_SCHED; PG8_LDA(At, 0, 0); PG8_STAGE(PG8_SA(1, 1), a1 + hstep, voffA);
            PG8_WAIT_L(8); PG8_BAR; PG8_WAIT_L(0); PG8_MMA(0, 0, At, B0); PG8_BAR; PG8_SCHED;
            PG8_LDB(B1, 0, 1); PG8_STAGE(PG8_SB(0, 0), b2, voffB);
            PG8_BAR; PG8_WAIT_L(0); PG8_MMA(0, 1, At, B1); PG8_BAR;
            PG8_LDA(At, 0, 1); PG8_STAGE(PG8_SA(0, 0), a2, voffA);
            PG8_BAR; PG8_WAIT_L(0); PG8_MMA(1, 0, At, B0); PG8_BAR; PG8_SCHED;
            PG8_STAGE(PG8_SB(0, 1), b2 + hstep, voffB);
            PG8_WAIT_V(6); PG8_BAR; PG8_MMA(1, 1, At, B1); PG8_BAR;
            PG8_LDB(B0, 1, 0); PG8_SCHED; PG8_LDA(At, 1, 0); PG8_STAGE(PG8_SA(0, 1), a2 + hstep, voffA);
            PG8_WAIT_L(8); PG8_BAR; PG8_WAIT_L(0); PG8_MMA(0, 0, At, B0); PG8_BAR; PG8_SCHED;
            PG8_LDB(B1, 1, 1); PG8_STAGE(PG8_SB(1, 0), b3, voffB);
            PG8_BAR; PG8_WAIT_L(0); PG8_MMA(0, 1, At, B1); PG8_BAR;
            PG8_LDA(At, 1, 1); PG8_STAGE(PG8_SA(1, 0), a3, voffA);
            PG8_BAR; PG8_WAIT_L(0); PG8_MMA(1, 0, At, B0); PG8_BAR; PG8_SCHED;
            PG8_STAGE(PG8_SB(1, 1), b3 + hstep, voffB);
            PG8_WAIT_V(6); PG8_BAR; PG8_MMA(1, 1, At, B1); PG8_BAR;
            }
        }
        if constexpr (ALIGN_EPI) { if (wr == 0) PG8_BAR; }
        if constexpr (!Epi::AFTER_DRAIN) { E(acc, cur, wr, wc, fr, fq); S.done(cur); }
        if (!has_next) break;
#pragma unroll
        for (int a = 0; a < 2; ++a)
#pragma unroll
            for (int b = 0; b < 2; ++b)
#pragma unroll
                for (int m = 0; m < 4; ++m)
#pragma unroll
                    for (int n = 0; n < 2; ++n) acc[a][b][m][n] = (f32x4){0.f, 0.f, 0.f, 0.f};
        cur = nxt; cA = nA; cB = nB; ++ui;
        if constexpr (ALIGN_EPI) { if (wr == 1) PG8_BAR; }
    }
    PG8_WAIT_V(0);
    if constexpr (!ALIGN_EPI) { if (wr == 0) PG8_BAR; }
    PG8_BAR;
    if constexpr (Epi::AFTER_DRAIN) { E.fused(acc, cur, wr, wc, fr, fq, lds, wid, lane); S.done(cur); }
#undef PG8_SA
#undef PG8_SB
#undef PG8_STAGE
#undef PG8_LDA
#undef PG8_LDB
#undef PG8_MMA
#undef PG8_WAIT_V
#undef PG8_WAIT_L
#undef PG8_BAR
#undef PG8_SCHED
}
}
#define GAS __attribute__((address_space(1)))
#define LAS __attribute__((address_space(3)))
typedef unsigned short bf16;
typedef unsigned v4u __attribute__((ext_vector_type(4)));
typedef float f32x4 __attribute__((ext_vector_type(4)));
typedef short bf16x8 __attribute__((ext_vector_type(8)));
typedef GAS unsigned gu32;
typedef GAS unsigned long long gu64;
#define RLX_AGENT __ATOMIC_RELAXED, __HIP_MEMORY_SCOPE_AGENT
#define LDS_WAIT() asm volatile("s_waitcnt lgkmcnt(0)" ::: "memory")
#define VM_WAIT() asm volatile("s_waitcnt vmcnt(0)" ::: "memory")
__device__ __forceinline__ unsigned long long rt() { return __builtin_amdgcn_s_memrealtime(); }
__device__ __forceinline__ unsigned f2bf(float f) { unsigned u = __builtin_bit_cast(unsigned, f); return (u + 0x7fffu + ((u >> 16) & 1u)) >> 16; }
__device__ __forceinline__ unsigned pk2(float lo, float hi) { return f2bf(lo) | (f2bf(hi) << 16); }
#define XB_TMO      128
#define XB_XCNT(j)  (256  + 64 * (j))
#define XB_XSUB(j)  (1280 + 64 * (j))
#define XB_XGEN(j)  (2304 + 64 * (j))
#define XB_TOP      3328
#define XB_TOPGEN   3392
#define XCD_BAR_WORDS 3456
#define XB_SPIN_CAP (1u << 18)

__device__ __forceinline__ unsigned xb_ld(unsigned* p)              { return __hip_atomic_load(p, __ATOMIC_RELAXED, __HIP_MEMORY_SCOPE_AGENT); }
__device__ __forceinline__ unsigned xb_add(unsigned* p, unsigned v) { return __hip_atomic_fetch_add(p, v, __ATOMIC_RELAXED, __HIP_MEMORY_SCOPE_AGENT); }
__device__ __forceinline__ unsigned xb_xcc_id() { return (unsigned)__builtin_amdgcn_s_getreg((3 << 11) | 20) & 0xFu; }
#define XB_SPIN(cond, bar) do { unsigned _sp = 0; while (cond) { __builtin_amdgcn_s_sleep(1); \
    if ((++_sp & 255u) == 0u) { if (xb_ld(&(bar)[XB_TMO])) break; if (_sp > XB_SPIN_CAP) { atomicAdd(&(bar)[XB_TMO], 1u); break; } } } } while (0)

struct XcdBarrier {
    unsigned* bar; unsigned x;
    volatile LAS unsigned* st;
};

__device__ __forceinline__ XcdBarrier xcd_barrier_post(unsigned* bar, volatile LAS unsigned* st) {
    XcdBarrier b; b.bar = bar; b.x = xb_xcc_id(); b.st = st;
    if (threadIdx.x == 0) (void)xb_add(&bar[XB_XCNT(b.x)], 1u);
    return b;
}
__device__ __forceinline__ void xcd_barrier_complete(unsigned* bar, unsigned x, unsigned& nloc, unsigned& nx) {
    const unsigned G = gridDim.x * gridDim.y * gridDim.z;
    unsigned sum, cnt, mine, sp = 0u;
    for (;;) {
        sum = 0u; cnt = 0u; mine = 0u;
#pragma unroll
        for (unsigned j = 0; j < 16; ++j) { const unsigned c = xb_ld(&bar[XB_XCNT(j)]); sum += c; cnt += (c > 0u) ? 1u : 0u; mine = (j == x) ? c : mine; }
        if (sum == G) break;
        __builtin_amdgcn_s_sleep(1);
        if ((++sp & 255u) == 0u) { if (xb_ld(&bar[XB_TMO])) break; if (sp > XB_SPIN_CAP) { atomicAdd(&bar[XB_TMO], 1u); break; } }
    }
    nloc = mine > 0u ? mine : 1u; nx = cnt > 0u ? cnt : 1u;
}

__device__ __forceinline__ void xcd_barrier(const XcdBarrier& b) {
    asm volatile("s_waitcnt vmcnt(0)" ::: "memory");
    __syncthreads();
    if (threadIdx.x == 0) {
        unsigned* bar = b.bar;
        __builtin_amdgcn_s_waitcnt(0);
        unsigned nloc = b.st[0], nx = b.st[1];
        if (nloc == 0u) { xcd_barrier_complete(bar, b.x, nloc, nx); b.st[0] = nloc; b.st[1] = nx; }
        const unsigned old = xb_add(&bar[XB_XSUB(b.x)], 1u);
        const unsigned gen = old / nloc;
        if (old + 1u == (gen + 1u) * nloc) {
            __builtin_amdgcn_fence(__ATOMIC_RELEASE, "agent");
            asm volatile("s_waitcnt vmcnt(0)" ::: "memory");
            const unsigned og = xb_add(&bar[XB_TOP], 1u);
            const unsigned tg = og / nx;
            if (og + 1u == (tg + 1u) * nx) xb_add(&bar[XB_TOPGEN], 1u);
            else XB_SPIN(xb_ld(&bar[XB_TOPGEN]) == tg, bar);
            __builtin_amdgcn_fence(__ATOMIC_ACQUIRE, "agent");
            xb_add(&bar[XB_XGEN(b.x)], 1u);
            asm volatile("s_waitcnt vmcnt(0)" ::: "memory");
        } else {
            XB_SPIN(xb_ld(&bar[XB_XGEN(b.x)]) == gen, bar);
            __builtin_amdgcn_fence(__ATOMIC_ACQUIRE, "agent");
            asm volatile("s_waitcnt vmcnt(0)" ::: "memory");
        }
    }
    __syncthreads();
}
constexpr int NWAVES = 8, NTHREADS = 512;
constexpr int TT = 16384, DM = 1024, SEQ = 8192, NIN = 1280, NQD = 2048, NEXP = 16384;
constexpr float DN_ALPHA = 1.189207115002721f;
constexpr float LN_EPS = 1e-5f;
constexpr float LOG2E = 1.4426950408889634f;
constexpr float QSCALE = 0.125f * LOG2E;

constexpr size_t MiB = 1u << 20;
constexpr size_t WS_CTL = 0, CTL_ZERO_BYTES = 64 * 1024;
constexpr size_t WS_MODP = 1 * MiB;
constexpr size_t WS_MOD = 1 * MiB + 896 * 1024;
constexpr size_t WS_ROPE = 2 * MiB;
constexpr size_t WS_WIN = 4 * MiB;
constexpr size_t WS_K1 = 6 * MiB + 512 * 1024, WS_K2 = WS_K1 + 32 * 1024;
constexpr size_t WS_WOUT = 7 * MiB;
constexpr size_t WS_WPQ = 9 * MiB;
constexpr size_t WS_U = 16 * MiB, WS_V = 48 * MiB;
constexpr size_t WS_XN = 80 * MiB;
constexpr size_t WS_MIX = 80 * MiB;
constexpr size_t WS_PE = 80 * MiB, WS_PG = 84 * MiB;
constexpr size_t WS_PROJ = 112 * MiB;
constexpr size_t WS_A2 = 152 * MiB;
constexpr size_t WS_X1 = 184 * MiB, WS_H2 = 216 * MiB;
constexpr size_t WS_Q = 112 * MiB;
constexpr size_t WS_END = 248 * MiB;
constexpr int CW_BAR = 4096;

constexpr int RING_BYTES = 131072, LDSCTL_OFF = RING_BYTES, MISC_OFF = LDSCTL_OFF + 320, LDS_BYTES = 147456;

typedef float f32x16 __attribute__((ext_vector_type(16)));
typedef float f32x2 __attribute__((ext_vector_type(2)));
typedef unsigned u32x2 __attribute__((ext_vector_type(2)));
typedef unsigned u32x4 __attribute__((ext_vector_type(4)));
typedef __bf16 bf16x2_t __attribute__((ext_vector_type(2)));
struct Frame {
    LAS unsigned char* lds;
    int tid, lane, wave, vcu, G;
    const float *x, *c, *w_ada, *b_ada, *w_in, *sinks, *w_pool, *pool_scale, *w_out, *ln1_g, *ln1_b, *w_pq, *k1, *k2, *pu, *pv, *ln2_g, *ln2_b;
    float* out; unsigned char* ws;
};
__device__ __forceinline__ float wave_sum(float v) {
#pragma unroll
    for (int o = 1; o < 64; o <<= 1) v += __shfl_xor(v, o);
    return v;
}
__device__ __forceinline__ float bf_lo(unsigned u) { return __uint_as_float(u << 16); }
__device__ __forceinline__ float bf_hi(unsigned u) { return __uint_as_float(u & 0xffff0000u); }
__device__ __forceinline__ float bf2f(bf16 b) { return __uint_as_float((unsigned)b << 16); }

template <int MODE>
__device__ __forceinline__ void transpose_item(const float* W, int ldw, bf16* WT, int ldt, int k0, int n0, LAS float* scr, int lane) {
    int nsrc = n0 + (lane & 31);
    if (MODE == 1 && nsrc < 640) { const int hd = nsrc >> 6, w = nsrc & 63; nsrc = hd * 64 + (w >> 1) + 32 * (w & 1); }
#pragma unroll 8
    for (int i = 0; i < 32; ++i) { const int kk = 2 * i + (lane >> 5); scr[kk * 33 + (lane & 31)] = W[(size_t)(k0 + kk) * ldw + nsrc]; }
    LDS_WAIT(); asm volatile("" ::: "memory");
    const int c = lane & 7;
#pragma unroll
    for (int j = 0; j < 4; ++j) { const int n = (lane >> 3) + 8 * j; const LAS float* s = scr + (8 * c) * 33 + n;
        v4u o; o.x = pk2(s[0 * 33], s[1 * 33]); o.y = pk2(s[2 * 33], s[3 * 33]); o.z = pk2(s[4 * 33], s[5 * 33]); o.w = pk2(s[6 * 33], s[7 * 33]);
        *(GAS v4u*)(WT + (size_t)(n0 + n) * ldt + k0 + 8 * c) = o; }
    LDS_WAIT(); asm volatile("" ::: "memory");
}
__device__ __forceinline__ void sincos_d(double a, float& s, float& c) {
    const double TWO_PI = 6.283185307179586476925, PI = 3.141592653589793238462643;
    double r = a - TWO_PI * rint(a / TWO_PI);
    double sg = 1.0;
    if (r > 0.5 * PI) { r = PI - r; sg = -1.0; } else if (r < -0.5 * PI) { r = -PI - r; sg = -1.0; }
    const double r2 = r * r;
    double sp = -1.0 / 121645100408832000.0;
    sp = sp * r2 + 1.0 / 355687428096000.0; sp = sp * r2 - 1.0 / 1307674368000.0; sp = sp * r2 + 1.0 / 6227020800.0; sp = sp * r2 - 1.0 / 39916800.0;
    sp = sp * r2 + 1.0 / 362880.0; sp = sp * r2 - 1.0 / 5040.0; sp = sp * r2 + 1.0 / 120.0; sp = sp * r2 - 1.0 / 6.0; sp = sp * r2 + 1.0;
    double cp = 1.0 / 6402373705728000.0;
    cp = cp * r2 - 1.0 / 20922789888000.0; cp = cp * r2 + 1.0 / 87178291200.0; cp = cp * r2 - 1.0 / 479001600.0; cp = cp * r2 + 1.0 / 3628800.0;
    cp = cp * r2 - 1.0 / 40320.0; cp = cp * r2 + 1.0 / 720.0; cp = cp * r2 - 1.0 / 24.0; cp = cp * r2 + 0.5; cp = 1.0 - cp * r2;
    s = (float)(sp * r); c = (float)(sg * cp);
}
__device__ __forceinline__ void p0_prologue(Frame& F) {
    LAS float* scr = (LAS float*)(F.lds + F.wave * 16384);
    const int gw = F.vcu * NWAVES + F.wave, NGW = F.G * NWAVES, lane = F.lane;
    float* modp = (float*)(F.ws + WS_MODP);
    for (int it = gw; it < 96 * 16; it += NGW) {
        const int cc = it % 96, ks = it / 96, col = cc * 64 + lane; float a0 = 0.f, a1 = 0.f;
#pragma unroll 8
        for (int k = ks * 64; k < ks * 64 + 64; ++k) {
            const float c0 = F.c[k], c1 = F.c[DM + k]; const float s0 = c0 / (1.f + __expf(-c0)), s1 = c1 / (1.f + __expf(-c1));
            const float w = F.w_ada[(size_t)k * 6144 + col]; a0 += s0 * w; a1 += s1 * w; }
        modp[(ks * 2 + 0) * 6144 + col] = a0; modp[(ks * 2 + 1) * 6144 + col] = a1;
    }
    { float* rope = (float*)(F.ws + WS_ROPE);
      for (int e = gw * 64 + lane; e < SEQ * 32; e += NGW * 64) { const int pos = e >> 5, i = e & 31;
          const float freq = powf(10000.0f, -(float)i / 32.0f); const float ang = (float)pos * freq; float s, c; sincos_d((double)ang, s, c);
          rope[2 * e] = c; rope[2 * e + 1] = s; } }
    { constexpr int I_IN = 16 * 40, I_PQ = 16 * 64, I_OUT = 8 * 32;
      for (int it = gw; it < I_IN + I_PQ + I_OUT; it += NGW) { int r = it;
          if (r < I_IN) { transpose_item<1>(F.w_in, NIN, (bf16*)(F.ws + WS_WIN), DM, 64 * (r / 40), 32 * (r % 40), scr, lane); continue; } r -= I_IN;
          if (r < I_PQ) { transpose_item<0>(F.w_pq, NQD, (bf16*)(F.ws + WS_WPQ), DM, 64 * (r / 64), 32 * (r % 64), scr, lane); continue; } r -= I_PQ;
          transpose_item<0>(F.w_out, DM, (bf16*)(F.ws + WS_WOUT), DM, 64 * (r / 32), 32 * (r % 32), scr, lane); } }
    { bf16* wout_t = (bf16*)(F.ws + WS_WOUT);
      for (int it = gw; it < 4 * 2 * 128; it += NGW) { const int g = it >> 8, ch = (it >> 7) & 1, n0 = (it & 127) * 8, cidx = ch * 64 + lane;
          float acc[8];
#pragma unroll
          for (int i = 0; i < 8; ++i) acc[i] = 0.f;
          const float* wp = F.w_pool + ((size_t)(g * 128 + cidx)) * 128; const float* ps = F.pool_scale + g * 128; const float* wo = F.w_out + (size_t)(512 + g * 128) * DM + n0;
          for (int e0 = 0; e0 < 128; e0 += 4) { const f32x4 wv = *(const f32x4*)(wp + e0);
#pragma unroll
              for (int ee = 0; ee < 4; ++ee) { const float w = wv[ee] * ps[e0 + ee]; const f32x4 o0 = *(const f32x4*)(wo + (size_t)(e0 + ee) * DM), o1 = *(const f32x4*)(wo + (size_t)(e0 + ee) * DM + 4);
                  acc[0] += w * o0[0]; acc[1] += w * o0[1]; acc[2] += w * o0[2]; acc[3] += w * o0[3]; acc[4] += w * o1[0]; acc[5] += w * o1[1]; acc[6] += w * o1[2]; acc[7] += w * o1[3]; } }
#pragma unroll
          for (int i = 0; i < 8; ++i) wout_t[(size_t)(n0 + i) * DM + 512 + g * 128 + cidx] = (bf16)f2bf(acc[i]); } }
    { bf16* k1b = (bf16*)(F.ws + WS_K1); bf16* k2b = (bf16*)(F.ws + WS_K2);
      for (int e = gw * 64 + lane; e < 128 * 128; e += NGW * 64) { k1b[e] = (bf16)f2bf(F.k1[e]); k2b[e] = (bf16)f2bf(F.k2[e]); } }
    { for (int it = gw; it < 2 * NEXP; it += NGW) { const int tb = it >= NEXP, e = it - tb * NEXP; const float* src = (tb ? F.pv : F.pu) + (size_t)e * DM; bf16* dst = (bf16*)(F.ws + (tb ? WS_V : WS_U)) + (size_t)e * DM;
          f32x4 v[4];
#pragma unroll
          for (int j = 0; j < 4; ++j) v[j] = *(const f32x4*)(src + 256 * j + 4 * lane);
          v4u o0, o1; o0.x = pk2(v[0][0], v[0][1]); o0.y = pk2(v[0][2], v[0][3]); o0.z = pk2(v[1][0], v[1][1]); o0.w = pk2(v[1][2], v[1][3]);
          o1.x = pk2(v[2][0], v[2][1]); o1.y = pk2(v[2][2], v[2][3]); o1.z = pk2(v[3][0], v[3][1]); o1.w = pk2(v[3][2], v[3][3]);
          *(v4u*)(dst + 8 * lane) = o0; *(v4u*)(dst + 512 + 8 * lane) = o1; } }
}
__device__ __forceinline__ void p1_xn(Frame& F) {
    const float* modp = (const float*)(F.ws + WS_MODP); float* mod = (float*)(F.ws + WS_MOD);
    if (F.vcu < 48 && F.tid < 256) { const int e = F.vcu * 256 + F.tid, b = e / 6144, n = e % 6144; float s = F.b_ada[n];
#pragma unroll
        for (int ks = 0; ks < 16; ++ks) s += modp[(ks * 2 + b) * 6144 + n];
        mod[e] = s; }
    LAS float* sc = (LAS float*)F.lds; LAS float* sh = sc + DM;
    const int row0 = F.vcu * (TT / F.G), nrows = TT / F.G, b = row0 >> 13;
    for (int n = F.tid; n < DM; n += NTHREADS) { float s0 = F.b_ada[n], s1 = F.b_ada[DM + n];
#pragma unroll
        for (int ks = 0; ks < 16; ++ks) { s0 += modp[(ks * 2 + b) * 6144 + n]; s1 += modp[(ks * 2 + b) * 6144 + DM + n]; }
        sh[n] = s0; sc[n] = 1.f + s1; }
    __syncthreads();
    bf16* xn = (bf16*)(F.ws + WS_XN);
    for (int r = F.wave; r < nrows; r += NWAVES) { const size_t m = (size_t)(row0 + r);
#pragma unroll
        for (int j = 0; j < 4; ++j) { const int d = 256 * j + 4 * F.lane; const f32x4 v = *(const f32x4*)(F.x + m * DM + d);
            u32x2 o; o.x = pk2(v[0] * sc[d] + sh[d], v[1] * sc[d + 1] + sh[d + 1]); o.y = pk2(v[2] * sc[d + 2] + sh[d + 2], v[3] * sc[d + 3] + sh[d + 3]);
            *(u32x2*)(xn + m * DM + d) = o; } }
    __syncthreads();
}
constexpr int KS_STRIDE = 144, VT_STRIDE = 520, KS_BYTES = 256 * KS_STRIDE, VT_BYTES = 64 * VT_STRIDE;
__device__ __forceinline__ void p3_attn_unit(Frame& F, int unit) {
    const int b = unit >> 7, kvh = (unit >> 6) & 1, n = unit & 63;
    const bf16* proj = (const bf16*)(F.ws + WS_PROJ); bf16* a2 = (bf16*)(F.ws + WS_A2);
    LAS unsigned char* Ks = F.lds; LAS unsigned char* Vt = F.lds + KS_BYTES;
    const int tid = F.tid, lane = F.lane, wave = F.wave, r32 = lane & 31, h = lane >> 5;
    const size_t tok0 = (size_t)b * SEQ + (size_t)n * 128;
#pragma unroll
    for (int i = 0; i < 4; ++i) { const int ci = tid + NTHREADS * i, row = ci >> 3, ch = ci & 7; const bool valid = (n > 0) || (row >= 128);
        const size_t tk = tok0 - 128 + row;
        v4u kv = (v4u){0u, 0u, 0u, 0u}, vv = (v4u){0u, 0u, 0u, 0u};
        if (valid) { kv = *(const v4u*)(proj + tk * NIN + 512 + kvh * 64 + ch * 8); vv = *(const v4u*)(proj + tk * NIN + 640 + kvh * 64 + ch * 8); }
        *(LAS v4u*)(Ks + row * KS_STRIDE + ch * 16) = kv;
        LAS bf16* vt = (LAS bf16*)(Vt + (ch * 8) * VT_STRIDE) + row;
        vt[0 * (VT_STRIDE / 2)] = (bf16)(vv.x & 0xffff); vt[1 * (VT_STRIDE / 2)] = (bf16)(vv.x >> 16); vt[2 * (VT_STRIDE / 2)] = (bf16)(vv.y & 0xffff); vt[3 * (VT_STRIDE / 2)] = (bf16)(vv.y >> 16);
        vt[4 * (VT_STRIDE / 2)] = (bf16)(vv.z & 0xffff); vt[5 * (VT_STRIDE / 2)] = (bf16)(vv.z >> 16); vt[6 * (VT_STRIDE / 2)] = (bf16)(vv.w & 0xffff); vt[7 * (VT_STRIDE / 2)] = (bf16)(vv.w >> 16); }
    __syncthreads();
    const int g = wave >> 1, hq = kvh * 4 + g; const float sink2 = F.sinks[hq] * LOG2E;
#pragma unroll 1
    for (int qt = 0; qt < 2; ++qt) {
        const int qi0 = (wave & 1) * 64 + qt * 32, t0 = qi0 >> 5; const size_t tokq = tok0 + qi0 + r32;
        bf16x8 qf[4];
#pragma unroll
        for (int s = 0; s < 4; ++s) qf[s] = *(const bf16x8*)(proj + tokq * NIN + hq * 64 + 16 * s + 8 * h);
        f32x16 sc[5];
#pragma unroll
        for (int kt = 0; kt < 5; ++kt) { sc[kt] = (f32x16){};
#pragma unroll
            for (int s = 0; s < 4; ++s) { const bf16x8 kf = *(const LAS bf16x8*)(Ks + (32 * (t0 + kt) + r32) * KS_STRIDE + (16 * s + 8 * h) * 2);
                sc[kt] = __builtin_amdgcn_mfma_f32_32x32x16_bf16(kf, qf[s], sc[kt], 0, 0, 0); } }
        const int qi = qi0 + r32; float m = sink2;
#pragma unroll
        for (int kt = 0; kt < 5; ++kt)
#pragma unroll
            for (int r = 0; r < 16; ++r) { const int sidx = 32 * (t0 + kt) + (r & 3) + 8 * (r >> 2) + 4 * h; const int rel = qi + 128 - sidx;
                const bool ok = (rel >= 0) && (rel < 128) && ((n > 0) || (sidx >= 128));
                const float v = ok ? sc[kt][r] : -INFINITY; sc[kt][r] = v; m = fmaxf(m, v); }
        m = fmaxf(m, __shfl_xor(m, 32));
        float l = 0.f;
#pragma unroll
        for (int kt = 0; kt < 5; ++kt)
#pragma unroll
            for (int r = 0; r < 16; ++r) { const float p = __builtin_amdgcn_exp2f(sc[kt][r] - m); sc[kt][r] = p; l += p; }
        l += __shfl_xor(l, 32); l += __builtin_amdgcn_exp2f(sink2 - m);
        f32x16 o[2]; o[0] = (f32x16){}; o[1] = (f32x16){};
#pragma unroll
        for (int kt = 0; kt < 5; ++kt)
#pragma unroll
            for (int s2 = 0; s2 < 2; ++s2) {
                u32x4 pw; pw.x = pg8::cvt_pk_bf16(sc[kt][8 * s2 + 0], sc[kt][8 * s2 + 1]); pw.y = pg8::cvt_pk_bf16(sc[kt][8 * s2 + 2], sc[kt][8 * s2 + 3]);
                pw.z = pg8::cvt_pk_bf16(sc[kt][8 * s2 + 4], sc[kt][8 * s2 + 5]); pw.w = pg8::cvt_pk_bf16(sc[kt][8 * s2 + 6], sc[kt][8 * s2 + 7]);
                const bf16x8 pf = __builtin_bit_cast(bf16x8, pw);
#pragma unroll
                for (int dt = 0; dt < 2; ++dt) { const LAS unsigned char* vp = Vt + (dt * 32 + r32) * VT_STRIDE + (32 * (t0 + kt) + 16 * s2 + 4 * h) * 2;
                    const u32x2 lo = *(const LAS u32x2*)vp, hi = *(const LAS u32x2*)(vp + 16);
                    const u32x4 vw = (u32x4){lo.x, lo.y, hi.x, hi.y};
                    o[dt] = __builtin_amdgcn_mfma_f32_32x32x16_bf16(__builtin_bit_cast(bf16x8, vw), pf, o[dt], 0, 0, 0); } }
        const float inv = 1.0f / l;
#pragma unroll
        for (int dt = 0; dt < 2; ++dt)
#pragma unroll
            for (int rg = 0; rg < 4; ++rg) { const int d0 = dt * 32 + 8 * rg + 4 * h;
                u32x2 w; w.x = pg8::cvt_pk_bf16(o[dt][4 * rg + 0] * inv, o[dt][4 * rg + 1] * inv); w.y = pg8::cvt_pk_bf16(o[dt][4 * rg + 2] * inv, o[dt][4 * rg + 3] * inv);
                *(u32x2*)(a2 + tokq * DM + hq * 64 + d0) = w; }
    }
    __syncthreads();
}
__device__ __forceinline__ void p3_pool_unit(Frame& F, int unit) {
    const bf16* proj = (const bf16*)(F.ws + WS_PROJ); bf16* a2 = (bf16*)(F.ws + WS_A2);
    const int cp = F.tid & 255, half = F.tid >> 8, gi = cp >> 6, w = 2 << gi;
    const int tstart = unit * 64 + half * 32, s0 = tstart & (SEQ - 1);
    const bf16* pc = proj + 768 + 2 * cp;
    float w0 = 0.f, w1 = 0.f;
    for (int j = 1; j <= w; ++j) if (s0 - j >= 0) { const unsigned u = *(const unsigned*)(pc + (size_t)(tstart - j) * NIN); w0 += bf_lo(u); w1 += bf_hi(u); }
    for (int i = 0; i < 32; ++i) { const int t = tstart + i, s = s0 + i;
        const unsigned u = *(const unsigned*)(pc + (size_t)t * NIN); const float p0 = bf_lo(u), p1 = bf_hi(u);
        w0 += p0; w1 += p1;
        if (s - w >= 0) { const unsigned uo = *(const unsigned*)(pc + (size_t)(t - w) * NIN); w0 -= bf_lo(uo); w1 -= bf_hi(uo); }
        const float rc = 1.0f / (float)((s + 1) < w ? (s + 1) : w);
        *(unsigned*)(a2 + (size_t)t * DM + 512 + 2 * cp) = pk2(w0 * rc - p0, w1 * rc - p1); }
}
__device__ __forceinline__ void p5_ln1(Frame& F) {
    const float* mod = (const float*)(F.ws + WS_MOD); const bf16* mix = (const bf16*)(F.ws + WS_MIX);
    bf16* x1 = (bf16*)(F.ws + WS_X1); bf16* h2 = (bf16*)(F.ws + WS_H2);
    const int gw = F.vcu * NWAVES + F.wave, lane = F.lane; const int rows_per_wave = TT / (F.G * NWAVES);
    const int row0 = gw * rows_per_wave, b = row0 >> 13;
    f32x4 g1[4], lg[4], lb[4], s2[4], h2s[4];
#pragma unroll
    for (int j = 0; j < 4; ++j) { const int d = 256 * j + 4 * lane;
        g1[j] = *(const f32x4*)(mod + b * 6144 + 2048 + d) + 1.0f; lg[j] = *(const f32x4*)(F.ln1_g + d); lb[j] = *(const f32x4*)(F.ln1_b + d);
        s2[j] = *(const f32x4*)(mod + b * 6144 + 4096 + d) + 1.0f; h2s[j] = *(const f32x4*)(mod + b * 6144 + 3072 + d); }
    for (int r = 0; r < rows_per_wave; ++r) { const size_t m = (size_t)(row0 + r);
        f32x4 v[4]; float s = 0.f;
#pragma unroll
        for (int j = 0; j < 4; ++j) { const int d = 256 * j + 4 * lane; const f32x4 xv = *(const f32x4*)(F.x + m * DM + d); const u32x2 mv = *(const u32x2*)(mix + m * DM + d);
            const f32x4 mf = (f32x4){bf_lo(mv.x), bf_hi(mv.x), bf_lo(mv.y), bf_hi(mv.y)};
            v[j] = xv * DN_ALPHA + g1[j] * mf; s += (v[j][0] + v[j][1]) + (v[j][2] + v[j][3]); }
        const float mean = wave_sum(s) * (1.f / DM); float q = 0.f;
#pragma unroll
        for (int j = 0; j < 4; ++j) { v[j] = v[j] - mean; q += (v[j][0] * v[j][0] + v[j][1] * v[j][1]) + (v[j][2] * v[j][2] + v[j][3] * v[j][3]); }
        const float rstd = 1.0f / sqrtf(wave_sum(q) * (1.f / DM) + LN_EPS);
#pragma unroll
        for (int j = 0; j < 4; ++j) { const int d = 256 * j + 4 * lane; const f32x4 y = v[j] * rstd * lg[j] + lb[j]; const f32x4 hh = y * s2[j] + h2s[j];
            u32x2 o; o.x = pk2(y[0], y[1]); o.y = pk2(y[2], y[3]); *(u32x2*)(x1 + m * DM + d) = o;
            u32x2 p; p.x = pk2(hh[0], hh[1]); p.y = pk2(hh[2], hh[3]); *(u32x2*)(h2 + m * DM + d) = p; } }
}
constexpr int KR_STRIDE = 272, KR_BYTES = 128 * KR_STRIDE;
#define INS16(a, v) do { _Pragma("unroll") for (int _i = 15; _i >= 1; --_i) a[_i] = __builtin_amdgcn_fmed3f(a[_i - 1], a[_i], (v)); a[0] = fmaxf(a[0], (v)); } while (0)
#define BITONIC16(a) do { _Pragma("unroll") for (int _st = 8; _st >= 1; _st >>= 1) { _Pragma("unroll") for (int _i = 0; _i < 16; ++_i) if ((_i & _st) == 0) { const float _x = a[_i], _y = a[_i + _st]; a[_i] = fmaxf(_x, _y); a[_i + _st] = fminf(_x, _y); } } } while (0)
__device__ __forceinline__ void p7_route(Frame& F) {
    const bf16* q = (const bf16*)(F.ws + WS_Q); unsigned short* pe = (unsigned short*)(F.ws + WS_PE); float* pg = (float*)(F.ws + WS_PG);
    const int tid = F.tid, lane = F.lane, wave = F.wave, r32 = lane & 31, h = lane >> 5;
    { const bf16* k1b = (const bf16*)(F.ws + WS_K1);
      for (int ci = tid; ci < 2 * 128 * 16; ci += NTHREADS) { const int side = ci >> 11, row = (ci >> 4) & 127, ch = ci & 15;
          *(LAS v4u*)(F.lds + side * KR_BYTES + row * KR_STRIDE + ch * 16) = *(const v4u*)(k1b + (size_t)side * 16384 + row * 128 + ch * 8); } }
    __syncthreads();
    LAS unsigned char* scr = F.lds + 2 * KR_BYTES + wave * 2048 + lane * 32;
    const int ntb = TT / 32;
    for (int tb = F.vcu; tb < ntb; tb += F.G) {
        const int head = wave; const size_t tok = (size_t)tb * 32 + r32;
        float vv[2][16];
#pragma unroll
        for (int side = 0; side < 2; ++side) {
            const bf16* qb = q + tok * NQD + head * 256 + side * 128;
            bf16x8 qf[8];
#pragma unroll
            for (int s = 0; s < 8; ++s) qf[s] = *(const bf16x8*)(qb + 16 * s + 8 * h);
            float a[16];
#pragma unroll
            for (int i = 0; i < 16; ++i) a[i] = -INFINITY;
#pragma unroll
            for (int kt = 0; kt < 4; ++kt) { f32x16 acc = (f32x16){};
#pragma unroll
                for (int s = 0; s < 8; ++s) { const bf16x8 kf = *(const LAS bf16x8*)(F.lds + side * KR_BYTES + (32 * kt + r32) * KR_STRIDE + (16 * s + 8 * h) * 2);
                    acc = __builtin_amdgcn_mfma_f32_32x32x16_bf16(kf, qf[s], acc, 0, 0, 0); }
#pragma unroll
                for (int r = 0; r < 16; ++r) { const unsigned key = (unsigned)(32 * kt + (r & 3) + 8 * (r >> 2)) | ((unsigned)h << 2);
                    const float v = __uint_as_float((__float_as_uint(acc[r]) & 0xFFFFFF80u) | key); INS16(a, v); }
                __builtin_amdgcn_sched_barrier(0); }
            float c[16];
#pragma unroll
            for (int i = 0; i < 16; ++i) c[i] = __shfl_xor(a[15 - i], 32);
#pragma unroll
            for (int i = 0; i < 16; ++i) c[i] = fmaxf(a[i], c[i]);
            BITONIC16(c);
#pragma unroll
            for (int i = 0; i < 16; ++i) vv[side][i] = c[i];
        }
        { v4u w1, w2;
#define PK4(L, b) ((__float_as_uint(L[b]) & 0x7Fu) | ((__float_as_uint(L[b + 1]) & 0x7Fu) << 8) | ((__float_as_uint(L[b + 2]) & 0x7Fu) << 16) | ((__float_as_uint(L[b + 3]) & 0x7Fu) << 24))
          w1.x = PK4(vv[0], 0); w1.y = PK4(vv[0], 4); w1.z = PK4(vv[0], 8); w1.w = PK4(vv[0], 12);
          w2.x = PK4(vv[1], 0); w2.y = PK4(vv[1], 4); w2.z = PK4(vv[1], 8); w2.w = PK4(vv[1], 12);
#undef PK4
          *(LAS v4u*)scr = w1; *(LAS v4u*)(scr + 16) = w2; }
        float c1[16], c2[16], top[16];
#pragma unroll
        for (int i = 0; i < 16; ++i) { c1[i] = __uint_as_float(__float_as_uint(vv[0][i]) & 0xFFFFFF80u); c2[i] = __uint_as_float(__float_as_uint(vv[1][i]) & 0xFFFFFF80u); top[i] = -INFINITY; }
#pragma unroll
        for (int ia = 0; ia < 16; ++ia)
#pragma unroll
            for (int ib = 0; ib < 16; ++ib) if ((ia + 1) * (ib + 1) <= 16) {
                const float sm = c1[ia] + c2[ib]; const float v = __uint_as_float((__float_as_uint(sm) & 0xFFFFFF00u) | (unsigned)(ia * 16 + ib)); INS16(top, v); }
        float ex[16], den = 0.f;
#pragma unroll
        for (int i = 0; i < 16; ++i) { ex[i] = __expf(top[i] - top[0]); den += ex[i]; }
        const float rden = 1.0f / den;
        LDS_WAIT();
        unsigned short ev[8]; float gv[8];
#pragma unroll
        for (int j = 0; j < 8; ++j) { const float t = h ? top[8 + j] : top[j]; const float e = h ? ex[8 + j] : ex[j];
            const unsigned code = __float_as_uint(t) & 0xFFu; const unsigned i1 = *(const LAS unsigned char*)(scr + (code >> 4)), i2 = *(const LAS unsigned char*)(scr + 16 + (code & 15u));
            ev[j] = (unsigned short)(i1 * 128u + i2); gv[j] = e * rden; }
        v4u ew; ew.x = ev[0] | ((unsigned)ev[1] << 16); ew.y = ev[2] | ((unsigned)ev[3] << 16); ew.z = ev[4] | ((unsigned)ev[5] << 16); ew.w = ev[6] | ((unsigned)ev[7] << 16);
        *(v4u*)(pe + tok * 128 + head * 16 + 8 * h) = ew;
        *(f32x4*)(pg + tok * 128 + head * 16 + 8 * h) = (f32x4){gv[0], gv[1], gv[2], gv[3]};
        *(f32x4*)(pg + tok * 128 + head * 16 + 8 * h + 4) = (f32x4){gv[4], gv[5], gv[6], gv[7]};
        LDS_WAIT();
    }
    __syncthreads();
}
__device__ __forceinline__ float dot2_bf16(unsigned w, unsigned x, float acc) { return __builtin_amdgcn_fdot2_f32_bf16(__builtin_bit_cast(bf16x2_t, w), __builtin_bit_cast(bf16x2_t, x), acc, false); }
__device__ __forceinline__ float gelu_erf(float x) { return 0.5f * x * (1.0f + erff(x * 0.70710678118654752f)); }
__device__ __forceinline__ void p8_peer(Frame& F) {
    const float* mod = (const float*)(F.ws + WS_MOD);
    const bf16* x1 = (const bf16*)(F.ws + WS_X1); const bf16* h2 = (const bf16*)(F.ws + WS_H2);
    const bf16* ut = (const bf16*)(F.ws + WS_U); const bf16* vt = (const bf16*)(F.ws + WS_V);
    const unsigned* pe = (const unsigned*)(F.ws + WS_PE); const float* pg = (const float*)(F.ws + WS_PG);
    const int gw = F.vcu * NWAVES + F.wave, NGW = F.G * NWAVES, lane = F.lane;
    const int b5 = (lane >> 5) & 1, b4 = (lane >> 4) & 1, b3 = (lane >> 3) & 1;
    for (int t = gw; t < TT; t += NGW) {
        const int b = t >> 13;
        unsigned hp[8];
#pragma unroll
        for (int j = 0; j < 4; ++j) { const u32x2 v = *(const u32x2*)(h2 + (size_t)t * DM + 256 * j + 4 * lane); hp[2 * j] = v.x; hp[2 * j + 1] = v.y; }
        const unsigned pe2 = pe[(size_t)t * 64 + lane]; const f32x2 pg2 = *(const f32x2*)(pg + (size_t)t * 128 + 2 * lane);
        float y[16];
#pragma unroll
        for (int i = 0; i < 16; ++i) y[i] = 0.f;
#pragma unroll 1
        for (int kb = 0; kb < 16; ++kb) {
            v4u ua[8], ub[8], va[8], vb[8];
#pragma unroll
            for (int kk = 0; kk < 8; ++kk) { const int k = kb * 8 + kk; const unsigned ew = (unsigned)__builtin_amdgcn_readlane((int)pe2, k >> 1); const unsigned e = (kk & 1) ? (ew >> 16) : (ew & 0xffffu);
                const bf16* ur = ut + (size_t)e * DM; const bf16* vr = vt + (size_t)e * DM;
                ua[kk] = *(const v4u*)(ur + 8 * lane); ub[kk] = *(const v4u*)(ur + 512 + 8 * lane);
                va[kk] = *(const v4u*)(vr + 8 * lane); vb[kk] = *(const v4u*)(vr + 512 + 8 * lane); }
            float p[8];
#pragma unroll
            for (int kk = 0; kk < 8; ++kk) { float s = 0.f;
#define DOT2(w, hh) s = dot2_bf16((w), (hh), s)
                DOT2(ua[kk].x, hp[0]); DOT2(ua[kk].y, hp[1]); DOT2(ua[kk].z, hp[2]); DOT2(ua[kk].w, hp[3]);
                DOT2(ub[kk].x, hp[4]); DOT2(ub[kk].y, hp[5]); DOT2(ub[kk].z, hp[6]); DOT2(ub[kk].w, hp[7]);
#undef DOT2
                p[kk] = s; }
            float q4[4], q2[2], q1;
#pragma unroll
            for (int i = 0; i < 4; ++i) { const float keep = b5 ? p[i + 4] : p[i], send = b5 ? p[i] : p[i + 4]; q4[i] = keep + __shfl_xor(send, 32); }
#pragma unroll
            for (int i = 0; i < 2; ++i) { const float keep = b4 ? q4[i + 2] : q4[i], send = b4 ? q4[i] : q4[i + 2]; q2[i] = keep + __shfl_xor(send, 16); }
            { const float keep = b3 ? q2[1] : q2[0], send = b3 ? q2[0] : q2[1]; q1 = keep + __shfl_xor(send, 8); }
            q1 += __shfl_xor(q1, 4); q1 += __shfl_xor(q1, 2); q1 += __shfl_xor(q1, 1);
            const int kmine = kb * 8 + 4 * b5 + 2 * b4 + b3;
            const float gl = __shfl(pg2.x, kmine >> 1), gh = __shfl(pg2.y, kmine >> 1);
            const float act = gelu_erf(q1) * ((kmine & 1) ? gh : gl);
#pragma unroll
            for (int kk = 0; kk < 8; ++kk) { const float a = __int_as_float(__builtin_amdgcn_readlane(__float_as_int(act), ((kk & 4) ? 32 : 0) + ((kk & 2) ? 16 : 0) + ((kk & 1) ? 8 : 0)));
                y[0] += a * bf_lo(va[kk].x); y[1] += a * bf_hi(va[kk].x); y[2] += a * bf_lo(va[kk].y); y[3] += a * bf_hi(va[kk].y);
                y[4] += a * bf_lo(va[kk].z); y[5] += a * bf_hi(va[kk].z); y[6] += a * bf_lo(va[kk].w); y[7] += a * bf_hi(va[kk].w);
                y[8] += a * bf_lo(vb[kk].x); y[9] += a * bf_hi(vb[kk].x); y[10] += a * bf_lo(vb[kk].y); y[11] += a * bf_hi(vb[kk].y);
                y[12] += a * bf_lo(vb[kk].z); y[13] += a * bf_hi(vb[kk].z); y[14] += a * bf_lo(vb[kk].w); y[15] += a * bf_hi(vb[kk].w); }
        }
        f32x4 v[4]; float s = 0.f;
#pragma unroll
        for (int j = 0; j < 4; ++j) { const int d = 256 * j + 4 * lane; const u32x2 xv = *(const u32x2*)(x1 + (size_t)t * DM + d); const f32x4 g2 = *(const f32x4*)(mod + b * 6144 + 5120 + d) + 1.0f;
            const f32x4 xf = (f32x4){bf_lo(xv.x), bf_hi(xv.x), bf_lo(xv.y), bf_hi(xv.y)}; const f32x4 yy = (f32x4){y[4 * j], y[4 * j + 1], y[4 * j + 2], y[4 * j + 3]};
            v[j] = xf * DN_ALPHA + g2 * yy; s += (v[j][0] + v[j][1]) + (v[j][2] + v[j][3]); }
        const float mean = wave_sum(s) * (1.f / DM); float qq = 0.f;
#pragma unroll
        for (int j = 0; j < 4; ++j) { v[j] = v[j] - mean; qq += (v[j][0] * v[j][0] + v[j][1] * v[j][1]) + (v[j][2] * v[j][2] + v[j][3] * v[j][3]); }
        const float rstd = 1.0f / sqrtf(wave_sum(qq) * (1.f / DM) + LN_EPS);
#pragma unroll
        for (int j = 0; j < 4; ++j) { const int d = 256 * j + 4 * lane; const f32x4 lg = *(const f32x4*)(F.ln2_g + d), lb = *(const f32x4*)(F.ln2_b + d);
            *(f32x4*)(F.out + (size_t)t * DM + d) = v[j] * rstd * lg + lb; }
    }
}
#ifndef NAIVE_MASK
#define NAIVE_MASK 0
#endif
template <int MODE>
__device__ __forceinline__ void naive_gemm(Frame& F, const bf16* A, const bf16* Bt, bf16* O, int M, int N, int K, const float* rope) {
    LAS float* As = (LAS float*)F.lds; LAS float* Bs = As + 64 * 33;
    const int tid = F.tid, ty = tid >> 4, tx = tid & 15; const int ntm = M / 64, ntn = N / 64;
    for (int tile = F.vcu; tile < ntm * ntn; tile += F.G) { const int tm = tile / ntn, tn = tile % ntn;
        float acc[2][4];
#pragma unroll
        for (int i = 0; i < 2; ++i)
#pragma unroll
            for (int j = 0; j < 4; ++j) acc[i][j] = 0.f;
        for (int k0 = 0; k0 < K; k0 += 32) {
            __syncthreads();
            for (int e = tid; e < 64 * 32; e += NTHREADS) { const int r = e >> 5, c = e & 31; As[r * 33 + c] = bf2f(A[(size_t)(tm * 64 + r) * K + k0 + c]); Bs[r * 33 + c] = bf2f(Bt[(size_t)(tn * 64 + r) * K + k0 + c]); }
            __syncthreads();
            for (int kk = 0; kk < 32; ++kk) { const float a0 = As[(ty * 2) * 33 + kk], a1 = As[(ty * 2 + 1) * 33 + kk];
#pragma unroll
                for (int j = 0; j < 4; ++j) { const float bb = Bs[(tx * 4 + j) * 33 + kk]; acc[0][j] += a0 * bb; acc[1][j] += a1 * bb; } }
        }
#pragma unroll
        for (int i = 0; i < 2; ++i) { const int row = tm * 64 + ty * 2 + i, col = tn * 64 + tx * 4; float v[4] = {acc[i][0], acc[i][1], acc[i][2], acc[i][3]};
            if (MODE == 1 && col < 640) { const int pos = row & 8191, ib = (col & 63) >> 1; const float sc = col < 512 ? QSCALE : 1.f;
                const float c0 = rope[((size_t)pos * 32 + ib) * 2], s0 = rope[((size_t)pos * 32 + ib) * 2 + 1], c1 = rope[((size_t)pos * 32 + ib + 1) * 2], s1 = rope[((size_t)pos * 32 + ib + 1) * 2 + 1];
                const float r0 = (v[0] * c0 - v[1] * s0) * sc, r1 = (v[1] * c0 + v[0] * s0) * sc, r2 = (v[2] * c1 - v[3] * s1) * sc, r3 = (v[3] * c1 + v[2] * s1) * sc; v[0] = r0; v[1] = r1; v[2] = r2; v[3] = r3; }
            u32x2 o; o.x = pk2(v[0], v[1]); o.y = pk2(v[2], v[3]); *(u32x2*)(O + (size_t)row * N + col) = o; }
    }
    __syncthreads();
}
__device__ __forceinline__ void naive_attn(Frame& F) {
    const bf16* proj = (const bf16*)(F.ws + WS_PROJ); bf16* a2 = (bf16*)(F.ws + WS_A2);
    const int gw = F.vcu * NWAVES + F.wave, NGW = F.G * NWAVES, lane = F.lane;
    for (int it = gw; it < TT * 8; it += NGW) { const int tok = it >> 3, hq = it & 7, kvh = hq >> 2, pos = tok & 8191, tokb = tok - pos;
        const bf16* qr = proj + (size_t)tok * NIN + hq * 64; const float sink2 = F.sinks[hq] * LOG2E;
        float sv[2];
#pragma unroll
        for (int u = 0; u < 2; ++u) { const int kp = pos - lane - 64 * u; float s = -INFINITY;
            if (kp >= 0) { const bf16* kr = proj + (size_t)(tokb + kp) * NIN + 512 + kvh * 64; s = 0.f; for (int d = 0; d < 64; ++d) s += bf2f(qr[d]) * bf2f(kr[d]); }
            sv[u] = s; }
        float m = fmaxf(fmaxf(sv[0], sv[1]), sink2);
#pragma unroll
        for (int o = 1; o < 64; o <<= 1) m = fmaxf(m, __shfl_xor(m, o));
        const float p0 = __builtin_amdgcn_exp2f(sv[0] - m), p1 = __builtin_amdgcn_exp2f(sv[1] - m);
        const float l = wave_sum(p0 + p1) + __builtin_amdgcn_exp2f(sink2 - m);
        float o = 0.f;
        for (int j = 0; j < 128; ++j) { const float pj = __shfl((j < 64) ? p0 : p1, j & 63); const int kp = pos - j;
            if (kp >= 0) o += pj * bf2f(proj[(size_t)(tokb + kp) * NIN + 640 + kvh * 64 + lane]); }
        a2[(size_t)tok * DM + hq * 64 + lane] = (bf16)f2bf(o / l); }
}
__device__ __forceinline__ void wave_argmax(float& v, int& id) {
#pragma unroll
    for (int o = 1; o < 64; o <<= 1) { const float ov = __shfl_xor(v, o); const int oi = __shfl_xor(id, o); if (ov > v || (ov == v && oi < id)) { v = ov; id = oi; } }
}
__device__ __forceinline__ void naive_route(Frame& F) {
    const bf16* q = (const bf16*)(F.ws + WS_Q); unsigned short* pe = (unsigned short*)(F.ws + WS_PE); float* pg = (float*)(F.ws + WS_PG);
    const int gw = F.vcu * NWAVES + F.wave, NGW = F.G * NWAVES, lane = F.lane;
    for (int it = gw; it < TT * 8; it += NGW) { const int tok = it >> 3, head = it & 7;
        float tv[2] = {0.f, 0.f}; int ti[2] = {0, 0};
#pragma unroll
        for (int side = 0; side < 2; ++side) { const bf16* qb = q + (size_t)tok * NQD + head * 256 + side * 128; const bf16* kb = (const bf16*)(F.ws + (side ? WS_K2 : WS_K1));
            float s0 = 0.f, s1 = 0.f; for (int c = 0; c < 128; ++c) { const float qq = bf2f(qb[c]); s0 += qq * bf2f(kb[lane * 128 + c]); s1 += qq * bf2f(kb[(lane + 64) * 128 + c]); }
            float mv = 0.f; int mi = 0;
            for (int r = 0; r < 16; ++r) { float bv; int bi; if (s0 >= s1) { bv = s0; bi = lane; } else { bv = s1; bi = lane + 64; }
                wave_argmax(bv, bi); if (bi == lane) s0 = -INFINITY; if (bi == lane + 64) s1 = -INFINITY; if (lane == r) { mv = bv; mi = bi; } }
            tv[side] = mv; ti[side] = mi; }
        float cs[4];
#pragma unroll
        for (int u = 0; u < 4; ++u) { const int id = lane * 4 + u; cs[u] = __shfl(tv[0], id >> 4) + __shfl(tv[1], id & 15); }
        float fv = 0.f; int fi = 0;
        for (int r = 0; r < 16; ++r) { float bv = cs[0]; int bi = lane * 4;
#pragma unroll
            for (int u = 1; u < 4; ++u) if (cs[u] > bv) { bv = cs[u]; bi = lane * 4 + u; }
            wave_argmax(bv, bi);
#pragma unroll
            for (int u = 0; u < 4; ++u) if (bi == lane * 4 + u) cs[u] = -INFINITY;
            if (lane == r) { fv = bv; fi = bi; } }
        const int e = __shfl(ti[0], fi >> 4) * 128 + __shfl(ti[1], fi & 15);
        const float mx = __shfl(fv, 0); const float ex = lane < 16 ? __expf(fv - mx) : 0.f; const float den = wave_sum(ex);
        if (lane < 16) { pe[(size_t)tok * 128 + head * 16 + lane] = (unsigned short)e; pg[(size_t)tok * 128 + head * 16 + lane] = ex / den; } }
}
__device__ __forceinline__ void naive_peer(Frame& F) {
    const float* mod = (const float*)(F.ws + WS_MOD);
    const bf16* x1 = (const bf16*)(F.ws + WS_X1); const bf16* h2 = (const bf16*)(F.ws + WS_H2);
    const unsigned short* pe = (const unsigned short*)(F.ws + WS_PE); const float* pg = (const float*)(F.ws + WS_PG);
    const int gw = F.vcu * NWAVES + F.wave, NGW = F.G * NWAVES, lane = F.lane;
    for (int t = gw; t < TT; t += NGW) { const int b = t >> 13;
        float hv[16], y[16];
#pragma unroll
        for (int j = 0; j < 4; ++j)
#pragma unroll
            for (int i = 0; i < 4; ++i) { hv[4 * j + i] = bf2f(h2[(size_t)t * DM + 256 * j + 4 * lane + i]); y[4 * j + i] = 0.f; }
        for (int k = 0; k < 128; ++k) { const int e = pe[(size_t)t * 128 + k]; const float g = pg[(size_t)t * 128 + k];
            const float* ur = F.pu + (size_t)e * DM; const float* vr = F.pv + (size_t)e * DM; float s = 0.f;
#pragma unroll
            for (int j = 0; j < 4; ++j) { const f32x4 u = *(const f32x4*)(ur + 256 * j + 4 * lane); s += u[0] * hv[4 * j] + u[1] * hv[4 * j + 1] + u[2] * hv[4 * j + 2] + u[3] * hv[4 * j + 3]; }
            const float a = gelu_erf(wave_sum(s)) * g;
#pragma unroll
            for (int j = 0; j < 4; ++j) { const f32x4 vv = *(const f32x4*)(vr + 256 * j + 4 * lane); y[4 * j] += a * vv[0]; y[4 * j + 1] += a * vv[1]; y[4 * j + 2] += a * vv[2]; y[4 * j + 3] += a * vv[3]; } }
        f32x4 v[4]; float s = 0.f;
#pragma unroll
        for (int j = 0; j < 4; ++j) { const int d = 256 * j + 4 * lane; const u32x2 xv = *(const u32x2*)(x1 + (size_t)t * DM + d); const f32x4 g2 = *(const f32x4*)(mod + b * 6144 + 5120 + d) + 1.0f;
            const f32x4 xf = (f32x4){bf_lo(xv.x), bf_hi(xv.x), bf_lo(xv.y), bf_hi(xv.y)}; const f32x4 yy = (f32x4){y[4 * j], y[4 * j + 1], y[4 * j + 2], y[4 * j + 3]};
            v[j] = xf * DN_ALPHA + g2 * yy; s += (v[j][0] + v[j][1]) + (v[j][2] + v[j][3]); }
        const float mean = wave_sum(s) * (1.f / DM); float qq = 0.f;
#pragma unroll
        for (int j = 0; j < 4; ++j) { v[j] = v[j] - mean; qq += (v[j][0] * v[j][0] + v[j][1] * v[j][1]) + (v[j][2] * v[j][2] + v[j][3] * v[j][3]); }
        const float rstd = 1.0f / sqrtf(wave_sum(qq) * (1.f / DM) + LN_EPS);
#pragma unroll
        for (int j = 0; j < 4; ++j) { const int d = 256 * j + 4 * lane; const f32x4 lg = *(const f32x4*)(F.ln2_g + d), lb = *(const f32x4*)(F.ln2_b + d);
            *(f32x4*)(F.out + (size_t)t * DM + d) = v[j] * rstd * lg + lb; } }
}
#ifndef MK_N_LAUNCHES
#define MK_N_LAUNCHES 1
#endif
constexpr int N_PHASES = 9;
struct Args { const float* in[18]; float* out; unsigned char* ws; int ph_lo, ph_hi; };
__global__ void __launch_bounds__(NTHREADS, 2) fwd_kernel(Args args) {
    extern __shared__ __attribute__((aligned(16))) unsigned char lds[];
    Frame F;
    F.lds = (LAS unsigned char*)lds;
    F.tid = threadIdx.x; F.lane = F.tid & 63; F.wave = __builtin_amdgcn_readfirstlane(F.tid >> 6);
    F.G = gridDim.x; { const int bx = blockIdx.x; F.vcu = (F.G % 8 == 0) ? (bx % 8) * (F.G / 8) + bx / 8 : bx; }
    F.x = args.in[0]; F.c = args.in[1]; F.w_ada = args.in[2]; F.b_ada = args.in[3]; F.w_in = args.in[4]; F.sinks = args.in[5]; F.w_pool = args.in[6]; F.pool_scale = args.in[7];
    F.w_out = args.in[8]; F.ln1_g = args.in[9]; F.ln1_b = args.in[10]; F.w_pq = args.in[11]; F.k1 = args.in[12]; F.k2 = args.in[13]; F.pu = args.in[14]; F.pv = args.in[15];
    F.ln2_g = args.in[16]; F.ln2_b = args.in[17]; F.out = args.out; F.ws = args.ws;
    volatile LAS unsigned* MISC = (volatile LAS unsigned*)(F.lds + MISC_OFF);
    for (int u = F.tid; u < (LDS_BYTES - LDSCTL_OFF) / 4; u += NTHREADS) ((LAS unsigned*)(F.lds + LDSCTL_OFF))[u] = 0u;
    __syncthreads();
    const int lo = args.ph_lo, hi = args.ph_hi;
    XcdBarrier bar; bar.bar = (unsigned*)(F.ws + WS_CTL) + CW_BAR; bar.x = 0; bar.st = nullptr;
    if (hi - lo > 1) bar = xcd_barrier_post((unsigned*)(F.ws + WS_CTL) + CW_BAR, MISC + 8);
#ifndef PH_MASK
#define PH_MASK 0x1ff
#endif
#define IN(k) (((PH_MASK >> (k)) & 1) && lo <= (k) && (k) < hi)
#define SEAM(k) do { if (IN(k) && IN((k) + 1)) xcd_barrier(bar); } while (0)
    if (IN(0)) { p0_prologue(F); } SEAM(0);
    if (IN(1)) { p1_xn(F); } SEAM(1);
    if (IN(2)) {
        if (NAIVE_MASK & 4) naive_gemm<1>(F, (const bf16*)(F.ws + WS_XN), (const bf16*)(F.ws + WS_WIN), (bf16*)(F.ws + WS_PROJ), TT, NIN, DM, (const float*)(F.ws + WS_ROPE));
        else { pg8::Gemm g{(const pg8::bf16_t*)(F.ws + WS_XN), (const pg8::bf16_t*)(F.ws + WS_WIN), TT, NIN, DM}; pg8::StaticOrder S; S.init(TT, NIN, F.G, (int)blockIdx.x);
            pg8::EpiRope E{(pg8::bf16_t*)(F.ws + WS_PROJ), NIN, (const float*)(F.ws + WS_ROPE), QSCALE};
            pg8::gemm_phase<pg8::EpiRope, pg8::StaticOrder, true, true>(F.lds, g, S, E); }
    } SEAM(2);
    if (IN(3)) {
        if (NAIVE_MASK & 8) naive_attn(F);
        else for (int u = F.vcu; u < 256; u += F.G) p3_attn_unit(F, u);
        for (int u = F.vcu; u < 256; u += F.G) p3_pool_unit(F, u);
    } SEAM(3);
    if (IN(4)) {
        if (NAIVE_MASK & 16) naive_gemm<0>(F, (const bf16*)(F.ws + WS_A2), (const bf16*)(F.ws + WS_WOUT), (bf16*)(F.ws + WS_MIX), TT, DM, DM, nullptr);
        else { pg8::Gemm g{(const pg8::bf16_t*)(F.ws + WS_A2), (const pg8::bf16_t*)(F.ws + WS_WOUT), TT, DM, DM}; pg8::StaticOrder S; S.init(TT, DM, F.G, (int)blockIdx.x);
            pg8::EpiPlain E{(pg8::bf16_t*)(F.ws + WS_MIX), DM};
            pg8::gemm_phase<pg8::EpiPlain, pg8::StaticOrder, true, true>(F.lds, g, S, E); }
    } SEAM(4);
    if (IN(5)) { p5_ln1(F); } SEAM(5);
    if (IN(6)) {
        if (NAIVE_MASK & 64) naive_gemm<0>(F, (const bf16*)(F.ws + WS_H2), (const bf16*)(F.ws + WS_WPQ), (bf16*)(F.ws + WS_Q), TT, NQD, DM, nullptr);
        else { pg8::Gemm g{(const pg8::bf16_t*)(F.ws + WS_H2), (const pg8::bf16_t*)(F.ws + WS_WPQ), TT, NQD, DM}; pg8::StaticOrder S; S.init(TT, NQD, F.G, (int)blockIdx.x);
            pg8::EpiPlain E{(pg8::bf16_t*)(F.ws + WS_Q), NQD};
            pg8::gemm_phase<pg8::EpiPlain, pg8::StaticOrder, true, true>(F.lds, g, S, E); }
    } SEAM(6);
    if (IN(7)) { if (NAIVE_MASK & 128) naive_route(F); else p7_route(F); } SEAM(7);
    if (IN(8)) { if (NAIVE_MASK & 256) naive_peer(F); else p8_peer(F); }
#undef IN
#undef SEAM
}

extern "C" void kernel_launch(void* const* d_in, const int* in_sizes, int n_in, void* d_out, int out_size, void* d_ws, size_t ws_size, hipStream_t stream) {
    static int grid = 0;
    if (grid == 0) {
        if (n_in != 18 || out_size != TT * DM || ws_size < WS_END) { fprintf(stderr, "kernel_launch: unexpected shapes (n_in %d out %d ws %zu)\n", n_in, out_size, ws_size); grid = -1; return; }
        int dev = 0, cus = 0, per_cu = 0;
        if (hipGetDevice(&dev) != hipSuccess || hipDeviceGetAttribute(&cus, hipDeviceAttributeMultiprocessorCount, dev) != hipSuccess) { grid = -1; return; }
        if (hipFuncSetAttribute((const void*)fwd_kernel, hipFuncAttributeMaxDynamicSharedMemorySize, LDS_BYTES) != hipSuccess) { fprintf(stderr, "kernel_launch: hipFuncSetAttribute failed\n"); grid = -1; return; }
        if (hipOccupancyMaxActiveBlocksPerMultiprocessor(&per_cu, (const void*)fwd_kernel, NTHREADS, LDS_BYTES) != hipSuccess || per_cu < 1) { fprintf(stderr, "kernel_launch: occupancy query says %d blocks per CU\n", per_cu); }
        (void)hipGetLastError();
        grid = cus;
        if (grid != 256) fprintf(stderr, "kernel_launch: built for 256 CUs, got %d\n", grid);
    }
    if (grid < 0) return;
    (void)hipMemsetAsync((char*)d_ws + WS_CTL, 0, CTL_ZERO_BYTES, stream);
    Args a{};
    for (int i = 0; i < 18; ++i) a.in[i] = (const float*)d_in[i];
    a.out = (float*)d_out; a.ws = (unsigned char*)d_ws;
#if MK_N_LAUNCHES == 1
    a.ph_lo = 0; a.ph_hi = N_PHASES;
    hipLaunchKernelGGL(fwd_kernel, dim3(grid), dim3(NTHREADS), LDS_BYTES, stream, a);
#else
    for (int p = 0; p < N_PHASES; ++p) { a.ph_lo = p; a.ph_hi = p + 1; hipLaunchKernelGGL(fwd_kernel, dim3(grid), dim3(NTHREADS), LDS_BYTES, stream, a); }
#endif
}
```

```cpp
#include <hip/hip_runtime.h>
#include <cstdio>
#include <cstdint>
#include <cmath>
namespace pg8 {
#define PG8_LAS __attribute__((address_space(3)))
typedef unsigned short bf16_t;
typedef short bf16x8 __attribute__((ext_vector_type(8)));
typedef float f32x4 __attribute__((ext_vector_type(4)));
typedef unsigned u32x4 __attribute__((ext_vector_type(4)));
constexpr int BM = 256, BK = 64, HALF = 128, HTB = HALF * BK * 2  , STAGE_BYTES = 8 * HTB, NXCD = 8, WGM = 8;

__host__ __device__ __forceinline__ int lds_byte(int r, int c) { const int st = (r >> 4) * 2 + (c >> 5), rr = r & 15, cc = c & 31, ob = rr * 64 + cc * 2; return st * 1024 + (ob ^ (((ob >> 9) & 1) << 5)); }
__host__ __device__ __forceinline__ void stage_rc(int b, int& R, int& C) { const int st = b / 1024, sb = b % 1024, swz = sb ^ (((sb >> 9) & 1) << 5); R = (st >> 1) * 16 + swz / 64; C = (st & 1) * 32 + (swz % 64) / 2; }
__host__ __device__ __forceinline__ int perm32(int rho) { const int n = rho >> 4, i = rho & 15; return 8 * (i >> 2) + 4 * n + (i & 3); }

struct Unit { int pm, pn; };
struct Gemm { const bf16_t* A; const bf16_t* Bt; int M, N, K; };

struct StaticOrder {
    int nM, nN, nwg, G, c;
    __host__ __device__ void init(int M, int N, int G_, int c_) { nM = M / BM; nN = N / BM; nwg = nM * nN; G = G_; c = c_; }
    __host__ __device__ bool next(int i, Unit& u) const {
        const long L = (long)i * G + c; if (L >= nwg) return false;
        int wgid = (int)L; { const int q = nwg / NXCD, r = nwg % NXCD, xcd = wgid % NXCD, off = wgid / NXCD; wgid = (xcd < r ? xcd * (q + 1) : r * (q + 1) + (xcd - r) * q) + off; }
        const int nig = WGM * nN, gid = wgid / nig, fm = gid * WGM, gsz = (nM - fm) < WGM ? (nM - fm) : WGM;
        u.pm = fm + ((wgid % nig) % gsz); u.pn = (wgid % nig) / gsz; return true;
    }
    __device__ __forceinline__ void a_ready(const Unit&) const {}
    __device__ __forceinline__ void done(const Unit&) const {}
};

__device__ __forceinline__ unsigned cvt_pk_bf16(float lo, float hi) { unsigned r; asm volatile("v_cvt_pk_bf16_f32 %0, %1, %2" : "=v"(r) : "v"(lo), "v"(hi)); return r; }

struct EpiPlain {
    static constexpr bool PERM = true, AFTER_DRAIN = false;
    bf16_t* O; int ldc;
    __device__ __forceinline__ void operator()(const f32x4 (&acc)[2][2][4][2], const Unit& u, int wr, int wc, int fr, int fq) const {
        const int row0 = u.pm * BM + wr * 64 + fr; const int col0 = u.pn * BM + wc * 32 + 8 * fq;
#pragma unroll
        for (int ai = 0; ai < 2; ++ai)
#pragma unroll
            for (int m = 0; m < 4; ++m) { bf16_t* rowp = O + (size_t)(row0 + ai * HALF + m * 16) * ldc + col0;
#pragma unroll
                for (int bj = 0; bj < 2; ++bj) { const f32x4 v0 = acc[ai][bj][m][0], v1 = acc[ai][bj][m][1];
                    u32x4 w; w.x = cvt_pk_bf16(v0[0], v0[1]); w.y = cvt_pk_bf16(v0[2], v0[3]); w.z = cvt_pk_bf16(v1[0], v1[1]); w.w = cvt_pk_bf16(v1[2], v1[3]);
                    *(u32x4*)(rowp + bj * HALF) = w; } }
    }
};
struct EpiRope {
    static constexpr bool PERM = true, AFTER_DRAIN = false;
    bf16_t* O; int ldc; const float* rope; float qscale;
    __device__ __forceinline__ void operator()(const f32x4 (&acc)[2][2][4][2], const Unit& u, int wr, int wc, int fr, int fq) const {
        const int row0 = u.pm * BM + wr * 64 + fr; const int col0 = u.pn * BM + wc * 32 + 8 * fq;
#pragma unroll
        for (int ai = 0; ai < 2; ++ai)
#pragma unroll
            for (int m = 0; m < 4; ++m) { const int row = row0 + ai * HALF + m * 16; bf16_t* rowp = O + (size_t)row * ldc + col0; const int pos = row & 8191;
#pragma unroll
                for (int bj = 0; bj < 2; ++bj) { f32x4 v0 = acc[ai][bj][m][0], v1 = acc[ai][bj][m][1];
                    const int colt = u.pn * BM + bj * HALF;
                    if (colt < 640) {
                        const int c = col0 + bj * HALF, ib = (c & 63) >> 1;
                        const f32x4 cs0 = *(const f32x4*)(rope + ((size_t)pos * 32 + ib) * 2), cs1 = *(const f32x4*)(rope + ((size_t)pos * 32 + ib) * 2 + 4);
                        const float sc = colt < 512 ? qscale : 1.0f;
                        f32x4 r0, r1;
                        r0[0] = (v0[0] * cs0[0] - v0[1] * cs0[1]) * sc; r0[1] = (v0[1] * cs0[0] + v0[0] * cs0[1]) * sc;
                        r0[2] = (v0[2] * cs0[2] - v0[3] * cs0[3]) * sc; r0[3] = (v0[3] * cs0[2] + v0[2] * cs0[3]) * sc;
                        r1[0] = (v1[0] * cs1[0] - v1[1] * cs1[1]) * sc; r1[1] = (v1[1] * cs1[0] + v1[0] * cs1[1]) * sc;
                        r1[2] = (v1[2] * cs1[2] - v1[3] * cs1[3]) * sc; r1[3] = (v1[3] * cs1[2] + v1[2] * cs1[3]) * sc;
                        v0 = r0; v1 = r1;
                    }
                    u32x4 w; w.x = cvt_pk_bf16(v0[0], v0[1]); w.y = cvt_pk_bf16(v0[2], v0[3]); w.z = cvt_pk_bf16(v1[0], v1[1]); w.w = cvt_pk_bf16(v1[2], v1[3]);
                    *(u32x4*)(rowp + bj * HALF) = w; } }
    }
};

template <class Epi, class Sched, bool ALIGN_EPI = false, bool SP2 = false>
__device__ __forceinline__ void gemm_phase(PG8_LAS unsigned char* lds, const Gemm g, const Sched& S, const Epi& E) {
    const int tid = threadIdx.x, wid = __builtin_amdgcn_readfirstlane(tid >> 6), lane = tid & 63, wr = wid >> 2, wc = wid & 3, fr = lane & 15, fq = lane >> 4;
    const int K = g.K, nt = K / BK;
    unsigned voffA[2], voffB[2];
#pragma unroll
    for (int i = 0; i < 2; ++i) { int R, C; stage_rc(tid * 16 + i * 8192, R, C); const int Rb = Epi::PERM ? ((R & ~31) + perm32(R & 31)) : R;
        voffA[i] = (unsigned)(R * K + C) * 2u; voffB[i] = (unsigned)(Rb * K + C) * 2u; }
    const size_t kstep = (size_t)(BK * 2);
    const size_t hstep = (size_t)HALF * K * 2;
    const size_t tstep = 2 * hstep;
    const unsigned ldsw = (unsigned)wid * 1024u;
    const int aoff = lds_byte(wr * 64 + fr, fq * 8), boff = lds_byte(wc * 32 + fr, fq * 8);
#define PG8_SA(b, h) (((b) * 2 + (h)) * HTB)
#define PG8_SB(b, h) ((4 + (b) * 2 + (h)) * HTB)
#define PG8_STAGE(bufoff, gbase, voff) do { _Pragma("unroll") for (int _i = 0; _i < 2; ++_i) \
        __builtin_amdgcn_global_load_lds((const unsigned*)((const char*)(gbase) + (voff)[_i]), (PG8_LAS unsigned*)(lds + (bufoff) + ldsw + _i * 8192), 16, 0, 0); } while (0)
#define PG8_LDA(dst, b, h) do { _Pragma("unroll") for (int m = 0; m < 4; ++m) _Pragma("unroll") for (int k = 0; k < 2; ++k) dst[m][k] = *(const PG8_LAS bf16x8*)(lds + PG8_SA(b, h) + aoff + m * 2048 + k * 1024); } while (0)
#define PG8_LDB(dst, b, h) do { _Pragma("unroll") for (int n = 0; n < 2; ++n) _Pragma("unroll") for (int k = 0; k < 2; ++k) dst[n][k] = *(const PG8_LAS bf16x8*)(lds + PG8_SB(b, h) + boff + n * 2048 + k * 1024); } while (0)
#define PG8_MMA(ai, bj, At, Bt) do { __builtin_amdgcn_s_setprio(1); _Pragma("unroll") for (int m = 0; m < 4; ++m) _Pragma("unroll") for (int n = 0; n < 2; ++n) _Pragma("unroll") for (int k = 0; k < 2; ++k) \
        acc[ai][bj][m][n] = __builtin_amdgcn_mfma_f32_16x16x32_bf16(Bt[n][k], At[m][k], acc[ai][bj][m][n], 0, 0, 0); __builtin_amdgcn_s_setprio(0); } while (0)
#define PG8_WAIT_V(n) asm volatile("s_waitcnt vmcnt(" #n ")" ::: "memory")
#define PG8_WAIT_L(n) asm volatile("s_waitcnt lgkmcnt(" #n ")" ::: "memory")
#define PG8_BAR __builtin_amdgcn_s_barrier()
#define PG8_SCHED __builtin_amdgcn_sched_barrier(0)
    Unit cur, nxt; int ui = 0;
    if (!S.next(0, cur)) return;
    f32x4 acc[2][2][4][2];
#pragma unroll
    for (int a = 0; a < 2; ++a)
#pragma unroll
        for (int b = 0; b < 2; ++b)
#pragma unroll
            for (int m = 0; m < 4; ++m)
#pragma unroll
                for (int n = 0; n < 2; ++n) acc[a][b][m][n] = (f32x4){0.f, 0.f, 0.f, 0.f};
    bf16x8 At[4][2], B0[2][2], B1[2][2];
    const char* cA = (const char*)g.A + (size_t)cur.pm * tstep; const char* cB = (const char*)g.Bt + (size_t)cur.pn * tstep;
    S.a_ready(cur);
    if constexpr (SP2) {
        PG8_STAGE(PG8_SB(0, 0), cB, voffB); PG8_STAGE(PG8_SB(0, 1), cB + hstep, voffB); PG8_STAGE(PG8_SA(0, 0), cA, voffA); PG8_STAGE(PG8_SA(0, 1), cA + hstep, voffA);
        if (wr == 1) PG8_BAR;
        PG8_WAIT_V(2); PG8_BAR;
        PG8_STAGE(PG8_SB(1, 0), cB + kstep, voffB); PG8_STAGE(PG8_SA(1, 0), cA + kstep, voffA); PG8_STAGE(PG8_SB(1, 1), cB + hstep + kstep, voffB);
        PG8_WAIT_V(6); PG8_BAR;
    } else {
        PG8_STAGE(PG8_SB(0, 0), cB, voffB); PG8_STAGE(PG8_SA(0, 0), cA, voffA); PG8_STAGE(PG8_SB(0, 1), cB + hstep, voffB); PG8_STAGE(PG8_SA(0, 1), cA + hstep, voffA);
        if (wr == 1) PG8_BAR;
        PG8_WAIT_V(4); PG8_BAR;
        PG8_STAGE(PG8_SB(1, 0), cB + kstep, voffB); PG8_STAGE(PG8_SA(1, 0), cA + kstep, voffA); PG8_STAGE(PG8_SB(1, 1), cB + hstep + kstep, voffB);
        PG8_WAIT_V(6); PG8_BAR;
    }
    for (;;) {
        const bool has_next = S.next(ui + 1, nxt);
        const char* nA = has_next ? (const char*)g.A + (size_t)nxt.pm * tstep : cA; const char* nB = has_next ? (const char*)g.Bt + (size_t)nxt.pn * tstep : cB;
        for (int t = 0; t < nt; t += 2) {
            const bool last = (t == nt - 2);
            const char* a1 = cA + (size_t)(t + 1) * kstep;
            const char* a2 = last ? nA : cA + (size_t)(t + 2) * kstep; const char* b2 = last ? nB : cB + (size_t)(t + 2) * kstep;
            const char* a3 = a2 + kstep; const char* b3 = b2 + kstep;
            if (last && has_next) S.a_ready(nxt);
            if constexpr (SP2) {
            PG8_LDB(B0, 0, 0); PG8_LDB(B1, 0, 1); PG8_SCHED; PG8_LDA(At, 0, 0); PG8_STAGE(PG8_SA(1, 1), a1 + hstep, voffA);
            PG8_WAIT_V(8); PG8_WAIT_L(0); PG8_BAR; PG8_MMA(0, 0, At, B0); PG8_MMA(0, 1, At, B1); PG8_BAR; PG8_SCHED;
            PG8_LDA(At, 0, 1); PG8_STAGE(PG8_SB(0, 0), b2, voffB); PG8_STAGE(PG8_SB(0, 1), b2 + hstep, voffB); PG8_STAGE(PG8_SA(0, 0), a2, voffA);
            PG8_WAIT_V(8); PG8_WAIT_L(0); PG8_BAR; PG8_MMA(1, 0, At, B0); PG8_MMA(1, 1, At, B1); PG8_BAR; PG8_SCHED;
            PG8_LDB(B0, 1, 0); PG8_LDB(B1, 1, 1); PG8_SCHED; PG8_LDA(At, 1, 0); PG8_STAGE(PG8_SA(0, 1), a2 + hstep, voffA);
            PG8_WAIT_V(8); PG8_WAIT_L(0); PG8_BAR; PG8_MMA(0, 0, At, B0); PG8_MMA(0, 1, At, B1); PG8_BAR; PG8_SCHED;
            PG8_LDA(At, 1, 1); PG8_STAGE(PG8_SB(1, 0), b3, voffB); PG8_STAGE(PG8_SB(1, 1), b3 + hstep, voffB); PG8_STAGE(PG8_SA(1, 0), a3, voffA);
            PG8_WAIT_V(8); PG8_WAIT_L(0); PG8_BAR; PG8_MMA(1, 0, At, B0); PG8_MMA(1, 1, At, B1); PG8_BAR; PG8_SCHED;
            } else {
            PG8_LDB(B0, 0, 0); PG8_SCHED; PG8_LDA(At, 0, 0); PG8_STAGE(PG8_SA(1, 1), a1 + hstep, voffA);
            PG8_WAIT_L(8); PG8_BAR; PG8_WAIT_L(0); PG8_MMA(0, 0, At, B0); PG8_BAR; PG8_SCHED;
            PG8_LDB(B1, 0, 1); PG8_STAGE(PG8_SB(0, 0), b2, voffB);
            PG8_BAR; PG8_WAIT_L(0); PG8_MMA(0, 1, At, B1); PG8_BAR;
            PG8_LDA(At, 0, 1); PG8_STAGE(PG8_SA(0, 0), a2, voffA);
            PG8_BAR; PG8_WAIT_L(0); PG8_MMA(1, 0, At, B0); PG8_BAR; PG8_SCHED;
            PG8_STAGE(PG8_SB(0, 1), b2 + hstep, voffB);
            PG8_WAIT_V(6); PG8_BAR; PG8_MMA(1, 1, At, B1); PG8_BAR;
            PG8_LDB(B0, 1, 0); PG8_SCHED; PG8_LDA(At, 1, 0); PG8_STAGE(PG8_SA(0, 1), a2 + hstep, voffA);
            PG8_WAIT_L(8); PG8_BAR; PG8_WAIT_L(0); PG8_MMA(0, 0, At, B0); PG8_BAR; PG8_SCHED;
            PG8_LDB(B1, 1, 1); PG8_STAGE(PG8_SB(1, 0), b3, voffB);
            PG8_BAR; PG8_WAIT_L(0); PG8_MMA(0, 1, At, B1); PG8_BAR;
            PG8_LDA(At, 1, 1); PG8_STAGE(PG8_SA(1, 0), a3, voffA);
            PG8_BAR; PG8_WAIT_L(0); PG8_MMA(1, 0, At, B0); PG8_BAR; PG8_SCHED;
            PG8_STAGE(PG8_SB(1, 1), b3 + hstep, voffB);
            PG8_WAIT_V(6); PG8_BAR; PG8_MMA(1, 1, At, B1); PG8_BAR;
            }
        }
        if constexpr (ALIGN_EPI) { if (wr == 0) PG8_BAR; }
        if constexpr (!Epi::AFTER_DRAIN) { E(acc, cur, wr, wc, fr, fq); S.done(cur); }
        if (!has_next) break;
#pragma unroll
        for (int a = 0; a < 2; ++a)
#pragma unroll
            for (int b = 0; b < 2; ++b)
#pragma unroll
                for (int m = 0; m < 4; ++m)
#pragma unroll
                    for (int n = 0; n < 2; ++n) acc[a][b][m][n] = (f32x4){0.f, 0.f, 0.f, 0.f};
        cur = nxt; cA = nA; cB = nB; ++ui;
        if constexpr (ALIGN_EPI) { if (wr == 1) PG8_BAR; }
    }
    PG8_WAIT_V(0);
    if constexpr (!ALIGN_EPI) { if (wr == 0) PG8_BAR; }
    PG8_BAR;
    if constexpr (Epi::AFTER_DRAIN) { E.fused(acc, cur, wr, wc, fr, fq, lds, wid, lane); S.done(cur); }
#undef PG8_SA
#undef PG8_SB
#undef PG8_STAGE
#undef PG8_LDA
#undef PG8_LDB
#undef PG8_MMA
#undef PG8_WAIT_V
#undef PG8_WAIT_L
#undef PG8_BAR
#undef PG8_SCHED
}
}
#define GAS __attribute__((address_space(1)))
#define LAS __attribute__((address_space(3)))
typedef unsigned short bf16;
typedef unsigned v4u __attribute__((ext_vector_type(4)));
typedef float f32x4 __attribute__((ext_vector_type(4)));
typedef short bf16x8 __attribute__((ext_vector_type(8)));
typedef GAS unsigned gu32;
typedef GAS unsigned long long gu64;
#define RLX_AGENT __ATOMIC_RELAXED, __HIP_MEMORY_SCOPE_AGENT
#define LDS_WAIT() asm volatile("s_waitcnt lgkmcnt(0)" ::: "memory")
#define VM_WAIT() asm volatile("s_waitcnt vmcnt(0)" ::: "memory")
__device__ __forceinline__ unsigned long long rt() { return __builtin_amdgcn_s_memrealtime(); }
__device__ __forceinline__ unsigned f2bf(float f) { unsigned u = __builtin_bit_cast(unsigned, f); return (u + 0x7fffu + ((u >> 16) & 1u)) >> 16; }
__device__ __forceinline__ unsigned pk2(float lo, float hi) { return f2bf(lo) | (f2bf(hi) << 16); }
#define XB_TMO      128
#define XB_XCNT(j)  (256  + 64 * (j))
#define XB_XSUB(j)  (1280 + 64 * (j))
#define XB_XGEN(j)  (2304 + 64 * (j))
#define XB_TOP      3328
#define XB_TOPGEN   3392
#define XCD_BAR_WORDS 3456
#define XB_SPIN_CAP (1u << 18)

__device__ __forceinline__ unsigned xb_ld(unsigned* p)              { return __hip_atomic_load(p, __ATOMIC_RELAXED, __HIP_MEMORY_SCOPE_AGENT); }
__device__ __forceinline__ unsigned xb_add(unsigned* p, unsigned v) { return __hip_atomic_fetch_add(p, v, __ATOMIC_RELAXED, __HIP_MEMORY_SCOPE_AGENT); }
__device__ __forceinline__ unsigned xb_xcc_id() { return (unsigned)__builtin_amdgcn_s_getreg((3 << 11) | 20) & 0xFu; }
#define XB_SPIN(cond, bar) do { unsigned _sp = 0; while (cond) { __builtin_amdgcn_s_sleep(1); \
    if ((++_sp & 255u) == 0u) { if (xb_ld(&(bar)[XB_TMO])) break; if (_sp > XB_SPIN_CAP) { atomicAdd(&(bar)[XB_TMO], 1u); break; } } } } while (0)

struct XcdBarrier {
    unsigned* bar; unsigned x;
    volatile LAS unsigned* st;
};

__device__ __forceinline__ XcdBarrier xcd_barrier_post(unsigned* bar, volatile LAS unsigned* st) {
    XcdBarrier b; b.bar = bar; b.x = xb_xcc_id(); b.st = st;
    if (threadIdx.x == 0) (void)xb_add(&bar[XB_XCNT(b.x)], 1u);
    return b;
}
__device__ __forceinline__ void xcd_barrier_complete(unsigned* bar, unsigned x, unsigned& nloc, unsigned& nx) {
    const unsigned G = gridDim.x * gridDim.y * gridDim.z;
    unsigned sum, cnt, mine, sp = 0u;
    for (;;) {
        sum = 0u; cnt = 0u; mine = 0u;
#pragma unroll
        for (unsigned j = 0; j < 16; ++j) { const unsigned c = xb_ld(&bar[XB_XCNT(j)]); sum += c; cnt += (c > 0u) ? 1u : 0u; mine = (j == x) ? c : mine; }
        if (sum == G) break;
        __builtin_amdgcn_s_sleep(1);
        if ((++sp & 255u) == 0u) { if (xb_ld(&bar[XB_TMO])) break; if (sp > XB_SPIN_CAP) { atomicAdd(&bar[XB_TMO], 1u); break; } }
    }
    nloc = mine > 0u ? mine : 1u; nx = cnt > 0u ? cnt : 1u;
}

__device__ __forceinline__ void xcd_barrier(const XcdBarrier& b) {
    asm volatile("s_waitcnt vmcnt(0)" ::: "memory");
    __syncthreads();
    if (threadIdx.x == 0) {
        unsigned* bar = b.bar;
        __builtin_amdgcn_s_waitcnt(0);
        unsigned nloc = b.st[0], nx = b.st[1];
        if (nloc == 0u) { xcd_barrier_complete(bar, b.x, nloc, nx); b.st[0] = nloc; b.st[1] = nx; }
        const unsigned old = xb_add(&bar[XB_XSUB(b.x)], 1u);
        const unsigned gen = old / nloc;
        if (old + 1u == (gen + 1u) * nloc) {
            __builtin_amdgcn_fence(__ATOMIC_RELEASE, "agent");
            asm volatile("s_waitcnt vmcnt(0)" ::: "memory");
            const unsigned og = xb_add(&bar[XB_TOP], 1u);
            const unsigned tg = og / nx;
            if (og + 1u == (tg + 1u) * nx) xb_add(&bar[XB_TOPGEN], 1u);
            else XB_SPIN(xb_ld(&bar[XB_TOPGEN]) == tg, bar);
            __builtin_amdgcn_fence(__ATOMIC_ACQUIRE, "agent");
            xb_add(&bar[XB_XGEN(b.x)], 1u);
            asm volatile("s_waitcnt vmcnt(0)" ::: "memory");
        } else {
            XB_SPIN(xb_ld(&bar[XB_XGEN(b.x)]) == gen, bar);
            __builtin_amdgcn_fence(__ATOMIC_ACQUIRE, "agent");
            asm volatile("s_waitcnt vmcnt(0)" ::: "memory");
        }
    }
    __syncthreads();
}
constexpr int NWAVES = 8, NTHREADS = 512;
constexpr int TT = 16384, DM = 1024, SEQ = 8192, NIN = 1280, NQD = 2048, NEXP = 16384;
constexpr float DN_ALPHA = 1.189207115002721f;
constexpr float LN_EPS = 1e-5f;
constexpr float LOG2E = 1.4426950408889634f;
constexpr float QSCALE = 0.125f * LOG2E;

constexpr size_t MiB = 1u << 20;
constexpr size_t WS_CTL = 0, CTL_ZERO_BYTES = 64 * 1024;
constexpr size_t WS_MODP = 1 * MiB;
constexpr size_t WS_MOD = 1 * MiB + 896 * 1024;
constexpr size_t WS_ROPE = 2 * MiB;
constexpr size_t WS_WIN = 4 * MiB;
constexpr size_t WS_K1 = 6 * MiB + 512 * 1024, WS_K2 = WS_K1 + 32 * 1024;
constexpr size_t WS_WOUT = 7 * MiB;
constexpr size_t WS_WPQ = 9 * MiB;
constexpr size_t WS_SU = 13 * MiB, WS_SV = 13 * MiB + 65536;
constexpr size_t WS_U = 16 * MiB, WS_V = 32 * MiB;
constexpr size_t WS_XN = 80 * MiB;
constexpr size_t WS_MIX = 80 * MiB;
constexpr size_t WS_PE = 80 * MiB, WS_PG = 84 * MiB;
constexpr size_t WS_PROJ = 112 * MiB;
constexpr size_t WS_A2 = 152 * MiB;
constexpr size_t WS_X1 = 184 * MiB, WS_H2 = 216 * MiB;
constexpr size_t WS_Q = 112 * MiB;
constexpr size_t WS_END = 248 * MiB;
constexpr int CW_BAR = 4096;

constexpr int RING_BYTES = 131072, LDSCTL_OFF = RING_BYTES, MISC_OFF = LDSCTL_OFF + 320, LDS_BYTES = 147456;

typedef float f32x16 __attribute__((ext_vector_type(16)));
typedef float f32x2 __attribute__((ext_vector_type(2)));
typedef unsigned u32x2 __attribute__((ext_vector_type(2)));
typedef unsigned u32x4 __attribute__((ext_vector_type(4)));
typedef __bf16 bf16x2_t __attribute__((ext_vector_type(2)));
struct Frame {
    LAS unsigned char* lds;
    int tid, lane, wave, vcu, G;
    const float *x, *c, *w_ada, *b_ada, *w_in, *sinks, *w_pool, *pool_scale, *w_out, *ln1_g, *ln1_b, *w_pq, *k1, *k2, *pu, *pv, *ln2_g, *ln2_b;
    float* out; unsigned char* ws;
};
__device__ __forceinline__ float wave_sum(float v) {
#pragma unroll
    for (int o = 1; o < 64; o <<= 1) v += __shfl_xor(v, o);
    return v;
}
__device__ __forceinline__ float bf_lo(unsigned u) { return __uint_as_float(u << 16); }
__device__ __forceinline__ float bf_hi(unsigned u) { return __uint_as_float(u & 0xffff0000u); }
__device__ __forceinline__ float bf2f(bf16 b) { return __uint_as_float((unsigned)b << 16); }

template <int MODE>
__device__ __forceinline__ void transpose_item(const float* W, int ldw, bf16* WT, int ldt, int k0, int n0, LAS float* scr, int lane) {
    int nsrc = n0 + (lane & 31);
    if (MODE == 1 && nsrc < 640) { const int hd = nsrc >> 6, w = nsrc & 63; nsrc = hd * 64 + (w >> 1) + 32 * (w & 1); }
#pragma unroll 8
    for (int i = 0; i < 32; ++i) { const int kk = 2 * i + (lane >> 5); scr[kk * 33 + (lane & 31)] = W[(size_t)(k0 + kk) * ldw + nsrc]; }
    LDS_WAIT(); asm volatile("" ::: "memory");
    const int c = lane & 7;
#pragma unroll
    for (int j = 0; j < 4; ++j) { const int n = (lane >> 3) + 8 * j; const LAS float* s = scr + (8 * c) * 33 + n;
        v4u o; o.x = pk2(s[0 * 33], s[1 * 33]); o.y = pk2(s[2 * 33], s[3 * 33]); o.z = pk2(s[4 * 33], s[5 * 33]); o.w = pk2(s[6 * 33], s[7 * 33]);
        *(GAS v4u*)(WT + (size_t)(n0 + n) * ldt + k0 + 8 * c) = o; }
    LDS_WAIT(); asm volatile("" ::: "memory");
}
__device__ __forceinline__ void sincos_d(double a, float& s, float& c) {
    const double TWO_PI = 6.283185307179586476925, PI = 3.141592653589793238462643;
    double r = a - TWO_PI * rint(a / TWO_PI);
    double sg = 1.0;
    if (r > 0.5 * PI) { r = PI - r; sg = -1.0; } else if (r < -0.5 * PI) { r = -PI - r; sg = -1.0; }
    const double r2 = r * r;
    double sp = -1.0 / 121645100408832000.0;
    sp = sp * r2 + 1.0 / 355687428096000.0; sp = sp * r2 - 1.0 / 1307674368000.0; sp = sp * r2 + 1.0 / 6227020800.0; sp = sp * r2 - 1.0 / 39916800.0;
    sp = sp * r2 + 1.0 / 362880.0; sp = sp * r2 - 1.0 / 5040.0; sp = sp * r2 + 1.0 / 120.0; sp = sp * r2 - 1.0 / 6.0; sp = sp * r2 + 1.0;
    double cp = 1.0 / 6402373705728000.0;
    cp = cp * r2 - 1.0 / 20922789888000.0; cp = cp * r2 + 1.0 / 87178291200.0; cp = cp * r2 - 1.0 / 479001600.0; cp = cp * r2 + 1.0 / 3628800.0;
    cp = cp * r2 - 1.0 / 40320.0; cp = cp * r2 + 1.0 / 720.0; cp = cp * r2 - 1.0 / 24.0; cp = cp * r2 + 0.5; cp = 1.0 - cp * r2;
    s = (float)(sp * r); c = (float)(sg * cp);
}
__device__ __forceinline__ void p0_prologue(Frame& F) {
    LAS float* scr = (LAS float*)(F.lds + F.wave * 16384);
    const int gw = F.vcu * NWAVES + F.wave, NGW = F.G * NWAVES, lane = F.lane;
    float* modp = (float*)(F.ws + WS_MODP);
    for (int it = gw; it < 96 * 16; it += NGW) {
        const int cc = it % 96, ks = it / 96, col = cc * 64 + lane; float a0 = 0.f, a1 = 0.f;
#pragma unroll 8
        for (int k = ks * 64; k < ks * 64 + 64; ++k) {
            const float c0 = F.c[k], c1 = F.c[DM + k]; const float s0 = c0 / (1.f + __expf(-c0)), s1 = c1 / (1.f + __expf(-c1));
            const float w = F.w_ada[(size_t)k * 6144 + col]; a0 += s0 * w; a1 += s1 * w; }
        modp[(ks * 2 + 0) * 6144 + col] = a0; modp[(ks * 2 + 1) * 6144 + col] = a1;
    }
    { float* rope = (float*)(F.ws + WS_ROPE);
      for (int e = gw * 64 + lane; e < SEQ * 32; e += NGW * 64) { const int pos = e >> 5, i = e & 31;
          const float freq = powf(10000.0f, -(float)i / 32.0f); const float ang = (float)pos * freq; float s, c; sincos_d((double)ang, s, c);
          rope[2 * e] = c; rope[2 * e + 1] = s; } }
    { constexpr int I_IN = 16 * 40, I_PQ = 16 * 64, I_OUT = 8 * 32;
      for (int it = gw; it < I_IN + I_PQ + I_OUT; it += NGW) { int r = it;
          if (r < I_IN) { transpose_item<1>(F.w_in, NIN, (bf16*)(F.ws + WS_WIN), DM, 64 * (r / 40), 32 * (r % 40), scr, lane); continue; } r -= I_IN;
          if (r < I_PQ) { transpose_item<0>(F.w_pq, NQD, (bf16*)(F.ws + WS_WPQ), DM, 64 * (r / 64), 32 * (r % 64), scr, lane); continue; } r -= I_PQ;
          transpose_item<0>(F.w_out, DM, (bf16*)(F.ws + WS_WOUT), DM, 64 * (r / 32), 32 * (r % 32), scr, lane); } }
    { bf16* wout_t = (bf16*)(F.ws + WS_WOUT);
      for (int it = gw; it < 4 * 2 * 128; it += NGW) { const int g = it >> 8, ch = (it >> 7) & 1, n0 = (it & 127) * 8, cidx = ch * 64 + lane;
          float acc[8];
#pragma unroll
          for (int i = 0; i < 8; ++i) acc[i] = 0.f;
          const float* wp = F.w_pool + ((size_t)(g * 128 + cidx)) * 128; const float* ps = F.pool_scale + g * 128; const float* wo = F.w_out + (size_t)(512 + g * 128) * DM + n0;
          for (int e0 = 0; e0 < 128; e0 += 4) { const f32x4 wv = *(const f32x4*)(wp + e0);
#pragma unroll
              for (int ee = 0; ee < 4; ++ee) { const float w = wv[ee] * ps[e0 + ee]; const f32x4 o0 = *(const f32x4*)(wo + (size_t)(e0 + ee) * DM), o1 = *(const f32x4*)(wo + (size_t)(e0 + ee) * DM + 4);
                  acc[0] += w * o0[0]; acc[1] += w * o0[1]; acc[2] += w * o0[2]; acc[3] += w * o0[3]; acc[4] += w * o1[0]; acc[5] += w * o1[1]; acc[6] += w * o1[2]; acc[7] += w * o1[3]; } }
#pragma unroll
          for (int i = 0; i < 8; ++i) wout_t[(size_t)(n0 + i) * DM + 512 + g * 128 + cidx] = (bf16)f2bf(acc[i]); } }
    { bf16* k1b = (bf16*)(F.ws + WS_K1); bf16* k2b = (bf16*)(F.ws + WS_K2);
      for (int e = gw * 64 + lane; e < 128 * 128; e += NGW * 64) { k1b[e] = (bf16)f2bf(F.k1[e]); k2b[e] = (bf16)f2bf(F.k2[e]); } }
    { float* su = (float*)(F.ws + WS_SU); float* sv = (float*)(F.ws + WS_SV);
      for (int it = gw; it < 2 * NEXP; it += NGW) { const int tb = it >= NEXP, e = it - tb * NEXP; const float* src = (tb ? F.pv : F.pu) + (size_t)e * DM;
          f32x4 v[4]; float am = 0.f;
#pragma unroll
          for (int j = 0; j < 4; ++j) { v[j] = *(const f32x4*)(src + 256 * j + 4 * lane); am = fmaxf(am, fmaxf(fmaxf(fabsf(v[j][0]), fabsf(v[j][1])), fmaxf(fabsf(v[j][2]), fabsf(v[j][3])))); }
#pragma unroll
          for (int o = 1; o < 64; o <<= 1) am = fmaxf(am, __shfl_xor(am, o));
          if (am == 0.f) am = 1.f;
          v4u o;
          if (!tb) { const float sc = am * (1.0f / 127.0f), inv = 127.0f / am;
              unsigned w[4];
#pragma unroll
              for (int j = 0; j < 4; ++j) { const int q0 = (int)rintf(v[j][0] * inv), q1 = (int)rintf(v[j][1] * inv), q2 = (int)rintf(v[j][2] * inv), q3 = (int)rintf(v[j][3] * inv);
                  w[j] = (unsigned)(q0 & 255) | ((unsigned)(q1 & 255) << 8) | ((unsigned)(q2 & 255) << 16) | ((unsigned)(q3 & 255) << 24); }
              o = (v4u){w[0], w[1], w[2], w[3]};
              *(v4u*)(F.ws + WS_U + (size_t)e * DM + 16 * lane) = o; if (lane == 0) su[e] = sc;
          } else { const float sc = am * (1.0f / 256.0f), inv = 256.0f / am;
              unsigned w[4];
#pragma unroll
              for (int j = 0; j < 4; ++j) { int pk = __builtin_amdgcn_cvt_pk_fp8_f32(v[j][0] * inv, v[j][1] * inv, 0, false); pk = __builtin_amdgcn_cvt_pk_fp8_f32(v[j][2] * inv, v[j][3] * inv, pk, true); w[j] = (unsigned)pk; }
              o = (v4u){w[0], w[1], w[2], w[3]};
              *(v4u*)(F.ws + WS_V + (size_t)e * DM + 16 * lane) = o; if (lane == 0) sv[e] = sc; } } }
}
__device__ __forceinline__ void p1_xn(Frame& F) {
    const float* modp = (const float*)(F.ws + WS_MODP); float* mod = (float*)(F.ws + WS_MOD);
    if (F.vcu < 48 && F.tid < 256) { const int e = F.vcu * 256 + F.tid, b = e / 6144, n = e % 6144; float s = F.b_ada[n];
#pragma unroll
        for (int ks = 0; ks < 16; ++ks) s += modp[(ks * 2 + b) * 6144 + n];
        mod[e] = s; }
    LAS float* sc = (LAS float*)F.lds; LAS float* sh = sc + DM;
    const int row0 = F.vcu * (TT / F.G), nrows = TT / F.G, b = row0 >> 13;
    for (int n = F.tid; n < DM; n += NTHREADS) { float s0 = F.b_ada[n], s1 = F.b_ada[DM + n];
#pragma unroll
        for (int ks = 0; ks < 16; ++ks) { s0 += modp[(ks * 2 + b) * 6144 + n]; s1 += modp[(ks * 2 + b) * 6144 + DM + n]; }
        sh[n] = s0; sc[n] = 1.f + s1; }
    __syncthreads();
    bf16* xn = (bf16*)(F.ws + WS_XN);
    for (int r = F.wave; r < nrows; r += NWAVES) { const size_t m = (size_t)(row0 + r);
#pragma unroll
        for (int j = 0; j < 4; ++j) { const int d = 256 * j + 4 * F.lane; const f32x4 v = *(const f32x4*)(F.x + m * DM + d);
            u32x2 o; o.x = pk2(v[0] * sc[d] + sh[d], v[1] * sc[d + 1] + sh[d + 1]); o.y = pk2(v[2] * sc[d + 2] + sh[d + 2], v[3] * sc[d + 3] + sh[d + 3]);
            *(u32x2*)(xn + m * DM + d) = o; } }
    __syncthreads();
}
constexpr int KS_STRIDE = 144, VT_STRIDE = 520, KS_BYTES = 256 * KS_STRIDE, VT_BYTES = 64 * VT_STRIDE;
__device__ __forceinline__ void p3_attn_unit(Frame& F, int unit) {
    const int b = unit >> 7, kvh = (unit >> 6) & 1, n = unit & 63;
    const bf16* proj = (const bf16*)(F.ws + WS_PROJ); bf16* a2 = (bf16*)(F.ws + WS_A2);
    LAS unsigned char* Ks = F.lds; LAS unsigned char* Vt = F.lds + KS_BYTES;
    const int tid = F.tid, lane = F.lane, wave = F.wave, r32 = lane & 31, h = lane >> 5;
    const size_t tok0 = (size_t)b * SEQ + (size_t)n * 128;
#pragma unroll
    for (int i = 0; i < 4; ++i) { const int ci = tid + NTHREADS * i, row = ci >> 3, ch = ci & 7; const bool valid = (n > 0) || (row >= 128);
        const size_t tk = tok0 - 128 + row;
        v4u kv = (v4u){0u, 0u, 0u, 0u}, vv = (v4u){0u, 0u, 0u, 0u};
        if (valid) { kv = *(const v4u*)(proj + tk * NIN + 512 + kvh * 64 + ch * 8); vv = *(const v4u*)(proj + tk * NIN + 640 + kvh * 64 + ch * 8); }
        *(LAS v4u*)(Ks + row * KS_STRIDE + ch * 16) = kv;
        LAS bf16* vt = (LAS bf16*)(Vt + (ch * 8) * VT_STRIDE) + row;
        vt[0 * (VT_STRIDE / 2)] = (bf16)(vv.x & 0xffff); vt[1 * (VT_STRIDE / 2)] = (bf16)(vv.x >> 16); vt[2 * (VT_STRIDE / 2)] = (bf16)(vv.y & 0xffff); vt[3 * (VT_STRIDE / 2)] = (bf16)(vv.y >> 16);
        vt[4 * (VT_STRIDE / 2)] = (bf16)(vv.z & 0xffff); vt[5 * (VT_STRIDE / 2)] = (bf16)(vv.z >> 16); vt[6 * (VT_STRIDE / 2)] = (bf16)(vv.w & 0xffff); vt[7 * (VT_STRIDE / 2)] = (bf16)(vv.w >> 16); }
    __syncthreads();
    const int g = wave >> 1, hq = kvh * 4 + g; const float sink2 = F.sinks[hq] * LOG2E;
#pragma unroll 1
    for (int qt = 0; qt < 2; ++qt) {
        const int qi0 = (wave & 1) * 64 + qt * 32, t0 = qi0 >> 5; const size_t tokq = tok0 + qi0 + r32;
        bf16x8 qf[4];
#pragma unroll
        for (int s = 0; s < 4; ++s) qf[s] = *(const bf16x8*)(proj + tokq * NIN + hq * 64 + 16 * s + 8 * h);
        f32x16 sc[5];
#pragma unroll
        for (int kt = 0; kt < 5; ++kt) { sc[kt] = (f32x16){};
#pragma unroll
            for (int s = 0; s < 4; ++s) { const bf16x8 kf = *(const LAS bf16x8*)(Ks + (32 * (t0 + kt) + r32) * KS_STRIDE + (16 * s + 8 * h) * 2);
                sc[kt] = __builtin_amdgcn_mfma_f32_32x32x16_bf16(kf, qf[s], sc[kt], 0, 0, 0); } }
        const int qi = qi0 + r32; float m = sink2;
#pragma unroll
        for (int kt = 0; kt < 5; ++kt)
#pragma unroll
            for (int r = 0; r < 16; ++r) { const int sidx = 32 * (t0 + kt) + (r & 3) + 8 * (r >> 2) + 4 * h; const int rel = qi + 128 - sidx;
                const bool ok = (rel >= 0) && (rel < 128) && ((n > 0) || (sidx >= 128));
                const float v = ok ? sc[kt][r] : -INFINITY; sc[kt][r] = v; m = fmaxf(m, v); }
        m = fmaxf(m, __shfl_xor(m, 32));
        float l = 0.f;
#pragma unroll
        for (int kt = 0; kt < 5; ++kt)
#pragma unroll
            for (int r = 0; r < 16; ++r) { const float p = __builtin_amdgcn_exp2f(sc[kt][r] - m); sc[kt][r] = p; l += p; }
        l += __shfl_xor(l, 32); l += __builtin_amdgcn_exp2f(sink2 - m);
        f32x16 o[2]; o[0] = (f32x16){}; o[1] = (f32x16){};
#pragma unroll
        for (int kt = 0; kt < 5; ++kt)
#pragma unroll
            for (int s2 = 0; s2 < 2; ++s2) {
                u32x4 pw; pw.x = pg8::cvt_pk_bf16(sc[kt][8 * s2 + 0], sc[kt][8 * s2 + 1]); pw.y = pg8::cvt_pk_bf16(sc[kt][8 * s2 + 2], sc[kt][8 * s2 + 3]);
                pw.z = pg8::cvt_pk_bf16(sc[kt][8 * s2 + 4], sc[kt][8 * s2 + 5]); pw.w = pg8::cvt_pk_bf16(sc[kt][8 * s2 + 6], sc[kt][8 * s2 + 7]);
                const bf16x8 pf = __builtin_bit_cast(bf16x8, pw);
#pragma unroll
                for (int dt = 0; dt < 2; ++dt) { const LAS unsigned char* vp = Vt + (dt * 32 + r32) * VT_STRIDE + (32 * (t0 + kt) + 16 * s2 + 4 * h) * 2;
                    const u32x2 lo = *(const LAS u32x2*)vp, hi = *(const LAS u32x2*)(vp + 16);
                    const u32x4 vw = (u32x4){lo.x, lo.y, hi.x, hi.y};
                    o[dt] = __builtin_amdgcn_mfma_f32_32x32x16_bf16(__builtin_bit_cast(bf16x8, vw), pf, o[dt], 0, 0, 0); } }
        const float inv = 1.0f / l;
#pragma unroll
        for (int dt = 0; dt < 2; ++dt)
#pragma unroll
            for (int rg = 0; rg < 4; ++rg) { const int d0 = dt * 32 + 8 * rg + 4 * h;
                u32x2 w; w.x = pg8::cvt_pk_bf16(o[dt][4 * rg + 0] * inv, o[dt][4 * rg + 1] * inv); w.y = pg8::cvt_pk_bf16(o[dt][4 * rg + 2] * inv, o[dt][4 * rg + 3] * inv);
                *(u32x2*)(a2 + tokq * DM + hq * 64 + d0) = w; }
    }
    __syncthreads();
}
__device__ __forceinline__ void p3_pool_unit(Frame& F, int unit) {
    const bf16* proj = (const bf16*)(F.ws + WS_PROJ); bf16* a2 = (bf16*)(F.ws + WS_A2);
    const int cp = F.tid & 255, half = F.tid >> 8, gi = cp >> 6, w = 2 << gi;
    const int tstart = unit * 64 + half * 32, s0 = tstart & (SEQ - 1);
    const bf16* pc = proj + 768 + 2 * cp;
    float w0 = 0.f, w1 = 0.f;
    for (int j = 1; j <= w; ++j) if (s0 - j >= 0) { const unsigned u = *(const unsigned*)(pc + (size_t)(tstart - j) * NIN); w0 += bf_lo(u); w1 += bf_hi(u); }
    for (int i = 0; i < 32; ++i) { const int t = tstart + i, s = s0 + i;
        const unsigned u = *(const unsigned*)(pc + (size_t)t * NIN); const float p0 = bf_lo(u), p1 = bf_hi(u);
        w0 += p0; w1 += p1;
        if (s - w >= 0) { const unsigned uo = *(const unsigned*)(pc + (size_t)(t - w) * NIN); w0 -= bf_lo(uo); w1 -= bf_hi(uo); }
        const float rc = 1.0f / (float)((s + 1) < w ? (s + 1) : w);
        *(unsigned*)(a2 + (size_t)t * DM + 512 + 2 * cp) = pk2(w0 * rc - p0, w1 * rc - p1); }
}
__device__ __forceinline__ void p5_ln1(Frame& F) {
    const float* mod = (const float*)(F.ws + WS_MOD); const bf16* mix = (const bf16*)(F.ws + WS_MIX);
    bf16* x1 = (bf16*)(F.ws + WS_X1); bf16* h2 = (bf16*)(F.ws + WS_H2);
    const int gw = F.vcu * NWAVES + F.wave, lane = F.lane; const int rows_per_wave = TT / (F.G * NWAVES);
    const int row0 = gw * rows_per_wave, b = row0 >> 13;
    f32x4 g1[4], lg[4], lb[4], s2[4], h2s[4];
#pragma unroll
    for (int j = 0; j < 4; ++j) { const int d = 256 * j + 4 * lane;
        g1[j] = *(const f32x4*)(mod + b * 6144 + 2048 + d) + 1.0f; lg[j] = *(const f32x4*)(F.ln1_g + d); lb[j] = *(const f32x4*)(F.ln1_b + d);
        s2[j] = *(const f32x4*)(mod + b * 6144 + 4096 + d) + 1.0f; h2s[j] = *(const f32x4*)(mod + b * 6144 + 3072 + d); }
    for (int r = 0; r < rows_per_wave; ++r) { const size_t m = (size_t)(row0 + r);
        f32x4 v[4]; float s = 0.f;
#pragma unroll
        for (int j = 0; j < 4; ++j) { const int d = 256 * j + 4 * lane; const f32x4 xv = *(const f32x4*)(F.x + m * DM + d); const u32x2 mv = *(const u32x2*)(mix + m * DM + d);
            const f32x4 mf = (f32x4){bf_lo(mv.x), bf_hi(mv.x), bf_lo(mv.y), bf_hi(mv.y)};
            v[j] = xv * DN_ALPHA + g1[j] * mf; s += (v[j][0] + v[j][1]) + (v[j][2] + v[j][3]); }
        const float mean = wave_sum(s) * (1.f / DM); float q = 0.f;
#pragma unroll
        for (int j = 0; j < 4; ++j) { v[j] = v[j] - mean; q += (v[j][0] * v[j][0] + v[j][1] * v[j][1]) + (v[j][2] * v[j][2] + v[j][3] * v[j][3]); }
        const float rstd = 1.0f / sqrtf(wave_sum(q) * (1.f / DM) + LN_EPS);
#pragma unroll
        for (int j = 0; j < 4; ++j) { const int d = 256 * j + 4 * lane; const f32x4 y = v[j] * rstd * lg[j] + lb[j]; const f32x4 hh = y * s2[j] + h2s[j];
            u32x2 o; o.x = pk2(y[0], y[1]); o.y = pk2(y[2], y[3]); *(u32x2*)(x1 + m * DM + d) = o;
            u32x2 p; p.x = pk2(hh[0], hh[1]); p.y = pk2(hh[2], hh[3]); *(u32x2*)(h2 + m * DM + d) = p; } }
}
constexpr int KR_STRIDE = 272, KR_BYTES = 128 * KR_STRIDE;
#define INS16(a, v) do { _Pragma("unroll") for (int _i = 15; _i >= 1; --_i) a[_i] = __builtin_amdgcn_fmed3f(a[_i - 1], a[_i], (v)); a[0] = fmaxf(a[0], (v)); } while (0)
#define BITONIC16(a) do { _Pragma("unroll") for (int _st = 8; _st >= 1; _st >>= 1) { _Pragma("unroll") for (int _i = 0; _i < 16; ++_i) if ((_i & _st) == 0) { const float _x = a[_i], _y = a[_i + _st]; a[_i] = fmaxf(_x, _y); a[_i + _st] = fminf(_x, _y); } } } while (0)
__device__ __forceinline__ void p7_route(Frame& F) {
    const bf16* q = (const bf16*)(F.ws + WS_Q); unsigned short* pe = (unsigned short*)(F.ws + WS_PE); float* pg = (float*)(F.ws + WS_PG);
    const int tid = F.tid, lane = F.lane, wave = F.wave, r32 = lane & 31, h = lane >> 5;
    { const bf16* k1b = (const bf16*)(F.ws + WS_K1);
      for (int ci = tid; ci < 2 * 128 * 16; ci += NTHREADS) { const int side = ci >> 11, row = (ci >> 4) & 127, ch = ci & 15;
          *(LAS v4u*)(F.lds + side * KR_BYTES + row * KR_STRIDE + ch * 16) = *(const v4u*)(k1b + (size_t)side * 16384 + row * 128 + ch * 8); } }
    __syncthreads();
    LAS unsigned char* scr = F.lds + 2 * KR_BYTES + wave * 2048 + lane * 32;
    const int ntb = TT / 32;
    for (int tb = F.vcu; tb < ntb; tb += F.G) {
        const int head = wave; const size_t tok = (size_t)tb * 32 + r32;
        float vv[2][16];
#pragma unroll
        for (int side = 0; side < 2; ++side) {
            const bf16* qb = q + tok * NQD + head * 256 + side * 128;
            bf16x8 qf[8];
#pragma unroll
            for (int s = 0; s < 8; ++s) qf[s] = *(const bf16x8*)(qb + 16 * s + 8 * h);
            float a[16];
#pragma unroll
            for (int i = 0; i < 16; ++i) a[i] = -INFINITY;
#pragma unroll
            for (int kt = 0; kt < 4; ++kt) { f32x16 acc = (f32x16){};
#pragma unroll
                for (int s = 0; s < 8; ++s) { const bf16x8 kf = *(const LAS bf16x8*)(F.lds + side * KR_BYTES + (32 * kt + r32) * KR_STRIDE + (16 * s + 8 * h) * 2);
                    acc = __builtin_amdgcn_mfma_f32_32x32x16_bf16(kf, qf[s], acc, 0, 0, 0); }
#pragma unroll
                for (int r = 0; r < 16; ++r) { const unsigned key = (unsigned)(32 * kt + (r & 3) + 8 * (r >> 2)) | ((unsigned)h << 2);
                    const float v = __uint_as_float((__float_as_uint(acc[r]) & 0xFFFFFF80u) | key); INS16(a, v); }
                __builtin_amdgcn_sched_barrier(0); }
            float c[16];
#pragma unroll
            for (int i = 0; i < 16; ++i) c[i] = __shfl_xor(a[15 - i], 32);
#pragma unroll
            for (int i = 0; i < 16; ++i) c[i] = fmaxf(a[i], c[i]);
            BITONIC16(c);
#pragma unroll
            for (int i = 0; i < 16; ++i) vv[side][i] = c[i];
        }
        { v4u w1, w2;
#define PK4(L, b) ((__float_as_uint(L[b]) & 0x7Fu) | ((__float_as_uint(L[b + 1]) & 0x7Fu) << 8) | ((__float_as_uint(L[b + 2]) & 0x7Fu) << 16) | ((__float_as_uint(L[b + 3]) & 0x7Fu) << 24))
          w1.x = PK4(vv[0], 0); w1.y = PK4(vv[0], 4); w1.z = PK4(vv[0], 8); w1.w = PK4(vv[0], 12);
          w2.x = PK4(vv[1], 0); w2.y = PK4(vv[1], 4); w2.z = PK4(vv[1], 8); w2.w = PK4(vv[1], 12);
#undef PK4
          *(LAS v4u*)scr = w1; *(LAS v4u*)(scr + 16) = w2; }
        float c1[16], c2[16], top[16];
#pragma unroll
        for (int i = 0; i < 16; ++i) { c1[i] = __uint_as_float(__float_as_uint(vv[0][i]) & 0xFFFFFF80u); c2[i] = __uint_as_float(__float_as_uint(vv[1][i]) & 0xFFFFFF80u); top[i] = -INFINITY; }
#pragma unroll
        for (int ia = 0; ia < 16; ++ia)
#pragma unroll
            for (int ib = 0; ib < 16; ++ib) if ((ia + 1) * (ib + 1) <= 16) {
                const float sm = c1[ia] + c2[ib]; const float v = __uint_as_float((__float_as_uint(sm) & 0xFFFFFF00u) | (unsigned)(ia * 16 + ib)); INS16(top, v); }
        float ex[16], den = 0.f;
#pragma unroll
        for (int i = 0; i < 16; ++i) { ex[i] = __expf(top[i] - top[0]); den += ex[i]; }
        const float rden = 1.0f / den;
        LDS_WAIT();
        unsigned short ev[8]; float gv[8];
#pragma unroll
        for (int j = 0; j < 8; ++j) { const float t = h ? top[8 + j] : top[j]; const float e = h ? ex[8 + j] : ex[j];
            const unsigned code = __float_as_uint(t) & 0xFFu; const unsigned i1 = *(const LAS unsigned char*)(scr + (code >> 4)), i2 = *(const LAS unsigned char*)(scr + 16 + (code & 15u));
            ev[j] = (unsigned short)(i1 * 128u + i2); gv[j] = e * rden; }
        v4u ew; ew.x = ev[0] | ((unsigned)ev[1] << 16); ew.y = ev[2] | ((unsigned)ev[3] << 16); ew.z = ev[4] | ((unsigned)ev[5] << 16); ew.w = ev[6] | ((unsigned)ev[7] << 16);
        *(v4u*)(pe + tok * 128 + head * 16 + 8 * h) = ew;
        *(f32x4*)(pg + tok * 128 + head * 16 + 8 * h) = (f32x4){gv[0], gv[1], gv[2], gv[3]};
        *(f32x4*)(pg + tok * 128 + head * 16 + 8 * h + 4) = (f32x4){gv[4], gv[5], gv[6], gv[7]};
        LDS_WAIT();
    }
    __syncthreads();
}
__device__ __forceinline__ float gelu_erf(float x) { return 0.5f * x * (1.0f + erff(x * 0.70710678118654752f)); }
#ifndef NPART
#define NPART 8
#endif
constexpr int TPW = 8;
constexpr int PSHIFT = (NPART == 8) ? 11 : (NPART == 16) ? 10 : (NPART == 4) ? 12 : (NPART == 2) ? 13 : 14;
__device__ __forceinline__ void p8_peer(Frame& F) {
    const float* mod = (const float*)(F.ws + WS_MOD);
    const bf16* x1 = (const bf16*)(F.ws + WS_X1); const bf16* h2 = (const bf16*)(F.ws + WS_H2);
    const unsigned char* ut = F.ws + WS_U; const unsigned char* vt = F.ws + WS_V;
    const float* su = (const float*)(F.ws + WS_SU); const float* sv = (const float*)(F.ws + WS_SV);
    const unsigned* pe = (const unsigned*)(F.ws + WS_PE); const float* pg = (const float*)(F.ws + WS_PG);
    const int gw = F.vcu * NWAVES + F.wave, lane = F.lane;
    const int b5 = (lane >> 5) & 1, b4 = (lane >> 4) & 1, b3 = (lane >> 3) & 1, kmine = 4 * b5 + 2 * b4 + b3;
    LAS unsigned* scr = (LAS unsigned*)(F.lds + F.wave * 1024);
    const int t0 = gw * TPW, b = t0 >> 13;
    unsigned hq[TPW][4]; float shs[TPW]; unsigned es[TPW]; float gs[TPW][2]; int offv[TPW];
#pragma unroll
    for (int tt = 0; tt < TPW; ++tt) { const size_t t = (size_t)(t0 + tt);
        float hv[16]; float am = 0.f;
#pragma unroll
        for (int j = 0; j < 4; ++j) { const u32x2 v = *(const u32x2*)(h2 + t * DM + 256 * j + 4 * lane); hv[4 * j] = bf_lo(v.x); hv[4 * j + 1] = bf_hi(v.x); hv[4 * j + 2] = bf_lo(v.y); hv[4 * j + 3] = bf_hi(v.y); }
#pragma unroll
        for (int i = 0; i < 16; ++i) am = fmaxf(am, fabsf(hv[i]));
#pragma unroll
        for (int o = 1; o < 64; o <<= 1) am = fmaxf(am, __shfl_xor(am, o));
        if (am == 0.f) am = 1.f;
        const float inv = 127.0f / am; shs[tt] = am * (1.0f / 127.0f);
#pragma unroll
        for (int j = 0; j < 4; ++j) { const int q0 = (int)rintf(hv[4 * j] * inv), q1 = (int)rintf(hv[4 * j + 1] * inv), q2 = (int)rintf(hv[4 * j + 2] * inv), q3 = (int)rintf(hv[4 * j + 3] * inv);
            hq[tt][j] = (unsigned)(q0 & 255) | ((unsigned)(q1 & 255) << 8) | ((unsigned)(q2 & 255) << 16) | ((unsigned)(q3 & 255) << 24); }
        const unsigned pe2 = pe[t * 64 + lane]; const f32x2 pg2 = *(const f32x2*)(pg + t * 128 + 2 * lane);
        const unsigned elo = pe2 & 0xffffu, ehi = pe2 >> 16; const int plo = (int)(elo >> PSHIFT), phi = (int)(ehi >> PSHIFT);
        int base = 0, poslo = 0, poshi = 0, ov = 0;
#pragma unroll
        for (int r = 0; r < NPART; ++r) { const unsigned long long mlo = __ballot(plo == r), mhi = __ballot(phi == r);
            const int clo = __popcll(mlo), chi = __popcll(mhi);
            const int rlo = (int)__builtin_amdgcn_mbcnt_hi((unsigned)(mlo >> 32), __builtin_amdgcn_mbcnt_lo((unsigned)mlo, 0u));
            const int rhi = (int)__builtin_amdgcn_mbcnt_hi((unsigned)(mhi >> 32), __builtin_amdgcn_mbcnt_lo((unsigned)mhi, 0u));
            if (plo == r) poslo = base + rlo; if (phi == r) poshi = base + clo + rhi;
            base += clo + chi; if (lane == r + 1) ov = base; }
        offv[tt] = ov;
        scr[2 * poslo] = elo; scr[2 * poslo + 1] = __float_as_uint(pg2.x); scr[2 * poshi] = ehi; scr[2 * poshi + 1] = __float_as_uint(pg2.y);
        LDS_WAIT();
        const u32x4 sr = *(const LAS u32x4*)(scr + 4 * lane);
        es[tt] = sr.x | (sr.z << 16); gs[tt][0] = __uint_as_float(sr.y); gs[tt][1] = __uint_as_float(sr.w);
        LDS_WAIT();
    }
#pragma unroll 1
    for (int r = 0; r < NPART; ++r) {
#pragma unroll
        for (int tt = 0; tt < TPW; ++tt) {
            const int start = __builtin_amdgcn_readlane(offv[tt], r), end = __builtin_amdgcn_readlane(offv[tt], r + 1);
            for (int i0 = start; i0 < end; i0 += 8) {
                u32x4 uq[8];
#pragma unroll
                for (int kk = 0; kk < 8; ++kk) { const int idx = (i0 + kk < end) ? (i0 + kk) : (end - 1); const unsigned ew = (unsigned)__builtin_amdgcn_readlane((int)es[tt], idx >> 1);
                    const unsigned e = (idx & 1) ? (ew >> 16) : (ew & 0xffffu); uq[kk] = *(const u32x4*)(ut + (size_t)e * DM + 16 * lane); }
                const int idm = (i0 + kmine < end) ? (i0 + kmine) : (end - 1);
                const unsigned ewm = (unsigned)__builtin_amdgcn_ds_bpermute((idm >> 1) << 2, (int)es[tt]); const unsigned em = (idm & 1) ? (ewm >> 16) : (ewm & 0xffffu);
                const float sum = su[em], svm = sv[em];
                const float g0 = __int_as_float(__builtin_amdgcn_ds_bpermute((idm >> 1) << 2, __float_as_int(gs[tt][0]))), g1 = __int_as_float(__builtin_amdgcn_ds_bpermute((idm >> 1) << 2, __float_as_int(gs[tt][1])));
                const float gm = (idm & 1) ? g1 : g0;
                int p[8];
#pragma unroll
                for (int kk = 0; kk < 8; ++kk) { int s = __builtin_amdgcn_sdot4((int)uq[kk].x, (int)hq[tt][0], 0, false); s = __builtin_amdgcn_sdot4((int)uq[kk].y, (int)hq[tt][1], s, false);
                    s = __builtin_amdgcn_sdot4((int)uq[kk].z, (int)hq[tt][2], s, false); s = __builtin_amdgcn_sdot4((int)uq[kk].w, (int)hq[tt][3], s, false); p[kk] = s; }
                int q4[4], q2[2], q1;
#pragma unroll
                for (int i = 0; i < 4; ++i) { const int keep = b5 ? p[i + 4] : p[i], send = b5 ? p[i] : p[i + 4]; q4[i] = keep + __shfl_xor(send, 32); }
#pragma unroll
                for (int i = 0; i < 2; ++i) { const int keep = b4 ? q4[i + 2] : q4[i], send = b4 ? q4[i] : q4[i + 2]; q2[i] = keep + __shfl_xor(send, 16); }
                { const int keep = b3 ? q2[1] : q2[0], send = b3 ? q2[0] : q2[1]; q1 = keep + __shfl_xor(send, 8); }
                q1 += __shfl_xor(q1, 4); q1 += __shfl_xor(q1, 2); q1 += __shfl_xor(q1, 1);
                const float hid = (float)q1 * (shs[tt] * sum);
                const float am = gelu_erf(hid) * gm * svm;
#pragma unroll
                for (int s = 0; s < 2; ++s) { const int kk = 2 * lane + s - i0; const float v = __int_as_float(__builtin_amdgcn_ds_bpermute((kk & 7) << 5, __float_as_int(am)));
                    if (kk >= 0 && kk < 8 && 2 * lane + s < end) gs[tt][s] = v; }
            }
        }
    }
    float y[TPW][16];
#pragma unroll
    for (int tt = 0; tt < TPW; ++tt)
#pragma unroll
        for (int i = 0; i < 16; ++i) y[tt][i] = 0.f;
#pragma unroll 1
    for (int r = 0; r < NPART; ++r) {
#pragma unroll
        for (int tt = 0; tt < TPW; ++tt) {
            const int start = __builtin_amdgcn_readlane(offv[tt], r), end = __builtin_amdgcn_readlane(offv[tt], r + 1);
            for (int i0 = start; i0 < end; i0 += 8) {
                u32x4 vq[8]; float av[8];
#pragma unroll
                for (int kk = 0; kk < 8; ++kk) { const bool valid = i0 + kk < end; const int idx = valid ? (i0 + kk) : (end - 1); const unsigned ew = (unsigned)__builtin_amdgcn_readlane((int)es[tt], idx >> 1);
                    const unsigned e = (idx & 1) ? (ew >> 16) : (ew & 0xffffu); vq[kk] = *(const u32x4*)(vt + (size_t)e * DM + 16 * lane);
                    const float a0 = __int_as_float(__builtin_amdgcn_readlane(__float_as_int(gs[tt][0]), idx >> 1)), a1 = __int_as_float(__builtin_amdgcn_readlane(__float_as_int(gs[tt][1]), idx >> 1));
                    av[kk] = valid ? ((idx & 1) ? a1 : a0) : 0.f; }
#pragma unroll
                for (int kk = 0; kk < 8; ++kk) { const float a = av[kk];
#define FP8ACC(word, j) { const unsigned _w = (word); const f32x2 _lo = __builtin_amdgcn_cvt_pk_f32_fp8((int)_w, false), _hi = __builtin_amdgcn_cvt_pk_f32_fp8((int)_w, true); \
                          y[tt][4 * (j)] += a * _lo.x; y[tt][4 * (j) + 1] += a * _lo.y; y[tt][4 * (j) + 2] += a * _hi.x; y[tt][4 * (j) + 3] += a * _hi.y; }
                    FP8ACC(vq[kk].x, 0) FP8ACC(vq[kk].y, 1) FP8ACC(vq[kk].z, 2) FP8ACC(vq[kk].w, 3)
#undef FP8ACC
                }
            }
        }
    }
#pragma unroll
    for (int tt = 0; tt < TPW; ++tt) { const size_t t = (size_t)(t0 + tt);
        f32x4 v[4]; float s = 0.f;
#pragma unroll
        for (int j = 0; j < 4; ++j) { const int d = 256 * j + 4 * lane; const u32x2 xv = *(const u32x2*)(x1 + t * DM + d); const f32x4 g2 = *(const f32x4*)(mod + b * 6144 + 5120 + d) + 1.0f;
            const f32x4 xf = (f32x4){bf_lo(xv.x), bf_hi(xv.x), bf_lo(xv.y), bf_hi(xv.y)}; const f32x4 yy = (f32x4){y[tt][4 * j], y[tt][4 * j + 1], y[tt][4 * j + 2], y[tt][4 * j + 3]};
            v[j] = xf * DN_ALPHA + g2 * yy; s += (v[j][0] + v[j][1]) + (v[j][2] + v[j][3]); }
        const float mean = wave_sum(s) * (1.f / DM); float qq = 0.f;
#pragma unroll
        for (int j = 0; j < 4; ++j) { v[j] = v[j] - mean; qq += (v[j][0] * v[j][0] + v[j][1] * v[j][1]) + (v[j][2] * v[j][2] + v[j][3] * v[j][3]); }
        const float rstd = 1.0f / sqrtf(wave_sum(qq) * (1.f / DM) + LN_EPS);
#pragma unroll
        for (int j = 0; j < 4; ++j) { const int d = 256 * j + 4 * lane; const f32x4 lg = *(const f32x4*)(F.ln2_g + d), lb = *(const f32x4*)(F.ln2_b + d);
            *(f32x4*)(F.out + t * DM + d) = v[j] * rstd * lg + lb; } }
}
#ifndef MK_N_LAUNCHES
#define MK_N_LAUNCHES 1
#endif
constexpr int N_PHASES = 9;
struct Args { const float* in[18]; float* out; unsigned char* ws; int ph_lo, ph_hi; };
__global__ void __launch_bounds__(NTHREADS, 2) fwd_kernel(Args args) {
    extern __shared__ __attribute__((aligned(16))) unsigned char lds[];
    Frame F;
    F.lds = (LAS unsigned char*)lds;
    F.tid = threadIdx.x; F.lane = F.tid & 63; F.wave = __builtin_amdgcn_readfirstlane(F.tid >> 6);
    F.G = gridDim.x; { const int bx = blockIdx.x; F.vcu = (F.G % 8 == 0) ? (bx % 8) * (F.G / 8) + bx / 8 : bx; }
    F.x = args.in[0]; F.c = args.in[1]; F.w_ada = args.in[2]; F.b_ada = args.in[3]; F.w_in = args.in[4]; F.sinks = args.in[5]; F.w_pool = args.in[6]; F.pool_scale = args.in[7];
    F.w_out = args.in[8]; F.ln1_g = args.in[9]; F.ln1_b = args.in[10]; F.w_pq = args.in[11]; F.k1 = args.in[12]; F.k2 = args.in[13]; F.pu = args.in[14]; F.pv = args.in[15];
    F.ln2_g = args.in[16]; F.ln2_b = args.in[17]; F.out = args.out; F.ws = args.ws;
    volatile LAS unsigned* MISC = (volatile LAS unsigned*)(F.lds + MISC_OFF);
    for (int u = F.tid; u < (LDS_BYTES - LDSCTL_OFF) / 4; u += NTHREADS) ((LAS unsigned*)(F.lds + LDSCTL_OFF))[u] = 0u;
    __syncthreads();
    const int lo = args.ph_lo, hi = args.ph_hi;
    XcdBarrier bar; bar.bar = (unsigned*)(F.ws + WS_CTL) + CW_BAR; bar.x = 0; bar.st = nullptr;
    if (hi - lo > 1) bar = xcd_barrier_post((unsigned*)(F.ws + WS_CTL) + CW_BAR, MISC + 8);
#ifndef PH_MASK
#define PH_MASK 0x1ff
#endif
#define IN(k) (((PH_MASK >> (k)) & 1) && lo <= (k) && (k) < hi)
#define SEAM(k) do { if (IN(k) && IN((k) + 1)) xcd_barrier(bar); } while (0)
#ifndef REP_MASK
#define REP_MASK 0
#endif
#define REPS(k) ((REP_MASK >> (k)) & 1)
#define PHASE(k, ...) if (IN(k)) { for (int _r = 0; _r <= REPS(k); ++_r) { __VA_ARGS__; if (_r < REPS(k)) xcd_barrier(bar); } } SEAM(k)
    PHASE(0, p0_prologue(F));
    PHASE(1, p1_xn(F));
    PHASE(2, { pg8::Gemm g{(const pg8::bf16_t*)(F.ws + WS_XN), (const pg8::bf16_t*)(F.ws + WS_WIN), TT, NIN, DM}; pg8::StaticOrder S; S.init(TT, NIN, F.G, (int)blockIdx.x);
            pg8::EpiRope E{(pg8::bf16_t*)(F.ws + WS_PROJ), NIN, (const float*)(F.ws + WS_ROPE), QSCALE};
            pg8::gemm_phase<pg8::EpiRope, pg8::StaticOrder, true, true>(F.lds, g, S, E); });
    PHASE(3, { for (int u = F.vcu; u < 256; u += F.G) p3_attn_unit(F, u);
               for (int u = F.vcu; u < 256; u += F.G) p3_pool_unit(F, u); });
    PHASE(4, { pg8::Gemm g{(const pg8::bf16_t*)(F.ws + WS_A2), (const pg8::bf16_t*)(F.ws + WS_WOUT), TT, DM, DM}; pg8::StaticOrder S; S.init(TT, DM, F.G, (int)blockIdx.x);
            pg8::EpiPlain E{(pg8::bf16_t*)(F.ws + WS_MIX), DM};
            pg8::gemm_phase<pg8::EpiPlain, pg8::StaticOrder, true, true>(F.lds, g, S, E); });
    PHASE(5, p5_ln1(F));
    PHASE(6, { pg8::Gemm g{(const pg8::bf16_t*)(F.ws + WS_H2), (const pg8::bf16_t*)(F.ws + WS_WPQ), TT, NQD, DM}; pg8::StaticOrder S; S.init(TT, NQD, F.G, (int)blockIdx.x);
            pg8::EpiPlain E{(pg8::bf16_t*)(F.ws + WS_Q), NQD};
            pg8::gemm_phase<pg8::EpiPlain, pg8::StaticOrder, true, true>(F.lds, g, S, E); });
    PHASE(7, p7_route(F));
    PHASE(8, p8_peer(F));
#undef IN
#undef SEAM
}

extern "C" void kernel_launch(void* const* d_in, const int* in_sizes, int n_in, void* d_out, int out_size, void* d_ws, size_t ws_size, hipStream_t stream) {
    static int grid = 0;
    if (grid == 0) {
        if (n_in != 18 || out_size != TT * DM || ws_size < WS_END) { fprintf(stderr, "kernel_launch: unexpected shapes (n_in %d out %d ws %zu)\n", n_in, out_size, ws_size); grid = -1; return; }
        int dev = 0, cus = 0, per_cu = 0;
        if (hipGetDevice(&dev) != hipSuccess || hipDeviceGetAttribute(&cus, hipDeviceAttributeMultiprocessorCount, dev) != hipSuccess) { grid = -1; return; }
        if (hipFuncSetAttribute((const void*)fwd_kernel, hipFuncAttributeMaxDynamicSharedMemorySize, LDS_BYTES) != hipSuccess) { fprintf(stderr, "kernel_launch: hipFuncSetAttribute failed\n"); grid = -1; return; }
        if (hipOccupancyMaxActiveBlocksPerMultiprocessor(&per_cu, (const void*)fwd_kernel, NTHREADS, LDS_BYTES) != hipSuccess || per_cu < 1) { fprintf(stderr, "kernel_launch: occupancy query says %d blocks per CU\n", per_cu); }
        (void)hipGetLastError();
        grid = cus;
        if (grid != 256) fprintf(stderr, "kernel_launch: built for 256 CUs, got %d\n", grid);
    }
    if (grid < 0) return;
    (void)hipMemsetAsync((char*)d_ws + WS_CTL, 0, CTL_ZERO_BYTES, stream);
    Args a{};
    for (int i = 0; i < 18; ++i) a.in[i] = (const float*)d_in[i];
    a.out = (float*)d_out; a.ws = (unsigned char*)d_ws;
#if MK_N_LAUNCHES == 1
    a.ph_lo = 0; a.ph_hi = N_PHASES;
    hipLaunchKernelGGL(fwd_kernel, dim3(grid), dim3(NTHREADS), LDS_BYTES, stream, a);
#else
    for (int p = 0; p < N_PHASES; ++p) { a.ph_lo = p; a.ph_hi = p + 1; hipLaunchKernelGGL(fwd_kernel, dim3(grid), dim3(NTHREADS), LDS_BYTES, stream, a); }
#endif
}
```

```cpp
#include <hip/hip_runtime.h>
#include <cstdio>
#include <cstdint>
#include <cmath>
namespace pg8 {
#define PG8_LAS __attribute__((address_space(3)))
typedef unsigned short bf16_t;
typedef short bf16x8 __attribute__((ext_vector_type(8)));
typedef float f32x4 __attribute__((ext_vector_type(4)));
typedef unsigned u32x4 __attribute__((ext_vector_type(4)));
constexpr int BM = 256, BK = 64, HALF = 128, HTB = HALF * BK * 2  , STAGE_BYTES = 8 * HTB, NXCD = 8, WGM = 8;

__host__ __device__ __forceinline__ int lds_byte(int r, int c) { const int st = (r >> 4) * 2 + (c >> 5), rr = r & 15, cc = c & 31, ob = rr * 64 + cc * 2; return st * 1024 + (ob ^ (((ob >> 9) & 1) << 5)); }
__host__ __device__ __forceinline__ void stage_rc(int b, int& R, int& C) { const int st = b / 1024, sb = b % 1024, swz = sb ^ (((sb >> 9) & 1) << 5); R = (st >> 1) * 16 + swz / 64; C = (st & 1) * 32 + (swz % 64) / 2; }
__host__ __device__ __forceinline__ int perm32(int rho) { const int n = rho >> 4, i = rho & 15; return 8 * (i >> 2) + 4 * n + (i & 3); }

struct Unit { int pm, pn; };
struct Gemm { const bf16_t* A; const bf16_t* Bt; int M, N, K; };

struct StaticOrder {
    int nM, nN, nwg, G, c;
    __host__ __device__ void init(int M, int N, int G_, int c_) { nM = M / BM; nN = N / BM; nwg = nM * nN; G = G_; c = c_; }
    __host__ __device__ bool next(int i, Unit& u) const {
        const long L = (long)i * G + c; if (L >= nwg) return false;
        int wgid = (int)L; { const int q = nwg / NXCD, r = nwg % NXCD, xcd = wgid % NXCD, off = wgid / NXCD; wgid = (xcd < r ? xcd * (q + 1) : r * (q + 1) + (xcd - r) * q) + off; }
        const int nig = WGM * nN, gid = wgid / nig, fm = gid * WGM, gsz = (nM - fm) < WGM ? (nM - fm) : WGM;
        u.pm = fm + ((wgid % nig) % gsz); u.pn = (wgid % nig) / gsz; return true;
    }
    __device__ __forceinline__ void a_ready(const Unit&) const {}
    __device__ __forceinline__ void done(const Unit&) const {}
};

__device__ __forceinline__ unsigned cvt_pk_bf16(float lo, float hi) { unsigned r; asm volatile("v_cvt_pk_bf16_f32 %0, %1, %2" : "=v"(r) : "v"(lo), "v"(hi)); return r; }

struct EpiPlain {
    static constexpr bool PERM = true, AFTER_DRAIN = false;
    bf16_t* O; int ldc;
    __device__ __forceinline__ void operator()(const f32x4 (&acc)[2][2][4][2], const Unit& u, int wr, int wc, int fr, int fq) const {
        const int row0 = u.pm * BM + wr * 64 + fr; const int col0 = u.pn * BM + wc * 32 + 8 * fq;
#pragma unroll
        for (int ai = 0; ai < 2; ++ai)
#pragma unroll
            for (int m = 0; m < 4; ++m) { bf16_t* rowp = O + (size_t)(row0 + ai * HALF + m * 16) * ldc + col0;
#pragma unroll
                for (int bj = 0; bj < 2; ++bj) { const f32x4 v0 = acc[ai][bj][m][0], v1 = acc[ai][bj][m][1];
                    u32x4 w; w.x = cvt_pk_bf16(v0[0], v0[1]); w.y = cvt_pk_bf16(v0[2], v0[3]); w.z = cvt_pk_bf16(v1[0], v1[1]); w.w = cvt_pk_bf16(v1[2], v1[3]);
                    *(u32x4*)(rowp + bj * HALF) = w; } }
    }
};
struct EpiRope {
    static constexpr bool PERM = true, AFTER_DRAIN = false;
    bf16_t* O; int ldc; const float* rope; float qscale;
    __device__ __forceinline__ void operator()(const f32x4 (&acc)[2][2][4][2], const Unit& u, int wr, int wc, int fr, int fq) const {
        const int row0 = u.pm * BM + wr * 64 + fr; const int col0 = u.pn * BM + wc * 32 + 8 * fq;
#pragma unroll
        for (int ai = 0; ai < 2; ++ai)
#pragma unroll
            for (int m = 0; m < 4; ++m) { const int row = row0 + ai * HALF + m * 16; bf16_t* rowp = O + (size_t)row * ldc + col0; const int pos = row & 8191;
#pragma unroll
                for (int bj = 0; bj < 2; ++bj) { f32x4 v0 = acc[ai][bj][m][0], v1 = acc[ai][bj][m][1];
                    const int colt = u.pn * BM + bj * HALF;
                    if (colt < 640) {
                        const int c = col0 + bj * HALF, ib = (c & 63) >> 1;
                        const f32x4 cs0 = *(const f32x4*)(rope + ((size_t)pos * 32 + ib) * 2), cs1 = *(const f32x4*)(rope + ((size_t)pos * 32 + ib) * 2 + 4);
                        const float sc = colt < 512 ? qscale : 1.0f;
                        f32x4 r0, r1;
                        r0[0] = (v0[0] * cs0[0] - v0[1] * cs0[1]) * sc; r0[1] = (v0[1] * cs0[0] + v0[0] * cs0[1]) * sc;
                        r0[2] = (v0[2] * cs0[2] - v0[3] * cs0[3]) * sc; r0[3] = (v0[3] * cs0[2] + v0[2] * cs0[3]) * sc;
                        r1[0] = (v1[0] * cs1[0] - v1[1] * cs1[1]) * sc; r1[1] = (v1[1] * cs1[0] + v1[0] * cs1[1]) * sc;
                        r1[2] = (v1[2] * cs1[2] - v1[3] * cs1[3]) * sc; r1[3] = (v1[3] * cs1[2] + v1[2] * cs1[3]) * sc;
                        v0 = r0; v1 = r1;
                    }
                    u32x4 w; w.x = cvt_pk_bf16(v0[0], v0[1]); w.y = cvt_pk_bf16(v0[2], v0[3]); w.z = cvt_pk_bf16(v1[0], v1[1]); w.w = cvt_pk_bf16(v1[2], v1[3]);
                    *(u32x4*)(rowp + bj * HALF) = w; } }
    }
};

template <class Epi, class Sched, bool ALIGN_EPI = false, bool SP2 = false>
__device__ __forceinline__ void gemm_phase(PG8_LAS unsigned char* lds, const Gemm g, const Sched& S, const Epi& E) {
    const int tid = threadIdx.x, wid = __builtin_amdgcn_readfirstlane(tid >> 6), lane = tid & 63, wr = wid >> 2, wc = wid & 3, fr = lane & 15, fq = lane >> 4;
    const int K = g.K, nt = K / BK;
    unsigned voffA[2], voffB[2];
#pragma unroll
    for (int i = 0; i < 2; ++i) { int R, C; stage_rc(tid * 16 + i * 8192, R, C); const int Rb = Epi::PERM ? ((R & ~31) + perm32(R & 31)) : R;
        voffA[i] = (unsigned)(R * K + C) * 2u; voffB[i] = (unsigned)(Rb * K + C) * 2u; }
    const size_t kstep = (size_t)(BK * 2);
    const size_t hstep = (size_t)HALF * K * 2;
    const size_t tstep = 2 * hstep;
    const unsigned ldsw = (unsigned)wid * 1024u;
    const int aoff = lds_byte(wr * 64 + fr, fq * 8), boff = lds_byte(wc * 32 + fr, fq * 8);
#define PG8_SA(b, h) (((b) * 2 + (h)) * HTB)
#define PG8_SB(b, h) ((4 + (b) * 2 + (h)) * HTB)
#define PG8_STAGE(bufoff, gbase, voff) do { _Pragma("unroll") for (int _i = 0; _i < 2; ++_i) \
        __builtin_amdgcn_global_load_lds((const unsigned*)((const char*)(gbase) + (voff)[_i]), (PG8_LAS unsigned*)(lds + (bufoff) + ldsw + _i * 8192), 16, 0, 0); } while (0)
#define PG8_LDA(dst, b, h) do { _Pragma("unroll") for (int m = 0; m < 4; ++m) _Pragma("unroll") for (int k = 0; k < 2; ++k) dst[m][k] = *(const PG8_LAS bf16x8*)(lds + PG8_SA(b, h) + aoff + m * 2048 + k * 1024); } while (0)
#define PG8_LDB(dst, b, h) do { _Pragma("unroll") for (int n = 0; n < 2; ++n) _Pragma("unroll") for (int k = 0; k < 2; ++k) dst[n][k] = *(const PG8_LAS bf16x8*)(lds + PG8_SB(b, h) + boff + n * 2048 + k * 1024); } while (0)
#define PG8_MMA(ai, bj, At, Bt) do { __builtin_amdgcn_s_setprio(1); _Pragma("unroll") for (int m = 0; m < 4; ++m) _Pragma("unroll") for (int n = 0; n < 2; ++n) _Pragma("unroll") for (int k = 0; k < 2; ++k) \
        acc[ai][bj][m][n] = __builtin_amdgcn_mfma_f32_16x16x32_bf16(Bt[n][k], At[m][k], acc[ai][bj][m][n], 0, 0, 0); __builtin_amdgcn_s_setprio(0); } while (0)
#define PG8_WAIT_V(n) asm volatile("s_waitcnt vmcnt(" #n ")" ::: "memory")
#define PG8_WAIT_L(n) asm volatile("s_waitcnt lgkmcnt(" #n ")" ::: "memory")
#define PG8_BAR __builtin_amdgcn_s_barrier()
#define PG8_SCHED __builtin_amdgcn_sched_barrier(0)
    Unit cur, nxt; int ui = 0;
    if (!S.next(0, cur)) return;
    f32x4 acc[2][2][4][2];
#pragma unroll
    for (int a = 0; a < 2; ++a)
#pragma unroll
        for (int b = 0; b < 2; ++b)
#pragma unroll
            for (int m = 0; m < 4; ++m)
#pragma unroll
                for (int n = 0; n < 2; ++n) acc[a][b][m][n] = (f32x4){0.f, 0.f, 0.f, 0.f};
    bf16x8 At[4][2], B0[2][2], B1[2][2];
    const char* cA = (const char*)g.A + (size_t)cur.pm * tstep; const char* cB = (const char*)g.Bt + (size_t)cur.pn * tstep;
    S.a_ready(cur);
    if constexpr (SP2) {
        PG8_STAGE(PG8_SB(0, 0), cB, voffB); PG8_STAGE(PG8_SB(0, 1), cB + hstep, voffB); PG8_STAGE(PG8_SA(0, 0), cA, voffA); PG8_STAGE(PG8_SA(0, 1), cA + hstep, voffA);
        if (wr == 1) PG8_BAR;
        PG8_WAIT_V(2); PG8_BAR;
        PG8_STAGE(PG8_SB(1, 0), cB + kstep, voffB); PG8_STAGE(PG8_SA(1, 0), cA + kstep, voffA); PG8_STAGE(PG8_SB(1, 1), cB + hstep + kstep, voffB);
        PG8_WAIT_V(6); PG8_BAR;
    } else {
        PG8_STAGE(PG8_SB(0, 0), cB, voffB); PG8_STAGE(PG8_SA(0, 0), cA, voffA); PG8_STAGE(PG8_SB(0, 1), cB + hstep, voffB); PG8_STAGE(PG8_SA(0, 1), cA + hstep, voffA);
        if (wr == 1) PG8_BAR;
        PG8_WAIT_V(4); PG8_BAR;
        PG8_STAGE(PG8_SB(1, 0), cB + kstep, voffB); PG8_STAGE(PG8_SA(1, 0), cA + kstep, voffA); PG8_STAGE(PG8_SB(1, 1), cB + hstep + kstep, voffB);
        PG8_WAIT_V(6); PG8_BAR;
    }
    for (;;) {
        const bool has_next = S.next(ui + 1, nxt);
        const char* nA = has_next ? (const char*)g.A + (size_t)nxt.pm * tstep : cA; const char* nB = has_next ? (const char*)g.Bt + (size_t)nxt.pn * tstep : cB;
        for (int t = 0; t < nt; t += 2) {
            const bool last = (t == nt - 2);
            const char* a1 = cA + (size_t)(t + 1) * kstep;
            const char* a2 = last ? nA : cA + (size_t)(t + 2) * kstep; const char* b2 = last ? nB : cB + (size_t)(t + 2) * kstep;
            const char* a3 = a2 + kstep; const char* b3 = b2 + kstep;
            if (last && has_next) S.a_ready(nxt);
            if constexpr (SP2) {
            PG8_LDB(B0, 0, 0); PG8_LDB(B1, 0, 1); PG8_SCHED; PG8_LDA(At, 0, 0); PG8_STAGE(PG8_SA(1, 1), a1 + hstep, voffA);
            PG8_WAIT_V(8); PG8_WAIT_L(0); PG8_BAR; PG8_MMA(0, 0, At, B0); PG8_MMA(0, 1, At, B1); PG8_BAR; PG8_SCHED;
            PG8_LDA(At, 0, 1); PG8_STAGE(PG8_SB(0, 0), b2, voffB); PG8_STAGE(PG8_SB(0, 1), b2 + hstep, voffB); PG8_STAGE(PG8_SA(0, 0), a2, voffA);
            PG8_WAIT_V(8); PG8_WAIT_L(0); PG8_BAR; PG8_MMA(1, 0, At, B0); PG8_MMA(1, 1, At, B1); PG8_BAR; PG8_SCHED;
            PG8_LDB(B0, 1, 0); PG8_LDB(B1, 1, 1); PG8_SCHED; PG8_LDA(At, 1, 0); PG8_STAGE(PG8_SA(0, 1), a2 + hstep, voffA);
            PG8_WAIT_V(8); PG8_WAIT_L(0); PG8_BAR; PG8_MMA(0, 0, At, B0); PG8_MMA(0, 1, At, B1); PG8_BAR; PG8_SCHED;
            PG8_LDA(At, 1, 1); PG8_STAGE(PG8_SB(1, 0), b3, voffB); PG8_STAGE(PG8_SB(1, 1), b3 + hstep, voffB); PG8_STAGE(PG8_SA(1, 0), a3, voffA);
            PG8_WAIT_V(8); PG8_WAIT_L(0); PG8_BAR; PG8_MMA(1, 0, At, B0); PG8_MMA(1, 1, At, B1); PG8_BAR; PG8_SCHED;
            } else {
            PG8_LDB(B0, 0, 0); PG8_SCHED; PG8_LDA(At, 0, 0); PG8_STAGE(PG8_SA(1, 1), a1 + hstep, voffA);
            PG8_WAIT_L(8); PG8_BAR; PG8_WAIT_L(0); PG8_MMA(0, 0, At, B0); PG8_BAR; PG8_SCHED;
            PG8_LDB(B1, 0, 1); PG8_STAGE(PG8_SB(0, 0), b2, voffB);
            PG8_BAR; PG8_WAIT_L(0); PG8_MMA(0, 1, At, B1); PG8_BAR;
            PG8_LDA(At, 0, 1); PG8_STAGE(PG8_SA(0, 0), a2, voffA);
            PG8_BAR; PG8_WAIT_L(0); PG8_MMA(1, 0, At, B0); PG8_BAR; PG8_SCHED;
            PG8_STAGE(PG8_SB(0, 1), b2 + hstep, voffB);
            PG8_WAIT_V(6); PG8_BAR; PG8_MMA(1, 1, At, B1); PG8_BAR;
            PG8_LDB(B0, 1, 0); PG8_SCHED; PG8_LDA(At, 1, 0); PG8_STAGE(PG8_SA(0, 1), a2 + hstep, voffA);
            PG8_WAIT_L(8); PG8_BAR; PG8_WAIT_L(0); PG8_MMA(0, 0, At, B0); PG8_BAR; PG8_SCHED;
            PG8_LDB(B1, 1, 1); PG8_STAGE(PG8_SB(1, 0), b3, voffB);
            PG8_BAR; PG8_WAIT_L(0); PG8_MMA(0, 1, At, B1); PG8_BAR;
            PG8_LDA(At, 1, 1); PG8_STAGE(PG8_SA(1, 0), a3, voffA);
            PG8_BAR; PG8_WAIT_L(0); PG8_MMA(1, 0, At, B0); PG8_BAR; PG8_SCHED;
            PG8_STAGE(PG8_SB(1, 1), b3 + hstep, voffB);
            PG8_WAIT_V(6); PG8_BAR; PG8_MMA(1, 1, At, B1); PG8_BAR;
            }
        }
        if constexpr (ALIGN_EPI) { if (wr == 0) PG8_BAR; }
        if constexpr (!Epi::AFTER_DRAIN) { E(acc, cur, wr, wc, fr, fq); S.done(cur); }
        if (!has_next) break;
#pragma unroll
        for (int a = 0; a < 2; ++a)
#pragma unroll
            for (int b = 0; b < 2; ++b)
#pragma unroll
                for (int m = 0; m < 4; ++m)
#pragma unroll
                    for (int n = 0; n < 2; ++n) acc[a][b][m][n] = (f32x4){0.f, 0.f, 0.f, 0.f};
        cur = nxt; cA = nA; cB = nB; ++ui;
        if constexpr (ALIGN_EPI) { if (wr == 1) PG8_BAR; }
    }
    PG8_WAIT_V(0);
    if constexpr (!ALIGN_EPI) { if (wr == 0) PG8_BAR; }
    PG8_BAR;
    if constexpr (Epi::AFTER_DRAIN) { E.fused(acc, cur, wr, wc, fr, fq, lds, wid, lane); S.done(cur); }
#undef PG8_SA
#undef PG8_SB
#undef PG8_STAGE
#undef PG8_LDA
#undef PG8_LDB
#undef PG8_MMA
#undef PG8_WAIT_V
#undef PG8_WAIT_L
#undef PG8_BAR
#undef PG8_SCHED
}
}
#define GAS __attribute__((address_space(1)))
#define LAS __attribute__((address_space(3)))
typedef unsigned short bf16;
typedef unsigned v4u __attribute__((ext_vector_type(4)));
typedef float f32x4 __attribute__((ext_vector_type(4)));
typedef short bf16x8 __attribute__((ext_vector_type(8)));
typedef GAS unsigned gu32;
typedef GAS unsigned long long gu64;
#define RLX_AGENT __ATOMIC_RELAXED, __HIP_MEMORY_SCOPE_AGENT
#define LDS_WAIT() asm volatile("s_waitcnt lgkmcnt(0)" ::: "memory")
#define VM_WAIT() asm volatile("s_waitcnt vmcnt(0)" ::: "memory")
__device__ __forceinline__ unsigned long long rt() { return __builtin_amdgcn_s_memrealtime(); }
__device__ __forceinline__ unsigned f2bf(float f) { unsigned u = __builtin_bit_cast(unsigned, f); return (u + 0x7fffu + ((u >> 16) & 1u)) >> 16; }
__device__ __forceinline__ unsigned pk2(float lo, float hi) { return f2bf(lo) | (f2bf(hi) << 16); }
#define XB_TMO      128
#define XB_XCNT(j)  (256  + 64 * (j))
#define XB_XSUB(j)  (1280 + 64 * (j))
#define XB_XGEN(j)  (2304 + 64 * (j))
#define XB_TOP      3328
#define XB_TOPGEN   3392
#define XCD_BAR_WORDS 3456
#define XB_SPIN_CAP (1u << 18)

__device__ __forceinline__ unsigned xb_ld(unsigned* p)              { return __hip_atomic_load(p, __ATOMIC_RELAXED, __HIP_MEMORY_SCOPE_AGENT); }
__device__ __forceinline__ unsigned xb_add(unsigned* p, unsigned v) { return __hip_atomic_fetch_add(p, v, __ATOMIC_RELAXED, __HIP_MEMORY_SCOPE_AGENT); }
__device__ __forceinline__ unsigned xb_xcc_id() { return (unsigned)__builtin_amdgcn_s_getreg((3 << 11) | 20) & 0xFu; }
#define XB_SPIN(cond, bar) do { unsigned _sp = 0; while (cond) { __builtin_amdgcn_s_sleep(1); \
    if ((++_sp & 255u) == 0u) { if (xb_ld(&(bar)[XB_TMO])) break; if (_sp > XB_SPIN_CAP) { atomicAdd(&(bar)[XB_TMO], 1u); break; } } } } while (0)

struct XcdBarrier {
    unsigned* bar; unsigned x;
    volatile LAS unsigned* st;
};

__device__ __forceinline__ XcdBarrier xcd_barrier_post(unsigned* bar, volatile LAS unsigned* st) {
    XcdBarrier b; b.bar = bar; b.x = xb_xcc_id(); b.st = st;
    if (threadIdx.x == 0) (void)xb_add(&bar[XB_XCNT(b.x)], 1u);
    return b;
}
__device__ __forceinline__ void xcd_barrier_complete(unsigned* bar, unsigned x, unsigned& nloc, unsigned& nx) {
    const unsigned G = gridDim.x * gridDim.y * gridDim.z;
    unsigned sum, cnt, mine, sp = 0u;
    for (;;) {
        sum = 0u; cnt = 0u; mine = 0u;
#pragma unroll
        for (unsigned j = 0; j < 16; ++j) { const unsigned c = xb_ld(&bar[XB_XCNT(j)]); sum += c; cnt += (c > 0u) ? 1u : 0u; mine = (j == x) ? c : mine; }
        if (sum == G) break;
        __builtin_amdgcn_s_sleep(1);
        if ((++sp & 255u) == 0u) { if (xb_ld(&bar[XB_TMO])) break; if (sp > XB_SPIN_CAP) { atomicAdd(&bar[XB_TMO], 1u); break; } }
    }
    nloc = mine > 0u ? mine : 1u; nx = cnt > 0u ? cnt : 1u;
}

__device__ __forceinline__ void xcd_barrier(const XcdBarrier& b) {
    asm volatile("s_waitcnt vmcnt(0)" ::: "memory");
    __syncthreads();
    if (threadIdx.x == 0) {
        unsigned* bar = b.bar;
        __builtin_amdgcn_s_waitcnt(0);
        unsigned nloc = b.st[0], nx = b.st[1];
        if (nloc == 0u) { xcd_barrier_complete(bar, b.x, nloc, nx); b.st[0] = nloc; b.st[1] = nx; }
        const unsigned old = xb_add(&bar[XB_XSUB(b.x)], 1u);
        const unsigned gen = old / nloc;
        if (old + 1u == (gen + 1u) * nloc) {
            __builtin_amdgcn_fence(__ATOMIC_RELEASE, "agent");
            asm volatile("s_waitcnt vmcnt(0)" ::: "memory");
            const unsigned og = xb_add(&bar[XB_TOP], 1u);
            const unsigned tg = og / nx;
            if (og + 1u == (tg + 1u) * nx) xb_add(&bar[XB_TOPGEN], 1u);
            else XB_SPIN(xb_ld(&bar[XB_TOPGEN]) == tg, bar);
            __builtin_amdgcn_fence(__ATOMIC_ACQUIRE, "agent");
            xb_add(&bar[XB_XGEN(b.x)], 1u);
            asm volatile("s_waitcnt vmcnt(0)" ::: "memory");
        } else {
            XB_SPIN(xb_ld(&bar[XB_XGEN(b.x)]) == gen, bar);
            __builtin_amdgcn_fence(__ATOMIC_ACQUIRE, "agent");
            asm volatile("s_waitcnt vmcnt(0)" ::: "memory");
        }
    }
    __syncthreads();
}
constexpr int NWAVES = 8, NTHREADS = 512;
constexpr int TT = 16384, DM = 1024, SEQ = 8192, NIN = 1280, NQD = 2048, NEXP = 16384;
constexpr float DN_ALPHA = 1.189207115002721f;
constexpr float LN_EPS = 1e-5f;
constexpr float LOG2E = 1.4426950408889634f;
constexpr float QSCALE = 0.125f * LOG2E;

constexpr size_t MiB = 1u << 20;
constexpr size_t WS_CTL = 0, CTL_ZERO_BYTES = 64 * 1024;
constexpr size_t WS_MODP = 1 * MiB;
constexpr size_t WS_MOD = 1 * MiB + 896 * 1024;
constexpr size_t WS_ROPE = 2 * MiB;
constexpr size_t WS_WIN = 4 * MiB;
constexpr size_t WS_K1 = 6 * MiB + 512 * 1024, WS_K2 = WS_K1 + 32 * 1024;
constexpr size_t WS_WOUT = 7 * MiB;
constexpr size_t WS_WPQ = 9 * MiB;
constexpr size_t WS_SU = 13 * MiB, WS_SV = 13 * MiB + 65536;
constexpr size_t WS_U = 16 * MiB, WS_V = 32 * MiB;
constexpr size_t WS_XN = 80 * MiB;
constexpr size_t WS_MIX = 80 * MiB;
constexpr size_t WS_PE = 80 * MiB, WS_PG = 84 * MiB;
constexpr size_t WS_PROJ = 112 * MiB;
constexpr size_t WS_A2 = 152 * MiB;
constexpr size_t WS_X1 = 184 * MiB, WS_H2 = 216 * MiB;
constexpr size_t WS_Q = 112 * MiB;
constexpr size_t WS_END = 248 * MiB;
constexpr int CW_BAR = 4096;

constexpr int RING_BYTES = 131072, LDSCTL_OFF = RING_BYTES, MISC_OFF = LDSCTL_OFF + 320, LDS_BYTES = 147456;

typedef float f32x16 __attribute__((ext_vector_type(16)));
typedef float f32x2 __attribute__((ext_vector_type(2)));
typedef unsigned u32x2 __attribute__((ext_vector_type(2)));
typedef unsigned u32x4 __attribute__((ext_vector_type(4)));
typedef __bf16 bf16x2_t __attribute__((ext_vector_type(2)));
struct Frame {
    LAS unsigned char* lds;
    int tid, lane, wave, vcu, G;
    const float *x, *c, *w_ada, *b_ada, *w_in, *sinks, *w_pool, *pool_scale, *w_out, *ln1_g, *ln1_b, *w_pq, *k1, *k2, *pu, *pv, *ln2_g, *ln2_b;
    float* out; unsigned char* ws;
};
__device__ __forceinline__ float wave_sum(float v) {
#pragma unroll
    for (int o = 1; o < 64; o <<= 1) v += __shfl_xor(v, o);
    return v;
}
__device__ __forceinline__ float bf_lo(unsigned u) { return __uint_as_float(u << 16); }
__device__ __forceinline__ float bf_hi(unsigned u) { return __uint_as_float(u & 0xffff0000u); }
__device__ __forceinline__ float bf2f(bf16 b) { return __uint_as_float((unsigned)b << 16); }

template <int MODE>
__device__ __forceinline__ void transpose_item(const float* W, int ldw, bf16* WT, int ldt, int k0, int n0, LAS float* scr, int lane) {
    int nsrc = n0 + (lane & 31);
    if (MODE == 1 && nsrc < 640) { const int hd = nsrc >> 6, w = nsrc & 63; nsrc = hd * 64 + (w >> 1) + 32 * (w & 1); }
#pragma unroll 8
    for (int i = 0; i < 32; ++i) { const int kk = 2 * i + (lane >> 5); scr[kk * 33 + (lane & 31)] = W[(size_t)(k0 + kk) * ldw + nsrc]; }
    LDS_WAIT(); asm volatile("" ::: "memory");
    const int c = lane & 7;
#pragma unroll
    for (int j = 0; j < 4; ++j) { const int n = (lane >> 3) + 8 * j; const LAS float* s = scr + (8 * c) * 33 + n;
        v4u o; o.x = pk2(s[0 * 33], s[1 * 33]); o.y = pk2(s[2 * 33], s[3 * 33]); o.z = pk2(s[4 * 33], s[5 * 33]); o.w = pk2(s[6 * 33], s[7 * 33]);
        *(GAS v4u*)(WT + (size_t)(n0 + n) * ldt + k0 + 8 * c) = o; }
    LDS_WAIT(); asm volatile("" ::: "memory");
}
__device__ __forceinline__ void sincos_d(double a, float& s, float& c) {
    const double TWO_PI = 6.283185307179586476925, PI = 3.141592653589793238462643;
    double r = a - TWO_PI * rint(a / TWO_PI);
    double sg = 1.0;
    if (r > 0.5 * PI) { r = PI - r; sg = -1.0; } else if (r < -0.5 * PI) { r = -PI - r; sg = -1.0; }
    const double r2 = r * r;
    double sp = -1.0 / 121645100408832000.0;
    sp = sp * r2 + 1.0 / 355687428096000.0; sp = sp * r2 - 1.0 / 1307674368000.0; sp = sp * r2 + 1.0 / 6227020800.0; sp = sp * r2 - 1.0 / 39916800.0;
    sp = sp * r2 + 1.0 / 362880.0; sp = sp * r2 - 1.0 / 5040.0; sp = sp * r2 + 1.0 / 120.0; sp = sp * r2 - 1.0 / 6.0; sp = sp * r2 + 1.0;
    double cp = 1.0 / 6402373705728000.0;
    cp = cp * r2 - 1.0 / 20922789888000.0; cp = cp * r2 + 1.0 / 87178291200.0; cp = cp * r2 - 1.0 / 479001600.0; cp = cp * r2 + 1.0 / 3628800.0;
    cp = cp * r2 - 1.0 / 40320.0; cp = cp * r2 + 1.0 / 720.0; cp = cp * r2 - 1.0 / 24.0; cp = cp * r2 + 0.5; cp = 1.0 - cp * r2;
    s = (float)(sp * r); c = (float)(sg * cp);
}
__device__ __forceinline__ void p0_prologue(Frame& F) {
    LAS float* scr = (LAS float*)(F.lds + F.wave * 16384);
    const int gw = F.vcu * NWAVES + F.wave, NGW = F.G * NWAVES, lane = F.lane;
    float* modp = (float*)(F.ws + WS_MODP);
    for (int it = gw; it < 96 * 16; it += NGW) {
        const int cc = it % 96, ks = it / 96, col = cc * 64 + lane; float a0 = 0.f, a1 = 0.f;
#pragma unroll 8
        for (int k = ks * 64; k < ks * 64 + 64; ++k) {
            const float c0 = F.c[k], c1 = F.c[DM + k]; const float s0 = c0 / (1.f + __expf(-c0)), s1 = c1 / (1.f + __expf(-c1));
            const float w = F.w_ada[(size_t)k * 6144 + col]; a0 += s0 * w; a1 += s1 * w; }
        modp[(ks * 2 + 0) * 6144 + col] = a0; modp[(ks * 2 + 1) * 6144 + col] = a1;
    }
    { float* rope = (float*)(F.ws + WS_ROPE);
      for (int e = gw * 64 + lane; e < SEQ * 32; e += NGW * 64) { const int pos = e >> 5, i = e & 31;
          const float freq = powf(10000.0f, -(float)i / 32.0f); const float ang = (float)pos * freq; float s, c; sincos_d((double)ang, s, c);
          rope[2 * e] = c; rope[2 * e + 1] = s; } }
    { constexpr int I_IN = 16 * 40, I_PQ = 16 * 64, I_OUT = 8 * 32;
      for (int it = gw; it < I_IN + I_PQ + I_OUT; it += NGW) { int r = it;
          if (r < I_IN) { transpose_item<1>(F.w_in, NIN, (bf16*)(F.ws + WS_WIN), DM, 64 * (r / 40), 32 * (r % 40), scr, lane); continue; } r -= I_IN;
          if (r < I_PQ) { transpose_item<0>(F.w_pq, NQD, (bf16*)(F.ws + WS_WPQ), DM, 64 * (r / 64), 32 * (r % 64), scr, lane); continue; } r -= I_PQ;
          transpose_item<0>(F.w_out, DM, (bf16*)(F.ws + WS_WOUT), DM, 64 * (r / 32), 32 * (r % 32), scr, lane); } }
    { bf16* wout_t = (bf16*)(F.ws + WS_WOUT);
      for (int it = gw; it < 4 * 2 * 128; it += NGW) { const int g = it >> 8, ch = (it >> 7) & 1, n0 = (it & 127) * 8, cidx = ch * 64 + lane;
          float acc[8];
#pragma unroll
          for (int i = 0; i < 8; ++i) acc[i] = 0.f;
          const float* wp = F.w_pool + ((size_t)(g * 128 + cidx)) * 128; const float* ps = F.pool_scale + g * 128; const float* wo = F.w_out + (size_t)(512 + g * 128) * DM + n0;
          for (int e0 = 0; e0 < 128; e0 += 4) { const f32x4 wv = *(const f32x4*)(wp + e0);
#pragma unroll
              for (int ee = 0; ee < 4; ++ee) { const float w = wv[ee] * ps[e0 + ee]; const f32x4 o0 = *(const f32x4*)(wo + (size_t)(e0 + ee) * DM), o1 = *(const f32x4*)(wo + (size_t)(e0 + ee) * DM + 4);
                  acc[0] += w * o0[0]; acc[1] += w * o0[1]; acc[2] += w * o0[2]; acc[3] += w * o0[3]; acc[4] += w * o1[0]; acc[5] += w * o1[1]; acc[6] += w * o1[2]; acc[7] += w * o1[3]; } }
#pragma unroll
          for (int i = 0; i < 8; ++i) wout_t[(size_t)(n0 + i) * DM + 512 + g * 128 + cidx] = (bf16)f2bf(acc[i]); } }
    { bf16* k1b = (bf16*)(F.ws + WS_K1); bf16* k2b = (bf16*)(F.ws + WS_K2);
      for (int e = gw * 64 + lane; e < 128 * 128; e += NGW * 64) { k1b[e] = (bf16)f2bf(F.k1[e]); k2b[e] = (bf16)f2bf(F.k2[e]); } }
    { float* su = (float*)(F.ws + WS_SU); float* sv = (float*)(F.ws + WS_SV);
      for (int it = gw; it < 2 * NEXP; it += NGW) { const int tb = it >= NEXP, e = it - tb * NEXP; const float* src = (tb ? F.pv : F.pu) + (size_t)e * DM;
          f32x4 v[4]; float am = 0.f;
#pragma unroll
          for (int j = 0; j < 4; ++j) { v[j] = *(const f32x4*)(src + 256 * j + 4 * lane); am = fmaxf(am, fmaxf(fmaxf(fabsf(v[j][0]), fabsf(v[j][1])), fmaxf(fabsf(v[j][2]), fabsf(v[j][3])))); }
#pragma unroll
          for (int o = 1; o < 64; o <<= 1) am = fmaxf(am, __shfl_xor(am, o));
          if (am == 0.f) am = 1.f;
          v4u o;
          if (!tb) { const float sc = am * (1.0f / 127.0f), inv = 127.0f / am;
              unsigned w[4];
#pragma unroll
              for (int j = 0; j < 4; ++j) { const int q0 = (int)rintf(v[j][0] * inv), q1 = (int)rintf(v[j][1] * inv), q2 = (int)rintf(v[j][2] * inv), q3 = (int)rintf(v[j][3] * inv);
                  w[j] = (unsigned)(q0 & 255) | ((unsigned)(q1 & 255) << 8) | ((unsigned)(q2 & 255) << 16) | ((unsigned)(q3 & 255) << 24); }
              o = (v4u){w[0], w[1], w[2], w[3]};
              *(v4u*)(F.ws + WS_U + (size_t)e * DM + 16 * lane) = o; if (lane == 0) su[e] = sc;
          } else { const float sc = am * (1.0f / 256.0f), inv = 256.0f / am;
              unsigned w[4];
#pragma unroll
              for (int j = 0; j < 4; ++j) { int pk = __builtin_amdgcn_cvt_pk_fp8_f32(v[j][0] * inv, v[j][1] * inv, 0, false); pk = __builtin_amdgcn_cvt_pk_fp8_f32(v[j][2] * inv, v[j][3] * inv, pk, true); w[j] = (unsigned)pk; }
              o = (v4u){w[0], w[1], w[2], w[3]};
              *(v4u*)(F.ws + WS_V + (size_t)e * DM + 16 * lane) = o; if (lane == 0) sv[e] = sc; } } }
}
__device__ __forceinline__ void p1_xn(Frame& F) {
    const float* modp = (const float*)(F.ws + WS_MODP); float* mod = (float*)(F.ws + WS_MOD);
    if (F.vcu < 48 && F.tid < 256) { const int e = F.vcu * 256 + F.tid, b = e / 6144, n = e % 6144; float s = F.b_ada[n];
#pragma unroll
        for (int ks = 0; ks < 16; ++ks) s += modp[(ks * 2 + b) * 6144 + n];
        mod[e] = s; }
    LAS float* sc = (LAS float*)F.lds; LAS float* sh = sc + DM;
    const int row0 = F.vcu * (TT / F.G), nrows = TT / F.G, b = row0 >> 13;
    for (int n = F.tid; n < DM; n += NTHREADS) { float s0 = F.b_ada[n], s1 = F.b_ada[DM + n];
#pragma unroll
        for (int ks = 0; ks < 16; ++ks) { s0 += modp[(ks * 2 + b) * 6144 + n]; s1 += modp[(ks * 2 + b) * 6144 + DM + n]; }
        sh[n] = s0; sc[n] = 1.f + s1; }
    __syncthreads();
    bf16* xn = (bf16*)(F.ws + WS_XN);
    for (int r = F.wave; r < nrows; r += NWAVES) { const size_t m = (size_t)(row0 + r);
#pragma unroll
        for (int j = 0; j < 4; ++j) { const int d = 256 * j + 4 * F.lane; const f32x4 v = *(const f32x4*)(F.x + m * DM + d);
            u32x2 o; o.x = pk2(v[0] * sc[d] + sh[d], v[1] * sc[d + 1] + sh[d + 1]); o.y = pk2(v[2] * sc[d + 2] + sh[d + 2], v[3] * sc[d + 3] + sh[d + 3]);
            *(u32x2*)(xn + m * DM + d) = o; } }
    __syncthreads();
}
constexpr int KS_STRIDE = 144, VT_STRIDE = 520, KS_BYTES = 256 * KS_STRIDE, VT_BYTES = 64 * VT_STRIDE;
__device__ __forceinline__ void p3_attn_unit(Frame& F, int unit) {
    const int b = unit >> 7, kvh = (unit >> 6) & 1, n = unit & 63;
    const bf16* proj = (const bf16*)(F.ws + WS_PROJ); bf16* a2 = (bf16*)(F.ws + WS_A2);
    LAS unsigned char* Ks = F.lds; LAS unsigned char* Vt = F.lds + KS_BYTES;
    const int tid = F.tid, lane = F.lane, wave = F.wave, r32 = lane & 31, h = lane >> 5;
    const size_t tok0 = (size_t)b * SEQ + (size_t)n * 128;
#pragma unroll
    for (int i = 0; i < 4; ++i) { const int ci = tid + NTHREADS * i, row = ci >> 3, ch = ci & 7; const bool valid = (n > 0) || (row >= 128);
        const size_t tk = tok0 - 128 + row;
        v4u kv = (v4u){0u, 0u, 0u, 0u}, vv = (v4u){0u, 0u, 0u, 0u};
        if (valid) { kv = *(const v4u*)(proj + tk * NIN + 512 + kvh * 64 + ch * 8); vv = *(const v4u*)(proj + tk * NIN + 640 + kvh * 64 + ch * 8); }
        *(LAS v4u*)(Ks + row * KS_STRIDE + ch * 16) = kv;
        LAS bf16* vt = (LAS bf16*)(Vt + (ch * 8) * VT_STRIDE) + row;
        vt[0 * (VT_STRIDE / 2)] = (bf16)(vv.x & 0xffff); vt[1 * (VT_STRIDE / 2)] = (bf16)(vv.x >> 16); vt[2 * (VT_STRIDE / 2)] = (bf16)(vv.y & 0xffff); vt[3 * (VT_STRIDE / 2)] = (bf16)(vv.y >> 16);
        vt[4 * (VT_STRIDE / 2)] = (bf16)(vv.z & 0xffff); vt[5 * (VT_STRIDE / 2)] = (bf16)(vv.z >> 16); vt[6 * (VT_STRIDE / 2)] = (bf16)(vv.w & 0xffff); vt[7 * (VT_STRIDE / 2)] = (bf16)(vv.w >> 16); }
    __syncthreads();
    const int g = wave >> 1, hq = kvh * 4 + g; const float sink2 = F.sinks[hq] * LOG2E;
#pragma unroll 1
    for (int qt = 0; qt < 2; ++qt) {
        const int qi0 = (wave & 1) * 64 + qt * 32, t0 = qi0 >> 5; const size_t tokq = tok0 + qi0 + r32;
        bf16x8 qf[4];
#pragma unroll
        for (int s = 0; s < 4; ++s) qf[s] = *(const bf16x8*)(proj + tokq * NIN + hq * 64 + 16 * s + 8 * h);
        f32x16 sc[5];
#pragma unroll
        for (int kt = 0; kt < 5; ++kt) { sc[kt] = (f32x16){};
#pragma unroll
            for (int s = 0; s < 4; ++s) { const bf16x8 kf = *(const LAS bf16x8*)(Ks + (32 * (t0 + kt) + r32) * KS_STRIDE + (16 * s + 8 * h) * 2);
                sc[kt] = __builtin_amdgcn_mfma_f32_32x32x16_bf16(kf, qf[s], sc[kt], 0, 0, 0); } }
        const int qi = qi0 + r32; float m = sink2;
#pragma unroll
        for (int kt = 0; kt < 5; ++kt)
#pragma unroll
            for (int r = 0; r < 16; ++r) { const int sidx = 32 * (t0 + kt) + (r & 3) + 8 * (r >> 2) + 4 * h; const int rel = qi + 128 - sidx;
                const bool ok = (rel >= 0) && (rel < 128) && ((n > 0) || (sidx >= 128));
                const float v = ok ? sc[kt][r] : -INFINITY; sc[kt][r] = v; m = fmaxf(m, v); }
        m = fmaxf(m, __shfl_xor(m, 32));
        float l = 0.f;
#pragma unroll
        for (int kt = 0; kt < 5; ++kt)
#pragma unroll
            for (int r = 0; r < 16; ++r) { const float p = __builtin_amdgcn_exp2f(sc[kt][r] - m); sc[kt][r] = p; l += p; }
        l += __shfl_xor(l, 32); l += __builtin_amdgcn_exp2f(sink2 - m);
        f32x16 o[2]; o[0] = (f32x16){}; o[1] = (f32x16){};
#pragma unroll
        for (int kt = 0; kt < 5; ++kt)
#pragma unroll
            for (int s2 = 0; s2 < 2; ++s2) {
                u32x4 pw; pw.x = pg8::cvt_pk_bf16(sc[kt][8 * s2 + 0], sc[kt][8 * s2 + 1]); pw.y = pg8::cvt_pk_bf16(sc[kt][8 * s2 + 2], sc[kt][8 * s2 + 3]);
                pw.z = pg8::cvt_pk_bf16(sc[kt][8 * s2 + 4], sc[kt][8 * s2 + 5]); pw.w = pg8::cvt_pk_bf16(sc[kt][8 * s2 + 6], sc[kt][8 * s2 + 7]);
                const bf16x8 pf = __builtin_bit_cast(bf16x8, pw);
#pragma unroll
                for (int dt = 0; dt < 2; ++dt) { const LAS unsigned char* vp = Vt + (dt * 32 + r32) * VT_STRIDE + (32 * (t0 + kt) + 16 * s2 + 4 * h) * 2;
                    const u32x2 lo = *(const LAS u32x2*)vp, hi = *(const LAS u32x2*)(vp + 16);
                    const u32x4 vw = (u32x4){lo.x, lo.y, hi.x, hi.y};
                    o[dt] = __builtin_amdgcn_mfma_f32_32x32x16_bf16(__builtin_bit_cast(bf16x8, vw), pf, o[dt], 0, 0, 0); } }
        const float inv = 1.0f / l;
#pragma unroll
        for (int dt = 0; dt < 2; ++dt)
#pragma unroll
            for (int rg = 0; rg < 4; ++rg) { const int d0 = dt * 32 + 8 * rg + 4 * h;
                u32x2 w; w.x = pg8::cvt_pk_bf16(o[dt][4 * rg + 0] * inv, o[dt][4 * rg + 1] * inv); w.y = pg8::cvt_pk_bf16(o[dt][4 * rg + 2] * inv, o[dt][4 * rg + 3] * inv);
                *(u32x2*)(a2 + tokq * DM + hq * 64 + d0) = w; }
    }
    __syncthreads();
}
__device__ __forceinline__ void p3_pool_unit(Frame& F, int unit) {
    const bf16* proj = (const bf16*)(F.ws + WS_PROJ); bf16* a2 = (bf16*)(F.ws + WS_A2);
    const int cp = F.tid & 255, half = F.tid >> 8, gi = cp >> 6, w = 2 << gi;
    const int tstart = unit * 64 + half * 32, s0 = tstart & (SEQ - 1);
    const bf16* pc = proj + 768 + 2 * cp;
    float w0 = 0.f, w1 = 0.f;
    for (int j = 1; j <= w; ++j) if (s0 - j >= 0) { const unsigned u = *(const unsigned*)(pc + (size_t)(tstart - j) * NIN); w0 += bf_lo(u); w1 += bf_hi(u); }
    for (int i = 0; i < 32; ++i) { const int t = tstart + i, s = s0 + i;
        const unsigned u = *(const unsigned*)(pc + (size_t)t * NIN); const float p0 = bf_lo(u), p1 = bf_hi(u);
        w0 += p0; w1 += p1;
        if (s - w >= 0) { const unsigned uo = *(const unsigned*)(pc + (size_t)(t - w) * NIN); w0 -= bf_lo(uo); w1 -= bf_hi(uo); }
        const float rc = 1.0f / (float)((s + 1) < w ? (s + 1) : w);
        *(unsigned*)(a2 + (size_t)t * DM + 512 + 2 * cp) = pk2(w0 * rc - p0, w1 * rc - p1); }
}
__device__ __forceinline__ void p5_ln1(Frame& F) {
    const float* mod = (const float*)(F.ws + WS_MOD); const bf16* mix = (const bf16*)(F.ws + WS_MIX);
    bf16* x1 = (bf16*)(F.ws + WS_X1); bf16* h2 = (bf16*)(F.ws + WS_H2);
    const int gw = F.vcu * NWAVES + F.wave, lane = F.lane; const int rows_per_wave = TT / (F.G * NWAVES);
    const int row0 = gw * rows_per_wave, b = row0 >> 13;
    f32x4 g1[4], lg[4], lb[4], s2[4], h2s[4];
#pragma unroll
    for (int j = 0; j < 4; ++j) { const int d = 256 * j + 4 * lane;
        g1[j] = *(const f32x4*)(mod + b * 6144 + 2048 + d) + 1.0f; lg[j] = *(const f32x4*)(F.ln1_g + d); lb[j] = *(const f32x4*)(F.ln1_b + d);
        s2[j] = *(const f32x4*)(mod + b * 6144 + 4096 + d) + 1.0f; h2s[j] = *(const f32x4*)(mod + b * 6144 + 3072 + d); }
    for (int r = 0; r < rows_per_wave; ++r) { const size_t m = (size_t)(row0 + r);
        f32x4 v[4]; float s = 0.f;
#pragma unroll
        for (int j = 0; j < 4; ++j) { const int d = 256 * j + 4 * lane; const f32x4 xv = *(const f32x4*)(F.x + m * DM + d); const u32x2 mv = *(const u32x2*)(mix + m * DM + d);
            const f32x4 mf = (f32x4){bf_lo(mv.x), bf_hi(mv.x), bf_lo(mv.y), bf_hi(mv.y)};
            v[j] = xv * DN_ALPHA + g1[j] * mf; s += (v[j][0] + v[j][1]) + (v[j][2] + v[j][3]); }
        const float mean = wave_sum(s) * (1.f / DM); float q = 0.f;
#pragma unroll
        for (int j = 0; j < 4; ++j) { v[j] = v[j] - mean; q += (v[j][0] * v[j][0] + v[j][1] * v[j][1]) + (v[j][2] * v[j][2] + v[j][3] * v[j][3]); }
        const float rstd = 1.0f / sqrtf(wave_sum(q) * (1.f / DM) + LN_EPS);
#pragma unroll
        for (int j = 0; j < 4; ++j) { const int d = 256 * j + 4 * lane; const f32x4 y = v[j] * rstd * lg[j] + lb[j]; const f32x4 hh = y * s2[j] + h2s[j];
            u32x2 o; o.x = pk2(y[0], y[1]); o.y = pk2(y[2], y[3]); *(u32x2*)(x1 + m * DM + d) = o;
            u32x2 p; p.x = pk2(hh[0], hh[1]); p.y = pk2(hh[2], hh[3]); *(u32x2*)(h2 + m * DM + d) = p; } }
}
constexpr int KR_STRIDE = 272, KR_BYTES = 128 * KR_STRIDE;
#define INS16(a, v) do { _Pragma("unroll") for (int _i = 15; _i >= 1; --_i) a[_i] = __builtin_amdgcn_fmed3f(a[_i - 1], a[_i], (v)); a[0] = fmaxf(a[0], (v)); } while (0)
#define BITONIC16(a) do { _Pragma("unroll") for (int _st = 8; _st >= 1; _st >>= 1) { _Pragma("unroll") for (int _i = 0; _i < 16; ++_i) if ((_i & _st) == 0) { const float _x = a[_i], _y = a[_i + _st]; a[_i] = fmaxf(_x, _y); a[_i + _st] = fminf(_x, _y); } } } while (0)
__device__ __forceinline__ void p7_route(Frame& F) {
    const bf16* q = (const bf16*)(F.ws + WS_Q); unsigned short* pe = (unsigned short*)(F.ws + WS_PE); float* pg = (float*)(F.ws + WS_PG);
    const int tid = F.tid, lane = F.lane, wave = F.wave, r32 = lane & 31, h = lane >> 5;
    { const bf16* k1b = (const bf16*)(F.ws + WS_K1);
      for (int ci = tid; ci < 2 * 128 * 16; ci += NTHREADS) { const int side = ci >> 11, row = (ci >> 4) & 127, ch = ci & 15;
          *(LAS v4u*)(F.lds + side * KR_BYTES + row * KR_STRIDE + ch * 16) = *(const v4u*)(k1b + (size_t)side * 16384 + row * 128 + ch * 8); } }
    __syncthreads();
    LAS unsigned char* scr = F.lds + 2 * KR_BYTES + wave * 2048 + lane * 32;
    const int ntb = TT / 32;
    for (int tb = F.vcu; tb < ntb; tb += F.G) {
        const int head = wave; const size_t tok = (size_t)tb * 32 + r32;
        float vv[2][16];
#pragma unroll
        for (int side = 0; side < 2; ++side) {
            const bf16* qb = q + tok * NQD + head * 256 + side * 128;
            bf16x8 qf[8];
#pragma unroll
            for (int s = 0; s < 8; ++s) qf[s] = *(const bf16x8*)(qb + 16 * s + 8 * h);
            float a[16];
#pragma unroll
            for (int i = 0; i < 16; ++i) a[i] = -INFINITY;
#pragma unroll
            for (int kt = 0; kt < 4; ++kt) { f32x16 acc = (f32x16){};
#pragma unroll
                for (int s = 0; s < 8; ++s) { const bf16x8 kf = *(const LAS bf16x8*)(F.lds + side * KR_BYTES + (32 * kt + r32) * KR_STRIDE + (16 * s + 8 * h) * 2);
                    acc = __builtin_amdgcn_mfma_f32_32x32x16_bf16(kf, qf[s], acc, 0, 0, 0); }
#pragma unroll
                for (int r = 0; r < 16; ++r) { const unsigned key = (unsigned)(32 * kt + (r & 3) + 8 * (r >> 2)) | ((unsigned)h << 2);
                    const float v = __uint_as_float((__float_as_uint(acc[r]) & 0xFFFFFF80u) | key); INS16(a, v); }
                __builtin_amdgcn_sched_barrier(0); }
            float c[16];
#pragma unroll
            for (int i = 0; i < 16; ++i) c[i] = __shfl_xor(a[15 - i], 32);
#pragma unroll
            for (int i = 0; i < 16; ++i) c[i] = fmaxf(a[i], c[i]);
            BITONIC16(c);
#pragma unroll
            for (int i = 0; i < 16; ++i) vv[side][i] = c[i];
        }
        { v4u w1, w2;
#define PK4(L, b) ((__float_as_uint(L[b]) & 0x7Fu) | ((__float_as_uint(L[b + 1]) & 0x7Fu) << 8) | ((__float_as_uint(L[b + 2]) & 0x7Fu) << 16) | ((__float_as_uint(L[b + 3]) & 0x7Fu) << 24))
          w1.x = PK4(vv[0], 0); w1.y = PK4(vv[0], 4); w1.z = PK4(vv[0], 8); w1.w = PK4(vv[0], 12);
          w2.x = PK4(vv[1], 0); w2.y = PK4(vv[1], 4); w2.z = PK4(vv[1], 8); w2.w = PK4(vv[1], 12);
#undef PK4
          *(LAS v4u*)scr = w1; *(LAS v4u*)(scr + 16) = w2; }
        float c1[16], c2[16], top[16];
#pragma unroll
        for (int i = 0; i < 16; ++i) { c1[i] = __uint_as_float(__float_as_uint(vv[0][i]) & 0xFFFFFF80u); c2[i] = __uint_as_float(__float_as_uint(vv[1][i]) & 0xFFFFFF80u); top[i] = -INFINITY; }
#pragma unroll
        for (int ia = 0; ia < 16; ++ia)
#pragma unroll
            for (int ib = 0; ib < 16; ++ib) if ((ia + 1) * (ib + 1) <= 16) {
                const float sm = c1[ia] + c2[ib]; const float v = __uint_as_float((__float_as_uint(sm) & 0xFFFFFF00u) | (unsigned)(ia * 16 + ib)); INS16(top, v); }
        float ex[16], den = 0.f;
#pragma unroll
        for (int i = 0; i < 16; ++i) { ex[i] = __expf(top[i] - top[0]); den += ex[i]; }
        const float rden = 1.0f / den;
        LDS_WAIT();
        unsigned short ev[8]; float gv[8];
#pragma unroll
        for (int j = 0; j < 8; ++j) { const float t = h ? top[8 + j] : top[j]; const float e = h ? ex[8 + j] : ex[j];
            const unsigned code = __float_as_uint(t) & 0xFFu; const unsigned i1 = *(const LAS unsigned char*)(scr + (code >> 4)), i2 = *(const LAS unsigned char*)(scr + 16 + (code & 15u));
            ev[j] = (unsigned short)(i1 * 128u + i2); gv[j] = e * rden; }
        v4u ew; ew.x = ev[0] | ((unsigned)ev[1] << 16); ew.y = ev[2] | ((unsigned)ev[3] << 16); ew.z = ev[4] | ((unsigned)ev[5] << 16); ew.w = ev[6] | ((unsigned)ev[7] << 16);
        *(v4u*)(pe + tok * 128 + head * 16 + 8 * h) = ew;
        *(f32x4*)(pg + tok * 128 + head * 16 + 8 * h) = (f32x4){gv[0], gv[1], gv[2], gv[3]};
        *(f32x4*)(pg + tok * 128 + head * 16 + 8 * h + 4) = (f32x4){gv[4], gv[5], gv[6], gv[7]};
        LDS_WAIT();
    }
    __syncthreads();
}
__device__ __forceinline__ float gelu_erf(float x) { return 0.5f * x * (1.0f + erff(x * 0.70710678118654752f)); }
#ifndef NPART
#define NPART 16
#endif
constexpr int TPW = 4, NSWEEP = 2;
constexpr int PSHIFT = (NPART == 8) ? 11 : (NPART == 16) ? 10 : (NPART == 4) ? 12 : (NPART == 2) ? 13 : 14;
__device__ __forceinline__ void p8_peer(Frame& F) {
    const float* mod = (const float*)(F.ws + WS_MOD);
    const bf16* x1 = (const bf16*)(F.ws + WS_X1); const bf16* h2 = (const bf16*)(F.ws + WS_H2);
    const unsigned char* ut = F.ws + WS_U; const unsigned char* vt = F.ws + WS_V;
    const float* su = (const float*)(F.ws + WS_SU); const float* sv = (const float*)(F.ws + WS_SV);
    const unsigned* pe = (const unsigned*)(F.ws + WS_PE); const float* pg = (const float*)(F.ws + WS_PG);
    const int gw = F.vcu * NWAVES + F.wave, lane = F.lane;
    const int b5 = (lane >> 5) & 1, b4 = (lane >> 4) & 1, b3 = (lane >> 3) & 1, kmine = 4 * b5 + 2 * b4 + b3;
    LAS unsigned* scr = (LAS unsigned*)(F.lds + F.wave * 1024);
#pragma unroll 1
    for (int sweep = 0; sweep < NSWEEP; ++sweep) {
    const int t0 = (gw * NSWEEP + sweep) * TPW, b = t0 >> 13;
    unsigned hq[TPW][4]; float shs[TPW]; unsigned es[TPW]; float gs[TPW][2]; int offv[TPW];
#pragma unroll
    for (int tt = 0; tt < TPW; ++tt) { const size_t t = (size_t)(t0 + tt);
        float hv[16]; float am = 0.f;
#pragma unroll
        for (int j = 0; j < 4; ++j) { const u32x2 v = *(const u32x2*)(h2 + t * DM + 256 * j + 4 * lane); hv[4 * j] = bf_lo(v.x); hv[4 * j + 1] = bf_hi(v.x); hv[4 * j + 2] = bf_lo(v.y); hv[4 * j + 3] = bf_hi(v.y); }
#pragma unroll
        for (int i = 0; i < 16; ++i) am = fmaxf(am, fabsf(hv[i]));
#pragma unroll
        for (int o = 1; o < 64; o <<= 1) am = fmaxf(am, __shfl_xor(am, o));
        if (am == 0.f) am = 1.f;
        const float inv = 127.0f / am; shs[tt] = am * (1.0f / 127.0f);
#pragma unroll
        for (int j = 0; j < 4; ++j) { const int q0 = (int)rintf(hv[4 * j] * inv), q1 = (int)rintf(hv[4 * j + 1] * inv), q2 = (int)rintf(hv[4 * j + 2] * inv), q3 = (int)rintf(hv[4 * j + 3] * inv);
            hq[tt][j] = (unsigned)(q0 & 255) | ((unsigned)(q1 & 255) << 8) | ((unsigned)(q2 & 255) << 16) | ((unsigned)(q3 & 255) << 24); }
        const unsigned pe2 = pe[t * 64 + lane]; const f32x2 pg2 = *(const f32x2*)(pg + t * 128 + 2 * lane);
        const unsigned elo = pe2 & 0xffffu, ehi = pe2 >> 16; const int plo = (int)(elo >> PSHIFT), phi = (int)(ehi >> PSHIFT);
        int base = 0, poslo = 0, poshi = 0, ov = 0;
#pragma unroll
        for (int r = 0; r < NPART; ++r) { const unsigned long long mlo = __ballot(plo == r), mhi = __ballot(phi == r);
            const int clo = __popcll(mlo), chi = __popcll(mhi);
            const int rlo = (int)__builtin_amdgcn_mbcnt_hi((unsigned)(mlo >> 32), __builtin_amdgcn_mbcnt_lo((unsigned)mlo, 0u));
            const int rhi = (int)__builtin_amdgcn_mbcnt_hi((unsigned)(mhi >> 32), __builtin_amdgcn_mbcnt_lo((unsigned)mhi, 0u));
            if (plo == r) poslo = base + rlo; if (phi == r) poshi = base + clo + rhi;
            base += clo + chi; if (lane == r + 1) ov = base; }
        offv[tt] = ov;
        scr[2 * poslo] = elo; scr[2 * poslo + 1] = __float_as_uint(pg2.x); scr[2 * poshi] = ehi; scr[2 * poshi + 1] = __float_as_uint(pg2.y);
        LDS_WAIT();
        const u32x4 sr = *(const LAS u32x4*)(scr + 4 * lane);
        es[tt] = sr.x | (sr.z << 16); gs[tt][0] = __uint_as_float(sr.y); gs[tt][1] = __uint_as_float(sr.w);
        LDS_WAIT();
    }
    int cur[TPW];
#pragma unroll
    for (int tt = 0; tt < TPW; ++tt) cur[tt] = 0;
#pragma unroll 1
    for (int r = 0; r < NPART; ++r) {
#pragma unroll
        for (int tt = 0; tt < TPW; ++tt) {
            const int end = __builtin_amdgcn_readlane(offv[tt], r + 1);
            while (cur[tt] < end) {
                const int k4 = cur[tt] >> 1;
                u32x4 uq[8];
#pragma unroll
                for (int k2 = 0; k2 < 4; ++k2) { const unsigned ew = (unsigned)__builtin_amdgcn_readlane((int)es[tt], k4 + k2);
                    uq[2 * k2] = *(const u32x4*)(ut + (size_t)(ew & 0xffffu) * DM + 16 * lane); uq[2 * k2 + 1] = *(const u32x4*)(ut + (size_t)(ew >> 16) * DM + 16 * lane); }
                const int srcl = (k4 + 2 * b5 + b4) << 2;
                const unsigned ewm = (unsigned)__builtin_amdgcn_ds_bpermute(srcl, (int)es[tt]); const unsigned em = b3 ? (ewm >> 16) : (ewm & 0xffffu);
                const float sum = su[em], svm = sv[em];
                const float g0 = __int_as_float(__builtin_amdgcn_ds_bpermute(srcl, __float_as_int(gs[tt][0]))), g1 = __int_as_float(__builtin_amdgcn_ds_bpermute(srcl, __float_as_int(gs[tt][1])));
                const float gm = b3 ? g1 : g0;
                int p[8];
#pragma unroll
                for (int kk = 0; kk < 8; ++kk) { int s = __builtin_amdgcn_sdot4((int)uq[kk].x, (int)hq[tt][0], 0, false); s = __builtin_amdgcn_sdot4((int)uq[kk].y, (int)hq[tt][1], s, false);
                    s = __builtin_amdgcn_sdot4((int)uq[kk].z, (int)hq[tt][2], s, false); s = __builtin_amdgcn_sdot4((int)uq[kk].w, (int)hq[tt][3], s, false); p[kk] = s; }
                int q4[4], q2[2], q1;
#pragma unroll
                for (int i = 0; i < 4; ++i) { const int keep = b5 ? p[i + 4] : p[i], send = b5 ? p[i] : p[i + 4]; q4[i] = keep + __shfl_xor(send, 32); }
#pragma unroll
                for (int i = 0; i < 2; ++i) { const int keep = b4 ? q4[i + 2] : q4[i], send = b4 ? q4[i] : q4[i + 2]; q2[i] = keep + __shfl_xor(send, 16); }
                { const int keep = b3 ? q2[1] : q2[0], send = b3 ? q2[0] : q2[1]; q1 = keep + __shfl_xor(send, 8); }
                q1 += __shfl_xor(q1, 4); q1 += __shfl_xor(q1, 2); q1 += __shfl_xor(q1, 1);
                const float hid = (float)q1 * (shs[tt] * sum);
                const float am = gelu_erf(hid) * gm * svm;
                { const int i2 = (lane & 3) * 2; const float v0 = __int_as_float(__builtin_amdgcn_ds_bpermute(i2 << 5, __float_as_int(am))), v1 = __int_as_float(__builtin_amdgcn_ds_bpermute((i2 + 1) << 5, __float_as_int(am)));
                  if ((lane & ~3) == k4) { gs[tt][0] = v0; gs[tt][1] = v1; } }
                cur[tt] += 8;
            }
        }
    }
    float y[TPW][16];
#pragma unroll
    for (int tt = 0; tt < TPW; ++tt) { cur[tt] = 0;
#pragma unroll
        for (int i = 0; i < 16; ++i) y[tt][i] = 0.f; }
#pragma unroll 1
    for (int r = 0; r < NPART; ++r) {
#pragma unroll
        for (int tt = 0; tt < TPW; ++tt) {
            const int end = __builtin_amdgcn_readlane(offv[tt], r + 1);
            while (cur[tt] < end) {
                const int k4 = cur[tt] >> 1;
                u32x4 vq[8]; float av[8];
#pragma unroll
                for (int k2 = 0; k2 < 4; ++k2) { const unsigned ew = (unsigned)__builtin_amdgcn_readlane((int)es[tt], k4 + k2);
                    vq[2 * k2] = *(const u32x4*)(vt + (size_t)(ew & 0xffffu) * DM + 16 * lane); vq[2 * k2 + 1] = *(const u32x4*)(vt + (size_t)(ew >> 16) * DM + 16 * lane);
                    av[2 * k2] = __int_as_float(__builtin_amdgcn_readlane(__float_as_int(gs[tt][0]), k4 + k2)); av[2 * k2 + 1] = __int_as_float(__builtin_amdgcn_readlane(__float_as_int(gs[tt][1]), k4 + k2)); }
#pragma unroll
                for (int kk = 0; kk < 8; ++kk) { const float a = av[kk];
#define FP8ACC(word, j) { const unsigned _w = (word); const f32x2 _lo = __builtin_amdgcn_cvt_pk_f32_fp8((int)_w, false), _hi = __builtin_amdgcn_cvt_pk_f32_fp8((int)_w, true); \
                          y[tt][4 * (j)] += a * _lo.x; y[tt][4 * (j) + 1] += a * _lo.y; y[tt][4 * (j) + 2] += a * _hi.x; y[tt][4 * (j) + 3] += a * _hi.y; }
                    FP8ACC(vq[kk].x, 0) FP8ACC(vq[kk].y, 1) FP8ACC(vq[kk].z, 2) FP8ACC(vq[kk].w, 3)
#undef FP8ACC
                }
                cur[tt] += 8;
            }
        }
    }
#pragma unroll
    for (int tt = 0; tt < TPW; ++tt) { const size_t t = (size_t)(t0 + tt);
        f32x4 v[4]; float s = 0.f;
#pragma unroll
        for (int j = 0; j < 4; ++j) { const int d = 256 * j + 4 * lane; const u32x2 xv = *(const u32x2*)(x1 + t * DM + d); const f32x4 g2 = *(const f32x4*)(mod + b * 6144 + 5120 + d) + 1.0f;
            const f32x4 xf = (f32x4){bf_lo(xv.x), bf_hi(xv.x), bf_lo(xv.y), bf_hi(xv.y)}; const f32x4 yy = (f32x4){y[tt][4 * j], y[tt][4 * j + 1], y[tt][4 * j + 2], y[tt][4 * j + 3]};
            v[j] = xf * DN_ALPHA + g2 * yy; s += (v[j][0] + v[j][1]) + (v[j][2] + v[j][3]); }
        const float mean = wave_sum(s) * (1.f / DM); float qq = 0.f;
#pragma unroll
        for (int j = 0; j < 4; ++j) { v[j] = v[j] - mean; qq += (v[j][0] * v[j][0] + v[j][1] * v[j][1]) + (v[j][2] * v[j][2] + v[j][3] * v[j][3]); }
        const float rstd = 1.0f / sqrtf(wave_sum(qq) * (1.f / DM) + LN_EPS);
#pragma unroll
        for (int j = 0; j < 4; ++j) { const int d = 256 * j + 4 * lane; const f32x4 lg = *(const f32x4*)(F.ln2_g + d), lb = *(const f32x4*)(F.ln2_b + d);
            *(f32x4*)(F.out + t * DM + d) = v[j] * rstd * lg + lb; } }
    }
}
#ifndef MK_N_LAUNCHES
#define MK_N_LAUNCHES 1
#endif
constexpr int N_PHASES = 9;
struct Args { const float* in[18]; float* out; unsigned char* ws; int ph_lo, ph_hi; };
__global__ void __launch_bounds__(NTHREADS, 2) fwd_kernel(Args args) {
    extern __shared__ __attribute__((aligned(16))) unsigned char lds[];
    Frame F;
    F.lds = (LAS unsigned char*)lds;
    F.tid = threadIdx.x; F.lane = F.tid & 63; F.wave = __builtin_amdgcn_readfirstlane(F.tid >> 6);
    F.G = gridDim.x; { const int bx = blockIdx.x; F.vcu = (F.G % 8 == 0) ? (bx % 8) * (F.G / 8) + bx / 8 : bx; }
    F.x = args.in[0]; F.c = args.in[1]; F.w_ada = args.in[2]; F.b_ada = args.in[3]; F.w_in = args.in[4]; F.sinks = args.in[5]; F.w_pool = args.in[6]; F.pool_scale = args.in[7];
    F.w_out = args.in[8]; F.ln1_g = args.in[9]; F.ln1_b = args.in[10]; F.w_pq = args.in[11]; F.k1 = args.in[12]; F.k2 = args.in[13]; F.pu = args.in[14]; F.pv = args.in[15];
    F.ln2_g = args.in[16]; F.ln2_b = args.in[17]; F.out = args.out; F.ws = args.ws;
    volatile LAS unsigned* MISC = (volatile LAS unsigned*)(F.lds + MISC_OFF);
    for (int u = F.tid; u < (LDS_BYTES - LDSCTL_OFF) / 4; u += NTHREADS) ((LAS unsigned*)(F.lds + LDSCTL_OFF))[u] = 0u;
    __syncthreads();
    const int lo = args.ph_lo, hi = args.ph_hi;
    XcdBarrier bar; bar.bar = (unsigned*)(F.ws + WS_CTL) + CW_BAR; bar.x = 0; bar.st = nullptr;
    if (hi - lo > 1) bar = xcd_barrier_post((unsigned*)(F.ws + WS_CTL) + CW_BAR, MISC + 8);
#ifndef PH_MASK
#define PH_MASK 0x1ff
#endif
#define IN(k) (((PH_MASK >> (k)) & 1) && lo <= (k) && (k) < hi)
#define SEAM(k) do { if (IN(k) && IN((k) + 1)) xcd_barrier(bar); } while (0)
#ifndef REP_MASK
#define REP_MASK 0
#endif
#define REPS(k) ((REP_MASK >> (k)) & 1)
#define PHASE(k, ...) if (IN(k)) { for (int _r = 0; _r <= REPS(k); ++_r) { __VA_ARGS__; if (_r < REPS(k)) xcd_barrier(bar); } } SEAM(k)
    PHASE(0, p0_prologue(F));
    PHASE(1, p1_xn(F));
    PHASE(2, { pg8::Gemm g{(const pg8::bf16_t*)(F.ws + WS_XN), (const pg8::bf16_t*)(F.ws + WS_WIN), TT, NIN, DM}; pg8::StaticOrder S; S.init(TT, NIN, F.G, (int)blockIdx.x);
            pg8::EpiRope E{(pg8::bf16_t*)(F.ws + WS_PROJ), NIN, (const float*)(F.ws + WS_ROPE), QSCALE};
            pg8::gemm_phase<pg8::EpiRope, pg8::StaticOrder, true, true>(F.lds, g, S, E); });
    PHASE(3, { for (int u = F.vcu; u < 256; u += F.G) p3_attn_unit(F, u);
               for (int u = F.vcu; u < 256; u += F.G) p3_pool_unit(F, u); });
    PHASE(4, { pg8::Gemm g{(const pg8::bf16_t*)(F.ws + WS_A2), (const pg8::bf16_t*)(F.ws + WS_WOUT), TT, DM, DM}; pg8::StaticOrder S; S.init(TT, DM, F.G, (int)blockIdx.x);
            pg8::EpiPlain E{(pg8::bf16_t*)(F.ws + WS_MIX), DM};
            pg8::gemm_phase<pg8::EpiPlain, pg8::StaticOrder, true, true>(F.lds, g, S, E); });
    PHASE(5, p5_ln1(F));
    PHASE(6, { pg8::Gemm g{(const pg8::bf16_t*)(F.ws + WS_H2), (const pg8::bf16_t*)(F.ws + WS_WPQ), TT, NQD, DM}; pg8::StaticOrder S; S.init(TT, NQD, F.G, (int)blockIdx.x);
            pg8::EpiPlain E{(pg8::bf16_t*)(F.ws + WS_Q), NQD};
            pg8::gemm_phase<pg8::EpiPlain, pg8::StaticOrder, true, true>(F.lds, g, S, E); });
    PHASE(7, p7_route(F));
    PHASE(8, p8_peer(F));
#undef IN
#undef SEAM
}

extern "C" void kernel_launch(void* const* d_in, const int* in_sizes, int n_in, void* d_out, int out_size, void* d_ws, size_t ws_size, hipStream_t stream) {
    static int grid = 0;
    if (grid == 0) {
        if (n_in != 18 || out_size != TT * DM || ws_size < WS_END) { fprintf(stderr, "kernel_launch: unexpected shapes (n_in %d out %d ws %zu)\n", n_in, out_size, ws_size); grid = -1; return; }
        int dev = 0, cus = 0, per_cu = 0;
        if (hipGetDevice(&dev) != hipSuccess || hipDeviceGetAttribute(&cus, hipDeviceAttributeMultiprocessorCount, dev) != hipSuccess) { grid = -1; return; }
        if (hipFuncSetAttribute((const void*)fwd_kernel, hipFuncAttributeMaxDynamicSharedMemorySize, LDS_BYTES) != hipSuccess) { fprintf(stderr, "kernel_launch: hipFuncSetAttribute failed\n"); grid = -1; return; }
        if (hipOccupancyMaxActiveBlocksPerMultiprocessor(&per_cu, (const void*)fwd_kernel, NTHREADS, LDS_BYTES) != hipSuccess || per_cu < 1) { fprintf(stderr, "kernel_launch: occupancy query says %d blocks per CU\n", per_cu); }
        (void)hipGetLastError();
        grid = cus;
        if (grid != 256) fprintf(stderr, "kernel_launch: built for 256 CUs, got %d\n", grid);
    }
    if (grid < 0) return;
    (void)hipMemsetAsync((char*)d_ws + WS_CTL, 0, CTL_ZERO_BYTES, stream);
    Args a{};
    for (int i = 0; i < 18; ++i) a.in[i] = (const float*)d_in[i];
    a.out = (float*)d_out; a.ws = (unsigned char*)d_ws;
#if MK_N_LAUNCHES == 1
    a.ph_lo = 0; a.ph_hi = N_PHASES;
    hipLaunchKernelGGL(fwd_kernel, dim3(grid), dim3(NTHREADS), LDS_BYTES, stream, a);
#else
    for (int p = 0; p < N_PHASES; ++p) { a.ph_lo = p; a.ph_hi = p + 1; hipLaunchKernelGGL(fwd_kernel, dim3(grid), dim3(NTHREADS), LDS_BYTES, stream, a); }
#endif
}
```

```cpp
#include <hip/hip_runtime.h>
#include <cstdio>
#include <cstdint>
#include <cmath>
namespace pg8 {
#define PG8_LAS __attribute__((address_space(3)))
typedef unsigned short bf16_t;
typedef short bf16x8 __attribute__((ext_vector_type(8)));
typedef float f32x4 __attribute__((ext_vector_type(4)));
typedef unsigned u32x4 __attribute__((ext_vector_type(4)));
constexpr int BM = 256, BK = 64, HALF = 128, HTB = HALF * BK * 2  , STAGE_BYTES = 8 * HTB, NXCD = 8, WGM = 8;

__host__ __device__ __forceinline__ int lds_byte(int r, int c) { const int st = (r >> 4) * 2 + (c >> 5), rr = r & 15, cc = c & 31, ob = rr * 64 + cc * 2; return st * 1024 + (ob ^ (((ob >> 9) & 1) << 5)); }
__host__ __device__ __forceinline__ void stage_rc(int b, int& R, int& C) { const int st = b / 1024, sb = b % 1024, swz = sb ^ (((sb >> 9) & 1) << 5); R = (st >> 1) * 16 + swz / 64; C = (st & 1) * 32 + (swz % 64) / 2; }
__host__ __device__ __forceinline__ int perm32(int rho) { const int n = rho >> 4, i = rho & 15; return 8 * (i >> 2) + 4 * n + (i & 3); }

struct Unit { int pm, pn; };
struct Gemm { const bf16_t* A; const bf16_t* Bt; int M, N, K; int bsplit; size_t bstride; };

struct StaticOrder {
    int nM, nN, nwg, G, c;
    __host__ __device__ void init(int M, int N, int G_, int c_) { nM = M / BM; nN = N / BM; nwg = nM * nN; G = G_; c = c_; }
    __host__ __device__ bool next(int i, Unit& u) const {
        const long L = (long)i * G + c; if (L >= nwg) return false;
        int wgid = (int)L; { const int q = nwg / NXCD, r = nwg % NXCD, xcd = wgid % NXCD, off = wgid / NXCD; wgid = (xcd < r ? xcd * (q + 1) : r * (q + 1) + (xcd - r) * q) + off; }
        const int nig = WGM * nN, gid = wgid / nig, fm = gid * WGM, gsz = (nM - fm) < WGM ? (nM - fm) : WGM;
        u.pm = fm + ((wgid % nig) % gsz); u.pn = (wgid % nig) / gsz; return true;
    }
    __device__ __forceinline__ void a_ready(const Unit&) const {}
    __device__ __forceinline__ void done(const Unit&) const {}
};

__device__ __forceinline__ unsigned cvt_pk_bf16(float lo, float hi) { unsigned r; asm volatile("v_cvt_pk_bf16_f32 %0, %1, %2" : "=v"(r) : "v"(lo), "v"(hi)); return r; }

struct EpiPlain {
    static constexpr bool PERM = true, AFTER_DRAIN = false;
    bf16_t* O; int ldc;
    __device__ __forceinline__ void operator()(const f32x4 (&acc)[2][2][4][2], const Unit& u, int wr, int wc, int fr, int fq) const {
        const int row0 = u.pm * BM + wr * 64 + fr; const int col0 = u.pn * BM + wc * 32 + 8 * fq;
#pragma unroll
        for (int ai = 0; ai < 2; ++ai)
#pragma unroll
            for (int m = 0; m < 4; ++m) { bf16_t* rowp = O + (size_t)(row0 + ai * HALF + m * 16) * ldc + col0;
#pragma unroll
                for (int bj = 0; bj < 2; ++bj) { const f32x4 v0 = acc[ai][bj][m][0], v1 = acc[ai][bj][m][1];
                    u32x4 w; w.x = cvt_pk_bf16(v0[0], v0[1]); w.y = cvt_pk_bf16(v0[2], v0[3]); w.z = cvt_pk_bf16(v1[0], v1[1]); w.w = cvt_pk_bf16(v1[2], v1[3]);
                    *(u32x4*)(rowp + bj * HALF) = w; } }
    }
};
struct EpiRope {
    static constexpr bool PERM = true, AFTER_DRAIN = false;
    bf16_t* O; int ldc; const float* rope; float qscale; const float* bias;
    __device__ __forceinline__ void operator()(const f32x4 (&acc)[2][2][4][2], const Unit& u, int wr, int wc, int fr, int fq) const {
        const int row0 = u.pm * BM + wr * 64 + fr; const int col0 = u.pn * BM + wc * 32 + 8 * fq;
#pragma unroll
        for (int ai = 0; ai < 2; ++ai)
#pragma unroll
            for (int m = 0; m < 4; ++m) { const int row = row0 + ai * HALF + m * 16; bf16_t* rowp = O + (size_t)row * ldc + col0; const int pos = row & 8191;
#pragma unroll
                for (int bj = 0; bj < 2; ++bj) { const float* bp = bias + (size_t)(row >> 13) * ldc + col0 + bj * HALF;
                    f32x4 v0 = acc[ai][bj][m][0] + *(const f32x4*)bp, v1 = acc[ai][bj][m][1] + *(const f32x4*)(bp + 4);
                    const int colt = u.pn * BM + bj * HALF;
                    if (colt < 640) {
                        const int c = col0 + bj * HALF, ib = (c & 63) >> 1;
                        const f32x4 cs0 = *(const f32x4*)(rope + ((size_t)pos * 32 + ib) * 2), cs1 = *(const f32x4*)(rope + ((size_t)pos * 32 + ib) * 2 + 4);
                        const float sc = colt < 512 ? qscale : 1.0f;
                        f32x4 r0, r1;
                        r0[0] = (v0[0] * cs0[0] - v0[1] * cs0[1]) * sc; r0[1] = (v0[1] * cs0[0] + v0[0] * cs0[1]) * sc;
                        r0[2] = (v0[2] * cs0[2] - v0[3] * cs0[3]) * sc; r0[3] = (v0[3] * cs0[2] + v0[2] * cs0[3]) * sc;
                        r1[0] = (v1[0] * cs1[0] - v1[1] * cs1[1]) * sc; r1[1] = (v1[1] * cs1[0] + v1[0] * cs1[1]) * sc;
                        r1[2] = (v1[2] * cs1[2] - v1[3] * cs1[3]) * sc; r1[3] = (v1[3] * cs1[2] + v1[2] * cs1[3]) * sc;
                        v0 = r0; v1 = r1;
                    }
                    u32x4 w; w.x = cvt_pk_bf16(v0[0], v0[1]); w.y = cvt_pk_bf16(v0[2], v0[3]); w.z = cvt_pk_bf16(v1[0], v1[1]); w.w = cvt_pk_bf16(v1[2], v1[3]);
                    *(u32x4*)(rowp + bj * HALF) = w; } }
    }
};

template <class Epi, class Sched, bool ALIGN_EPI = false, bool SP2 = false>
__device__ __forceinline__ void gemm_phase(PG8_LAS unsigned char* lds, const Gemm g, const Sched& S, const Epi& E) {
    const int tid = threadIdx.x, wid = __builtin_amdgcn_readfirstlane(tid >> 6), lane = tid & 63, wr = wid >> 2, wc = wid & 3, fr = lane & 15, fq = lane >> 4;
    const int K = g.K, nt = K / BK;
    unsigned voffA[2], voffB[2];
#pragma unroll
    for (int i = 0; i < 2; ++i) { int R, C; stage_rc(tid * 16 + i * 8192, R, C); const int Rb = Epi::PERM ? ((R & ~31) + perm32(R & 31)) : R;
        voffA[i] = (unsigned)(R * K + C) * 2u; voffB[i] = (unsigned)(Rb * K + C) * 2u; }
    const size_t kstep = (size_t)(BK * 2);
    const size_t hstep = (size_t)HALF * K * 2;
    const size_t tstep = 2 * hstep;
    const unsigned ldsw = (unsigned)wid * 1024u;
    const int aoff = lds_byte(wr * 64 + fr, fq * 8), boff = lds_byte(wc * 32 + fr, fq * 8);
#define PG8_SA(b, h) (((b) * 2 + (h)) * HTB)
#define PG8_SB(b, h) ((4 + (b) * 2 + (h)) * HTB)
#define PG8_STAGE(bufoff, gbase, voff) do { _Pragma("unroll") for (int _i = 0; _i < 2; ++_i) \
        __builtin_amdgcn_global_load_lds((const unsigned*)((const char*)(gbase) + (voff)[_i]), (PG8_LAS unsigned*)(lds + (bufoff) + ldsw + _i * 8192), 16, 0, 0); } while (0)
#define PG8_LDA(dst, b, h) do { _Pragma("unroll") for (int m = 0; m < 4; ++m) _Pragma("unroll") for (int k = 0; k < 2; ++k) dst[m][k] = *(const PG8_LAS bf16x8*)(lds + PG8_SA(b, h) + aoff + m * 2048 + k * 1024); } while (0)
#define PG8_LDB(dst, b, h) do { _Pragma("unroll") for (int n = 0; n < 2; ++n) _Pragma("unroll") for (int k = 0; k < 2; ++k) dst[n][k] = *(const PG8_LAS bf16x8*)(lds + PG8_SB(b, h) + boff + n * 2048 + k * 1024); } while (0)
#define PG8_MMA(ai, bj, At, Bt) do { __builtin_amdgcn_s_setprio(1); _Pragma("unroll") for (int m = 0; m < 4; ++m) _Pragma("unroll") for (int n = 0; n < 2; ++n) _Pragma("unroll") for (int k = 0; k < 2; ++k) \
        acc[ai][bj][m][n] = __builtin_amdgcn_mfma_f32_16x16x32_bf16(Bt[n][k], At[m][k], acc[ai][bj][m][n], 0, 0, 0); __builtin_amdgcn_s_setprio(0); } while (0)
#define PG8_WAIT_V(n) asm volatile("s_waitcnt vmcnt(" #n ")" ::: "memory")
#define PG8_WAIT_L(n) asm volatile("s_waitcnt lgkmcnt(" #n ")" ::: "memory")
#define PG8_BAR __builtin_amdgcn_s_barrier()
#define PG8_SCHED __builtin_amdgcn_sched_barrier(0)
    Unit cur, nxt; int ui = 0;
    if (!S.next(0, cur)) return;
    f32x4 acc[2][2][4][2];
#pragma unroll
    for (int a = 0; a < 2; ++a)
#pragma unroll
        for (int b = 0; b < 2; ++b)
#pragma unroll
            for (int m = 0; m < 4; ++m)
#pragma unroll
                for (int n = 0; n < 2; ++n) acc[a][b][m][n] = (f32x4){0.f, 0.f, 0.f, 0.f};
    bf16x8 At[4][2], B0[2][2], B1[2][2];
    const char* cA = (const char*)g.A + (size_t)cur.pm * tstep; const char* cB = (const char*)g.Bt + (size_t)cur.pn * tstep + (cur.pm >= g.bsplit ? g.bstride : (size_t)0);
    S.a_ready(cur);
    if constexpr (SP2) {
        PG8_STAGE(PG8_SB(0, 0), cB, voffB); PG8_STAGE(PG8_SB(0, 1), cB + hstep, voffB); PG8_STAGE(PG8_SA(0, 0), cA, voffA); PG8_STAGE(PG8_SA(0, 1), cA + hstep, voffA);
        if (wr == 1) PG8_BAR;
        PG8_WAIT_V(2); PG8_BAR;
        PG8_STAGE(PG8_SB(1, 0), cB + kstep, voffB); PG8_STAGE(PG8_SA(1, 0), cA + kstep, voffA); PG8_STAGE(PG8_SB(1, 1), cB + hstep + kstep, voffB);
        PG8_WAIT_V(6); PG8_BAR;
    } else {
        PG8_STAGE(PG8_SB(0, 0), cB, voffB); PG8_STAGE(PG8_SA(0, 0), cA, voffA); PG8_STAGE(PG8_SB(0, 1), cB + hstep, voffB); PG8_STAGE(PG8_SA(0, 1), cA + hstep, voffA);
        if (wr == 1) PG8_BAR;
        PG8_WAIT_V(4); PG8_BAR;
        PG8_STAGE(PG8_SB(1, 0), cB + kstep, voffB); PG8_STAGE(PG8_SA(1, 0), cA + kstep, voffA); PG8_STAGE(PG8_SB(1, 1), cB + hstep + kstep, voffB);
        PG8_WAIT_V(6); PG8_BAR;
    }
    for (;;) {
        const bool has_next = S.next(ui + 1, nxt);
        const char* nA = has_next ? (const char*)g.A + (size_t)nxt.pm * tstep : cA; const char* nB = has_next ? (const char*)g.Bt + (size_t)nxt.pn * tstep + (nxt.pm >= g.bsplit ? g.bstride : (size_t)0) : cB;
        for (int t = 0; t < nt; t += 2) {
            const bool last = (t == nt - 2);
            const char* a1 = cA + (size_t)(t + 1) * kstep;
            const char* a2 = last ? nA : cA + (size_t)(t + 2) * kstep; const char* b2 = last ? nB : cB + (size_t)(t + 2) * kstep;
            const char* a3 = a2 + kstep; const char* b3 = b2 + kstep;
            if (last && has_next) S.a_ready(nxt);
            if constexpr (SP2) {
            PG8_LDB(B0, 0, 0); PG8_LDB(B1, 0, 1); PG8_SCHED; PG8_LDA(At, 0, 0); PG8_STAGE(PG8_SA(1, 1), a1 + hstep, voffA);
            PG8_WAIT_V(8); PG8_WAIT_L(0); PG8_BAR; PG8_MMA(0, 0, At, B0); PG8_MMA(0, 1, At, B1); PG8_BAR; PG8_SCHED;
            PG8_LDA(At, 0, 1); PG8_STAGE(PG8_SB(0, 0), b2, voffB); PG8_STAGE(PG8_SB(0, 1), b2 + hstep, voffB); PG8_STAGE(PG8_SA(0, 0), a2, voffA);
            PG8_WAIT_V(8); PG8_WAIT_L(0); PG8_BAR; PG8_MMA(1, 0, At, B0); PG8_MMA(1, 1, At, B1); PG8_BAR; PG8_SCHED;
            PG8_LDB(B0, 1, 0); PG8_LDB(B1, 1, 1); PG8_SCHED; PG8_LDA(At, 1, 0); PG8_STAGE(PG8_SA(0, 1), a2 + hstep, voffA);
            PG8_WAIT_V(8); PG8_WAIT_L(0); PG8_BAR; PG8_MMA(0, 0, At, B0); PG8_MMA(0, 1, At, B1); PG8_BAR; PG8_SCHED;
            PG8_LDA(At, 1, 1); PG8_STAGE(PG8_SB(1, 0), b3, voffB); PG8_STAGE(PG8_SB(1, 1), b3 + hstep, voffB); PG8_STAGE(PG8_SA(1, 0), a3, voffA);
            PG8_WAIT_V(8); PG8_WAIT_L(0); PG8_BAR; PG8_MMA(1, 0, At, B0); PG8_MMA(1, 1, At, B1); PG8_BAR; PG8_SCHED;
            } else {
            PG8_LDB(B0, 0, 0); PG8_SCHED; PG8_LDA(At, 0, 0); PG8_STAGE(PG8_SA(1, 1), a1 + hstep, voffA);
            PG8_WAIT_L(8); PG8_BAR; PG8_WAIT_L(0); PG8_MMA(0, 0, At, B0); PG8_BAR; PG8_SCHED;
            PG8_LDB(B1, 0, 1); PG8_STAGE(PG8_SB(0, 0), b2, voffB);
            PG8_BAR; PG8_WAIT_L(0); PG8_MMA(0, 1, At, B1); PG8_BAR;
            PG8_LDA(At, 0, 1); PG8_STAGE(PG8_SA(0, 0), a2, voffA);
            PG8_BAR; PG8_WAIT_L(0); PG8_MMA(1, 0, At, B0); PG8_BAR; PG8_SCHED;
            PG8_STAGE(PG8_SB(0, 1), b2 + hstep, voffB);
            PG8_WAIT_V(6); PG8_BAR; PG8_MMA(1, 1, At, B1); PG8_BAR;
            PG8_LDB(B0, 1, 0); PG8_SCHED; PG8_LDA(At, 1, 0); PG8_STAGE(PG8_SA(0, 1), a2 + hstep, voffA);
            PG8_WAIT_L(8); PG8_BAR; PG8_WAIT_L(0); PG8_MMA(0, 0, At, B0); PG8_BAR; PG8_SCHED;
            PG8_LDB(B1, 1, 1); PG8_STAGE(PG8_SB(1, 0), b3, voffB);
            PG8_BAR; PG8_WAIT_L(0); PG8_MMA(0, 1, At, B1); PG8_BAR;
            PG8_LDA(At, 1, 1); PG8_STAGE(PG8_SA(1, 0), a3, voffA);
            PG8_BAR; PG8_WAIT_L(0); PG8_MMA(1, 0, At, B0); PG8_BAR; PG8_SCHED;
            PG8_STAGE(PG8_SB(1, 1), b3 + hstep, voffB);
            PG8_WAIT_V(6); PG8_BAR; PG8_MMA(1, 1, At, B1); PG8_BAR;
            }
        }
        if constexpr (ALIGN_EPI) { if (wr == 0) PG8_BAR; }
        if constexpr (!Epi::AFTER_DRAIN) { E(acc, cur, wr, wc, fr, fq); S.done(cur); }
        if (!has_next) break;
#pragma unroll
        for (int a = 0; a < 2; ++a)
#pragma unroll
            for (int b = 0; b < 2; ++b)
#pragma unroll
                for (int m = 0; m < 4; ++m)
#pragma unroll
                    for (int n = 0; n < 2; ++n) acc[a][b][m][n] = (f32x4){0.f, 0.f, 0.f, 0.f};
        cur = nxt; cA = nA; cB = nB; ++ui;
        if constexpr (ALIGN_EPI) { if (wr == 1) PG8_BAR; }
    }
    PG8_WAIT_V(0);
    if constexpr (!ALIGN_EPI) { if (wr == 0) PG8_BAR; }
    PG8_BAR;
    if constexpr (Epi::AFTER_DRAIN) { E.fused(acc, cur, wr, wc, fr, fq, lds, wid, lane); S.done(cur); }
#undef PG8_SA
#undef PG8_SB
#undef PG8_STAGE
#undef PG8_LDA
#undef PG8_LDB
#undef PG8_MMA
#undef PG8_WAIT_V
#undef PG8_WAIT_L
#undef PG8_BAR
#undef PG8_SCHED
}
}
#define GAS __attribute__((address_space(1)))
#define LAS __attribute__((address_space(3)))
typedef unsigned short bf16;
typedef unsigned v4u __attribute__((ext_vector_type(4)));
typedef float f32x4 __attribute__((ext_vector_type(4)));
typedef short bf16x8 __attribute__((ext_vector_type(8)));
typedef GAS unsigned gu32;
typedef GAS unsigned long long gu64;
#define RLX_AGENT __ATOMIC_RELAXED, __HIP_MEMORY_SCOPE_AGENT
#define LDS_WAIT() asm volatile("s_waitcnt lgkmcnt(0)" ::: "memory")
#define VM_WAIT() asm volatile("s_waitcnt vmcnt(0)" ::: "memory")
__device__ __forceinline__ unsigned long long rt() { return __builtin_amdgcn_s_memrealtime(); }
__device__ __forceinline__ unsigned f2bf(float f) { unsigned u = __builtin_bit_cast(unsigned, f); return (u + 0x7fffu + ((u >> 16) & 1u)) >> 16; }
__device__ __forceinline__ unsigned pk2(float lo, float hi) { return f2bf(lo) | (f2bf(hi) << 16); }
#define XB_TMO      128
#define XB_XCNT(j)  (256  + 64 * (j))
#define XB_XSUB(j)  (1280 + 64 * (j))
#define XB_XGEN(j)  (2304 + 64 * (j))
#define XB_TOP      3328
#define XB_TOPGEN   3392
#define XCD_BAR_WORDS 3456
#define XB_SPIN_CAP (1u << 18)

__device__ __forceinline__ unsigned xb_ld(unsigned* p)              { return __hip_atomic_load(p, __ATOMIC_RELAXED, __HIP_MEMORY_SCOPE_AGENT); }
__device__ __forceinline__ unsigned xb_add(unsigned* p, unsigned v) { return __hip_atomic_fetch_add(p, v, __ATOMIC_RELAXED, __HIP_MEMORY_SCOPE_AGENT); }
__device__ __forceinline__ unsigned xb_xcc_id() { return (unsigned)__builtin_amdgcn_s_getreg((3 << 11) | 20) & 0xFu; }
#define XB_SPIN(cond, bar) do { unsigned _sp = 0; while (cond) { __builtin_amdgcn_s_sleep(1); \
    if ((++_sp & 255u) == 0u) { if (xb_ld(&(bar)[XB_TMO])) break; if (_sp > XB_SPIN_CAP) { atomicAdd(&(bar)[XB_TMO], 1u); break; } } } } while (0)

struct XcdBarrier {
    unsigned* bar; unsigned x;
    volatile LAS unsigned* st;
};

__device__ __forceinline__ XcdBarrier xcd_barrier_post(unsigned* bar, volatile LAS unsigned* st) {
    XcdBarrier b; b.bar = bar; b.x = xb_xcc_id(); b.st = st;
    if (threadIdx.x == 0) (void)xb_add(&bar[XB_XCNT(b.x)], 1u);
    return b;
}
__device__ __forceinline__ void xcd_barrier_complete(unsigned* bar, unsigned x, unsigned& nloc, unsigned& nx) {
    const unsigned G = gridDim.x * gridDim.y * gridDim.z;
    unsigned sum, cnt, mine, sp = 0u;
    for (;;) {
        sum = 0u; cnt = 0u; mine = 0u;
#pragma unroll
        for (unsigned j = 0; j < 16; ++j) { const unsigned c = xb_ld(&bar[XB_XCNT(j)]); sum += c; cnt += (c > 0u) ? 1u : 0u; mine = (j == x) ? c : mine; }
        if (sum == G) break;
        __builtin_amdgcn_s_sleep(1);
        if ((++sp & 255u) == 0u) { if (xb_ld(&bar[XB_TMO])) break; if (sp > XB_SPIN_CAP) { atomicAdd(&bar[XB_TMO], 1u); break; } }
    }
    nloc = mine > 0u ? mine : 1u; nx = cnt > 0u ? cnt : 1u;
}

__device__ __forceinline__ void xcd_barrier(const XcdBarrier& b) {
    asm volatile("s_waitcnt vmcnt(0)" ::: "memory");
    __syncthreads();
    if (threadIdx.x == 0) {
        unsigned* bar = b.bar;
        __builtin_amdgcn_s_waitcnt(0);
        unsigned nloc = b.st[0], nx = b.st[1];
        if (nloc == 0u) { xcd_barrier_complete(bar, b.x, nloc, nx); b.st[0] = nloc; b.st[1] = nx; }
        const unsigned old = xb_add(&bar[XB_XSUB(b.x)], 1u);
        const unsigned gen = old / nloc;
        if (old + 1u == (gen + 1u) * nloc) {
            __builtin_amdgcn_fence(__ATOMIC_RELEASE, "agent");
            asm volatile("s_waitcnt vmcnt(0)" ::: "memory");
            const unsigned og = xb_add(&bar[XB_TOP], 1u);
            const unsigned tg = og / nx;
            if (og + 1u == (tg + 1u) * nx) xb_add(&bar[XB_TOPGEN], 1u);
            else XB_SPIN(xb_ld(&bar[XB_TOPGEN]) == tg, bar);
            __builtin_amdgcn_fence(__ATOMIC_ACQUIRE, "agent");
            xb_add(&bar[XB_XGEN(b.x)], 1u);
            asm volatile("s_waitcnt vmcnt(0)" ::: "memory");
        } else {
            XB_SPIN(xb_ld(&bar[XB_XGEN(b.x)]) == gen, bar);
            __builtin_amdgcn_fence(__ATOMIC_ACQUIRE, "agent");
            asm volatile("s_waitcnt vmcnt(0)" ::: "memory");
        }
    }
    __syncthreads();
}
constexpr int NWAVES = 8, NTHREADS = 512;
constexpr int TT = 16384, DM = 1024, SEQ = 8192, NIN = 1280, NQD = 2048, NEXP = 16384;
constexpr float DN_ALPHA = 1.189207115002721f;
constexpr float LN_EPS = 1e-5f;
constexpr float LOG2E = 1.4426950408889634f;
constexpr float QSCALE = 0.125f * LOG2E;

constexpr size_t MiB = 1u << 20;
constexpr size_t WS_CTL = 0, CTL_ZERO_BYTES = 64 * 1024;
constexpr size_t WS_MOD = 1 * MiB + 896 * 1024;
constexpr size_t WS_ROPE = 2 * MiB;
constexpr size_t WS_WIN = 248 * MiB;
constexpr size_t WS_BIAS = 4 * MiB;
constexpr size_t WS_K1 = 6 * MiB + 512 * 1024, WS_K2 = WS_K1 + 32 * 1024;
constexpr size_t WS_WOUT = 7 * MiB;
constexpr size_t WS_WPQ = 9 * MiB;
constexpr size_t WS_SU = 13 * MiB, WS_SV = 13 * MiB + 65536;
constexpr size_t WS_U = 16 * MiB, WS_V = 32 * MiB;
constexpr size_t WS_XN = 80 * MiB;
constexpr size_t WS_MIX = 80 * MiB;
constexpr size_t WS_PE = 80 * MiB, WS_PG = 84 * MiB;
constexpr size_t WS_PROJ = 112 * MiB;
constexpr size_t WS_A2 = 152 * MiB;
constexpr size_t WS_X1 = 184 * MiB, WS_H2 = 216 * MiB;
constexpr size_t WS_Q = 112 * MiB;
constexpr size_t WS_END = 253 * MiB;
constexpr int CW_BAR = 4096;

constexpr int RING_BYTES = 131072, LDSCTL_OFF = RING_BYTES, MISC_OFF = LDSCTL_OFF + 320, LDS_BYTES = 147456;

typedef float f32x16 __attribute__((ext_vector_type(16)));
typedef float f32x2 __attribute__((ext_vector_type(2)));
typedef unsigned u32x2 __attribute__((ext_vector_type(2)));
typedef unsigned u32x4 __attribute__((ext_vector_type(4)));
typedef __bf16 bf16x2_t __attribute__((ext_vector_type(2)));
struct Frame {
    LAS unsigned char* lds;
    int tid, lane, wave, vcu, G;
    const float *x, *c, *w_ada, *b_ada, *w_in, *sinks, *w_pool, *pool_scale, *w_out, *ln1_g, *ln1_b, *w_pq, *k1, *k2, *pu, *pv, *ln2_g, *ln2_b;
    float* out; unsigned char* ws;
};
__device__ __forceinline__ float wave_sum(float v) {
#pragma unroll
    for (int o = 1; o < 64; o <<= 1) v += __shfl_xor(v, o);
    return v;
}
__device__ __forceinline__ float bf_lo(unsigned u) { return __uint_as_float(u << 16); }
__device__ __forceinline__ float bf_hi(unsigned u) { return __uint_as_float(u & 0xffff0000u); }
__device__ __forceinline__ float bf2f(bf16 b) { return __uint_as_float((unsigned)b << 16); }

template <int MODE>
__device__ __forceinline__ void transpose_item(const float* W, int ldw, bf16* WT, int ldt, int k0, int n0, LAS float* scr, int lane, const LAS float* ksc = nullptr) {
    int nsrc = n0 + (lane & 31);
    if (MODE == 1 && nsrc < 640) { const int hd = nsrc >> 6, w = nsrc & 63; nsrc = hd * 64 + (w >> 1) + 32 * (w & 1); }
#pragma unroll 8
    for (int i = 0; i < 32; ++i) { const int kk = 2 * i + (lane >> 5); float wv = W[(size_t)(k0 + kk) * ldw + nsrc]; if (MODE == 1) wv *= ksc[k0 + kk]; scr[kk * 33 + (lane & 31)] = wv; }
    LDS_WAIT(); asm volatile("" ::: "memory");
    const int c = lane & 7;
#pragma unroll
    for (int j = 0; j < 4; ++j) { const int n = (lane >> 3) + 8 * j; const LAS float* s = scr + (8 * c) * 33 + n;
        v4u o; o.x = pk2(s[0 * 33], s[1 * 33]); o.y = pk2(s[2 * 33], s[3 * 33]); o.z = pk2(s[4 * 33], s[5 * 33]); o.w = pk2(s[6 * 33], s[7 * 33]);
        *(GAS v4u*)(WT + (size_t)(n0 + n) * ldt + k0 + 8 * c) = o; }
    LDS_WAIT(); asm volatile("" ::: "memory");
}
__device__ __forceinline__ void sincos_d(double a, float& s, float& c) {
    const double TWO_PI = 6.283185307179586476925, PI = 3.141592653589793238462643;
    double r = a - TWO_PI * rint(a / TWO_PI);
    double sg = 1.0;
    if (r > 0.5 * PI) { r = PI - r; sg = -1.0; } else if (r < -0.5 * PI) { r = -PI - r; sg = -1.0; }
    const double r2 = r * r;
    double sp = -1.0 / 121645100408832000.0;
    sp = sp * r2 + 1.0 / 355687428096000.0; sp = sp * r2 - 1.0 / 1307674368000.0; sp = sp * r2 + 1.0 / 6227020800.0; sp = sp * r2 - 1.0 / 39916800.0;
    sp = sp * r2 + 1.0 / 362880.0; sp = sp * r2 - 1.0 / 5040.0; sp = sp * r2 + 1.0 / 120.0; sp = sp * r2 - 1.0 / 6.0; sp = sp * r2 + 1.0;
    double cp = 1.0 / 6402373705728000.0;
    cp = cp * r2 - 1.0 / 20922789888000.0; cp = cp * r2 + 1.0 / 87178291200.0; cp = cp * r2 - 1.0 / 479001600.0; cp = cp * r2 + 1.0 / 3628800.0;
    cp = cp * r2 - 1.0 / 40320.0; cp = cp * r2 + 1.0 / 720.0; cp = cp * r2 - 1.0 / 24.0; cp = cp * r2 + 0.5; cp = 1.0 - cp * r2;
    s = (float)(sp * r); c = (float)(sg * cp);
}
__device__ __forceinline__ void p0_prologue(Frame& F) {
    LAS float* scr = (LAS float*)(F.lds + F.wave * 16384);
    const int gw = F.vcu * NWAVES + F.wave, NGW = F.G * NWAVES, lane = F.lane;
    if (F.vcu < 96) { const int col = F.vcu * 64 + lane; float a0 = 0.f, a1 = 0.f;
#pragma unroll 32
        for (int k = F.wave * 128; k < F.wave * 128 + 128; ++k) {
            const float c0 = F.c[k], c1 = F.c[DM + k]; const float s0 = c0 / (1.f + __expf(-c0)), s1 = c1 / (1.f + __expf(-c1));
            const float w = F.w_ada[(size_t)k * 6144 + col]; a0 += s0 * w; a1 += s1 * w; }
        LAS float* red = (LAS float*)(F.lds + F.wave * 16384 + 12288); red[lane] = a0; red[64 + lane] = a1;
        __syncthreads();
        if (F.tid < 128) { const int bb = F.tid >> 6, l = F.tid & 63; float sacc = F.b_ada[F.vcu * 64 + l];
#pragma unroll
            for (int w = 0; w < 8; ++w) sacc += ((const LAS float*)(F.lds + w * 16384 + 12288))[bb * 64 + l];
            ((float*)(F.ws + WS_MOD))[bb * 6144 + F.vcu * 64 + l] = sacc; } }
    { float* rope = (float*)(F.ws + WS_ROPE);
      for (int e = gw * 64 + lane; e < SEQ * 32; e += NGW * 64) { const int pos = e >> 5, i = e & 31;
          const float freq = powf(10000.0f, -(float)i / 32.0f); const float ang = (float)pos * freq; float s, c; sincos_d((double)ang, s, c);
          rope[2 * e] = c; rope[2 * e + 1] = s; } }
    { constexpr int I_PQ = 16 * 64, I_OUT = 8 * 32;
      for (int it = gw; it < I_PQ + I_OUT; it += NGW) { int r = it;
          if (r < I_PQ) { transpose_item<0>(F.w_pq, NQD, (bf16*)(F.ws + WS_WPQ), DM, 64 * (r / 64), 32 * (r % 64), scr, lane); continue; } r -= I_PQ;
          transpose_item<0>(F.w_out, DM, (bf16*)(F.ws + WS_WOUT), DM, 64 * (r / 32), 32 * (r % 32), scr, lane); } }
    { bf16* wout_t = (bf16*)(F.ws + WS_WOUT);
      for (int it = gw; it < 4 * 2 * 128; it += NGW) { const int g = it >> 8, ch = (it >> 7) & 1, n0 = (it & 127) * 8, cidx = ch * 64 + lane;
          const float* wo = F.w_out + (size_t)(512 + g * 128) * DM + n0; const float* ps = F.pool_scale + g * 128;
#pragma unroll
          for (int i = 0; i < 4; ++i) { const int f4 = lane + 64 * i, e = f4 >> 1, hf = f4 & 1; const f32x4 o = *(const f32x4*)(wo + (size_t)e * DM + 4 * hf) * ps[e]; *(LAS f32x4*)(scr + e * 8 + 4 * hf) = o; }
          float acc[8];
#pragma unroll
          for (int i = 0; i < 8; ++i) acc[i] = 0.f;
          const float* wp = F.w_pool + ((size_t)(g * 128 + cidx)) * 128;
          LDS_WAIT(); asm volatile("" ::: "memory");
#pragma unroll 1
          for (int e0 = 0; e0 < 128; e0 += 32) { f32x4 wv[8];
#pragma unroll
              for (int q = 0; q < 8; ++q) wv[q] = *(const f32x4*)(wp + e0 + 4 * q);
#pragma unroll
              for (int q = 0; q < 8; ++q)
#pragma unroll
                  for (int ee = 0; ee < 4; ++ee) { const float w = wv[q][ee]; const f32x4 o0 = *(const LAS f32x4*)(scr + (e0 + 4 * q + ee) * 8), o1 = *(const LAS f32x4*)(scr + (e0 + 4 * q + ee) * 8 + 4);
                      acc[0] += w * o0[0]; acc[1] += w * o0[1]; acc[2] += w * o0[2]; acc[3] += w * o0[3]; acc[4] += w * o1[0]; acc[5] += w * o1[1]; acc[6] += w * o1[2]; acc[7] += w * o1[3]; } }
#pragma unroll
          for (int i = 0; i < 8; ++i) wout_t[(size_t)(n0 + i) * DM + 512 + g * 128 + cidx] = (bf16)f2bf(acc[i]);
          LDS_WAIT(); asm volatile("" ::: "memory"); } }
    { bf16* k1b = (bf16*)(F.ws + WS_K1); bf16* k2b = (bf16*)(F.ws + WS_K2);
      for (int e = gw * 64 + lane; e < 128 * 128; e += NGW * 64) { k1b[e] = (bf16)f2bf(F.k1[e]); k2b[e] = (bf16)f2bf(F.k2[e]); } }
    { bf16* xn = (bf16*)(F.ws + WS_XN); const int rpw = TT / NGW;
      for (int m = gw * rpw; m < gw * rpw + rpw; m += 2) { f32x4 v[2][4];
#pragma unroll
          for (int q = 0; q < 2; ++q)
#pragma unroll
              for (int j = 0; j < 4; ++j) v[q][j] = *(const f32x4*)(F.x + (size_t)(m + q) * DM + 256 * j + 4 * lane);
#pragma unroll
          for (int q = 0; q < 2; ++q)
#pragma unroll
              for (int j = 0; j < 4; ++j) { u32x2 o; o.x = pk2(v[q][j][0], v[q][j][1]); o.y = pk2(v[q][j][2], v[q][j][3]); *(u32x2*)(xn + (size_t)(m + q) * DM + 256 * j + 4 * lane) = o; } } }
}
__device__ __forceinline__ void p2_tables(Frame& F, int cw, int ncw) {
    const int lane = F.lane; float* su = (float*)(F.ws + WS_SU); float* sv = (float*)(F.ws + WS_SV);
    const int per = (2 * NEXP + ncw - 1) / ncw, r0 = cw * per, r1 = (r0 + per) < 2 * NEXP ? (r0 + per) : 2 * NEXP;
    for (int it0 = r0; it0 < r1; it0 += 4) {
        f32x4 v[4][4]; float am[4];
#pragma unroll
        for (int q = 0; q < 4; ++q) { const int it = (it0 + q < r1) ? it0 + q : r1 - 1; const int tb = it >= NEXP, e = it - tb * NEXP; const float* src = (tb ? F.pv : F.pu) + (size_t)e * DM;
#pragma unroll
            for (int j = 0; j < 4; ++j) v[q][j] = *(const f32x4*)(src + 256 * j + 4 * lane); }
#pragma unroll
        for (int q = 0; q < 4; ++q) { float a = 0.f;
#pragma unroll
            for (int j = 0; j < 4; ++j) a = fmaxf(a, fmaxf(fmaxf(fabsf(v[q][j][0]), fabsf(v[q][j][1])), fmaxf(fabsf(v[q][j][2]), fabsf(v[q][j][3])))); am[q] = a; }
#pragma unroll
        for (int o = 1; o < 64; o <<= 1) {
#pragma unroll
            for (int q = 0; q < 4; ++q) am[q] = fmaxf(am[q], __shfl_xor(am[q], o)); }
#pragma unroll
        for (int q = 0; q < 4; ++q) { const int it = (it0 + q < r1) ? it0 + q : r1 - 1; const int tb = it >= NEXP, e = it - tb * NEXP; float a = am[q]; if (a == 0.f) a = 1.f;
            unsigned w[4];
            if (!tb) { const float inv = 127.0f / a;
#pragma unroll
                for (int j = 0; j < 4; ++j) { const int q0 = (int)rintf(v[q][j][0] * inv), q1 = (int)rintf(v[q][j][1] * inv), q2 = (int)rintf(v[q][j][2] * inv), q3 = (int)rintf(v[q][j][3] * inv);
                    w[j] = (unsigned)(q0 & 255) | ((unsigned)(q1 & 255) << 8) | ((unsigned)(q2 & 255) << 16) | ((unsigned)(q3 & 255) << 24); }
                *(v4u*)(F.ws + WS_U + (size_t)e * DM + 16 * lane) = (v4u){w[0], w[1], w[2], w[3]}; if (lane == 0) su[e] = a * (1.0f / 127.0f);
            } else { const float inv = 256.0f / a;
#pragma unroll
                for (int j = 0; j < 4; ++j) { int pk = __builtin_amdgcn_cvt_pk_fp8_f32(v[q][j][0] * inv, v[q][j][1] * inv, 0, false); pk = __builtin_amdgcn_cvt_pk_fp8_f32(v[q][j][2] * inv, v[q][j][3] * inv, pk, true); w[j] = (unsigned)pk; }
                *(v4u*)(F.ws + WS_V + (size_t)e * DM + 16 * lane) = (v4u){w[0], w[1], w[2], w[3]}; if (lane == 0) sv[e] = a * (1.0f / 256.0f); } } }
}
__device__ __forceinline__ void p1_win(Frame& F) {
    const float* mod = (const float*)(F.ws + WS_MOD);
    LAS float* sc = (LAS float*)F.lds; LAS float* sh = sc + 2048;
    for (int i = F.tid; i < 2048; i += NTHREADS) { const int b = i >> 10, k = i & 1023; sc[i] = 1.f + mod[b * 6144 + 1024 + k]; sh[i] = mod[b * 6144 + k]; }
    __syncthreads();
    const int lane = F.lane;
    if (F.vcu < 40) { const int b = F.vcu / 20, n = (F.vcu % 20) * 64 + lane; int nsrc = n; if (n < 640) { const int hd = n >> 6, w = n & 63; nsrc = hd * 64 + (w >> 1) + 32 * (w & 1); }
        float a = 0.f;
#pragma unroll 32
        for (int k = F.wave * 128; k < F.wave * 128 + 128; ++k) a += sh[b * 1024 + k] * F.w_in[(size_t)k * NIN + nsrc];
        LAS float* red = (LAS float*)(F.lds + 16384); red[F.wave * 64 + lane] = a;
        __syncthreads();
        if (F.tid < 64) { float sacc = 0.f;
#pragma unroll
            for (int w = 0; w < 8; ++w) sacc += red[w * 64 + F.tid];
            ((float*)(F.ws + WS_BIAS))[b * NIN + (F.vcu % 20) * 64 + F.tid] = sacc; } }
    LAS float* scr = (LAS float*)(F.lds + 32768 + F.wave * 8448);
    const int gw = F.vcu * NWAVES + F.wave, NGW = F.G * NWAVES;
    for (int it = gw; it < 2 * 640; it += NGW) { const int b = it / 640, r = it % 640;
        transpose_item<1>(F.w_in, NIN, (bf16*)(F.ws + WS_WIN) + (size_t)b * NIN * DM, DM, 64 * (r / 40), 32 * (r % 40), scr, lane, sc + b * 1024); }
    __syncthreads();
}
constexpr int KS_STRIDE = 144, VT_STRIDE = 520, KS_BYTES = 256 * KS_STRIDE, VT_BYTES = 64 * VT_STRIDE;
__device__ __forceinline__ void p3_attn_unit(Frame& F, int unit) {
    const int b = unit >> 7, kvh = (unit >> 6) & 1, n = unit & 63;
    const bf16* proj = (const bf16*)(F.ws + WS_PROJ); bf16* a2 = (bf16*)(F.ws + WS_A2);
    LAS unsigned char* Ks = F.lds; LAS unsigned char* Vt = F.lds + KS_BYTES;
    const int tid = F.tid, lane = F.lane, wave = F.wave, r32 = lane & 31, h = lane >> 5;
    const size_t tok0 = (size_t)b * SEQ + (size_t)n * 128;
#pragma unroll
    for (int i = 0; i < 4; ++i) { const int ci = tid + NTHREADS * i, row = ci >> 3, ch = ci & 7; const bool valid = (n > 0) || (row >= 128);
        const size_t tk = tok0 - 128 + row;
        v4u kv = (v4u){0u, 0u, 0u, 0u}, vv = (v4u){0u, 0u, 0u, 0u};
        if (valid) { kv = *(const v4u*)(proj + tk * NIN + 512 + kvh * 64 + ch * 8); vv = *(const v4u*)(proj + tk * NIN + 640 + kvh * 64 + ch * 8); }
        *(LAS v4u*)(Ks + row * KS_STRIDE + ch * 16) = kv;
        LAS bf16* vt = (LAS bf16*)(Vt + (ch * 8) * VT_STRIDE) + row;
        vt[0 * (VT_STRIDE / 2)] = (bf16)(vv.x & 0xffff); vt[1 * (VT_STRIDE / 2)] = (bf16)(vv.x >> 16); vt[2 * (VT_STRIDE / 2)] = (bf16)(vv.y & 0xffff); vt[3 * (VT_STRIDE / 2)] = (bf16)(vv.y >> 16);
        vt[4 * (VT_STRIDE / 2)] = (bf16)(vv.z & 0xffff); vt[5 * (VT_STRIDE / 2)] = (bf16)(vv.z >> 16); vt[6 * (VT_STRIDE / 2)] = (bf16)(vv.w & 0xffff); vt[7 * (VT_STRIDE / 2)] = (bf16)(vv.w >> 16); }
    __syncthreads();
    const int g = wave >> 1, hq = kvh * 4 + g; const float sink2 = F.sinks[hq] * LOG2E;
#pragma unroll 1
    for (int qt = 0; qt < 2; ++qt) {
        const int qi0 = (wave & 1) * 64 + qt * 32, t0 = qi0 >> 5; const size_t tokq = tok0 + qi0 + r32;
        bf16x8 qf[4];
#pragma unroll
        for (int s = 0; s < 4; ++s) qf[s] = *(const bf16x8*)(proj + tokq * NIN + hq * 64 + 16 * s + 8 * h);
        f32x16 sc[5];
#pragma unroll
        for (int kt = 0; kt < 5; ++kt) { sc[kt] = (f32x16){};
#pragma unroll
            for (int s = 0; s < 4; ++s) { const bf16x8 kf = *(const LAS bf16x8*)(Ks + (32 * (t0 + kt) + r32) * KS_STRIDE + (16 * s + 8 * h) * 2);
                sc[kt] = __builtin_amdgcn_mfma_f32_32x32x16_bf16(kf, qf[s], sc[kt], 0, 0, 0); } }
        const int qi = qi0 + r32; float m = sink2;
#pragma unroll
        for (int kt = 0; kt < 5; ++kt)
#pragma unroll
            for (int r = 0; r < 16; ++r) { const int sidx = 32 * (t0 + kt) + (r & 3) + 8 * (r >> 2) + 4 * h; const int rel = qi + 128 - sidx;
                const bool ok = (rel >= 0) && (rel < 128) && ((n > 0) || (sidx >= 128));
                const float v = ok ? sc[kt][r] : -INFINITY; sc[kt][r] = v; m = fmaxf(m, v); }
        m = fmaxf(m, __shfl_xor(m, 32));
        float l = 0.f;
#pragma unroll
        for (int kt = 0; kt < 5; ++kt)
#pragma unroll
            for (int r = 0; r < 16; ++r) { const float p = __builtin_amdgcn_exp2f(sc[kt][r] - m); sc[kt][r] = p; l += p; }
        l += __shfl_xor(l, 32); l += __builtin_amdgcn_exp2f(sink2 - m);
        f32x16 o[2]; o[0] = (f32x16){}; o[1] = (f32x16){};
#pragma unroll
        for (int kt = 0; kt < 5; ++kt)
#pragma unroll
            for (int s2 = 0; s2 < 2; ++s2) {
                u32x4 pw; pw.x = pg8::cvt_pk_bf16(sc[kt][8 * s2 + 0], sc[kt][8 * s2 + 1]); pw.y = pg8::cvt_pk_bf16(sc[kt][8 * s2 + 2], sc[kt][8 * s2 + 3]);
                pw.z = pg8::cvt_pk_bf16(sc[kt][8 * s2 + 4], sc[kt][8 * s2 + 5]); pw.w = pg8::cvt_pk_bf16(sc[kt][8 * s2 + 6], sc[kt][8 * s2 + 7]);
                const bf16x8 pf = __builtin_bit_cast(bf16x8, pw);
#pragma unroll
                for (int dt = 0; dt < 2; ++dt) { const LAS unsigned char* vp = Vt + (dt * 32 + r32) * VT_STRIDE + (32 * (t0 + kt) + 16 * s2 + 4 * h) * 2;
                    const u32x2 lo = *(const LAS u32x2*)vp, hi = *(const LAS u32x2*)(vp + 16);
                    const u32x4 vw = (u32x4){lo.x, lo.y, hi.x, hi.y};
                    o[dt] = __builtin_amdgcn_mfma_f32_32x32x16_bf16(__builtin_bit_cast(bf16x8, vw), pf, o[dt], 0, 0, 0); } }
        const float inv = 1.0f / l;
#pragma unroll
        for (int dt = 0; dt < 2; ++dt)
#pragma unroll
            for (int rg = 0; rg < 4; ++rg) { const int d0 = dt * 32 + 8 * rg + 4 * h;
                u32x2 w; w.x = pg8::cvt_pk_bf16(o[dt][4 * rg + 0] * inv, o[dt][4 * rg + 1] * inv); w.y = pg8::cvt_pk_bf16(o[dt][4 * rg + 2] * inv, o[dt][4 * rg + 3] * inv);
                *(u32x2*)(a2 + tokq * DM + hq * 64 + d0) = w; }
    }
    __syncthreads();
}
__device__ __forceinline__ void p3_pool_unit(Frame& F, int unit) {
    const bf16* proj = (const bf16*)(F.ws + WS_PROJ); bf16* a2 = (bf16*)(F.ws + WS_A2);
    const int cp = F.tid & 255, half = F.tid >> 8, gi = cp >> 6, w = 2 << gi;
    const int tstart = unit * 64 + half * 32, s0 = tstart & (SEQ - 1);
    const bf16* pc = proj + 768 + 2 * cp;
    float w0 = 0.f, w1 = 0.f;
    for (int j = 1; j <= w; ++j) if (s0 - j >= 0) { const unsigned u = *(const unsigned*)(pc + (size_t)(tstart - j) * NIN); w0 += bf_lo(u); w1 += bf_hi(u); }
    for (int i = 0; i < 32; ++i) { const int t = tstart + i, s = s0 + i;
        const unsigned u = *(const unsigned*)(pc + (size_t)t * NIN); const float p0 = bf_lo(u), p1 = bf_hi(u);
        w0 += p0; w1 += p1;
        if (s - w >= 0) { const unsigned uo = *(const unsigned*)(pc + (size_t)(t - w) * NIN); w0 -= bf_lo(uo); w1 -= bf_hi(uo); }
        const float rc = 1.0f / (float)((s + 1) < w ? (s + 1) : w);
        *(unsigned*)(a2 + (size_t)t * DM + 512 + 2 * cp) = pk2(w0 * rc - p0, w1 * rc - p1); }
}
__device__ __forceinline__ void p5_ln1(Frame& F) {
    const float* mod = (const float*)(F.ws + WS_MOD); const bf16* mix = (const bf16*)(F.ws + WS_MIX);
    bf16* x1 = (bf16*)(F.ws + WS_X1); bf16* h2 = (bf16*)(F.ws + WS_H2);
    const int gw = F.vcu * NWAVES + F.wave, lane = F.lane; const int rows_per_wave = TT / (F.G * NWAVES);
    const int row0 = gw * rows_per_wave, b = row0 >> 13;
    f32x4 g1[4], lg[4], lb[4], s2[4], h2s[4];
#pragma unroll
    for (int j = 0; j < 4; ++j) { const int d = 256 * j + 4 * lane;
        g1[j] = *(const f32x4*)(mod + b * 6144 + 2048 + d) + 1.0f; lg[j] = *(const f32x4*)(F.ln1_g + d); lb[j] = *(const f32x4*)(F.ln1_b + d);
        s2[j] = *(const f32x4*)(mod + b * 6144 + 4096 + d) + 1.0f; h2s[j] = *(const f32x4*)(mod + b * 6144 + 3072 + d); }
    for (int r = 0; r < rows_per_wave; ++r) { const size_t m = (size_t)(row0 + r);
        f32x4 v[4]; float s = 0.f;
#pragma unroll
        for (int j = 0; j < 4; ++j) { const int d = 256 * j + 4 * lane; const f32x4 xv = *(const f32x4*)(F.x + m * DM + d); const u32x2 mv = *(const u32x2*)(mix + m * DM + d);
            const f32x4 mf = (f32x4){bf_lo(mv.x), bf_hi(mv.x), bf_lo(mv.y), bf_hi(mv.y)};
            v[j] = xv * DN_ALPHA + g1[j] * mf; s += (v[j][0] + v[j][1]) + (v[j][2] + v[j][3]); }
        const float mean = wave_sum(s) * (1.f / DM); float q = 0.f;
#pragma unroll
        for (int j = 0; j < 4; ++j) { v[j] = v[j] - mean; q += (v[j][0] * v[j][0] + v[j][1] * v[j][1]) + (v[j][2] * v[j][2] + v[j][3] * v[j][3]); }
        const float rstd = 1.0f / sqrtf(wave_sum(q) * (1.f / DM) + LN_EPS);
#pragma unroll
        for (int j = 0; j < 4; ++j) { const int d = 256 * j + 4 * lane; const f32x4 y = v[j] * rstd * lg[j] + lb[j]; const f32x4 hh = y * s2[j] + h2s[j];
            u32x2 o; o.x = pk2(y[0], y[1]); o.y = pk2(y[2], y[3]); *(u32x2*)(x1 + m * DM + d) = o;
            u32x2 p; p.x = pk2(hh[0], hh[1]); p.y = pk2(hh[2], hh[3]); *(u32x2*)(h2 + m * DM + d) = p; } }
}
constexpr int KR_STRIDE = 272, KR_BYTES = 128 * KR_STRIDE;
#define INS16(a, v) do { _Pragma("unroll") for (int _i = 15; _i >= 1; --_i) a[_i] = __builtin_amdgcn_fmed3f(a[_i - 1], a[_i], (v)); a[0] = fmaxf(a[0], (v)); } while (0)
#define BITONIC16(a) do { _Pragma("unroll") for (int _st = 8; _st >= 1; _st >>= 1) { _Pragma("unroll") for (int _i = 0; _i < 16; ++_i) if ((_i & _st) == 0) { const float _x = a[_i], _y = a[_i + _st]; a[_i] = fmaxf(_x, _y); a[_i + _st] = fminf(_x, _y); } } } while (0)
__device__ __forceinline__ void p7_route(Frame& F) {
    const bf16* q = (const bf16*)(F.ws + WS_Q); unsigned short* pe = (unsigned short*)(F.ws + WS_PE); float* pg = (float*)(F.ws + WS_PG);
    const int tid = F.tid, lane = F.lane, wave = F.wave, r32 = lane & 31, h = lane >> 5;
    { const bf16* k1b = (const bf16*)(F.ws + WS_K1);
      for (int ci = tid; ci < 2 * 128 * 16; ci += NTHREADS) { const int side = ci >> 11, row = (ci >> 4) & 127, ch = ci & 15;
          *(LAS v4u*)(F.lds + side * KR_BYTES + row * KR_STRIDE + ch * 16) = *(const v4u*)(k1b + (size_t)side * 16384 + row * 128 + ch * 8); } }
    __syncthreads();
    LAS unsigned char* scr = F.lds + 2 * KR_BYTES + wave * 2048 + lane * 32;
    const int ntb = TT / 32;
    for (int tb = F.vcu; tb < ntb; tb += F.G) {
        const int head = wave; const size_t tok = (size_t)tb * 32 + r32;
        float vv[2][16];
#pragma unroll
        for (int side = 0; side < 2; ++side) {
            const bf16* qb = q + tok * NQD + head * 256 + side * 128;
            bf16x8 qf[8];
#pragma unroll
            for (int s = 0; s < 8; ++s) qf[s] = *(const bf16x8*)(qb + 16 * s + 8 * h);
            float a[16];
#pragma unroll
            for (int i = 0; i < 16; ++i) a[i] = -INFINITY;
#pragma unroll
            for (int kt = 0; kt < 4; ++kt) { f32x16 acc = (f32x16){};
#pragma unroll
                for (int s = 0; s < 8; ++s) { const bf16x8 kf = *(const LAS bf16x8*)(F.lds + side * KR_BYTES + (32 * kt + r32) * KR_STRIDE + (16 * s + 8 * h) * 2);
                    acc = __builtin_amdgcn_mfma_f32_32x32x16_bf16(kf, qf[s], acc, 0, 0, 0); }
#pragma unroll
                for (int r = 0; r < 16; ++r) { const unsigned key = (unsigned)(32 * kt + (r & 3) + 8 * (r >> 2)) | ((unsigned)h << 2);
                    const float v = __uint_as_float((__float_as_uint(acc[r]) & 0xFFFFFF80u) | key); INS16(a, v); }
                __builtin_amdgcn_sched_barrier(0); }
            float c[16];
#pragma unroll
            for (int i = 0; i < 16; ++i) c[i] = __shfl_xor(a[15 - i], 32);
#pragma unroll
            for (int i = 0; i < 16; ++i) c[i] = fmaxf(a[i], c[i]);
            BITONIC16(c);
#pragma unroll
            for (int i = 0; i < 16; ++i) vv[side][i] = c[i];
        }
        { v4u w1, w2;
#define PK4(L, b) ((__float_as_uint(L[b]) & 0x7Fu) | ((__float_as_uint(L[b + 1]) & 0x7Fu) << 8) | ((__float_as_uint(L[b + 2]) & 0x7Fu) << 16) | ((__float_as_uint(L[b + 3]) & 0x7Fu) << 24))
          w1.x = PK4(vv[0], 0); w1.y = PK4(vv[0], 4); w1.z = PK4(vv[0], 8); w1.w = PK4(vv[0], 12);
          w2.x = PK4(vv[1], 0); w2.y = PK4(vv[1], 4); w2.z = PK4(vv[1], 8); w2.w = PK4(vv[1], 12);
#undef PK4
          *(LAS v4u*)scr = w1; *(LAS v4u*)(scr + 16) = w2; }
        float c1[16], c2[16], top[16];
#pragma unroll
        for (int i = 0; i < 16; ++i) { c1[i] = __uint_as_float(__float_as_uint(vv[0][i]) & 0xFFFFFF80u); c2[i] = __uint_as_float(__float_as_uint(vv[1][i]) & 0xFFFFFF80u); top[i] = -INFINITY; }
#pragma unroll
        for (int ia = 0; ia < 16; ++ia)
#pragma unroll
            for (int ib = 0; ib < 16; ++ib) if ((ia + 1) * (ib + 1) <= 16) {
                const float sm = c1[ia] + c2[ib]; const float v = __uint_as_float((__float_as_uint(sm) & 0xFFFFFF00u) | (unsigned)(ia * 16 + ib)); INS16(top, v); }
        float ex[16], den = 0.f;
#pragma unroll
        for (int i = 0; i < 16; ++i) { ex[i] = __expf(top[i] - top[0]); den += ex[i]; }
        const float rden = 1.0f / den;
        LDS_WAIT();
        unsigned short ev[8]; float gv[8];
#pragma unroll
        for (int j = 0; j < 8; ++j) { const float t = h ? top[8 + j] : top[j]; const float e = h ? ex[8 + j] : ex[j];
            const unsigned code = __float_as_uint(t) & 0xFFu; const unsigned i1 = *(const LAS unsigned char*)(scr + (code >> 4)), i2 = *(const LAS unsigned char*)(scr + 16 + (code & 15u));
            ev[j] = (unsigned short)(i1 * 128u + i2); gv[j] = e * rden; }
        v4u ew; ew.x = ev[0] | ((unsigned)ev[1] << 16); ew.y = ev[2] | ((unsigned)ev[3] << 16); ew.z = ev[4] | ((unsigned)ev[5] << 16); ew.w = ev[6] | ((unsigned)ev[7] << 16);
        *(v4u*)(pe + tok * 128 + head * 16 + 8 * h) = ew;
        *(f32x4*)(pg + tok * 128 + head * 16 + 8 * h) = (f32x4){gv[0], gv[1], gv[2], gv[3]};
        *(f32x4*)(pg + tok * 128 + head * 16 + 8 * h + 4) = (f32x4){gv[4], gv[5], gv[6], gv[7]};
        LDS_WAIT();
    }
    __syncthreads();
}
__device__ __forceinline__ float gelu_erf(float x) { return 0.5f * x * (1.0f + erff(x * 0.70710678118654752f)); }
#ifndef NPART
#define NPART 16
#endif
constexpr int TPW = 4, NSWEEP = 2;
constexpr int PSHIFT = (NPART == 8) ? 11 : (NPART == 16) ? 10 : (NPART == 4) ? 12 : (NPART == 2) ? 13 : 14;
__device__ __forceinline__ void p8_peer(Frame& F) {
    const float* mod = (const float*)(F.ws + WS_MOD);
    const bf16* x1 = (const bf16*)(F.ws + WS_X1); const bf16* h2 = (const bf16*)(F.ws + WS_H2);
    const unsigned char* ut = F.ws + WS_U; const unsigned char* vt = F.ws + WS_V;
    const float* su = (const float*)(F.ws + WS_SU); const float* sv = (const float*)(F.ws + WS_SV);
    const unsigned* pe = (const unsigned*)(F.ws + WS_PE); const float* pg = (const float*)(F.ws + WS_PG);
    const int gw = F.vcu * NWAVES + F.wave, lane = F.lane;
    const int b5 = (lane >> 5) & 1, b4 = (lane >> 4) & 1, b3 = (lane >> 3) & 1, kmine = 4 * b5 + 2 * b4 + b3;
    LAS unsigned* scr = (LAS unsigned*)(F.lds + F.wave * 1024);
#pragma unroll 1
    for (int sweep = 0; sweep < NSWEEP; ++sweep) {
    const int t0 = (gw * NSWEEP + sweep) * TPW, b = t0 >> 13;
    unsigned hq[TPW][4]; float shs[TPW]; unsigned es[TPW]; float gs[TPW][2]; int offv[TPW];
#pragma unroll
    for (int tt = 0; tt < TPW; ++tt) { const size_t t = (size_t)(t0 + tt);
        float hv[16]; float am = 0.f;
#pragma unroll
        for (int j = 0; j < 4; ++j) { const u32x2 v = *(const u32x2*)(h2 + t * DM + 256 * j + 4 * lane); hv[4 * j] = bf_lo(v.x); hv[4 * j + 1] = bf_hi(v.x); hv[4 * j + 2] = bf_lo(v.y); hv[4 * j + 3] = bf_hi(v.y); }
#pragma unroll
        for (int i = 0; i < 16; ++i) am = fmaxf(am, fabsf(hv[i]));
#pragma unroll
        for (int o = 1; o < 64; o <<= 1) am = fmaxf(am, __shfl_xor(am, o));
        if (am == 0.f) am = 1.f;
        const float inv = 127.0f / am; shs[tt] = am * (1.0f / 127.0f);
#pragma unroll
        for (int j = 0; j < 4; ++j) { const int q0 = (int)rintf(hv[4 * j] * inv), q1 = (int)rintf(hv[4 * j + 1] * inv), q2 = (int)rintf(hv[4 * j + 2] * inv), q3 = (int)rintf(hv[4 * j + 3] * inv);
            hq[tt][j] = (unsigned)(q0 & 255) | ((unsigned)(q1 & 255) << 8) | ((unsigned)(q2 & 255) << 16) | ((unsigned)(q3 & 255) << 24); }
        const unsigned pe2 = pe[t * 64 + lane]; const f32x2 pg2 = *(const f32x2*)(pg + t * 128 + 2 * lane);
        const unsigned elo = pe2 & 0xffffu, ehi = pe2 >> 16; const int plo = (int)(elo >> PSHIFT), phi = (int)(ehi >> PSHIFT);
        int base = 0, poslo = 0, poshi = 0, ov = 0;
#pragma unroll
        for (int r = 0; r < NPART; ++r) { const unsigned long long mlo = __ballot(plo == r), mhi = __ballot(phi == r);
            const int clo = __popcll(mlo), chi = __popcll(mhi);
            const int rlo = (int)__builtin_amdgcn_mbcnt_hi((unsigned)(mlo >> 32), __builtin_amdgcn_mbcnt_lo((unsigned)mlo, 0u));
            const int rhi = (int)__builtin_amdgcn_mbcnt_hi((unsigned)(mhi >> 32), __builtin_amdgcn_mbcnt_lo((unsigned)mhi, 0u));
            if (plo == r) poslo = base + rlo; if (phi == r) poshi = base + clo + rhi;
            base += clo + chi; if (lane == r + 1) ov = base; }
        offv[tt] = ov;
        scr[2 * poslo] = elo; scr[2 * poslo + 1] = __float_as_uint(pg2.x); scr[2 * poshi] = ehi; scr[2 * poshi + 1] = __float_as_uint(pg2.y);
        LDS_WAIT();
        const u32x4 sr = *(const LAS u32x4*)(scr + 4 * lane);
        es[tt] = sr.x | (sr.z << 16); gs[tt][0] = __uint_as_float(sr.y); gs[tt][1] = __uint_as_float(sr.w);
        LDS_WAIT();
    }
    int cur[TPW];
#pragma unroll
    for (int tt = 0; tt < TPW; ++tt) cur[tt] = 0;
#pragma unroll 1
    for (int r = 0; r < NPART; ++r) {
#pragma unroll
        for (int tt = 0; tt < TPW; ++tt) {
            const int end = __builtin_amdgcn_readlane(offv[tt], r + 1);
            while (cur[tt] < end) {
                const int k4 = cur[tt] >> 1;
                u32x4 uq[8];
#pragma unroll
                for (int k2 = 0; k2 < 4; ++k2) { const unsigned ew = (unsigned)__builtin_amdgcn_readlane((int)es[tt], k4 + k2);
                    uq[2 * k2] = *(const u32x4*)(ut + (size_t)(ew & 0xffffu) * DM + 16 * lane); uq[2 * k2 + 1] = *(const u32x4*)(ut + (size_t)(ew >> 16) * DM + 16 * lane); }
                const int srcl = (k4 + 2 * b5 + b4) << 2;
                const unsigned ewm = (unsigned)__builtin_amdgcn_ds_bpermute(srcl, (int)es[tt]); const unsigned em = b3 ? (ewm >> 16) : (ewm & 0xffffu);
                const float sum = su[em], svm = sv[em];
                const float g0 = __int_as_float(__builtin_amdgcn_ds_bpermute(srcl, __float_as_int(gs[tt][0]))), g1 = __int_as_float(__builtin_amdgcn_ds_bpermute(srcl, __float_as_int(gs[tt][1])));
                const float gm = b3 ? g1 : g0;
                int p[8];
#pragma unroll
                for (int kk = 0; kk < 8; ++kk) { int s = __builtin_amdgcn_sdot4((int)uq[kk].x, (int)hq[tt][0], 0, false); s = __builtin_amdgcn_sdot4((int)uq[kk].y, (int)hq[tt][1], s, false);
                    s = __builtin_amdgcn_sdot4((int)uq[kk].z, (int)hq[tt][2], s, false); s = __builtin_amdgcn_sdot4((int)uq[kk].w, (int)hq[tt][3], s, false); p[kk] = s; }
                int q4[4], q2[2], q1;
#pragma unroll
                for (int i = 0; i < 4; ++i) { const int keep = b5 ? p[i + 4] : p[i], send = b5 ? p[i] : p[i + 4]; q4[i] = keep + __shfl_xor(send, 32); }
#pragma unroll
                for (int i = 0; i < 2; ++i) { const int keep = b4 ? q4[i + 2] : q4[i], send = b4 ? q4[i] : q4[i + 2]; q2[i] = keep + __shfl_xor(send, 16); }
                { const int keep = b3 ? q2[1] : q2[0], send = b3 ? q2[0] : q2[1]; q1 = keep + __shfl_xor(send, 8); }
                q1 += __shfl_xor(q1, 4); q1 += __shfl_xor(q1, 2); q1 += __shfl_xor(q1, 1);
                const float hid = (float)q1 * (shs[tt] * sum);
                const float am = gelu_erf(hid) * gm * svm;
                { const int i2 = (lane & 3) * 2; const float v0 = __int_as_float(__builtin_amdgcn_ds_bpermute(i2 << 5, __float_as_int(am))), v1 = __int_as_float(__builtin_amdgcn_ds_bpermute((i2 + 1) << 5, __float_as_int(am)));
                  if ((lane & ~3) == k4) { gs[tt][0] = v0; gs[tt][1] = v1; } }
                cur[tt] += 8;
            }
        }
    }
    float y[TPW][16];
#pragma unroll
    for (int tt = 0; tt < TPW; ++tt) { cur[tt] = 0;
#pragma unroll
        for (int i = 0; i < 16; ++i) y[tt][i] = 0.f; }
#pragma unroll 1
    for (int r = 0; r < NPART; ++r) {
#pragma unroll
        for (int tt = 0; tt < TPW; ++tt) {
            const int end = __builtin_amdgcn_readlane(offv[tt], r + 1);
            while (cur[tt] < end) {
                const int k4 = cur[tt] >> 1;
                u32x4 vq[8]; float av[8];
#pragma unroll
                for (int k2 = 0; k2 < 4; ++k2) { const unsigned ew = (unsigned)__builtin_amdgcn_readlane((int)es[tt], k4 + k2);
                    vq[2 * k2] = *(const u32x4*)(vt + (size_t)(ew & 0xffffu) * DM + 16 * lane); vq[2 * k2 + 1] = *(const u32x4*)(vt + (size_t)(ew >> 16) * DM + 16 * lane);
                    av[2 * k2] = __int_as_float(__builtin_amdgcn_readlane(__float_as_int(gs[tt][0]), k4 + k2)); av[2 * k2 + 1] = __int_as_float(__builtin_amdgcn_readlane(__float_as_int(gs[tt][1]), k4 + k2)); }
#pragma unroll
                for (int kk = 0; kk < 8; ++kk) { const float a = av[kk];
#define FP8ACC(word, j) { const unsigned _w = (word); const f32x2 _lo = __builtin_amdgcn_cvt_pk_f32_fp8((int)_w, false), _hi = __builtin_amdgcn_cvt_pk_f32_fp8((int)_w, true); \
                          y[tt][4 * (j)] += a * _lo.x; y[tt][4 * (j) + 1] += a * _lo.y; y[tt][4 * (j) + 2] += a * _hi.x; y[tt][4 * (j) + 3] += a * _hi.y; }
                    FP8ACC(vq[kk].x, 0) FP8ACC(vq[kk].y, 1) FP8ACC(vq[kk].z, 2) FP8ACC(vq[kk].w, 3)
#undef FP8ACC
                }
                cur[tt] += 8;
            }
        }
    }
#pragma unroll
    for (int tt = 0; tt < TPW; ++tt) { const size_t t = (size_t)(t0 + tt);
        f32x4 v[4]; float s = 0.f;
#pragma unroll
        for (int j = 0; j < 4; ++j) { const int d = 256 * j + 4 * lane; const u32x2 xv = *(const u32x2*)(x1 + t * DM + d); const f32x4 g2 = *(const f32x4*)(mod + b * 6144 + 5120 + d) + 1.0f;
            const f32x4 xf = (f32x4){bf_lo(xv.x), bf_hi(xv.x), bf_lo(xv.y), bf_hi(xv.y)}; const f32x4 yy = (f32x4){y[tt][4 * j], y[tt][4 * j + 1], y[tt][4 * j + 2], y[tt][4 * j + 3]};
            v[j] = xf * DN_ALPHA + g2 * yy; s += (v[j][0] + v[j][1]) + (v[j][2] + v[j][3]); }
        const float mean = wave_sum(s) * (1.f / DM); float qq = 0.f;
#pragma unroll
        for (int j = 0; j < 4; ++j) { v[j] = v[j] - mean; qq += (v[j][0] * v[j][0] + v[j][1] * v[j][1]) + (v[j][2] * v[j][2] + v[j][3] * v[j][3]); }
        const float rstd = 1.0f / sqrtf(wave_sum(qq) * (1.f / DM) + LN_EPS);
#pragma unroll
        for (int j = 0; j < 4; ++j) { const int d = 256 * j + 4 * lane; const f32x4 lg = *(const f32x4*)(F.ln2_g + d), lb = *(const f32x4*)(F.ln2_b + d);
            *(f32x4*)(F.out + t * DM + d) = v[j] * rstd * lg + lb; } }
    }
}
#ifndef MK_N_LAUNCHES
#define MK_N_LAUNCHES 1
#endif
constexpr int N_PHASES = 9;
struct Args { const float* in[18]; float* out; unsigned char* ws; int ph_lo, ph_hi; };
__global__ void __launch_bounds__(NTHREADS, 2) fwd_kernel(Args args) {
    extern __shared__ __attribute__((aligned(16))) unsigned char lds[];
    Frame F;
    F.lds = (LAS unsigned char*)lds;
    F.tid = threadIdx.x; F.lane = F.tid & 63; F.wave = __builtin_amdgcn_readfirstlane(F.tid >> 6);
    F.G = gridDim.x; { const int bx = blockIdx.x; F.vcu = (F.G % 8 == 0) ? (bx % 8) * (F.G / 8) + bx / 8 : bx; }
    F.x = args.in[0]; F.c = args.in[1]; F.w_ada = args.in[2]; F.b_ada = args.in[3]; F.w_in = args.in[4]; F.sinks = args.in[5]; F.w_pool = args.in[6]; F.pool_scale = args.in[7];
    F.w_out = args.in[8]; F.ln1_g = args.in[9]; F.ln1_b = args.in[10]; F.w_pq = args.in[11]; F.k1 = args.in[12]; F.k2 = args.in[13]; F.pu = args.in[14]; F.pv = args.in[15];
    F.ln2_g = args.in[16]; F.ln2_b = args.in[17]; F.out = args.out; F.ws = args.ws;
    volatile LAS unsigned* MISC = (volatile LAS unsigned*)(F.lds + MISC_OFF);
    for (int u = F.tid; u < (LDS_BYTES - LDSCTL_OFF) / 4; u += NTHREADS) ((LAS unsigned*)(F.lds + LDSCTL_OFF))[u] = 0u;
    __syncthreads();
    const int lo = args.ph_lo, hi = args.ph_hi;
    XcdBarrier bar; bar.bar = (unsigned*)(F.ws + WS_CTL) + CW_BAR; bar.x = 0; bar.st = nullptr;
    if (hi - lo > 1) bar = xcd_barrier_post((unsigned*)(F.ws + WS_CTL) + CW_BAR, MISC + 8);
#ifndef PH_MASK
#define PH_MASK 0x1ff
#endif
#define IN(k) (((PH_MASK >> (k)) & 1) && lo <= (k) && (k) < hi)
#define SEAM(k) do { if (IN(k) && IN((k) + 1)) xcd_barrier(bar); } while (0)
#ifndef REP_MASK
#define REP_MASK 0
#endif
#ifndef REP_CNT
#define REP_CNT 4
#endif
#define REPS(k) (((REP_MASK >> (k)) & 1) * REP_CNT)
#define PHASE(k, ...) if (IN(k)) { _Pragma("unroll 1") for (int _r = 0; _r <= REPS(k); ++_r) { __VA_ARGS__; if (_r < REPS(k)) xcd_barrier(bar); } } SEAM(k)
    PHASE(0, p0_prologue(F));
    PHASE(1, p1_win(F));
    PHASE(2, { pg8::Gemm g{(const pg8::bf16_t*)(F.ws + WS_XN), (const pg8::bf16_t*)(F.ws + WS_WIN), TT, NIN, DM, 32, (size_t)NIN * DM * 2}; pg8::StaticOrder S; S.init(TT, NIN, F.G, (int)blockIdx.x);
            pg8::EpiRope E{(pg8::bf16_t*)(F.ws + WS_PROJ), NIN, (const float*)(F.ws + WS_ROPE), QSCALE, (const float*)(F.ws + WS_BIAS)};
            pg8::gemm_phase<pg8::EpiRope, pg8::StaticOrder, true, true>(F.lds, g, S, E);
            if ((int)blockIdx.x >= 320 - F.G) p2_tables(F, ((int)blockIdx.x - (320 - F.G)) * NWAVES + F.wave, (2 * F.G - 320) * NWAVES); });
    PHASE(3, { for (int u = F.vcu; u < 256; u += F.G) p3_attn_unit(F, u);
               for (int u = F.vcu; u < 256; u += F.G) p3_pool_unit(F, u); });
    PHASE(4, { pg8::Gemm g{(const pg8::bf16_t*)(F.ws + WS_A2), (const pg8::bf16_t*)(F.ws + WS_WOUT), TT, DM, DM, 1 << 30, 0}; pg8::StaticOrder S; S.init(TT, DM, F.G, (int)blockIdx.x);
            pg8::EpiPlain E{(pg8::bf16_t*)(F.ws + WS_MIX), DM};
            pg8::gemm_phase<pg8::EpiPlain, pg8::StaticOrder, true, true>(F.lds, g, S, E); });
    PHASE(5, p5_ln1(F));
    PHASE(6, { pg8::Gemm g{(const pg8::bf16_t*)(F.ws + WS_H2), (const pg8::bf16_t*)(F.ws + WS_WPQ), TT, NQD, DM, 1 << 30, 0}; pg8::StaticOrder S; S.init(TT, NQD, F.G, (int)blockIdx.x);
            pg8::EpiPlain E{(pg8::bf16_t*)(F.ws + WS_Q), NQD};
            pg8::gemm_phase<pg8::EpiPlain, pg8::StaticOrder, true, true>(F.lds, g, S, E); });
    PHASE(7, p7_route(F));
    PHASE(8, p8_peer(F));
#undef IN
#undef SEAM
}

extern "C" void kernel_launch(void* const* d_in, const int* in_sizes, int n_in, void* d_out, int out_size, void* d_ws, size_t ws_size, hipStream_t stream) {
    static int grid = 0;
    if (grid == 0) {
        if (n_in != 18 || out_size != TT * DM || ws_size < WS_END) { fprintf(stderr, "kernel_launch: unexpected shapes (n_in %d out %d ws %zu)\n", n_in, out_size, ws_size); grid = -1; return; }
        int dev = 0, cus = 0, per_cu = 0;
        if (hipGetDevice(&dev) != hipSuccess || hipDeviceGetAttribute(&cus, hipDeviceAttributeMultiprocessorCount, dev) != hipSuccess) { grid = -1; return; }
        if (hipFuncSetAttribute((const void*)fwd_kernel, hipFuncAttributeMaxDynamicSharedMemorySize, LDS_BYTES) != hipSuccess) { fprintf(stderr, "kernel_launch: hipFuncSetAttribute failed\n"); grid = -1; return; }
        if (hipOccupancyMaxActiveBlocksPerMultiprocessor(&per_cu, (const void*)fwd_kernel, NTHREADS, LDS_BYTES) != hipSuccess || per_cu < 1) { fprintf(stderr, "kernel_launch: occupancy query says %d blocks per CU\n", per_cu); }
        (void)hipGetLastError();
        grid = cus;
        if (grid != 256) fprintf(stderr, "kernel_launch: built for 256 CUs, got %d\n", grid);
    }
    if (grid < 0) return;
    (void)hipMemsetAsync((char*)d_ws + WS_CTL, 0, CTL_ZERO_BYTES, stream);
    Args a{};
    for (int i = 0; i < 18; ++i) a.in[i] = (const float*)d_in[i];
    a.out = (float*)d_out; a.ws = (unsigned char*)d_ws;
#if MK_N_LAUNCHES == 1
    a.ph_lo = 0; a.ph_hi = N_PHASES;
    hipLaunchKernelGGL(fwd_kernel, dim3(grid), dim3(NTHREADS), LDS_BYTES, stream, a);
#else
    for (int p = 0; p < N_PHASES; ++p) { a.ph_lo = p; a.ph_hi = p + 1; hipLaunchKernelGGL(fwd_kernel, dim3(grid), dim3(NTHREADS), LDS_BYTES, stream, a); }
#endif
}
```

```cpp
#include <hip/hip_runtime.h>
#include <cstdio>
#include <cstdint>
#include <cmath>
namespace pg8 {
#define PG8_LAS __attribute__((address_space(3)))
typedef unsigned short bf16_t;
typedef short bf16x8 __attribute__((ext_vector_type(8)));
typedef float f32x4 __attribute__((ext_vector_type(4)));
typedef unsigned u32x4 __attribute__((ext_vector_type(4)));
constexpr int BM = 256, BK = 64, HALF = 128, HTB = HALF * BK * 2  , STAGE_BYTES = 8 * HTB, NXCD = 8, WGM = 8;

__host__ __device__ __forceinline__ int lds_byte(int r, int c) { const int st = (r >> 4) * 2 + (c >> 5), rr = r & 15, cc = c & 31, ob = rr * 64 + cc * 2; return st * 1024 + (ob ^ (((ob >> 9) & 1) << 5)); }
__host__ __device__ __forceinline__ void stage_rc(int b, int& R, int& C) { const int st = b / 1024, sb = b % 1024, swz = sb ^ (((sb >> 9) & 1) << 5); R = (st >> 1) * 16 + swz / 64; C = (st & 1) * 32 + (swz % 64) / 2; }
__host__ __device__ __forceinline__ int perm32(int rho) { const int n = rho >> 4, i = rho & 15; return 8 * (i >> 2) + 4 * n + (i & 3); }

struct Unit { int pm, pn; };
struct Gemm { const bf16_t* A; const bf16_t* Bt; int M, N, K; int bsplit; size_t bstride; };

struct StaticOrder {
    int nM, nN, nwg, G, c;
    __host__ __device__ void init(int M, int N, int G_, int c_) { nM = M / BM; nN = N / BM; nwg = nM * nN; G = G_; c = c_; }
    __host__ __device__ bool next(int i, Unit& u) const {
        const long L = (long)i * G + c; if (L >= nwg) return false;
        int wgid = (int)L; { const int q = nwg / NXCD, r = nwg % NXCD, xcd = wgid % NXCD, off = wgid / NXCD; wgid = (xcd < r ? xcd * (q + 1) : r * (q + 1) + (xcd - r) * q) + off; }
        const int nig = WGM * nN, gid = wgid / nig, fm = gid * WGM, gsz = (nM - fm) < WGM ? (nM - fm) : WGM;
        u.pm = fm + ((wgid % nig) % gsz); u.pn = (wgid % nig) / gsz; return true;
    }
    __device__ __forceinline__ void a_ready(const Unit&) const {}
    __device__ __forceinline__ void done(const Unit&) const {}
};

__device__ __forceinline__ unsigned cvt_pk_bf16(float lo, float hi) { unsigned r; asm volatile("v_cvt_pk_bf16_f32 %0, %1, %2" : "=v"(r) : "v"(lo), "v"(hi)); return r; }

struct EpiPlain {
    static constexpr bool PERM = true, AFTER_DRAIN = false;
    bf16_t* O; int ldc;
    __device__ __forceinline__ void operator()(const f32x4 (&acc)[2][2][4][2], const Unit& u, int wr, int wc, int fr, int fq) const {
        const int row0 = u.pm * BM + wr * 64 + fr; const int col0 = u.pn * BM + wc * 32 + 8 * fq;
#pragma unroll
        for (int ai = 0; ai < 2; ++ai)
#pragma unroll
            for (int m = 0; m < 4; ++m) { bf16_t* rowp = O + (size_t)(row0 + ai * HALF + m * 16) * ldc + col0;
#pragma unroll
                for (int bj = 0; bj < 2; ++bj) { const f32x4 v0 = acc[ai][bj][m][0], v1 = acc[ai][bj][m][1];
                    u32x4 w; w.x = cvt_pk_bf16(v0[0], v0[1]); w.y = cvt_pk_bf16(v0[2], v0[3]); w.z = cvt_pk_bf16(v1[0], v1[1]); w.w = cvt_pk_bf16(v1[2], v1[3]);
                    *(u32x4*)(rowp + bj * HALF) = w; } }
    }
};
struct EpiRope {
    static constexpr bool PERM = true, AFTER_DRAIN = false;
    bf16_t* O; int ldc; const float* rope; float qscale; const float* bias;
    __device__ __forceinline__ void operator()(const f32x4 (&acc)[2][2][4][2], const Unit& u, int wr, int wc, int fr, int fq) const {
        const int row0 = u.pm * BM + wr * 64 + fr; const int col0 = u.pn * BM + wc * 32 + 8 * fq;
#pragma unroll
        for (int ai = 0; ai < 2; ++ai)
#pragma unroll
            for (int m = 0; m < 4; ++m) { const int row = row0 + ai * HALF + m * 16; bf16_t* rowp = O + (size_t)row * ldc + col0; const int pos = row & 8191;
#pragma unroll
                for (int bj = 0; bj < 2; ++bj) { const float* bp = bias + (size_t)(row >> 13) * ldc + col0 + bj * HALF;
                    f32x4 v0 = acc[ai][bj][m][0] + *(const f32x4*)bp, v1 = acc[ai][bj][m][1] + *(const f32x4*)(bp + 4);
                    const int colt = u.pn * BM + bj * HALF;
                    if (colt < 640) {
                        const int c = col0 + bj * HALF, ib = (c & 63) >> 1;
                        const f32x4 cs0 = *(const f32x4*)(rope + ((size_t)pos * 32 + ib) * 2), cs1 = *(const f32x4*)(rope + ((size_t)pos * 32 + ib) * 2 + 4);
                        const float sc = colt < 512 ? qscale : 1.0f;
                        f32x4 r0, r1;
                        r0[0] = (v0[0] * cs0[0] - v0[1] * cs0[1]) * sc; r0[1] = (v0[1] * cs0[0] + v0[0] * cs0[1]) * sc;
                        r0[2] = (v0[2] * cs0[2] - v0[3] * cs0[3]) * sc; r0[3] = (v0[3] * cs0[2] + v0[2] * cs0[3]) * sc;
                        r1[0] = (v1[0] * cs1[0] - v1[1] * cs1[1]) * sc; r1[1] = (v1[1] * cs1[0] + v1[0] * cs1[1]) * sc;
                        r1[2] = (v1[2] * cs1[2] - v1[3] * cs1[3]) * sc; r1[3] = (v1[3] * cs1[2] + v1[2] * cs1[3]) * sc;
                        v0 = r0; v1 = r1;
                    }
                    u32x4 w; w.x = cvt_pk_bf16(v0[0], v0[1]); w.y = cvt_pk_bf16(v0[2], v0[3]); w.z = cvt_pk_bf16(v1[0], v1[1]); w.w = cvt_pk_bf16(v1[2], v1[3]);
                    *(u32x4*)(rowp + bj * HALF) = w; } }
    }
};

template <class Epi, class Sched, bool ALIGN_EPI = false, bool SP2 = false>
__device__ __forceinline__ void gemm_phase(PG8_LAS unsigned char* lds, const Gemm g, const Sched& S, const Epi& E) {
    const int tid = threadIdx.x, wid = __builtin_amdgcn_readfirstlane(tid >> 6), lane = tid & 63, wr = wid >> 2, wc = wid & 3, fr = lane & 15, fq = lane >> 4;
    const int K = g.K, nt = K / BK;
    unsigned voffA[2], voffB[2];
#pragma unroll
    for (int i = 0; i < 2; ++i) { int R, C; stage_rc(tid * 16 + i * 8192, R, C); const int Rb = Epi::PERM ? ((R & ~31) + perm32(R & 31)) : R;
        voffA[i] = (unsigned)(R * K + C) * 2u; voffB[i] = (unsigned)(Rb * K + C) * 2u; }
    const size_t kstep = (size_t)(BK * 2);
    const size_t hstep = (size_t)HALF * K * 2;
    const size_t tstep = 2 * hstep;
    const unsigned ldsw = (unsigned)wid * 1024u;
    const int aoff = lds_byte(wr * 64 + fr, fq * 8), boff = lds_byte(wc * 32 + fr, fq * 8);
#define PG8_SA(b, h) (((b) * 2 + (h)) * HTB)
#define PG8_SB(b, h) ((4 + (b) * 2 + (h)) * HTB)
#define PG8_STAGE(bufoff, gbase, voff) do { _Pragma("unroll") for (int _i = 0; _i < 2; ++_i) \
        __builtin_amdgcn_global_load_lds((const unsigned*)((const char*)(gbase) + (voff)[_i]), (PG8_LAS unsigned*)(lds + (bufoff) + ldsw + _i * 8192), 16, 0, 0); } while (0)
#define PG8_LDA(dst, b, h) do { _Pragma("unroll") for (int m = 0; m < 4; ++m) _Pragma("unroll") for (int k = 0; k < 2; ++k) dst[m][k] = *(const PG8_LAS bf16x8*)(lds + PG8_SA(b, h) + aoff + m * 2048 + k * 1024); } while (0)
#define PG8_LDB(dst, b, h) do { _Pragma("unroll") for (int n = 0; n < 2; ++n) _Pragma("unroll") for (int k = 0; k < 2; ++k) dst[n][k] = *(const PG8_LAS bf16x8*)(lds + PG8_SB(b, h) + boff + n * 2048 + k * 1024); } while (0)
#define PG8_MMA(ai, bj, At, Bt) do { __builtin_amdgcn_s_setprio(1); _Pragma("unroll") for (int m = 0; m < 4; ++m) _Pragma("unroll") for (int n = 0; n < 2; ++n) _Pragma("unroll") for (int k = 0; k < 2; ++k) \
        acc[ai][bj][m][n] = __builtin_amdgcn_mfma_f32_16x16x32_bf16(Bt[n][k], At[m][k], acc[ai][bj][m][n], 0, 0, 0); __builtin_amdgcn_s_setprio(0); } while (0)
#define PG8_WAIT_V(n) asm volatile("s_waitcnt vmcnt(" #n ")" ::: "memory")
#define PG8_WAIT_L(n) asm volatile("s_waitcnt lgkmcnt(" #n ")" ::: "memory")
#define PG8_BAR __builtin_amdgcn_s_barrier()
#define PG8_SCHED __builtin_amdgcn_sched_barrier(0)
    Unit cur, nxt; int ui = 0;
    if (!S.next(0, cur)) return;
    f32x4 acc[2][2][4][2];
#pragma unroll
    for (int a = 0; a < 2; ++a)
#pragma unroll
        for (int b = 0; b < 2; ++b)
#pragma unroll
            for (int m = 0; m < 4; ++m)
#pragma unroll
                for (int n = 0; n < 2; ++n) acc[a][b][m][n] = (f32x4){0.f, 0.f, 0.f, 0.f};
    bf16x8 At[4][2], B0[2][2], B1[2][2];
    const char* cA = (const char*)g.A + (size_t)cur.pm * tstep; const char* cB = (const char*)g.Bt + (size_t)cur.pn * tstep + (cur.pm >= g.bsplit ? g.bstride : (size_t)0);
    S.a_ready(cur);
    if constexpr (SP2) {
        PG8_STAGE(PG8_SB(0, 0), cB, voffB); PG8_STAGE(PG8_SB(0, 1), cB + hstep, voffB); PG8_STAGE(PG8_SA(0, 0), cA, voffA); PG8_STAGE(PG8_SA(0, 1), cA + hstep, voffA);
        if (wr == 1) PG8_BAR;
        PG8_WAIT_V(2); PG8_BAR;
        PG8_STAGE(PG8_SB(1, 0), cB + kstep, voffB); PG8_STAGE(PG8_SA(1, 0), cA + kstep, voffA); PG8_STAGE(PG8_SB(1, 1), cB + hstep + kstep, voffB);
        PG8_WAIT_V(6); PG8_BAR;
    } else {
        PG8_STAGE(PG8_SB(0, 0), cB, voffB); PG8_STAGE(PG8_SA(0, 0), cA, voffA); PG8_STAGE(PG8_SB(0, 1), cB + hstep, voffB); PG8_STAGE(PG8_SA(0, 1), cA + hstep, voffA);
        if (wr == 1) PG8_BAR;
        PG8_WAIT_V(4); PG8_BAR;
        PG8_STAGE(PG8_SB(1, 0), cB + kstep, voffB); PG8_STAGE(PG8_SA(1, 0), cA + kstep, voffA); PG8_STAGE(PG8_SB(1, 1), cB + hstep + kstep, voffB);
        PG8_WAIT_V(6); PG8_BAR;
    }
    for (;;) {
        const bool has_next = S.next(ui + 1, nxt);
        const char* nA = has_next ? (const char*)g.A + (size_t)nxt.pm * tstep : cA; const char* nB = has_next ? (const char*)g.Bt + (size_t)nxt.pn * tstep + (nxt.pm >= g.bsplit ? g.bstride : (size_t)0) : cB;
        for (int t = 0; t < nt; t += 2) {
            const bool last = (t == nt - 2);
            const char* a1 = cA + (size_t)(t + 1) * kstep;
            const char* a2 = last ? nA : cA + (size_t)(t + 2) * kstep; const char* b2 = last ? nB : cB + (size_t)(t + 2) * kstep;
            const char* a3 = a2 + kstep; const char* b3 = b2 + kstep;
            if (last && has_next) S.a_ready(nxt);
            if constexpr (SP2) {
            PG8_LDB(B0, 0, 0); PG8_LDB(B1, 0, 1); PG8_SCHED; PG8_LDA(At, 0, 0); PG8_STAGE(PG8_SA(1, 1), a1 + hstep, voffA);
            PG8_WAIT_V(8); PG8_WAIT_L(0); PG8_BAR; PG8_MMA(0, 0, At, B0); PG8_MMA(0, 1, At, B1); PG8_BAR; PG8_SCHED;
            PG8_LDA(At, 0, 1); PG8_STAGE(PG8_SB(0, 0), b2, voffB); PG8_STAGE(PG8_SB(0, 1), b2 + hstep, voffB); PG8_STAGE(PG8_SA(0, 0), a2, voffA);
            PG8_WAIT_V(8); PG8_WAIT_L(0); PG8_BAR; PG8_MMA(1, 0, At, B0); PG8_MMA(1, 1, At, B1); PG8_BAR; PG8_SCHED;
            PG8_LDB(B0, 1, 0); PG8_LDB(B1, 1, 1); PG8_SCHED; PG8_LDA(At, 1, 0); PG8_STAGE(PG8_SA(0, 1), a2 + hstep, voffA);
            PG8_WAIT_V(8); PG8_WAIT_L(0); PG8_BAR; PG8_MMA(0, 0, At, B0); PG8_MMA(0, 1, At, B1); PG8_BAR; PG8_SCHED;
            PG8_LDA(At, 1, 1); PG8_STAGE(PG8_SB(1, 0), b3, voffB); PG8_STAGE(PG8_SB(1, 1), b3 + hstep, voffB); PG8_STAGE(PG8_SA(1, 0), a3, voffA);
            PG8_WAIT_V(8); PG8_WAIT_L(0); PG8_BAR; PG8_MMA(1, 0, At, B0); PG8_MMA(1, 1, At, B1); PG8_BAR; PG8_SCHED;
            } else {
            PG8_LDB(B0, 0, 0); PG8_SCHED; PG8_LDA(At, 0, 0); PG8_STAGE(PG8_SA(1, 1), a1 + hstep, voffA);
            PG8_WAIT_L(8); PG8_BAR; PG8_WAIT_L(0); PG8_MMA(0, 0, At, B0); PG8_BAR; PG8_SCHED;
            PG8_LDB(B1, 0, 1); PG8_STAGE(PG8_SB(0, 0), b2, voffB);
            PG8_BAR; PG8_WAIT_L(0); PG8_MMA(0, 1, At, B1); PG8_BAR;
            PG8_LDA(At, 0, 1); PG8_STAGE(PG8_SA(0, 0), a2, voffA);
            PG8_BAR; PG8_WAIT_L(0); PG8_MMA(1, 0, At, B0); PG8_BAR; PG8_SCHED;
            PG8_STAGE(PG8_SB(0, 1), b2 + hstep, voffB);
            PG8_WAIT_V(6); PG8_BAR; PG8_MMA(1, 1, At, B1); PG8_BAR;
            PG8_LDB(B0, 1, 0); PG8_SCHED; PG8_LDA(At, 1, 0); PG8_STAGE(PG8_SA(0, 1), a2 + hstep, voffA);
            PG8_WAIT_L(8); PG8_BAR; PG8_WAIT_L(0); PG8_MMA(0, 0, At, B0); PG8_BAR; PG8_SCHED;
            PG8_LDB(B1, 1, 1); PG8_STAGE(PG8_SB(1, 0), b3, voffB);
            PG8_BAR; PG8_WAIT_L(0); PG8_MMA(0, 1, At, B1); PG8_BAR;
            PG8_LDA(At, 1, 1); PG8_STAGE(PG8_SA(1, 0), a3, voffA);
            PG8_BAR; PG8_WAIT_L(0); PG8_MMA(1, 0, At, B0); PG8_BAR; PG8_SCHED;
            PG8_STAGE(PG8_SB(1, 1), b3 + hstep, voffB);
            PG8_WAIT_V(6); PG8_BAR; PG8_MMA(1, 1, At, B1); PG8_BAR;
            }
        }
        if constexpr (ALIGN_EPI) { if (wr == 0) PG8_BAR; }
        if constexpr (!Epi::AFTER_DRAIN) { E(acc, cur, wr, wc, fr, fq); S.done(cur); }
        if (!has_next) break;
#pragma unroll
        for (int a = 0; a < 2; ++a)
#pragma unroll
            for (int b = 0; b < 2; ++b)
#pragma unroll
                for (int m = 0; m < 4; ++m)
#pragma unroll
                    for (int n = 0; n < 2; ++n) acc[a][b][m][n] = (f32x4){0.f, 0.f, 0.f, 0.f};
        cur = nxt; cA = nA; cB = nB; ++ui;
        if constexpr (ALIGN_EPI) { if (wr == 1) PG8_BAR; }
    }
    PG8_WAIT_V(0);
    if constexpr (!ALIGN_EPI) { if (wr == 0) PG8_BAR; }
    PG8_BAR;
    if constexpr (Epi::AFTER_DRAIN) { E.fused(acc, cur, wr, wc, fr, fq, lds, wid, lane); S.done(cur); }
#undef PG8_SA
#undef PG8_SB
#undef PG8_STAGE
#undef PG8_LDA
#undef PG8_LDB
#undef PG8_MMA
#undef PG8_WAIT_V
#undef PG8_WAIT_L
#undef PG8_BAR
#undef PG8_SCHED
}
}
#define GAS __attribute__((address_space(1)))
#define LAS __attribute__((address_space(3)))
typedef unsigned short bf16;
typedef unsigned v4u __attribute__((ext_vector_type(4)));
typedef float f32x4 __attribute__((ext_vector_type(4)));
typedef short bf16x8 __attribute__((ext_vector_type(8)));
typedef GAS unsigned gu32;
typedef GAS unsigned long long gu64;
#define RLX_AGENT __ATOMIC_RELAXED, __HIP_MEMORY_SCOPE_AGENT
#define LDS_WAIT() asm volatile("s_waitcnt lgkmcnt(0)" ::: "memory")
#define VM_WAIT() asm volatile("s_waitcnt vmcnt(0)" ::: "memory")
__device__ __forceinline__ unsigned long long rt() { return __builtin_amdgcn_s_memrealtime(); }
__device__ __forceinline__ unsigned f2bf(float f) { unsigned u = __builtin_bit_cast(unsigned, f); return (u + 0x7fffu + ((u >> 16) & 1u)) >> 16; }
__device__ __forceinline__ unsigned pk2(float lo, float hi) { return f2bf(lo) | (f2bf(hi) << 16); }
#define XB_TMO      128
#define XB_XCNT(j)  (256  + 64 * (j))
#define XB_XSUB(j)  (1280 + 64 * (j))
#define XB_XGEN(j)  (2304 + 64 * (j))
#define XB_TOP      3328
#define XB_TOPGEN   3392
#define XCD_BAR_WORDS 3456
#define XB_SPIN_CAP (1u << 18)

__device__ __forceinline__ unsigned xb_ld(unsigned* p)              { return __hip_atomic_load(p, __ATOMIC_RELAXED, __HIP_MEMORY_SCOPE_AGENT); }
__device__ __forceinline__ unsigned xb_add(unsigned* p, unsigned v) { return __hip_atomic_fetch_add(p, v, __ATOMIC_RELAXED, __HIP_MEMORY_SCOPE_AGENT); }
__device__ __forceinline__ unsigned xb_xcc_id() { return (unsigned)__builtin_amdgcn_s_getreg((3 << 11) | 20) & 0xFu; }
#define XB_SPIN(cond, bar) do { unsigned _sp = 0; while (cond) { __builtin_amdgcn_s_sleep(1); \
    if ((++_sp & 255u) == 0u) { if (xb_ld(&(bar)[XB_TMO])) break; if (_sp > XB_SPIN_CAP) { atomicAdd(&(bar)[XB_TMO], 1u); break; } } } } while (0)

struct XcdBarrier {
    unsigned* bar; unsigned x;
    volatile LAS unsigned* st;
};

__device__ __forceinline__ XcdBarrier xcd_barrier_post(unsigned* bar, volatile LAS unsigned* st) {
    XcdBarrier b; b.bar = bar; b.x = xb_xcc_id(); b.st = st;
    if (threadIdx.x == 0) (void)xb_add(&bar[XB_XCNT(b.x)], 1u);
    return b;
}
__device__ __forceinline__ void xcd_barrier_complete(unsigned* bar, unsigned x, unsigned& nloc, unsigned& nx) {
    const unsigned G = gridDim.x * gridDim.y * gridDim.z;
    unsigned sum, cnt, mine, sp = 0u;
    for (;;) {
        sum = 0u; cnt = 0u; mine = 0u;
#pragma unroll
        for (unsigned j = 0; j < 16; ++j) { const unsigned c = xb_ld(&bar[XB_XCNT(j)]); sum += c; cnt += (c > 0u) ? 1u : 0u; mine = (j == x) ? c : mine; }
        if (sum == G) break;
        __builtin_amdgcn_s_sleep(1);
        if ((++sp & 255u) == 0u) { if (xb_ld(&bar[XB_TMO])) break; if (sp > XB_SPIN_CAP) { atomicAdd(&bar[XB_TMO], 1u); break; } }
    }
    nloc = mine > 0u ? mine : 1u; nx = cnt > 0u ? cnt : 1u;
}

__device__ __forceinline__ void xcd_barrier(const XcdBarrier& b) {
    asm volatile("s_waitcnt vmcnt(0)" ::: "memory");
    __syncthreads();
    if (threadIdx.x == 0) {
        unsigned* bar = b.bar;
        __builtin_amdgcn_s_waitcnt(0);
        unsigned nloc = b.st[0], nx = b.st[1];
        if (nloc == 0u) { xcd_barrier_complete(bar, b.x, nloc, nx); b.st[0] = nloc; b.st[1] = nx; }
        const unsigned old = xb_add(&bar[XB_XSUB(b.x)], 1u);
        const unsigned gen = old / nloc;
        if (old + 1u == (gen + 1u) * nloc) {
            __builtin_amdgcn_fence(__ATOMIC_RELEASE, "agent");
            asm volatile("s_waitcnt vmcnt(0)" ::: "memory");
            const unsigned og = xb_add(&bar[XB_TOP], 1u);
            const unsigned tg = og / nx;
            if (og + 1u == (tg + 1u) * nx) xb_add(&bar[XB_TOPGEN], 1u);
            else XB_SPIN(xb_ld(&bar[XB_TOPGEN]) == tg, bar);
            __builtin_amdgcn_fence(__ATOMIC_ACQUIRE, "agent");
            xb_add(&bar[XB_XGEN(b.x)], 1u);
            asm volatile("s_waitcnt vmcnt(0)" ::: "memory");
        } else {
            XB_SPIN(xb_ld(&bar[XB_XGEN(b.x)]) == gen, bar);
            __builtin_amdgcn_fence(__ATOMIC_ACQUIRE, "agent");
            asm volatile("s_waitcnt vmcnt(0)" ::: "memory");
        }
    }
    __syncthreads();
}
constexpr int NWAVES = 8, NTHREADS = 512;
constexpr int TT = 16384, DM = 1024, SEQ = 8192, NIN = 1280, NQD = 2048, NEXP = 16384;
constexpr float DN_ALPHA = 1.189207115002721f;
constexpr float LN_EPS = 1e-5f;
constexpr float LOG2E = 1.4426950408889634f;
constexpr float QSCALE = 0.125f * LOG2E;

constexpr size_t MiB = 1u << 20;
constexpr size_t WS_CTL = 0, CTL_ZERO_BYTES = 64 * 1024;
constexpr size_t WS_MOD = 1 * MiB + 896 * 1024;
constexpr size_t WS_ROPE = 2 * MiB;
constexpr size_t WS_WIN = 248 * MiB;
constexpr size_t WS_BIAS = 4 * MiB;
constexpr size_t WS_K1 = 6 * MiB + 512 * 1024, WS_K2 = WS_K1 + 32 * 1024;
constexpr size_t WS_WOUT = 7 * MiB;
constexpr size_t WS_WPQ = 9 * MiB;
constexpr size_t WS_SU = 13 * MiB, WS_SV = 13 * MiB + 65536;
constexpr size_t WS_U = 16 * MiB, WS_V = 32 * MiB;
constexpr size_t WS_XN = 80 * MiB;
constexpr size_t WS_MIX = 80 * MiB;
constexpr size_t WS_PE = 80 * MiB, WS_PG = 84 * MiB;
constexpr size_t WS_PROJ = 112 * MiB;
constexpr size_t WS_A2 = 152 * MiB;
constexpr size_t WS_X1 = 184 * MiB, WS_H2 = 216 * MiB;
constexpr size_t WS_Q = 112 * MiB;
constexpr size_t WS_END = 253 * MiB;
constexpr int CW_BAR = 4096;

constexpr int RING_BYTES = 131072, LDSCTL_OFF = RING_BYTES, MISC_OFF = LDSCTL_OFF + 320, LDS_BYTES = 147456;

typedef float f32x16 __attribute__((ext_vector_type(16)));
typedef float f32x2 __attribute__((ext_vector_type(2)));
typedef unsigned u32x2 __attribute__((ext_vector_type(2)));
typedef unsigned u32x4 __attribute__((ext_vector_type(4)));
typedef __bf16 bf16x2_t __attribute__((ext_vector_type(2)));
struct Frame {
    LAS unsigned char* lds;
    int tid, lane, wave, vcu, G;
    const float *x, *c, *w_ada, *b_ada, *w_in, *sinks, *w_pool, *pool_scale, *w_out, *ln1_g, *ln1_b, *w_pq, *k1, *k2, *pu, *pv, *ln2_g, *ln2_b;
    float* out; unsigned char* ws;
};
__device__ __forceinline__ float wave_sum(float v) {
#pragma unroll
    for (int o = 1; o < 64; o <<= 1) v += __shfl_xor(v, o);
    return v;
}
__device__ __forceinline__ float bf_lo(unsigned u) { return __uint_as_float(u << 16); }
__device__ __forceinline__ float bf_hi(unsigned u) { return __uint_as_float(u & 0xffff0000u); }
__device__ __forceinline__ float bf2f(bf16 b) { return __uint_as_float((unsigned)b << 16); }

template <int MODE>
__device__ __forceinline__ void transpose_item(const float* W, int ldw, bf16* WT, int ldt, int k0, int n0, LAS float* scr, int lane, const LAS float* ksc = nullptr) {
    int nsrc = n0 + (lane & 31);
    if (MODE == 1 && nsrc < 640) { const int hd = nsrc >> 6, w = nsrc & 63; nsrc = hd * 64 + (w >> 1) + 32 * (w & 1); }
#pragma unroll 8
    for (int i = 0; i < 32; ++i) { const int kk = 2 * i + (lane >> 5); float wv = W[(size_t)(k0 + kk) * ldw + nsrc]; if (MODE == 1) wv *= ksc[k0 + kk]; scr[kk * 33 + (lane & 31)] = wv; }
    LDS_WAIT(); asm volatile("" ::: "memory");
    const int c = lane & 7;
#pragma unroll
    for (int j = 0; j < 4; ++j) { const int n = (lane >> 3) + 8 * j; const LAS float* s = scr + (8 * c) * 33 + n;
        v4u o; o.x = pk2(s[0 * 33], s[1 * 33]); o.y = pk2(s[2 * 33], s[3 * 33]); o.z = pk2(s[4 * 33], s[5 * 33]); o.w = pk2(s[6 * 33], s[7 * 33]);
        *(GAS v4u*)(WT + (size_t)(n0 + n) * ldt + k0 + 8 * c) = o; }
    LDS_WAIT(); asm volatile("" ::: "memory");
}
__device__ __forceinline__ void sincos_d(double a, float& s, float& c) {
    const double TWO_PI = 6.283185307179586476925, PI = 3.141592653589793238462643;
    double r = a - TWO_PI * rint(a / TWO_PI);
    double sg = 1.0;
    if (r > 0.5 * PI) { r = PI - r; sg = -1.0; } else if (r < -0.5 * PI) { r = -PI - r; sg = -1.0; }
    const double r2 = r * r;
    double sp = -1.0 / 121645100408832000.0;
    sp = sp * r2 + 1.0 / 355687428096000.0; sp = sp * r2 - 1.0 / 1307674368000.0; sp = sp * r2 + 1.0 / 6227020800.0; sp = sp * r2 - 1.0 / 39916800.0;
    sp = sp * r2 + 1.0 / 362880.0; sp = sp * r2 - 1.0 / 5040.0; sp = sp * r2 + 1.0 / 120.0; sp = sp * r2 - 1.0 / 6.0; sp = sp * r2 + 1.0;
    double cp = 1.0 / 6402373705728000.0;
    cp = cp * r2 - 1.0 / 20922789888000.0; cp = cp * r2 + 1.0 / 87178291200.0; cp = cp * r2 - 1.0 / 479001600.0; cp = cp * r2 + 1.0 / 3628800.0;
    cp = cp * r2 - 1.0 / 40320.0; cp = cp * r2 + 1.0 / 720.0; cp = cp * r2 - 1.0 / 24.0; cp = cp * r2 + 0.5; cp = 1.0 - cp * r2;
    s = (float)(sp * r); c = (float)(sg * cp);
}
__device__ __forceinline__ void p0_prologue(Frame& F, int parts = 0xff) {
    LAS float* scr = (LAS float*)(F.lds + F.wave * 16384);
    const int gw = F.vcu * NWAVES + F.wave, NGW = F.G * NWAVES, lane = F.lane;
    if ((parts & 1) && F.vcu < 96) { const int col = F.vcu * 64 + lane; float a0 = 0.f, a1 = 0.f;
        LAS float* sl = (LAS float*)(F.lds + F.wave * 16384 + 8448);
#pragma unroll
        for (int q = 0; q < 2; ++q) { const int k = F.wave * 128 + 64 * q + lane; const float c0 = F.c[k], c1 = F.c[DM + k];
            sl[64 * q + lane] = c0 / (1.f + __expf(-c0)); sl[128 + 64 * q + lane] = c1 / (1.f + __expf(-c1)); }
        LDS_WAIT(); asm volatile("" ::: "memory");
#pragma unroll 1
        for (int kb = 0; kb < 128; kb += 32) { float w[32];
#pragma unroll
            for (int u = 0; u < 32; ++u) w[u] = F.w_ada[(size_t)(F.wave * 128 + kb + u) * 6144 + col];
#pragma unroll
            for (int u = 0; u < 32; ++u) { a0 += sl[kb + u] * w[u]; a1 += sl[128 + kb + u] * w[u]; } }
        LAS float* red = (LAS float*)(F.lds + F.wave * 16384 + 12288); red[lane] = a0; red[64 + lane] = a1;
        __syncthreads();
        if (F.tid < 128) { const int bb = F.tid >> 6, l = F.tid & 63; float sacc = F.b_ada[F.vcu * 64 + l];
#pragma unroll
            for (int w = 0; w < 8; ++w) sacc += ((const LAS float*)(F.lds + w * 16384 + 12288))[bb * 64 + l];
            ((float*)(F.ws + WS_MOD))[bb * 6144 + F.vcu * 64 + l] = sacc; } }
    if (parts & 2) { float* rope = (float*)(F.ws + WS_ROPE);
      for (int e = gw * 64 + lane; e < SEQ * 32; e += NGW * 64) { const int pos = e >> 5, i = e & 31;
          const float freq = powf(10000.0f, -(float)i / 32.0f); const float ang = (float)pos * freq; float s, c; sincos_d((double)ang, s, c);
          rope[2 * e] = c; rope[2 * e + 1] = s; } }
    if (parts & 4) { constexpr int I_PQ = 16 * 64, I_OUT = 8 * 32;
      for (int it = gw; it < I_PQ + I_OUT; it += NGW) { int r = it;
          if (r < I_PQ) { transpose_item<0>(F.w_pq, NQD, (bf16*)(F.ws + WS_WPQ), DM, 64 * (r / 64), 32 * (r % 64), scr, lane); continue; } r -= I_PQ;
          transpose_item<0>(F.w_out, DM, (bf16*)(F.ws + WS_WOUT), DM, 64 * (r / 32), 32 * (r % 32), scr, lane); } }
    if (parts & 8) { bf16* wout_t = (bf16*)(F.ws + WS_WOUT);
      for (int it = gw; it < 4 * 2 * 128; it += NGW) { const int g = it >> 8, ch = (it >> 7) & 1, n0 = (it & 127) * 8, cidx = ch * 64 + lane;
          const float* wo = F.w_out + (size_t)(512 + g * 128) * DM + n0; const float* ps = F.pool_scale + g * 128;
#pragma unroll
          for (int i = 0; i < 4; ++i) { const int f4 = lane + 64 * i, e = f4 >> 1, hf = f4 & 1; const f32x4 o = *(const f32x4*)(wo + (size_t)e * DM + 4 * hf) * ps[e]; *(LAS f32x4*)(scr + e * 8 + 4 * hf) = o; }
          float acc[8];
#pragma unroll
          for (int i = 0; i < 8; ++i) acc[i] = 0.f;
          const float* wp = F.w_pool + ((size_t)(g * 128 + cidx)) * 128;
          LDS_WAIT(); asm volatile("" ::: "memory");
#pragma unroll 1
          for (int e0 = 0; e0 < 128; e0 += 32) { f32x4 wv[8];
#pragma unroll
              for (int q = 0; q < 8; ++q) wv[q] = *(const f32x4*)(wp + e0 + 4 * q);
#pragma unroll
              for (int q = 0; q < 8; ++q)
#pragma unroll
                  for (int ee = 0; ee < 4; ++ee) { const float w = wv[q][ee]; const f32x4 o0 = *(const LAS f32x4*)(scr + (e0 + 4 * q + ee) * 8), o1 = *(const LAS f32x4*)(scr + (e0 + 4 * q + ee) * 8 + 4);
                      acc[0] += w * o0[0]; acc[1] += w * o0[1]; acc[2] += w * o0[2]; acc[3] += w * o0[3]; acc[4] += w * o1[0]; acc[5] += w * o1[1]; acc[6] += w * o1[2]; acc[7] += w * o1[3]; } }
#pragma unroll
          for (int i = 0; i < 8; ++i) wout_t[(size_t)(n0 + i) * DM + 512 + g * 128 + cidx] = (bf16)f2bf(acc[i]);
          LDS_WAIT(); asm volatile("" ::: "memory"); } }
    if (parts & 16) { bf16* k1b = (bf16*)(F.ws + WS_K1); bf16* k2b = (bf16*)(F.ws + WS_K2);
      for (int e = gw * 64 + lane; e < 128 * 128; e += NGW * 64) { k1b[e] = (bf16)f2bf(F.k1[e]); k2b[e] = (bf16)f2bf(F.k2[e]); } }
    if (parts & 32) { bf16* xn = (bf16*)(F.ws + WS_XN); const int rpw = TT / NGW;
      for (int m = gw * rpw; m < gw * rpw + rpw; m += 2) { f32x4 v[2][4];
#pragma unroll
          for (int q = 0; q < 2; ++q)
#pragma unroll
              for (int j = 0; j < 4; ++j) v[q][j] = *(const f32x4*)(F.x + (size_t)(m + q) * DM + 256 * j + 4 * lane);
#pragma unroll
          for (int q = 0; q < 2; ++q)
#pragma unroll
              for (int j = 0; j < 4; ++j) { u32x2 o; o.x = pk2(v[q][j][0], v[q][j][1]); o.y = pk2(v[q][j][2], v[q][j][3]); *(u32x2*)(xn + (size_t)(m + q) * DM + 256 * j + 4 * lane) = o; } } }
}
__device__ __forceinline__ void p2_tables(Frame& F, int cw, int ncw) {
    const int lane = F.lane; float* su = (float*)(F.ws + WS_SU); float* sv = (float*)(F.ws + WS_SV);
    const int per = (2 * NEXP + ncw - 1) / ncw, r0 = cw * per, r1 = (r0 + per) < 2 * NEXP ? (r0 + per) : 2 * NEXP;
    for (int it0 = r0; it0 < r1; it0 += 4) {
        f32x4 v[4][4]; float am[4];
#pragma unroll
        for (int q = 0; q < 4; ++q) { const int it = (it0 + q < r1) ? it0 + q : r1 - 1; const int tb = it >= NEXP, e = it - tb * NEXP; const float* src = (tb ? F.pv : F.pu) + (size_t)e * DM;
#pragma unroll
            for (int j = 0; j < 4; ++j) v[q][j] = *(const f32x4*)(src + 256 * j + 4 * lane); }
#pragma unroll
        for (int q = 0; q < 4; ++q) { float a = 0.f;
#pragma unroll
            for (int j = 0; j < 4; ++j) a = fmaxf(a, fmaxf(fmaxf(fabsf(v[q][j][0]), fabsf(v[q][j][1])), fmaxf(fabsf(v[q][j][2]), fabsf(v[q][j][3])))); am[q] = a; }
#pragma unroll
        for (int o = 1; o < 64; o <<= 1) {
#pragma unroll
            for (int q = 0; q < 4; ++q) am[q] = fmaxf(am[q], __shfl_xor(am[q], o)); }
#pragma unroll
        for (int q = 0; q < 4; ++q) { const int it = (it0 + q < r1) ? it0 + q : r1 - 1; const int tb = it >= NEXP, e = it - tb * NEXP; float a = am[q]; if (a == 0.f) a = 1.f;
            unsigned w[4];
            if (!tb) { const float inv = 127.0f / a;
#pragma unroll
                for (int j = 0; j < 4; ++j) { const int q0 = (int)rintf(v[q][j][0] * inv), q1 = (int)rintf(v[q][j][1] * inv), q2 = (int)rintf(v[q][j][2] * inv), q3 = (int)rintf(v[q][j][3] * inv);
                    w[j] = (unsigned)(q0 & 255) | ((unsigned)(q1 & 255) << 8) | ((unsigned)(q2 & 255) << 16) | ((unsigned)(q3 & 255) << 24); }
                *(v4u*)(F.ws + WS_U + (size_t)e * DM + 16 * lane) = (v4u){w[0], w[1], w[2], w[3]}; if (lane == 0) su[e] = a * (1.0f / 127.0f);
            } else { const float inv = 256.0f / a;
#pragma unroll
                for (int j = 0; j < 4; ++j) { int pk = __builtin_amdgcn_cvt_pk_bf8_f32(v[q][j][0] * inv, v[q][j][1] * inv, 0, false); pk = __builtin_amdgcn_cvt_pk_bf8_f32(v[q][j][2] * inv, v[q][j][3] * inv, pk, true); w[j] = (unsigned)pk; }
                *(v4u*)(F.ws + WS_V + (size_t)e * DM + 16 * lane) = (v4u){w[0], w[1], w[2], w[3]}; if (lane == 0) sv[e] = a * (1.0f / 256.0f); } } }
}
__device__ __forceinline__ void p1_win(Frame& F) {
    const float* mod = (const float*)(F.ws + WS_MOD);
    LAS float* sc = (LAS float*)F.lds; LAS float* sh = sc + 2048;
    for (int i = F.tid; i < 2048; i += NTHREADS) { const int b = i >> 10, k = i & 1023; sc[i] = 1.f + mod[b * 6144 + 1024 + k]; sh[i] = mod[b * 6144 + k]; }
    __syncthreads();
    const int lane = F.lane;
    if (F.vcu < 40) { const int b = F.vcu / 20, n = (F.vcu % 20) * 64 + lane; int nsrc = n; if (n < 640) { const int hd = n >> 6, w = n & 63; nsrc = hd * 64 + (w >> 1) + 32 * (w & 1); }
        float a = 0.f;
#pragma unroll 32
        for (int k = F.wave * 128; k < F.wave * 128 + 128; ++k) a += sh[b * 1024 + k] * F.w_in[(size_t)k * NIN + nsrc];
        LAS float* red = (LAS float*)(F.lds + 16384); red[F.wave * 64 + lane] = a;
        __syncthreads();
        if (F.tid < 64) { float sacc = 0.f;
#pragma unroll
            for (int w = 0; w < 8; ++w) sacc += red[w * 64 + F.tid];
            ((float*)(F.ws + WS_BIAS))[b * NIN + (F.vcu % 20) * 64 + F.tid] = sacc; } }
    LAS float* scr = (LAS float*)(F.lds + 32768 + F.wave * 8448);
    const int gw = F.vcu * NWAVES + F.wave, NGW = F.G * NWAVES;
    for (int it = gw; it < 2 * 640; it += NGW) { const int b = it / 640, r = it % 640;
        transpose_item<1>(F.w_in, NIN, (bf16*)(F.ws + WS_WIN) + (size_t)b * NIN * DM, DM, 64 * (r / 40), 32 * (r % 40), scr, lane, sc + b * 1024); }
    __syncthreads();
}
constexpr int KS_STRIDE = 144, VT_STRIDE = 520, KS_BYTES = 256 * KS_STRIDE, VT_BYTES = 64 * VT_STRIDE;
__device__ __forceinline__ void p3_attn_unit(Frame& F, int unit) {
    const int b = unit >> 7, kvh = (unit >> 6) & 1, n = unit & 63;
    const bf16* proj = (const bf16*)(F.ws + WS_PROJ); bf16* a2 = (bf16*)(F.ws + WS_A2);
    LAS unsigned char* Ks = F.lds; LAS unsigned char* Vt = F.lds + KS_BYTES;
    const int tid = F.tid, lane = F.lane, wave = F.wave, r32 = lane & 31, h = lane >> 5;
    const size_t tok0 = (size_t)b * SEQ + (size_t)n * 128;
#pragma unroll
    for (int i = 0; i < 4; ++i) { const int ci = tid + NTHREADS * i, row = ci >> 3, ch = ci & 7; const bool valid = (n > 0) || (row >= 128);
        const size_t tk = tok0 - 128 + row;
        v4u kv = (v4u){0u, 0u, 0u, 0u}, vv = (v4u){0u, 0u, 0u, 0u};
        if (valid) { kv = *(const v4u*)(proj + tk * NIN + 512 + kvh * 64 + ch * 8); vv = *(const v4u*)(proj + tk * NIN + 640 + kvh * 64 + ch * 8); }
        *(LAS v4u*)(Ks + row * KS_STRIDE + ch * 16) = kv;
        LAS bf16* vt = (LAS bf16*)(Vt + (ch * 8) * VT_STRIDE) + row;
        vt[0 * (VT_STRIDE / 2)] = (bf16)(vv.x & 0xffff); vt[1 * (VT_STRIDE / 2)] = (bf16)(vv.x >> 16); vt[2 * (VT_STRIDE / 2)] = (bf16)(vv.y & 0xffff); vt[3 * (VT_STRIDE / 2)] = (bf16)(vv.y >> 16);
        vt[4 * (VT_STRIDE / 2)] = (bf16)(vv.z & 0xffff); vt[5 * (VT_STRIDE / 2)] = (bf16)(vv.z >> 16); vt[6 * (VT_STRIDE / 2)] = (bf16)(vv.w & 0xffff); vt[7 * (VT_STRIDE / 2)] = (bf16)(vv.w >> 16); }
    __syncthreads();
    const int g = wave >> 1, hq = kvh * 4 + g; const float sink2 = F.sinks[hq] * LOG2E;
#pragma unroll 1
    for (int qt = 0; qt < 2; ++qt) {
        const int qi0 = (wave & 1) * 64 + qt * 32, t0 = qi0 >> 5; const size_t tokq = tok0 + qi0 + r32;
        bf16x8 qf[4];
#pragma unroll
        for (int s = 0; s < 4; ++s) qf[s] = *(const bf16x8*)(proj + tokq * NIN + hq * 64 + 16 * s + 8 * h);
        f32x16 sc[5];
#pragma unroll
        for (int kt = 0; kt < 5; ++kt) { sc[kt] = (f32x16){};
#pragma unroll
            for (int s = 0; s < 4; ++s) { const bf16x8 kf = *(const LAS bf16x8*)(Ks + (32 * (t0 + kt) + r32) * KS_STRIDE + (16 * s + 8 * h) * 2);
                sc[kt] = __builtin_amdgcn_mfma_f32_32x32x16_bf16(kf, qf[s], sc[kt], 0, 0, 0); } }
        const int qi = qi0 + r32; float m = sink2;
#pragma unroll
        for (int kt = 0; kt < 5; ++kt)
#pragma unroll
            for (int r = 0; r < 16; ++r) { const int sidx = 32 * (t0 + kt) + (r & 3) + 8 * (r >> 2) + 4 * h; const int rel = qi + 128 - sidx;
                const bool ok = (rel >= 0) && (rel < 128) && ((n > 0) || (sidx >= 128));
                const float v = ok ? sc[kt][r] : -INFINITY; sc[kt][r] = v; m = fmaxf(m, v); }
        m = fmaxf(m, __shfl_xor(m, 32));
        float l = 0.f;
#pragma unroll
        for (int kt = 0; kt < 5; ++kt)
#pragma unroll
            for (int r = 0; r < 16; ++r) { const float p = __builtin_amdgcn_exp2f(sc[kt][r] - m); sc[kt][r] = p; l += p; }
        l += __shfl_xor(l, 32); l += __builtin_amdgcn_exp2f(sink2 - m);
        f32x16 o[2]; o[0] = (f32x16){}; o[1] = (f32x16){};
#pragma unroll
        for (int kt = 0; kt < 5; ++kt)
#pragma unroll
            for (int s2 = 0; s2 < 2; ++s2) {
                u32x4 pw; pw.x = pg8::cvt_pk_bf16(sc[kt][8 * s2 + 0], sc[kt][8 * s2 + 1]); pw.y = pg8::cvt_pk_bf16(sc[kt][8 * s2 + 2], sc[kt][8 * s2 + 3]);
                pw.z = pg8::cvt_pk_bf16(sc[kt][8 * s2 + 4], sc[kt][8 * s2 + 5]); pw.w = pg8::cvt_pk_bf16(sc[kt][8 * s2 + 6], sc[kt][8 * s2 + 7]);
                const bf16x8 pf = __builtin_bit_cast(bf16x8, pw);
#pragma unroll
                for (int dt = 0; dt < 2; ++dt) { const LAS unsigned char* vp = Vt + (dt * 32 + r32) * VT_STRIDE + (32 * (t0 + kt) + 16 * s2 + 4 * h) * 2;
                    const u32x2 lo = *(const LAS u32x2*)vp, hi = *(const LAS u32x2*)(vp + 16);
                    const u32x4 vw = (u32x4){lo.x, lo.y, hi.x, hi.y};
                    o[dt] = __builtin_amdgcn_mfma_f32_32x32x16_bf16(__builtin_bit_cast(bf16x8, vw), pf, o[dt], 0, 0, 0); } }
        const float inv = 1.0f / l;
#pragma unroll
        for (int dt = 0; dt < 2; ++dt)
#pragma unroll
            for (int rg = 0; rg < 4; ++rg) { const int d0 = dt * 32 + 8 * rg + 4 * h;
                u32x2 w; w.x = pg8::cvt_pk_bf16(o[dt][4 * rg + 0] * inv, o[dt][4 * rg + 1] * inv); w.y = pg8::cvt_pk_bf16(o[dt][4 * rg + 2] * inv, o[dt][4 * rg + 3] * inv);
                *(u32x2*)(a2 + tokq * DM + hq * 64 + d0) = w; }
    }
    __syncthreads();
}
__device__ __forceinline__ void p3_pool_unit(Frame& F, int unit) {
    const bf16* proj = (const bf16*)(F.ws + WS_PROJ); bf16* a2 = (bf16*)(F.ws + WS_A2);
    const int cp = F.tid & 255, half = F.tid >> 8, gi = cp >> 6, w = 2 << gi;
    const int tstart = unit * 64 + half * 32, s0 = tstart & (SEQ - 1);
    const bf16* pc = proj + 768 + 2 * cp;
    unsigned u[48];
#pragma unroll
    for (int i = 0; i < 48; ++i) { const int s = s0 - 16 + i; u[i] = (s >= 0) ? *(const unsigned*)(pc + (size_t)(tstart - 16 + i) * NIN) : 0u; }
    float w0 = 0.f, w1 = 0.f;
#pragma unroll
    for (int j = 1; j <= 16; ++j) if (j <= w) { w0 += bf_lo(u[16 - j]); w1 += bf_hi(u[16 - j]); }
#pragma unroll
    for (int i = 0; i < 32; ++i) { const int s = s0 + i; const float p0 = bf_lo(u[16 + i]), p1 = bf_hi(u[16 + i]);
        const unsigned uo = (w == 2) ? u[14 + i] : (w == 4) ? u[12 + i] : (w == 8) ? u[8 + i] : u[i];
        w0 += p0 - bf_lo(uo); w1 += p1 - bf_hi(uo);
        const float rc = 1.0f / (float)((s + 1) < w ? (s + 1) : w);
        *(unsigned*)(a2 + (size_t)(tstart + i) * DM + 512 + 2 * cp) = pk2(w0 * rc - p0, w1 * rc - p1); }
}
__device__ __forceinline__ void p5_ln1(Frame& F) {
    const float* mod = (const float*)(F.ws + WS_MOD); const bf16* mix = (const bf16*)(F.ws + WS_MIX);
    bf16* x1 = (bf16*)(F.ws + WS_X1); bf16* h2 = (bf16*)(F.ws + WS_H2);
    const int gw = F.vcu * NWAVES + F.wave, lane = F.lane; const int rows_per_wave = TT / (F.G * NWAVES);
    const int row0 = gw * rows_per_wave, b = row0 >> 13;
    f32x4 g1[4], lg[4], lb[4], s2[4], h2s[4];
#pragma unroll
    for (int j = 0; j < 4; ++j) { const int d = 256 * j + 4 * lane;
        g1[j] = *(const f32x4*)(mod + b * 6144 + 2048 + d) + 1.0f; lg[j] = *(const f32x4*)(F.ln1_g + d); lb[j] = *(const f32x4*)(F.ln1_b + d);
        s2[j] = *(const f32x4*)(mod + b * 6144 + 4096 + d) + 1.0f; h2s[j] = *(const f32x4*)(mod + b * 6144 + 3072 + d); }
    for (int r = 0; r < rows_per_wave; r += 2) {
        f32x4 xv[2][4]; u32x2 mv[2][4];
#pragma unroll
        for (int q = 0; q < 2; ++q)
#pragma unroll
            for (int j = 0; j < 4; ++j) { const size_t m = (size_t)(row0 + r + q); const int d = 256 * j + 4 * lane; xv[q][j] = *(const f32x4*)(F.x + m * DM + d); mv[q][j] = *(const u32x2*)(mix + m * DM + d); }
#pragma unroll
        for (int q = 0; q < 2; ++q) { const size_t m = (size_t)(row0 + r + q);
        f32x4 v[4]; float s = 0.f;
#pragma unroll
        for (int j = 0; j < 4; ++j) {
            const f32x4 mf = (f32x4){bf_lo(mv[q][j].x), bf_hi(mv[q][j].x), bf_lo(mv[q][j].y), bf_hi(mv[q][j].y)};
            v[j] = xv[q][j] * DN_ALPHA + g1[j] * mf; s += (v[j][0] + v[j][1]) + (v[j][2] + v[j][3]); }
        const float mean = wave_sum(s) * (1.f / DM); float qq = 0.f;
#pragma unroll
        for (int j = 0; j < 4; ++j) { v[j] = v[j] - mean; qq += (v[j][0] * v[j][0] + v[j][1] * v[j][1]) + (v[j][2] * v[j][2] + v[j][3] * v[j][3]); }
        const float rstd = 1.0f / sqrtf(wave_sum(qq) * (1.f / DM) + LN_EPS);
#pragma unroll
        for (int j = 0; j < 4; ++j) { const int d = 256 * j + 4 * lane; const f32x4 y = v[j] * rstd * lg[j] + lb[j]; const f32x4 hh = y * s2[j] + h2s[j];
            u32x2 o; o.x = pk2(y[0], y[1]); o.y = pk2(y[2], y[3]); *(u32x2*)(x1 + m * DM + d) = o;
            u32x2 p; p.x = pk2(hh[0], hh[1]); p.y = pk2(hh[2], hh[3]); *(u32x2*)(h2 + m * DM + d) = p; } } }
}
constexpr int KR_STRIDE = 272, KR_BYTES = 128 * KR_STRIDE;
#define INS16(a, v) do { _Pragma("unroll") for (int _i = 15; _i >= 1; --_i) a[_i] = __builtin_amdgcn_fmed3f(a[_i - 1], a[_i], (v)); a[0] = fmaxf(a[0], (v)); } while (0)
#define BITONIC16(a) do { _Pragma("unroll") for (int _st = 8; _st >= 1; _st >>= 1) { _Pragma("unroll") for (int _i = 0; _i < 16; ++_i) if ((_i & _st) == 0) { const float _x = a[_i], _y = a[_i + _st]; a[_i] = fmaxf(_x, _y); a[_i + _st] = fminf(_x, _y); } } } while (0)
__device__ __forceinline__ void p7_route(Frame& F) {
    const bf16* q = (const bf16*)(F.ws + WS_Q); unsigned short* pe = (unsigned short*)(F.ws + WS_PE); float* pg = (float*)(F.ws + WS_PG);
    const int tid = F.tid, lane = F.lane, wave = F.wave, r32 = lane & 31, h = lane >> 5;
    { const bf16* k1b = (const bf16*)(F.ws + WS_K1);
      for (int ci = tid; ci < 2 * 128 * 16; ci += NTHREADS) { const int side = ci >> 11, row = (ci >> 4) & 127, ch = ci & 15;
          *(LAS v4u*)(F.lds + side * KR_BYTES + row * KR_STRIDE + ch * 16) = *(const v4u*)(k1b + (size_t)side * 16384 + row * 128 + ch * 8); } }
    __syncthreads();
    LAS unsigned char* scr = F.lds + 2 * KR_BYTES + wave * 2048 + lane * 32;
    const int ntb = TT / 32;
    for (int tb = F.vcu; tb < ntb; tb += F.G) {
        const int head = wave; const size_t tok = (size_t)tb * 32 + r32;
        float vv[2][16];
#pragma unroll
        for (int side = 0; side < 2; ++side) {
            const bf16* qb = q + tok * NQD + head * 256 + side * 128;
            bf16x8 qf[8];
#pragma unroll
            for (int s = 0; s < 8; ++s) qf[s] = *(const bf16x8*)(qb + 16 * s + 8 * h);
            float a[16];
#pragma unroll
            for (int i = 0; i < 16; ++i) a[i] = -INFINITY;
#pragma unroll
            for (int kt = 0; kt < 4; ++kt) { f32x16 acc = (f32x16){};
#pragma unroll
                for (int s = 0; s < 8; ++s) { const bf16x8 kf = *(const LAS bf16x8*)(F.lds + side * KR_BYTES + (32 * kt + r32) * KR_STRIDE + (16 * s + 8 * h) * 2);
                    acc = __builtin_amdgcn_mfma_f32_32x32x16_bf16(kf, qf[s], acc, 0, 0, 0); }
#pragma unroll
                for (int r = 0; r < 16; ++r) { const unsigned key = (unsigned)(32 * kt + (r & 3) + 8 * (r >> 2)) | ((unsigned)h << 2);
                    const float v = __uint_as_float((__float_as_uint(acc[r]) & 0xFFFFFF80u) | key); INS16(a, v); }
                __builtin_amdgcn_sched_barrier(0); }
            float c[16];
#pragma unroll
            for (int i = 0; i < 16; ++i) c[i] = __shfl_xor(a[15 - i], 32);
#pragma unroll
            for (int i = 0; i < 16; ++i) c[i] = fmaxf(a[i], c[i]);
            BITONIC16(c);
#pragma unroll
            for (int i = 0; i < 16; ++i) vv[side][i] = c[i];
        }
        { v4u w1, w2;
#define PK4(L, b) ((__float_as_uint(L[b]) & 0x7Fu) | ((__float_as_uint(L[b + 1]) & 0x7Fu) << 8) | ((__float_as_uint(L[b + 2]) & 0x7Fu) << 16) | ((__float_as_uint(L[b + 3]) & 0x7Fu) << 24))
          w1.x = PK4(vv[0], 0); w1.y = PK4(vv[0], 4); w1.z = PK4(vv[0], 8); w1.w = PK4(vv[0], 12);
          w2.x = PK4(vv[1], 0); w2.y = PK4(vv[1], 4); w2.z = PK4(vv[1], 8); w2.w = PK4(vv[1], 12);
#undef PK4
          *(LAS v4u*)scr = w1; *(LAS v4u*)(scr + 16) = w2; }
        float c1[16], c2[16], top[16];
#pragma unroll
        for (int i = 0; i < 16; ++i) { c1[i] = __uint_as_float(__float_as_uint(vv[0][i]) & 0xFFFFFF80u); c2[i] = __uint_as_float(__float_as_uint(vv[1][i]) & 0xFFFFFF80u); top[i] = -INFINITY; }
#pragma unroll
        for (int ia = 0; ia < 16; ++ia)
#pragma unroll
            for (int ib = 0; ib < 16; ++ib) if ((ia + 1) * (ib + 1) <= 16) {
                const float sm = c1[ia] + c2[ib]; const float v = __uint_as_float((__float_as_uint(sm) & 0xFFFFFF00u) | (unsigned)(ia * 16 + ib)); INS16(top, v); }
        float ex[16], den = 0.f;
#pragma unroll
        for (int i = 0; i < 16; ++i) { ex[i] = __expf(top[i] - top[0]); den += ex[i]; }
        const float rden = 1.0f / den;
        LDS_WAIT();
        unsigned short ev[8]; float gv[8];
#pragma unroll
        for (int j = 0; j < 8; ++j) { const float t = h ? top[8 + j] : top[j]; const float e = h ? ex[8 + j] : ex[j];
            const unsigned code = __float_as_uint(t) & 0xFFu; const unsigned i1 = *(const LAS unsigned char*)(scr + (code >> 4)), i2 = *(const LAS unsigned char*)(scr + 16 + (code & 15u));
            ev[j] = (unsigned short)(i1 * 128u + i2); gv[j] = e * rden; }
        v4u ew; ew.x = ev[0] | ((unsigned)ev[1] << 16); ew.y = ev[2] | ((unsigned)ev[3] << 16); ew.z = ev[4] | ((unsigned)ev[5] << 16); ew.w = ev[6] | ((unsigned)ev[7] << 16);
        *(v4u*)(pe + tok * 128 + head * 16 + 8 * h) = ew;
        *(f32x4*)(pg + tok * 128 + head * 16 + 8 * h) = (f32x4){gv[0], gv[1], gv[2], gv[3]};
        *(f32x4*)(pg + tok * 128 + head * 16 + 8 * h + 4) = (f32x4){gv[4], gv[5], gv[6], gv[7]};
        LDS_WAIT();
    }
    __syncthreads();
}
__device__ __forceinline__ float gelu_erf(float x) { return 0.5f * x * (1.0f + erff(x * 0.70710678118654752f)); }
#ifndef NPART
#define NPART 16
#endif
constexpr int TPW = 8, NSWEEP = 1;
constexpr int PSHIFT = (NPART == 32) ? 9 : (NPART == 8) ? 11 : (NPART == 16) ? 10 : (NPART == 4) ? 12 : (NPART == 2) ? 13 : 14;
__device__ __forceinline__ void p8_peer(Frame& F, unsigned emask = 0xffffu, int skip = 0) {
    const float* mod = (const float*)(F.ws + WS_MOD);
    const bf16* x1 = (const bf16*)(F.ws + WS_X1); const bf16* h2 = (const bf16*)(F.ws + WS_H2);
    const unsigned char* ut = F.ws + WS_U; const unsigned char* vt = F.ws + WS_V;
    const float* su = (const float*)(F.ws + WS_SU); const float* sv = (const float*)(F.ws + WS_SV);
    const unsigned* pe = (const unsigned*)(F.ws + WS_PE); const float* pg = (const float*)(F.ws + WS_PG);
    const int gw = F.vcu * NWAVES + F.wave;
    const int b3 = (F.lane >> 3) & 1;
    LAS unsigned* scr = (LAS unsigned*)(F.lds + F.wave * 1024);
#pragma unroll 1
    for (int sweep = 0; sweep < NSWEEP; ++sweep) {
    const int t0 = (gw * NSWEEP + sweep) * TPW, b = t0 >> 13;
    int lane = F.lane; asm volatile("" : "+v"(lane));
    unsigned hq[TPW][4]; float shs[TPW]; unsigned es[TPW]; float gs[TPW][2]; int offv[TPW];
#pragma unroll
    for (int tt = 0; tt < TPW; ++tt) { const size_t t = (size_t)(t0 + tt);
        float hv[16]; float am = 0.f;
#pragma unroll
        for (int j = 0; j < 4; ++j) { const u32x2 v = *(const u32x2*)(h2 + t * DM + 256 * j + 4 * lane); hv[4 * j] = bf_lo(v.x); hv[4 * j + 1] = bf_hi(v.x); hv[4 * j + 2] = bf_lo(v.y); hv[4 * j + 3] = bf_hi(v.y); }
#pragma unroll
        for (int i = 0; i < 16; ++i) am = fmaxf(am, fabsf(hv[i]));
#pragma unroll
        for (int o = 1; o < 64; o <<= 1) am = fmaxf(am, __shfl_xor(am, o));
        if (am == 0.f) am = 1.f;
        const float inv = 127.0f / am; shs[tt] = am * (1.0f / 127.0f);
#pragma unroll
        for (int j = 0; j < 4; ++j) { const int q0 = (int)rintf(hv[4 * j] * inv), q1 = (int)rintf(hv[4 * j + 1] * inv), q2 = (int)rintf(hv[4 * j + 2] * inv), q3 = (int)rintf(hv[4 * j + 3] * inv);
            hq[tt][j] = (unsigned)(q0 & 255) | ((unsigned)(q1 & 255) << 8) | ((unsigned)(q2 & 255) << 16) | ((unsigned)(q3 & 255) << 24); }
        const unsigned pe2 = pe[t * 64 + lane]; const f32x2 pg2 = *(const f32x2*)(pg + t * 128 + 2 * lane);
        const unsigned elo = pe2 & emask, ehi = (pe2 >> 16) & emask; const int plo = (int)(elo >> PSHIFT), phi = (int)(ehi >> PSHIFT);
        int base = 0, poslo = 0, poshi = 0, ov = 0;
#pragma unroll
        for (int r = 0; r < NPART; ++r) { const unsigned long long mlo = __ballot(plo == r), mhi = __ballot(phi == r);
            const int clo = __popcll(mlo), chi = __popcll(mhi);
            const int rlo = (int)__builtin_amdgcn_mbcnt_hi((unsigned)(mlo >> 32), __builtin_amdgcn_mbcnt_lo((unsigned)mlo, 0u));
            const int rhi = (int)__builtin_amdgcn_mbcnt_hi((unsigned)(mhi >> 32), __builtin_amdgcn_mbcnt_lo((unsigned)mhi, 0u));
            if (plo == r) poslo = base + rlo; if (phi == r) poshi = base + clo + rhi;
            base += clo + chi; if (lane == r + 1) ov = base; }
        offv[tt] = ov;
        scr[2 * poslo] = elo; scr[2 * poslo + 1] = __float_as_uint(pg2.x); scr[2 * poshi] = ehi; scr[2 * poshi + 1] = __float_as_uint(pg2.y);
        LDS_WAIT();
        const u32x4 sr = *(const LAS u32x4*)(scr + 4 * lane);
        es[tt] = sr.x | (sr.z << 16); gs[tt][0] = __uint_as_float(sr.y); gs[tt][1] = __uint_as_float(sr.w);
        LDS_WAIT();
    }
#define P8_ISSUE(buf, tbl, tok, bb) do { _Pragma("unroll") for (int k2 = 0; k2 < 4; ++k2) { const unsigned ew = (unsigned)__builtin_amdgcn_readlane((int)es[tok], 4 * (bb) + k2); \
        buf[2 * k2] = *(const u32x4*)((tbl) + (size_t)(ew & 0xffffu) * DM + 16 * lane); buf[2 * k2 + 1] = *(const u32x4*)((tbl) + (size_t)(ew >> 16) * DM + 16 * lane); } } while (0)
    int hidv[TPW][2];
#pragma unroll
    for (int tt = 0; tt < TPW; ++tt) { hidv[tt][0] = 0; hidv[tt][1] = 0; }
    {
        u32x4 bufA[8], bufB[8];
#define P8_DOTS(buf, tok, bb) do { int p[8]; \
            _Pragma("unroll") for (int kk = 0; kk < 8; ++kk) { int s_ = __builtin_amdgcn_sdot4((int)buf[kk].x, (int)hq[tok][0], 0, false); s_ = __builtin_amdgcn_sdot4((int)buf[kk].y, (int)hq[tok][1], s_, false); \
                s_ = __builtin_amdgcn_sdot4((int)buf[kk].z, (int)hq[tok][2], s_, false); s_ = __builtin_amdgcn_sdot4((int)buf[kk].w, (int)hq[tok][3], s_, false); p[kk] = s_; } \
            int q4[4], q2[2], q1; \
            _Pragma("unroll") for (int i = 0; i < 4; ++i) { auto r_ = __builtin_amdgcn_permlane32_swap((unsigned)p[i], (unsigned)p[i + 4], false, false); q4[i] = (int)(r_[0] + r_[1]); } \
            _Pragma("unroll") for (int i = 0; i < 2; ++i) { auto r_ = __builtin_amdgcn_permlane16_swap((unsigned)q4[i], (unsigned)q4[i + 2], false, false); q2[i] = (int)(r_[0] + r_[1]); } \
            { const int keep = b3 ? q2[1] : q2[0], send = b3 ? q2[0] : q2[1]; q1 = keep + __builtin_amdgcn_update_dpp(0, send, 0x128, 0xF, 0xF, true); } \
            q1 += __builtin_amdgcn_update_dpp(0, q1, 0xB1, 0xF, 0xF, true); q1 += __builtin_amdgcn_update_dpp(0, q1, 0x4E, 0xF, 0xF, true); q1 += __builtin_amdgcn_update_dpp(0, q1, 0x141, 0xF, 0xF, true); \
            const int i2_ = (lane & 3) * 2; const int v0_ = __builtin_amdgcn_ds_bpermute(i2_ << 5, q1), v1_ = __builtin_amdgcn_ds_bpermute((i2_ + 1) << 5, q1); \
            if ((lane >> 2) == (bb)) { hidv[tok][0] = v0_; hidv[tok][1] = v1_; } } while (0)
        int cur[TPW];
#pragma unroll
        for (int tt = 0; tt < TPW; ++tt) cur[tt] = 0;
#define P8_STEP_A(tt_, bufX, bufY, r_) { const int end_ = __builtin_amdgcn_readlane(offv[tt_], (r_) + 1); \
            { constexpr int tn_ = ((tt_) + 1) % TPW; const int rn_ = (r_) + ((tt_) + 1) / TPW; \
              if (rn_ < NPART && cur[tn_] < __builtin_amdgcn_readlane(offv[tn_], rn_ + 1)) P8_ISSUE(bufY, ut, tn_, cur[tn_] >> 3); } \
            __builtin_amdgcn_sched_barrier(0); \
            bool pre_ = true; \
            while (cur[tt_] < end_) { if (!pre_) P8_ISSUE(bufX, ut, tt_, cur[tt_] >> 3); pre_ = false; P8_DOTS(bufX, tt_, cur[tt_] >> 3); cur[tt_] += 8; } }
        if ((skip & 1) == 0) {
        if (0 < __builtin_amdgcn_readlane(offv[0], 1)) P8_ISSUE(bufA, ut, 0, 0);
#pragma unroll 1
        for (int r = 0; r < NPART; ++r) {
            P8_STEP_A(0, bufA, bufB, r) P8_STEP_A(1, bufB, bufA, r) P8_STEP_A(2, bufA, bufB, r) P8_STEP_A(3, bufB, bufA, r)
            P8_STEP_A(4, bufA, bufB, r) P8_STEP_A(5, bufB, bufA, r) P8_STEP_A(6, bufA, bufB, r) P8_STEP_A(7, bufB, bufA, r)
        } }
#undef P8_STEP_A
#undef P8_DOTS
    }
#pragma unroll
    for (int tt = 0; tt < TPW; ++tt) { const unsigned e0 = es[tt] & 0xffffu, e1 = es[tt] >> 16;
        const float su0 = su[e0], su1 = su[e1], sv0 = sv[e0], sv1 = sv[e1];
        gs[tt][0] = gelu_erf((float)hidv[tt][0] * (shs[tt] * su0)) * gs[tt][0] * sv0;
        gs[tt][1] = gelu_erf((float)hidv[tt][1] * (shs[tt] * su1)) * gs[tt][1] * sv1; }
    typedef _Float16 f16x2 __attribute__((ext_vector_type(2)));
    f16x2 yh[TPW][8];
#pragma unroll
    for (int tt = 0; tt < TPW; ++tt) {
#pragma unroll
        for (int i = 0; i < 8; ++i) yh[tt][i] = (f16x2){(_Float16)0.f, (_Float16)0.f}; }
    {
        u32x4 bufA[8], bufB[8];
#define BF8ACC(tok, a, word, j) { const unsigned _w = (word); const unsigned _h02 = __builtin_amdgcn_perm(0u, _w, 0x020c000cu), _h13 = __builtin_amdgcn_perm(0u, _w, 0x030c010cu); \
                          yh[tok][2 * (j)] = __builtin_elementwise_fma(__builtin_bit_cast(f16x2, _h02), (a), yh[tok][2 * (j)]); yh[tok][2 * (j) + 1] = __builtin_elementwise_fma(__builtin_bit_cast(f16x2, _h13), (a), yh[tok][2 * (j) + 1]); }
#define P8_ACC(buf, tok, bb) do { _Pragma("unroll") for (int k2 = 0; k2 < 4; ++k2) { \
            const _Float16 h0_ = (_Float16)__int_as_float(__builtin_amdgcn_readlane(__float_as_int(gs[tok][0]), 4 * (bb) + k2)), h1_ = (_Float16)__int_as_float(__builtin_amdgcn_readlane(__float_as_int(gs[tok][1]), 4 * (bb) + k2)); \
            const f16x2 a0_ = (f16x2){h0_, h0_}, a1_ = (f16x2){h1_, h1_}; \
            BF8ACC(tok, a0_, buf[2 * k2].x, 0) BF8ACC(tok, a0_, buf[2 * k2].y, 1) BF8ACC(tok, a0_, buf[2 * k2].z, 2) BF8ACC(tok, a0_, buf[2 * k2].w, 3) __builtin_amdgcn_sched_barrier(0); \
            BF8ACC(tok, a1_, buf[2 * k2 + 1].x, 0) BF8ACC(tok, a1_, buf[2 * k2 + 1].y, 1) BF8ACC(tok, a1_, buf[2 * k2 + 1].z, 2) BF8ACC(tok, a1_, buf[2 * k2 + 1].w, 3) __builtin_amdgcn_sched_barrier(0); } } while (0)
        int cur[TPW];
#pragma unroll
        for (int tt = 0; tt < TPW; ++tt) cur[tt] = 0;
#define P8_STEP_B(tt_, bufX, bufY, r_) { const int end_ = __builtin_amdgcn_readlane(offv[tt_], (r_) + 1); \
            { constexpr int tn_ = ((tt_) + 1) % TPW; const int rn_ = (r_) + ((tt_) + 1) / TPW; \
              if (rn_ < NPART && cur[tn_] < __builtin_amdgcn_readlane(offv[tn_], rn_ + 1)) P8_ISSUE(bufY, vt, tn_, cur[tn_] >> 3); } \
            __builtin_amdgcn_sched_barrier(0); \
            bool pre_ = true; \
            while (cur[tt_] < end_) { if (!pre_) P8_ISSUE(bufX, vt, tt_, cur[tt_] >> 3); pre_ = false; P8_ACC(bufX, tt_, cur[tt_] >> 3); cur[tt_] += 8; } }
        if ((skip & 2) == 0) {
        if (0 < __builtin_amdgcn_readlane(offv[0], 1)) P8_ISSUE(bufA, vt, 0, 0);
#pragma unroll 1
        for (int r = 0; r < NPART; ++r) {
            P8_STEP_B(0, bufA, bufB, r) P8_STEP_B(1, bufB, bufA, r) P8_STEP_B(2, bufA, bufB, r) P8_STEP_B(3, bufB, bufA, r)
            P8_STEP_B(4, bufA, bufB, r) P8_STEP_B(5, bufB, bufA, r) P8_STEP_B(6, bufA, bufB, r) P8_STEP_B(7, bufB, bufA, r)
        } }
#undef P8_STEP_B
#undef P8_ACC
#undef BF8ACC
    }
#undef P8_ISSUE
#pragma unroll
    for (int tt = 0; tt < TPW; ++tt) { const size_t t = (size_t)(t0 + tt);
        f32x4 v[4]; float s = 0.f;
#pragma unroll
        for (int j = 0; j < 4; ++j) { const int d = 256 * j + 4 * lane; const u32x2 xv = *(const u32x2*)(x1 + t * DM + d); const f32x4 g2 = *(const f32x4*)(mod + b * 6144 + 5120 + d) + 1.0f;
            const f32x4 xf = (f32x4){bf_lo(xv.x), bf_hi(xv.x), bf_lo(xv.y), bf_hi(xv.y)}; const f32x4 yy = (f32x4){(float)yh[tt][2 * j].x, (float)yh[tt][2 * j + 1].x, (float)yh[tt][2 * j].y, (float)yh[tt][2 * j + 1].y};
            v[j] = xf * DN_ALPHA + g2 * yy; s += (v[j][0] + v[j][1]) + (v[j][2] + v[j][3]); }
        const float mean = wave_sum(s) * (1.f / DM); float qq = 0.f;
#pragma unroll
        for (int j = 0; j < 4; ++j) { v[j] = v[j] - mean; qq += (v[j][0] * v[j][0] + v[j][1] * v[j][1]) + (v[j][2] * v[j][2] + v[j][3] * v[j][3]); }
        const float rstd = 1.0f / sqrtf(wave_sum(qq) * (1.f / DM) + LN_EPS);
#pragma unroll
        for (int j = 0; j < 4; ++j) { const int d = 256 * j + 4 * lane; const f32x4 lg = *(const f32x4*)(F.ln2_g + d), lb = *(const f32x4*)(F.ln2_b + d);
            *(f32x4*)(F.out + t * DM + d) = v[j] * rstd * lg + lb; } }
    }
}
#ifndef MK_N_LAUNCHES
#define MK_N_LAUNCHES 1
#endif
constexpr int N_PHASES = 9;
struct Args { const float* in[18]; float* out; unsigned char* ws; int ph_lo, ph_hi; };
__global__ void __launch_bounds__(NTHREADS, 2) fwd_kernel(Args args) {
    extern __shared__ __attribute__((aligned(16))) unsigned char lds[];
    Frame F;
    F.lds = (LAS unsigned char*)lds;
    F.tid = threadIdx.x; F.lane = F.tid & 63; F.wave = __builtin_amdgcn_readfirstlane(F.tid >> 6);
    F.G = gridDim.x; { const int bx = blockIdx.x; F.vcu = (F.G % 8 == 0) ? (bx % 8) * (F.G / 8) + bx / 8 : bx; }
    F.x = args.in[0]; F.c = args.in[1]; F.w_ada = args.in[2]; F.b_ada = args.in[3]; F.w_in = args.in[4]; F.sinks = args.in[5]; F.w_pool = args.in[6]; F.pool_scale = args.in[7];
    F.w_out = args.in[8]; F.ln1_g = args.in[9]; F.ln1_b = args.in[10]; F.w_pq = args.in[11]; F.k1 = args.in[12]; F.k2 = args.in[13]; F.pu = args.in[14]; F.pv = args.in[15];
    F.ln2_g = args.in[16]; F.ln2_b = args.in[17]; F.out = args.out; F.ws = args.ws;
    volatile LAS unsigned* MISC = (volatile LAS unsigned*)(F.lds + MISC_OFF);
    for (int u = F.tid; u < (LDS_BYTES - LDSCTL_OFF) / 4; u += NTHREADS) ((LAS unsigned*)(F.lds + LDSCTL_OFF))[u] = 0u;
    __syncthreads();
    const int lo = args.ph_lo, hi = args.ph_hi;
    XcdBarrier bar; bar.bar = (unsigned*)(F.ws + WS_CTL) + CW_BAR; bar.x = 0; bar.st = nullptr;
    if (hi - lo > 1) bar = xcd_barrier_post((unsigned*)(F.ws + WS_CTL) + CW_BAR, MISC + 8);
#ifndef PH_MASK
#define PH_MASK 0x1ff
#endif
#define IN(k) (((PH_MASK >> (k)) & 1) && lo <= (k) && (k) < hi)
#define SEAM(k) do { if (IN(k) && IN((k) + 1)) xcd_barrier(bar); } while (0)
#ifndef REP_MASK
#define REP_MASK 0
#endif
#ifndef REP_CNT
#define REP_CNT 2
#endif
#define REPS(k) (((REP_MASK >> (k)) & 1) * REP_CNT)
#define PHASE(k, ...) if (IN(k)) { _Pragma("unroll 1") for (int _r = 0; _r <= REPS(k); ++_r) { __VA_ARGS__; if (_r < REPS(k)) xcd_barrier(bar); } } SEAM(k)
#ifndef P0_SUB
#define P0_SUB 0xff
#endif
    PHASE(0, p0_prologue(F, _r == 0 ? 0xff : P0_SUB));
    PHASE(1, p1_win(F));
    PHASE(2, { pg8::Gemm g{(const pg8::bf16_t*)(F.ws + WS_XN), (const pg8::bf16_t*)(F.ws + WS_WIN), TT, NIN, DM, 32, (size_t)NIN * DM * 2}; pg8::StaticOrder S; S.init(TT, NIN, F.G, (int)blockIdx.x);
            pg8::EpiRope E{(pg8::bf16_t*)(F.ws + WS_PROJ), NIN, (const float*)(F.ws + WS_ROPE), QSCALE, (const float*)(F.ws + WS_BIAS)};
            pg8::gemm_phase<pg8::EpiRope, pg8::StaticOrder, true, true>(F.lds, g, S, E);
            if ((int)blockIdx.x >= 320 - F.G) p2_tables(F, ((int)blockIdx.x - (320 - F.G)) * NWAVES + F.wave, (2 * F.G - 320) * NWAVES); });
    PHASE(3, { for (int u = F.vcu; u < 256; u += F.G) p3_attn_unit(F, u);
               for (int u = F.vcu; u < 256; u += F.G) p3_pool_unit(F, u); });
    PHASE(4, { pg8::Gemm g{(const pg8::bf16_t*)(F.ws + WS_A2), (const pg8::bf16_t*)(F.ws + WS_WOUT), TT, DM, DM, 1 << 30, 0}; pg8::StaticOrder S; S.init(TT, DM, F.G, (int)blockIdx.x);
            pg8::EpiPlain E{(pg8::bf16_t*)(F.ws + WS_MIX), DM};
            pg8::gemm_phase<pg8::EpiPlain, pg8::StaticOrder, true, true>(F.lds, g, S, E); });
    PHASE(5, p5_ln1(F));
    PHASE(6, { pg8::Gemm g{(const pg8::bf16_t*)(F.ws + WS_H2), (const pg8::bf16_t*)(F.ws + WS_WPQ), TT, NQD, DM, 1 << 30, 0}; pg8::StaticOrder S; S.init(TT, NQD, F.G, (int)blockIdx.x);
            pg8::EpiPlain E{(pg8::bf16_t*)(F.ws + WS_Q), NQD};
            pg8::gemm_phase<pg8::EpiPlain, pg8::StaticOrder, true, true>(F.lds, g, S, E); });
    PHASE(7, p7_route(F));
#ifndef P8_FAKE
#define P8_FAKE 0x03ffu
#endif
#ifndef P8_SKIP
#define P8_SKIP 2
#endif
    PHASE(8, p8_peer(F, _r == REPS(8) ? 0xffffu : P8_FAKE, _r == REPS(8) ? 0 : P8_SKIP));
#undef IN
#undef SEAM
}

extern "C" void kernel_launch(void* const* d_in, const int* in_sizes, int n_in, void* d_out, int out_size, void* d_ws, size_t ws_size, hipStream_t stream) {
    static int grid = 0;
    if (grid == 0) {
        if (n_in != 18 || out_size != TT * DM || ws_size < WS_END) { fprintf(stderr, "kernel_launch: unexpected shapes (n_in %d out %d ws %zu)\n", n_in, out_size, ws_size); grid = -1; return; }
        int dev = 0, cus = 0, per_cu = 0;
        if (hipGetDevice(&dev) != hipSuccess || hipDeviceGetAttribute(&cus, hipDeviceAttributeMultiprocessorCount, dev) != hipSuccess) { grid = -1; return; }
        if (hipFuncSetAttribute((const void*)fwd_kernel, hipFuncAttributeMaxDynamicSharedMemorySize, LDS_BYTES) != hipSuccess) { fprintf(stderr, "kernel_launch: hipFuncSetAttribute failed\n"); grid = -1; return; }
        if (hipOccupancyMaxActiveBlocksPerMultiprocessor(&per_cu, (const void*)fwd_kernel, NTHREADS, LDS_BYTES) != hipSuccess || per_cu < 1) { fprintf(stderr, "kernel_launch: occupancy query says %d blocks per CU\n", per_cu); }
        (void)hipGetLastError();
        grid = cus;
        if (grid != 256) fprintf(stderr, "kernel_launch: built for 256 CUs, got %d\n", grid);
    }
    if (grid < 0) return;
    (void)hipMemsetAsync((char*)d_ws + WS_CTL, 0, CTL_ZERO_BYTES, stream);
    Args a{};
    for (int i = 0; i < 18; ++i) a.in[i] = (const float*)d_in[i];
    a.out = (float*)d_out; a.ws = (unsigned char*)d_ws;
#if MK_N_LAUNCHES == 1
    a.ph_lo = 0; a.ph_hi = N_PHASES;
    hipLaunchKernelGGL(fwd_kernel, dim3(grid), dim3(NTHREADS), LDS_BYTES, stream, a);
#else
    for (int p = 0; p < N_PHASES; ++p) { a.ph_lo = p; a.ph_hi = p + 1; hipLaunchKernelGGL(fwd_kernel, dim3(grid), dim3(NTHREADS), LDS_BYTES, stream, a); }
#endif
}
```

```cpp
#include <hip/hip_runtime.h>
#include <cstdio>
#include <cstdint>
#include <cmath>
namespace pg8 {
#define PG8_LAS __attribute__((address_space(3)))
typedef unsigned short bf16_t;
typedef short bf16x8 __attribute__((ext_vector_type(8)));
typedef float f32x4 __attribute__((ext_vector_type(4)));
typedef unsigned u32x4 __attribute__((ext_vector_type(4)));
constexpr int BM = 256, BK = 64, HALF = 128, HTB = HALF * BK * 2  , STAGE_BYTES = 8 * HTB, NXCD = 8, WGM = 8;

__host__ __device__ __forceinline__ int lds_byte(int r, int c) { const int st = (r >> 4) * 2 + (c >> 5), rr = r & 15, cc = c & 31, ob = rr * 64 + cc * 2; return st * 1024 + (ob ^ (((ob >> 9) & 1) << 5)); }
__host__ __device__ __forceinline__ void stage_rc(int b, int& R, int& C) { const int st = b / 1024, sb = b % 1024, swz = sb ^ (((sb >> 9) & 1) << 5); R = (st >> 1) * 16 + swz / 64; C = (st & 1) * 32 + (swz % 64) / 2; }
__host__ __device__ __forceinline__ int perm32(int rho) { const int n = rho >> 4, i = rho & 15; return 8 * (i >> 2) + 4 * n + (i & 3); }

struct Unit { int pm, pn; };
struct Gemm { const bf16_t* A; const bf16_t* Bt; int M, N, K; int bsplit; size_t bstride; };

struct StaticOrder {
    int nM, nN, nwg, G, c;
    __host__ __device__ void init(int M, int N, int G_, int c_) { nM = M / BM; nN = N / BM; nwg = nM * nN; G = G_; c = c_; }
    __host__ __device__ bool next(int i, Unit& u) const {
        const long L = (long)i * G + c; if (L >= nwg) return false;
        int wgid = (int)L; { const int q = nwg / NXCD, r = nwg % NXCD, xcd = wgid % NXCD, off = wgid / NXCD; wgid = (xcd < r ? xcd * (q + 1) : r * (q + 1) + (xcd - r) * q) + off; }
        const int nig = WGM * nN, gid = wgid / nig, fm = gid * WGM, gsz = (nM - fm) < WGM ? (nM - fm) : WGM;
        u.pm = fm + ((wgid % nig) % gsz); u.pn = (wgid % nig) / gsz; return true;
    }
    __device__ __forceinline__ void a_ready(const Unit&) const {}
    __device__ __forceinline__ void done(const Unit&) const {}
};

__device__ __forceinline__ unsigned cvt_pk_bf16(float lo, float hi) { unsigned r; asm volatile("v_cvt_pk_bf16_f32 %0, %1, %2" : "=v"(r) : "v"(lo), "v"(hi)); return r; }

struct EpiPlain {
    static constexpr bool PERM = true, AFTER_DRAIN = false;
    bf16_t* O; int ldc;
    __device__ __forceinline__ void operator()(const f32x4 (&acc)[2][2][4][2], const Unit& u, int wr, int wc, int fr, int fq) const {
        const int row0 = u.pm * BM + wr * 64 + fr; const int col0 = u.pn * BM + wc * 32 + 8 * fq;
#pragma unroll
        for (int ai = 0; ai < 2; ++ai)
#pragma unroll
            for (int m = 0; m < 4; ++m) { bf16_t* rowp = O + (size_t)(row0 + ai * HALF + m * 16) * ldc + col0;
#pragma unroll
                for (int bj = 0; bj < 2; ++bj) { const f32x4 v0 = acc[ai][bj][m][0], v1 = acc[ai][bj][m][1];
                    u32x4 w; w.x = cvt_pk_bf16(v0[0], v0[1]); w.y = cvt_pk_bf16(v0[2], v0[3]); w.z = cvt_pk_bf16(v1[0], v1[1]); w.w = cvt_pk_bf16(v1[2], v1[3]);
                    *(u32x4*)(rowp + bj * HALF) = w; } }
    }
};
struct EpiRope {
    static constexpr bool PERM = true, AFTER_DRAIN = false;
    bf16_t* O; int ldc; const float* rope; float qscale; const float* bias;
    __device__ __forceinline__ void operator()(const f32x4 (&acc)[2][2][4][2], const Unit& u, int wr, int wc, int fr, int fq) const {
        const int row0 = u.pm * BM + wr * 64 + fr; const int col0 = u.pn * BM + wc * 32 + 8 * fq;
#pragma unroll
        for (int ai = 0; ai < 2; ++ai)
#pragma unroll
            for (int m = 0; m < 4; ++m) { const int row = row0 + ai * HALF + m * 16; bf16_t* rowp = O + (size_t)row * ldc + col0; const int pos = row & 8191;
#pragma unroll
                for (int bj = 0; bj < 2; ++bj) { const float* bp = bias + (size_t)(row >> 13) * ldc + col0 + bj * HALF;
                    f32x4 v0 = acc[ai][bj][m][0] + *(const f32x4*)bp, v1 = acc[ai][bj][m][1] + *(const f32x4*)(bp + 4);
                    const int colt = u.pn * BM + bj * HALF;
                    if (colt < 640) {
                        const int c = col0 + bj * HALF, ib = (c & 63) >> 1;
                        const f32x4 cs0 = *(const f32x4*)(rope + ((size_t)pos * 32 + ib) * 2), cs1 = *(const f32x4*)(rope + ((size_t)pos * 32 + ib) * 2 + 4);
                        const float sc = colt < 512 ? qscale : 1.0f;
                        f32x4 r0, r1;
                        r0[0] = (v0[0] * cs0[0] - v0[1] * cs0[1]) * sc; r0[1] = (v0[1] * cs0[0] + v0[0] * cs0[1]) * sc;
                        r0[2] = (v0[2] * cs0[2] - v0[3] * cs0[3]) * sc; r0[3] = (v0[3] * cs0[2] + v0[2] * cs0[3]) * sc;
                        r1[0] = (v1[0] * cs1[0] - v1[1] * cs1[1]) * sc; r1[1] = (v1[1] * cs1[0] + v1[0] * cs1[1]) * sc;
                        r1[2] = (v1[2] * cs1[2] - v1[3] * cs1[3]) * sc; r1[3] = (v1[3] * cs1[2] + v1[2] * cs1[3]) * sc;
                        v0 = r0; v1 = r1;
                    }
                    u32x4 w; w.x = cvt_pk_bf16(v0[0], v0[1]); w.y = cvt_pk_bf16(v0[2], v0[3]); w.z = cvt_pk_bf16(v1[0], v1[1]); w.w = cvt_pk_bf16(v1[2], v1[3]);
                    *(u32x4*)(rowp + bj * HALF) = w; } }
    }
};

template <class Epi, class Sched, bool ALIGN_EPI = false, bool SP2 = false>
__device__ __forceinline__ void gemm_phase(PG8_LAS unsigned char* lds, const Gemm g, const Sched& S, const Epi& E) {
    const int tid = threadIdx.x, wid = __builtin_amdgcn_readfirstlane(tid >> 6), lane = tid & 63, wr = wid >> 2, wc = wid & 3, fr = lane & 15, fq = lane >> 4;
    const int K = g.K, nt = K / BK;
    unsigned voffA[2], voffB[2];
#pragma unroll
    for (int i = 0; i < 2; ++i) { int R, C; stage_rc(tid * 16 + i * 8192, R, C); const int Rb = Epi::PERM ? ((R & ~31) + perm32(R & 31)) : R;
        voffA[i] = (unsigned)(R * K + C) * 2u; voffB[i] = (unsigned)(Rb * K + C) * 2u; }
    const size_t kstep = (size_t)(BK * 2);
    const size_t hstep = (size_t)HALF * K * 2;
    const size_t tstep = 2 * hstep;
    const unsigned ldsw = (unsigned)wid * 1024u;
    const int aoff = lds_byte(wr * 64 + fr, fq * 8), boff = lds_byte(wc * 32 + fr, fq * 8);
#define PG8_SA(b, h) (((b) * 2 + (h)) * HTB)
#define PG8_SB(b, h) ((4 + (b) * 2 + (h)) * HTB)
#define PG8_STAGE(bufoff, gbase, voff) do { _Pragma("unroll") for (int _i = 0; _i < 2; ++_i) \
        __builtin_amdgcn_global_load_lds((const unsigned*)((const char*)(gbase) + (voff)[_i]), (PG8_LAS unsigned*)(lds + (bufoff) + ldsw + _i * 8192), 16, 0, 0); } while (0)
#define PG8_LDA(dst, b, h) do { _Pragma("unroll") for (int m = 0; m < 4; ++m) _Pragma("unroll") for (int k = 0; k < 2; ++k) dst[m][k] = *(const PG8_LAS bf16x8*)(lds + PG8_SA(b, h) + aoff + m * 2048 + k * 1024); } while (0)
#define PG8_LDB(dst, b, h) do { _Pragma("unroll") for (int n = 0; n < 2; ++n) _Pragma("unroll") for (int k = 0; k < 2; ++k) dst[n][k] = *(const PG8_LAS bf16x8*)(lds + PG8_SB(b, h) + boff + n * 2048 + k * 1024); } while (0)
#define PG8_MMA(ai, bj, At, Bt) do { __builtin_amdgcn_s_setprio(1); _Pragma("unroll") for (int m = 0; m < 4; ++m) _Pragma("unroll") for (int n = 0; n < 2; ++n) _Pragma("unroll") for (int k = 0; k < 2; ++k) \
        acc[ai][bj][m][n] = __builtin_amdgcn_mfma_f32_16x16x32_bf16(Bt[n][k], At[m][k], acc[ai][bj][m][n], 0, 0, 0); __builtin_amdgcn_s_setprio(0); } while (0)
#define PG8_WAIT_V(n) asm volatile("s_waitcnt vmcnt(" #n ")" ::: "memory")
#define PG8_WAIT_L(n) asm volatile("s_waitcnt lgkmcnt(" #n ")" ::: "memory")
#define PG8_BAR __builtin_amdgcn_s_barrier()
#define PG8_SCHED __builtin_amdgcn_sched_barrier(0)
    Unit cur, nxt; int ui = 0;
    if (!S.next(0, cur)) return;
    f32x4 acc[2][2][4][2];
#pragma unroll
    for (int a = 0; a < 2; ++a)
#pragma unroll
        for (int b = 0; b < 2; ++b)
#pragma unroll
            for (int m = 0; m < 4; ++m)
#pragma unroll
                for (int n = 0; n < 2; ++n) acc[a][b][m][n] = (f32x4){0.f, 0.f, 0.f, 0.f};
    bf16x8 At[4][2], B0[2][2], B1[2][2];
    const char* cA = (const char*)g.A + (size_t)cur.pm * tstep; const char* cB = (const char*)g.Bt + (size_t)cur.pn * tstep + (cur.pm >= g.bsplit ? g.bstride : (size_t)0);
    S.a_ready(cur);
    if constexpr (SP2) {
        PG8_STAGE(PG8_SB(0, 0), cB, voffB); PG8_STAGE(PG8_SB(0, 1), cB + hstep, voffB); PG8_STAGE(PG8_SA(0, 0), cA, voffA); PG8_STAGE(PG8_SA(0, 1), cA + hstep, voffA);
        if (wr == 1) PG8_BAR;
        PG8_WAIT_V(2); PG8_BAR;
        PG8_STAGE(PG8_SB(1, 0), cB + kstep, voffB); PG8_STAGE(PG8_SA(1, 0), cA + kstep, voffA); PG8_STAGE(PG8_SB(1, 1), cB + hstep + kstep, voffB);
        PG8_WAIT_V(6); PG8_BAR;
    } else {
        PG8_STAGE(PG8_SB(0, 0), cB, voffB); PG8_STAGE(PG8_SA(0, 0), cA, voffA); PG8_STAGE(PG8_SB(0, 1), cB + hstep, voffB); PG8_STAGE(PG8_SA(0, 1), cA + hstep, voffA);
        if (wr == 1) PG8_BAR;
        PG8_WAIT_V(4); PG8_BAR;
        PG8_STAGE(PG8_SB(1, 0), cB + kstep, voffB); PG8_STAGE(PG8_SA(1, 0), cA + kstep, voffA); PG8_STAGE(PG8_SB(1, 1), cB + hstep + kstep, voffB);
        PG8_WAIT_V(6); PG8_BAR;
    }
    for (;;) {
        const bool has_next = S.next(ui + 1, nxt);
        const char* nA = has_next ? (const char*)g.A + (size_t)nxt.pm * tstep : cA; const char* nB = has_next ? (const char*)g.Bt + (size_t)nxt.pn * tstep + (nxt.pm >= g.bsplit ? g.bstride : (size_t)0) : cB;
        for (int t = 0; t < nt; t += 2) {
            const bool last = (t == nt - 2);
            const char* a1 = cA + (size_t)(t + 1) * kstep;
            const char* a2 = last ? nA : cA + (size_t)(t + 2) * kstep; const char* b2 = last ? nB : cB + (size_t)(t + 2) * kstep;
            const char* a3 = a2 + kstep; const char* b3 = b2 + kstep;
            if (last && has_next) S.a_ready(nxt);
            if constexpr (SP2) {
            PG8_LDB(B0, 0, 0); PG8_LDB(B1, 0, 1); PG8_SCHED; PG8_LDA(At, 0, 0); PG8_STAGE(PG8_SA(1, 1), a1 + hstep, voffA);
            PG8_WAIT_V(8); PG8_WAIT_L(0); PG8_BAR; PG8_MMA(0, 0, At, B0); PG8_MMA(0, 1, At, B1); PG8_BAR; PG8_SCHED;
            PG8_LDA(At, 0, 1); PG8_STAGE(PG8_SB(0, 0), b2, voffB); PG8_STAGE(PG8_SB(0, 1), b2 + hstep, voffB); PG8_STAGE(PG8_SA(0, 0), a2, voffA);
            PG8_WAIT_V(8); PG8_WAIT_L(0); PG8_BAR; PG8_MMA(1, 0, At, B0); PG8_MMA(1, 1, At, B1); PG8_BAR; PG8_SCHED;
            PG8_LDB(B0, 1, 0); PG8_LDB(B1, 1, 1); PG8_SCHED; PG8_LDA(At, 1, 0); PG8_STAGE(PG8_SA(0, 1), a2 + hstep, voffA);
            PG8_WAIT_V(8); PG8_WAIT_L(0); PG8_BAR; PG8_MMA(0, 0, At, B0); PG8_MMA(0, 1, At, B1); PG8_BAR; PG8_SCHED;
            PG8_LDA(At, 1, 1); PG8_STAGE(PG8_SB(1, 0), b3, voffB); PG8_STAGE(PG8_SB(1, 1), b3 + hstep, voffB); PG8_STAGE(PG8_SA(1, 0), a3, voffA);
            PG8_WAIT_V(8); PG8_WAIT_L(0); PG8_BAR; PG8_MMA(1, 0, At, B0); PG8_MMA(1, 1, At, B1); PG8_BAR; PG8_SCHED;
            } else {
            PG8_LDB(B0, 0, 0); PG8_SCHED; PG8_LDA(At, 0, 0); PG8_STAGE(PG8_SA(1, 1), a1 + hstep, voffA);
            PG8_WAIT_L(8); PG8_BAR; PG8_WAIT_L(0); PG8_MMA(0, 0, At, B0); PG8_BAR; PG8_SCHED;
            PG8_LDB(B1, 0, 1); PG8_STAGE(PG8_SB(0, 0), b2, voffB);
            PG8_BAR; PG8_WAIT_L(0); PG8_MMA(0, 1, At, B1); PG8_BAR;
            PG8_LDA(At, 0, 1); PG8_STAGE(PG8_SA(0, 0), a2, voffA);
            PG8_BAR; PG8_WAIT_L(0); PG8_MMA(1, 0, At, B0); PG8_BAR; PG8_SCHED;
            PG8_STAGE(PG8_SB(0, 1), b2 + hstep, voffB);
            PG8_WAIT_V(6); PG8_BAR; PG8_MMA(1, 1, At, B1); PG8_BAR;
            PG8_LDB(B0, 1, 0); PG8_SCHED; PG8_LDA(At, 1, 0); PG8_STAGE(PG8_SA(0, 1), a2 + hstep, voffA);
            PG8_WAIT_L(8); PG8_BAR; PG8_WAIT_L(0); PG8_MMA(0, 0, At, B0); PG8_BAR; PG8_SCHED;
            PG8_LDB(B1, 1, 1); PG8_STAGE(PG8_SB(1, 0), b3, voffB);
            PG8_BAR; PG8_WAIT_L(0); PG8_MMA(0, 1, At, B1); PG8_BAR;
            PG8_LDA(At, 1, 1); PG8_STAGE(PG8_SA(1, 0), a3, voffA);
            PG8_BAR; PG8_WAIT_L(0); PG8_MMA(1, 0, At, B0); PG8_BAR; PG8_SCHED;
            PG8_STAGE(PG8_SB(1, 1), b3 + hstep, voffB);
            PG8_WAIT_V(6); PG8_BAR; PG8_MMA(1, 1, At, B1); PG8_BAR;
            }
        }
        if constexpr (ALIGN_EPI) { if (wr == 0) PG8_BAR; }
        if constexpr (!Epi::AFTER_DRAIN) { E(acc, cur, wr, wc, fr, fq); S.done(cur); }
        if (!has_next) break;
#pragma unroll
        for (int a = 0; a < 2; ++a)
#pragma unroll
            for (int b = 0; b < 2; ++b)
#pragma unroll
                for (int m = 0; m < 4; ++m)
#pragma unroll
                    for (int n = 0; n < 2; ++n) acc[a][b][m][n] = (f32x4){0.f, 0.f, 0.f, 0.f};
        cur = nxt; cA = nA; cB = nB; ++ui;
        if constexpr (ALIGN_EPI) { if (wr == 1) PG8_BAR; }
    }
    PG8_WAIT_V(0);
    if constexpr (!ALIGN_EPI) { if (wr == 0) PG8_BAR; }
    PG8_BAR;
    if constexpr (Epi::AFTER_DRAIN) { E.fused(acc, cur, wr, wc, fr, fq, lds, wid, lane); S.done(cur); }
#undef PG8_SA
#undef PG8_SB
#undef PG8_STAGE
#undef PG8_LDA
#undef PG8_LDB
#undef PG8_MMA
#undef PG8_WAIT_V
#undef PG8_WAIT_L
#undef PG8_BAR
#undef PG8_SCHED
}
}
#define GAS __attribute__((address_space(1)))
#define LAS __attribute__((address_space(3)))
typedef unsigned short bf16;
typedef unsigned v4u __attribute__((ext_vector_type(4)));
typedef float f32x4 __attribute__((ext_vector_type(4)));
typedef short bf16x8 __attribute__((ext_vector_type(8)));
typedef GAS unsigned gu32;
typedef GAS unsigned long long gu64;
#define RLX_AGENT __ATOMIC_RELAXED, __HIP_MEMORY_SCOPE_AGENT
#define LDS_WAIT() asm volatile("s_waitcnt lgkmcnt(0)" ::: "memory")
#define VM_WAIT() asm volatile("s_waitcnt vmcnt(0)" ::: "memory")
__device__ __forceinline__ unsigned long long rt() { return __builtin_amdgcn_s_memrealtime(); }
__device__ __forceinline__ unsigned f2bf(float f) { unsigned u = __builtin_bit_cast(unsigned, f); return (u + 0x7fffu + ((u >> 16) & 1u)) >> 16; }
__device__ __forceinline__ unsigned pk2(float lo, float hi) { return f2bf(lo) | (f2bf(hi) << 16); }
#define XB_TMO      128
#define XB_XCNT(j)  (256  + 64 * (j))
#define XB_XSUB(j)  (1280 + 64 * (j))
#define XB_XGEN(j)  (2304 + 64 * (j))
#define XB_TOP      3328
#define XB_TOPGEN   3392
#define XCD_BAR_WORDS 3456
#define XB_SPIN_CAP (1u << 18)

__device__ __forceinline__ unsigned xb_ld(unsigned* p)              { return __hip_atomic_load(p, __ATOMIC_RELAXED, __HIP_MEMORY_SCOPE_AGENT); }
__device__ __forceinline__ unsigned xb_add(unsigned* p, unsigned v) { return __hip_atomic_fetch_add(p, v, __ATOMIC_RELAXED, __HIP_MEMORY_SCOPE_AGENT); }
__device__ __forceinline__ unsigned xb_xcc_id() { return (unsigned)__builtin_amdgcn_s_getreg((3 << 11) | 20) & 0xFu; }
#define XB_SPIN(cond, bar) do { unsigned _sp = 0; while (cond) { __builtin_amdgcn_s_sleep(1); \
    if ((++_sp & 255u) == 0u) { if (xb_ld(&(bar)[XB_TMO])) break; if (_sp > XB_SPIN_CAP) { atomicAdd(&(bar)[XB_TMO], 1u); break; } } } } while (0)

struct XcdBarrier {
    unsigned* bar; unsigned x;
    volatile LAS unsigned* st;
};

__device__ __forceinline__ XcdBarrier xcd_barrier_post(unsigned* bar, volatile LAS unsigned* st) {
    XcdBarrier b; b.bar = bar; b.x = xb_xcc_id(); b.st = st;
    if (threadIdx.x == 0) (void)xb_add(&bar[XB_XCNT(b.x)], 1u);
    return b;
}
__device__ __forceinline__ void xcd_barrier_complete(unsigned* bar, unsigned x, unsigned& nloc, unsigned& nx) {
    const unsigned G = gridDim.x * gridDim.y * gridDim.z;
    unsigned sum, cnt, mine, sp = 0u;
    for (;;) {
        sum = 0u; cnt = 0u; mine = 0u;
#pragma unroll
        for (unsigned j = 0; j < 16; ++j) { const unsigned c = xb_ld(&bar[XB_XCNT(j)]); sum += c; cnt += (c > 0u) ? 1u : 0u; mine = (j == x) ? c : mine; }
        if (sum == G) break;
        __builtin_amdgcn_s_sleep(1);
        if ((++sp & 255u) == 0u) { if (xb_ld(&bar[XB_TMO])) break; if (sp > XB_SPIN_CAP) { atomicAdd(&bar[XB_TMO], 1u); break; } }
    }
    nloc = mine > 0u ? mine : 1u; nx = cnt > 0u ? cnt : 1u;
}

__device__ __forceinline__ void xcd_barrier(const XcdBarrier& b) {
    asm volatile("s_waitcnt vmcnt(0)" ::: "memory");
    __syncthreads();
    if (threadIdx.x == 0) {
        unsigned* bar = b.bar;
        __builtin_amdgcn_s_waitcnt(0);
        unsigned nloc = b.st[0], nx = b.st[1];
        if (nloc == 0u) { xcd_barrier_complete(bar, b.x, nloc, nx); b.st[0] = nloc; b.st[1] = nx; }
        const unsigned old = xb_add(&bar[XB_XSUB(b.x)], 1u);
        const unsigned gen = old / nloc;
        if (old + 1u == (gen + 1u) * nloc) {
            __builtin_amdgcn_fence(__ATOMIC_RELEASE, "agent");
            asm volatile("s_waitcnt vmcnt(0)" ::: "memory");
            const unsigned og = xb_add(&bar[XB_TOP], 1u);
            const unsigned tg = og / nx;
            if (og + 1u == (tg + 1u) * nx) xb_add(&bar[XB_TOPGEN], 1u);
            else XB_SPIN(xb_ld(&bar[XB_TOPGEN]) == tg, bar);
            __builtin_amdgcn_fence(__ATOMIC_ACQUIRE, "agent");
            xb_add(&bar[XB_XGEN(b.x)], 1u);
            asm volatile("s_waitcnt vmcnt(0)" ::: "memory");
        } else {
            XB_SPIN(xb_ld(&bar[XB_XGEN(b.x)]) == gen, bar);
            __builtin_amdgcn_fence(__ATOMIC_ACQUIRE, "agent");
            asm volatile("s_waitcnt vmcnt(0)" ::: "memory");
        }
    }
    __syncthreads();
}
constexpr int NWAVES = 8, NTHREADS = 512;
constexpr int TT = 16384, DM = 1024, SEQ = 8192, NIN = 1280, NQD = 2048, NEXP = 16384;
constexpr float DN_ALPHA = 1.189207115002721f;
constexpr float LN_EPS = 1e-5f;
constexpr float LOG2E = 1.4426950408889634f;
constexpr float QSCALE = 0.125f * LOG2E;

constexpr size_t MiB = 1u << 20;
constexpr size_t WS_CTL = 0, CTL_ZERO_BYTES = 64 * 1024;
constexpr size_t WS_MOD = 1 * MiB + 896 * 1024;
constexpr size_t WS_ROPE = 2 * MiB;
constexpr size_t WS_WIN = 248 * MiB;
constexpr size_t WS_BIAS = 4 * MiB;
constexpr size_t WS_K1 = 6 * MiB + 512 * 1024, WS_K2 = WS_K1 + 32 * 1024;
constexpr size_t WS_WOUT = 7 * MiB;
constexpr size_t WS_WPQ = 9 * MiB;
constexpr size_t WS_SU = 13 * MiB, WS_SV = 13 * MiB + 65536;
constexpr size_t WS_U = 16 * MiB, WS_V = 32 * MiB;
constexpr size_t WS_XN = 80 * MiB;
constexpr size_t WS_MIX = 112 * MiB;
constexpr size_t WS_PE = 80 * MiB, WS_PG = 84 * MiB;
constexpr size_t WS_PROJ = 112 * MiB;
constexpr size_t WS_A2 = 152 * MiB;
constexpr size_t WS_X1 = 184 * MiB, WS_H2 = 216 * MiB;
constexpr size_t WS_Q = 112 * MiB;
constexpr size_t WS_END = 253 * MiB;
constexpr int CW_MODCNT = 1024;
constexpr int CW_BAR = 4096;

constexpr int RING_BYTES = 131072, LDSCTL_OFF = RING_BYTES, MISC_OFF = LDSCTL_OFF + 320, LDS_BYTES = 147456;

typedef float f32x16 __attribute__((ext_vector_type(16)));
typedef float f32x2 __attribute__((ext_vector_type(2)));
typedef unsigned u32x2 __attribute__((ext_vector_type(2)));
typedef unsigned u32x4 __attribute__((ext_vector_type(4)));
typedef __bf16 bf16x2_t __attribute__((ext_vector_type(2)));
struct Frame {
    LAS unsigned char* lds;
    int tid, lane, wave, vcu, G;
    const float *x, *c, *w_ada, *b_ada, *w_in, *sinks, *w_pool, *pool_scale, *w_out, *ln1_g, *ln1_b, *w_pq, *k1, *k2, *pu, *pv, *ln2_g, *ln2_b;
    float* out; unsigned char* ws;
};
__device__ __forceinline__ float wave_sum(float v) {
#pragma unroll
    for (int o = 1; o < 64; o <<= 1) v += __shfl_xor(v, o);
    return v;
}
__device__ __forceinline__ float bf_lo(unsigned u) { return __uint_as_float(u << 16); }
__device__ __forceinline__ float bf_hi(unsigned u) { return __uint_as_float(u & 0xffff0000u); }
__device__ __forceinline__ float bf2f(bf16 b) { return __uint_as_float((unsigned)b << 16); }

template <int MODE>
__device__ __forceinline__ void transpose_item(const float* W, int ldw, bf16* WT, int ldt, int k0, int n0, LAS float* scr, int lane, const LAS float* ksc = nullptr) {
    int nsrc = n0 + (lane & 31);
    if (MODE == 1 && nsrc < 640) { const int hd = nsrc >> 6, w = nsrc & 63; nsrc = hd * 64 + (w >> 1) + 32 * (w & 1); }
    float wv[32];
#pragma unroll
    for (int i = 0; i < 32; ++i) wv[i] = W[(size_t)(k0 + 2 * i + (lane >> 5)) * ldw + nsrc];
#pragma unroll
    for (int i = 0; i < 32; ++i) { const int kk = 2 * i + (lane >> 5); float w_ = wv[i]; if (MODE == 1) w_ *= ksc[k0 + kk]; scr[kk * 33 + (lane & 31)] = w_; }
    LDS_WAIT(); asm volatile("" ::: "memory");
    const int c = lane & 7;
#pragma unroll
    for (int j = 0; j < 4; ++j) { const int n = (lane >> 3) + 8 * j; const LAS float* s = scr + (8 * c) * 33 + n;
        v4u o; o.x = pk2(s[0 * 33], s[1 * 33]); o.y = pk2(s[2 * 33], s[3 * 33]); o.z = pk2(s[4 * 33], s[5 * 33]); o.w = pk2(s[6 * 33], s[7 * 33]);
        *(GAS v4u*)(WT + (size_t)(n0 + n) * ldt + k0 + 8 * c) = o; }
    LDS_WAIT(); asm volatile("" ::: "memory");
}
__device__ __forceinline__ void sincos_d(double a, float& s, float& c) {
    const double TWO_PI = 6.283185307179586476925, PI = 3.141592653589793238462643;
    double r = a - TWO_PI * rint(a / TWO_PI);
    double sg = 1.0;
    if (r > 0.5 * PI) { r = PI - r; sg = -1.0; } else if (r < -0.5 * PI) { r = -PI - r; sg = -1.0; }
    const double r2 = r * r;
    double sp = -1.0 / 121645100408832000.0;
    sp = sp * r2 + 1.0 / 355687428096000.0; sp = sp * r2 - 1.0 / 1307674368000.0; sp = sp * r2 + 1.0 / 6227020800.0; sp = sp * r2 - 1.0 / 39916800.0;
    sp = sp * r2 + 1.0 / 362880.0; sp = sp * r2 - 1.0 / 5040.0; sp = sp * r2 + 1.0 / 120.0; sp = sp * r2 - 1.0 / 6.0; sp = sp * r2 + 1.0;
    double cp = 1.0 / 6402373705728000.0;
    cp = cp * r2 - 1.0 / 20922789888000.0; cp = cp * r2 + 1.0 / 87178291200.0; cp = cp * r2 - 1.0 / 479001600.0; cp = cp * r2 + 1.0 / 3628800.0;
    cp = cp * r2 - 1.0 / 40320.0; cp = cp * r2 + 1.0 / 720.0; cp = cp * r2 - 1.0 / 24.0; cp = cp * r2 + 0.5; cp = 1.0 - cp * r2;
    s = (float)(sp * r); c = (float)(sg * cp);
}
__device__ __forceinline__ void p1_win(Frame& F);
__device__ __forceinline__ void p0_prologue(Frame& F, int parts = 0xff) {
    LAS float* scr = (LAS float*)(F.lds + F.wave * 16384);
    const int gw = F.vcu * NWAVES + F.wave, NGW = F.G * NWAVES, lane = F.lane;
    if ((parts & 1) && F.vcu < 96) { const int col = F.vcu * 64 + lane; float a0 = 0.f, a1 = 0.f;
        LAS float* sl = (LAS float*)(F.lds + F.wave * 16384 + 8448);
#pragma unroll
        for (int q = 0; q < 2; ++q) { const int k = F.wave * 128 + 64 * q + lane; const float c0 = F.c[k], c1 = F.c[DM + k];
            sl[64 * q + lane] = c0 / (1.f + __expf(-c0)); sl[128 + 64 * q + lane] = c1 / (1.f + __expf(-c1)); }
        LDS_WAIT(); asm volatile("" ::: "memory");
#pragma unroll 1
        for (int kb = 0; kb < 128; kb += 64) { float w[64];
#pragma unroll
            for (int u = 0; u < 64; ++u) w[u] = F.w_ada[(size_t)(F.wave * 128 + kb + u) * 6144 + col];
#pragma unroll
            for (int u = 0; u < 64; ++u) { a0 += sl[kb + u] * w[u]; a1 += sl[128 + kb + u] * w[u]; } }
        LAS float* red = (LAS float*)(F.lds + F.wave * 16384 + 12288); red[lane] = a0; red[64 + lane] = a1;
        __syncthreads();
        if (F.tid < 128) { const int bb = F.tid >> 6, l = F.tid & 63; float sacc = F.b_ada[F.vcu * 64 + l];
#pragma unroll
            for (int w = 0; w < 8; ++w) sacc += ((const LAS float*)(F.lds + w * 16384 + 12288))[bb * 64 + l];
            ((float*)(F.ws + WS_MOD))[bb * 6144 + F.vcu * 64 + l] = sacc; }
        asm volatile("s_waitcnt vmcnt(0)" ::: "memory"); __syncthreads();
        if (F.tid == 0) { __builtin_amdgcn_fence(__ATOMIC_RELEASE, "agent"); asm volatile("s_waitcnt vmcnt(0)" ::: "memory");
            __hip_atomic_fetch_add((unsigned*)(F.ws + WS_CTL) + CW_MODCNT, 1u, __ATOMIC_RELAXED, __HIP_MEMORY_SCOPE_AGENT); } }
    if (parts & 2) { float* rope = (float*)(F.ws + WS_ROPE);
      for (int e = gw * 64 + lane; e < SEQ * 32; e += NGW * 64) { const int pos = e >> 5, i = e & 31;
          const float freq = powf(10000.0f, -(float)i / 32.0f); const float ang = (float)pos * freq; float s, c; sincos_d((double)ang, s, c);
          rope[2 * e] = c; rope[2 * e + 1] = s; } }
    if (parts & 4) { constexpr int I_PQ = 16 * 64, I_OUT = 8 * 32;
      for (int it = NGW - 1 - gw; it < I_PQ + I_OUT; it += NGW) { int r = it;
          if (r < I_PQ) { transpose_item<0>(F.w_pq, NQD, (bf16*)(F.ws + WS_WPQ), DM, 64 * (r / 64), 32 * (r % 64), scr, lane); continue; } r -= I_PQ;
          transpose_item<0>(F.w_out, DM, (bf16*)(F.ws + WS_WOUT), DM, 64 * (r / 32), 32 * (r % 32), scr, lane); } }
    if (parts & 8) { bf16* wout_t = (bf16*)(F.ws + WS_WOUT);
      for (int it = gw; it < 4 * 2 * 128; it += NGW) { const int g = it >> 8, ch = (it >> 7) & 1, n0 = (it & 127) * 8, cidx = ch * 64 + lane;
          const float* wo = F.w_out + (size_t)(512 + g * 128) * DM + n0; const float* ps = F.pool_scale + g * 128;
#pragma unroll
          for (int i = 0; i < 4; ++i) { const int f4 = lane + 64 * i, e = f4 >> 1, hf = f4 & 1; const f32x4 o = *(const f32x4*)(wo + (size_t)e * DM + 4 * hf) * ps[e]; *(LAS f32x4*)(scr + e * 8 + 4 * hf) = o; }
          float acc[8];
#pragma unroll
          for (int i = 0; i < 8; ++i) acc[i] = 0.f;
          const float* wp = F.w_pool + ((size_t)(g * 128 + cidx)) * 128;
          LDS_WAIT(); asm volatile("" ::: "memory");
#pragma unroll 1
          for (int e0 = 0; e0 < 128; e0 += 64) { f32x4 wv[16];
#pragma unroll
              for (int q = 0; q < 16; ++q) wv[q] = *(const f32x4*)(wp + e0 + 4 * q);
#pragma unroll
              for (int q = 0; q < 16; ++q)
#pragma unroll
                  for (int ee = 0; ee < 4; ++ee) { const float w = wv[q][ee]; const f32x4 o0 = *(const LAS f32x4*)(scr + (e0 + 4 * q + ee) * 8), o1 = *(const LAS f32x4*)(scr + (e0 + 4 * q + ee) * 8 + 4);
                      acc[0] += w * o0[0]; acc[1] += w * o0[1]; acc[2] += w * o0[2]; acc[3] += w * o0[3]; acc[4] += w * o1[0]; acc[5] += w * o1[1]; acc[6] += w * o1[2]; acc[7] += w * o1[3]; } }
#pragma unroll
          for (int i = 0; i < 8; ++i) wout_t[(size_t)(n0 + i) * DM + 512 + g * 128 + cidx] = (bf16)f2bf(acc[i]);
          LDS_WAIT(); asm volatile("" ::: "memory"); } }
    if (parts & 16) { bf16* k1b = (bf16*)(F.ws + WS_K1); bf16* k2b = (bf16*)(F.ws + WS_K2);
      for (int e = gw * 64 + lane; e < 128 * 128; e += NGW * 64) { k1b[e] = (bf16)f2bf(F.k1[e]); k2b[e] = (bf16)f2bf(F.k2[e]); } }
    if (parts & 32) { bf16* xn = (bf16*)(F.ws + WS_XN); const int rpw = TT / NGW;
      for (int m = gw * rpw; m < gw * rpw + rpw; m += 4) { f32x4 v[4][4];
#pragma unroll
          for (int q = 0; q < 4; ++q)
#pragma unroll
              for (int j = 0; j < 4; ++j) v[q][j] = *(const f32x4*)(F.x + (size_t)(m + q) * DM + 256 * j + 4 * lane);
#pragma unroll
          for (int q = 0; q < 4; ++q)
#pragma unroll
              for (int j = 0; j < 4; ++j) { u32x2 o; o.x = pk2(v[q][j][0], v[q][j][1]); o.y = pk2(v[q][j][2], v[q][j][3]); *(u32x2*)(xn + (size_t)(m + q) * DM + 256 * j + 4 * lane) = o; } } }
    if (parts & 64) {
        __syncthreads();
        if (F.tid == 0) { unsigned sp = 0; const unsigned* cnt = (const unsigned*)(F.ws + WS_CTL) + CW_MODCNT;
            while (__hip_atomic_load(cnt, __ATOMIC_RELAXED, __HIP_MEMORY_SCOPE_AGENT) < 96u) { __builtin_amdgcn_s_sleep(2); if (++sp > (1u << 22)) break; }
            __builtin_amdgcn_fence(__ATOMIC_ACQUIRE, "agent"); asm volatile("s_waitcnt vmcnt(0)" ::: "memory"); }
        __syncthreads();
        p1_win(F);
    }
}
__device__ __forceinline__ void p2_tables(Frame& F, int cw, int ncw) {
    const int lane = F.lane; float* su = (float*)(F.ws + WS_SU); float* sv = (float*)(F.ws + WS_SV);
    const int per = (2 * NEXP + ncw - 1) / ncw, r0 = cw * per, r1 = (r0 + per) < 2 * NEXP ? (r0 + per) : 2 * NEXP;
    for (int it0 = r0; it0 < r1; it0 += 4) {
        f32x4 v[4][4]; float am[4];
#pragma unroll
        for (int q = 0; q < 4; ++q) { const int it = (it0 + q < r1) ? it0 + q : r1 - 1; const int tb = it >= NEXP, e = it - tb * NEXP; const float* src = (tb ? F.pv : F.pu) + (size_t)e * DM;
#pragma unroll
            for (int j = 0; j < 4; ++j) v[q][j] = *(const f32x4*)(src + 256 * j + 4 * lane); }
#pragma unroll
        for (int q = 0; q < 4; ++q) { float a = 0.f;
#pragma unroll
            for (int j = 0; j < 4; ++j) a = fmaxf(a, fmaxf(fmaxf(fabsf(v[q][j][0]), fabsf(v[q][j][1])), fmaxf(fabsf(v[q][j][2]), fabsf(v[q][j][3])))); am[q] = a; }
#pragma unroll
        for (int o = 1; o < 64; o <<= 1) {
#pragma unroll
            for (int q = 0; q < 4; ++q) am[q] = fmaxf(am[q], __shfl_xor(am[q], o)); }
#pragma unroll
        for (int q = 0; q < 4; ++q) { const int it = (it0 + q < r1) ? it0 + q : r1 - 1; const int tb = it >= NEXP, e = it - tb * NEXP; float a = am[q]; if (a == 0.f) a = 1.f;
            unsigned w[4];
            if (!tb) { const float inv = 127.0f / a;
#pragma unroll
                for (int j = 0; j < 4; ++j) { const int q0 = (int)rintf(v[q][j][0] * inv), q1 = (int)rintf(v[q][j][1] * inv), q2 = (int)rintf(v[q][j][2] * inv), q3 = (int)rintf(v[q][j][3] * inv);
                    w[j] = (unsigned)(q0 & 255) | ((unsigned)(q1 & 255) << 8) | ((unsigned)(q2 & 255) << 16) | ((unsigned)(q3 & 255) << 24); }
                *(v4u*)(F.ws + WS_U + (size_t)e * DM + 16 * lane) = (v4u){w[0], w[1], w[2], w[3]}; if (lane == 0) su[e] = a * (1.0f / 127.0f);
            } else { const float inv = 256.0f / a;
#pragma unroll
                for (int j = 0; j < 4; ++j) { int pk = __builtin_amdgcn_cvt_pk_bf8_f32(v[q][j][0] * inv, v[q][j][1] * inv, 0, false); pk = __builtin_amdgcn_cvt_pk_bf8_f32(v[q][j][2] * inv, v[q][j][3] * inv, pk, true); w[j] = (unsigned)pk; }
                *(v4u*)(F.ws + WS_V + (size_t)e * DM + 16 * lane) = (v4u){w[0], w[1], w[2], w[3]}; if (lane == 0) sv[e] = a * (1.0f / 256.0f); } } }
}
__device__ __forceinline__ void p1_win(Frame& F) {
    const float* mod = (const float*)(F.ws + WS_MOD);
    LAS float* sc = (LAS float*)F.lds; LAS float* sh = sc + 2048;
    for (int i = F.tid; i < 2048; i += NTHREADS) { const int b = i >> 10, k = i & 1023; sc[i] = 1.f + mod[b * 6144 + 1024 + k]; sh[i] = mod[b * 6144 + k]; }
    __syncthreads();
    const int lane = F.lane;
    if (F.vcu < 40) { const int b = F.vcu / 20, n = (F.vcu % 20) * 64 + lane; int nsrc = n; if (n < 640) { const int hd = n >> 6, w = n & 63; nsrc = hd * 64 + (w >> 1) + 32 * (w & 1); }
        float a = 0.f;
#pragma unroll 1
        for (int kb = 0; kb < 128; kb += 64) { float w[64];
#pragma unroll
            for (int u = 0; u < 64; ++u) w[u] = F.w_in[(size_t)(F.wave * 128 + kb + u) * NIN + nsrc];
#pragma unroll
            for (int u = 0; u < 64; ++u) a += sh[b * 1024 + F.wave * 128 + kb + u] * w[u]; }
        LAS float* red = (LAS float*)(F.lds + 16384); red[F.wave * 64 + lane] = a;
        __syncthreads();
        if (F.tid < 64) { float sacc = 0.f;
#pragma unroll
            for (int w = 0; w < 8; ++w) sacc += red[w * 64 + F.tid];
            ((float*)(F.ws + WS_BIAS))[b * NIN + (F.vcu % 20) * 64 + F.tid] = sacc; } }
    LAS float* scr = (LAS float*)(F.lds + 32768 + F.wave * 8448);
    const int gw = F.vcu * NWAVES + F.wave, NGW = F.G * NWAVES;
    for (int it = gw; it < 2 * 640; it += NGW) { const int b = it / 640, r = it % 640;
        transpose_item<1>(F.w_in, NIN, (bf16*)(F.ws + WS_WIN) + (size_t)b * NIN * DM, DM, 64 * (r / 40), 32 * (r % 40), scr, lane, sc + b * 1024); }
    __syncthreads();
}
constexpr int KS_STRIDE = 144, VT_STRIDE = 520, KS_BYTES = 256 * KS_STRIDE, VT_BYTES = 64 * VT_STRIDE;
__device__ __forceinline__ void p3_attn_unit(Frame& F, int unit) {
    const int b = unit >> 7, kvh = (unit >> 6) & 1, n = unit & 63;
    const bf16* proj = (const bf16*)(F.ws + WS_PROJ); bf16* a2 = (bf16*)(F.ws + WS_A2);
    LAS unsigned char* Ks = F.lds; LAS unsigned char* Vt = F.lds + KS_BYTES;
    const int tid = F.tid, lane = F.lane, wave = F.wave, r32 = lane & 31, h = lane >> 5;
    const size_t tok0 = (size_t)b * SEQ + (size_t)n * 128;
#pragma unroll
    for (int i = 0; i < 4; ++i) { const int ci = tid + NTHREADS * i, row = ci >> 3, ch = ci & 7; const bool valid = (n > 0) || (row >= 128);
        const size_t tk = tok0 - 128 + row;
        v4u kv = (v4u){0u, 0u, 0u, 0u}, vv = (v4u){0u, 0u, 0u, 0u};
        if (valid) { kv = *(const v4u*)(proj + tk * NIN + 512 + kvh * 64 + ch * 8); vv = *(const v4u*)(proj + tk * NIN + 640 + kvh * 64 + ch * 8); }
        *(LAS v4u*)(Ks + row * KS_STRIDE + ch * 16) = kv;
        LAS bf16* vt = (LAS bf16*)(Vt + (ch * 8) * VT_STRIDE) + row;
        vt[0 * (VT_STRIDE / 2)] = (bf16)(vv.x & 0xffff); vt[1 * (VT_STRIDE / 2)] = (bf16)(vv.x >> 16); vt[2 * (VT_STRIDE / 2)] = (bf16)(vv.y & 0xffff); vt[3 * (VT_STRIDE / 2)] = (bf16)(vv.y >> 16);
        vt[4 * (VT_STRIDE / 2)] = (bf16)(vv.z & 0xffff); vt[5 * (VT_STRIDE / 2)] = (bf16)(vv.z >> 16); vt[6 * (VT_STRIDE / 2)] = (bf16)(vv.w & 0xffff); vt[7 * (VT_STRIDE / 2)] = (bf16)(vv.w >> 16); }
    __syncthreads();
    const int g = wave >> 1, hq = kvh * 4 + g; const float sink2 = F.sinks[hq] * LOG2E;
#pragma unroll 1
    for (int qt = 0; qt < 2; ++qt) {
        const int qi0 = (wave & 1) * 64 + qt * 32, t0 = qi0 >> 5; const size_t tokq = tok0 + qi0 + r32;
        bf16x8 qf[4];
#pragma unroll
        for (int s = 0; s < 4; ++s) qf[s] = *(const bf16x8*)(proj + tokq * NIN + hq * 64 + 16 * s + 8 * h);
        f32x16 sc[5];
#pragma unroll
        for (int kt = 0; kt < 5; ++kt) { sc[kt] = (f32x16){};
#pragma unroll
            for (int s = 0; s < 4; ++s) { const bf16x8 kf = *(const LAS bf16x8*)(Ks + (32 * (t0 + kt) + r32) * KS_STRIDE + (16 * s + 8 * h) * 2);
                sc[kt] = __builtin_amdgcn_mfma_f32_32x32x16_bf16(kf, qf[s], sc[kt], 0, 0, 0); } }
        const int qi = qi0 + r32; float m = sink2;
#pragma unroll
        for (int kt = 0; kt < 5; ++kt)
#pragma unroll
            for (int r = 0; r < 16; ++r) { const int sidx = 32 * (t0 + kt) + (r & 3) + 8 * (r >> 2) + 4 * h; const int rel = qi + 128 - sidx;
                const bool ok = (rel >= 0) && (rel < 128) && ((n > 0) || (sidx >= 128));
                const float v = ok ? sc[kt][r] : -INFINITY; sc[kt][r] = v; m = fmaxf(m, v); }
        m = fmaxf(m, __shfl_xor(m, 32));
        float l = 0.f;
#pragma unroll
        for (int kt = 0; kt < 5; ++kt)
#pragma unroll
            for (int r = 0; r < 16; ++r) { const float p = __builtin_amdgcn_exp2f(sc[kt][r] - m); sc[kt][r] = p; l += p; }
        l += __shfl_xor(l, 32); l += __builtin_amdgcn_exp2f(sink2 - m);
        f32x16 o[2]; o[0] = (f32x16){}; o[1] = (f32x16){};
#pragma unroll
        for (int kt = 0; kt < 5; ++kt)
#pragma unroll
            for (int s2 = 0; s2 < 2; ++s2) {
                u32x4 pw; pw.x = pg8::cvt_pk_bf16(sc[kt][8 * s2 + 0], sc[kt][8 * s2 + 1]); pw.y = pg8::cvt_pk_bf16(sc[kt][8 * s2 + 2], sc[kt][8 * s2 + 3]);
                pw.z = pg8::cvt_pk_bf16(sc[kt][8 * s2 + 4], sc[kt][8 * s2 + 5]); pw.w = pg8::cvt_pk_bf16(sc[kt][8 * s2 + 6], sc[kt][8 * s2 + 7]);
                const bf16x8 pf = __builtin_bit_cast(bf16x8, pw);
#pragma unroll
                for (int dt = 0; dt < 2; ++dt) { const LAS unsigned char* vp = Vt + (dt * 32 + r32) * VT_STRIDE + (32 * (t0 + kt) + 16 * s2 + 4 * h) * 2;
                    const u32x2 lo = *(const LAS u32x2*)vp, hi = *(const LAS u32x2*)(vp + 16);
                    const u32x4 vw = (u32x4){lo.x, lo.y, hi.x, hi.y};
                    o[dt] = __builtin_amdgcn_mfma_f32_32x32x16_bf16(__builtin_bit_cast(bf16x8, vw), pf, o[dt], 0, 0, 0); } }
        const float inv = 1.0f / l;
#pragma unroll
        for (int dt = 0; dt < 2; ++dt)
#pragma unroll
            for (int rg = 0; rg < 4; ++rg) { const int d0 = dt * 32 + 8 * rg + 4 * h;
                u32x2 w; w.x = pg8::cvt_pk_bf16(o[dt][4 * rg + 0] * inv, o[dt][4 * rg + 1] * inv); w.y = pg8::cvt_pk_bf16(o[dt][4 * rg + 2] * inv, o[dt][4 * rg + 3] * inv);
                *(u32x2*)(a2 + tokq * DM + hq * 64 + d0) = w; }
    }
    __syncthreads();
}
__device__ __forceinline__ void p3_pool_unit(Frame& F, int unit) {
    const bf16* proj = (const bf16*)(F.ws + WS_PROJ); bf16* a2 = (bf16*)(F.ws + WS_A2);
    const int cp = F.tid & 255, half = F.tid >> 8, gi = cp >> 6, w = 2 << gi;
    const int tstart = unit * 64 + half * 32, s0 = tstart & (SEQ - 1);
    const bf16* pc = proj + 768 + 2 * cp;
    unsigned u[48];
#pragma unroll
    for (int i = 0; i < 48; ++i) { const int s = s0 - 16 + i; u[i] = (s >= 0) ? *(const unsigned*)(pc + (size_t)(tstart - 16 + i) * NIN) : 0u; }
    float w0 = 0.f, w1 = 0.f;
#pragma unroll
    for (int j = 1; j <= 16; ++j) if (j <= w) { w0 += bf_lo(u[16 - j]); w1 += bf_hi(u[16 - j]); }
#pragma unroll
    for (int i = 0; i < 32; ++i) { const int s = s0 + i; const float p0 = bf_lo(u[16 + i]), p1 = bf_hi(u[16 + i]);
        const unsigned uo = (w == 2) ? u[14 + i] : (w == 4) ? u[12 + i] : (w == 8) ? u[8 + i] : u[i];
        w0 += p0 - bf_lo(uo); w1 += p1 - bf_hi(uo);
        const float rc = 1.0f / (float)((s + 1) < w ? (s + 1) : w);
        *(unsigned*)(a2 + (size_t)(tstart + i) * DM + 512 + 2 * cp) = pk2(w0 * rc - p0, w1 * rc - p1); }
}
__device__ __forceinline__ void p5_ln1(Frame& F) {
    const float* mod = (const float*)(F.ws + WS_MOD); const bf16* mix = (const bf16*)(F.ws + WS_MIX); const bf16* xn = (const bf16*)(F.ws + WS_XN);
    bf16* x1 = (bf16*)(F.ws + WS_X1); bf16* h2 = (bf16*)(F.ws + WS_H2);
    const int gw = F.vcu * NWAVES + F.wave, lane = F.lane; const int rows_per_wave = TT / (F.G * NWAVES);
    const int row0 = gw * rows_per_wave, b = row0 >> 13;
    f32x4 g1[4], lg[4], lb[4], s2[4], h2s[4];
#pragma unroll
    for (int j = 0; j < 4; ++j) { const int d = 256 * j + 4 * lane;
        g1[j] = *(const f32x4*)(mod + b * 6144 + 2048 + d) + 1.0f; lg[j] = *(const f32x4*)(F.ln1_g + d); lb[j] = *(const f32x4*)(F.ln1_b + d);
        s2[j] = *(const f32x4*)(mod + b * 6144 + 4096 + d) + 1.0f; h2s[j] = *(const f32x4*)(mod + b * 6144 + 3072 + d); }
    for (int r = 0; r < rows_per_wave; r += 2) {
        u32x2 xw[2][4]; u32x2 mv[2][4];
#pragma unroll
        for (int q = 0; q < 2; ++q)
#pragma unroll
            for (int j = 0; j < 4; ++j) { const size_t m = (size_t)(row0 + r + q); const int d = 256 * j + 4 * lane; xw[q][j] = *(const u32x2*)(xn + m * DM + d); mv[q][j] = *(const u32x2*)(mix + m * DM + d); }
#pragma unroll
        for (int q = 0; q < 2; ++q) { const size_t m = (size_t)(row0 + r + q);
        f32x4 v[4]; float s = 0.f;
#pragma unroll
        for (int j = 0; j < 4; ++j) {
            const f32x4 mf = (f32x4){bf_lo(mv[q][j].x), bf_hi(mv[q][j].x), bf_lo(mv[q][j].y), bf_hi(mv[q][j].y)};
            const f32x4 xf = (f32x4){bf_lo(xw[q][j].x), bf_hi(xw[q][j].x), bf_lo(xw[q][j].y), bf_hi(xw[q][j].y)};
            v[j] = xf * DN_ALPHA + g1[j] * mf; s += (v[j][0] + v[j][1]) + (v[j][2] + v[j][3]); }
        const float mean = wave_sum(s) * (1.f / DM); float qq = 0.f;
#pragma unroll
        for (int j = 0; j < 4; ++j) { v[j] = v[j] - mean; qq += (v[j][0] * v[j][0] + v[j][1] * v[j][1]) + (v[j][2] * v[j][2] + v[j][3] * v[j][3]); }
        const float rstd = 1.0f / sqrtf(wave_sum(qq) * (1.f / DM) + LN_EPS);
#pragma unroll
        for (int j = 0; j < 4; ++j) { const int d = 256 * j + 4 * lane; const f32x4 y = v[j] * rstd * lg[j] + lb[j]; const f32x4 hh = y * s2[j] + h2s[j];
            u32x2 o; o.x = pk2(y[0], y[1]); o.y = pk2(y[2], y[3]); *(u32x2*)(x1 + m * DM + d) = o;
            u32x2 p; p.x = pk2(hh[0], hh[1]); p.y = pk2(hh[2], hh[3]); *(u32x2*)(h2 + m * DM + d) = p; } } }
}
constexpr int KR_STRIDE = 272, KR_BYTES = 128 * KR_STRIDE;
#define INS16(a, v) do { _Pragma("unroll") for (int _i = 15; _i >= 1; --_i) a[_i] = __builtin_amdgcn_fmed3f(a[_i - 1], a[_i], (v)); a[0] = fmaxf(a[0], (v)); } while (0)
#define BITONIC16(a) do { _Pragma("unroll") for (int _st = 8; _st >= 1; _st >>= 1) { _Pragma("unroll") for (int _i = 0; _i < 16; ++_i) if ((_i & _st) == 0) { const float _x = a[_i], _y = a[_i + _st]; a[_i] = fmaxf(_x, _y); a[_i + _st] = fminf(_x, _y); } } } while (0)
__device__ __forceinline__ void p7_route(Frame& F) {
    const bf16* q = (const bf16*)(F.ws + WS_Q); unsigned short* pe = (unsigned short*)(F.ws + WS_PE); float* pg = (float*)(F.ws + WS_PG);
    const int tid = F.tid, lane = F.lane, wave = F.wave, r32 = lane & 31, h = lane >> 5;
    { const bf16* k1b = (const bf16*)(F.ws + WS_K1);
      for (int ci = tid; ci < 2 * 128 * 16; ci += NTHREADS) { const int side = ci >> 11, row = (ci >> 4) & 127, ch = ci & 15;
          *(LAS v4u*)(F.lds + side * KR_BYTES + row * KR_STRIDE + ch * 16) = *(const v4u*)(k1b + (size_t)side * 16384 + row * 128 + ch * 8); } }
    __syncthreads();
    LAS unsigned char* scr = F.lds + 2 * KR_BYTES + wave * 2048 + lane * 32;
    pg8::StaticOrder S; S.init(TT, NQD, F.G, (int)blockIdx.x); pg8::Unit u;
    for (int ui = 0; S.next(ui, u); ++ui) {
        const int head = u.pn; const size_t tok = (size_t)u.pm * 256 + wave * 32 + r32;
        float vv[2][16];
#pragma unroll
        for (int side = 0; side < 2; ++side) {
            const bf16* qb = q + tok * NQD + head * 256 + side * 128;
            bf16x8 qf[8];
#pragma unroll
            for (int s = 0; s < 8; ++s) qf[s] = *(const bf16x8*)(qb + 16 * s + 8 * h);
            float a[16];
#pragma unroll
            for (int i = 0; i < 16; ++i) a[i] = -INFINITY;
#pragma unroll
            for (int kt = 0; kt < 4; ++kt) { f32x16 acc = (f32x16){};
#pragma unroll
                for (int s = 0; s < 8; ++s) { const bf16x8 kf = *(const LAS bf16x8*)(F.lds + side * KR_BYTES + (32 * kt + r32) * KR_STRIDE + (16 * s + 8 * h) * 2);
                    acc = __builtin_amdgcn_mfma_f32_32x32x16_bf16(kf, qf[s], acc, 0, 0, 0); }
#pragma unroll
                for (int r = 0; r < 16; ++r) { const unsigned key = (unsigned)(32 * kt + (r & 3) + 8 * (r >> 2)) | ((unsigned)h << 2);
                    const float v = __uint_as_float((__float_as_uint(acc[r]) & 0xFFFFFF80u) | key); INS16(a, v); }
                __builtin_amdgcn_sched_barrier(0); }
            float c[16];
#pragma unroll
            for (int i = 0; i < 16; ++i) c[i] = __shfl_xor(a[15 - i], 32);
#pragma unroll
            for (int i = 0; i < 16; ++i) c[i] = fmaxf(a[i], c[i]);
            BITONIC16(c);
#pragma unroll
            for (int i = 0; i < 16; ++i) vv[side][i] = c[i];
        }
        { v4u w1, w2;
#define PK4(L, b) ((__float_as_uint(L[b]) & 0x7Fu) | ((__float_as_uint(L[b + 1]) & 0x7Fu) << 8) | ((__float_as_uint(L[b + 2]) & 0x7Fu) << 16) | ((__float_as_uint(L[b + 3]) & 0x7Fu) << 24))
          w1.x = PK4(vv[0], 0); w1.y = PK4(vv[0], 4); w1.z = PK4(vv[0], 8); w1.w = PK4(vv[0], 12);
          w2.x = PK4(vv[1], 0); w2.y = PK4(vv[1], 4); w2.z = PK4(vv[1], 8); w2.w = PK4(vv[1], 12);
#undef PK4
          *(LAS v4u*)scr = w1; *(LAS v4u*)(scr + 16) = w2; }
        float c1[16], c2[16], top[16];
#pragma unroll
        for (int i = 0; i < 16; ++i) { c1[i] = __uint_as_float(__float_as_uint(vv[0][i]) & 0xFFFFFF80u); c2[i] = __uint_as_float(__float_as_uint(vv[1][i]) & 0xFFFFFF80u); top[i] = -INFINITY; }
#pragma unroll
        for (int ia = 0; ia < 16; ++ia)
#pragma unroll
            for (int ib = 0; ib < 16; ++ib) if ((ia + 1) * (ib + 1) <= 16) {
                const float sm = c1[ia] + c2[ib]; const float v = __uint_as_float((__float_as_uint(sm) & 0xFFFFFF00u) | (unsigned)(ia * 16 + ib)); INS16(top, v); }
        float ex[16], den = 0.f;
#pragma unroll
        for (int i = 0; i < 16; ++i) { ex[i] = __expf(top[i] - top[0]); den += ex[i]; }
        const float rden = 1.0f / den;
        LDS_WAIT();
        unsigned short ev[8]; float gv[8];
#pragma unroll
        for (int j = 0; j < 8; ++j) { const float t = h ? top[8 + j] : top[j]; const float e = h ? ex[8 + j] : ex[j];
            const unsigned code = __float_as_uint(t) & 0xFFu; const unsigned i1 = *(const LAS unsigned char*)(scr + (code >> 4)), i2 = *(const LAS unsigned char*)(scr + 16 + (code & 15u));
            ev[j] = (unsigned short)(i1 * 128u + i2); gv[j] = e * rden; }
        v4u ew; ew.x = ev[0] | ((unsigned)ev[1] << 16); ew.y = ev[2] | ((unsigned)ev[3] << 16); ew.z = ev[4] | ((unsigned)ev[5] << 16); ew.w = ev[6] | ((unsigned)ev[7] << 16);
        *(v4u*)(pe + tok * 128 + head * 16 + 8 * h) = ew;
        *(f32x4*)(pg + tok * 128 + head * 16 + 8 * h) = (f32x4){gv[0], gv[1], gv[2], gv[3]};
        *(f32x4*)(pg + tok * 128 + head * 16 + 8 * h + 4) = (f32x4){gv[4], gv[5], gv[6], gv[7]};
        LDS_WAIT();
    }
    __syncthreads();
}
__device__ __forceinline__ float gelu_erf(float x) { return 0.5f * x * (1.0f + erff(x * 0.70710678118654752f)); }
#ifndef NPART
#define NPART 16
#endif
constexpr int TPW = 8, NSWEEP = 1;
constexpr int PSHIFT = (NPART == 32) ? 9 : (NPART == 8) ? 11 : (NPART == 16) ? 10 : (NPART == 4) ? 12 : (NPART == 2) ? 13 : 14;
__device__ __forceinline__ void p8_peer(Frame& F, unsigned emask = 0xffffu, int skip = 0) {
    const float* mod = (const float*)(F.ws + WS_MOD);
    const bf16* x1 = (const bf16*)(F.ws + WS_X1); const bf16* h2 = (const bf16*)(F.ws + WS_H2);
    const unsigned char* ut = F.ws + WS_U; const unsigned char* vt = F.ws + WS_V;
    const float* su = (const float*)(F.ws + WS_SU); const float* sv = (const float*)(F.ws + WS_SV);
    const unsigned* pe = (const unsigned*)(F.ws + WS_PE); const float* pg = (const float*)(F.ws + WS_PG);
    const int gw = F.vcu * NWAVES + F.wave;
    const int b3 = (F.lane >> 3) & 1;
    LAS unsigned* scr = (LAS unsigned*)(F.lds + F.wave * 1024);
#pragma unroll 1
    for (int sweep = 0; sweep < NSWEEP; ++sweep) {
    const int t0 = (gw * NSWEEP + sweep) * TPW, b = t0 >> 13;
    int lane = F.lane; asm volatile("" : "+v"(lane));
    unsigned hq[TPW][4]; float shs[TPW]; unsigned es[TPW]; float gs[TPW][2]; int offv[TPW];
#pragma unroll
    for (int tt = 0; tt < TPW; ++tt) { const size_t t = (size_t)(t0 + tt);
        float hv[16]; float am = 0.f;
#pragma unroll
        for (int j = 0; j < 4; ++j) { const u32x2 v = *(const u32x2*)(h2 + t * DM + 256 * j + 4 * lane); hv[4 * j] = bf_lo(v.x); hv[4 * j + 1] = bf_hi(v.x); hv[4 * j + 2] = bf_lo(v.y); hv[4 * j + 3] = bf_hi(v.y); }
#pragma unroll
        for (int i = 0; i < 16; ++i) am = fmaxf(am, fabsf(hv[i]));
#pragma unroll
        for (int o = 1; o < 64; o <<= 1) am = fmaxf(am, __shfl_xor(am, o));
        if (am == 0.f) am = 1.f;
        const float inv = 127.0f / am; shs[tt] = am * (1.0f / 127.0f);
#pragma unroll
        for (int j = 0; j < 4; ++j) { const int q0 = (int)rintf(hv[4 * j] * inv), q1 = (int)rintf(hv[4 * j + 1] * inv), q2 = (int)rintf(hv[4 * j + 2] * inv), q3 = (int)rintf(hv[4 * j + 3] * inv);
            hq[tt][j] = (unsigned)(q0 & 255) | ((unsigned)(q1 & 255) << 8) | ((unsigned)(q2 & 255) << 16) | ((unsigned)(q3 & 255) << 24); }
        const unsigned pe2 = pe[t * 64 + lane]; const f32x2 pg2 = *(const f32x2*)(pg + t * 128 + 2 * lane);
        const unsigned elo = pe2 & emask, ehi = (pe2 >> 16) & emask; const int plo = (int)(elo >> PSHIFT), phi = (int)(ehi >> PSHIFT);
        int base = 0, poslo = 0, poshi = 0, ov = 0;
#pragma unroll
        for (int r = 0; r < NPART; ++r) { const unsigned long long mlo = __ballot(plo == r), mhi = __ballot(phi == r);
            const int clo = __popcll(mlo), chi = __popcll(mhi);
            const int rlo = (int)__builtin_amdgcn_mbcnt_hi((unsigned)(mlo >> 32), __builtin_amdgcn_mbcnt_lo((unsigned)mlo, 0u));
            const int rhi = (int)__builtin_amdgcn_mbcnt_hi((unsigned)(mhi >> 32), __builtin_amdgcn_mbcnt_lo((unsigned)mhi, 0u));
            if (plo == r) poslo = base + rlo; if (phi == r) poshi = base + clo + rhi;
            base += clo + chi; if (lane == r + 1) ov = base; }
        offv[tt] = ov;
        scr[2 * poslo] = elo; scr[2 * poslo + 1] = __float_as_uint(pg2.x); scr[2 * poshi] = ehi; scr[2 * poshi + 1] = __float_as_uint(pg2.y);
        LDS_WAIT();
        const u32x4 sr = *(const LAS u32x4*)(scr + 4 * lane);
        es[tt] = sr.x | (sr.z << 16); gs[tt][0] = __uint_as_float(sr.y); gs[tt][1] = __uint_as_float(sr.w);
        LDS_WAIT();
    }
#define P8_ISSUE(buf, tbl, tok, bb) do { _Pragma("unroll") for (int k2 = 0; k2 < 4; ++k2) { const unsigned ew = (unsigned)__builtin_amdgcn_readlane((int)es[tok], 4 * (bb) + k2); \
        buf[2 * k2] = *(const u32x4*)((tbl) + (size_t)(ew & 0xffffu) * DM + 16 * lane); buf[2 * k2 + 1] = *(const u32x4*)((tbl) + (size_t)(ew >> 16) * DM + 16 * lane); } } while (0)
    int hidv[TPW][2];
#pragma unroll
    for (int tt = 0; tt < TPW; ++tt) { hidv[tt][0] = 0; hidv[tt][1] = 0; }
    {
        u32x4 bufA[8], bufB[8];
#define P8_DOTS(buf, tok, bb) do { int p[8]; \
            _Pragma("unroll") for (int kk = 0; kk < 8; ++kk) { int s_ = __builtin_amdgcn_sdot4((int)buf[kk].x, (int)hq[tok][0], 0, false); s_ = __builtin_amdgcn_sdot4((int)buf[kk].y, (int)hq[tok][1], s_, false); \
                s_ = __builtin_amdgcn_sdot4((int)buf[kk].z, (int)hq[tok][2], s_, false); s_ = __builtin_amdgcn_sdot4((int)buf[kk].w, (int)hq[tok][3], s_, false); p[kk] = s_; } \
            int q4[4], q2[2], q1; \
            _Pragma("unroll") for (int i = 0; i < 4; ++i) { auto r_ = __builtin_amdgcn_permlane32_swap((unsigned)p[i], (unsigned)p[i + 4], false, false); q4[i] = (int)(r_[0] + r_[1]); } \
            _Pragma("unroll") for (int i = 0; i < 2; ++i) { auto r_ = __builtin_amdgcn_permlane16_swap((unsigned)q4[i], (unsigned)q4[i + 2], false, false); q2[i] = (int)(r_[0] + r_[1]); } \
            { const int keep = b3 ? q2[1] : q2[0], send = b3 ? q2[0] : q2[1]; q1 = keep + __builtin_amdgcn_update_dpp(0, send, 0x128, 0xF, 0xF, true); } \
            q1 += __builtin_amdgcn_update_dpp(0, q1, 0xB1, 0xF, 0xF, true); q1 += __builtin_amdgcn_update_dpp(0, q1, 0x4E, 0xF, 0xF, true); q1 += __builtin_amdgcn_update_dpp(0, q1, 0x141, 0xF, 0xF, true); \
            const int i2_ = (lane & 3) * 2; const int v0_ = __builtin_amdgcn_ds_bpermute(i2_ << 5, q1), v1_ = __builtin_amdgcn_ds_bpermute((i2_ + 1) << 5, q1); \
            if ((lane >> 2) == (bb)) { hidv[tok][0] = v0_; hidv[tok][1] = v1_; } } while (0)
        int cur[TPW];
#pragma unroll
        for (int tt = 0; tt < TPW; ++tt) cur[tt] = 0;
#define P8_STEP_A(tt_, bufX, bufY, r_) { const int end_ = __builtin_amdgcn_readlane(offv[tt_], (r_) + 1); \
            { constexpr int tn_ = ((tt_) + 1) % TPW; const int rn_ = (r_) + ((tt_) + 1) / TPW; \
              if (rn_ < NPART && cur[tn_] < __builtin_amdgcn_readlane(offv[tn_], rn_ + 1)) P8_ISSUE(bufY, ut, tn_, cur[tn_] >> 3); } \
            __builtin_amdgcn_sched_barrier(0); \
            bool pre_ = true; \
            while (cur[tt_] < end_) { if (!pre_) P8_ISSUE(bufX, ut, tt_, cur[tt_] >> 3); pre_ = false; P8_DOTS(bufX, tt_, cur[tt_] >> 3); cur[tt_] += 8; } }
        if ((skip & 1) == 0) {
        if (0 < __builtin_amdgcn_readlane(offv[0], 1)) P8_ISSUE(bufA, ut, 0, 0);
#pragma unroll 1
        for (int r = 0; r < NPART; ++r) {
            P8_STEP_A(0, bufA, bufB, r) P8_STEP_A(1, bufB, bufA, r) P8_STEP_A(2, bufA, bufB, r) P8_STEP_A(3, bufB, bufA, r)
            P8_STEP_A(4, bufA, bufB, r) P8_STEP_A(5, bufB, bufA, r) P8_STEP_A(6, bufA, bufB, r) P8_STEP_A(7, bufB, bufA, r)
        } }
#undef P8_STEP_A
#undef P8_DOTS
    }
#pragma unroll
    for (int tt = 0; tt < TPW; ++tt) { const unsigned e0 = es[tt] & 0xffffu, e1 = es[tt] >> 16;
        const float su0 = su[e0], su1 = su[e1], sv0 = sv[e0], sv1 = sv[e1];
        gs[tt][0] = gelu_erf((float)hidv[tt][0] * (shs[tt] * su0)) * gs[tt][0] * sv0;
        gs[tt][1] = gelu_erf((float)hidv[tt][1] * (shs[tt] * su1)) * gs[tt][1] * sv1; }
    typedef _Float16 f16x2 __attribute__((ext_vector_type(2)));
    f16x2 yh[TPW][8];
#pragma unroll
    for (int tt = 0; tt < TPW; ++tt) {
#pragma unroll
        for (int i = 0; i < 8; ++i) yh[tt][i] = (f16x2){(_Float16)0.f, (_Float16)0.f}; }
    {
        u32x4 bufA[8], bufB[8];
#define BF8ACC(tok, a, word, j) { const unsigned _w = (word); const unsigned _h02 = __builtin_amdgcn_perm(0u, _w, 0x020c000cu), _h13 = __builtin_amdgcn_perm(0u, _w, 0x030c010cu); \
                          yh[tok][2 * (j)] = __builtin_elementwise_fma(__builtin_bit_cast(f16x2, _h02), (a), yh[tok][2 * (j)]); yh[tok][2 * (j) + 1] = __builtin_elementwise_fma(__builtin_bit_cast(f16x2, _h13), (a), yh[tok][2 * (j) + 1]); }
#define P8_ACC(buf, tok, bb) do { _Pragma("unroll") for (int k2 = 0; k2 < 4; ++k2) { \
            const _Float16 h0_ = (_Float16)__int_as_float(__builtin_amdgcn_readlane(__float_as_int(gs[tok][0]), 4 * (bb) + k2)), h1_ = (_Float16)__int_as_float(__builtin_amdgcn_readlane(__float_as_int(gs[tok][1]), 4 * (bb) + k2)); \
            const f16x2 a0_ = (f16x2){h0_, h0_}, a1_ = (f16x2){h1_, h1_}; \
            BF8ACC(tok, a0_, buf[2 * k2].x, 0) BF8ACC(tok, a0_, buf[2 * k2].y, 1) BF8ACC(tok, a0_, buf[2 * k2].z, 2) BF8ACC(tok, a0_, buf[2 * k2].w, 3) \
            BF8ACC(tok, a1_, buf[2 * k2 + 1].x, 0) BF8ACC(tok, a1_, buf[2 * k2 + 1].y, 1) BF8ACC(tok, a1_, buf[2 * k2 + 1].z, 2) BF8ACC(tok, a1_, buf[2 * k2 + 1].w, 3) __builtin_amdgcn_sched_barrier(0); } } while (0)
        int cur[TPW];
#pragma unroll
        for (int tt = 0; tt < TPW; ++tt) cur[tt] = 0;
#define P8_STEP_B(tt_, bufX, bufY, r_) { const int end_ = __builtin_amdgcn_readlane(offv[tt_], (r_) + 1); \
            { constexpr int tn_ = ((tt_) + 1) % TPW; const int rn_ = (r_) + ((tt_) + 1) / TPW; \
              if (rn_ < NPART && cur[tn_] < __builtin_amdgcn_readlane(offv[tn_], rn_ + 1)) P8_ISSUE(bufY, vt, tn_, cur[tn_] >> 3); } \
            __builtin_amdgcn_sched_barrier(0); \
            bool pre_ = true; \
            while (cur[tt_] < end_) { if (!pre_) P8_ISSUE(bufX, vt, tt_, cur[tt_] >> 3); pre_ = false; P8_ACC(bufX, tt_, cur[tt_] >> 3); cur[tt_] += 8; } }
        if ((skip & 2) == 0) {
        if (0 < __builtin_amdgcn_readlane(offv[0], 1)) P8_ISSUE(bufA, vt, 0, 0);
#pragma unroll 1
        for (int r = 0; r < NPART; ++r) {
            P8_STEP_B(0, bufA, bufB, r) P8_STEP_B(1, bufB, bufA, r) P8_STEP_B(2, bufA, bufB, r) P8_STEP_B(3, bufB, bufA, r)
            P8_STEP_B(4, bufA, bufB, r) P8_STEP_B(5, bufB, bufA, r) P8_STEP_B(6, bufA, bufB, r) P8_STEP_B(7, bufB, bufA, r)
        } }
#undef P8_STEP_B
#undef P8_ACC
#undef BF8ACC
    }
#undef P8_ISSUE
#pragma unroll
    for (int tt = 0; tt < TPW; ++tt) { const size_t t = (size_t)(t0 + tt);
        f32x4 v[4]; float s = 0.f;
#pragma unroll
        for (int j = 0; j < 4; ++j) { const int d = 256 * j + 4 * lane; const u32x2 xv = *(const u32x2*)(x1 + t * DM + d); const f32x4 g2 = *(const f32x4*)(mod + b * 6144 + 5120 + d) + 1.0f;
            const f32x4 xf = (f32x4){bf_lo(xv.x), bf_hi(xv.x), bf_lo(xv.y), bf_hi(xv.y)}; const f32x4 yy = (f32x4){(float)yh[tt][2 * j].x, (float)yh[tt][2 * j + 1].x, (float)yh[tt][2 * j].y, (float)yh[tt][2 * j + 1].y};
            v[j] = xf * DN_ALPHA + g2 * yy; s += (v[j][0] + v[j][1]) + (v[j][2] + v[j][3]); }
        const float mean = wave_sum(s) * (1.f / DM); float qq = 0.f;
#pragma unroll
        for (int j = 0; j < 4; ++j) { v[j] = v[j] - mean; qq += (v[j][0] * v[j][0] + v[j][1] * v[j][1]) + (v[j][2] * v[j][2] + v[j][3] * v[j][3]); }
        const float rstd = 1.0f / sqrtf(wave_sum(qq) * (1.f / DM) + LN_EPS);
#pragma unroll
        for (int j = 0; j < 4; ++j) { const int d = 256 * j + 4 * lane; const f32x4 lg = *(const f32x4*)(F.ln2_g + d), lb = *(const f32x4*)(F.ln2_b + d);
            *(f32x4*)(F.out + t * DM + d) = v[j] * rstd * lg + lb; } }
    }
}
#ifndef PROBE_PARTS
#define PROBE_PARTS 0xff
#endif
#ifndef MK_N_LAUNCHES
#define MK_N_LAUNCHES 1
#endif
constexpr int N_PHASES = 9;
struct Args { const float* in[18]; float* out; unsigned char* ws; int ph_lo, ph_hi, p0_parts, pad; };
__global__ void __launch_bounds__(NTHREADS, 2) fwd_kernel(Args args) {
    extern __shared__ __attribute__((aligned(16))) unsigned char lds[];
    Frame F;
    F.lds = (LAS unsigned char*)lds;
    F.tid = threadIdx.x; F.lane = F.tid & 63; F.wave = __builtin_amdgcn_readfirstlane(F.tid >> 6);
    F.G = gridDim.x; { const int bx = blockIdx.x; F.vcu = (F.G % 8 == 0) ? (bx % 8) * (F.G / 8) + bx / 8 : bx; }
    F.x = args.in[0]; F.c = args.in[1]; F.w_ada = args.in[2]; F.b_ada = args.in[3]; F.w_in = args.in[4]; F.sinks = args.in[5]; F.w_pool = args.in[6]; F.pool_scale = args.in[7];
    F.w_out = args.in[8]; F.ln1_g = args.in[9]; F.ln1_b = args.in[10]; F.w_pq = args.in[11]; F.k1 = args.in[12]; F.k2 = args.in[13]; F.pu = args.in[14]; F.pv = args.in[15];
    F.ln2_g = args.in[16]; F.ln2_b = args.in[17]; F.out = args.out; F.ws = args.ws;
    volatile LAS unsigned* MISC = (volatile LAS unsigned*)(F.lds + MISC_OFF);
    for (int u = F.tid; u < (LDS_BYTES - LDSCTL_OFF) / 4; u += NTHREADS) ((LAS unsigned*)(F.lds + LDSCTL_OFF))[u] = 0u;
    __syncthreads();
    const int lo = args.ph_lo, hi = args.ph_hi;
    XcdBarrier bar; bar.bar = (unsigned*)(F.ws + WS_CTL) + CW_BAR; bar.x = 0; bar.st = nullptr;
    if (hi - lo > 1) bar = xcd_barrier_post((unsigned*)(F.ws + WS_CTL) + CW_BAR, MISC + 8);
#ifndef PH_MASK
#define PH_MASK 0x1ff
#endif
#define IN(k) (((PH_MASK >> (k)) & 1) && lo <= (k) && (k) < hi)
#define SEAM(k) do { if (IN(k) && IN((k) + 1)) xcd_barrier(bar); } while (0)
#ifndef REP_MASK
#define REP_MASK 0
#endif
#ifndef REP_CNT
#define REP_CNT 4
#endif
#define REPS(k) (((REP_MASK >> (k)) & 1) * REP_CNT)
#define PHASE_NS(k, ...) if (IN(k)) { _Pragma("unroll 1") for (int _r = 0; _r <= REPS(k); ++_r) { __VA_ARGS__; if (_r < REPS(k)) xcd_barrier(bar); } }
#define PHASE(k, ...) if (IN(k)) { _Pragma("unroll 1") for (int _r = 0; _r <= REPS(k); ++_r) { __VA_ARGS__; if (_r < REPS(k)) xcd_barrier(bar); } } SEAM(k)
#ifndef P0_SUB
#define P0_SUB 0xff
#endif
    PHASE(0, p0_prologue(F, args.p0_parts));
    PHASE(2, { pg8::Gemm g{(const pg8::bf16_t*)(F.ws + WS_XN), (const pg8::bf16_t*)(F.ws + WS_WIN), TT, NIN, DM, 32, (size_t)NIN * DM * 2}; pg8::StaticOrder S; S.init(TT, NIN, F.G, (int)blockIdx.x);
            pg8::EpiRope E{(pg8::bf16_t*)(F.ws + WS_PROJ), NIN, (const float*)(F.ws + WS_ROPE), QSCALE, (const float*)(F.ws + WS_BIAS)};
            pg8::gemm_phase<pg8::EpiRope, pg8::StaticOrder, true, true>(F.lds, g, S, E);
            if ((int)blockIdx.x >= 320 - F.G) p2_tables(F, ((int)blockIdx.x - (320 - F.G)) * NWAVES + F.wave, (2 * F.G - 320) * NWAVES); });
    PHASE(3, { for (int u = F.vcu; u < 256; u += F.G) p3_attn_unit(F, u);
               for (int u = F.vcu; u < 256; u += F.G) p3_pool_unit(F, u); });
    PHASE(4, { pg8::Gemm g{(const pg8::bf16_t*)(F.ws + WS_A2), (const pg8::bf16_t*)(F.ws + WS_WOUT), TT, DM, DM, 1 << 30, 0}; pg8::StaticOrder S; S.init(TT, DM, F.G, (int)blockIdx.x);
            pg8::EpiPlain E{(pg8::bf16_t*)(F.ws + WS_MIX), DM};
            pg8::gemm_phase<pg8::EpiPlain, pg8::StaticOrder, true, true>(F.lds, g, S, E); });
    PHASE(5, p5_ln1(F));
    PHASE_NS(6, { pg8::Gemm g{(const pg8::bf16_t*)(F.ws + WS_H2), (const pg8::bf16_t*)(F.ws + WS_WPQ), TT, NQD, DM, 1 << 30, 0}; pg8::StaticOrder S; S.init(TT, NQD, F.G, (int)blockIdx.x);
            pg8::EpiPlain E{(pg8::bf16_t*)(F.ws + WS_Q), NQD};
            pg8::gemm_phase<pg8::EpiPlain, pg8::StaticOrder, true, true>(F.lds, g, S, E); });
    if (IN(6) && IN(7)) { asm volatile("s_waitcnt vmcnt(0)" ::: "memory"); __syncthreads(); }
    PHASE(7, p7_route(F));
#ifndef P8_FAKE
#define P8_FAKE 0xffffu
#endif
#ifndef P8_SKIP
#define P8_SKIP 0
#endif
    PHASE(8, p8_peer(F, _r == REPS(8) ? 0xffffu : P8_FAKE, _r == REPS(8) ? 0 : P8_SKIP));
#undef IN
#undef SEAM
}

extern "C" void kernel_launch(void* const* d_in, const int* in_sizes, int n_in, void* d_out, int out_size, void* d_ws, size_t ws_size, hipStream_t stream) {
    static int grid = 0;
    if (grid == 0) {
        if (n_in != 18 || out_size != TT * DM || ws_size < WS_END) { fprintf(stderr, "kernel_launch: unexpected shapes (n_in %d out %d ws %zu)\n", n_in, out_size, ws_size); grid = -1; return; }
        int dev = 0, cus = 0, per_cu = 0;
        if (hipGetDevice(&dev) != hipSuccess || hipDeviceGetAttribute(&cus, hipDeviceAttributeMultiprocessorCount, dev) != hipSuccess) { grid = -1; return; }
        if (hipFuncSetAttribute((const void*)fwd_kernel, hipFuncAttributeMaxDynamicSharedMemorySize, LDS_BYTES) != hipSuccess) { fprintf(stderr, "kernel_launch: hipFuncSetAttribute failed\n"); grid = -1; return; }
        if (hipOccupancyMaxActiveBlocksPerMultiprocessor(&per_cu, (const void*)fwd_kernel, NTHREADS, LDS_BYTES) != hipSuccess || per_cu < 1) { fprintf(stderr, "kernel_launch: occupancy query says %d blocks per CU\n", per_cu); }
        (void)hipGetLastError();
        grid = cus;
        if (grid != 256) fprintf(stderr, "kernel_launch: built for 256 CUs, got %d\n", grid);
    }
    if (grid < 0) return;
    (void)hipMemsetAsync((char*)d_ws + WS_CTL, 0, CTL_ZERO_BYTES, stream);
    Args a{};
    for (int i = 0; i < 18; ++i) a.in[i] = (const float*)d_in[i];
    a.out = (float*)d_out; a.ws = (unsigned char*)d_ws; a.p0_parts = 0xff;
#if MK_N_LAUNCHES == 1
    a.ph_lo = 0; a.ph_hi = N_PHASES;
    hipLaunchKernelGGL(fwd_kernel, dim3(grid), dim3(NTHREADS), LDS_BYTES, stream, a);
#ifdef PROBE_PHASE
    for (int i = 0; i < PROBE_N; ++i) { a.ph_lo = PROBE_PHASE; a.ph_hi = PROBE_PHASE + 1; a.p0_parts = PROBE_PARTS; hipLaunchKernelGGL(fwd_kernel, dim3(grid), dim3(NTHREADS), LDS_BYTES, stream, a); }
#endif
#else
    for (int p = 0; p < N_PHASES; ++p) { a.ph_lo = p; a.ph_hi = p + 1; hipLaunchKernelGGL(fwd_kernel, dim3(grid), dim3(NTHREADS), LDS_BYTES, stream, a); }
#endif
}
```

```cpp
#include <hip/hip_runtime.h>
#include <cstdio>
#include <cstdint>
#include <cmath>
namespace pg8 {
#define PG8_LAS __attribute__((address_space(3)))
typedef unsigned short bf16_t;
typedef short bf16x8 __attribute__((ext_vector_type(8)));
typedef float f32x4 __attribute__((ext_vector_type(4)));
typedef unsigned u32x4 __attribute__((ext_vector_type(4)));
constexpr int BM = 256, BK = 64, HALF = 128, HTB = HALF * BK * 2  , STAGE_BYTES = 8 * HTB, NXCD = 8, WGM = 8;

__host__ __device__ __forceinline__ int lds_byte(int r, int c) { const int st = (r >> 4) * 2 + (c >> 5), rr = r & 15, cc = c & 31, ob = rr * 64 + cc * 2; return st * 1024 + (ob ^ (((ob >> 9) & 1) << 5)); }
__host__ __device__ __forceinline__ void stage_rc(int b, int& R, int& C) { const int st = b / 1024, sb = b % 1024, swz = sb ^ (((sb >> 9) & 1) << 5); R = (st >> 1) * 16 + swz / 64; C = (st & 1) * 32 + (swz % 64) / 2; }
__host__ __device__ __forceinline__ int perm32(int rho) { const int n = rho >> 4, i = rho & 15; return 8 * (i >> 2) + 4 * n + (i & 3); }

struct Unit { int pm, pn; };
struct Gemm { const bf16_t* A; const bf16_t* Bt; int M, N, K; int bsplit; size_t bstride; };

struct StaticOrder {
    int nM, nN, nwg, G, c;
    __host__ __device__ void init(int M, int N, int G_, int c_) { nM = M / BM; nN = N / BM; nwg = nM * nN; G = G_; c = c_; }
    __host__ __device__ bool next(int i, Unit& u) const {
        const long L = (long)i * G + c; if (L >= nwg) return false;
        int wgid = (int)L; { const int q = nwg / NXCD, r = nwg % NXCD, xcd = wgid % NXCD, off = wgid / NXCD; wgid = (xcd < r ? xcd * (q + 1) : r * (q + 1) + (xcd - r) * q) + off; }
        const int nig = WGM * nN, gid = wgid / nig, fm = gid * WGM, gsz = (nM - fm) < WGM ? (nM - fm) : WGM;
        u.pm = fm + ((wgid % nig) % gsz); u.pn = (wgid % nig) / gsz; return true;
    }
    __device__ __forceinline__ void a_ready(const Unit&) const {}
    __device__ __forceinline__ void done(const Unit&) const {}
};

__device__ __forceinline__ unsigned cvt_pk_bf16(float lo, float hi) { unsigned r; asm volatile("v_cvt_pk_bf16_f32 %0, %1, %2" : "=v"(r) : "v"(lo), "v"(hi)); return r; }

struct EpiPlain {
    static constexpr bool PERM = true, AFTER_DRAIN = false;
    bf16_t* O; int ldc;
    __device__ __forceinline__ void operator()(const f32x4 (&acc)[2][2][4][2], const Unit& u, int wr, int wc, int fr, int fq) const {
        const int row0 = u.pm * BM + wr * 64 + fr; const int col0 = u.pn * BM + wc * 32 + 8 * fq;
#pragma unroll
        for (int ai = 0; ai < 2; ++ai)
#pragma unroll
            for (int m = 0; m < 4; ++m) { bf16_t* rowp = O + (size_t)(row0 + ai * HALF + m * 16) * ldc + col0;
#pragma unroll
                for (int bj = 0; bj < 2; ++bj) { const f32x4 v0 = acc[ai][bj][m][0], v1 = acc[ai][bj][m][1];
                    u32x4 w; w.x = cvt_pk_bf16(v0[0], v0[1]); w.y = cvt_pk_bf16(v0[2], v0[3]); w.z = cvt_pk_bf16(v1[0], v1[1]); w.w = cvt_pk_bf16(v1[2], v1[3]);
                    *(u32x4*)(rowp + bj * HALF) = w; } }
    }
};
struct EpiRope {
    static constexpr bool PERM = true, AFTER_DRAIN = false;
    bf16_t* O; int ldc; const float* rope; float qscale; const float* bias;
    __device__ __forceinline__ void operator()(const f32x4 (&acc)[2][2][4][2], const Unit& u, int wr, int wc, int fr, int fq) const {
        const int row0 = u.pm * BM + wr * 64 + fr; const int col0 = u.pn * BM + wc * 32 + 8 * fq;
#pragma unroll
        for (int ai = 0; ai < 2; ++ai)
#pragma unroll
            for (int m = 0; m < 4; ++m) { const int row = row0 + ai * HALF + m * 16; bf16_t* rowp = O + (size_t)row * ldc + col0; const int pos = row & 8191;
#pragma unroll
                for (int bj = 0; bj < 2; ++bj) { const float* bp = bias + (size_t)(row >> 13) * ldc + col0 + bj * HALF;
                    f32x4 v0 = acc[ai][bj][m][0] + *(const f32x4*)bp, v1 = acc[ai][bj][m][1] + *(const f32x4*)(bp + 4);
                    const int colt = u.pn * BM + bj * HALF;
                    if (colt < 640) {
                        const int c = col0 + bj * HALF, ib = (c & 63) >> 1;
                        const f32x4 cs0 = *(const f32x4*)(rope + ((size_t)pos * 32 + ib) * 2), cs1 = *(const f32x4*)(rope + ((size_t)pos * 32 + ib) * 2 + 4);
                        const float sc = colt < 512 ? qscale : 1.0f;
                        f32x4 r0, r1;
                        r0[0] = (v0[0] * cs0[0] - v0[1] * cs0[1]) * sc; r0[1] = (v0[1] * cs0[0] + v0[0] * cs0[1]) * sc;
                        r0[2] = (v0[2] * cs0[2] - v0[3] * cs0[3]) * sc; r0[3] = (v0[3] * cs0[2] + v0[2] * cs0[3]) * sc;
                        r1[0] = (v1[0] * cs1[0] - v1[1] * cs1[1]) * sc; r1[1] = (v1[1] * cs1[0] + v1[0] * cs1[1]) * sc;
                        r1[2] = (v1[2] * cs1[2] - v1[3] * cs1[3]) * sc; r1[3] = (v1[3] * cs1[2] + v1[2] * cs1[3]) * sc;
                        v0 = r0; v1 = r1;
                    }
                    u32x4 w; w.x = cvt_pk_bf16(v0[0], v0[1]); w.y = cvt_pk_bf16(v0[2], v0[3]); w.z = cvt_pk_bf16(v1[0], v1[1]); w.w = cvt_pk_bf16(v1[2], v1[3]);
                    *(u32x4*)(rowp + bj * HALF) = w; } }
    }
};

template <class Epi, class Sched, bool ALIGN_EPI = false, bool SP2 = false>
__device__ __forceinline__ void gemm_phase(PG8_LAS unsigned char* lds, const Gemm g, const Sched& S, const Epi& E) {
    const int tid = threadIdx.x, wid = __builtin_amdgcn_readfirstlane(tid >> 6), lane = tid & 63, wr = wid >> 2, wc = wid & 3, fr = lane & 15, fq = lane >> 4;
    const int K = g.K, nt = K / BK;
    unsigned voffA[2], voffB[2];
#pragma unroll
    for (int i = 0; i < 2; ++i) { int R, C; stage_rc(tid * 16 + i * 8192, R, C); const int Rb = Epi::PERM ? ((R & ~31) + perm32(R & 31)) : R;
        voffA[i] = (unsigned)(R * K + C) * 2u; voffB[i] = (unsigned)(Rb * K + C) * 2u; }
    const size_t kstep = (size_t)(BK * 2);
    const size_t hstep = (size_t)HALF * K * 2;
    const size_t tstep = 2 * hstep;
    const unsigned ldsw = (unsigned)wid * 1024u;
    const int aoff = lds_byte(wr * 64 + fr, fq * 8), boff = lds_byte(wc * 32 + fr, fq * 8);
#define PG8_SA(b, h) (((b) * 2 + (h)) * HTB)
#define PG8_SB(b, h) ((4 + (b) * 2 + (h)) * HTB)
#define PG8_STAGE(bufoff, gbase, voff) do { _Pragma("unroll") for (int _i = 0; _i < 2; ++_i) \
        __builtin_amdgcn_global_load_lds((const unsigned*)((const char*)(gbase) + (voff)[_i]), (PG8_LAS unsigned*)(lds + (bufoff) + ldsw + _i * 8192), 16, 0, 0); } while (0)
#define PG8_LDA(dst, b, h) do { _Pragma("unroll") for (int m = 0; m < 4; ++m) _Pragma("unroll") for (int k = 0; k < 2; ++k) dst[m][k] = *(const PG8_LAS bf16x8*)(lds + PG8_SA(b, h) + aoff + m * 2048 + k * 1024); } while (0)
#define PG8_LDB(dst, b, h) do { _Pragma("unroll") for (int n = 0; n < 2; ++n) _Pragma("unroll") for (int k = 0; k < 2; ++k) dst[n][k] = *(const PG8_LAS bf16x8*)(lds + PG8_SB(b, h) + boff + n * 2048 + k * 1024); } while (0)
#define PG8_MMA(ai, bj, At, Bt) do { __builtin_amdgcn_s_setprio(1); _Pragma("unroll") for (int m = 0; m < 4; ++m) _Pragma("unroll") for (int n = 0; n < 2; ++n) _Pragma("unroll") for (int k = 0; k < 2; ++k) \
        acc[ai][bj][m][n] = __builtin_amdgcn_mfma_f32_16x16x32_bf16(Bt[n][k], At[m][k], acc[ai][bj][m][n], 0, 0, 0); __builtin_amdgcn_s_setprio(0); } while (0)
#define PG8_WAIT_V(n) asm volatile("s_waitcnt vmcnt(" #n ")" ::: "memory")
#define PG8_WAIT_L(n) asm volatile("s_waitcnt lgkmcnt(" #n ")" ::: "memory")
#define PG8_BAR __builtin_amdgcn_s_barrier()
#define PG8_SCHED __builtin_amdgcn_sched_barrier(0)
    Unit cur, nxt; int ui = 0;
    if (!S.next(0, cur)) return;
    f32x4 acc[2][2][4][2];
#pragma unroll
    for (int a = 0; a < 2; ++a)
#pragma unroll
        for (int b = 0; b < 2; ++b)
#pragma unroll
            for (int m = 0; m < 4; ++m)
#pragma unroll
                for (int n = 0; n < 2; ++n) acc[a][b][m][n] = (f32x4){0.f, 0.f, 0.f, 0.f};
    bf16x8 At[4][2], B0[2][2], B1[2][2];
    const char* cA = (const char*)g.A + (size_t)cur.pm * tstep; const char* cB = (const char*)g.Bt + (size_t)cur.pn * tstep + (cur.pm >= g.bsplit ? g.bstride : (size_t)0);
    S.a_ready(cur);
    if constexpr (SP2) {
        PG8_STAGE(PG8_SB(0, 0), cB, voffB); PG8_STAGE(PG8_SB(0, 1), cB + hstep, voffB); PG8_STAGE(PG8_SA(0, 0), cA, voffA); PG8_STAGE(PG8_SA(0, 1), cA + hstep, voffA);
        if (wr == 1) PG8_BAR;
        PG8_WAIT_V(2); PG8_BAR;
        PG8_STAGE(PG8_SB(1, 0), cB + kstep, voffB); PG8_STAGE(PG8_SA(1, 0), cA + kstep, voffA); PG8_STAGE(PG8_SB(1, 1), cB + hstep + kstep, voffB);
        PG8_WAIT_V(6); PG8_BAR;
    } else {
        PG8_STAGE(PG8_SB(0, 0), cB, voffB); PG8_STAGE(PG8_SA(0, 0), cA, voffA); PG8_STAGE(PG8_SB(0, 1), cB + hstep, voffB); PG8_STAGE(PG8_SA(0, 1), cA + hstep, voffA);
        if (wr == 1) PG8_BAR;
        PG8_WAIT_V(4); PG8_BAR;
        PG8_STAGE(PG8_SB(1, 0), cB + kstep, voffB); PG8_STAGE(PG8_SA(1, 0), cA + kstep, voffA); PG8_STAGE(PG8_SB(1, 1), cB + hstep + kstep, voffB);
        PG8_WAIT_V(6); PG8_BAR;
    }
    for (;;) {
        const bool has_next = S.next(ui + 1, nxt);
        const char* nA = has_next ? (const char*)g.A + (size_t)nxt.pm * tstep : cA; const char* nB = has_next ? (const char*)g.Bt + (size_t)nxt.pn * tstep + (nxt.pm >= g.bsplit ? g.bstride : (size_t)0) : cB;
        for (int t = 0; t < nt; t += 2) {
            const bool last = (t == nt - 2);
            const char* a1 = cA + (size_t)(t + 1) * kstep;
            const char* a2 = last ? nA : cA + (size_t)(t + 2) * kstep; const char* b2 = last ? nB : cB + (size_t)(t + 2) * kstep;
            const char* a3 = a2 + kstep; const char* b3 = b2 + kstep;
            if (last && has_next) S.a_ready(nxt);
            if constexpr (SP2) {
            PG8_LDB(B0, 0, 0); PG8_LDB(B1, 0, 1); PG8_SCHED; PG8_LDA(At, 0, 0); PG8_STAGE(PG8_SA(1, 1), a1 + hstep, voffA);
            PG8_WAIT_V(8); PG8_WAIT_L(0); PG8_BAR; PG8_MMA(0, 0, At, B0); PG8_MMA(0, 1, At, B1); PG8_BAR; PG8_SCHED;
            PG8_LDA(At, 0, 1); PG8_STAGE(PG8_SB(0, 0), b2, voffB); PG8_STAGE(PG8_SB(0, 1), b2 + hstep, voffB); PG8_STAGE(PG8_SA(0, 0), a2, voffA);
            PG8_WAIT_V(8); PG8_WAIT_L(0); PG8_BAR; PG8_MMA(1, 0, At, B0); PG8_MMA(1, 1, At, B1); PG8_BAR; PG8_SCHED;
            PG8_LDB(B0, 1, 0); PG8_LDB(B1, 1, 1); PG8_SCHED; PG8_LDA(At, 1, 0); PG8_STAGE(PG8_SA(0, 1), a2 + hstep, voffA);
            PG8_WAIT_V(8); PG8_WAIT_L(0); PG8_BAR; PG8_MMA(0, 0, At, B0); PG8_MMA(0, 1, At, B1); PG8_BAR; PG8_SCHED;
            PG8_LDA(At, 1, 1); PG8_STAGE(PG8_SB(1, 0), b3, voffB); PG8_STAGE(PG8_SB(1, 1), b3 + hstep, voffB); PG8_STAGE(PG8_SA(1, 0), a3, voffA);
            PG8_WAIT_V(8); PG8_WAIT_L(0); PG8_BAR; PG8_MMA(1, 0, At, B0); PG8_MMA(1, 1, At, B1); PG8_BAR; PG8_SCHED;
            } else {
            PG8_LDB(B0, 0, 0); PG8_SCHED; PG8_LDA(At, 0, 0); PG8_STAGE(PG8_SA(1, 1), a1 + hstep, voffA);
            PG8_WAIT_L(8); PG8_BAR; PG8_WAIT_L(0); PG8_MMA(0, 0, At, B0); PG8_BAR; PG8_SCHED;
            PG8_LDB(B1, 0, 1); PG8_STAGE(PG8_SB(0, 0), b2, voffB);
            PG8_BAR; PG8_WAIT_L(0); PG8_MMA(0, 1, At, B1); PG8_BAR;
            PG8_LDA(At, 0, 1); PG8_STAGE(PG8_SA(0, 0), a2, voffA);
            PG8_BAR; PG8_WAIT_L(0); PG8_MMA(1, 0, At, B0); PG8_BAR; PG8_SCHED;
            PG8_STAGE(PG8_SB(0, 1), b2 + hstep, voffB);
            PG8_WAIT_V(6); PG8_BAR; PG8_MMA(1, 1, At, B1); PG8_BAR;
            PG8_LDB(B0, 1, 0); PG8_SCHED; PG8_LDA(At, 1, 0); PG8_STAGE(PG8_SA(0, 1), a2 + hstep, voffA);
            PG8_WAIT_L(8); PG8_BAR; PG8_WAIT_L(0); PG8_MMA(0, 0, At, B0); PG8_BAR; PG8_SCHED;
            PG8_LDB(B1, 1, 1); PG8_STAGE(PG8_SB(1, 0), b3, voffB);
            PG8_BAR; PG8_WAIT_L(0); PG8_MMA(0, 1, At, B1); PG8_BAR;
            PG8_LDA(At, 1, 1); PG8_STAGE(PG8_SA(1, 0), a3, voffA);
            PG8_BAR; PG8_WAIT_L(0); PG8_MMA(1, 0, At, B0); PG8_BAR; PG8_SCHED;
            PG8_STAGE(PG8_SB(1, 1), b3 + hstep, voffB);
            PG8_WAIT_V(6); PG8_BAR; PG8_MMA(1, 1, At, B1); PG8_BAR;
            }
        }
        if constexpr (ALIGN_EPI) { if (wr == 0) PG8_BAR; }
        if constexpr (!Epi::AFTER_DRAIN) { E(acc, cur, wr, wc, fr, fq); S.done(cur); }
        if (!has_next) break;
#pragma unroll
        for (int a = 0; a < 2; ++a)
#pragma unroll
            for (int b = 0; b < 2; ++b)
#pragma unroll
                for (int m = 0; m < 4; ++m)
#pragma unroll
                    for (int n = 0; n < 2; ++n) acc[a][b][m][n] = (f32x4){0.f, 0.f, 0.f, 0.f};
        cur = nxt; cA = nA; cB = nB; ++ui;
        if constexpr (ALIGN_EPI) { if (wr == 1) PG8_BAR; }
    }
    PG8_WAIT_V(0);
    if constexpr (!ALIGN_EPI) { if (wr == 0) PG8_BAR; }
    PG8_BAR;
    if constexpr (Epi::AFTER_DRAIN) { E.fused(acc, cur, wr, wc, fr, fq, lds, wid, lane); S.done(cur); }
#undef PG8_SA
#undef PG8_SB
#undef PG8_STAGE
#undef PG8_LDA
#undef PG8_LDB
#undef PG8_MMA
#undef PG8_WAIT_V
#undef PG8_WAIT_L
#undef PG8_BAR
#undef PG8_SCHED
}
}
#define GAS __attribute__((address_space(1)))
#define LAS __attribute__((address_space(3)))
typedef unsigned short bf16;
typedef unsigned v4u __attribute__((ext_vector_type(4)));
typedef float f32x4 __attribute__((ext_vector_type(4)));
typedef short bf16x8 __attribute__((ext_vector_type(8)));
typedef GAS unsigned gu32;
typedef GAS unsigned long long gu64;
#define RLX_AGENT __ATOMIC_RELAXED, __HIP_MEMORY_SCOPE_AGENT
#define LDS_WAIT() asm volatile("s_waitcnt lgkmcnt(0)" ::: "memory")
#define VM_WAIT() asm volatile("s_waitcnt vmcnt(0)" ::: "memory")
__device__ __forceinline__ unsigned long long rt() { return __builtin_amdgcn_s_memrealtime(); }
__device__ __forceinline__ unsigned f2bf(float f) { unsigned u = __builtin_bit_cast(unsigned, f); return (u + 0x7fffu + ((u >> 16) & 1u)) >> 16; }
__device__ __forceinline__ unsigned pk2(float lo, float hi) { return f2bf(lo) | (f2bf(hi) << 16); }
#define XB_TMO      128
#define XB_XCNT(j)  (256  + 64 * (j))
#define XB_XSUB(j)  (1280 + 64 * (j))
#define XB_XGEN(j)  (2304 + 64 * (j))
#define XB_TOP      3328
#define XB_TOPGEN   3392
#define XCD_BAR_WORDS 3456
#define XB_SPIN_CAP (1u << 18)

__device__ __forceinline__ unsigned xb_ld(unsigned* p)              { return __hip_atomic_load(p, __ATOMIC_RELAXED, __HIP_MEMORY_SCOPE_AGENT); }
__device__ __forceinline__ unsigned xb_add(unsigned* p, unsigned v) { return __hip_atomic_fetch_add(p, v, __ATOMIC_RELAXED, __HIP_MEMORY_SCOPE_AGENT); }
__device__ __forceinline__ unsigned xb_xcc_id() { return (unsigned)__builtin_amdgcn_s_getreg((3 << 11) | 20) & 0xFu; }
#define XB_SPIN(cond, bar) do { unsigned _sp = 0; while (cond) { __builtin_amdgcn_s_sleep(1); \
    if ((++_sp & 255u) == 0u) { if (xb_ld(&(bar)[XB_TMO])) break; if (_sp > XB_SPIN_CAP) { atomicAdd(&(bar)[XB_TMO], 1u); break; } } } } while (0)

struct XcdBarrier {
    unsigned* bar; unsigned x;
    volatile LAS unsigned* st;
};

__device__ __forceinline__ XcdBarrier xcd_barrier_post(unsigned* bar, volatile LAS unsigned* st) {
    XcdBarrier b; b.bar = bar; b.x = xb_xcc_id(); b.st = st;
    if (threadIdx.x == 0) (void)xb_add(&bar[XB_XCNT(b.x)], 1u);
    return b;
}
__device__ __forceinline__ void xcd_barrier_complete(unsigned* bar, unsigned x, unsigned& nloc, unsigned& nx) {
    const unsigned G = gridDim.x * gridDim.y * gridDim.z;
    unsigned sum, cnt, mine, sp = 0u;
    for (;;) {
        sum = 0u; cnt = 0u; mine = 0u;
#pragma unroll
        for (unsigned j = 0; j < 16; ++j) { const unsigned c = xb_ld(&bar[XB_XCNT(j)]); sum += c; cnt += (c > 0u) ? 1u : 0u; mine = (j == x) ? c : mine; }
        if (sum == G) break;
        __builtin_amdgcn_s_sleep(1);
        if ((++sp & 255u) == 0u) { if (xb_ld(&bar[XB_TMO])) break; if (sp > XB_SPIN_CAP) { atomicAdd(&bar[XB_TMO], 1u); break; } }
    }
    nloc = mine > 0u ? mine : 1u; nx = cnt > 0u ? cnt : 1u;
}

__device__ __forceinline__ void xcd_barrier(const XcdBarrier& b) {
    asm volatile("s_waitcnt vmcnt(0)" ::: "memory");
    __syncthreads();
    if (threadIdx.x == 0) {
        unsigned* bar = b.bar;
        __builtin_amdgcn_s_waitcnt(0);
        unsigned nloc = b.st[0], nx = b.st[1];
        if (nloc == 0u) { xcd_barrier_complete(bar, b.x, nloc, nx); b.st[0] = nloc; b.st[1] = nx; }
        const unsigned old = xb_add(&bar[XB_XSUB(b.x)], 1u);
        const unsigned gen = old / nloc;
        if (old + 1u == (gen + 1u) * nloc) {
            __builtin_amdgcn_fence(__ATOMIC_RELEASE, "agent");
            asm volatile("s_waitcnt vmcnt(0)" ::: "memory");
            const unsigned og = xb_add(&bar[XB_TOP], 1u);
            const unsigned tg = og / nx;
            if (og + 1u == (tg + 1u) * nx) xb_add(&bar[XB_TOPGEN], 1u);
            else XB_SPIN(xb_ld(&bar[XB_TOPGEN]) == tg, bar);
            __builtin_amdgcn_fence(__ATOMIC_ACQUIRE, "agent");
            xb_add(&bar[XB_XGEN(b.x)], 1u);
            asm volatile("s_waitcnt vmcnt(0)" ::: "memory");
        } else {
            XB_SPIN(xb_ld(&bar[XB_XGEN(b.x)]) == gen, bar);
            __builtin_amdgcn_fence(__ATOMIC_ACQUIRE, "agent");
            asm volatile("s_waitcnt vmcnt(0)" ::: "memory");
        }
    }
    __syncthreads();
}
constexpr int NWAVES = 8, NTHREADS = 512;
constexpr int TT = 16384, DM = 1024, SEQ = 8192, NIN = 1280, NQD = 2048, NEXP = 16384;
constexpr float DN_ALPHA = 1.189207115002721f;
constexpr float LN_EPS = 1e-5f;
constexpr float LOG2E = 1.4426950408889634f;
constexpr float QSCALE = 0.125f * LOG2E;

constexpr size_t MiB = 1u << 20;
constexpr size_t WS_CTL = 0, CTL_ZERO_BYTES = 64 * 1024;
constexpr size_t WS_MOD = 1 * MiB + 896 * 1024;
constexpr size_t WS_ROPE = 2 * MiB;
constexpr size_t WS_WIN = 248 * MiB;
constexpr size_t WS_BIAS = 4 * MiB;
constexpr size_t WS_K1 = 6 * MiB + 512 * 1024, WS_K2 = WS_K1 + 32 * 1024;
constexpr size_t WS_WOUT = 7 * MiB;
constexpr size_t WS_WPQ = 9 * MiB;
constexpr size_t WS_SU = 13 * MiB, WS_SV = 13 * MiB + 65536;
constexpr size_t WS_U = 16 * MiB, WS_V = 32 * MiB;
constexpr size_t WS_XN = 80 * MiB;
constexpr size_t WS_MIX = 112 * MiB;
constexpr size_t WS_PE = 80 * MiB, WS_PG = 84 * MiB;
constexpr size_t WS_PROJ = 112 * MiB;
constexpr size_t WS_A2 = 152 * MiB;
constexpr size_t WS_X1 = 184 * MiB, WS_H2 = 216 * MiB;
constexpr size_t WS_Q = 112 * MiB;
constexpr size_t WS_END = 253 * MiB;
constexpr int CW_MODCNT = 1024;
constexpr int CW_BAR = 4096;

constexpr int RING_BYTES = 131072, LDSCTL_OFF = RING_BYTES, MISC_OFF = LDSCTL_OFF + 320, LDS_BYTES = 147456;

typedef float f32x16 __attribute__((ext_vector_type(16)));
typedef float f32x2 __attribute__((ext_vector_type(2)));
typedef unsigned u32x2 __attribute__((ext_vector_type(2)));
typedef unsigned u32x4 __attribute__((ext_vector_type(4)));
typedef __bf16 bf16x2_t __attribute__((ext_vector_type(2)));
struct Frame {
    LAS unsigned char* lds;
    int tid, lane, wave, vcu, G;
    const float *x, *c, *w_ada, *b_ada, *w_in, *sinks, *w_pool, *pool_scale, *w_out, *ln1_g, *ln1_b, *w_pq, *k1, *k2, *pu, *pv, *ln2_g, *ln2_b;
    float* out; unsigned char* ws;
};
__device__ __forceinline__ float wave_sum(float v) {
#pragma unroll
    for (int o = 1; o < 64; o <<= 1) v += __shfl_xor(v, o);
    return v;
}
__device__ __forceinline__ float bf_lo(unsigned u) { return __uint_as_float(u << 16); }
__device__ __forceinline__ float bf_hi(unsigned u) { return __uint_as_float(u & 0xffff0000u); }
__device__ __forceinline__ float bf2f(bf16 b) { return __uint_as_float((unsigned)b << 16); }

template <int MODE>
__device__ __forceinline__ void transpose_item(const float* W, int ldw, bf16* WT, int ldt, int k0, int n0, LAS float* scr, int lane, const LAS float* ksc = nullptr) {
    int nsrc = n0 + (lane & 31);
    if (MODE == 1 && nsrc < 640) { const int hd = nsrc >> 6, w = nsrc & 63; nsrc = hd * 64 + (w >> 1) + 32 * (w & 1); }
    float wv[32];
#pragma unroll
    for (int i = 0; i < 32; ++i) wv[i] = W[(size_t)(k0 + 2 * i + (lane >> 5)) * ldw + nsrc];
#pragma unroll
    for (int i = 0; i < 32; ++i) { const int kk = 2 * i + (lane >> 5); float w_ = wv[i]; if (MODE == 1) w_ *= ksc[k0 + kk]; scr[kk * 33 + (lane & 31)] = w_; }
    LDS_WAIT(); asm volatile("" ::: "memory");
    const int c = lane & 7;
#pragma unroll
    for (int j = 0; j < 4; ++j) { const int n = (lane >> 3) + 8 * j; const LAS float* s = scr + (8 * c) * 33 + n;
        v4u o; o.x = pk2(s[0 * 33], s[1 * 33]); o.y = pk2(s[2 * 33], s[3 * 33]); o.z = pk2(s[4 * 33], s[5 * 33]); o.w = pk2(s[6 * 33], s[7 * 33]);
        *(GAS v4u*)(WT + (size_t)(n0 + n) * ldt + k0 + 8 * c) = o; }
    LDS_WAIT(); asm volatile("" ::: "memory");
}
__device__ __forceinline__ void sincos_d(double a, float& s, float& c) {
    const double TWO_PI = 6.283185307179586476925, PI = 3.141592653589793238462643;
    double r = a - TWO_PI * rint(a / TWO_PI);
    double sg = 1.0;
    if (r > 0.5 * PI) { r = PI - r; sg = -1.0; } else if (r < -0.5 * PI) { r = -PI - r; sg = -1.0; }
    const double r2 = r * r;
    double sp = -1.0 / 121645100408832000.0;
    sp = sp * r2 + 1.0 / 355687428096000.0; sp = sp * r2 - 1.0 / 1307674368000.0; sp = sp * r2 + 1.0 / 6227020800.0; sp = sp * r2 - 1.0 / 39916800.0;
    sp = sp * r2 + 1.0 / 362880.0; sp = sp * r2 - 1.0 / 5040.0; sp = sp * r2 + 1.0 / 120.0; sp = sp * r2 - 1.0 / 6.0; sp = sp * r2 + 1.0;
    double cp = 1.0 / 6402373705728000.0;
    cp = cp * r2 - 1.0 / 20922789888000.0; cp = cp * r2 + 1.0 / 87178291200.0; cp = cp * r2 - 1.0 / 479001600.0; cp = cp * r2 + 1.0 / 3628800.0;
    cp = cp * r2 - 1.0 / 40320.0; cp = cp * r2 + 1.0 / 720.0; cp = cp * r2 - 1.0 / 24.0; cp = cp * r2 + 0.5; cp = 1.0 - cp * r2;
    s = (float)(sp * r); c = (float)(sg * cp);
}
__device__ __forceinline__ void p1_win(Frame& F);
__device__ __forceinline__ void p0_prologue(Frame& F, int parts = 0xff) {
    LAS float* scr = (LAS float*)(F.lds + F.wave * 16384);
    const int gw = F.vcu * NWAVES + F.wave, NGW = F.G * NWAVES, lane = F.lane;
    if ((parts & 1) && F.vcu < 96) { const int col = F.vcu * 64 + lane; float a0 = 0.f, a1 = 0.f;
        LAS float* sl = (LAS float*)(F.lds + F.wave * 16384 + 8448);
#pragma unroll
        for (int q = 0; q < 2; ++q) { const int k = F.wave * 128 + 64 * q + lane; const float c0 = F.c[k], c1 = F.c[DM + k];
            sl[64 * q + lane] = c0 / (1.f + __expf(-c0)); sl[128 + 64 * q + lane] = c1 / (1.f + __expf(-c1)); }
        LDS_WAIT(); asm volatile("" ::: "memory");
#pragma unroll 1
        for (int kb = 0; kb < 128; kb += 64) { float w[64];
#pragma unroll
            for (int u = 0; u < 64; ++u) w[u] = F.w_ada[(size_t)(F.wave * 128 + kb + u) * 6144 + col];
#pragma unroll
            for (int u = 0; u < 64; ++u) { a0 += sl[kb + u] * w[u]; a1 += sl[128 + kb + u] * w[u]; } }
        LAS float* red = (LAS float*)(F.lds + F.wave * 16384 + 12288); red[lane] = a0; red[64 + lane] = a1;
        __syncthreads();
        if (F.tid < 128) { const int bb = F.tid >> 6, l = F.tid & 63; float sacc = F.b_ada[F.vcu * 64 + l];
#pragma unroll
            for (int w = 0; w < 8; ++w) sacc += ((const LAS float*)(F.lds + w * 16384 + 12288))[bb * 64 + l];
            ((float*)(F.ws + WS_MOD))[bb * 6144 + F.vcu * 64 + l] = sacc; }
        asm volatile("s_waitcnt vmcnt(0)" ::: "memory"); __syncthreads();
        if (F.tid == 0) { __builtin_amdgcn_fence(__ATOMIC_RELEASE, "agent"); asm volatile("s_waitcnt vmcnt(0)" ::: "memory");
            __hip_atomic_fetch_add((unsigned*)(F.ws + WS_CTL) + CW_MODCNT, 1u, __ATOMIC_RELAXED, __HIP_MEMORY_SCOPE_AGENT); } }
    if (parts & 2) { float* rope = (float*)(F.ws + WS_ROPE);
      for (int e = gw * 64 + lane; e < SEQ * 32; e += NGW * 64) { const int pos = e >> 5, i = e & 31;
          const float freq = powf(10000.0f, -(float)i / 32.0f); const float ang = (float)pos * freq; float s, c; sincos_d((double)ang, s, c);
          rope[2 * e] = c; rope[2 * e + 1] = s; } }
    if (parts & 4) { constexpr int I_PQ = 16 * 64, I_OUT = 8 * 32;
      for (int it = NGW - 1 - gw; it < I_PQ + I_OUT; it += NGW) { int r = it;
          if (r < I_PQ) { transpose_item<0>(F.w_pq, NQD, (bf16*)(F.ws + WS_WPQ), DM, 64 * (r / 64), 32 * (r % 64), scr, lane); continue; } r -= I_PQ;
          transpose_item<0>(F.w_out, DM, (bf16*)(F.ws + WS_WOUT), DM, 64 * (r / 32), 32 * (r % 32), scr, lane); } }
    if (parts & 8) { bf16* wout_t = (bf16*)(F.ws + WS_WOUT);
      for (int it = gw; it < 4 * 2 * 128; it += NGW) { const int g = it >> 8, ch = (it >> 7) & 1, n0 = (it & 127) * 8, cidx = ch * 64 + lane;
          const float* wo = F.w_out + (size_t)(512 + g * 128) * DM + n0; const float* ps = F.pool_scale + g * 128;
#pragma unroll
          for (int i = 0; i < 4; ++i) { const int f4 = lane + 64 * i, e = f4 >> 1, hf = f4 & 1; const f32x4 o = *(const f32x4*)(wo + (size_t)e * DM + 4 * hf) * ps[e]; *(LAS f32x4*)(scr + e * 8 + 4 * hf) = o; }
          float acc[8];
#pragma unroll
          for (int i = 0; i < 8; ++i) acc[i] = 0.f;
          const float* wp = F.w_pool + ((size_t)(g * 128 + cidx)) * 128;
          LDS_WAIT(); asm volatile("" ::: "memory");
#pragma unroll 1
          for (int e0 = 0; e0 < 128; e0 += 64) { f32x4 wv[16];
#pragma unroll
              for (int q = 0; q < 16; ++q) wv[q] = *(const f32x4*)(wp + e0 + 4 * q);
#pragma unroll
              for (int q = 0; q < 16; ++q)
#pragma unroll
                  for (int ee = 0; ee < 4; ++ee) { const float w = wv[q][ee]; const f32x4 o0 = *(const LAS f32x4*)(scr + (e0 + 4 * q + ee) * 8), o1 = *(const LAS f32x4*)(scr + (e0 + 4 * q + ee) * 8 + 4);
                      acc[0] += w * o0[0]; acc[1] += w * o0[1]; acc[2] += w * o0[2]; acc[3] += w * o0[3]; acc[4] += w * o1[0]; acc[5] += w * o1[1]; acc[6] += w * o1[2]; acc[7] += w * o1[3]; } }
#pragma unroll
          for (int i = 0; i < 8; ++i) wout_t[(size_t)(n0 + i) * DM + 512 + g * 128 + cidx] = (bf16)f2bf(acc[i]);
          LDS_WAIT(); asm volatile("" ::: "memory"); } }
    if (parts & 16) { bf16* k1b = (bf16*)(F.ws + WS_K1); bf16* k2b = (bf16*)(F.ws + WS_K2);
      for (int e = gw * 64 + lane; e < 128 * 128; e += NGW * 64) { k1b[e] = (bf16)f2bf(F.k1[e]); k2b[e] = (bf16)f2bf(F.k2[e]); } }
    if (parts & 32) { bf16* xn = (bf16*)(F.ws + WS_XN); const int rpw = TT / NGW;
      for (int m = gw * rpw; m < gw * rpw + rpw; m += 4) { f32x4 v[4][4];
#pragma unroll
          for (int q = 0; q < 4; ++q)
#pragma unroll
              for (int j = 0; j < 4; ++j) v[q][j] = *(const f32x4*)(F.x + (size_t)(m + q) * DM + 256 * j + 4 * lane);
#pragma unroll
          for (int q = 0; q < 4; ++q)
#pragma unroll
              for (int j = 0; j < 4; ++j) { u32x2 o; o.x = pk2(v[q][j][0], v[q][j][1]); o.y = pk2(v[q][j][2], v[q][j][3]); *(u32x2*)(xn + (size_t)(m + q) * DM + 256 * j + 4 * lane) = o; } } }
    if (parts & 64) {
        __syncthreads();
        if (F.tid == 0) { unsigned sp = 0; const unsigned* cnt = (const unsigned*)(F.ws + WS_CTL) + CW_MODCNT;
            while (__hip_atomic_load(cnt, __ATOMIC_RELAXED, __HIP_MEMORY_SCOPE_AGENT) < 96u) { __builtin_amdgcn_s_sleep(2); if (++sp > (1u << 22)) break; }
            __builtin_amdgcn_fence(__ATOMIC_ACQUIRE, "agent"); asm volatile("s_waitcnt vmcnt(0)" ::: "memory"); }
        __syncthreads();
        p1_win(F);
    }
}
__device__ __forceinline__ void p2_tables(Frame& F, int cw, int ncw) {
    const int lane = F.lane; float* su = (float*)(F.ws + WS_SU); float* sv = (float*)(F.ws + WS_SV);
    const int per = (2 * NEXP + ncw - 1) / ncw, r0 = cw * per, r1 = (r0 + per) < 2 * NEXP ? (r0 + per) : 2 * NEXP;
    if (r0 >= r1) return;
#define TB_LOAD(dst, base) do { _Pragma("unroll") for (int q = 0; q < 4; ++q) { const int it = ((base) + q < r1) ? (base) + q : r1 - 1; const int tb = it >= NEXP, e = it - tb * NEXP; const float* src = (tb ? F.pv : F.pu) + (size_t)e * DM; \
            _Pragma("unroll") for (int j = 0; j < 4; ++j) dst[q][j] = *(const f32x4*)(src + 256 * j + 4 * lane); } } while (0)
#define TB_PROC(v, base) do { float am[4]; \
        _Pragma("unroll") for (int q = 0; q < 4; ++q) { float a = 0.f; \
            _Pragma("unroll") for (int j = 0; j < 4; ++j) a = fmaxf(a, fmaxf(fmaxf(fabsf(v[q][j][0]), fabsf(v[q][j][1])), fmaxf(fabsf(v[q][j][2]), fabsf(v[q][j][3])))); am[q] = a; } \
        _Pragma("unroll") for (int o = 1; o < 64; o <<= 1) { _Pragma("unroll") for (int q = 0; q < 4; ++q) am[q] = fmaxf(am[q], __shfl_xor(am[q], o)); } \
        _Pragma("unroll") for (int q = 0; q < 4; ++q) { const int it = ((base) + q < r1) ? (base) + q : r1 - 1; const int tb = it >= NEXP, e = it - tb * NEXP; float a = am[q]; if (a == 0.f) a = 1.f; \
            unsigned w[4]; \
            if (!tb) { const float inv = 127.0f / a; \
                _Pragma("unroll") for (int j = 0; j < 4; ++j) { const int q0 = (int)rintf(v[q][j][0] * inv), q1 = (int)rintf(v[q][j][1] * inv), q2 = (int)rintf(v[q][j][2] * inv), q3 = (int)rintf(v[q][j][3] * inv); \
                    w[j] = (unsigned)(q0 & 255) | ((unsigned)(q1 & 255) << 8) | ((unsigned)(q2 & 255) << 16) | ((unsigned)(q3 & 255) << 24); } \
                *(v4u*)(F.ws + WS_U + (size_t)e * DM + 16 * lane) = (v4u){w[0], w[1], w[2], w[3]}; if (lane == 0) su[e] = a * (1.0f / 127.0f); \
            } else { const float inv = 256.0f / a; \
                _Pragma("unroll") for (int j = 0; j < 4; ++j) { int pk = __builtin_amdgcn_cvt_pk_bf8_f32(v[q][j][0] * inv, v[q][j][1] * inv, 0, false); pk = __builtin_amdgcn_cvt_pk_bf8_f32(v[q][j][2] * inv, v[q][j][3] * inv, pk, true); w[j] = (unsigned)pk; } \
                *(v4u*)(F.ws + WS_V + (size_t)e * DM + 16 * lane) = (v4u){w[0], w[1], w[2], w[3]}; if (lane == 0) sv[e] = a * (1.0f / 256.0f); } } } while (0)
    f32x4 va[4][4], vb[4][4];
    TB_LOAD(va, r0);
    for (int it0 = r0; it0 < r1; it0 += 8) {
        if (it0 + 4 < r1) TB_LOAD(vb, it0 + 4);
        TB_PROC(va, it0);
        if (it0 + 4 < r1) { if (it0 + 8 < r1) TB_LOAD(va, it0 + 8); TB_PROC(vb, it0 + 4); }
    }
#undef TB_LOAD
#undef TB_PROC
}
__device__ __forceinline__ void p1_win(Frame& F) {
    const float* mod = (const float*)(F.ws + WS_MOD);
    LAS float* sc = (LAS float*)F.lds; LAS float* sh = sc + 2048;
    for (int i = F.tid; i < 2048; i += NTHREADS) { const int b = i >> 10, k = i & 1023; sc[i] = 1.f + mod[b * 6144 + 1024 + k]; sh[i] = mod[b * 6144 + k]; }
    __syncthreads();
    const int lane = F.lane;
    if (F.vcu < 40) { const int b = F.vcu / 20, n = (F.vcu % 20) * 64 + lane; int nsrc = n; if (n < 640) { const int hd = n >> 6, w = n & 63; nsrc = hd * 64 + (w >> 1) + 32 * (w & 1); }
        float a = 0.f;
#pragma unroll 1
        for (int kb = 0; kb < 128; kb += 64) { float w[64];
#pragma unroll
            for (int u = 0; u < 64; ++u) w[u] = F.w_in[(size_t)(F.wave * 128 + kb + u) * NIN + nsrc];
#pragma unroll
            for (int u = 0; u < 64; ++u) a += sh[b * 1024 + F.wave * 128 + kb + u] * w[u]; }
        LAS float* red = (LAS float*)(F.lds + 16384); red[F.wave * 64 + lane] = a;
        __syncthreads();
        if (F.tid < 64) { float sacc = 0.f;
#pragma unroll
            for (int w = 0; w < 8; ++w) sacc += red[w * 64 + F.tid];
            ((float*)(F.ws + WS_BIAS))[b * NIN + (F.vcu % 20) * 64 + F.tid] = sacc; } }
    LAS float* scr = (LAS float*)(F.lds + 32768 + F.wave * 8448);
    const int gw = F.vcu * NWAVES + F.wave, NGW = F.G * NWAVES;
    for (int it = gw; it < 2 * 640; it += NGW) { const int b = it / 640, r = it % 640;
        transpose_item<1>(F.w_in, NIN, (bf16*)(F.ws + WS_WIN) + (size_t)b * NIN * DM, DM, 64 * (r / 40), 32 * (r % 40), scr, lane, sc + b * 1024); }
    __syncthreads();
}
constexpr int KS_STRIDE = 144, VT_STRIDE = 520, KS_BYTES = 256 * KS_STRIDE, VT_BYTES = 64 * VT_STRIDE;
__device__ __forceinline__ void p3_attn_unit(Frame& F, int unit) {
    const int b = unit >> 7, kvh = (unit >> 6) & 1, n = unit & 63;
    const bf16* proj = (const bf16*)(F.ws + WS_PROJ); bf16* a2 = (bf16*)(F.ws + WS_A2);
    LAS unsigned char* Ks = F.lds; LAS unsigned char* Vt = F.lds + KS_BYTES;
    const int tid = F.tid, lane = F.lane, wave = F.wave, r32 = lane & 31, h = lane >> 5;
    const size_t tok0 = (size_t)b * SEQ + (size_t)n * 128;
#pragma unroll
    for (int i = 0; i < 4; ++i) { const int ci = tid + NTHREADS * i, row = ci >> 3, ch = ci & 7; const bool valid = (n > 0) || (row >= 128);
        const size_t tk = tok0 - 128 + row;
        v4u kv = (v4u){0u, 0u, 0u, 0u}, vv = (v4u){0u, 0u, 0u, 0u};
        if (valid) { kv = *(const v4u*)(proj + tk * NIN + 512 + kvh * 64 + ch * 8); vv = *(const v4u*)(proj + tk * NIN + 640 + kvh * 64 + ch * 8); }
        *(LAS v4u*)(Ks + row * KS_STRIDE + ch * 16) = kv;
        LAS bf16* vt = (LAS bf16*)(Vt + (ch * 8) * VT_STRIDE) + row;
        vt[0 * (VT_STRIDE / 2)] = (bf16)(vv.x & 0xffff); vt[1 * (VT_STRIDE / 2)] = (bf16)(vv.x >> 16); vt[2 * (VT_STRIDE / 2)] = (bf16)(vv.y & 0xffff); vt[3 * (VT_STRIDE / 2)] = (bf16)(vv.y >> 16);
        vt[4 * (VT_STRIDE / 2)] = (bf16)(vv.z & 0xffff); vt[5 * (VT_STRIDE / 2)] = (bf16)(vv.z >> 16); vt[6 * (VT_STRIDE / 2)] = (bf16)(vv.w & 0xffff); vt[7 * (VT_STRIDE / 2)] = (bf16)(vv.w >> 16); }
    __syncthreads();
    const int g = wave >> 1, hq = kvh * 4 + g; const float sink2 = F.sinks[hq] * LOG2E;
#pragma unroll 1
    for (int qt = 0; qt < 2; ++qt) {
        const int qi0 = (wave & 1) * 64 + qt * 32, t0 = qi0 >> 5; const size_t tokq = tok0 + qi0 + r32;
        bf16x8 qf[4];
#pragma unroll
        for (int s = 0; s < 4; ++s) qf[s] = *(const bf16x8*)(proj + tokq * NIN + hq * 64 + 16 * s + 8 * h);
        f32x16 sc[5];
#pragma unroll
        for (int kt = 0; kt < 5; ++kt) { sc[kt] = (f32x16){};
#pragma unroll
            for (int s = 0; s < 4; ++s) { const bf16x8 kf = *(const LAS bf16x8*)(Ks + (32 * (t0 + kt) + r32) * KS_STRIDE + (16 * s + 8 * h) * 2);
                sc[kt] = __builtin_amdgcn_mfma_f32_32x32x16_bf16(kf, qf[s], sc[kt], 0, 0, 0); } }
        const int qi = qi0 + r32; float m = sink2;
#pragma unroll
        for (int kt = 0; kt < 5; ++kt)
#pragma unroll
            for (int r = 0; r < 16; ++r) { const int sidx = 32 * (t0 + kt) + (r & 3) + 8 * (r >> 2) + 4 * h; const int rel = qi + 128 - sidx;
                const bool ok = (rel >= 0) && (rel < 128) && ((n > 0) || (sidx >= 128));
                const float v = ok ? sc[kt][r] : -INFINITY; sc[kt][r] = v; m = fmaxf(m, v); }
        m = fmaxf(m, __shfl_xor(m, 32));
        float l = 0.f;
#pragma unroll
        for (int kt = 0; kt < 5; ++kt)
#pragma unroll
            for (int r = 0; r < 16; ++r) { const float p = __builtin_amdgcn_exp2f(sc[kt][r] - m); sc[kt][r] = p; l += p; }
        l += __shfl_xor(l, 32); l += __builtin_amdgcn_exp2f(sink2 - m);
        f32x16 o[2]; o[0] = (f32x16){}; o[1] = (f32x16){};
#pragma unroll
        for (int kt = 0; kt < 5; ++kt)
#pragma unroll
            for (int s2 = 0; s2 < 2; ++s2) {
                u32x4 pw; pw.x = pg8::cvt_pk_bf16(sc[kt][8 * s2 + 0], sc[kt][8 * s2 + 1]); pw.y = pg8::cvt_pk_bf16(sc[kt][8 * s2 + 2], sc[kt][8 * s2 + 3]);
                pw.z = pg8::cvt_pk_bf16(sc[kt][8 * s2 + 4], sc[kt][8 * s2 + 5]); pw.w = pg8::cvt_pk_bf16(sc[kt][8 * s2 + 6], sc[kt][8 * s2 + 7]);
                const bf16x8 pf = __builtin_bit_cast(bf16x8, pw);
#pragma unroll
                for (int dt = 0; dt < 2; ++dt) { const LAS unsigned char* vp = Vt + (dt * 32 + r32) * VT_STRIDE + (32 * (t0 + kt) + 16 * s2 + 4 * h) * 2;
                    const u32x2 lo = *(const LAS u32x2*)vp, hi = *(const LAS u32x2*)(vp + 16);
                    const u32x4 vw = (u32x4){lo.x, lo.y, hi.x, hi.y};
                    o[dt] = __builtin_amdgcn_mfma_f32_32x32x16_bf16(__builtin_bit_cast(bf16x8, vw), pf, o[dt], 0, 0, 0); } }
        const float inv = 1.0f / l;
#pragma unroll
        for (int dt = 0; dt < 2; ++dt)
#pragma unroll
            for (int rg = 0; rg < 4; ++rg) { const int d0 = dt * 32 + 8 * rg + 4 * h;
                u32x2 w; w.x = pg8::cvt_pk_bf16(o[dt][4 * rg + 0] * inv, o[dt][4 * rg + 1] * inv); w.y = pg8::cvt_pk_bf16(o[dt][4 * rg + 2] * inv, o[dt][4 * rg + 3] * inv);
                *(u32x2*)(a2 + tokq * DM + hq * 64 + d0) = w; }
    }
    __syncthreads();
}
__device__ __forceinline__ void p3_pool_unit(Frame& F, int unit) {
    const bf16* proj = (const bf16*)(F.ws + WS_PROJ); bf16* a2 = (bf16*)(F.ws + WS_A2);
    const int cp = F.tid & 255, half = F.tid >> 8, gi = cp >> 6, w = 2 << gi;
    const int tstart = unit * 64 + half * 32, s0 = tstart & (SEQ - 1);
    const bf16* pc = proj + 768 + 2 * cp;
    unsigned u[48];
#pragma unroll
    for (int i = 0; i < 48; ++i) { const int s = s0 - 16 + i; u[i] = (s >= 0) ? *(const unsigned*)(pc + (size_t)(tstart - 16 + i) * NIN) : 0u; }
    float w0 = 0.f, w1 = 0.f;
#pragma unroll
    for (int j = 1; j <= 16; ++j) if (j <= w) { w0 += bf_lo(u[16 - j]); w1 += bf_hi(u[16 - j]); }
#pragma unroll
    for (int i = 0; i < 32; ++i) { const int s = s0 + i; const float p0 = bf_lo(u[16 + i]), p1 = bf_hi(u[16 + i]);
        const unsigned uo = (w == 2) ? u[14 + i] : (w == 4) ? u[12 + i] : (w == 8) ? u[8 + i] : u[i];
        w0 += p0 - bf_lo(uo); w1 += p1 - bf_hi(uo);
        const float rc = 1.0f / (float)((s + 1) < w ? (s + 1) : w);
        *(unsigned*)(a2 + (size_t)(tstart + i) * DM + 512 + 2 * cp) = pk2(w0 * rc - p0, w1 * rc - p1); }
}
__device__ __forceinline__ void p5_ln1(Frame& F) {
    const float* mod = (const float*)(F.ws + WS_MOD); const bf16* mix = (const bf16*)(F.ws + WS_MIX); const bf16* xn = (const bf16*)(F.ws + WS_XN);
    bf16* x1 = (bf16*)(F.ws + WS_X1); bf16* h2 = (bf16*)(F.ws + WS_H2);
    const int gw = F.vcu * NWAVES + F.wave, lane = F.lane; const int rows_per_wave = TT / (F.G * NWAVES);
    const int row0 = gw * rows_per_wave, b = row0 >> 13;
    f32x4 g1[4], lg[4], lb[4], s2[4], h2s[4];
#pragma unroll
    for (int j = 0; j < 4; ++j) { const int d = 256 * j + 4 * lane;
        g1[j] = *(const f32x4*)(mod + b * 6144 + 2048 + d) + 1.0f; lg[j] = *(const f32x4*)(F.ln1_g + d); lb[j] = *(const f32x4*)(F.ln1_b + d);
        s2[j] = *(const f32x4*)(mod + b * 6144 + 4096 + d) + 1.0f; h2s[j] = *(const f32x4*)(mod + b * 6144 + 3072 + d); }
    for (int r = 0; r < rows_per_wave; r += 2) {
        u32x2 xw[2][4]; u32x2 mv[2][4];
#pragma unroll
        for (int q = 0; q < 2; ++q)
#pragma unroll
            for (int j = 0; j < 4; ++j) { const size_t m = (size_t)(row0 + r + q); const int d = 256 * j + 4 * lane; xw[q][j] = *(const u32x2*)(xn + m * DM + d); mv[q][j] = *(const u32x2*)(mix + m * DM + d); }
#pragma unroll
        for (int q = 0; q < 2; ++q) { const size_t m = (size_t)(row0 + r + q);
        f32x4 v[4]; float s = 0.f;
#pragma unroll
        for (int j = 0; j < 4; ++j) {
            const f32x4 mf = (f32x4){bf_lo(mv[q][j].x), bf_hi(mv[q][j].x), bf_lo(mv[q][j].y), bf_hi(mv[q][j].y)};
            const f32x4 xf = (f32x4){bf_lo(xw[q][j].x), bf_hi(xw[q][j].x), bf_lo(xw[q][j].y), bf_hi(xw[q][j].y)};
            v[j] = xf * DN_ALPHA + g1[j] * mf; s += (v[j][0] + v[j][1]) + (v[j][2] + v[j][3]); }
        const float mean = wave_sum(s) * (1.f / DM); float qq = 0.f;
#pragma unroll
        for (int j = 0; j < 4; ++j) { v[j] = v[j] - mean; qq += (v[j][0] * v[j][0] + v[j][1] * v[j][1]) + (v[j][2] * v[j][2] + v[j][3] * v[j][3]); }
        const float rstd = 1.0f / sqrtf(wave_sum(qq) * (1.f / DM) + LN_EPS);
#pragma unroll
        for (int j = 0; j < 4; ++j) { const int d = 256 * j + 4 * lane; const f32x4 y = v[j] * rstd * lg[j] + lb[j]; const f32x4 hh = y * s2[j] + h2s[j];
            u32x2 o; o.x = pk2(y[0], y[1]); o.y = pk2(y[2], y[3]); *(u32x2*)(x1 + m * DM + d) = o;
            u32x2 p; p.x = pk2(hh[0], hh[1]); p.y = pk2(hh[2], hh[3]); *(u32x2*)(h2 + m * DM + d) = p; } } }
}
constexpr int KR_STRIDE = 272, KR_BYTES = 128 * KR_STRIDE;
#define INS16(a, v) do { _Pragma("unroll") for (int _i = 15; _i >= 1; --_i) a[_i] = __builtin_amdgcn_fmed3f(a[_i - 1], a[_i], (v)); a[0] = fmaxf(a[0], (v)); } while (0)
#define BITONIC16(a) do { _Pragma("unroll") for (int _st = 8; _st >= 1; _st >>= 1) { _Pragma("unroll") for (int _i = 0; _i < 16; ++_i) if ((_i & _st) == 0) { const float _x = a[_i], _y = a[_i + _st]; a[_i] = fmaxf(_x, _y); a[_i + _st] = fminf(_x, _y); } } } while (0)
__device__ __forceinline__ void p7_route(Frame& F) {
    const bf16* q = (const bf16*)(F.ws + WS_Q); unsigned short* pe = (unsigned short*)(F.ws + WS_PE); float* pg = (float*)(F.ws + WS_PG);
    const int tid = F.tid, lane = F.lane, wave = F.wave, r32 = lane & 31, h = lane >> 5;
    { const bf16* k1b = (const bf16*)(F.ws + WS_K1);
      for (int ci = tid; ci < 2 * 128 * 16; ci += NTHREADS) { const int side = ci >> 11, row = (ci >> 4) & 127, ch = ci & 15;
          *(LAS v4u*)(F.lds + side * KR_BYTES + row * KR_STRIDE + ch * 16) = *(const v4u*)(k1b + (size_t)side * 16384 + row * 128 + ch * 8); } }
    __syncthreads();
    LAS unsigned char* scr = F.lds + 2 * KR_BYTES + wave * 2048 + lane * 32;
    pg8::StaticOrder S; S.init(TT, NQD, F.G, (int)blockIdx.x); pg8::Unit u;
    for (int ui = 0; S.next(ui, u); ++ui) {
        const int head = u.pn; const size_t tok = (size_t)u.pm * 256 + wave * 32 + r32;
        float vv[2][16];
#pragma unroll
        for (int side = 0; side < 2; ++side) {
            const bf16* qb = q + tok * NQD + head * 256 + side * 128;
            bf16x8 qf[8];
#pragma unroll
            for (int s = 0; s < 8; ++s) qf[s] = *(const bf16x8*)(qb + 16 * s + 8 * h);
            float a[16];
#pragma unroll
            for (int i = 0; i < 16; ++i) a[i] = -INFINITY;
#pragma unroll
            for (int kt = 0; kt < 4; ++kt) { f32x16 acc = (f32x16){};
#pragma unroll
                for (int s = 0; s < 8; ++s) { const bf16x8 kf = *(const LAS bf16x8*)(F.lds + side * KR_BYTES + (32 * kt + r32) * KR_STRIDE + (16 * s + 8 * h) * 2);
                    acc = __builtin_amdgcn_mfma_f32_32x32x16_bf16(kf, qf[s], acc, 0, 0, 0); }
#pragma unroll
                for (int r = 0; r < 16; ++r) { const unsigned key = (unsigned)(32 * kt + (r & 3) + 8 * (r >> 2)) | ((unsigned)h << 2);
                    const float v = __uint_as_float((__float_as_uint(acc[r]) & 0xFFFFFF80u) | key); INS16(a, v); }
                __builtin_amdgcn_sched_barrier(0); }
            float c[16];
#pragma unroll
            for (int i = 0; i < 16; ++i) c[i] = __shfl_xor(a[15 - i], 32);
#pragma unroll
            for (int i = 0; i < 16; ++i) c[i] = fmaxf(a[i], c[i]);
            BITONIC16(c);
#pragma unroll
            for (int i = 0; i < 16; ++i) vv[side][i] = c[i];
        }
        { v4u w1, w2;
#define PK4(L, b) ((__float_as_uint(L[b]) & 0x7Fu) | ((__float_as_uint(L[b + 1]) & 0x7Fu) << 8) | ((__float_as_uint(L[b + 2]) & 0x7Fu) << 16) | ((__float_as_uint(L[b + 3]) & 0x7Fu) << 24))
          w1.x = PK4(vv[0], 0); w1.y = PK4(vv[0], 4); w1.z = PK4(vv[0], 8); w1.w = PK4(vv[0], 12);
          w2.x = PK4(vv[1], 0); w2.y = PK4(vv[1], 4); w2.z = PK4(vv[1], 8); w2.w = PK4(vv[1], 12);
#undef PK4
          *(LAS v4u*)scr = w1; *(LAS v4u*)(scr + 16) = w2; }
        float c1[16], c2[16], top[16];
#pragma unroll
        for (int i = 0; i < 16; ++i) { c1[i] = __uint_as_float(__float_as_uint(vv[0][i]) & 0xFFFFFF80u); c2[i] = __uint_as_float(__float_as_uint(vv[1][i]) & 0xFFFFFF80u); top[i] = -INFINITY; }
#pragma unroll
        for (int ia = 0; ia < 16; ++ia)
#pragma unroll
            for (int ib = 0; ib < 16; ++ib) if ((ia + 1) * (ib + 1) <= 16) {
                const float sm = c1[ia] + c2[ib]; const float v = __uint_as_float((__float_as_uint(sm) & 0xFFFFFF00u) | (unsigned)(ia * 16 + ib)); INS16(top, v); }
        float ex[16], den = 0.f;
#pragma unroll
        for (int i = 0; i < 16; ++i) { ex[i] = __expf(top[i] - top[0]); den += ex[i]; }
        const float rden = 1.0f / den;
        LDS_WAIT();
        unsigned short ev[8]; float gv[8];
#pragma unroll
        for (int j = 0; j < 8; ++j) { const float t = h ? top[8 + j] : top[j]; const float e = h ? ex[8 + j] : ex[j];
            const unsigned code = __float_as_uint(t) & 0xFFu; const unsigned i1 = *(const LAS unsigned char*)(scr + (code >> 4)), i2 = *(const LAS unsigned char*)(scr + 16 + (code & 15u));
            ev[j] = (unsigned short)(i1 * 128u + i2); gv[j] = e * rden; }
        v4u ew; ew.x = ev[0] | ((unsigned)ev[1] << 16); ew.y = ev[2] | ((unsigned)ev[3] << 16); ew.z = ev[4] | ((unsigned)ev[5] << 16); ew.w = ev[6] | ((unsigned)ev[7] << 16);
        *(v4u*)(pe + tok * 128 + head * 16 + 8 * h) = ew;
        *(f32x4*)(pg + tok * 128 + head * 16 + 8 * h) = (f32x4){gv[0], gv[1], gv[2], gv[3]};
        *(f32x4*)(pg + tok * 128 + head * 16 + 8 * h + 4) = (f32x4){gv[4], gv[5], gv[6], gv[7]};
        LDS_WAIT();
    }
    __syncthreads();
}
__device__ __forceinline__ float gelu_erf(float x) { return 0.5f * x * (1.0f + erff(x * 0.70710678118654752f)); }
#ifndef NPART
#define NPART 8
#endif
constexpr int TPW = 8, NSWEEP = 1;
constexpr int PSHIFT = (NPART == 32) ? 9 : (NPART == 8) ? 11 : (NPART == 16) ? 10 : (NPART == 4) ? 12 : (NPART == 2) ? 13 : 14;
__device__ __forceinline__ void p8_peer(Frame& F, unsigned emask = 0xffffu, int skip = 0) {
    const float* mod = (const float*)(F.ws + WS_MOD);
    const bf16* x1 = (const bf16*)(F.ws + WS_X1); const bf16* h2 = (const bf16*)(F.ws + WS_H2);
    const unsigned char* ut = F.ws + WS_U; const unsigned char* vt = F.ws + WS_V;
    const float* su = (const float*)(F.ws + WS_SU); const float* sv = (const float*)(F.ws + WS_SV);
    const unsigned* pe = (const unsigned*)(F.ws + WS_PE); const float* pg = (const float*)(F.ws + WS_PG);
    const int gw = F.vcu * NWAVES + F.wave;
    const int b3 = (F.lane >> 3) & 1;
    LAS unsigned* scr = (LAS unsigned*)(F.lds + F.wave * 1024);
#pragma unroll 1
    for (int sweep = 0; sweep < NSWEEP; ++sweep) {
    const int t0 = (gw * NSWEEP + sweep) * TPW, b = t0 >> 13;
    int lane = F.lane; asm volatile("" : "+v"(lane));
    unsigned hq[TPW][4]; float shs[TPW]; unsigned es[TPW]; float gs[TPW][2]; int offv[TPW];
#pragma unroll
    for (int tt = 0; tt < TPW; ++tt) { const size_t t = (size_t)(t0 + tt);
        float hv[16]; float am = 0.f;
#pragma unroll
        for (int j = 0; j < 4; ++j) { const u32x2 v = *(const u32x2*)(h2 + t * DM + 256 * j + 4 * lane); hv[4 * j] = bf_lo(v.x); hv[4 * j + 1] = bf_hi(v.x); hv[4 * j + 2] = bf_lo(v.y); hv[4 * j + 3] = bf_hi(v.y); }
#pragma unroll
        for (int i = 0; i < 16; ++i) am = fmaxf(am, fabsf(hv[i]));
#pragma unroll
        for (int o = 1; o < 64; o <<= 1) am = fmaxf(am, __shfl_xor(am, o));
        if (am == 0.f) am = 1.f;
        const float inv = 127.0f / am; shs[tt] = am * (1.0f / 127.0f);
#pragma unroll
        for (int j = 0; j < 4; ++j) { const int q0 = (int)rintf(hv[4 * j] * inv), q1 = (int)rintf(hv[4 * j + 1] * inv), q2 = (int)rintf(hv[4 * j + 2] * inv), q3 = (int)rintf(hv[4 * j + 3] * inv);
            hq[tt][j] = (unsigned)(q0 & 255) | ((unsigned)(q1 & 255) << 8) | ((unsigned)(q2 & 255) << 16) | ((unsigned)(q3 & 255) << 24); }
        const unsigned pe2 = pe[t * 64 + lane]; const f32x2 pg2 = *(const f32x2*)(pg + t * 128 + 2 * lane);
        const unsigned elo = pe2 & emask, ehi = (pe2 >> 16) & emask; const int plo = (int)(elo >> PSHIFT), phi = (int)(ehi >> PSHIFT);
        int base = 0, poslo = 0, poshi = 0, ov = 0;
#pragma unroll
        for (int r = 0; r < NPART; ++r) { const unsigned long long mlo = __ballot(plo == r), mhi = __ballot(phi == r);
            const int clo = __popcll(mlo), chi = __popcll(mhi);
            const int rlo = (int)__builtin_amdgcn_mbcnt_hi((unsigned)(mlo >> 32), __builtin_amdgcn_mbcnt_lo((unsigned)mlo, 0u));
            const int rhi = (int)__builtin_amdgcn_mbcnt_hi((unsigned)(mhi >> 32), __builtin_amdgcn_mbcnt_lo((unsigned)mhi, 0u));
            if (plo == r) poslo = base + rlo; if (phi == r) poshi = base + clo + rhi;
            base += clo + chi; if (lane == r + 1) ov = base; }
        offv[tt] = ov;
        scr[2 * poslo] = elo; scr[2 * poslo + 1] = __float_as_uint(pg2.x); scr[2 * poshi] = ehi; scr[2 * poshi + 1] = __float_as_uint(pg2.y);
        LDS_WAIT();
        const u32x4 sr = *(const LAS u32x4*)(scr + 4 * lane);
        es[tt] = sr.x | (sr.z << 16); gs[tt][0] = __uint_as_float(sr.y); gs[tt][1] = __uint_as_float(sr.w);
        LDS_WAIT();
    }
#define P8_ISSUE(buf, tbl, tok, bb) do { _Pragma("unroll") for (int k2 = 0; k2 < 4; ++k2) { const unsigned ew = (unsigned)__builtin_amdgcn_readlane((int)es[tok], 4 * (bb) + k2); \
        buf[2 * k2] = *(const u32x4*)((tbl) + (size_t)(ew & 0xffffu) * DM + 16 * lane); buf[2 * k2 + 1] = *(const u32x4*)((tbl) + (size_t)(ew >> 16) * DM + 16 * lane); } } while (0)
    int hidv[TPW][2];
#pragma unroll
    for (int tt = 0; tt < TPW; ++tt) { hidv[tt][0] = 0; hidv[tt][1] = 0; }
    {
        u32x4 bufA[8], bufB[8];
#define P8_DOTS(buf, tok, bb) do { int p[8]; \
            _Pragma("unroll") for (int kk = 0; kk < 8; ++kk) { int s_ = __builtin_amdgcn_sdot4((int)buf[kk].x, (int)hq[tok][0], 0, false); s_ = __builtin_amdgcn_sdot4((int)buf[kk].y, (int)hq[tok][1], s_, false); \
                s_ = __builtin_amdgcn_sdot4((int)buf[kk].z, (int)hq[tok][2], s_, false); s_ = __builtin_amdgcn_sdot4((int)buf[kk].w, (int)hq[tok][3], s_, false); p[kk] = s_; } \
            int q4[4], q2[2], q1; \
            _Pragma("unroll") for (int i = 0; i < 4; ++i) { auto r_ = __builtin_amdgcn_permlane32_swap((unsigned)p[i], (unsigned)p[i + 4], false, false); q4[i] = (int)(r_[0] + r_[1]); } \
            _Pragma("unroll") for (int i = 0; i < 2; ++i) { auto r_ = __builtin_amdgcn_permlane16_swap((unsigned)q4[i], (unsigned)q4[i + 2], false, false); q2[i] = (int)(r_[0] + r_[1]); } \
            { const int keep = b3 ? q2[1] : q2[0], send = b3 ? q2[0] : q2[1]; q1 = keep + __builtin_amdgcn_update_dpp(0, send, 0x128, 0xF, 0xF, true); } \
            q1 += __builtin_amdgcn_update_dpp(0, q1, 0xB1, 0xF, 0xF, true); q1 += __builtin_amdgcn_update_dpp(0, q1, 0x4E, 0xF, 0xF, true); q1 += __builtin_amdgcn_update_dpp(0, q1, 0x141, 0xF, 0xF, true); \
            const int i2_ = (lane & 3) * 2; const int v0_ = __builtin_amdgcn_ds_bpermute(i2_ << 5, q1), v1_ = __builtin_amdgcn_ds_bpermute((i2_ + 1) << 5, q1); \
            if ((lane >> 2) == (bb)) { hidv[tok][0] = v0_; hidv[tok][1] = v1_; } } while (0)
        int cur[TPW];
#pragma unroll
        for (int tt = 0; tt < TPW; ++tt) cur[tt] = 0;
#define P8_STEP_A(tt_, bufX, bufY, r_) { const int end_ = __builtin_amdgcn_readlane(offv[tt_], (r_) + 1); \
            { constexpr int tn_ = ((tt_) + 1) % TPW; const int rn_ = (r_) + ((tt_) + 1) / TPW; \
              if (rn_ < NPART && cur[tn_] < __builtin_amdgcn_readlane(offv[tn_], rn_ + 1)) P8_ISSUE(bufY, ut, tn_, cur[tn_] >> 3); } \
            __builtin_amdgcn_sched_barrier(0); \
            bool pre_ = true; \
            while (cur[tt_] < end_) { if (!pre_) P8_ISSUE(bufX, ut, tt_, cur[tt_] >> 3); pre_ = false; P8_DOTS(bufX, tt_, cur[tt_] >> 3); cur[tt_] += 8; } }
        if ((skip & 1) == 0) {
        if (0 < __builtin_amdgcn_readlane(offv[0], 1)) P8_ISSUE(bufA, ut, 0, 0);
#pragma unroll 1
        for (int r = 0; r < NPART; ++r) {
            P8_STEP_A(0, bufA, bufB, r) P8_STEP_A(1, bufB, bufA, r) P8_STEP_A(2, bufA, bufB, r) P8_STEP_A(3, bufB, bufA, r)
            P8_STEP_A(4, bufA, bufB, r) P8_STEP_A(5, bufB, bufA, r) P8_STEP_A(6, bufA, bufB, r) P8_STEP_A(7, bufB, bufA, r)
        } }
#undef P8_STEP_A
#undef P8_DOTS
    }
#pragma unroll
    for (int tt = 0; tt < TPW; ++tt) { const unsigned e0 = es[tt] & 0xffffu, e1 = es[tt] >> 16;
        const float su0 = su[e0], su1 = su[e1], sv0 = sv[e0], sv1 = sv[e1];
        gs[tt][0] = gelu_erf((float)hidv[tt][0] * (shs[tt] * su0)) * gs[tt][0] * sv0;
        gs[tt][1] = gelu_erf((float)hidv[tt][1] * (shs[tt] * su1)) * gs[tt][1] * sv1; }
    typedef _Float16 f16x2 __attribute__((ext_vector_type(2)));
    f16x2 yh[TPW][8];
#pragma unroll
    for (int tt = 0; tt < TPW; ++tt) {
#pragma unroll
        for (int i = 0; i < 8; ++i) yh[tt][i] = (f16x2){(_Float16)0.f, (_Float16)0.f}; }
    {
        u32x4 bufA[8], bufB[8];
#define BF8ACC(tok, a, word, j) { const unsigned _w = (word); const unsigned _h02 = __builtin_amdgcn_perm(0u, _w, 0x020c000cu), _h13 = __builtin_amdgcn_perm(0u, _w, 0x030c010cu); \
                          yh[tok][2 * (j)] = __builtin_elementwise_fma(__builtin_bit_cast(f16x2, _h02), (a), yh[tok][2 * (j)]); yh[tok][2 * (j) + 1] = __builtin_elementwise_fma(__builtin_bit_cast(f16x2, _h13), (a), yh[tok][2 * (j) + 1]); }
#define P8_ACC(buf, tok, bb) do { _Pragma("unroll") for (int k2 = 0; k2 < 4; ++k2) { \
            const _Float16 h0_ = (_Float16)__int_as_float(__builtin_amdgcn_readlane(__float_as_int(gs[tok][0]), 4 * (bb) + k2)), h1_ = (_Float16)__int_as_float(__builtin_amdgcn_readlane(__float_as_int(gs[tok][1]), 4 * (bb) + k2)); \
            const f16x2 a0_ = (f16x2){h0_, h0_}, a1_ = (f16x2){h1_, h1_}; \
            BF8ACC(tok, a0_, buf[2 * k2].x, 0) BF8ACC(tok, a0_, buf[2 * k2].y, 1) BF8ACC(tok, a0_, buf[2 * k2].z, 2) BF8ACC(tok, a0_, buf[2 * k2].w, 3) \
            BF8ACC(tok, a1_, buf[2 * k2 + 1].x, 0) BF8ACC(tok, a1_, buf[2 * k2 + 1].y, 1) BF8ACC(tok, a1_, buf[2 * k2 + 1].z, 2) BF8ACC(tok, a1_, buf[2 * k2 + 1].w, 3) __builtin_amdgcn_sched_barrier(0); } } while (0)
        int cur[TPW];
#pragma unroll
        for (int tt = 0; tt < TPW; ++tt) cur[tt] = 0;
#define P8_STEP_B(tt_, bufX, bufY, r_) { const int end_ = __builtin_amdgcn_readlane(offv[tt_], (r_) + 1); \
            { constexpr int tn_ = ((tt_) + 1) % TPW; const int rn_ = (r_) + ((tt_) + 1) / TPW; \
              if (rn_ < NPART && cur[tn_] < __builtin_amdgcn_readlane(offv[tn_], rn_ + 1)) P8_ISSUE(bufY, vt, tn_, cur[tn_] >> 3); } \
            __builtin_amdgcn_sched_barrier(0); \
            bool pre_ = true; \
            while (cur[tt_] < end_) { if (!pre_) P8_ISSUE(bufX, vt, tt_, cur[tt_] >> 3); pre_ = false; P8_ACC(bufX, tt_, cur[tt_] >> 3); cur[tt_] += 8; } }
        if ((skip & 2) == 0) {
        if (0 < __builtin_amdgcn_readlane(offv[0], 1)) P8_ISSUE(bufA, vt, 0, 0);
#pragma unroll 1
        for (int r = 0; r < NPART; ++r) {
            P8_STEP_B(0, bufA, bufB, r) P8_STEP_B(1, bufB, bufA, r) P8_STEP_B(2, bufA, bufB, r) P8_STEP_B(3, bufB, bufA, r)
            P8_STEP_B(4, bufA, bufB, r) P8_STEP_B(5, bufB, bufA, r) P8_STEP_B(6, bufA, bufB, r) P8_STEP_B(7, bufB, bufA, r)
        } }
#undef P8_STEP_B
#undef P8_ACC
#undef BF8ACC
    }
#undef P8_ISSUE
#pragma unroll
    for (int tt = 0; tt < TPW; ++tt) { const size_t t = (size_t)(t0 + tt);
        f32x4 v[4]; float s = 0.f;
#pragma unroll
        for (int j = 0; j < 4; ++j) { const int d = 256 * j + 4 * lane; const u32x2 xv = *(const u32x2*)(x1 + t * DM + d); const f32x4 g2 = *(const f32x4*)(mod + b * 6144 + 5120 + d) + 1.0f;
            const f32x4 xf = (f32x4){bf_lo(xv.x), bf_hi(xv.x), bf_lo(xv.y), bf_hi(xv.y)}; const f32x4 yy = (f32x4){(float)yh[tt][2 * j].x, (float)yh[tt][2 * j + 1].x, (float)yh[tt][2 * j].y, (float)yh[tt][2 * j + 1].y};
            v[j] = xf * DN_ALPHA + g2 * yy; s += (v[j][0] + v[j][1]) + (v[j][2] + v[j][3]); }
        const float mean = wave_sum(s) * (1.f / DM); float qq = 0.f;
#pragma unroll
        for (int j = 0; j < 4; ++j) { v[j] = v[j] - mean; qq += (v[j][0] * v[j][0] + v[j][1] * v[j][1]) + (v[j][2] * v[j][2] + v[j][3] * v[j][3]); }
        const float rstd = 1.0f / sqrtf(wave_sum(qq) * (1.f / DM) + LN_EPS);
#pragma unroll
        for (int j = 0; j < 4; ++j) { const int d = 256 * j + 4 * lane; const f32x4 lg = *(const f32x4*)(F.ln2_g + d), lb = *(const f32x4*)(F.ln2_b + d);
            *(f32x4*)(F.out + t * DM + d) = v[j] * rstd * lg + lb; } }
    }
}
#ifndef PROBE_PARTS
#define PROBE_PARTS 0xff
#endif
#ifndef MK_N_LAUNCHES
#define MK_N_LAUNCHES 1
#endif
constexpr int N_PHASES = 9;
struct Args { const float* in[18]; float* out; unsigned char* ws; int ph_lo, ph_hi, p0_parts, pad; };
__global__ void __launch_bounds__(NTHREADS, 2) fwd_kernel(Args args) {
    extern __shared__ __attribute__((aligned(16))) unsigned char lds[];
    Frame F;
    F.lds = (LAS unsigned char*)lds;
    F.tid = threadIdx.x; F.lane = F.tid & 63; F.wave = __builtin_amdgcn_readfirstlane(F.tid >> 6);
    F.G = gridDim.x; { const int bx = blockIdx.x; F.vcu = (F.G % 8 == 0) ? (bx % 8) * (F.G / 8) + bx / 8 : bx; }
    F.x = args.in[0]; F.c = args.in[1]; F.w_ada = args.in[2]; F.b_ada = args.in[3]; F.w_in = args.in[4]; F.sinks = args.in[5]; F.w_pool = args.in[6]; F.pool_scale = args.in[7];
    F.w_out = args.in[8]; F.ln1_g = args.in[9]; F.ln1_b = args.in[10]; F.w_pq = args.in[11]; F.k1 = args.in[12]; F.k2 = args.in[13]; F.pu = args.in[14]; F.pv = args.in[15];
    F.ln2_g = args.in[16]; F.ln2_b = args.in[17]; F.out = args.out; F.ws = args.ws;
    volatile LAS unsigned* MISC = (volatile LAS unsigned*)(F.lds + MISC_OFF);
    for (int u = F.tid; u < (LDS_BYTES - LDSCTL_OFF) / 4; u += NTHREADS) ((LAS unsigned*)(F.lds + LDSCTL_OFF))[u] = 0u;
    __syncthreads();
    const int lo = args.ph_lo, hi = args.ph_hi;
    XcdBarrier bar; bar.bar = (unsigned*)(F.ws + WS_CTL) + CW_BAR; bar.x = 0; bar.st = nullptr;
    if (hi - lo > 1) bar = xcd_barrier_post((unsigned*)(F.ws + WS_CTL) + CW_BAR, MISC + 8);
#ifndef PH_MASK
#define PH_MASK 0x1ff
#endif
#define IN(k) (((PH_MASK >> (k)) & 1) && lo <= (k) && (k) < hi)
#define SEAM(k) do { if (IN(k) && IN((k) + 1)) xcd_barrier(bar); } while (0)
#ifndef REP_MASK
#define REP_MASK 0
#endif
#ifndef REP_CNT
#define REP_CNT 4
#endif
#define REPS(k) (((REP_MASK >> (k)) & 1) * REP_CNT)
#define PHASE_NS(k, ...) if (IN(k)) { _Pragma("unroll 1") for (int _r = 0; _r <= REPS(k); ++_r) { __VA_ARGS__; if (_r < REPS(k)) xcd_barrier(bar); } }
#define PHASE(k, ...) if (IN(k)) { _Pragma("unroll 1") for (int _r = 0; _r <= REPS(k); ++_r) { __VA_ARGS__; if (_r < REPS(k)) xcd_barrier(bar); } } SEAM(k)
#ifndef P0_SUB
#define P0_SUB 0xff
#endif
    PHASE(0, p0_prologue(F, args.p0_parts));
    PHASE(2, { pg8::Gemm g{(const pg8::bf16_t*)(F.ws + WS_XN), (const pg8::bf16_t*)(F.ws + WS_WIN), TT, NIN, DM, 32, (size_t)NIN * DM * 2}; pg8::StaticOrder S; S.init(TT, NIN, F.G, (int)blockIdx.x);
            pg8::EpiRope E{(pg8::bf16_t*)(F.ws + WS_PROJ), NIN, (const float*)(F.ws + WS_ROPE), QSCALE, (const float*)(F.ws + WS_BIAS)};
            pg8::gemm_phase<pg8::EpiRope, pg8::StaticOrder, true, true>(F.lds, g, S, E);
            if ((args.p0_parts & 0x80) && (int)blockIdx.x >= 320 - F.G) p2_tables(F, ((int)blockIdx.x - (320 - F.G)) * NWAVES + F.wave, (2 * F.G - 320) * NWAVES); });
    PHASE(3, { for (int u = F.vcu; u < 256; u += F.G) p3_attn_unit(F, u);
               for (int u = F.vcu; u < 256; u += F.G) p3_pool_unit(F, u); });
    PHASE(4, { pg8::Gemm g{(const pg8::bf16_t*)(F.ws + WS_A2), (const pg8::bf16_t*)(F.ws + WS_WOUT), TT, DM, DM, 1 << 30, 0}; pg8::StaticOrder S; S.init(TT, DM, F.G, (int)blockIdx.x);
            pg8::EpiPlain E{(pg8::bf16_t*)(F.ws + WS_MIX), DM};
            pg8::gemm_phase<pg8::EpiPlain, pg8::StaticOrder, true, true>(F.lds, g, S, E); });
    PHASE(5, p5_ln1(F));
    PHASE_NS(6, { pg8::Gemm g{(const pg8::bf16_t*)(F.ws + WS_H2), (const pg8::bf16_t*)(F.ws + WS_WPQ), TT, NQD, DM, 1 << 30, 0}; pg8::StaticOrder S; S.init(TT, NQD, F.G, (int)blockIdx.x);
            pg8::EpiPlain E{(pg8::bf16_t*)(F.ws + WS_Q), NQD};
            pg8::gemm_phase<pg8::EpiPlain, pg8::StaticOrder, true, true>(F.lds, g, S, E); });
    if (IN(6) && IN(7)) { asm volatile("s_waitcnt vmcnt(0)" ::: "memory"); __syncthreads(); }
    PHASE(7, p7_route(F));
#ifndef P8_FAKE
#define P8_FAKE 0xffffu
#endif
#ifndef P8_SKIP
#define P8_SKIP 0
#endif
    PHASE(8, p8_peer(F, _r == REPS(8) ? 0xffffu : P8_FAKE, _r == REPS(8) ? 0 : P8_SKIP));
#undef IN
#undef SEAM
}

extern "C" void kernel_launch(void* const* d_in, const int* in_sizes, int n_in, void* d_out, int out_size, void* d_ws, size_t ws_size, hipStream_t stream) {
    static int grid = 0;
    if (grid == 0) {
        if (n_in != 18 || out_size != TT * DM || ws_size < WS_END) { fprintf(stderr, "kernel_launch: unexpected shapes (n_in %d out %d ws %zu)\n", n_in, out_size, ws_size); grid = -1; return; }
        int dev = 0, cus = 0, per_cu = 0;
        if (hipGetDevice(&dev) != hipSuccess || hipDeviceGetAttribute(&cus, hipDeviceAttributeMultiprocessorCount, dev) != hipSuccess) { grid = -1; return; }
        if (hipFuncSetAttribute((const void*)fwd_kernel, hipFuncAttributeMaxDynamicSharedMemorySize, LDS_BYTES) != hipSuccess) { fprintf(stderr, "kernel_launch: hipFuncSetAttribute failed\n"); grid = -1; return; }
        if (hipOccupancyMaxActiveBlocksPerMultiprocessor(&per_cu, (const void*)fwd_kernel, NTHREADS, LDS_BYTES) != hipSuccess || per_cu < 1) { fprintf(stderr, "kernel_launch: occupancy query says %d blocks per CU\n", per_cu); }
        (void)hipGetLastError();
        grid = cus;
        if (grid != 256) fprintf(stderr, "kernel_launch: built for 256 CUs, got %d\n", grid);
    }
    if (grid < 0) return;
    (void)hipMemsetAsync((char*)d_ws + WS_CTL, 0, CTL_ZERO_BYTES, stream);
    Args a{};
    for (int i = 0; i < 18; ++i) a.in[i] = (const float*)d_in[i];
    a.out = (float*)d_out; a.ws = (unsigned char*)d_ws; a.p0_parts = 0xff;
#if MK_N_LAUNCHES == 1
    a.ph_lo = 0; a.ph_hi = N_PHASES;
    hipLaunchKernelGGL(fwd_kernel, dim3(grid), dim3(NTHREADS), LDS_BYTES, stream, a);
#ifdef PROBE_PHASE
    for (int i = 0; i < PROBE_N; ++i) { a.ph_lo = PROBE_PHASE; a.ph_hi = PROBE_PHASE + 1; a.p0_parts = PROBE_PARTS; hipLaunchKernelGGL(fwd_kernel, dim3(grid), dim3(NTHREADS), LDS_BYTES, stream, a); }
#endif
#else
    for (int p = 0; p < N_PHASES; ++p) { a.ph_lo = p; a.ph_hi = p + 1; hipLaunchKernelGGL(fwd_kernel, dim3(grid), dim3(NTHREADS), LDS_BYTES, stream, a); }
#endif
}
```

```cpp
#include <hip/hip_runtime.h>
#include <cstdio>
#include <cstdint>
#include <cmath>
namespace pg8 {
#define PG8_LAS __attribute__((address_space(3)))
typedef unsigned short bf16_t;
typedef short bf16x8 __attribute__((ext_vector_type(8)));
typedef float f32x4 __attribute__((ext_vector_type(4)));
typedef unsigned u32x4 __attribute__((ext_vector_type(4)));
constexpr int BM = 256, BK = 64, HALF = 128, HTB = HALF * BK * 2  , STAGE_BYTES = 8 * HTB, NXCD = 8, WGM = 8;

__host__ __device__ __forceinline__ int lds_byte(int r, int c) { const int st = (r >> 4) * 2 + (c >> 5), rr = r & 15, cc = c & 31, ob = rr * 64 + cc * 2; return st * 1024 + (ob ^ (((ob >> 9) & 1) << 5)); }
__host__ __device__ __forceinline__ void stage_rc(int b, int& R, int& C) { const int st = b / 1024, sb = b % 1024, swz = sb ^ (((sb >> 9) & 1) << 5); R = (st >> 1) * 16 + swz / 64; C = (st & 1) * 32 + (swz % 64) / 2; }
__host__ __device__ __forceinline__ int perm32(int rho) { const int n = rho >> 4, i = rho & 15; return 8 * (i >> 2) + 4 * n + (i & 3); }

struct Unit { int pm, pn; };
struct Gemm { const bf16_t* A; const bf16_t* Bt; int M, N, K; int bsplit; size_t bstride; int sc_w, sc_x; };

struct StaticOrder {
    int nM, nN, nwg, G, c;
    __host__ __device__ void init(int M, int N, int G_, int c_) { nM = M / BM; nN = N / BM; nwg = nM * nN; G = G_; c = c_; }
    __host__ __device__ bool next(int i, Unit& u) const {
        const long L = (long)i * G + c; if (L >= nwg) return false;
        int wgid = (int)L; { const int q = nwg / NXCD, r = nwg % NXCD, xcd = wgid % NXCD, off = wgid / NXCD; wgid = (xcd < r ? xcd * (q + 1) : r * (q + 1) + (xcd - r) * q) + off; }
        const int nig = WGM * nN, gid = wgid / nig, fm = gid * WGM, gsz = (nM - fm) < WGM ? (nM - fm) : WGM;
        u.pm = fm + ((wgid % nig) % gsz); u.pn = (wgid % nig) / gsz; return true;
    }
    __device__ __forceinline__ void a_ready(const Unit&) const {}
    __device__ __forceinline__ void done(const Unit&) const {}
};

__device__ __forceinline__ unsigned cvt_pk_bf16(float lo, float hi) { unsigned r; asm volatile("v_cvt_pk_bf16_f32 %0, %1, %2" : "=v"(r) : "v"(lo), "v"(hi)); return r; }

struct EpiPlain {
    static constexpr bool PERM = true, AFTER_DRAIN = false;
    bf16_t* O; int ldc;
    __device__ __forceinline__ void operator()(const f32x4 (&acc)[2][2][4][2], const Unit& u, int wr, int wc, int fr, int fq) const {
        const int row0 = u.pm * BM + wr * 64 + fr; const int col0 = u.pn * BM + wc * 32 + 8 * fq;
#pragma unroll
        for (int ai = 0; ai < 2; ++ai)
#pragma unroll
            for (int m = 0; m < 4; ++m) { bf16_t* rowp = O + (size_t)(row0 + ai * HALF + m * 16) * ldc + col0;
#pragma unroll
                for (int bj = 0; bj < 2; ++bj) { const f32x4 v0 = acc[ai][bj][m][0], v1 = acc[ai][bj][m][1];
                    u32x4 w; w.x = cvt_pk_bf16(v0[0], v0[1]); w.y = cvt_pk_bf16(v0[2], v0[3]); w.z = cvt_pk_bf16(v1[0], v1[1]); w.w = cvt_pk_bf16(v1[2], v1[3]);
                    *(u32x4*)(rowp + bj * HALF) = w; } }
    }
};
struct EpiRope {
    static constexpr bool PERM = true, AFTER_DRAIN = false;
    bf16_t* O; int ldc; const float* rope; float qscale; const float* bias;
    __device__ __forceinline__ void operator()(const f32x4 (&acc)[2][2][4][2], const Unit& u, int wr, int wc, int fr, int fq) const {
        const int row0 = u.pm * BM + wr * 64 + fr; const int col0 = u.pn * BM + wc * 32 + 8 * fq;
#pragma unroll
        for (int ai = 0; ai < 2; ++ai)
#pragma unroll
            for (int m = 0; m < 4; ++m) { const int row = row0 + ai * HALF + m * 16; bf16_t* rowp = O + (size_t)row * ldc + col0; const int pos = row & 8191;
#pragma unroll
                for (int bj = 0; bj < 2; ++bj) { const float* bp = bias + (size_t)(row >> 13) * ldc + col0 + bj * HALF;
                    f32x4 v0 = acc[ai][bj][m][0] + *(const f32x4*)bp, v1 = acc[ai][bj][m][1] + *(const f32x4*)(bp + 4);
                    const int colt = u.pn * BM + bj * HALF;
                    if (colt < 640) {
                        const int c = col0 + bj * HALF, ib = (c & 63) >> 1;
                        const f32x4 cs0 = *(const f32x4*)(rope + ((size_t)pos * 32 + ib) * 2), cs1 = *(const f32x4*)(rope + ((size_t)pos * 32 + ib) * 2 + 4);
                        const float sc = colt < 512 ? qscale : 1.0f;
                        f32x4 r0, r1;
                        r0[0] = (v0[0] * cs0[0] - v0[1] * cs0[1]) * sc; r0[1] = (v0[1] * cs0[0] + v0[0] * cs0[1]) * sc;
                        r0[2] = (v0[2] * cs0[2] - v0[3] * cs0[3]) * sc; r0[3] = (v0[3] * cs0[2] + v0[2] * cs0[3]) * sc;
                        r1[0] = (v1[0] * cs1[0] - v1[1] * cs1[1]) * sc; r1[1] = (v1[1] * cs1[0] + v1[0] * cs1[1]) * sc;
                        r1[2] = (v1[2] * cs1[2] - v1[3] * cs1[3]) * sc; r1[3] = (v1[3] * cs1[2] + v1[2] * cs1[3]) * sc;
                        v0 = r0; v1 = r1;
                    }
                    u32x4 w; w.x = cvt_pk_bf16(v0[0], v0[1]); w.y = cvt_pk_bf16(v0[2], v0[3]); w.z = cvt_pk_bf16(v1[0], v1[1]); w.w = cvt_pk_bf16(v1[2], v1[3]);
                    *(u32x4*)(rowp + bj * HALF) = w; } }
    }
};

template <class Epi, class Sched, bool ALIGN_EPI = false, bool SP2 = false, bool FP8 = false>
__device__ __forceinline__ void gemm_phase(PG8_LAS unsigned char* lds, const Gemm g, const Sched& S, const Epi& E) {
    typedef int pg8_i32x4 __attribute__((ext_vector_type(4))); typedef int pg8_frag __attribute__((ext_vector_type(8)));
    const int tid = threadIdx.x, wid = __builtin_amdgcn_readfirstlane(tid >> 6), lane = tid & 63, wr = wid >> 2, wc = wid & 3, fr = lane & 15, fq = lane >> 4;
    const int K = g.K, nt = K / BK;
    unsigned voffA[2], voffB[2];
#pragma unroll
    for (int i = 0; i < 2; ++i) { int R, C; stage_rc(tid * 16 + i * 8192, R, C); const int Rb = Epi::PERM ? ((R & ~31) + perm32(R & 31)) : R;
        voffA[i] = (unsigned)(R * K + C) * 2u; voffB[i] = (unsigned)(Rb * K + C) * 2u; }
    const size_t kstep = (size_t)(BK * 2);
    const size_t hstep = (size_t)HALF * K * 2;
    const size_t tstep = 2 * hstep;
    const unsigned ldsw = (unsigned)wid * 1024u;
    const int aoff = lds_byte(wr * 64 + fr, fq * 8), boff = lds_byte(wc * 32 + fr, fq * 8);
#define PG8_SA(b, h) (((b) * 2 + (h)) * HTB)
#define PG8_SB(b, h) ((4 + (b) * 2 + (h)) * HTB)
#define PG8_STAGE(bufoff, gbase, voff) do { _Pragma("unroll") for (int _i = 0; _i < 2; ++_i) \
        __builtin_amdgcn_global_load_lds((const unsigned*)((const char*)(gbase) + (voff)[_i]), (PG8_LAS unsigned*)(lds + (bufoff) + ldsw + _i * 8192), 16, 0, 0); } while (0)
#define PG8_LDA(dst, b, h) do { _Pragma("unroll") for (int m = 0; m < 4; ++m) { const pg8_i32x4 l0_ = *(const PG8_LAS pg8_i32x4*)(lds + PG8_SA(b, h) + aoff + m * 2048), l1_ = *(const PG8_LAS pg8_i32x4*)(lds + PG8_SA(b, h) + aoff + m * 2048 + 1024); dst[m] = __builtin_shufflevector(l0_, l1_, 0, 1, 2, 3, 4, 5, 6, 7); } } while (0)
#define PG8_LDB(dst, b, h) do { _Pragma("unroll") for (int n = 0; n < 2; ++n) { const pg8_i32x4 l0_ = *(const PG8_LAS pg8_i32x4*)(lds + PG8_SB(b, h) + boff + n * 2048), l1_ = *(const PG8_LAS pg8_i32x4*)(lds + PG8_SB(b, h) + boff + n * 2048 + 1024); dst[n] = __builtin_shufflevector(l0_, l1_, 0, 1, 2, 3, 4, 5, 6, 7); } } while (0)
#define PG8_H0(f) __builtin_bit_cast(bf16x8, __builtin_shufflevector((f), (f), 0, 1, 2, 3))
#define PG8_H1(f) __builtin_bit_cast(bf16x8, __builtin_shufflevector((f), (f), 4, 5, 6, 7))
#define PG8_MMA(ai, bj, At, Bt) do { __builtin_amdgcn_s_setprio(1); \
        if constexpr (FP8) { _Pragma("unroll") for (int m = 0; m < 4; ++m) _Pragma("unroll") for (int n = 0; n < 2; ++n) \
            asm volatile("v_mfma_scale_f32_16x16x128_f8f6f4 %0, %1, %2, %0, %3, %4 op_sel_hi:[0,0,0]" : "+v"(acc[ai][bj][m][n]) : "v"(Bt[n]), "v"(At[m]), "v"(scw_), "v"(scx_)); } \
        else { _Pragma("unroll") for (int m = 0; m < 4; ++m) _Pragma("unroll") for (int n = 0; n < 2; ++n) { \
            acc[ai][bj][m][n] = __builtin_amdgcn_mfma_f32_16x16x32_bf16(PG8_H0(Bt[n]), PG8_H0(At[m]), acc[ai][bj][m][n], 0, 0, 0); \
            acc[ai][bj][m][n] = __builtin_amdgcn_mfma_f32_16x16x32_bf16(PG8_H1(Bt[n]), PG8_H1(At[m]), acc[ai][bj][m][n], 0, 0, 0); } } \
        __builtin_amdgcn_s_setprio(0); } while (0)
#define PG8_WAIT_V(n) asm volatile("s_waitcnt vmcnt(" #n ")" ::: "memory")
#define PG8_WAIT_L(n) asm volatile("s_waitcnt lgkmcnt(" #n ")" ::: "memory")
#define PG8_BAR __builtin_amdgcn_s_barrier()
#define PG8_SCHED __builtin_amdgcn_sched_barrier(0)
    Unit cur, nxt; int ui = 0;
    if (!S.next(0, cur)) return;
    f32x4 acc[2][2][4][2];
#pragma unroll
    for (int a = 0; a < 2; ++a)
#pragma unroll
        for (int b = 0; b < 2; ++b)
#pragma unroll
            for (int m = 0; m < 4; ++m)
#pragma unroll
                for (int n = 0; n < 2; ++n) acc[a][b][m][n] = (f32x4){0.f, 0.f, 0.f, 0.f};
    pg8_frag At[4], B0[2], B1[2]; const int scw_ = g.sc_w, scx_ = g.sc_x;
    const char* cA = (const char*)g.A + (size_t)cur.pm * tstep; const char* cB = (const char*)g.Bt + (size_t)cur.pn * tstep + (cur.pm >= g.bsplit ? g.bstride : (size_t)0);
    S.a_ready(cur);
    if constexpr (SP2) {
        PG8_STAGE(PG8_SB(0, 0), cB, voffB); PG8_STAGE(PG8_SB(0, 1), cB + hstep, voffB); PG8_STAGE(PG8_SA(0, 0), cA, voffA); PG8_STAGE(PG8_SA(0, 1), cA + hstep, voffA);
        if (wr == 1) PG8_BAR;
        PG8_WAIT_V(2); PG8_BAR;
        PG8_STAGE(PG8_SB(1, 0), cB + kstep, voffB); PG8_STAGE(PG8_SA(1, 0), cA + kstep, voffA); PG8_STAGE(PG8_SB(1, 1), cB + hstep + kstep, voffB);
        PG8_WAIT_V(6); PG8_BAR;
    } else {
        PG8_STAGE(PG8_SB(0, 0), cB, voffB); PG8_STAGE(PG8_SA(0, 0), cA, voffA); PG8_STAGE(PG8_SB(0, 1), cB + hstep, voffB); PG8_STAGE(PG8_SA(0, 1), cA + hstep, voffA);
        if (wr == 1) PG8_BAR;
        PG8_WAIT_V(4); PG8_BAR;
        PG8_STAGE(PG8_SB(1, 0), cB + kstep, voffB); PG8_STAGE(PG8_SA(1, 0), cA + kstep, voffA); PG8_STAGE(PG8_SB(1, 1), cB + hstep + kstep, voffB);
        PG8_WAIT_V(6); PG8_BAR;
    }
    for (;;) {
        const bool has_next = S.next(ui + 1, nxt);
        const char* nA = has_next ? (const char*)g.A + (size_t)nxt.pm * tstep : cA; const char* nB = has_next ? (const char*)g.Bt + (size_t)nxt.pn * tstep + (nxt.pm >= g.bsplit ? g.bstride : (size_t)0) : cB;
        _Pragma("unroll 1") for (int t = 0; t < nt; t += 2) {
            const bool last = (t == nt - 2);
            const char* a1 = cA + (size_t)(t + 1) * kstep;
            const char* a2 = last ? nA : cA + (size_t)(t + 2) * kstep; const char* b2 = last ? nB : cB + (size_t)(t + 2) * kstep;
            const char* a3 = a2 + kstep; const char* b3 = b2 + kstep;
            if (last && has_next) S.a_ready(nxt);
            if constexpr (SP2) {
            PG8_LDB(B0, 0, 0); PG8_LDB(B1, 0, 1); PG8_SCHED; PG8_LDA(At, 0, 0); PG8_STAGE(PG8_SA(1, 1), a1 + hstep, voffA);
            PG8_WAIT_V(8); PG8_WAIT_L(0); PG8_BAR; PG8_MMA(0, 0, At, B0); PG8_MMA(0, 1, At, B1); PG8_BAR; PG8_SCHED;
            PG8_LDA(At, 0, 1); PG8_STAGE(PG8_SB(0, 0), b2, voffB); PG8_STAGE(PG8_SB(0, 1), b2 + hstep, voffB); PG8_STAGE(PG8_SA(0, 0), a2, voffA);
            PG8_WAIT_V(8); PG8_WAIT_L(0); PG8_BAR; PG8_MMA(1, 0, At, B0); PG8_MMA(1, 1, At, B1); PG8_BAR; PG8_SCHED;
            PG8_LDB(B0, 1, 0); PG8_LDB(B1, 1, 1); PG8_SCHED; PG8_LDA(At, 1, 0); PG8_STAGE(PG8_SA(0, 1), a2 + hstep, voffA);
            PG8_WAIT_V(8); PG8_WAIT_L(0); PG8_BAR; PG8_MMA(0, 0, At, B0); PG8_MMA(0, 1, At, B1); PG8_BAR; PG8_SCHED;
            PG8_LDA(At, 1, 1); PG8_STAGE(PG8_SB(1, 0), b3, voffB); PG8_STAGE(PG8_SB(1, 1), b3 + hstep, voffB); PG8_STAGE(PG8_SA(1, 0), a3, voffA);
            PG8_WAIT_V(8); PG8_WAIT_L(0); PG8_BAR; PG8_MMA(1, 0, At, B0); PG8_MMA(1, 1, At, B1); PG8_BAR; PG8_SCHED;
            } else {
            PG8_LDB(B0, 0, 0); PG8_SCHED; PG8_LDA(At, 0, 0); PG8_STAGE(PG8_SA(1, 1), a1 + hstep, voffA);
            PG8_WAIT_L(8); PG8_BAR; PG8_WAIT_L(0); PG8_MMA(0, 0, At, B0); PG8_BAR; PG8_SCHED;
            PG8_LDB(B1, 0, 1); PG8_STAGE(PG8_SB(0, 0), b2, voffB);
            PG8_BAR; PG8_WAIT_L(0); PG8_MMA(0, 1, At, B1); PG8_BAR;
            PG8_LDA(At, 0, 1); PG8_STAGE(PG8_SA(0, 0), a2, voffA);
            PG8_BAR; PG8_WAIT_L(0); PG8_MMA(1, 0, At, B0); PG8_BAR; PG8_SCHED;
            PG8_STAGE(PG8_SB(0, 1), b2 + hstep, voffB);
            PG8_WAIT_V(6); PG8_BAR; PG8_MMA(1, 1, At, B1); PG8_BAR;
            PG8_LDB(B0, 1, 0); PG8_SCHED; PG8_LDA(At, 1, 0); PG8_STAGE(PG8_SA(0, 1), a2 + hstep, voffA);
            PG8_WAIT_L(8); PG8_BAR; PG8_WAIT_L(0); PG8_MMA(0, 0, At, B0); PG8_BAR; PG8_SCHED;
            PG8_LDB(B1, 1, 1); PG8_STAGE(PG8_SB(1, 0), b3, voffB);
            PG8_BAR; PG8_WAIT_L(0); PG8_MMA(0, 1, At, B1); PG8_BAR;
            PG8_LDA(At, 1, 1); PG8_STAGE(PG8_SA(1, 0), a3, voffA);
            PG8_BAR; PG8_WAIT_L(0); PG8_MMA(1, 0, At, B0); PG8_BAR; PG8_SCHED;
            PG8_STAGE(PG8_SB(1, 1), b3 + hstep, voffB);
            PG8_WAIT_V(6); PG8_BAR; PG8_MMA(1, 1, At, B1); PG8_BAR;
            }
        }
        if constexpr (ALIGN_EPI) { if (wr == 0) PG8_BAR; }
        if constexpr (FP8) {
            asm volatile("s_nop 15\n\ts_nop 15" ::: "memory");
#pragma unroll
            for (int a = 0; a < 2; ++a)
#pragma unroll
                for (int b = 0; b < 2; ++b)
#pragma unroll
                    for (int m = 0; m < 4; ++m)
#pragma unroll
                        for (int n = 0; n < 2; ++n) asm volatile("" : "+v"(acc[a][b][m][n]));
        }
        if constexpr (!Epi::AFTER_DRAIN) { E(acc, cur, wr, wc, fr, fq); S.done(cur); }
        if (!has_next) break;
#pragma unroll
        for (int a = 0; a < 2; ++a)
#pragma unroll
            for (int b = 0; b < 2; ++b)
#pragma unroll
                for (int m = 0; m < 4; ++m)
#pragma unroll
                    for (int n = 0; n < 2; ++n) acc[a][b][m][n] = (f32x4){0.f, 0.f, 0.f, 0.f};
        cur = nxt; cA = nA; cB = nB; ++ui;
        if constexpr (ALIGN_EPI) { if (wr == 1) PG8_BAR; }
    }
    PG8_WAIT_V(0);
    if constexpr (!ALIGN_EPI) { if (wr == 0) PG8_BAR; }
    PG8_BAR;
    if constexpr (Epi::AFTER_DRAIN) { E.fused(acc, cur, wr, wc, fr, fq, lds, wid, lane); S.done(cur); }
#undef PG8_SA
#undef PG8_SB
#undef PG8_STAGE
#undef PG8_LDA
#undef PG8_LDB
#undef PG8_MMA
#undef PG8_H0
#undef PG8_H1
#undef PG8_WAIT_V
#undef PG8_WAIT_L
#undef PG8_BAR
#undef PG8_SCHED
}
}
#define GAS __attribute__((address_space(1)))
#define LAS __attribute__((address_space(3)))
typedef unsigned short bf16;
typedef unsigned v4u __attribute__((ext_vector_type(4)));
typedef float f32x4 __attribute__((ext_vector_type(4)));
typedef short bf16x8 __attribute__((ext_vector_type(8)));
typedef GAS unsigned gu32;
typedef GAS unsigned long long gu64;
#define RLX_AGENT __ATOMIC_RELAXED, __HIP_MEMORY_SCOPE_AGENT
#define LDS_WAIT() asm volatile("s_waitcnt lgkmcnt(0)" ::: "memory")
#define VM_WAIT() asm volatile("s_waitcnt vmcnt(0)" ::: "memory")
__device__ __forceinline__ unsigned long long rt() { return __builtin_amdgcn_s_memrealtime(); }
__device__ __forceinline__ unsigned f2bf(float f) { unsigned u = __builtin_bit_cast(unsigned, f); return (u + 0x7fffu + ((u >> 16) & 1u)) >> 16; }
__device__ __forceinline__ unsigned pk2(float lo, float hi) { return f2bf(lo) | (f2bf(hi) << 16); }
#define XB_TMO      128
#define XB_XCNT(j)  (256  + 64 * (j))
#define XB_XSUB(j)  (1280 + 64 * (j))
#define XB_XGEN(j)  (2304 + 64 * (j))
#define XB_TOP      3328
#define XB_TOPGEN   3392
#define XCD_BAR_WORDS 3456
#define XB_SPIN_CAP (1u << 18)

__device__ __forceinline__ unsigned xb_ld(unsigned* p)              { return __hip_atomic_load(p, __ATOMIC_RELAXED, __HIP_MEMORY_SCOPE_AGENT); }
__device__ __forceinline__ unsigned xb_add(unsigned* p, unsigned v) { return __hip_atomic_fetch_add(p, v, __ATOMIC_RELAXED, __HIP_MEMORY_SCOPE_AGENT); }
__device__ __forceinline__ unsigned xb_xcc_id() { return (unsigned)__builtin_amdgcn_s_getreg((3 << 11) | 20) & 0xFu; }
#define XB_SPIN(cond, bar) do { unsigned _sp = 0; while (cond) { __builtin_amdgcn_s_sleep(1); \
    if ((++_sp & 255u) == 0u) { if (xb_ld(&(bar)[XB_TMO])) break; if (_sp > XB_SPIN_CAP) { atomicAdd(&(bar)[XB_TMO], 1u); break; } } } } while (0)

struct XcdBarrier {
    unsigned* bar; unsigned x;
    volatile LAS unsigned* st;
};

__device__ __forceinline__ XcdBarrier xcd_barrier_post(unsigned* bar, volatile LAS unsigned* st) {
    XcdBarrier b; b.bar = bar; b.x = xb_xcc_id(); b.st = st;
    if (threadIdx.x == 0) (void)xb_add(&bar[XB_XCNT(b.x)], 1u);
    return b;
}
__device__ __forceinline__ void xcd_barrier_complete(unsigned* bar, unsigned x, unsigned& nloc, unsigned& nx) {
    const unsigned G = gridDim.x * gridDim.y * gridDim.z;
    unsigned sum, cnt, mine, sp = 0u;
    for (;;) {
        sum = 0u; cnt = 0u; mine = 0u;
#pragma unroll
        for (unsigned j = 0; j < 16; ++j) { const unsigned c = xb_ld(&bar[XB_XCNT(j)]); sum += c; cnt += (c > 0u) ? 1u : 0u; mine = (j == x) ? c : mine; }
        if (sum == G) break;
        __builtin_amdgcn_s_sleep(1);
        if ((++sp & 255u) == 0u) { if (xb_ld(&bar[XB_TMO])) break; if (sp > XB_SPIN_CAP) { atomicAdd(&bar[XB_TMO], 1u); break; } }
    }
    nloc = mine > 0u ? mine : 1u; nx = cnt > 0u ? cnt : 1u;
}

__device__ __forceinline__ void xcd_barrier(const XcdBarrier& b) {
    asm volatile("s_waitcnt vmcnt(0)" ::: "memory");
    __syncthreads();
    if (threadIdx.x == 0) {
        unsigned* bar = b.bar;
        __builtin_amdgcn_s_waitcnt(0);
        unsigned nloc = b.st[0], nx = b.st[1];
        if (nloc == 0u) { xcd_barrier_complete(bar, b.x, nloc, nx); b.st[0] = nloc; b.st[1] = nx; }
        const unsigned old = xb_add(&bar[XB_XSUB(b.x)], 1u);
        const unsigned gen = old / nloc;
        if (old + 1u == (gen + 1u) * nloc) {
            __builtin_amdgcn_fence(__ATOMIC_RELEASE, "agent");
            asm volatile("s_waitcnt vmcnt(0)" ::: "memory");
            const unsigned og = xb_add(&bar[XB_TOP], 1u);
            const unsigned tg = og / nx;
            if (og + 1u == (tg + 1u) * nx) xb_add(&bar[XB_TOPGEN], 1u);
            else XB_SPIN(xb_ld(&bar[XB_TOPGEN]) == tg, bar);
            __builtin_amdgcn_fence(__ATOMIC_ACQUIRE, "agent");
            xb_add(&bar[XB_XGEN(b.x)], 1u);
            asm volatile("s_waitcnt vmcnt(0)" ::: "memory");
        } else {
            XB_SPIN(xb_ld(&bar[XB_XGEN(b.x)]) == gen, bar);
            __builtin_amdgcn_fence(__ATOMIC_ACQUIRE, "agent");
            asm volatile("s_waitcnt vmcnt(0)" ::: "memory");
        }
    }
    __syncthreads();
}
constexpr int NWAVES = 8, NTHREADS = 512;
constexpr int TT = 16384, DM = 1024, SEQ = 8192, NIN = 1280, NQD = 2048, NEXP = 16384;
constexpr float DN_ALPHA = 1.189207115002721f;
constexpr float LN_EPS = 1e-5f;
constexpr float LOG2E = 1.4426950408889634f;
constexpr float QSCALE = 0.125f * LOG2E;

constexpr size_t MiB = 1u << 20;
constexpr size_t WS_CTL = 0, CTL_ZERO_BYTES = 64 * 1024;
constexpr size_t WS_MOD = 1 * MiB + 896 * 1024;
constexpr size_t WS_ROPE = 2 * MiB;
constexpr size_t WS_WIN = 248 * MiB;
constexpr size_t WS_BIAS = 4 * MiB;
constexpr size_t WS_K1 = 6 * MiB + 512 * 1024, WS_K2 = WS_K1 + 32 * 1024;
constexpr size_t WS_WOUT = 7 * MiB;
constexpr size_t WS_WPQ = 9 * MiB;
constexpr size_t WS_SU = 13 * MiB, WS_SV = 13 * MiB + 65536;
constexpr size_t WS_U = 16 * MiB, WS_V = 32 * MiB;
constexpr size_t WS_H2Q = 48 * MiB, WS_SH = 13 * MiB + 131072;
constexpr size_t WS_XN8 = 64 * MiB;
constexpr size_t WS_XN = 80 * MiB;
constexpr size_t WS_MIX = 112 * MiB;
constexpr size_t WS_PE = 80 * MiB, WS_PG = 84 * MiB;
constexpr size_t WS_PROJ = 112 * MiB;
constexpr size_t WS_A2 = 152 * MiB;
constexpr size_t WS_X1 = 184 * MiB, WS_H2 = 216 * MiB;
constexpr size_t WS_Q = 112 * MiB;
constexpr size_t WS_END = 253 * MiB;
constexpr int CW_MODCNT = 1024;
constexpr int CW_BAR = 4096;

constexpr int RING_BYTES = 131072, LDSCTL_OFF = RING_BYTES, MISC_OFF = LDSCTL_OFF + 320, LDS_BYTES = 147456;

typedef float f32x16 __attribute__((ext_vector_type(16)));
typedef float f32x2 __attribute__((ext_vector_type(2)));
typedef unsigned u32x2 __attribute__((ext_vector_type(2)));
typedef unsigned u32x4 __attribute__((ext_vector_type(4)));
typedef __bf16 bf16x2_t __attribute__((ext_vector_type(2)));
struct Frame {
    LAS unsigned char* lds;
    int tid, lane, wave, vcu, G;
    const float *x, *c, *w_ada, *b_ada, *w_in, *sinks, *w_pool, *pool_scale, *w_out, *ln1_g, *ln1_b, *w_pq, *k1, *k2, *pu, *pv, *ln2_g, *ln2_b;
    float* out; unsigned char* ws;
};
__device__ __forceinline__ float wave_sum(float v) {
#pragma unroll
    for (int o = 1; o < 64; o <<= 1) v += __shfl_xor(v, o);
    return v;
}
__device__ __forceinline__ float bf_lo(unsigned u) { return __uint_as_float(u << 16); }
__device__ __forceinline__ float bf_hi(unsigned u) { return __uint_as_float(u & 0xffff0000u); }
__device__ __forceinline__ float bf2f(bf16 b) { return __uint_as_float((unsigned)b << 16); }
__device__ __forceinline__ unsigned fp8x4(float a, float b, float c, float d) { int pk = __builtin_amdgcn_cvt_pk_fp8_f32(a, b, 0, false); pk = __builtin_amdgcn_cvt_pk_fp8_f32(c, d, pk, true); return (unsigned)pk; }

template <int MODE, bool OUT8 = false>
__device__ __forceinline__ void transpose_item(const float* W, int ldw, bf16* WT, int ldt, int k0, int n0, LAS float* scr, int lane, const LAS float* ksc = nullptr, float oscale = 1.0f) {
    int nsrc = n0 + (lane & 31);
    if (MODE == 1 && nsrc < 640) { const int hd = nsrc >> 6, w = nsrc & 63; nsrc = hd * 64 + (w >> 1) + 32 * (w & 1); }
    float wv[32];
#pragma unroll
    for (int i = 0; i < 32; ++i) wv[i] = W[(size_t)(k0 + 2 * i + (lane >> 5)) * ldw + nsrc];
#pragma unroll
    for (int i = 0; i < 32; ++i) { const int kk = 2 * i + (lane >> 5); float w_ = wv[i]; if (MODE == 1) w_ *= ksc[k0 + kk]; scr[kk * 33 + (lane & 31)] = w_; }
    LDS_WAIT(); asm volatile("" ::: "memory");
    const int c = lane & 7;
#pragma unroll
    for (int j = 0; j < 4; ++j) { const int n = (lane >> 3) + 8 * j; const LAS float* s = scr + (8 * c) * 33 + n;
        if (OUT8) { u32x2 o8; o8.x = fp8x4(s[0 * 33] * oscale, s[1 * 33] * oscale, s[2 * 33] * oscale, s[3 * 33] * oscale); o8.y = fp8x4(s[4 * 33] * oscale, s[5 * 33] * oscale, s[6 * 33] * oscale, s[7 * 33] * oscale);
            *(u32x2*)((unsigned char*)WT + (size_t)(n0 + n) * ldt + k0 + 8 * c) = o8; }
        else { v4u o; o.x = pk2(s[0 * 33], s[1 * 33]); o.y = pk2(s[2 * 33], s[3 * 33]); o.z = pk2(s[4 * 33], s[5 * 33]); o.w = pk2(s[6 * 33], s[7 * 33]);
            *(GAS v4u*)(WT + (size_t)(n0 + n) * ldt + k0 + 8 * c) = o; } }
    LDS_WAIT(); asm volatile("" ::: "memory");
}
__device__ __forceinline__ void sincos_d(double a, float& s, float& c) {
    const double TWO_PI = 6.283185307179586476925, PI = 3.141592653589793238462643;
    double r = a - TWO_PI * rint(a / TWO_PI);
    double sg = 1.0;
    if (r > 0.5 * PI) { r = PI - r; sg = -1.0; } else if (r < -0.5 * PI) { r = -PI - r; sg = -1.0; }
    const double r2 = r * r;
    double sp = -1.0 / 121645100408832000.0;
    sp = sp * r2 + 1.0 / 355687428096000.0; sp = sp * r2 - 1.0 / 1307674368000.0; sp = sp * r2 + 1.0 / 6227020800.0; sp = sp * r2 - 1.0 / 39916800.0;
    sp = sp * r2 + 1.0 / 362880.0; sp = sp * r2 - 1.0 / 5040.0; sp = sp * r2 + 1.0 / 120.0; sp = sp * r2 - 1.0 / 6.0; sp = sp * r2 + 1.0;
    double cp = 1.0 / 6402373705728000.0;
    cp = cp * r2 - 1.0 / 20922789888000.0; cp = cp * r2 + 1.0 / 87178291200.0; cp = cp * r2 - 1.0 / 479001600.0; cp = cp * r2 + 1.0 / 3628800.0;
    cp = cp * r2 - 1.0 / 40320.0; cp = cp * r2 + 1.0 / 720.0; cp = cp * r2 - 1.0 / 24.0; cp = cp * r2 + 0.5; cp = 1.0 - cp * r2;
    s = (float)(sp * r); c = (float)(sg * cp);
}
__device__ __forceinline__ void p1_win(Frame& F);
__device__ __forceinline__ void p0_prologue(Frame& F, int parts = 0xff) {
    LAS float* scr = (LAS float*)(F.lds + F.wave * 16384);
    const int gw = F.vcu * NWAVES + F.wave, NGW = F.G * NWAVES, lane = F.lane;
    if ((parts & 1) && F.vcu < 96) { const int col = F.vcu * 64 + lane; float a0 = 0.f, a1 = 0.f;
        LAS float* sl = (LAS float*)(F.lds + F.wave * 16384 + 8448);
#pragma unroll
        for (int q = 0; q < 2; ++q) { const int k = F.wave * 128 + 64 * q + lane; const float c0 = F.c[k], c1 = F.c[DM + k];
            sl[64 * q + lane] = c0 / (1.f + __expf(-c0)); sl[128 + 64 * q + lane] = c1 / (1.f + __expf(-c1)); }
        LDS_WAIT(); asm volatile("" ::: "memory");
#pragma unroll 1
        for (int kb = 0; kb < 128; kb += 64) { float w[64];
#pragma unroll
            for (int u = 0; u < 64; ++u) w[u] = F.w_ada[(size_t)(F.wave * 128 + kb + u) * 6144 + col];
#pragma unroll
            for (int u = 0; u < 64; ++u) { a0 += sl[kb + u] * w[u]; a1 += sl[128 + kb + u] * w[u]; } }
        LAS float* red = (LAS float*)(F.lds + F.wave * 16384 + 12288); red[lane] = a0; red[64 + lane] = a1;
        __syncthreads();
        if (F.tid < 128) { const int bb = F.tid >> 6, l = F.tid & 63; float sacc = F.b_ada[F.vcu * 64 + l];
#pragma unroll
            for (int w = 0; w < 8; ++w) sacc += ((const LAS float*)(F.lds + w * 16384 + 12288))[bb * 64 + l];
            ((float*)(F.ws + WS_MOD))[bb * 6144 + F.vcu * 64 + l] = sacc; }
        asm volatile("s_waitcnt vmcnt(0)" ::: "memory"); __syncthreads();
        if (F.tid == 0) { __builtin_amdgcn_fence(__ATOMIC_RELEASE, "agent"); asm volatile("s_waitcnt vmcnt(0)" ::: "memory");
            __hip_atomic_fetch_add((unsigned*)(F.ws + WS_CTL) + CW_MODCNT, 1u, __ATOMIC_RELAXED, __HIP_MEMORY_SCOPE_AGENT); } }
    if (parts & 2) { float* rope = (float*)(F.ws + WS_ROPE);
      for (int e = gw * 64 + lane; e < SEQ * 32; e += NGW * 64) { const int pos = e >> 5, i = e & 31;
          const float freq = powf(10000.0f, -(float)i / 32.0f); const float ang = (float)pos * freq; float s, c; sincos_d((double)ang, s, c);
          rope[2 * e] = c; rope[2 * e + 1] = s; } }
    if (parts & 4) { constexpr int I_PQ = 16 * 64, I_OUT = 8 * 32;
      for (int it = NGW - 1 - gw; it < I_PQ + I_OUT; it += NGW) { int r = it;
          if (r < I_PQ) { transpose_item<0>(F.w_pq, NQD, (bf16*)(F.ws + WS_WPQ), DM, 64 * (r / 64), 32 * (r % 64), scr, lane); continue; } r -= I_PQ;
          transpose_item<0, true>(F.w_out, DM, (bf16*)(F.ws + WS_WOUT), DM, 64 * (r / 32), 32 * (r % 32), scr, lane, nullptr, 64.0f); } }
    if (parts & 8) { unsigned char* wout_t = F.ws + WS_WOUT;
      for (int it = gw; it < 4 * 2 * 128; it += NGW) { const int g = it >> 8, ch = (it >> 7) & 1, n0 = (it & 127) * 8, cidx = ch * 64 + lane;
          const float* wo = F.w_out + (size_t)(512 + g * 128) * DM + n0; const float* ps = F.pool_scale + g * 128;
#pragma unroll
          for (int i = 0; i < 4; ++i) { const int f4 = lane + 64 * i, e = f4 >> 1, hf = f4 & 1; const f32x4 o = *(const f32x4*)(wo + (size_t)e * DM + 4 * hf) * ps[e]; *(LAS f32x4*)(scr + e * 8 + 4 * hf) = o; }
          float acc[8];
#pragma unroll
          for (int i = 0; i < 8; ++i) acc[i] = 0.f;
          const float* wp = F.w_pool + ((size_t)(g * 128 + cidx)) * 128;
          LDS_WAIT(); asm volatile("" ::: "memory");
#pragma unroll 1
          for (int e0 = 0; e0 < 128; e0 += 64) { f32x4 wv[16];
#pragma unroll
              for (int q = 0; q < 16; ++q) wv[q] = *(const f32x4*)(wp + e0 + 4 * q);
#pragma unroll
              for (int q = 0; q < 16; ++q)
#pragma unroll
                  for (int ee = 0; ee < 4; ++ee) { const float w = wv[q][ee]; const f32x4 o0 = *(const LAS f32x4*)(scr + (e0 + 4 * q + ee) * 8), o1 = *(const LAS f32x4*)(scr + (e0 + 4 * q + ee) * 8 + 4);
                      acc[0] += w * o0[0]; acc[1] += w * o0[1]; acc[2] += w * o0[2]; acc[3] += w * o0[3]; acc[4] += w * o1[0]; acc[5] += w * o1[1]; acc[6] += w * o1[2]; acc[7] += w * o1[3]; } }
#pragma unroll
          for (int i = 0; i < 8; ++i) wout_t[(size_t)(n0 + i) * DM + 512 + g * 128 + cidx] = (unsigned char)(fp8x4(acc[i] * 64.0f, 0.f, 0.f, 0.f) & 0xffu);
          LDS_WAIT(); asm volatile("" ::: "memory"); } }
    if (parts & 16) { bf16* k1b = (bf16*)(F.ws + WS_K1); bf16* k2b = (bf16*)(F.ws + WS_K2);
      for (int e = gw * 64 + lane; e < 128 * 128; e += NGW * 64) { k1b[e] = (bf16)f2bf(F.k1[e]); k2b[e] = (bf16)f2bf(F.k2[e]); } }
    if (parts & 32) { bf16* xn = (bf16*)(F.ws + WS_XN); const int rpw = TT / NGW;
      for (int m = gw * rpw; m < gw * rpw + rpw; m += 4) { f32x4 v[4][4];
#pragma unroll
          for (int q = 0; q < 4; ++q)
#pragma unroll
              for (int j = 0; j < 4; ++j) v[q][j] = *(const f32x4*)(F.x + (size_t)(m + q) * DM + 256 * j + 4 * lane);
#pragma unroll
          for (int q = 0; q < 4; ++q)
#pragma unroll
              for (int j = 0; j < 4; ++j) { u32x2 o; o.x = pk2(v[q][j][0], v[q][j][1]); o.y = pk2(v[q][j][2], v[q][j][3]); *(u32x2*)(xn + (size_t)(m + q) * DM + 256 * j + 4 * lane) = o;
                  *(unsigned*)(F.ws + WS_XN8 + (size_t)(m + q) * DM + 256 * j + 4 * lane) = fp8x4(v[q][j][0], v[q][j][1], v[q][j][2], v[q][j][3]); } } }
    if (parts & 64) {
        __syncthreads();
        if (F.tid == 0) { unsigned sp = 0; const unsigned* cnt = (const unsigned*)(F.ws + WS_CTL) + CW_MODCNT;
            while (__hip_atomic_load(cnt, __ATOMIC_RELAXED, __HIP_MEMORY_SCOPE_AGENT) < 96u) { __builtin_amdgcn_s_sleep(2); if (++sp > (1u << 22)) break; }
            __builtin_amdgcn_fence(__ATOMIC_ACQUIRE, "agent"); asm volatile("s_waitcnt vmcnt(0)" ::: "memory"); }
        __syncthreads();
        p1_win(F);
    }
}
__device__ __forceinline__ void tb_load4(Frame& F, int base, int r1, f32x4 (&dst)[4][4]) {
#pragma unroll
    for (int q = 0; q < 4; ++q) { const int it = (base + q < r1) ? base + q : r1 - 1; const int tb = it >= NEXP, e = it - tb * NEXP; const float* src = (tb ? F.pv : F.pu) + (size_t)e * DM;
#pragma unroll
        for (int j = 0; j < 4; ++j) dst[q][j] = *(const f32x4*)(src + 256 * j + 4 * F.lane); }
}
__device__ __forceinline__ void tb_proc4(Frame& F, int base, int r1, const f32x4 (&v)[4][4]) {
    const int lane = F.lane; float* su = (float*)(F.ws + WS_SU); float* sv = (float*)(F.ws + WS_SV); float am[4];
#pragma unroll
    for (int q = 0; q < 4; ++q) { float a = 0.f;
#pragma unroll
        for (int j = 0; j < 4; ++j) a = fmaxf(a, fmaxf(fmaxf(fabsf(v[q][j][0]), fabsf(v[q][j][1])), fmaxf(fabsf(v[q][j][2]), fabsf(v[q][j][3])))); am[q] = a; }
#pragma unroll
    for (int o = 1; o < 64; o <<= 1) {
#pragma unroll
        for (int q = 0; q < 4; ++q) am[q] = fmaxf(am[q], __shfl_xor(am[q], o)); }
#pragma unroll
    for (int q = 0; q < 4; ++q) { const int it = (base + q < r1) ? base + q : r1 - 1; const int tb = it >= NEXP, e = it - tb * NEXP; float a = am[q]; if (a == 0.f) a = 1.f;
        unsigned w[4];
        if (!tb) { const float inv = 127.0f / a;
#pragma unroll
            for (int j = 0; j < 4; ++j) { const int q0 = (int)rintf(v[q][j][0] * inv), q1 = (int)rintf(v[q][j][1] * inv), q2 = (int)rintf(v[q][j][2] * inv), q3 = (int)rintf(v[q][j][3] * inv);
                w[j] = (unsigned)(q0 & 255) | ((unsigned)(q1 & 255) << 8) | ((unsigned)(q2 & 255) << 16) | ((unsigned)(q3 & 255) << 24); }
            *(v4u*)(F.ws + WS_U + (size_t)e * DM + 16 * lane) = (v4u){w[0], w[1], w[2], w[3]}; if (lane == 0) su[e] = a * (1.0f / 127.0f);
        } else { const float inv = 256.0f / a;
#pragma unroll
            for (int j = 0; j < 4; ++j) { int pk = __builtin_amdgcn_cvt_pk_bf8_f32(v[q][j][0] * inv, v[q][j][1] * inv, 0, false); pk = __builtin_amdgcn_cvt_pk_bf8_f32(v[q][j][2] * inv, v[q][j][3] * inv, pk, true); w[j] = (unsigned)pk; }
            *(v4u*)(F.ws + WS_V + (size_t)e * DM + 16 * lane) = (v4u){w[0], w[1], w[2], w[3]}; if (lane == 0) sv[e] = a * (1.0f / 256.0f); } }
}
__device__ __forceinline__ void p2_tables(Frame& F, int cw, int ncw, int row_lo, int row_hi) {
    const int per = (row_hi - row_lo + ncw - 1) / ncw, r0 = row_lo + cw * per, r1 = (r0 + per) < row_hi ? (r0 + per) : row_hi;
    if (r0 >= r1) return;
    f32x4 va[4][4], vb[4][4];
    tb_load4(F, r0, r1, va);
    for (int it0 = r0; it0 < r1; it0 += 8) {
        if (it0 + 4 < r1) tb_load4(F, it0 + 4, r1, vb);
        tb_proc4(F, it0, r1, va);
        if (it0 + 4 < r1) { if (it0 + 8 < r1) tb_load4(F, it0 + 8, r1, va); tb_proc4(F, it0 + 4, r1, vb); }
    }
}
__device__ __forceinline__ void p1_win(Frame& F) {
    const float* mod = (const float*)(F.ws + WS_MOD);
    LAS float* sc = (LAS float*)F.lds; LAS float* sh = sc + 2048;
    for (int i = F.tid; i < 2048; i += NTHREADS) { const int b = i >> 10, k = i & 1023; sc[i] = 1.f + mod[b * 6144 + 1024 + k]; sh[i] = mod[b * 6144 + k]; }
    __syncthreads();
    const int lane = F.lane;
    if (F.vcu < 40) { const int b = F.vcu / 20, n = (F.vcu % 20) * 64 + lane; int nsrc = n; if (n < 640) { const int hd = n >> 6, w = n & 63; nsrc = hd * 64 + (w >> 1) + 32 * (w & 1); }
        float a = 0.f;
#pragma unroll 1
        for (int kb = 0; kb < 128; kb += 64) { float w[64];
#pragma unroll
            for (int u = 0; u < 64; ++u) w[u] = F.w_in[(size_t)(F.wave * 128 + kb + u) * NIN + nsrc];
#pragma unroll
            for (int u = 0; u < 64; ++u) a += sh[b * 1024 + F.wave * 128 + kb + u] * w[u]; }
        LAS float* red = (LAS float*)(F.lds + 16384); red[F.wave * 64 + lane] = a;
        __syncthreads();
        if (F.tid < 64) { float sacc = 0.f;
#pragma unroll
            for (int w = 0; w < 8; ++w) sacc += red[w * 64 + F.tid];
            ((float*)(F.ws + WS_BIAS))[b * NIN + (F.vcu % 20) * 64 + F.tid] = sacc; } }
    LAS float* scr = (LAS float*)(F.lds + 32768 + F.wave * 8448);
    const int gw = F.vcu * NWAVES + F.wave, NGW = F.G * NWAVES;
    for (int it = gw; it < 2 * 640; it += NGW) { const int b = it / 640, r = it % 640;
        transpose_item<1, true>(F.w_in, NIN, (bf16*)(F.ws + WS_WIN + (size_t)b * NIN * DM), DM, 64 * (r / 40), 32 * (r % 40), scr, lane, sc + b * 1024, 64.0f); }
    __syncthreads();
}
constexpr int KS_STRIDE = 144, VT_STRIDE = 520, KS_BYTES = 256 * KS_STRIDE, VT_BYTES = 64 * VT_STRIDE;
__device__ __forceinline__ void p3_attn_unit(Frame& F, int unit) {
    const int b = unit >> 7, kvh = (unit >> 6) & 1, n = unit & 63;
    const bf16* proj = (const bf16*)(F.ws + WS_PROJ); unsigned char* a2 = F.ws + WS_A2;
    LAS unsigned char* Ks = F.lds; LAS unsigned char* Vt = F.lds + KS_BYTES;
    const int tid = F.tid, lane = F.lane, wave = F.wave, r32 = lane & 31, h = lane >> 5;
    const size_t tok0 = (size_t)b * SEQ + (size_t)n * 128;
#pragma unroll
    for (int i = 0; i < 4; ++i) { const int ci = tid + NTHREADS * i, row = ci >> 3, ch = ci & 7; const bool valid = (n > 0) || (row >= 128);
        const size_t tk = tok0 - 128 + row;
        v4u kv = (v4u){0u, 0u, 0u, 0u}, vv = (v4u){0u, 0u, 0u, 0u};
        if (valid) { kv = *(const v4u*)(proj + tk * NIN + 512 + kvh * 64 + ch * 8); vv = *(const v4u*)(proj + tk * NIN + 640 + kvh * 64 + ch * 8); }
        *(LAS v4u*)(Ks + row * KS_STRIDE + ch * 16) = kv;
        LAS bf16* vt = (LAS bf16*)(Vt + (ch * 8) * VT_STRIDE) + row;
        vt[0 * (VT_STRIDE / 2)] = (bf16)(vv.x & 0xffff); vt[1 * (VT_STRIDE / 2)] = (bf16)(vv.x >> 16); vt[2 * (VT_STRIDE / 2)] = (bf16)(vv.y & 0xffff); vt[3 * (VT_STRIDE / 2)] = (bf16)(vv.y >> 16);
        vt[4 * (VT_STRIDE / 2)] = (bf16)(vv.z & 0xffff); vt[5 * (VT_STRIDE / 2)] = (bf16)(vv.z >> 16); vt[6 * (VT_STRIDE / 2)] = (bf16)(vv.w & 0xffff); vt[7 * (VT_STRIDE / 2)] = (bf16)(vv.w >> 16); }
    __syncthreads();
    const int g = wave >> 1, hq = kvh * 4 + g; const float sink2 = F.sinks[hq] * LOG2E;
#pragma unroll 1
    for (int qt = 0; qt < 2; ++qt) {
        const int qi0 = (wave & 1) * 64 + qt * 32, t0 = qi0 >> 5; const size_t tokq = tok0 + qi0 + r32;
        bf16x8 qf[4];
#pragma unroll
        for (int s = 0; s < 4; ++s) qf[s] = *(const bf16x8*)(proj + tokq * NIN + hq * 64 + 16 * s + 8 * h);
        f32x16 sc[5];
#pragma unroll
        for (int kt = 0; kt < 5; ++kt) { sc[kt] = (f32x16){};
#pragma unroll
            for (int s = 0; s < 4; ++s) { const bf16x8 kf = *(const LAS bf16x8*)(Ks + (32 * (t0 + kt) + r32) * KS_STRIDE + (16 * s + 8 * h) * 2);
                sc[kt] = __builtin_amdgcn_mfma_f32_32x32x16_bf16(kf, qf[s], sc[kt], 0, 0, 0); } }
        const int qi = qi0 + r32; float m = sink2;
#pragma unroll
        for (int kt = 0; kt < 5; ++kt)
#pragma unroll
            for (int r = 0; r < 16; ++r) { const int sidx = 32 * (t0 + kt) + (r & 3) + 8 * (r >> 2) + 4 * h; const int rel = qi + 128 - sidx;
                const bool ok = (rel >= 0) && (rel < 128) && ((n > 0) || (sidx >= 128));
                const float v = ok ? sc[kt][r] : -INFINITY; sc[kt][r] = v; m = fmaxf(m, v); }
        m = fmaxf(m, __shfl_xor(m, 32));
        float l = 0.f;
#pragma unroll
        for (int kt = 0; kt < 5; ++kt)
#pragma unroll
            for (int r = 0; r < 16; ++r) { const float p = __builtin_amdgcn_exp2f(sc[kt][r] - m); sc[kt][r] = p; l += p; }
        l += __shfl_xor(l, 32); l += __builtin_amdgcn_exp2f(sink2 - m);
        f32x16 o[2]; o[0] = (f32x16){}; o[1] = (f32x16){};
#pragma unroll
        for (int kt = 0; kt < 5; ++kt)
#pragma unroll
            for (int s2 = 0; s2 < 2; ++s2) {
                u32x4 pw; pw.x = pg8::cvt_pk_bf16(sc[kt][8 * s2 + 0], sc[kt][8 * s2 + 1]); pw.y = pg8::cvt_pk_bf16(sc[kt][8 * s2 + 2], sc[kt][8 * s2 + 3]);
                pw.z = pg8::cvt_pk_bf16(sc[kt][8 * s2 + 4], sc[kt][8 * s2 + 5]); pw.w = pg8::cvt_pk_bf16(sc[kt][8 * s2 + 6], sc[kt][8 * s2 + 7]);
                const bf16x8 pf = __builtin_bit_cast(bf16x8, pw);
#pragma unroll
                for (int dt = 0; dt < 2; ++dt) { const LAS unsigned char* vp = Vt + (dt * 32 + r32) * VT_STRIDE + (32 * (t0 + kt) + 16 * s2 + 4 * h) * 2;
                    const u32x2 lo = *(const LAS u32x2*)vp, hi = *(const LAS u32x2*)(vp + 16);
                    const u32x4 vw = (u32x4){lo.x, lo.y, hi.x, hi.y};
                    o[dt] = __builtin_amdgcn_mfma_f32_32x32x16_bf16(__builtin_bit_cast(bf16x8, vw), pf, o[dt], 0, 0, 0); } }
        const float inv = 16.0f / l;
#pragma unroll
        for (int dt = 0; dt < 2; ++dt)
#pragma unroll
            for (int rg = 0; rg < 4; ++rg) { const int d0 = dt * 32 + 8 * rg + 4 * h;
                *(unsigned*)(a2 + tokq * DM + hq * 64 + d0) = fp8x4(o[dt][4 * rg + 0] * inv, o[dt][4 * rg + 1] * inv, o[dt][4 * rg + 2] * inv, o[dt][4 * rg + 3] * inv); }
    }
    __syncthreads();
}
__device__ __forceinline__ void p3_pool_unit(Frame& F, int unit) {
    const bf16* proj = (const bf16*)(F.ws + WS_PROJ); unsigned char* a2 = F.ws + WS_A2;
    const int cp = F.tid & 255, half = F.tid >> 8, gi = cp >> 6, w = 2 << gi;
    const int tstart = unit * 64 + half * 32, s0 = tstart & (SEQ - 1);
    const bf16* pc = proj + 768 + 2 * cp;
    unsigned u[48];
#pragma unroll
    for (int i = 0; i < 48; ++i) { const int s = s0 - 16 + i; u[i] = (s >= 0) ? *(const unsigned*)(pc + (size_t)(tstart - 16 + i) * NIN) : 0u; }
    float w0 = 0.f, w1 = 0.f;
#pragma unroll
    for (int j = 1; j <= 16; ++j) if (j <= w) { w0 += bf_lo(u[16 - j]); w1 += bf_hi(u[16 - j]); }
#pragma unroll
    for (int i = 0; i < 32; ++i) { const int s = s0 + i; const float p0 = bf_lo(u[16 + i]), p1 = bf_hi(u[16 + i]);
        const unsigned uo = (w == 2) ? u[14 + i] : (w == 4) ? u[12 + i] : (w == 8) ? u[8 + i] : u[i];
        w0 += p0 - bf_lo(uo); w1 += p1 - bf_hi(uo);
        const float rc = 1.0f / (float)((s + 1) < w ? (s + 1) : w);
        *(unsigned short*)(a2 + (size_t)(tstart + i) * DM + 512 + 2 * cp) = (unsigned short)(fp8x4((w0 * rc - p0) * 16.0f, (w1 * rc - p1) * 16.0f, 0.f, 0.f) & 0xffffu); }
}
__device__ __forceinline__ void p5_ln1(Frame& F) {
    const float* mod = (const float*)(F.ws + WS_MOD); const bf16* mix = (const bf16*)(F.ws + WS_MIX); const bf16* xn = (const bf16*)(F.ws + WS_XN);
    bf16* x1 = (bf16*)(F.ws + WS_X1); bf16* h2 = (bf16*)(F.ws + WS_H2); unsigned char* h2q = F.ws + WS_H2Q; float* shp = (float*)(F.ws + WS_SH);
    const int gw = F.vcu * NWAVES + F.wave, lane = F.lane; const int rows_per_wave = TT / (F.G * NWAVES);
    const int row0 = gw * rows_per_wave, b = row0 >> 13;
    f32x4 g1[4], lg[4], lb[4], s2[4], h2s[4];
#pragma unroll
    for (int j = 0; j < 4; ++j) { const int d = 256 * j + 4 * lane;
        g1[j] = *(const f32x4*)(mod + b * 6144 + 2048 + d) + 1.0f; lg[j] = *(const f32x4*)(F.ln1_g + d); lb[j] = *(const f32x4*)(F.ln1_b + d);
        s2[j] = *(const f32x4*)(mod + b * 6144 + 4096 + d) + 1.0f; h2s[j] = *(const f32x4*)(mod + b * 6144 + 3072 + d); }
    for (int r = 0; r < rows_per_wave; r += 2) {
        u32x2 xw[2][4]; u32x2 mv[2][4];
#pragma unroll
        for (int q = 0; q < 2; ++q)
#pragma unroll
            for (int j = 0; j < 4; ++j) { const size_t m = (size_t)(row0 + r + q); const int d = 256 * j + 4 * lane; xw[q][j] = *(const u32x2*)(xn + m * DM + d); mv[q][j] = *(const u32x2*)(mix + m * DM + d); }
#pragma unroll
        for (int q = 0; q < 2; ++q) { const size_t m = (size_t)(row0 + r + q);
        f32x4 v[4]; float s = 0.f;
#pragma unroll
        for (int j = 0; j < 4; ++j) {
            const f32x4 mf = (f32x4){bf_lo(mv[q][j].x), bf_hi(mv[q][j].x), bf_lo(mv[q][j].y), bf_hi(mv[q][j].y)};
            const f32x4 xf = (f32x4){bf_lo(xw[q][j].x), bf_hi(xw[q][j].x), bf_lo(xw[q][j].y), bf_hi(xw[q][j].y)};
            v[j] = xf * DN_ALPHA + g1[j] * mf; s += (v[j][0] + v[j][1]) + (v[j][2] + v[j][3]); }
        const float mean = wave_sum(s) * (1.f / DM); float qq = 0.f;
#pragma unroll
        for (int j = 0; j < 4; ++j) { v[j] = v[j] - mean; qq += (v[j][0] * v[j][0] + v[j][1] * v[j][1]) + (v[j][2] * v[j][2] + v[j][3] * v[j][3]); }
        const float rstd = 1.0f / sqrtf(wave_sum(qq) * (1.f / DM) + LN_EPS);
        f32x4 hh[4]; float am = 0.f;
#pragma unroll
        for (int j = 0; j < 4; ++j) { const int d = 256 * j + 4 * lane; const f32x4 y = v[j] * rstd * lg[j] + lb[j]; hh[j] = y * s2[j] + h2s[j];
            u32x2 o; o.x = pk2(y[0], y[1]); o.y = pk2(y[2], y[3]); *(u32x2*)(x1 + m * DM + d) = o;
            u32x2 p; p.x = pk2(hh[j][0], hh[j][1]); p.y = pk2(hh[j][2], hh[j][3]); *(u32x2*)(h2 + m * DM + d) = p;
            hh[j] = (f32x4){bf_lo(p.x), bf_hi(p.x), bf_lo(p.y), bf_hi(p.y)};
            am = fmaxf(am, fmaxf(fmaxf(fabsf(hh[j][0]), fabsf(hh[j][1])), fmaxf(fabsf(hh[j][2]), fabsf(hh[j][3])))); }
#pragma unroll
        for (int o = 1; o < 64; o <<= 1) am = fmaxf(am, __shfl_xor(am, o));
        if (am == 0.f) am = 1.f;
        const float inv = 127.0f / am; unsigned w[4];
#pragma unroll
        for (int j = 0; j < 4; ++j) { const int q0 = (int)rintf(hh[j][0] * inv), q1 = (int)rintf(hh[j][1] * inv), q2 = (int)rintf(hh[j][2] * inv), q3 = (int)rintf(hh[j][3] * inv);
            w[j] = (unsigned)(q0 & 255) | ((unsigned)(q1 & 255) << 8) | ((unsigned)(q2 & 255) << 16) | ((unsigned)(q3 & 255) << 24); }
        *(v4u*)(h2q + m * DM + 16 * lane) = (v4u){w[0], w[1], w[2], w[3]}; if (lane == 0) shp[m] = am * (1.0f / 127.0f); } }
}
constexpr int KR_STRIDE = 272, KR_BYTES = 128 * KR_STRIDE;
#define INS16(a, v) do { _Pragma("unroll") for (int _i = 15; _i >= 1; --_i) a[_i] = __builtin_amdgcn_fmed3f(a[_i - 1], a[_i], (v)); a[0] = fmaxf(a[0], (v)); } while (0)
#define BITONIC16(a) do { _Pragma("unroll") for (int _st = 8; _st >= 1; _st >>= 1) { _Pragma("unroll") for (int _i = 0; _i < 16; ++_i) if ((_i & _st) == 0) { const float _x = a[_i], _y = a[_i + _st]; a[_i] = fmaxf(_x, _y); a[_i + _st] = fminf(_x, _y); } } } while (0)
__device__ __forceinline__ void p7_route(Frame& F) {
    const bf16* q = (const bf16*)(F.ws + WS_Q); unsigned short* pe = (unsigned short*)(F.ws + WS_PE); float* pg = (float*)(F.ws + WS_PG);
    const int tid = F.tid, lane = F.lane, wave = F.wave, r32 = lane & 31, h = lane >> 5;
    { const bf16* k1b = (const bf16*)(F.ws + WS_K1);
      for (int ci = tid; ci < 2 * 128 * 16; ci += NTHREADS) { const int side = ci >> 11, row = (ci >> 4) & 127, ch = ci & 15;
          *(LAS v4u*)(F.lds + side * KR_BYTES + row * KR_STRIDE + ch * 16) = *(const v4u*)(k1b + (size_t)side * 16384 + row * 128 + ch * 8); } }
    __syncthreads();
    LAS unsigned char* scr = F.lds + 2 * KR_BYTES + wave * 2048 + lane * 32;
    pg8::StaticOrder S; S.init(TT, NQD, F.G, (int)blockIdx.x); pg8::Unit u;
    for (int ui = 0; S.next(ui, u); ++ui) {
        const int head = u.pn; const size_t tok = (size_t)u.pm * 256 + wave * 32 + r32;
        float vv[2][16];
#pragma unroll
        for (int side = 0; side < 2; ++side) {
            const bf16* qb = q + tok * NQD + head * 256 + side * 128;
            bf16x8 qf[8];
#pragma unroll
            for (int s = 0; s < 8; ++s) qf[s] = *(const bf16x8*)(qb + 16 * s + 8 * h);
            float a[16];
#pragma unroll
            for (int i = 0; i < 16; ++i) a[i] = -INFINITY;
#pragma unroll
            for (int kt = 0; kt < 4; ++kt) { f32x16 acc = (f32x16){};
#pragma unroll
                for (int s = 0; s < 8; ++s) { const bf16x8 kf = *(const LAS bf16x8*)(F.lds + side * KR_BYTES + (32 * kt + r32) * KR_STRIDE + (16 * s + 8 * h) * 2);
                    acc = __builtin_amdgcn_mfma_f32_32x32x16_bf16(kf, qf[s], acc, 0, 0, 0); }
#pragma unroll
                for (int r = 0; r < 16; ++r) { const unsigned key = (unsigned)(32 * kt + (r & 3) + 8 * (r >> 2)) | ((unsigned)h << 2);
                    const float v = __uint_as_float((__float_as_uint(acc[r]) & 0xFFFFFF80u) | key); INS16(a, v); }
                __builtin_amdgcn_sched_barrier(0); }
            float c[16];
#pragma unroll
            for (int i = 0; i < 16; ++i) c[i] = __shfl_xor(a[15 - i], 32);
#pragma unroll
            for (int i = 0; i < 16; ++i) c[i] = fmaxf(a[i], c[i]);
            BITONIC16(c);
#pragma unroll
            for (int i = 0; i < 16; ++i) vv[side][i] = c[i];
        }
        { v4u w1, w2;
#define PK4(L, b) ((__float_as_uint(L[b]) & 0x7Fu) | ((__float_as_uint(L[b + 1]) & 0x7Fu) << 8) | ((__float_as_uint(L[b + 2]) & 0x7Fu) << 16) | ((__float_as_uint(L[b + 3]) & 0x7Fu) << 24))
          w1.x = PK4(vv[0], 0); w1.y = PK4(vv[0], 4); w1.z = PK4(vv[0], 8); w1.w = PK4(vv[0], 12);
          w2.x = PK4(vv[1], 0); w2.y = PK4(vv[1], 4); w2.z = PK4(vv[1], 8); w2.w = PK4(vv[1], 12);
#undef PK4
          *(LAS v4u*)scr = w1; *(LAS v4u*)(scr + 16) = w2; }
        float c1[16], c2[16], top[16];
#pragma unroll
        for (int i = 0; i < 16; ++i) { c1[i] = __uint_as_float(__float_as_uint(vv[0][i]) & 0xFFFFFF80u); c2[i] = __uint_as_float(__float_as_uint(vv[1][i]) & 0xFFFFFF80u); top[i] = -INFINITY; }
#pragma unroll
        for (int ia = 0; ia < 16; ++ia)
#pragma unroll
            for (int ib = 0; ib < 16; ++ib) if ((ia + 1) * (ib + 1) <= 16) {
                const float sm = c1[ia] + c2[ib]; const float v = __uint_as_float((__float_as_uint(sm) & 0xFFFFFF00u) | (unsigned)(ia * 16 + ib)); INS16(top, v); }
        float ex[16], den = 0.f;
#pragma unroll
        for (int i = 0; i < 16; ++i) { ex[i] = __expf(top[i] - top[0]); den += ex[i]; }
        const float rden = 1.0f / den;
        LDS_WAIT();
        unsigned short ev[8]; float gv[8];
#pragma unroll
        for (int j = 0; j < 8; ++j) { const float t = h ? top[8 + j] : top[j]; const float e = h ? ex[8 + j] : ex[j];
            const unsigned code = __float_as_uint(t) & 0xFFu; const unsigned i1 = *(const LAS unsigned char*)(scr + (code >> 4)), i2 = *(const LAS unsigned char*)(scr + 16 + (code & 15u));
            ev[j] = (unsigned short)(i1 * 128u + i2); gv[j] = e * rden; }
        v4u ew; ew.x = ev[0] | ((unsigned)ev[1] << 16); ew.y = ev[2] | ((unsigned)ev[3] << 16); ew.z = ev[4] | ((unsigned)ev[5] << 16); ew.w = ev[6] | ((unsigned)ev[7] << 16);
        *(v4u*)(pe + tok * 128 + head * 16 + 8 * h) = ew;
        *(f32x4*)(pg + tok * 128 + head * 16 + 8 * h) = (f32x4){gv[0], gv[1], gv[2], gv[3]};
        *(f32x4*)(pg + tok * 128 + head * 16 + 8 * h + 4) = (f32x4){gv[4], gv[5], gv[6], gv[7]};
        LDS_WAIT();
    }
    __syncthreads();
}
__device__ __forceinline__ float gelu_erf(float v) {
    const float d = fabsf(v) * 0.2316418882f + 1.0f, t = __builtin_amdgcn_rcpf(d);
    float q = t * 0.5307027145f + (-0.7265760135f); q = q * t + 0.7107068705f; q = q * t + (-0.142248368f); q = q * t + 0.127414796f; q = q * t;
    const float e = __builtin_amdgcn_exp2f(v * v * (-0.72134752044f)), m = v * (q * e);
    return v < 0.f ? m : v - m; }
#ifndef NPART
#define NPART 8
#endif
constexpr int TPW = 8, NSWEEP = 1;
constexpr int PSHIFT = (NPART == 32) ? 9 : (NPART == 8) ? 11 : (NPART == 16) ? 10 : (NPART == 4) ? 12 : (NPART == 2) ? 13 : 14;
__device__ __forceinline__ void p8_peer(Frame& F, unsigned emask = 0xffffu, int skip = 0) {
    const float* mod = (const float*)(F.ws + WS_MOD);
    const bf16* x1 = (const bf16*)(F.ws + WS_X1); const bf16* h2 = (const bf16*)(F.ws + WS_H2);
    const unsigned char* ut = F.ws + WS_U; const unsigned char* vt = F.ws + WS_V;
    const float* su = (const float*)(F.ws + WS_SU); const float* sv = (const float*)(F.ws + WS_SV);
    const unsigned* pe = (const unsigned*)(F.ws + WS_PE); const float* pg = (const float*)(F.ws + WS_PG);
    const int gw = F.vcu * NWAVES + F.wave;
    const int b3 = (F.lane >> 3) & 1;
    LAS unsigned* scr = (LAS unsigned*)(F.lds + F.wave * 1024);
#pragma unroll 1
    for (int sweep = 0; sweep < NSWEEP; ++sweep) {
    const int t0 = (gw * NSWEEP + sweep) * TPW, b = t0 >> 13;
    int lane = F.lane; asm volatile("" : "+v"(lane));
    unsigned hq[TPW][4]; float shs[TPW]; unsigned es[TPW]; float gs[TPW][2]; int offv[TPW];
#pragma unroll
    for (int tt = 0; tt < TPW; ++tt) { const size_t t = (size_t)(t0 + tt);
        { const u32x4 hw = *(const u32x4*)(F.ws + WS_H2Q + t * DM + 16 * lane); hq[tt][0] = hw.x; hq[tt][1] = hw.y; hq[tt][2] = hw.z; hq[tt][3] = hw.w; shs[tt] = ((const float*)(F.ws + WS_SH))[t]; }
        const unsigned pe2 = pe[t * 64 + lane]; const f32x2 pg2 = *(const f32x2*)(pg + t * 128 + 2 * lane);
        const unsigned elo = pe2 & emask, ehi = (pe2 >> 16) & emask; const int plo = (int)(elo >> PSHIFT), phi = (int)(ehi >> PSHIFT);
        int base = 0, poslo = 0, poshi = 0, ov = 0;
#pragma unroll
        for (int r = 0; r < NPART; ++r) { const unsigned long long mlo = __ballot(plo == r), mhi = __ballot(phi == r);
            const int clo = __popcll(mlo), chi = __popcll(mhi);
            const int rlo = (int)__builtin_amdgcn_mbcnt_hi((unsigned)(mlo >> 32), __builtin_amdgcn_mbcnt_lo((unsigned)mlo, 0u));
            const int rhi = (int)__builtin_amdgcn_mbcnt_hi((unsigned)(mhi >> 32), __builtin_amdgcn_mbcnt_lo((unsigned)mhi, 0u));
            if (plo == r) poslo = base + rlo; if (phi == r) poshi = base + clo + rhi;
            base += clo + chi; if (lane == r + 1) ov = base; }
        offv[tt] = ov;
        scr[2 * poslo] = elo; scr[2 * poslo + 1] = __float_as_uint(pg2.x); scr[2 * poshi] = ehi; scr[2 * poshi + 1] = __float_as_uint(pg2.y);
        LDS_WAIT();
        const u32x4 sr = *(const LAS u32x4*)(scr + 4 * lane);
        es[tt] = sr.x | (sr.z << 16); gs[tt][0] = __uint_as_float(sr.y); gs[tt][1] = __uint_as_float(sr.w);
        LDS_WAIT();
    }
#define P8_ISSUE(buf, tbl, tok, bb) do { _Pragma("unroll") for (int k2 = 0; k2 < 4; ++k2) { const unsigned ew = (unsigned)__builtin_amdgcn_readlane((int)es[tok], 4 * (bb) + k2); \
        buf[2 * k2] = *(const u32x4*)((tbl) + (size_t)(ew & 0xffffu) * DM + 16 * lane); buf[2 * k2 + 1] = *(const u32x4*)((tbl) + (size_t)(ew >> 16) * DM + 16 * lane); } } while (0)
    int hidv[TPW][2];
#pragma unroll
    for (int tt = 0; tt < TPW; ++tt) { hidv[tt][0] = 0; hidv[tt][1] = 0; }
    {
        u32x4 bufA[8], bufB[8];
#define P8_DOTS(buf, tok, bb) do { int p[8]; \
            _Pragma("unroll") for (int kk = 0; kk < 8; ++kk) { int s_ = __builtin_amdgcn_sdot4((int)buf[kk].x, (int)hq[tok][0], 0, false); s_ = __builtin_amdgcn_sdot4((int)buf[kk].y, (int)hq[tok][1], s_, false); \
                s_ = __builtin_amdgcn_sdot4((int)buf[kk].z, (int)hq[tok][2], s_, false); s_ = __builtin_amdgcn_sdot4((int)buf[kk].w, (int)hq[tok][3], s_, false); p[kk] = s_; } \
            int q4[4], q2[2], q1; \
            _Pragma("unroll") for (int i = 0; i < 4; ++i) { auto r_ = __builtin_amdgcn_permlane32_swap((unsigned)p[i], (unsigned)p[i + 4], false, false); q4[i] = (int)(r_[0] + r_[1]); } \
            _Pragma("unroll") for (int i = 0; i < 2; ++i) { auto r_ = __builtin_amdgcn_permlane16_swap((unsigned)q4[i], (unsigned)q4[i + 2], false, false); q2[i] = (int)(r_[0] + r_[1]); } \
            { const int keep = b3 ? q2[1] : q2[0], send = b3 ? q2[0] : q2[1]; q1 = keep + __builtin_amdgcn_update_dpp(0, send, 0x128, 0xF, 0xF, true); } \
            q1 += __builtin_amdgcn_update_dpp(0, q1, 0xB1, 0xF, 0xF, true); q1 += __builtin_amdgcn_update_dpp(0, q1, 0x4E, 0xF, 0xF, true); q1 += __builtin_amdgcn_update_dpp(0, q1, 0x141, 0xF, 0xF, true); \
            const int i2_ = (lane & 3) * 2; const int v0_ = __builtin_amdgcn_ds_bpermute(i2_ << 5, q1), v1_ = __builtin_amdgcn_ds_bpermute((i2_ + 1) << 5, q1); \
            if ((lane >> 2) == (bb)) { hidv[tok][0] = v0_; hidv[tok][1] = v1_; } } while (0)
        int cur[TPW];
#pragma unroll
        for (int tt = 0; tt < TPW; ++tt) cur[tt] = 0;
#define P8_STEP_A(tt_, bufX, bufY, r_) { const int end_ = __builtin_amdgcn_readlane(offv[tt_], (r_) + 1); \
            { constexpr int tn_ = ((tt_) + 1) % TPW; const int rn_ = (r_) + ((tt_) + 1) / TPW; \
              if (rn_ < NPART && cur[tn_] < __builtin_amdgcn_readlane(offv[tn_], rn_ + 1)) P8_ISSUE(bufY, ut, tn_, cur[tn_] >> 3); } \
            __builtin_amdgcn_sched_barrier(0); \
            bool pre_ = true; \
            while (cur[tt_] < end_) { if (!pre_) P8_ISSUE(bufX, ut, tt_, cur[tt_] >> 3); pre_ = false; P8_DOTS(bufX, tt_, cur[tt_] >> 3); cur[tt_] += 8; } }
        if ((skip & 1) == 0) {
        if (0 < __builtin_amdgcn_readlane(offv[0], 1)) P8_ISSUE(bufA, ut, 0, 0);
#pragma unroll 1
        for (int r = 0; r < NPART; ++r) {
            P8_STEP_A(0, bufA, bufB, r) P8_STEP_A(1, bufB, bufA, r) P8_STEP_A(2, bufA, bufB, r) P8_STEP_A(3, bufB, bufA, r)
            P8_STEP_A(4, bufA, bufB, r) P8_STEP_A(5, bufB, bufA, r) P8_STEP_A(6, bufA, bufB, r) P8_STEP_A(7, bufB, bufA, r)
        } }
#undef P8_STEP_A
#undef P8_DOTS
    }
#pragma unroll
    for (int tt = 0; tt < TPW; ++tt) { const unsigned e0 = es[tt] & 0xffffu, e1 = es[tt] >> 16;
        const float su0 = su[e0], su1 = su[e1], sv0 = sv[e0], sv1 = sv[e1];
        gs[tt][0] = gelu_erf((float)hidv[tt][0] * (shs[tt] * su0)) * gs[tt][0] * sv0;
        gs[tt][1] = gelu_erf((float)hidv[tt][1] * (shs[tt] * su1)) * gs[tt][1] * sv1; }
    typedef _Float16 f16x2 __attribute__((ext_vector_type(2)));
    f16x2 yh[TPW][8];
#pragma unroll
    for (int tt = 0; tt < TPW; ++tt) {
#pragma unroll
        for (int i = 0; i < 8; ++i) yh[tt][i] = (f16x2){(_Float16)0.f, (_Float16)0.f}; }
    {
        u32x4 bufA[8], bufB[8];
#define BF8ACC(tok, a, word, j) { const unsigned _w = (word); const unsigned _h02 = __builtin_amdgcn_perm(0u, _w, 0x020c000cu), _h13 = __builtin_amdgcn_perm(0u, _w, 0x030c010cu); \
                          yh[tok][2 * (j)] = __builtin_elementwise_fma(__builtin_bit_cast(f16x2, _h02), (a), yh[tok][2 * (j)]); yh[tok][2 * (j) + 1] = __builtin_elementwise_fma(__builtin_bit_cast(f16x2, _h13), (a), yh[tok][2 * (j) + 1]); }
#define P8_ACC(buf, tok, bb) do { _Pragma("unroll") for (int k2 = 0; k2 < 4; ++k2) { \
            const _Float16 h0_ = (_Float16)__int_as_float(__builtin_amdgcn_readlane(__float_as_int(gs[tok][0]), 4 * (bb) + k2)), h1_ = (_Float16)__int_as_float(__builtin_amdgcn_readlane(__float_as_int(gs[tok][1]), 4 * (bb) + k2)); \
            const f16x2 a0_ = (f16x2){h0_, h0_}, a1_ = (f16x2){h1_, h1_}; \
            BF8ACC(tok, a0_, buf[2 * k2].x, 0) BF8ACC(tok, a0_, buf[2 * k2].y, 1) BF8ACC(tok, a0_, buf[2 * k2].z, 2) BF8ACC(tok, a0_, buf[2 * k2].w, 3) \
            BF8ACC(tok, a1_, buf[2 * k2 + 1].x, 0) BF8ACC(tok, a1_, buf[2 * k2 + 1].y, 1) BF8ACC(tok, a1_, buf[2 * k2 + 1].z, 2) BF8ACC(tok, a1_, buf[2 * k2 + 1].w, 3) __builtin_amdgcn_sched_barrier(0); } } while (0)
        int cur[TPW];
#pragma unroll
        for (int tt = 0; tt < TPW; ++tt) cur[tt] = 0;
#define P8_STEP_B(tt_, bufX, bufY, r_) { const int end_ = __builtin_amdgcn_readlane(offv[tt_], (r_) + 1); \
            { constexpr int tn_ = ((tt_) + 1) % TPW; const int rn_ = (r_) + ((tt_) + 1) / TPW; \
              if (rn_ < NPART && cur[tn_] < __builtin_amdgcn_readlane(offv[tn_], rn_ + 1)) P8_ISSUE(bufY, vt, tn_, cur[tn_] >> 3); } \
            __builtin_amdgcn_sched_barrier(0); \
            bool pre_ = true; \
            while (cur[tt_] < end_) { if (!pre_) P8_ISSUE(bufX, vt, tt_, cur[tt_] >> 3); pre_ = false; P8_ACC(bufX, tt_, cur[tt_] >> 3); cur[tt_] += 8; } }
        if ((skip & 2) == 0) {
        if (0 < __builtin_amdgcn_readlane(offv[0], 1)) P8_ISSUE(bufA, vt, 0, 0);
#pragma unroll 1
        for (int r = 0; r < NPART; ++r) {
            P8_STEP_B(0, bufA, bufB, r) P8_STEP_B(1, bufB, bufA, r) P8_STEP_B(2, bufA, bufB, r) P8_STEP_B(3, bufB, bufA, r)
            P8_STEP_B(4, bufA, bufB, r) P8_STEP_B(5, bufB, bufA, r) P8_STEP_B(6, bufA, bufB, r) P8_STEP_B(7, bufB, bufA, r)
        } }
#undef P8_STEP_B
#undef P8_ACC
#undef BF8ACC
    }
#undef P8_ISSUE
#pragma unroll
    for (int tt = 0; tt < TPW; ++tt) { const size_t t = (size_t)(t0 + tt);
        f32x4 v[4]; float s = 0.f;
#pragma unroll
        for (int j = 0; j < 4; ++j) { const int d = 256 * j + 4 * lane; const u32x2 xv = *(const u32x2*)(x1 + t * DM + d); const f32x4 g2 = *(const f32x4*)(mod + b * 6144 + 5120 + d) + 1.0f;
            const f32x4 xf = (f32x4){bf_lo(xv.x), bf_hi(xv.x), bf_lo(xv.y), bf_hi(xv.y)}; const f32x4 yy = (f32x4){(float)yh[tt][2 * j].x, (float)yh[tt][2 * j + 1].x, (float)yh[tt][2 * j].y, (float)yh[tt][2 * j + 1].y};
            v[j] = xf * DN_ALPHA + g2 * yy; s += (v[j][0] + v[j][1]) + (v[j][2] + v[j][3]); }
        const float mean = wave_sum(s) * (1.f / DM); float qq = 0.f;
#pragma unroll
        for (int j = 0; j < 4; ++j) { v[j] = v[j] - mean; qq += (v[j][0] * v[j][0] + v[j][1] * v[j][1]) + (v[j][2] * v[j][2] + v[j][3] * v[j][3]); }
        const float rstd = 1.0f / sqrtf(wave_sum(qq) * (1.f / DM) + LN_EPS);
#pragma unroll
        for (int j = 0; j < 4; ++j) { const int d = 256 * j + 4 * lane; const f32x4 lg = *(const f32x4*)(F.ln2_g + d), lb = *(const f32x4*)(F.ln2_b + d);
            *(f32x4*)(F.out + t * DM + d) = v[j] * rstd * lg + lb; } }
    }
}
#ifndef PROBE_PARTS
#define PROBE_PARTS 0xff
#endif
#ifndef MK_N_LAUNCHES
#define MK_N_LAUNCHES 1
#endif
constexpr int N_PHASES = 9;
struct Args { const float* in[18]; float* out; unsigned char* ws; int ph_lo, ph_hi, p0_parts, pad; };
__global__ void __launch_bounds__(NTHREADS, 2) fwd_kernel(Args args) {
    extern __shared__ __attribute__((aligned(16))) unsigned char lds[];
    Frame F;
    F.lds = (LAS unsigned char*)lds;
    F.tid = threadIdx.x; F.lane = F.tid & 63; F.wave = __builtin_amdgcn_readfirstlane(F.tid >> 6);
    F.G = gridDim.x; { const int bx = blockIdx.x; F.vcu = (F.G % 8 == 0) ? (bx % 8) * (F.G / 8) + bx / 8 : bx; }
    F.x = args.in[0]; F.c = args.in[1]; F.w_ada = args.in[2]; F.b_ada = args.in[3]; F.w_in = args.in[4]; F.sinks = args.in[5]; F.w_pool = args.in[6]; F.pool_scale = args.in[7];
    F.w_out = args.in[8]; F.ln1_g = args.in[9]; F.ln1_b = args.in[10]; F.w_pq = args.in[11]; F.k1 = args.in[12]; F.k2 = args.in[13]; F.pu = args.in[14]; F.pv = args.in[15];
    F.ln2_g = args.in[16]; F.ln2_b = args.in[17]; F.out = args.out; F.ws = args.ws;
    volatile LAS unsigned* MISC = (volatile LAS unsigned*)(F.lds + MISC_OFF);
    for (int u = F.tid; u < (LDS_BYTES - LDSCTL_OFF) / 4; u += NTHREADS) ((LAS unsigned*)(F.lds + LDSCTL_OFF))[u] = 0u;
    __syncthreads();
    const int lo = args.ph_lo, hi = args.ph_hi;
    XcdBarrier bar; bar.bar = (unsigned*)(F.ws + WS_CTL) + CW_BAR; bar.x = 0; bar.st = nullptr;
    if (hi - lo > 1) bar = xcd_barrier_post((unsigned*)(F.ws + WS_CTL) + CW_BAR, MISC + 8);
#ifndef PH_MASK
#define PH_MASK 0x1ff
#endif
#define IN(k) (((PH_MASK >> (k)) & 1) && lo <= (k) && (k) < hi)
#define SEAM(k) do { if (IN(k) && IN((k) + 1)) xcd_barrier(bar); } while (0)
#ifndef REP_MASK
#define REP_MASK 0
#endif
#ifndef REP_CNT
#define REP_CNT 4
#endif
#define REPS(k) (((REP_MASK >> (k)) & 1) * REP_CNT)
#define PHASE_NS(k, ...) if (IN(k)) { _Pragma("unroll 1") for (int _r = 0; _r <= REPS(k); ++_r) { __VA_ARGS__; if (_r < REPS(k)) xcd_barrier(bar); } }
#define PHASE(k, ...) if (IN(k)) { _Pragma("unroll 1") for (int _r = 0; _r <= REPS(k); ++_r) { __VA_ARGS__; if (_r < REPS(k)) xcd_barrier(bar); } } SEAM(k)
#ifndef P0_SUB
#define P0_SUB 0xff
#endif
    PHASE(0, p0_prologue(F, args.p0_parts));
    PHASE(2, { pg8::Gemm g{(const pg8::bf16_t*)(F.ws + WS_XN8), (const pg8::bf16_t*)(F.ws + WS_WIN), TT, NIN, DM / 2, 32, (size_t)NIN * DM, 0x79797979, 0x7F7F7F7F};    pg8::StaticOrder S; S.init(TT, NIN, F.G, (int)blockIdx.x);
            pg8::EpiRope E{(pg8::bf16_t*)(F.ws + WS_PROJ), NIN, (const float*)(F.ws + WS_ROPE), QSCALE, (const float*)(F.ws + WS_BIAS)};
            pg8::gemm_phase<pg8::EpiRope, pg8::StaticOrder, true, true, true>(F.lds, g, S, E);
            if ((args.p0_parts & 0x80) && (int)blockIdx.x >= 320 - F.G) p2_tables(F, ((int)blockIdx.x - (320 - F.G)) * NWAVES + F.wave, (2 * F.G - 320) * NWAVES, 0, 2 * NEXP); });
    PHASE(3, { for (int u = F.vcu; u < 256; u += F.G) p3_attn_unit(F, u);
               for (int u = F.vcu; u < 256; u += F.G) p3_pool_unit(F, u); });
    PHASE(4, { pg8::Gemm g{(const pg8::bf16_t*)(F.ws + WS_A2), (const pg8::bf16_t*)(F.ws + WS_WOUT), TT, DM, DM / 2, 1 << 30, 0, 0x79797979, 0x7B7B7B7B}; pg8::StaticOrder S; S.init(TT, DM, F.G, (int)blockIdx.x);
            pg8::EpiPlain E{(pg8::bf16_t*)(F.ws + WS_MIX), DM};
            pg8::gemm_phase<pg8::EpiPlain, pg8::StaticOrder, true, true, true>(F.lds, g, S, E); });
    PHASE(5, p5_ln1(F));
    PHASE_NS(6, { pg8::Gemm g{(const pg8::bf16_t*)(F.ws + WS_H2), (const pg8::bf16_t*)(F.ws + WS_WPQ), TT, NQD, DM, 1 << 30, 0, 0, 0}; pg8::StaticOrder S; S.init(TT, NQD, F.G, (int)blockIdx.x);
            pg8::EpiPlain E{(pg8::bf16_t*)(F.ws + WS_Q), NQD};
            pg8::gemm_phase<pg8::EpiPlain, pg8::StaticOrder, true, true>(F.lds, g, S, E); });
    if (IN(6) && IN(7)) { asm volatile("s_waitcnt vmcnt(0)" ::: "memory"); __syncthreads(); }
    PHASE(7, p7_route(F));
#ifndef P8_FAKE
#define P8_FAKE 0xffffu
#endif
#ifndef P8_SKIP
#define P8_SKIP 0
#endif
    PHASE(8, p8_peer(F, _r == REPS(8) ? 0xffffu : P8_FAKE, _r == REPS(8) ? 0 : P8_SKIP));
#undef IN
#undef SEAM
}

extern "C" void kernel_launch(void* const* d_in, const int* in_sizes, int n_in, void* d_out, int out_size, void* d_ws, size_t ws_size, hipStream_t stream) {
    static int grid = 0;
    if (grid == 0) {
        if (n_in != 18 || out_size != TT * DM || ws_size < WS_END) { fprintf(stderr, "kernel_launch: unexpected shapes (n_in %d out %d ws %zu)\n", n_in, out_size, ws_size); grid = -1; return; }
        int dev = 0, cus = 0, per_cu = 0;
        if (hipGetDevice(&dev) != hipSuccess || hipDeviceGetAttribute(&cus, hipDeviceAttributeMultiprocessorCount, dev) != hipSuccess) { grid = -1; return; }
        if (hipFuncSetAttribute((const void*)fwd_kernel, hipFuncAttributeMaxDynamicSharedMemorySize, LDS_BYTES) != hipSuccess) { fprintf(stderr, "kernel_launch: hipFuncSetAttribute failed\n"); grid = -1; return; }
        if (hipOccupancyMaxActiveBlocksPerMultiprocessor(&per_cu, (const void*)fwd_kernel, NTHREADS, LDS_BYTES) != hipSuccess || per_cu < 1) { fprintf(stderr, "kernel_launch: occupancy query says %d blocks per CU\n", per_cu); }
        (void)hipGetLastError();
        grid = cus;
        if (grid != 256) fprintf(stderr, "kernel_launch: built for 256 CUs, got %d\n", grid);
    }
    if (grid < 0) return;
    (void)hipMemsetAsync((char*)d_ws + WS_CTL, 0, CTL_ZERO_BYTES, stream);
    Args a{};
    for (int i = 0; i < 18; ++i) a.in[i] = (const float*)d_in[i];
    a.out = (float*)d_out; a.ws = (unsigned char*)d_ws; a.p0_parts = 0xff;
#if MK_N_LAUNCHES == 1
    a.ph_lo = 0; a.ph_hi = N_PHASES;
    hipLaunchKernelGGL(fwd_kernel, dim3(grid), dim3(NTHREADS), LDS_BYTES, stream, a);
#ifdef PROBE_PHASE
    for (int i = 0; i < PROBE_N; ++i) { a.ph_lo = PROBE_PHASE; a.ph_hi = PROBE_PHASE + 1; a.p0_parts = PROBE_PARTS; hipLaunchKernelGGL(fwd_kernel, dim3(grid), dim3(NTHREADS), LDS_BYTES, stream, a); }
#endif
#else
    for (int p = 0; p < N_PHASES; ++p) { a.ph_lo = p; a.ph_hi = p + 1; hipLaunchKernelGGL(fwd_kernel, dim3(grid), dim3(NTHREADS), LDS_BYTES, stream, a); }
#endif
}
```

```cpp
#include <hip/hip_runtime.h>
#include <cstdio>
#include <cstdint>
#include <cmath>
namespace pg8 {
#define PG8_LAS __attribute__((address_space(3)))
typedef unsigned short bf16_t;
typedef short bf16x8 __attribute__((ext_vector_type(8)));
typedef float f32x4 __attribute__((ext_vector_type(4)));
typedef unsigned u32x4 __attribute__((ext_vector_type(4)));
constexpr int BM = 256, BK = 64, HALF = 128, HTB = HALF * BK * 2  , STAGE_BYTES = 8 * HTB, NXCD = 8, WGM = 8;

__host__ __device__ __forceinline__ int lds_byte(int r, int c) { const int st = (r >> 4) * 2 + (c >> 5), rr = r & 15, cc = c & 31, ob = rr * 64 + cc * 2; return st * 1024 + (ob ^ (((ob >> 9) & 1) << 5)); }
__host__ __device__ __forceinline__ void stage_rc(int b, int& R, int& C) { const int st = b / 1024, sb = b % 1024, swz = sb ^ (((sb >> 9) & 1) << 5); R = (st >> 1) * 16 + swz / 64; C = (st & 1) * 32 + (swz % 64) / 2; }
__host__ __device__ __forceinline__ int perm32(int rho) { const int n = rho >> 4, i = rho & 15; return 8 * (i >> 2) + 4 * n + (i & 3); }

struct Unit { int pm, pn; };
struct Gemm { const bf16_t* A; const bf16_t* Bt; int M, N, K; int bsplit; size_t bstride; int sc_w, sc_x; };

struct StaticOrder {
    int nM, nN, nwg, G, c;
    __host__ __device__ void init(int M, int N, int G_, int c_) { nM = M / BM; nN = N / BM; nwg = nM * nN; G = G_; c = c_; }
    __host__ __device__ bool next(int i, Unit& u) const {
        const long L = (long)i * G + c; if (L >= nwg) return false;
        int wgid = (int)L; { const int q = nwg / NXCD, r = nwg % NXCD, xcd = wgid % NXCD, off = wgid / NXCD; wgid = (xcd < r ? xcd * (q + 1) : r * (q + 1) + (xcd - r) * q) + off; }
        const int nig = WGM * nN, gid = wgid / nig, fm = gid * WGM, gsz = (nM - fm) < WGM ? (nM - fm) : WGM;
        u.pm = fm + ((wgid % nig) % gsz); u.pn = (wgid % nig) / gsz; return true;
    }
    __device__ __forceinline__ void a_ready(const Unit&) const {}
    __device__ __forceinline__ void done(const Unit&) const {}
};

__device__ __forceinline__ unsigned cvt_pk_bf16(float lo, float hi) { unsigned r; asm volatile("v_cvt_pk_bf16_f32 %0, %1, %2" : "=v"(r) : "v"(lo), "v"(hi)); return r; }

struct EpiPlain {
    static constexpr bool PERM = true, AFTER_DRAIN = false;
    bf16_t* O; int ldc;
    __device__ __forceinline__ void operator()(const f32x4 (&acc)[2][2][4][2], const Unit& u, int wr, int wc, int fr, int fq) const {
        const int row0 = u.pm * BM + wr * 64 + fr; const int col0 = u.pn * BM + wc * 32 + 8 * fq;
#pragma unroll
        for (int ai = 0; ai < 2; ++ai)
#pragma unroll
            for (int m = 0; m < 4; ++m) { bf16_t* rowp = O + (size_t)(row0 + ai * HALF + m * 16) * ldc + col0;
#pragma unroll
                for (int bj = 0; bj < 2; ++bj) { const f32x4 v0 = acc[ai][bj][m][0], v1 = acc[ai][bj][m][1];
                    u32x4 w; w.x = cvt_pk_bf16(v0[0], v0[1]); w.y = cvt_pk_bf16(v0[2], v0[3]); w.z = cvt_pk_bf16(v1[0], v1[1]); w.w = cvt_pk_bf16(v1[2], v1[3]);
                    *(u32x4*)(rowp + bj * HALF) = w; } }
    }
};
struct EpiRope {
    static constexpr bool PERM = true, AFTER_DRAIN = false;
    bf16_t* O; int ldc; const float* rope; float qscale; const float* bias;
    __device__ __forceinline__ void operator()(const f32x4 (&acc)[2][2][4][2], const Unit& u, int wr, int wc, int fr, int fq) const {
        const int row0 = u.pm * BM + wr * 64 + fr; const int col0 = u.pn * BM + wc * 32 + 8 * fq;
#pragma unroll
        for (int ai = 0; ai < 2; ++ai)
#pragma unroll
            for (int m = 0; m < 4; ++m) { const int row = row0 + ai * HALF + m * 16; bf16_t* rowp = O + (size_t)row * ldc + col0; const int pos = row & 8191;
#pragma unroll
                for (int bj = 0; bj < 2; ++bj) { const float* bp = bias + (size_t)(row >> 13) * ldc + col0 + bj * HALF;
                    f32x4 v0 = acc[ai][bj][m][0] + *(const f32x4*)bp, v1 = acc[ai][bj][m][1] + *(const f32x4*)(bp + 4);
                    const int colt = u.pn * BM + bj * HALF;
                    if (colt < 640) {
                        const int c = col0 + bj * HALF, ib = (c & 63) >> 1;
                        const f32x4 cs0 = *(const f32x4*)(rope + ((size_t)pos * 32 + ib) * 2), cs1 = *(const f32x4*)(rope + ((size_t)pos * 32 + ib) * 2 + 4);
                        const float sc = colt < 512 ? qscale : 1.0f;
                        f32x4 r0, r1;
                        r0[0] = (v0[0] * cs0[0] - v0[1] * cs0[1]) * sc; r0[1] = (v0[1] * cs0[0] + v0[0] * cs0[1]) * sc;
                        r0[2] = (v0[2] * cs0[2] - v0[3] * cs0[3]) * sc; r0[3] = (v0[3] * cs0[2] + v0[2] * cs0[3]) * sc;
                        r1[0] = (v1[0] * cs1[0] - v1[1] * cs1[1]) * sc; r1[1] = (v1[1] * cs1[0] + v1[0] * cs1[1]) * sc;
                        r1[2] = (v1[2] * cs1[2] - v1[3] * cs1[3]) * sc; r1[3] = (v1[3] * cs1[2] + v1[2] * cs1[3]) * sc;
                        v0 = r0; v1 = r1;
                    }
                    u32x4 w; w.x = cvt_pk_bf16(v0[0], v0[1]); w.y = cvt_pk_bf16(v0[2], v0[3]); w.z = cvt_pk_bf16(v1[0], v1[1]); w.w = cvt_pk_bf16(v1[2], v1[3]);
                    *(u32x4*)(rowp + bj * HALF) = w; } }
    }
};

template <class Epi, class Sched, bool ALIGN_EPI = false, bool SP2 = false, bool FP8 = false>
__device__ __forceinline__ void gemm_phase(PG8_LAS unsigned char* lds, const Gemm g, const Sched& S, const Epi& E) {
    typedef int pg8_i32x4 __attribute__((ext_vector_type(4))); typedef int pg8_frag __attribute__((ext_vector_type(8)));
    const int tid = threadIdx.x, wid = __builtin_amdgcn_readfirstlane(tid >> 6), lane = tid & 63, wr = wid >> 2, wc = wid & 3, fr = lane & 15, fq = lane >> 4;
    const int K = g.K, nt = K / BK;
    unsigned voffA[2], voffB[2];
#pragma unroll
    for (int i = 0; i < 2; ++i) { int R, C; stage_rc(tid * 16 + i * 8192, R, C); const int Rb = Epi::PERM ? ((R & ~31) + perm32(R & 31)) : R;
        voffA[i] = (unsigned)(R * K + C) * 2u; voffB[i] = (unsigned)(Rb * K + C) * 2u; }
    const size_t kstep = (size_t)(BK * 2);
    const size_t hstep = (size_t)HALF * K * 2;
    const size_t tstep = 2 * hstep;
    const unsigned ldsw = (unsigned)wid * 1024u;
    const int aoff = lds_byte(wr * 64 + fr, fq * 8), boff = lds_byte(wc * 32 + fr, fq * 8);
#define PG8_SA(b, h) (((b) * 2 + (h)) * HTB)
#define PG8_SB(b, h) ((4 + (b) * 2 + (h)) * HTB)
#define PG8_STAGE(bufoff, gbase, voff) do { _Pragma("unroll") for (int _i = 0; _i < 2; ++_i) \
        __builtin_amdgcn_global_load_lds((const unsigned*)((const char*)(gbase) + (voff)[_i]), (PG8_LAS unsigned*)(lds + (bufoff) + ldsw + _i * 8192), 16, 0, 0); } while (0)
#define PG8_LDA(dst, b, h) do { _Pragma("unroll") for (int m = 0; m < 4; ++m) { const pg8_i32x4 l0_ = *(const PG8_LAS pg8_i32x4*)(lds + PG8_SA(b, h) + aoff + m * 2048), l1_ = *(const PG8_LAS pg8_i32x4*)(lds + PG8_SA(b, h) + aoff + m * 2048 + 1024); dst[m] = __builtin_shufflevector(l0_, l1_, 0, 1, 2, 3, 4, 5, 6, 7); } } while (0)
#define PG8_LDB(dst, b, h) do { _Pragma("unroll") for (int n = 0; n < 2; ++n) { const pg8_i32x4 l0_ = *(const PG8_LAS pg8_i32x4*)(lds + PG8_SB(b, h) + boff + n * 2048), l1_ = *(const PG8_LAS pg8_i32x4*)(lds + PG8_SB(b, h) + boff + n * 2048 + 1024); dst[n] = __builtin_shufflevector(l0_, l1_, 0, 1, 2, 3, 4, 5, 6, 7); } } while (0)
#define PG8_H0(f) __builtin_bit_cast(bf16x8, __builtin_shufflevector((f), (f), 0, 1, 2, 3))
#define PG8_H1(f) __builtin_bit_cast(bf16x8, __builtin_shufflevector((f), (f), 4, 5, 6, 7))
#define PG8_MMA(ai, bj, At, Bt) do { __builtin_amdgcn_s_setprio(1); \
        if constexpr (FP8) { _Pragma("unroll") for (int m = 0; m < 4; ++m) _Pragma("unroll") for (int n = 0; n < 2; ++n) \
            asm volatile("v_mfma_scale_f32_16x16x128_f8f6f4 %0, %1, %2, %0, %3, %4 op_sel_hi:[0,0,0]" : "+v"(acc[ai][bj][m][n]) : "v"(Bt[n]), "v"(At[m]), "v"(scw_), "v"(scx_)); } \
        else { _Pragma("unroll") for (int m = 0; m < 4; ++m) _Pragma("unroll") for (int n = 0; n < 2; ++n) { \
            acc[ai][bj][m][n] = __builtin_amdgcn_mfma_f32_16x16x32_bf16(PG8_H0(Bt[n]), PG8_H0(At[m]), acc[ai][bj][m][n], 0, 0, 0); \
            acc[ai][bj][m][n] = __builtin_amdgcn_mfma_f32_16x16x32_bf16(PG8_H1(Bt[n]), PG8_H1(At[m]), acc[ai][bj][m][n], 0, 0, 0); } } \
        __builtin_amdgcn_s_setprio(0); } while (0)
#define PG8_WAIT_V(n) asm volatile("s_waitcnt vmcnt(" #n ")" ::: "memory")
#define PG8_WAIT_L(n) asm volatile("s_waitcnt lgkmcnt(" #n ")" ::: "memory")
#define PG8_BAR __builtin_amdgcn_s_barrier()
#define PG8_SCHED __builtin_amdgcn_sched_barrier(0)
    Unit cur, nxt; int ui = 0;
    if (!S.next(0, cur)) return;
    f32x4 acc[2][2][4][2];
#pragma unroll
    for (int a = 0; a < 2; ++a)
#pragma unroll
        for (int b = 0; b < 2; ++b)
#pragma unroll
            for (int m = 0; m < 4; ++m)
#pragma unroll
                for (int n = 0; n < 2; ++n) acc[a][b][m][n] = (f32x4){0.f, 0.f, 0.f, 0.f};
    pg8_frag At[4], B0[2], B1[2]; const int scw_ = g.sc_w, scx_ = g.sc_x;
    const char* cA = (const char*)g.A + (size_t)cur.pm * tstep; const char* cB = (const char*)g.Bt + (size_t)cur.pn * tstep + (cur.pm >= g.bsplit ? g.bstride : (size_t)0);
    S.a_ready(cur);
    if constexpr (SP2) {
        PG8_STAGE(PG8_SB(0, 0), cB, voffB); PG8_STAGE(PG8_SB(0, 1), cB + hstep, voffB); PG8_STAGE(PG8_SA(0, 0), cA, voffA); PG8_STAGE(PG8_SA(0, 1), cA + hstep, voffA);
        if (wr == 1) PG8_BAR;
        PG8_WAIT_V(2); PG8_BAR;
        PG8_STAGE(PG8_SB(1, 0), cB + kstep, voffB); PG8_STAGE(PG8_SA(1, 0), cA + kstep, voffA); PG8_STAGE(PG8_SB(1, 1), cB + hstep + kstep, voffB);
        PG8_WAIT_V(6); PG8_BAR;
    } else {
        PG8_STAGE(PG8_SB(0, 0), cB, voffB); PG8_STAGE(PG8_SA(0, 0), cA, voffA); PG8_STAGE(PG8_SB(0, 1), cB + hstep, voffB); PG8_STAGE(PG8_SA(0, 1), cA + hstep, voffA);
        if (wr == 1) PG8_BAR;
        PG8_WAIT_V(4); PG8_BAR;
        PG8_STAGE(PG8_SB(1, 0), cB + kstep, voffB); PG8_STAGE(PG8_SA(1, 0), cA + kstep, voffA); PG8_STAGE(PG8_SB(1, 1), cB + hstep + kstep, voffB);
        PG8_WAIT_V(6); PG8_BAR;
    }
    for (;;) {
        const bool has_next = S.next(ui + 1, nxt);
        const char* nA = has_next ? (const char*)g.A + (size_t)nxt.pm * tstep : cA; const char* nB = has_next ? (const char*)g.Bt + (size_t)nxt.pn * tstep + (nxt.pm >= g.bsplit ? g.bstride : (size_t)0) : cB;
        _Pragma("unroll 1") for (int t = 0; t < nt; t += 2) {
            const bool last = (t == nt - 2);
            const char* a1 = cA + (size_t)(t + 1) * kstep;
            const char* a2 = last ? nA : cA + (size_t)(t + 2) * kstep; const char* b2 = last ? nB : cB + (size_t)(t + 2) * kstep;
            const char* a3 = a2 + kstep; const char* b3 = b2 + kstep;
            if (last && has_next) S.a_ready(nxt);
            if constexpr (SP2) {
            PG8_LDB(B0, 0, 0); PG8_LDB(B1, 0, 1); PG8_SCHED; PG8_LDA(At, 0, 0); PG8_STAGE(PG8_SA(1, 1), a1 + hstep, voffA);
            PG8_WAIT_V(8); PG8_WAIT_L(0); PG8_BAR; PG8_MMA(0, 0, At, B0); PG8_MMA(0, 1, At, B1); PG8_BAR; PG8_SCHED;
            PG8_LDA(At, 0, 1); PG8_STAGE(PG8_SB(0, 0), b2, voffB); PG8_STAGE(PG8_SB(0, 1), b2 + hstep, voffB); PG8_STAGE(PG8_SA(0, 0), a2, voffA);
            PG8_WAIT_V(8); PG8_WAIT_L(0); PG8_BAR; PG8_MMA(1, 0, At, B0); PG8_MMA(1, 1, At, B1); PG8_BAR; PG8_SCHED;
            PG8_LDB(B0, 1, 0); PG8_LDB(B1, 1, 1); PG8_SCHED; PG8_LDA(At, 1, 0); PG8_STAGE(PG8_SA(0, 1), a2 + hstep, voffA);
            PG8_WAIT_V(8); PG8_WAIT_L(0); PG8_BAR; PG8_MMA(0, 0, At, B0); PG8_MMA(0, 1, At, B1); PG8_BAR; PG8_SCHED;
            PG8_LDA(At, 1, 1); PG8_STAGE(PG8_SB(1, 0), b3, voffB); PG8_STAGE(PG8_SB(1, 1), b3 + hstep, voffB); PG8_STAGE(PG8_SA(1, 0), a3, voffA);
            PG8_WAIT_V(8); PG8_WAIT_L(0); PG8_BAR; PG8_MMA(1, 0, At, B0); PG8_MMA(1, 1, At, B1); PG8_BAR; PG8_SCHED;
            } else {
            PG8_LDB(B0, 0, 0); PG8_SCHED; PG8_LDA(At, 0, 0); PG8_STAGE(PG8_SA(1, 1), a1 + hstep, voffA);
            PG8_WAIT_L(8); PG8_BAR; PG8_WAIT_L(0); PG8_MMA(0, 0, At, B0); PG8_BAR; PG8_SCHED;
            PG8_LDB(B1, 0, 1); PG8_STAGE(PG8_SB(0, 0), b2, voffB);
            PG8_BAR; PG8_WAIT_L(0); PG8_MMA(0, 1, At, B1); PG8_BAR;
            PG8_LDA(At, 0, 1); PG8_STAGE(PG8_SA(0, 0), a2, voffA);
            PG8_BAR; PG8_WAIT_L(0); PG8_MMA(1, 0, At, B0); PG8_BAR; PG8_SCHED;
            PG8_STAGE(PG8_SB(0, 1), b2 + hstep, voffB);
            PG8_WAIT_V(6); PG8_BAR; PG8_MMA(1, 1, At, B1); PG8_BAR;
            PG8_LDB(B0, 1, 0); PG8_SCHED; PG8_LDA(At, 1, 0); PG8_STAGE(PG8_SA(0, 1), a2 + hstep, voffA);
            PG8_WAIT_L(8); PG8_BAR; PG8_WAIT_L(0); PG8_MMA(0, 0, At, B0); PG8_BAR; PG8_SCHED;
            PG8_LDB(B1, 1, 1); PG8_STAGE(PG8_SB(1, 0), b3, voffB);
            PG8_BAR; PG8_WAIT_L(0); PG8_MMA(0, 1, At, B1); PG8_BAR;
            PG8_LDA(At, 1, 1); PG8_STAGE(PG8_SA(1, 0), a3, voffA);
            PG8_BAR; PG8_WAIT_L(0); PG8_MMA(1, 0, At, B0); PG8_BAR; PG8_SCHED;
            PG8_STAGE(PG8_SB(1, 1), b3 + hstep, voffB);
            PG8_WAIT_V(6); PG8_BAR; PG8_MMA(1, 1, At, B1); PG8_BAR;
            }
        }
        if constexpr (ALIGN_EPI) { if (wr == 0) PG8_BAR; }
        if constexpr (FP8) {
            asm volatile("s_nop 15\n\ts_nop 15" ::: "memory");
#pragma unroll
            for (int a = 0; a < 2; ++a)
#pragma unroll
                for (int b = 0; b < 2; ++b)
#pragma unroll
                    for (int m = 0; m < 4; ++m)
#pragma unroll
                        for (int n = 0; n < 2; ++n) asm volatile("" : "+v"(acc[a][b][m][n]));
        }
        if constexpr (!Epi::AFTER_DRAIN) { E(acc, cur, wr, wc, fr, fq); S.done(cur); }
        if (!has_next) break;
#pragma unroll
        for (int a = 0; a < 2; ++a)
#pragma unroll
            for (int b = 0; b < 2; ++b)
#pragma unroll
                for (int m = 0; m < 4; ++m)
#pragma unroll
                    for (int n = 0; n < 2; ++n) acc[a][b][m][n] = (f32x4){0.f, 0.f, 0.f, 0.f};
        cur = nxt; cA = nA; cB = nB; ++ui;
        if constexpr (ALIGN_EPI) { if (wr == 1) PG8_BAR; }
    }
    PG8_WAIT_V(0);
    if constexpr (!ALIGN_EPI) { if (wr == 0) PG8_BAR; }
    PG8_BAR;
    if constexpr (Epi::AFTER_DRAIN) { E.fused(acc, cur, wr, wc, fr, fq, lds, wid, lane); S.done(cur); }
#undef PG8_SA
#undef PG8_SB
#undef PG8_STAGE
#undef PG8_LDA
#undef PG8_LDB
#undef PG8_MMA
#undef PG8_H0
#undef PG8_H1
#undef PG8_WAIT_V
#undef PG8_WAIT_L
#undef PG8_BAR
#undef PG8_SCHED
}
}
#define GAS __attribute__((address_space(1)))
#define LAS __attribute__((address_space(3)))
typedef unsigned short bf16;
typedef unsigned v4u __attribute__((ext_vector_type(4)));
typedef float f32x4 __attribute__((ext_vector_type(4)));
typedef short bf16x8 __attribute__((ext_vector_type(8)));
typedef GAS unsigned gu32;
typedef GAS unsigned long long gu64;
#define RLX_AGENT __ATOMIC_RELAXED, __HIP_MEMORY_SCOPE_AGENT
#define LDS_WAIT() asm volatile("s_waitcnt lgkmcnt(0)" ::: "memory")
#define VM_WAIT() asm volatile("s_waitcnt vmcnt(0)" ::: "memory")
__device__ __forceinline__ unsigned long long rt() { return __builtin_amdgcn_s_memrealtime(); }
__device__ __forceinline__ unsigned f2bf(float f) { unsigned u = __builtin_bit_cast(unsigned, f); return (u + 0x7fffu + ((u >> 16) & 1u)) >> 16; }
__device__ __forceinline__ unsigned pk2(float lo, float hi) { return f2bf(lo) | (f2bf(hi) << 16); }
#define XB_TMO      128
#define XB_XCNT(j)  (256  + 64 * (j))
#define XB_XSUB(j)  (1280 + 64 * (j))
#define XB_XGEN(j)  (2304 + 64 * (j))
#define XB_TOP      3328
#define XB_TOPGEN   3392
#define XCD_BAR_WORDS 3456
#define XB_SPIN_CAP (1u << 18)

__device__ __forceinline__ unsigned xb_ld(unsigned* p)              { return __hip_atomic_load(p, __ATOMIC_RELAXED, __HIP_MEMORY_SCOPE_AGENT); }
__device__ __forceinline__ unsigned xb_add(unsigned* p, unsigned v) { return __hip_atomic_fetch_add(p, v, __ATOMIC_RELAXED, __HIP_MEMORY_SCOPE_AGENT); }
__device__ __forceinline__ unsigned xb_xcc_id() { return (unsigned)__builtin_amdgcn_s_getreg((3 << 11) | 20) & 0xFu; }
#define XB_SPIN(cond, bar) do { unsigned _sp = 0; while (cond) { __builtin_amdgcn_s_sleep(1); \
    if ((++_sp & 255u) == 0u) { if (xb_ld(&(bar)[XB_TMO])) break; if (_sp > XB_SPIN_CAP) { atomicAdd(&(bar)[XB_TMO], 1u); break; } } } } while (0)

struct XcdBarrier {
    unsigned* bar; unsigned x;
    volatile LAS unsigned* st;
};

__device__ __forceinline__ XcdBarrier xcd_barrier_post(unsigned* bar, volatile LAS unsigned* st) {
    XcdBarrier b; b.bar = bar; b.x = xb_xcc_id(); b.st = st;
    if (threadIdx.x == 0) (void)xb_add(&bar[XB_XCNT(b.x)], 1u);
    return b;
}
__device__ __forceinline__ void xcd_barrier_complete(unsigned* bar, unsigned x, unsigned& nloc, unsigned& nx) {
    const unsigned G = gridDim.x * gridDim.y * gridDim.z;
    unsigned sum, cnt, mine, sp = 0u;
    for (;;) {
        sum = 0u; cnt = 0u; mine = 0u;
#pragma unroll
        for (unsigned j = 0; j < 16; ++j) { const unsigned c = xb_ld(&bar[XB_XCNT(j)]); sum += c; cnt += (c > 0u) ? 1u : 0u; mine = (j == x) ? c : mine; }
        if (sum == G) break;
        __builtin_amdgcn_s_sleep(1);
        if ((++sp & 255u) == 0u) { if (xb_ld(&bar[XB_TMO])) break; if (sp > XB_SPIN_CAP) { atomicAdd(&bar[XB_TMO], 1u); break; } }
    }
    nloc = mine > 0u ? mine : 1u; nx = cnt > 0u ? cnt : 1u;
}

__device__ __forceinline__ void xcd_barrier(const XcdBarrier& b) {
    asm volatile("s_waitcnt vmcnt(0)" ::: "memory");
    __syncthreads();
    if (threadIdx.x == 0) {
        unsigned* bar = b.bar;
        __builtin_amdgcn_s_waitcnt(0);
        unsigned nloc = b.st[0], nx = b.st[1];
        if (nloc == 0u) { xcd_barrier_complete(bar, b.x, nloc, nx); b.st[0] = nloc; b.st[1] = nx; }
        const unsigned old = xb_add(&bar[XB_XSUB(b.x)], 1u);
        const unsigned gen = old / nloc;
        if (old + 1u == (gen + 1u) * nloc) {
            __builtin_amdgcn_fence(__ATOMIC_RELEASE, "agent");
            asm volatile("s_waitcnt vmcnt(0)" ::: "memory");
            const unsigned og = xb_add(&bar[XB_TOP], 1u);
            const unsigned tg = og / nx;
            if (og + 1u == (tg + 1u) * nx) xb_add(&bar[XB_TOPGEN], 1u);
            else XB_SPIN(xb_ld(&bar[XB_TOPGEN]) == tg, bar);
            __builtin_amdgcn_fence(__ATOMIC_ACQUIRE, "agent");
            xb_add(&bar[XB_XGEN(b.x)], 1u);
            asm volatile("s_waitcnt vmcnt(0)" ::: "memory");
        } else {
            XB_SPIN(xb_ld(&bar[XB_XGEN(b.x)]) == gen, bar);
            __builtin_amdgcn_fence(__ATOMIC_ACQUIRE, "agent");
            asm volatile("s_waitcnt vmcnt(0)" ::: "memory");
        }
    }
    __syncthreads();
}
constexpr int NWAVES = 8, NTHREADS = 512;
constexpr int TT = 16384, DM = 1024, SEQ = 8192, NIN = 1280, NQD = 2048, NEXP = 16384;
constexpr float DN_ALPHA = 1.189207115002721f;
constexpr float LN_EPS = 1e-5f;
constexpr float LOG2E = 1.4426950408889634f;
constexpr float QSCALE = 0.125f * LOG2E;

constexpr size_t MiB = 1u << 20;
constexpr size_t WS_CTL = 0, CTL_ZERO_BYTES = 64 * 1024;
constexpr size_t WS_MOD = 1 * MiB + 896 * 1024;
constexpr size_t WS_ROPE = 2 * MiB;
constexpr size_t WS_WIN = 248 * MiB;
constexpr size_t WS_BIAS = 4 * MiB;
constexpr size_t WS_K1 = 6 * MiB + 512 * 1024, WS_K2 = WS_K1 + 32 * 1024;
constexpr size_t WS_WOUT = 7 * MiB;
constexpr size_t WS_WPQ = 9 * MiB;
constexpr size_t WS_SU = 13 * MiB, WS_SV = 13 * MiB + 65536;
constexpr size_t WS_U = 16 * MiB, WS_V = 32 * MiB;
constexpr size_t WS_H2Q = 48 * MiB, WS_SH = 13 * MiB + 131072;
constexpr size_t WS_XN8 = 64 * MiB;
constexpr size_t WS_XN = 80 * MiB;
constexpr size_t WS_MIX = 112 * MiB;
constexpr size_t WS_PE = 80 * MiB, WS_PG = 84 * MiB;
constexpr size_t WS_PROJ = 112 * MiB;
constexpr size_t WS_A2 = 152 * MiB;
constexpr size_t WS_X1 = 184 * MiB, WS_H2 = 216 * MiB;
constexpr size_t WS_Q = 112 * MiB;
constexpr size_t WS_END = 253 * MiB;
constexpr int CW_MODCNT = 1024;
constexpr int CW_BAR = 4096;

constexpr int RING_BYTES = 131072, LDSCTL_OFF = RING_BYTES, MISC_OFF = LDSCTL_OFF + 320, LDS_BYTES = 147456;

typedef float f32x16 __attribute__((ext_vector_type(16)));
typedef float f32x2 __attribute__((ext_vector_type(2)));
typedef unsigned u32x2 __attribute__((ext_vector_type(2)));
typedef unsigned u32x4 __attribute__((ext_vector_type(4)));
typedef __bf16 bf16x2_t __attribute__((ext_vector_type(2)));
struct Frame {
    LAS unsigned char* lds;
    int tid, lane, wave, vcu, G;
    const float *x, *c, *w_ada, *b_ada, *w_in, *sinks, *w_pool, *pool_scale, *w_out, *ln1_g, *ln1_b, *w_pq, *k1, *k2, *pu, *pv, *ln2_g, *ln2_b;
    float* out; unsigned char* ws;
};
__device__ __forceinline__ float wave_sum(float v) {
#pragma unroll
    for (int o = 1; o < 64; o <<= 1) v += __shfl_xor(v, o);
    return v;
}
__device__ __forceinline__ float bf_lo(unsigned u) { return __uint_as_float(u << 16); }
__device__ __forceinline__ float bf_hi(unsigned u) { return __uint_as_float(u & 0xffff0000u); }
__device__ __forceinline__ float bf2f(bf16 b) { return __uint_as_float((unsigned)b << 16); }
__device__ __forceinline__ unsigned fp8x4(float a, float b, float c, float d) { int pk = __builtin_amdgcn_cvt_pk_fp8_f32(a, b, 0, false); pk = __builtin_amdgcn_cvt_pk_fp8_f32(c, d, pk, true); return (unsigned)pk; }

template <int MODE, bool OUT8 = false>
__device__ __forceinline__ void transpose_item(const float* W, int ldw, bf16* WT, int ldt, int k0, int n0, LAS float* scr, int lane, const LAS float* ksc = nullptr, float oscale = 1.0f) {
    int nsrc = n0 + (lane & 31);
    if (MODE == 1 && nsrc < 640) { const int hd = nsrc >> 6, w = nsrc & 63; nsrc = hd * 64 + (w >> 1) + 32 * (w & 1); }
    float wv[32];
#pragma unroll
    for (int i = 0; i < 32; ++i) wv[i] = W[(size_t)(k0 + 2 * i + (lane >> 5)) * ldw + nsrc];
#pragma unroll
    for (int i = 0; i < 32; ++i) { const int kk = 2 * i + (lane >> 5); float w_ = wv[i]; if (MODE == 1) w_ *= ksc[k0 + kk]; scr[kk * 33 + (lane & 31)] = w_; }
    LDS_WAIT(); asm volatile("" ::: "memory");
    const int c = lane & 7;
#pragma unroll
    for (int j = 0; j < 4; ++j) { const int n = (lane >> 3) + 8 * j; const LAS float* s = scr + (8 * c) * 33 + n;
        if (OUT8) { u32x2 o8; o8.x = fp8x4(s[0 * 33] * oscale, s[1 * 33] * oscale, s[2 * 33] * oscale, s[3 * 33] * oscale); o8.y = fp8x4(s[4 * 33] * oscale, s[5 * 33] * oscale, s[6 * 33] * oscale, s[7 * 33] * oscale);
            *(u32x2*)((unsigned char*)WT + (size_t)(n0 + n) * ldt + k0 + 8 * c) = o8; }
        else { v4u o; o.x = pk2(s[0 * 33], s[1 * 33]); o.y = pk2(s[2 * 33], s[3 * 33]); o.z = pk2(s[4 * 33], s[5 * 33]); o.w = pk2(s[6 * 33], s[7 * 33]);
            *(GAS v4u*)(WT + (size_t)(n0 + n) * ldt + k0 + 8 * c) = o; } }
    LDS_WAIT(); asm volatile("" ::: "memory");
}
__device__ __forceinline__ void sincos_d(double a, float& s, float& c) {
    const double TWO_PI = 6.283185307179586476925, PI = 3.141592653589793238462643;
    double r = a - TWO_PI * rint(a / TWO_PI);
    double sg = 1.0;
    if (r > 0.5 * PI) { r = PI - r; sg = -1.0; } else if (r < -0.5 * PI) { r = -PI - r; sg = -1.0; }
    const double r2 = r * r;
    double sp = -1.0 / 121645100408832000.0;
    sp = sp * r2 + 1.0 / 355687428096000.0; sp = sp * r2 - 1.0 / 1307674368000.0; sp = sp * r2 + 1.0 / 6227020800.0; sp = sp * r2 - 1.0 / 39916800.0;
    sp = sp * r2 + 1.0 / 362880.0; sp = sp * r2 - 1.0 / 5040.0; sp = sp * r2 + 1.0 / 120.0; sp = sp * r2 - 1.0 / 6.0; sp = sp * r2 + 1.0;
    double cp = 1.0 / 6402373705728000.0;
    cp = cp * r2 - 1.0 / 20922789888000.0; cp = cp * r2 + 1.0 / 87178291200.0; cp = cp * r2 - 1.0 / 479001600.0; cp = cp * r2 + 1.0 / 3628800.0;
    cp = cp * r2 - 1.0 / 40320.0; cp = cp * r2 + 1.0 / 720.0; cp = cp * r2 - 1.0 / 24.0; cp = cp * r2 + 0.5; cp = 1.0 - cp * r2;
    s = (float)(sp * r); c = (float)(sg * cp);
}
__device__ __forceinline__ void p1_win(Frame& F);
__device__ __forceinline__ void p0_prologue(Frame& F, int parts = 0xff) {
    LAS float* scr = (LAS float*)(F.lds + F.wave * 16384);
    const int gw = F.vcu * NWAVES + F.wave, NGW = F.G * NWAVES, lane = F.lane;
    if ((parts & 1) && F.vcu < 96) { const int col = F.vcu * 64 + lane; float a0 = 0.f, a1 = 0.f;
        LAS float* sl = (LAS float*)(F.lds + F.wave * 16384 + 8448);
#pragma unroll
        for (int q = 0; q < 2; ++q) { const int k = F.wave * 128 + 64 * q + lane; const float c0 = F.c[k], c1 = F.c[DM + k];
            sl[64 * q + lane] = c0 / (1.f + __expf(-c0)); sl[128 + 64 * q + lane] = c1 / (1.f + __expf(-c1)); }
        LDS_WAIT(); asm volatile("" ::: "memory");
#pragma unroll 1
        for (int kb = 0; kb < 128; kb += 64) { float w[64];
#pragma unroll
            for (int u = 0; u < 64; ++u) w[u] = F.w_ada[(size_t)(F.wave * 128 + kb + u) * 6144 + col];
#pragma unroll
            for (int u = 0; u < 64; ++u) { a0 += sl[kb + u] * w[u]; a1 += sl[128 + kb + u] * w[u]; } }
        LAS float* red = (LAS float*)(F.lds + F.wave * 16384 + 12288); red[lane] = a0; red[64 + lane] = a1;
        __syncthreads();
        if (F.tid < 128) { const int bb = F.tid >> 6, l = F.tid & 63; float sacc = F.b_ada[F.vcu * 64 + l];
#pragma unroll
            for (int w = 0; w < 8; ++w) sacc += ((const LAS float*)(F.lds + w * 16384 + 12288))[bb * 64 + l];
            ((float*)(F.ws + WS_MOD))[bb * 6144 + F.vcu * 64 + l] = sacc; }
        asm volatile("s_waitcnt vmcnt(0)" ::: "memory"); __syncthreads();
        if (F.tid == 0) { __builtin_amdgcn_fence(__ATOMIC_RELEASE, "agent"); asm volatile("s_waitcnt vmcnt(0)" ::: "memory");
            __hip_atomic_fetch_add((unsigned*)(F.ws + WS_CTL) + CW_MODCNT, 1u, __ATOMIC_RELAXED, __HIP_MEMORY_SCOPE_AGENT); } }
    if (parts & 2) { float* rope = (float*)(F.ws + WS_ROPE);
      for (int e = gw * 64 + lane; e < SEQ * 32; e += NGW * 64) { const int pos = e >> 5, i = e & 31;
          const float freq = powf(10000.0f, -(float)i / 32.0f); const float ang = (float)pos * freq; float s, c; sincos_d((double)ang, s, c);
          rope[2 * e] = c; rope[2 * e + 1] = s; } }
    if (parts & 4) { constexpr int I_PQ = 16 * 64, I_OUT = 8 * 32;
      for (int it = NGW - 1 - gw; it < I_PQ + I_OUT; it += NGW) { int r = it;
          if (r < I_PQ) { transpose_item<0>(F.w_pq, NQD, (bf16*)(F.ws + WS_WPQ), DM, 64 * (r / 64), 32 * (r % 64), scr, lane); continue; } r -= I_PQ;
          transpose_item<0, true>(F.w_out, DM, (bf16*)(F.ws + WS_WOUT), DM, 64 * (r / 32), 32 * (r % 32), scr, lane, nullptr, 64.0f); } }
    if (parts & 8) { unsigned char* wout_t = F.ws + WS_WOUT;
      for (int it = gw; it < 4 * 2 * 128; it += NGW) { const int g = it >> 8, ch = (it >> 7) & 1, n0 = (it & 127) * 8, cidx = ch * 64 + lane;
          const float* wo = F.w_out + (size_t)(512 + g * 128) * DM + n0; const float* ps = F.pool_scale + g * 128;
#pragma unroll
          for (int i = 0; i < 4; ++i) { const int f4 = lane + 64 * i, e = f4 >> 1, hf = f4 & 1; const f32x4 o = *(const f32x4*)(wo + (size_t)e * DM + 4 * hf) * ps[e]; *(LAS f32x4*)(scr + e * 8 + 4 * hf) = o; }
          float acc[8];
#pragma unroll
          for (int i = 0; i < 8; ++i) acc[i] = 0.f;
          const float* wp = F.w_pool + ((size_t)(g * 128 + cidx)) * 128;
          LDS_WAIT(); asm volatile("" ::: "memory");
#pragma unroll 1
          for (int e0 = 0; e0 < 128; e0 += 64) { f32x4 wv[16];
#pragma unroll
              for (int q = 0; q < 16; ++q) wv[q] = *(const f32x4*)(wp + e0 + 4 * q);
#pragma unroll
              for (int q = 0; q < 16; ++q)
#pragma unroll
                  for (int ee = 0; ee < 4; ++ee) { const float w = wv[q][ee]; const f32x4 o0 = *(const LAS f32x4*)(scr + (e0 + 4 * q + ee) * 8), o1 = *(const LAS f32x4*)(scr + (e0 + 4 * q + ee) * 8 + 4);
                      acc[0] += w * o0[0]; acc[1] += w * o0[1]; acc[2] += w * o0[2]; acc[3] += w * o0[3]; acc[4] += w * o1[0]; acc[5] += w * o1[1]; acc[6] += w * o1[2]; acc[7] += w * o1[3]; } }
#pragma unroll
          for (int i = 0; i < 8; ++i) wout_t[(size_t)(n0 + i) * DM + 512 + g * 128 + cidx] = (unsigned char)(fp8x4(acc[i] * 64.0f, 0.f, 0.f, 0.f) & 0xffu);
          LDS_WAIT(); asm volatile("" ::: "memory"); } }
    if (parts & 16) { bf16* k1b = (bf16*)(F.ws + WS_K1); bf16* k2b = (bf16*)(F.ws + WS_K2);
      for (int e = gw * 64 + lane; e < 128 * 128; e += NGW * 64) { k1b[e] = (bf16)f2bf(F.k1[e]); k2b[e] = (bf16)f2bf(F.k2[e]); } }
    if (parts & 32) { bf16* xn = (bf16*)(F.ws + WS_XN); const int rpw = TT / NGW;
      for (int m = gw * rpw; m < gw * rpw + rpw; m += 4) { f32x4 v[4][4];
#pragma unroll
          for (int q = 0; q < 4; ++q)
#pragma unroll
              for (int j = 0; j < 4; ++j) v[q][j] = *(const f32x4*)(F.x + (size_t)(m + q) * DM + 256 * j + 4 * lane);
#pragma unroll
          for (int q = 0; q < 4; ++q)
#pragma unroll
              for (int j = 0; j < 4; ++j) { u32x2 o; o.x = pk2(v[q][j][0], v[q][j][1]); o.y = pk2(v[q][j][2], v[q][j][3]); *(u32x2*)(xn + (size_t)(m + q) * DM + 256 * j + 4 * lane) = o;
                  *(unsigned*)(F.ws + WS_XN8 + (size_t)(m + q) * DM + 256 * j + 4 * lane) = fp8x4(v[q][j][0], v[q][j][1], v[q][j][2], v[q][j][3]); } } }
    if (parts & 64) {
        __syncthreads();
        if (F.tid == 0) { unsigned sp = 0; const unsigned* cnt = (const unsigned*)(F.ws + WS_CTL) + CW_MODCNT;
            while (__hip_atomic_load(cnt, __ATOMIC_RELAXED, __HIP_MEMORY_SCOPE_AGENT) < 96u) { __builtin_amdgcn_s_sleep(2); if (++sp > (1u << 22)) break; }
            __builtin_amdgcn_fence(__ATOMIC_ACQUIRE, "agent"); asm volatile("s_waitcnt vmcnt(0)" ::: "memory"); }
        __syncthreads();
        p1_win(F);
    }
}
__device__ __forceinline__ void tb_load4(Frame& F, int base, int r1, f32x4 (&dst)[4][4]) {
#pragma unroll
    for (int q = 0; q < 4; ++q) { const int it = (base + q < r1) ? base + q : r1 - 1; const int tb = it >= NEXP, e = it - tb * NEXP; const float* src = (tb ? F.pv : F.pu) + (size_t)e * DM;
#pragma unroll
        for (int j = 0; j < 4; ++j) dst[q][j] = *(const f32x4*)(src + 256 * j + 4 * F.lane); }
}
__device__ __forceinline__ void tb_proc4(Frame& F, int base, int r1, const f32x4 (&v)[4][4]) {
    const int lane = F.lane; float* su = (float*)(F.ws + WS_SU); float* sv = (float*)(F.ws + WS_SV); float am[4];
#pragma unroll
    for (int q = 0; q < 4; ++q) { float a = 0.f;
#pragma unroll
        for (int j = 0; j < 4; ++j) a = fmaxf(a, fmaxf(fmaxf(fabsf(v[q][j][0]), fabsf(v[q][j][1])), fmaxf(fabsf(v[q][j][2]), fabsf(v[q][j][3])))); am[q] = a; }
#pragma unroll
    for (int o = 1; o < 64; o <<= 1) {
#pragma unroll
        for (int q = 0; q < 4; ++q) am[q] = fmaxf(am[q], __shfl_xor(am[q], o)); }
#pragma unroll
    for (int q = 0; q < 4; ++q) { const int it = (base + q < r1) ? base + q : r1 - 1; const int tb = it >= NEXP, e = it - tb * NEXP; float a = am[q]; if (a == 0.f) a = 1.f;
        unsigned w[4];
        if (!tb) { const float inv = 127.0f / a;
#pragma unroll
            for (int j = 0; j < 4; ++j) { const int q0 = (int)rintf(v[q][j][0] * inv), q1 = (int)rintf(v[q][j][1] * inv), q2 = (int)rintf(v[q][j][2] * inv), q3 = (int)rintf(v[q][j][3] * inv);
                w[j] = (unsigned)(q0 & 255) | ((unsigned)(q1 & 255) << 8) | ((unsigned)(q2 & 255) << 16) | ((unsigned)(q3 & 255) << 24); }
            *(v4u*)(F.ws + WS_U + (size_t)e * DM + 16 * lane) = (v4u){w[0], w[1], w[2], w[3]}; if (lane == 0) su[e] = a * (1.0f / 127.0f);
        } else { const float inv = 256.0f / a;
#pragma unroll
            for (int j = 0; j < 4; ++j) { int pk = __builtin_amdgcn_cvt_pk_bf8_f32(v[q][j][0] * inv, v[q][j][1] * inv, 0, false); pk = __builtin_amdgcn_cvt_pk_bf8_f32(v[q][j][2] * inv, v[q][j][3] * inv, pk, true); w[j] = (unsigned)pk; }
            *(v4u*)(F.ws + WS_V + (size_t)e * DM + 16 * lane) = (v4u){w[0], w[1], w[2], w[3]}; if (lane == 0) sv[e] = a * (1.0f / 256.0f); } }
}
__device__ __forceinline__ void p2_tables(Frame& F, int cw, int ncw, int row_lo, int row_hi) {
    const int per = (row_hi - row_lo + ncw - 1) / ncw, r0 = row_lo + cw * per, r1 = (r0 + per) < row_hi ? (r0 + per) : row_hi;
    if (r0 >= r1) return;
    f32x4 va[4][4], vb[4][4];
    tb_load4(F, r0, r1, va);
    for (int it0 = r0; it0 < r1; it0 += 8) {
        if (it0 + 4 < r1) tb_load4(F, it0 + 4, r1, vb);
        tb_proc4(F, it0, r1, va);
        if (it0 + 4 < r1) { if (it0 + 8 < r1) tb_load4(F, it0 + 8, r1, va); tb_proc4(F, it0 + 4, r1, vb); }
    }
}
__device__ __forceinline__ void p1_win(Frame& F) {
    const float* mod = (const float*)(F.ws + WS_MOD);
    LAS float* sc = (LAS float*)F.lds; LAS float* sh = sc + 2048;
    for (int i = F.tid; i < 2048; i += NTHREADS) { const int b = i >> 10, k = i & 1023; sc[i] = 1.f + mod[b * 6144 + 1024 + k]; sh[i] = mod[b * 6144 + k]; }
    __syncthreads();
    const int lane = F.lane;
    if (F.vcu < 40) { const int b = F.vcu / 20, n = (F.vcu % 20) * 64 + lane; int nsrc = n; if (n < 640) { const int hd = n >> 6, w = n & 63; nsrc = hd * 64 + (w >> 1) + 32 * (w & 1); }
        float a = 0.f;
#pragma unroll 1
        for (int kb = 0; kb < 128; kb += 64) { float w[64];
#pragma unroll
            for (int u = 0; u < 64; ++u) w[u] = F.w_in[(size_t)(F.wave * 128 + kb + u) * NIN + nsrc];
#pragma unroll
            for (int u = 0; u < 64; ++u) a += sh[b * 1024 + F.wave * 128 + kb + u] * w[u]; }
        LAS float* red = (LAS float*)(F.lds + 16384); red[F.wave * 64 + lane] = a;
        __syncthreads();
        if (F.tid < 64) { float sacc = 0.f;
#pragma unroll
            for (int w = 0; w < 8; ++w) sacc += red[w * 64 + F.tid];
            ((float*)(F.ws + WS_BIAS))[b * NIN + (F.vcu % 20) * 64 + F.tid] = sacc; } }
    LAS float* scr = (LAS float*)(F.lds + 32768 + F.wave * 8448);
    const int gw = F.vcu * NWAVES + F.wave, NGW = F.G * NWAVES;
    for (int it = gw; it < 2 * 640; it += NGW) { const int b = it / 640, r = it % 640;
        transpose_item<1, true>(F.w_in, NIN, (bf16*)(F.ws + WS_WIN + (size_t)b * NIN * DM), DM, 64 * (r / 40), 32 * (r % 40), scr, lane, sc + b * 1024, 64.0f); }
    __syncthreads();
}
constexpr int KS_STRIDE = 144, VT_STRIDE = 520, KS_BYTES = 256 * KS_STRIDE, VT_BYTES = 64 * VT_STRIDE;
__device__ __forceinline__ void p3_attn_unit(Frame& F, int unit) {
    const int b = unit >> 7, kvh = (unit >> 6) & 1, n = unit & 63;
    const bf16* proj = (const bf16*)(F.ws + WS_PROJ); unsigned char* a2 = F.ws + WS_A2;
    LAS unsigned char* Ks = F.lds; LAS unsigned char* Vt = F.lds + KS_BYTES;
    const int tid = F.tid, lane = F.lane, wave = F.wave, r32 = lane & 31, h = lane >> 5;
    const size_t tok0 = (size_t)b * SEQ + (size_t)n * 128;
#pragma unroll
    for (int i = 0; i < 4; ++i) { const int ci = tid + NTHREADS * i, row = ci >> 3, ch = ci & 7; const bool valid = (n > 0) || (row >= 128);
        const size_t tk = tok0 - 128 + row;
        v4u kv = (v4u){0u, 0u, 0u, 0u}, vv = (v4u){0u, 0u, 0u, 0u};
        if (valid) { kv = *(const v4u*)(proj + tk * NIN + 512 + kvh * 64 + ch * 8); vv = *(const v4u*)(proj + tk * NIN + 640 + kvh * 64 + ch * 8); }
        *(LAS v4u*)(Ks + row * KS_STRIDE + ch * 16) = kv;
        LAS bf16* vt = (LAS bf16*)(Vt + (ch * 8) * VT_STRIDE) + row;
        vt[0 * (VT_STRIDE / 2)] = (bf16)(vv.x & 0xffff); vt[1 * (VT_STRIDE / 2)] = (bf16)(vv.x >> 16); vt[2 * (VT_STRIDE / 2)] = (bf16)(vv.y & 0xffff); vt[3 * (VT_STRIDE / 2)] = (bf16)(vv.y >> 16);
        vt[4 * (VT_STRIDE / 2)] = (bf16)(vv.z & 0xffff); vt[5 * (VT_STRIDE / 2)] = (bf16)(vv.z >> 16); vt[6 * (VT_STRIDE / 2)] = (bf16)(vv.w & 0xffff); vt[7 * (VT_STRIDE / 2)] = (bf16)(vv.w >> 16); }
    __syncthreads();
    const int g = wave >> 1, hq = kvh * 4 + g; const float sink2 = F.sinks[hq] * LOG2E;
#pragma unroll 1
    for (int qt = 0; qt < 2; ++qt) {
        const int qi0 = (wave & 1) * 64 + qt * 32, t0 = qi0 >> 5; const size_t tokq = tok0 + qi0 + r32;
        bf16x8 qf[4];
#pragma unroll
        for (int s = 0; s < 4; ++s) qf[s] = *(const bf16x8*)(proj + tokq * NIN + hq * 64 + 16 * s + 8 * h);
        f32x16 sc[5];
#pragma unroll
        for (int kt = 0; kt < 5; ++kt) { sc[kt] = (f32x16){};
#pragma unroll
            for (int s = 0; s < 4; ++s) { const bf16x8 kf = *(const LAS bf16x8*)(Ks + (32 * (t0 + kt) + r32) * KS_STRIDE + (16 * s + 8 * h) * 2);
                sc[kt] = __builtin_amdgcn_mfma_f32_32x32x16_bf16(kf, qf[s], sc[kt], 0, 0, 0); } }
        const int qi = qi0 + r32; float m = sink2;
#pragma unroll
        for (int kt = 0; kt < 5; ++kt)
#pragma unroll
            for (int r = 0; r < 16; ++r) { const int sidx = 32 * (t0 + kt) + (r & 3) + 8 * (r >> 2) + 4 * h; const int rel = qi + 128 - sidx;
                const bool ok = (rel >= 0) && (rel < 128) && ((n > 0) || (sidx >= 128));
                const float v = ok ? sc[kt][r] : -INFINITY; sc[kt][r] = v; m = fmaxf(m, v); }
        m = fmaxf(m, __shfl_xor(m, 32));
        float l = 0.f;
#pragma unroll
        for (int kt = 0; kt < 5; ++kt)
#pragma unroll
            for (int r = 0; r < 16; ++r) { const float p = __builtin_amdgcn_exp2f(sc[kt][r] - m); sc[kt][r] = p; l += p; }
        l += __shfl_xor(l, 32); l += __builtin_amdgcn_exp2f(sink2 - m);
        f32x16 o[2]; o[0] = (f32x16){}; o[1] = (f32x16){};
#pragma unroll
        for (int kt = 0; kt < 5; ++kt)
#pragma unroll
            for (int s2 = 0; s2 < 2; ++s2) {
                u32x4 pw; pw.x = pg8::cvt_pk_bf16(sc[kt][8 * s2 + 0], sc[kt][8 * s2 + 1]); pw.y = pg8::cvt_pk_bf16(sc[kt][8 * s2 + 2], sc[kt][8 * s2 + 3]);
                pw.z = pg8::cvt_pk_bf16(sc[kt][8 * s2 + 4], sc[kt][8 * s2 + 5]); pw.w = pg8::cvt_pk_bf16(sc[kt][8 * s2 + 6], sc[kt][8 * s2 + 7]);
                const bf16x8 pf = __builtin_bit_cast(bf16x8, pw);
#pragma unroll
                for (int dt = 0; dt < 2; ++dt) { const LAS unsigned char* vp = Vt + (dt * 32 + r32) * VT_STRIDE + (32 * (t0 + kt) + 16 * s2 + 4 * h) * 2;
                    const u32x2 lo = *(const LAS u32x2*)vp, hi = *(const LAS u32x2*)(vp + 16);
                    const u32x4 vw = (u32x4){lo.x, lo.y, hi.x, hi.y};
                    o[dt] = __builtin_amdgcn_mfma_f32_32x32x16_bf16(__builtin_bit_cast(bf16x8, vw), pf, o[dt], 0, 0, 0); } }
        const float inv = 16.0f / l;
#pragma unroll
        for (int dt = 0; dt < 2; ++dt)
#pragma unroll
            for (int rg = 0; rg < 4; ++rg) { const int d0 = dt * 32 + 8 * rg + 4 * h;
                *(unsigned*)(a2 + tokq * DM + hq * 64 + d0) = fp8x4(o[dt][4 * rg + 0] * inv, o[dt][4 * rg + 1] * inv, o[dt][4 * rg + 2] * inv, o[dt][4 * rg + 3] * inv); }
    }
    __syncthreads();
}
__device__ __forceinline__ void p3_pool_unit(Frame& F, int unit) {
    const bf16* proj = (const bf16*)(F.ws + WS_PROJ); unsigned char* a2 = F.ws + WS_A2;
    const int cp = F.tid & 255, half = F.tid >> 8, gi = cp >> 6, w = 2 << gi;
    const int tstart = unit * 64 + half * 32, s0 = tstart & (SEQ - 1);
    const bf16* pc = proj + 768 + 2 * cp;
    unsigned u[48];
#pragma unroll
    for (int i = 0; i < 48; ++i) { const int s = s0 - 16 + i; u[i] = (s >= 0) ? *(const unsigned*)(pc + (size_t)(tstart - 16 + i) * NIN) : 0u; }
    float w0 = 0.f, w1 = 0.f;
#pragma unroll
    for (int j = 1; j <= 16; ++j) if (j <= w) { w0 += bf_lo(u[16 - j]); w1 += bf_hi(u[16 - j]); }
#pragma unroll
    for (int i = 0; i < 32; ++i) { const int s = s0 + i; const float p0 = bf_lo(u[16 + i]), p1 = bf_hi(u[16 + i]);
        const unsigned uo = (w == 2) ? u[14 + i] : (w == 4) ? u[12 + i] : (w == 8) ? u[8 + i] : u[i];
        w0 += p0 - bf_lo(uo); w1 += p1 - bf_hi(uo);
        const float rc = 1.0f / (float)((s + 1) < w ? (s + 1) : w);
        *(unsigned short*)(a2 + (size_t)(tstart + i) * DM + 512 + 2 * cp) = (unsigned short)(fp8x4((w0 * rc - p0) * 16.0f, (w1 * rc - p1) * 16.0f, 0.f, 0.f) & 0xffffu); }
}
__device__ __forceinline__ void p5_ln1(Frame& F) {
    const float* mod = (const float*)(F.ws + WS_MOD); const bf16* mix = (const bf16*)(F.ws + WS_MIX); const bf16* xn = (const bf16*)(F.ws + WS_XN);
    bf16* x1 = (bf16*)(F.ws + WS_X1); bf16* h2 = (bf16*)(F.ws + WS_H2); unsigned char* h2q = F.ws + WS_H2Q; float* shp = (float*)(F.ws + WS_SH);
    const int gw = F.vcu * NWAVES + F.wave, lane = F.lane; const int rows_per_wave = TT / (F.G * NWAVES);
    const int row0 = gw * rows_per_wave, b = row0 >> 13;
    f32x4 g1[4], lg[4], lb[4], s2[4], h2s[4];
#pragma unroll
    for (int j = 0; j < 4; ++j) { const int d = 256 * j + 4 * lane;
        g1[j] = *(const f32x4*)(mod + b * 6144 + 2048 + d) + 1.0f; lg[j] = *(const f32x4*)(F.ln1_g + d); lb[j] = *(const f32x4*)(F.ln1_b + d);
        s2[j] = *(const f32x4*)(mod + b * 6144 + 4096 + d) + 1.0f; h2s[j] = *(const f32x4*)(mod + b * 6144 + 3072 + d); }
    for (int r = 0; r < rows_per_wave; r += 2) {
        u32x2 xw[2][4]; u32x2 mv[2][4];
#pragma unroll
        for (int q = 0; q < 2; ++q)
#pragma unroll
            for (int j = 0; j < 4; ++j) { const size_t m = (size_t)(row0 + r + q); const int d = 256 * j + 4 * lane; xw[q][j] = *(const u32x2*)(xn + m * DM + d); mv[q][j] = *(const u32x2*)(mix + m * DM + d); }
#pragma unroll
        for (int q = 0; q < 2; ++q) { const size_t m = (size_t)(row0 + r + q);
        f32x4 v[4]; float s = 0.f;
#pragma unroll
        for (int j = 0; j < 4; ++j) {
            const f32x4 mf = (f32x4){bf_lo(mv[q][j].x), bf_hi(mv[q][j].x), bf_lo(mv[q][j].y), bf_hi(mv[q][j].y)};
            const f32x4 xf = (f32x4){bf_lo(xw[q][j].x), bf_hi(xw[q][j].x), bf_lo(xw[q][j].y), bf_hi(xw[q][j].y)};
            v[j] = xf * DN_ALPHA + g1[j] * mf; s += (v[j][0] + v[j][1]) + (v[j][2] + v[j][3]); }
        const float mean = wave_sum(s) * (1.f / DM); float qq = 0.f;
#pragma unroll
        for (int j = 0; j < 4; ++j) { v[j] = v[j] - mean; qq += (v[j][0] * v[j][0] + v[j][1] * v[j][1]) + (v[j][2] * v[j][2] + v[j][3] * v[j][3]); }
        const float rstd = 1.0f / sqrtf(wave_sum(qq) * (1.f / DM) + LN_EPS);
        f32x4 hh[4]; float am = 0.f;
#pragma unroll
        for (int j = 0; j < 4; ++j) { const int d = 256 * j + 4 * lane; const f32x4 y = v[j] * rstd * lg[j] + lb[j]; hh[j] = y * s2[j] + h2s[j];
            u32x2 o; o.x = pk2(y[0], y[1]); o.y = pk2(y[2], y[3]); *(u32x2*)(x1 + m * DM + d) = o;
            u32x2 p; p.x = pk2(hh[j][0], hh[j][1]); p.y = pk2(hh[j][2], hh[j][3]); *(u32x2*)(h2 + m * DM + d) = p;
            hh[j] = (f32x4){bf_lo(p.x), bf_hi(p.x), bf_lo(p.y), bf_hi(p.y)};
            am = fmaxf(am, fmaxf(fmaxf(fabsf(hh[j][0]), fabsf(hh[j][1])), fmaxf(fabsf(hh[j][2]), fabsf(hh[j][3])))); }
#pragma unroll
        for (int o = 1; o < 64; o <<= 1) am = fmaxf(am, __shfl_xor(am, o));
        if (am == 0.f) am = 1.f;
        const float inv = 127.0f / am; unsigned w[4];
#pragma unroll
        for (int j = 0; j < 4; ++j) { const int q0 = (int)rintf(hh[j][0] * inv), q1 = (int)rintf(hh[j][1] * inv), q2 = (int)rintf(hh[j][2] * inv), q3 = (int)rintf(hh[j][3] * inv);
            w[j] = (unsigned)(q0 & 255) | ((unsigned)(q1 & 255) << 8) | ((unsigned)(q2 & 255) << 16) | ((unsigned)(q3 & 255) << 24); }
        *(v4u*)(h2q + m * DM + 16 * lane) = (v4u){w[0], w[1], w[2], w[3]}; if (lane == 0) shp[m] = am * (1.0f / 127.0f); } }
}
constexpr int KR_STRIDE = 272, KR_BYTES = 128 * KR_STRIDE;
#define INS16(a, v) do { _Pragma("unroll") for (int _i = 15; _i >= 1; --_i) a[_i] = __builtin_amdgcn_fmed3f(a[_i - 1], a[_i], (v)); a[0] = fmaxf(a[0], (v)); } while (0)
#define BITONIC16(a) do { _Pragma("unroll") for (int _st = 8; _st >= 1; _st >>= 1) { _Pragma("unroll") for (int _i = 0; _i < 16; ++_i) if ((_i & _st) == 0) { const float _x = a[_i], _y = a[_i + _st]; a[_i] = fmaxf(_x, _y); a[_i + _st] = fminf(_x, _y); } } } while (0)
__device__ __forceinline__ void p7_route(Frame& F) {
    const bf16* q = (const bf16*)(F.ws + WS_Q); unsigned short* pe = (unsigned short*)(F.ws + WS_PE); float* pg = (float*)(F.ws + WS_PG);
    const int tid = F.tid, lane = F.lane, wave = F.wave, r32 = lane & 31, h = lane >> 5;
    { const bf16* k1b = (const bf16*)(F.ws + WS_K1);
      for (int ci = tid; ci < 2 * 128 * 16; ci += NTHREADS) { const int side = ci >> 11, row = (ci >> 4) & 127, ch = ci & 15;
          *(LAS v4u*)(F.lds + side * KR_BYTES + row * KR_STRIDE + ch * 16) = *(const v4u*)(k1b + (size_t)side * 16384 + row * 128 + ch * 8); } }
    __syncthreads();
    LAS unsigned char* scr = F.lds + 2 * KR_BYTES + wave * 2048 + lane * 32;
    pg8::StaticOrder S; S.init(TT, NQD, F.G, (int)blockIdx.x); pg8::Unit u;
    for (int ui = 0; S.next(ui, u); ++ui) {
        const int head = u.pn; const size_t tok = (size_t)u.pm * 256 + wave * 32 + r32;
        float vv[2][16];
#pragma unroll
        for (int side = 0; side < 2; ++side) {
            const bf16* qb = q + tok * NQD + head * 256 + side * 128;
            bf16x8 qf[8];
#pragma unroll
            for (int s = 0; s < 8; ++s) qf[s] = *(const bf16x8*)(qb + 16 * s + 8 * h);
            float a[16];
#pragma unroll
            for (int i = 0; i < 16; ++i) a[i] = -INFINITY;
#pragma unroll
            for (int kt = 0; kt < 4; ++kt) { f32x16 acc = (f32x16){};
#pragma unroll
                for (int s = 0; s < 8; ++s) { const bf16x8 kf = *(const LAS bf16x8*)(F.lds + side * KR_BYTES + (32 * kt + r32) * KR_STRIDE + (16 * s + 8 * h) * 2);
                    acc = __builtin_amdgcn_mfma_f32_32x32x16_bf16(kf, qf[s], acc, 0, 0, 0); }
#pragma unroll
                for (int r = 0; r < 16; ++r) { const unsigned key = (unsigned)(32 * kt + (r & 3) + 8 * (r >> 2)) | ((unsigned)h << 2);
                    const float v = __uint_as_float((__float_as_uint(acc[r]) & 0xFFFFFF80u) | key); INS16(a, v); }
                __builtin_amdgcn_sched_barrier(0); }
            float c[16];
#pragma unroll
            for (int i = 0; i < 16; ++i) c[i] = __shfl_xor(a[15 - i], 32);
#pragma unroll
            for (int i = 0; i < 16; ++i) c[i] = fmaxf(a[i], c[i]);
            BITONIC16(c);
#pragma unroll
            for (int i = 0; i < 16; ++i) vv[side][i] = c[i];
        }
        { v4u w1, w2;
#define PK4(L, b) ((__float_as_uint(L[b]) & 0x7Fu) | ((__float_as_uint(L[b + 1]) & 0x7Fu) << 8) | ((__float_as_uint(L[b + 2]) & 0x7Fu) << 16) | ((__float_as_uint(L[b + 3]) & 0x7Fu) << 24))
          w1.x = PK4(vv[0], 0); w1.y = PK4(vv[0], 4); w1.z = PK4(vv[0], 8); w1.w = PK4(vv[0], 12);
          w2.x = PK4(vv[1], 0); w2.y = PK4(vv[1], 4); w2.z = PK4(vv[1], 8); w2.w = PK4(vv[1], 12);
#undef PK4
          *(LAS v4u*)scr = w1; *(LAS v4u*)(scr + 16) = w2; }
        float c1[16], c2[16], top[16];
#pragma unroll
        for (int i = 0; i < 16; ++i) { c1[i] = __uint_as_float(__float_as_uint(vv[0][i]) & 0xFFFFFF80u); c2[i] = __uint_as_float(__float_as_uint(vv[1][i]) & 0xFFFFFF80u); top[i] = -INFINITY; }
#pragma unroll
        for (int ia = 0; ia < 16; ++ia)
#pragma unroll
            for (int ib = 0; ib < 16; ++ib) if ((ia + 1) * (ib + 1) <= 16) {
                const float sm = c1[ia] + c2[ib]; const float v = __uint_as_float((__float_as_uint(sm) & 0xFFFFFF00u) | (unsigned)(ia * 16 + ib)); INS16(top, v); }
        float ex[16], den = 0.f;
#pragma unroll
        for (int i = 0; i < 16; ++i) { ex[i] = __expf(top[i] - top[0]); den += ex[i]; }
        const float rden = 1.0f / den;
        LDS_WAIT();
        unsigned short ev[8]; float gv[8];
#pragma unroll
        for (int j = 0; j < 8; ++j) { const float t = h ? top[8 + j] : top[j]; const float e = h ? ex[8 + j] : ex[j];
            const unsigned code = __float_as_uint(t) & 0xFFu; const unsigned i1 = *(const LAS unsigned char*)(scr + (code >> 4)), i2 = *(const LAS unsigned char*)(scr + 16 + (code & 15u));
            ev[j] = (unsigned short)(i1 * 128u + i2); gv[j] = e * rden; }
        v4u ew; ew.x = ev[0] | ((unsigned)ev[1] << 16); ew.y = ev[2] | ((unsigned)ev[3] << 16); ew.z = ev[4] | ((unsigned)ev[5] << 16); ew.w = ev[6] | ((unsigned)ev[7] << 16);
        *(v4u*)(pe + tok * 128 + head * 16 + 8 * h) = ew;
        *(f32x4*)(pg + tok * 128 + head * 16 + 8 * h) = (f32x4){gv[0], gv[1], gv[2], gv[3]};
        *(f32x4*)(pg + tok * 128 + head * 16 + 8 * h + 4) = (f32x4){gv[4], gv[5], gv[6], gv[7]};
        LDS_WAIT();
    }
    __syncthreads();
}
__device__ __forceinline__ float gelu_erf(float v) {
    const float d = fabsf(v) * 0.2316418882f + 1.0f, t = __builtin_amdgcn_rcpf(d);
    float q = t * 0.5307027145f + (-0.7265760135f); q = q * t + 0.7107068705f; q = q * t + (-0.142248368f); q = q * t + 0.127414796f; q = q * t;
    const float e = __builtin_amdgcn_exp2f(v * v * (-0.72134752044f)), m = v * (q * e);
    return v < 0.f ? m : v - m; }
#ifndef NPART
#define NPART 8
#endif
constexpr int TPW = 8, NSWEEP = 1;
constexpr int PSHIFT = (NPART == 32) ? 9 : (NPART == 8) ? 11 : (NPART == 16) ? 10 : (NPART == 4) ? 12 : (NPART == 2) ? 13 : 14;
__device__ __forceinline__ void p8_peer(Frame& F, unsigned emask = 0xffffu, int skip = 0) {
    const float* mod = (const float*)(F.ws + WS_MOD);
    const bf16* x1 = (const bf16*)(F.ws + WS_X1); const bf16* h2 = (const bf16*)(F.ws + WS_H2);
    const unsigned char* ut = F.ws + WS_U; const unsigned char* vt = F.ws + WS_V;
    const float* su = (const float*)(F.ws + WS_SU); const float* sv = (const float*)(F.ws + WS_SV);
    const unsigned* pe = (const unsigned*)(F.ws + WS_PE); const float* pg = (const float*)(F.ws + WS_PG);
    const int gw = F.vcu * NWAVES + F.wave;
    const int b3 = (F.lane >> 3) & 1;
#pragma unroll 1
    for (int sweep = 0; sweep < NSWEEP; ++sweep) {
    const int t0 = (gw * NSWEEP + sweep) * TPW, b = t0 >> 13;
    int lane = F.lane; asm volatile("" : "+v"(lane));
    unsigned hq[TPW][4]; float shs[TPW]; unsigned es[TPW]; float gs[TPW][2]; int offv[TPW];
    unsigned pe2v[TPW]; f32x2 pg2v[TPW];
#pragma unroll
    for (int tt = 0; tt < TPW; ++tt) { const size_t t = (size_t)(t0 + tt);
        const u32x4 hw = *(const u32x4*)(F.ws + WS_H2Q + t * DM + 16 * lane); hq[tt][0] = hw.x; hq[tt][1] = hw.y; hq[tt][2] = hw.z; hq[tt][3] = hw.w; shs[tt] = ((const float*)(F.ws + WS_SH))[t];
        pe2v[tt] = pe[t * 64 + lane]; pg2v[tt] = *(const f32x2*)(pg + t * 128 + 2 * lane); }
#pragma unroll
    for (int tt = 0; tt < TPW; ++tt) { LAS unsigned* scr = (LAS unsigned*)(F.lds + (F.wave * TPW + tt) * 1024);
        const unsigned pe2 = pe2v[tt]; const f32x2 pg2 = pg2v[tt];
        const unsigned elo = pe2 & emask, ehi = (pe2 >> 16) & emask; const int plo = (int)(elo >> PSHIFT), phi = (int)(ehi >> PSHIFT);
        int base = 0, poslo = 0, poshi = 0, ov = 0;
#pragma unroll
        for (int r = 0; r < NPART; ++r) { const unsigned long long mlo = __ballot(plo == r), mhi = __ballot(phi == r);
            const int clo = __popcll(mlo), chi = __popcll(mhi);
            const int rlo = (int)__builtin_amdgcn_mbcnt_hi((unsigned)(mlo >> 32), __builtin_amdgcn_mbcnt_lo((unsigned)mlo, 0u));
            const int rhi = (int)__builtin_amdgcn_mbcnt_hi((unsigned)(mhi >> 32), __builtin_amdgcn_mbcnt_lo((unsigned)mhi, 0u));
            if (plo == r) poslo = base + rlo; if (phi == r) poshi = base + clo + rhi;
            base += clo + chi; if (lane == r + 1) ov = base; }
        offv[tt] = ov;
        scr[2 * poslo] = elo; scr[2 * poslo + 1] = __float_as_uint(pg2.x); scr[2 * poshi] = ehi; scr[2 * poshi + 1] = __float_as_uint(pg2.y); }
    LDS_WAIT();
#pragma unroll
    for (int tt = 0; tt < TPW; ++tt) { const LAS unsigned* scr = (const LAS unsigned*)(F.lds + (F.wave * TPW + tt) * 1024);
        const u32x4 sr = *(const LAS u32x4*)(scr + 4 * lane);
        es[tt] = sr.x | (sr.z << 16); gs[tt][0] = __uint_as_float(sr.y); gs[tt][1] = __uint_as_float(sr.w); }
    LDS_WAIT();
#define P8_ISSUE(buf, tbl, tok, bb) do { _Pragma("unroll") for (int k2 = 0; k2 < 4; ++k2) { const unsigned ew = (unsigned)__builtin_amdgcn_readlane((int)es[tok], 4 * (bb) + k2); \
        buf[2 * k2] = *(const u32x4*)((tbl) + (size_t)(ew & 0xffffu) * DM + 16 * lane); buf[2 * k2 + 1] = *(const u32x4*)((tbl) + (size_t)(ew >> 16) * DM + 16 * lane); } } while (0)
    int hidv[TPW][2];
#pragma unroll
    for (int tt = 0; tt < TPW; ++tt) { hidv[tt][0] = 0; hidv[tt][1] = 0; }
    {
        u32x4 bufA[8], bufB[8];
#define P8_DOTS(buf, tok, bb) do { int p[8]; \
            _Pragma("unroll") for (int kk = 0; kk < 8; ++kk) { int s_ = __builtin_amdgcn_sdot4((int)buf[kk].x, (int)hq[tok][0], 0, false); s_ = __builtin_amdgcn_sdot4((int)buf[kk].y, (int)hq[tok][1], s_, false); \
                s_ = __builtin_amdgcn_sdot4((int)buf[kk].z, (int)hq[tok][2], s_, false); s_ = __builtin_amdgcn_sdot4((int)buf[kk].w, (int)hq[tok][3], s_, false); p[kk] = s_; } \
            int q4[4], q2[2], q1; \
            _Pragma("unroll") for (int i = 0; i < 4; ++i) { auto r_ = __builtin_amdgcn_permlane32_swap((unsigned)p[i], (unsigned)p[i + 4], false, false); q4[i] = (int)(r_[0] + r_[1]); } \
            _Pragma("unroll") for (int i = 0; i < 2; ++i) { auto r_ = __builtin_amdgcn_permlane16_swap((unsigned)q4[i], (unsigned)q4[i + 2], false, false); q2[i] = (int)(r_[0] + r_[1]); } \
            { const int keep = b3 ? q2[1] : q2[0], send = b3 ? q2[0] : q2[1]; q1 = keep + __builtin_amdgcn_update_dpp(0, send, 0x128, 0xF, 0xF, true); } \
            q1 += __builtin_amdgcn_update_dpp(0, q1, 0xB1, 0xF, 0xF, true); q1 += __builtin_amdgcn_update_dpp(0, q1, 0x4E, 0xF, 0xF, true); q1 += __builtin_amdgcn_update_dpp(0, q1, 0x141, 0xF, 0xF, true); \
            const int i2_ = (lane & 3) * 2; const int v0_ = __builtin_amdgcn_ds_bpermute(i2_ << 5, q1), v1_ = __builtin_amdgcn_ds_bpermute((i2_ + 1) << 5, q1); \
            if ((lane >> 2) == (bb)) { hidv[tok][0] = v0_; hidv[tok][1] = v1_; } } while (0)
        int cur[TPW];
#pragma unroll
        for (int tt = 0; tt < TPW; ++tt) cur[tt] = 0;
#define P8_STEP_A(tt_, bufX, bufY, r_) { const int end_ = __builtin_amdgcn_readlane(offv[tt_], (r_) + 1); \
            { constexpr int tn_ = ((tt_) + 1) % TPW; const int rn_ = (r_) + ((tt_) + 1) / TPW; \
              if (rn_ < NPART && cur[tn_] < __builtin_amdgcn_readlane(offv[tn_], rn_ + 1)) P8_ISSUE(bufY, ut, tn_, cur[tn_] >> 3); } \
            __builtin_amdgcn_sched_barrier(0); \
            bool pre_ = true; \
            while (cur[tt_] < end_) { if (!pre_) P8_ISSUE(bufX, ut, tt_, cur[tt_] >> 3); pre_ = false; P8_DOTS(bufX, tt_, cur[tt_] >> 3); cur[tt_] += 8; } }
        if ((skip & 1) == 0) {
        if (0 < __builtin_amdgcn_readlane(offv[0], 1)) P8_ISSUE(bufA, ut, 0, 0);
#pragma unroll 1
        for (int r = 0; r < NPART; ++r) {
            P8_STEP_A(0, bufA, bufB, r) P8_STEP_A(1, bufB, bufA, r) P8_STEP_A(2, bufA, bufB, r) P8_STEP_A(3, bufB, bufA, r)
            P8_STEP_A(4, bufA, bufB, r) P8_STEP_A(5, bufB, bufA, r) P8_STEP_A(6, bufA, bufB, r) P8_STEP_A(7, bufB, bufA, r)
        } }
#undef P8_STEP_A
#undef P8_DOTS
    }
    { float su0[TPW], su1[TPW], sv0[TPW], sv1[TPW];
#pragma unroll
      for (int tt = 0; tt < TPW; ++tt) { const unsigned e0 = es[tt] & 0xffffu, e1 = es[tt] >> 16; su0[tt] = su[e0]; su1[tt] = su[e1]; sv0[tt] = sv[e0]; sv1[tt] = sv[e1]; }
#pragma unroll
      for (int tt = 0; tt < TPW; ++tt) {
        gs[tt][0] = gelu_erf((float)hidv[tt][0] * (shs[tt] * su0[tt])) * gs[tt][0] * sv0[tt];
        gs[tt][1] = gelu_erf((float)hidv[tt][1] * (shs[tt] * su1[tt])) * gs[tt][1] * sv1[tt]; } }
    typedef _Float16 f16x2 __attribute__((ext_vector_type(2)));
    f16x2 yh[TPW][8];
#pragma unroll
    for (int tt = 0; tt < TPW; ++tt) {
#pragma unroll
        for (int i = 0; i < 8; ++i) yh[tt][i] = (f16x2){(_Float16)0.f, (_Float16)0.f}; }
    {
        u32x4 bufA[8], bufB[8];
#define BF8ACC(tok, a, word, j) { const unsigned _w = (word); const unsigned _h02 = __builtin_amdgcn_perm(0u, _w, 0x020c000cu), _h13 = __builtin_amdgcn_perm(0u, _w, 0x030c010cu); \
                          yh[tok][2 * (j)] = __builtin_elementwise_fma(__builtin_bit_cast(f16x2, _h02), (a), yh[tok][2 * (j)]); yh[tok][2 * (j) + 1] = __builtin_elementwise_fma(__builtin_bit_cast(f16x2, _h13), (a), yh[tok][2 * (j) + 1]); }
#define P8_ACC(buf, tok, bb) do { _Pragma("unroll") for (int k2 = 0; k2 < 4; ++k2) { \
            const _Float16 h0_ = (_Float16)__int_as_float(__builtin_amdgcn_readlane(__float_as_int(gs[tok][0]), 4 * (bb) + k2)), h1_ = (_Float16)__int_as_float(__builtin_amdgcn_readlane(__float_as_int(gs[tok][1]), 4 * (bb) + k2)); \
            const f16x2 a0_ = (f16x2){h0_, h0_}, a1_ = (f16x2){h1_, h1_}; \
            BF8ACC(tok, a0_, buf[2 * k2].x, 0) BF8ACC(tok, a0_, buf[2 * k2].y, 1) BF8ACC(tok, a0_, buf[2 * k2].z, 2) BF8ACC(tok, a0_, buf[2 * k2].w, 3) \
            BF8ACC(tok, a1_, buf[2 * k2 + 1].x, 0) BF8ACC(tok, a1_, buf[2 * k2 + 1].y, 1) BF8ACC(tok, a1_, buf[2 * k2 + 1].z, 2) BF8ACC(tok, a1_, buf[2 * k2 + 1].w, 3) __builtin_amdgcn_sched_barrier(0); } } while (0)
        int cur[TPW];
#pragma unroll
        for (int tt = 0; tt < TPW; ++tt) cur[tt] = 0;
#define P8_STEP_B(tt_, bufX, bufY, r_) { const int end_ = __builtin_amdgcn_readlane(offv[tt_], (r_) + 1); \
            { constexpr int tn_ = ((tt_) + 1) % TPW; const int rn_ = (r_) + ((tt_) + 1) / TPW; \
              if (rn_ < NPART && cur[tn_] < __builtin_amdgcn_readlane(offv[tn_], rn_ + 1)) P8_ISSUE(bufY, vt, tn_, cur[tn_] >> 3); } \
            __builtin_amdgcn_sched_barrier(0); \
            bool pre_ = true; \
            while (cur[tt_] < end_) { if (!pre_) P8_ISSUE(bufX, vt, tt_, cur[tt_] >> 3); pre_ = false; P8_ACC(bufX, tt_, cur[tt_] >> 3); cur[tt_] += 8; } }
        if ((skip & 2) == 0) {
        if (0 < __builtin_amdgcn_readlane(offv[0], 1)) P8_ISSUE(bufA, vt, 0, 0);
#pragma unroll 1
        for (int r = 0; r < NPART; ++r) {
            P8_STEP_B(0, bufA, bufB, r) P8_STEP_B(1, bufB, bufA, r) P8_STEP_B(2, bufA, bufB, r) P8_STEP_B(3, bufB, bufA, r)
            P8_STEP_B(4, bufA, bufB, r) P8_STEP_B(5, bufB, bufA, r) P8_STEP_B(6, bufA, bufB, r) P8_STEP_B(7, bufB, bufA, r)
        } }
#undef P8_STEP_B
#undef P8_ACC
#undef BF8ACC
    }
#undef P8_ISSUE
    u32x2 xw[TPW][4]; f32x4 g2v[4], lgv[4], lbv[4];
#pragma unroll
    for (int tt = 0; tt < TPW; ++tt)
#pragma unroll
        for (int j = 0; j < 4; ++j) xw[tt][j] = *(const u32x2*)(x1 + (size_t)(t0 + tt) * DM + 256 * j + 4 * lane);
#pragma unroll
    for (int j = 0; j < 4; ++j) { const int d = 256 * j + 4 * lane; g2v[j] = *(const f32x4*)(mod + b * 6144 + 5120 + d) + 1.0f; lgv[j] = *(const f32x4*)(F.ln2_g + d); lbv[j] = *(const f32x4*)(F.ln2_b + d); }
#pragma unroll
    for (int tt = 0; tt < TPW; ++tt) { const size_t t = (size_t)(t0 + tt);
        f32x4 v[4]; float s = 0.f;
#pragma unroll
        for (int j = 0; j < 4; ++j) { const u32x2 xv = xw[tt][j];
            const f32x4 xf = (f32x4){bf_lo(xv.x), bf_hi(xv.x), bf_lo(xv.y), bf_hi(xv.y)}; const f32x4 yy = (f32x4){(float)yh[tt][2 * j].x, (float)yh[tt][2 * j + 1].x, (float)yh[tt][2 * j].y, (float)yh[tt][2 * j + 1].y};
            v[j] = xf * DN_ALPHA + g2v[j] * yy; s += (v[j][0] + v[j][1]) + (v[j][2] + v[j][3]); }
        const float mean = wave_sum(s) * (1.f / DM); float qq = 0.f;
#pragma unroll
        for (int j = 0; j < 4; ++j) { v[j] = v[j] - mean; qq += (v[j][0] * v[j][0] + v[j][1] * v[j][1]) + (v[j][2] * v[j][2] + v[j][3] * v[j][3]); }
        const float rstd = 1.0f / sqrtf(wave_sum(qq) * (1.f / DM) + LN_EPS);
#pragma unroll
        for (int j = 0; j < 4; ++j) { const int d = 256 * j + 4 * lane;
            *(f32x4*)(F.out + t * DM + d) = v[j] * rstd * lgv[j] + lbv[j]; } }
    }
}
#ifndef PROBE_PARTS
#define PROBE_PARTS 0xff
#endif
#ifndef MK_N_LAUNCHES
#define MK_N_LAUNCHES 1
#endif
constexpr int N_PHASES = 9;
struct Args { const float* in[18]; float* out; unsigned char* ws; int ph_lo, ph_hi, p0_parts, pad; };
__global__ void __launch_bounds__(NTHREADS, 2) fwd_kernel(Args args) {
    extern __shared__ __attribute__((aligned(16))) unsigned char lds[];
    Frame F;
    F.lds = (LAS unsigned char*)lds;
    F.tid = threadIdx.x; F.lane = F.tid & 63; F.wave = __builtin_amdgcn_readfirstlane(F.tid >> 6);
    F.G = gridDim.x; { const int bx = blockIdx.x; F.vcu = (F.G % 8 == 0) ? (bx % 8) * (F.G / 8) + bx / 8 : bx; }
    F.x = args.in[0]; F.c = args.in[1]; F.w_ada = args.in[2]; F.b_ada = args.in[3]; F.w_in = args.in[4]; F.sinks = args.in[5]; F.w_pool = args.in[6]; F.pool_scale = args.in[7];
    F.w_out = args.in[8]; F.ln1_g = args.in[9]; F.ln1_b = args.in[10]; F.w_pq = args.in[11]; F.k1 = args.in[12]; F.k2 = args.in[13]; F.pu = args.in[14]; F.pv = args.in[15];
    F.ln2_g = args.in[16]; F.ln2_b = args.in[17]; F.out = args.out; F.ws = args.ws;
    volatile LAS unsigned* MISC = (volatile LAS unsigned*)(F.lds + MISC_OFF);
    for (int u = F.tid; u < (LDS_BYTES - LDSCTL_OFF) / 4; u += NTHREADS) ((LAS unsigned*)(F.lds + LDSCTL_OFF))[u] = 0u;
    __syncthreads();
    const int lo = args.ph_lo, hi = args.ph_hi;
    XcdBarrier bar; bar.bar = (unsigned*)(F.ws + WS_CTL) + CW_BAR; bar.x = 0; bar.st = nullptr;
    if (hi - lo > 1) bar = xcd_barrier_post((unsigned*)(F.ws + WS_CTL) + CW_BAR, MISC + 8);
#ifndef PH_MASK
#define PH_MASK 0x1ff
#endif
#define IN(k) (((PH_MASK >> (k)) & 1) && lo <= (k) && (k) < hi)
#define SEAM(k) do { if (IN(k) && IN((k) + 1)) xcd_barrier(bar); } while (0)
#ifndef REP_MASK
#define REP_MASK 0
#endif
#ifndef REP_CNT
#define REP_CNT 4
#endif
#define REPS(k) (((REP_MASK >> (k)) & 1) * REP_CNT)
#define PHASE_NS(k, ...) if (IN(k)) { _Pragma("unroll 1") for (int _r = 0; _r <= REPS(k); ++_r) { __VA_ARGS__; if (_r < REPS(k)) xcd_barrier(bar); } }
#define PHASE(k, ...) if (IN(k)) { _Pragma("unroll 1") for (int _r = 0; _r <= REPS(k); ++_r) { __VA_ARGS__; if (_r < REPS(k)) xcd_barrier(bar); } } SEAM(k)
#ifndef P0_SUB
#define P0_SUB 0xff
#endif
    PHASE(0, p0_prologue(F, args.p0_parts));
    PHASE(2, { pg8::Gemm g{(const pg8::bf16_t*)(F.ws + WS_XN8), (const pg8::bf16_t*)(F.ws + WS_WIN), TT, NIN, DM / 2, 32, (size_t)NIN * DM, 0x79797979, 0x7F7F7F7F};    pg8::StaticOrder S; S.init(TT, NIN, F.G, (int)blockIdx.x);
            pg8::EpiRope E{(pg8::bf16_t*)(F.ws + WS_PROJ), NIN, (const float*)(F.ws + WS_ROPE), QSCALE, (const float*)(F.ws + WS_BIAS)};
            pg8::gemm_phase<pg8::EpiRope, pg8::StaticOrder, true, true, true>(F.lds, g, S, E);
            if ((args.p0_parts & 0x80) && (int)blockIdx.x >= 320 - F.G) p2_tables(F, ((int)blockIdx.x - (320 - F.G)) * NWAVES + F.wave, (2 * F.G - 320) * NWAVES, 0, 2 * NEXP); });
    PHASE(3, { for (int u = F.vcu; u < 256; u += F.G) p3_attn_unit(F, u);
               for (int u = F.vcu; u < 256; u += F.G) p3_pool_unit(F, u); });
    PHASE(4, { pg8::Gemm g{(const pg8::bf16_t*)(F.ws + WS_A2), (const pg8::bf16_t*)(F.ws + WS_WOUT), TT, DM, DM / 2, 1 << 30, 0, 0x79797979, 0x7B7B7B7B}; pg8::StaticOrder S; S.init(TT, DM, F.G, (int)blockIdx.x);
            pg8::EpiPlain E{(pg8::bf16_t*)(F.ws + WS_MIX), DM};
            pg8::gemm_phase<pg8::EpiPlain, pg8::StaticOrder, true, true, true>(F.lds, g, S, E); });
    PHASE(5, p5_ln1(F));
    PHASE_NS(6, { pg8::Gemm g{(const pg8::bf16_t*)(F.ws + WS_H2), (const pg8::bf16_t*)(F.ws + WS_WPQ), TT, NQD, DM, 1 << 30, 0, 0, 0}; pg8::StaticOrder S; S.init(TT, NQD, F.G, (int)blockIdx.x);
            pg8::EpiPlain E{(pg8::bf16_t*)(F.ws + WS_Q), NQD};
            pg8::gemm_phase<pg8::EpiPlain, pg8::StaticOrder, true, true>(F.lds, g, S, E); });
    if (IN(6) && IN(7)) { asm volatile("s_waitcnt vmcnt(0)" ::: "memory"); __syncthreads(); }
    PHASE(7, p7_route(F));
#ifndef P8_FAKE
#define P8_FAKE 0xffffu
#endif
#ifndef P8_SKIP
#define P8_SKIP 0
#endif
    PHASE(8, p8_peer(F, _r == REPS(8) ? 0xffffu : P8_FAKE, _r == REPS(8) ? 0 : P8_SKIP));
#undef IN
#undef SEAM
}

extern "C" void kernel_launch(void* const* d_in, const int* in_sizes, int n_in, void* d_out, int out_size, void* d_ws, size_t ws_size, hipStream_t stream) {
    static int grid = 0;
    if (grid == 0) {
        if (n_in != 18 || out_size != TT * DM || ws_size < WS_END) { fprintf(stderr, "kernel_launch: unexpected shapes (n_in %d out %d ws %zu)\n", n_in, out_size, ws_size); grid = -1; return; }
        int dev = 0, cus = 0, per_cu = 0;
        if (hipGetDevice(&dev) != hipSuccess || hipDeviceGetAttribute(&cus, hipDeviceAttributeMultiprocessorCount, dev) != hipSuccess) { grid = -1; return; }
        if (hipFuncSetAttribute((const void*)fwd_kernel, hipFuncAttributeMaxDynamicSharedMemorySize, LDS_BYTES) != hipSuccess) { fprintf(stderr, "kernel_launch: hipFuncSetAttribute failed\n"); grid = -1; return; }
        if (hipOccupancyMaxActiveBlocksPerMultiprocessor(&per_cu, (const void*)fwd_kernel, NTHREADS, LDS_BYTES) != hipSuccess || per_cu < 1) { fprintf(stderr, "kernel_launch: occupancy query says %d blocks per CU\n", per_cu); }
        (void)hipGetLastError();
        grid = cus;
        if (grid != 256) fprintf(stderr, "kernel_launch: built for 256 CUs, got %d\n", grid);
    }
    if (grid < 0) return;
    (void)hipMemsetAsync((char*)d_ws + WS_CTL, 0, CTL_ZERO_BYTES, stream);
    Args a{};
    for (int i = 0; i < 18; ++i) a.in[i] = (const float*)d_in[i];
    a.out = (float*)d_out; a.ws = (unsigned char*)d_ws; a.p0_parts = 0xff;
#if MK_N_LAUNCHES == 1
    a.ph_lo = 0; a.ph_hi = N_PHASES;
    hipLaunchKernelGGL(fwd_kernel, dim3(grid), dim3(NTHREADS), LDS_BYTES, stream, a);
#ifdef PROBE_PHASE
    for (int i = 0; i < PROBE_N; ++i) { a.ph_lo = PROBE_PHASE; a.ph_hi = PROBE_PHASE + 1; a.p0_parts = PROBE_PARTS; hipLaunchKernelGGL(fwd_kernel, dim3(grid), dim3(NTHREADS), LDS_BYTES, stream, a); }
#endif
#else
    for (int p = 0; p < N_PHASES; ++p) { a.ph_lo = p; a.ph_hi = p + 1; hipLaunchKernelGGL(fwd_kernel, dim3(grid), dim3(NTHREADS), LDS_BYTES, stream, a); }
#endif
}
```

```cpp
#include <hip/hip_runtime.h>
#include <cstdio>
#include <cstdint>
#include <cmath>
namespace pg8 {
#define PG8_LAS __attribute__((address_space(3)))
typedef unsigned short bf16_t;
typedef short bf16x8 __attribute__((ext_vector_type(8)));
typedef float f32x4 __attribute__((ext_vector_type(4)));
typedef unsigned u32x4 __attribute__((ext_vector_type(4)));
constexpr int BM = 256, BK = 64, HALF = 128, HTB = HALF * BK * 2  , STAGE_BYTES = 8 * HTB, NXCD = 8, WGM = 8;

__host__ __device__ __forceinline__ int lds_byte(int r, int c) { const int st = (r >> 4) * 2 + (c >> 5), rr = r & 15, cc = c & 31, ob = rr * 64 + cc * 2; return st * 1024 + (ob ^ (((ob >> 9) & 1) << 5)); }
__host__ __device__ __forceinline__ void stage_rc(int b, int& R, int& C) { const int st = b / 1024, sb = b % 1024, swz = sb ^ (((sb >> 9) & 1) << 5); R = (st >> 1) * 16 + swz / 64; C = (st & 1) * 32 + (swz % 64) / 2; }
__host__ __device__ __forceinline__ int perm32(int rho) { const int n = rho >> 4, i = rho & 15; return 8 * (i >> 2) + 4 * n + (i & 3); }

struct Unit { int pm, pn; };
struct Gemm { const bf16_t* A; const bf16_t* Bt; int M, N, K; int bsplit; size_t bstride; int sc_w, sc_x; };

struct StaticOrder {
    int nM, nN, nwg, G, c;
    __host__ __device__ void init(int M, int N, int G_, int c_) { nM = M / BM; nN = N / BM; nwg = nM * nN; G = G_; c = c_; }
    __host__ __device__ bool next(int i, Unit& u) const {
        const long L = (long)i * G + c; if (L >= nwg) return false;
        int wgid = (int)L; { const int q = nwg / NXCD, r = nwg % NXCD, xcd = wgid % NXCD, off = wgid / NXCD; wgid = (xcd < r ? xcd * (q + 1) : r * (q + 1) + (xcd - r) * q) + off; }
        const int nig = WGM * nN, gid = wgid / nig, fm = gid * WGM, gsz = (nM - fm) < WGM ? (nM - fm) : WGM;
        u.pm = fm + ((wgid % nig) % gsz); u.pn = (wgid % nig) / gsz; return true;
    }
    __device__ __forceinline__ void a_ready(const Unit&) const {}
    __device__ __forceinline__ void done(const Unit&) const {}
};

__device__ __forceinline__ unsigned cvt_pk_bf16(float lo, float hi) { unsigned r; asm volatile("v_cvt_pk_bf16_f32 %0, %1, %2" : "=v"(r) : "v"(lo), "v"(hi)); return r; }

struct EpiPlain {
    static constexpr bool PERM = true, AFTER_DRAIN = false;
    bf16_t* O; int ldc;
    __device__ __forceinline__ void operator()(const f32x4 (&acc)[2][2][4][2], const Unit& u, int wr, int wc, int fr, int fq) const {
        const int row0 = u.pm * BM + wr * 64 + fr; const int col0 = u.pn * BM + wc * 32 + 8 * fq;
#pragma unroll
        for (int ai = 0; ai < 2; ++ai)
#pragma unroll
            for (int m = 0; m < 4; ++m) { bf16_t* rowp = O + (size_t)(row0 + ai * HALF + m * 16) * ldc + col0;
#pragma unroll
                for (int bj = 0; bj < 2; ++bj) { const f32x4 v0 = acc[ai][bj][m][0], v1 = acc[ai][bj][m][1];
                    u32x4 w; w.x = cvt_pk_bf16(v0[0], v0[1]); w.y = cvt_pk_bf16(v0[2], v0[3]); w.z = cvt_pk_bf16(v1[0], v1[1]); w.w = cvt_pk_bf16(v1[2], v1[3]);
                    *(u32x4*)(rowp + bj * HALF) = w; } }
    }
};
struct EpiRope {
    static constexpr bool PERM = true, AFTER_DRAIN = false;
    bf16_t* O; int ldc; const float* rope; float qscale; const float* bias;
    __device__ __forceinline__ void operator()(const f32x4 (&acc)[2][2][4][2], const Unit& u, int wr, int wc, int fr, int fq) const {
        const int row0 = u.pm * BM + wr * 64 + fr; const int col0 = u.pn * BM + wc * 32 + 8 * fq;
#pragma unroll
        for (int ai = 0; ai < 2; ++ai)
#pragma unroll
            for (int m = 0; m < 4; ++m) { const int row = row0 + ai * HALF + m * 16; bf16_t* rowp = O + (size_t)row * ldc + col0; const int pos = row & 8191;
#pragma unroll
                for (int bj = 0; bj < 2; ++bj) { const float* bp = bias + (size_t)(row >> 13) * ldc + col0 + bj * HALF;
                    f32x4 v0 = acc[ai][bj][m][0] + *(const f32x4*)bp, v1 = acc[ai][bj][m][1] + *(const f32x4*)(bp + 4);
                    const int colt = u.pn * BM + bj * HALF;
                    if (colt < 640) {
                        const int c = col0 + bj * HALF, ib = (c & 63) >> 1;
                        const f32x4 cs0 = *(const f32x4*)(rope + ((size_t)pos * 32 + ib) * 2), cs1 = *(const f32x4*)(rope + ((size_t)pos * 32 + ib) * 2 + 4);
                        const float sc = colt < 512 ? qscale : 1.0f;
                        f32x4 r0, r1;
                        r0[0] = (v0[0] * cs0[0] - v0[1] * cs0[1]) * sc; r0[1] = (v0[1] * cs0[0] + v0[0] * cs0[1]) * sc;
                        r0[2] = (v0[2] * cs0[2] - v0[3] * cs0[3]) * sc; r0[3] = (v0[3] * cs0[2] + v0[2] * cs0[3]) * sc;
                        r1[0] = (v1[0] * cs1[0] - v1[1] * cs1[1]) * sc; r1[1] = (v1[1] * cs1[0] + v1[0] * cs1[1]) * sc;
                        r1[2] = (v1[2] * cs1[2] - v1[3] * cs1[3]) * sc; r1[3] = (v1[3] * cs1[2] + v1[2] * cs1[3]) * sc;
                        v0 = r0; v1 = r1;
                    }
                    u32x4 w; w.x = cvt_pk_bf16(v0[0], v0[1]); w.y = cvt_pk_bf16(v0[2], v0[3]); w.z = cvt_pk_bf16(v1[0], v1[1]); w.w = cvt_pk_bf16(v1[2], v1[3]);
                    *(u32x4*)(rowp + bj * HALF) = w; } }
    }
};

template <class Epi, class Sched, bool ALIGN_EPI = false, bool SP2 = false, bool FP8 = false>
__device__ __forceinline__ void gemm_phase(PG8_LAS unsigned char* lds, const Gemm g, const Sched& S, const Epi& E) {
    typedef int pg8_i32x4 __attribute__((ext_vector_type(4))); typedef int pg8_frag __attribute__((ext_vector_type(8)));
    const int tid = threadIdx.x, wid = __builtin_amdgcn_readfirstlane(tid >> 6), lane = tid & 63, wr = wid >> 2, wc = wid & 3, fr = lane & 15, fq = lane >> 4;
    const int K = g.K, nt = K / BK;
    unsigned voffA[2], voffB[2];
#pragma unroll
    for (int i = 0; i < 2; ++i) { int R, C; stage_rc(tid * 16 + i * 8192, R, C); const int Rb = Epi::PERM ? ((R & ~31) + perm32(R & 31)) : R;
        voffA[i] = (unsigned)(R * K + C) * 2u; voffB[i] = (unsigned)(Rb * K + C) * 2u; }
    const size_t kstep = (size_t)(BK * 2);
    const size_t hstep = (size_t)HALF * K * 2;
    const size_t tstep = 2 * hstep;
    const unsigned ldsw = (unsigned)wid * 1024u;
    const int aoff = lds_byte(wr * 64 + fr, fq * 8), boff = lds_byte(wc * 32 + fr, fq * 8);
#define PG8_SA(b, h) (((b) * 2 + (h)) * HTB)
#define PG8_SB(b, h) ((4 + (b) * 2 + (h)) * HTB)
#define PG8_STAGE(bufoff, gbase, voff) do { _Pragma("unroll") for (int _i = 0; _i < 2; ++_i) \
        __builtin_amdgcn_global_load_lds((const unsigned*)((const char*)(gbase) + (voff)[_i]), (PG8_LAS unsigned*)(lds + (bufoff) + ldsw + _i * 8192), 16, 0, 0); } while (0)
#define PG8_LDA(dst, b, h) do { _Pragma("unroll") for (int m = 0; m < 4; ++m) { const pg8_i32x4 l0_ = *(const PG8_LAS pg8_i32x4*)(lds + PG8_SA(b, h) + aoff + m * 2048), l1_ = *(const PG8_LAS pg8_i32x4*)(lds + PG8_SA(b, h) + aoff + m * 2048 + 1024); dst[m] = __builtin_shufflevector(l0_, l1_, 0, 1, 2, 3, 4, 5, 6, 7); } } while (0)
#define PG8_LDB(dst, b, h) do { _Pragma("unroll") for (int n = 0; n < 2; ++n) { const pg8_i32x4 l0_ = *(const PG8_LAS pg8_i32x4*)(lds + PG8_SB(b, h) + boff + n * 2048), l1_ = *(const PG8_LAS pg8_i32x4*)(lds + PG8_SB(b, h) + boff + n * 2048 + 1024); dst[n] = __builtin_shufflevector(l0_, l1_, 0, 1, 2, 3, 4, 5, 6, 7); } } while (0)
#define PG8_H0(f) __builtin_bit_cast(bf16x8, __builtin_shufflevector((f), (f), 0, 1, 2, 3))
#define PG8_H1(f) __builtin_bit_cast(bf16x8, __builtin_shufflevector((f), (f), 4, 5, 6, 7))
#define PG8_MMA(ai, bj, At, Bt) do { __builtin_amdgcn_s_setprio(1); \
        if constexpr (FP8) { _Pragma("unroll") for (int m = 0; m < 4; ++m) _Pragma("unroll") for (int n = 0; n < 2; ++n) \
            asm volatile("v_mfma_scale_f32_16x16x128_f8f6f4 %0, %1, %2, %0, %3, %4 op_sel_hi:[0,0,0]" : "+v"(acc[ai][bj][m][n]) : "v"(Bt[n]), "v"(At[m]), "v"(scw_), "v"(scx_)); } \
        else { _Pragma("unroll") for (int m = 0; m < 4; ++m) _Pragma("unroll") for (int n = 0; n < 2; ++n) { \
            acc[ai][bj][m][n] = __builtin_amdgcn_mfma_f32_16x16x32_bf16(PG8_H0(Bt[n]), PG8_H0(At[m]), acc[ai][bj][m][n], 0, 0, 0); \
            acc[ai][bj][m][n] = __builtin_amdgcn_mfma_f32_16x16x32_bf16(PG8_H1(Bt[n]), PG8_H1(At[m]), acc[ai][bj][m][n], 0, 0, 0); } } \
        __builtin_amdgcn_s_setprio(0); } while (0)
#define PG8_WAIT_V(n) asm volatile("s_waitcnt vmcnt(" #n ")" ::: "memory")
#define PG8_WAIT_L(n) asm volatile("s_waitcnt lgkmcnt(" #n ")" ::: "memory")
#define PG8_BAR __builtin_amdgcn_s_barrier()
#define PG8_SCHED __builtin_amdgcn_sched_barrier(0)
    Unit cur, nxt; int ui = 0;
    if (!S.next(0, cur)) return;
    f32x4 acc[2][2][4][2];
#pragma unroll
    for (int a = 0; a < 2; ++a)
#pragma unroll
        for (int b = 0; b < 2; ++b)
#pragma unroll
            for (int m = 0; m < 4; ++m)
#pragma unroll
                for (int n = 0; n < 2; ++n) acc[a][b][m][n] = (f32x4){0.f, 0.f, 0.f, 0.f};
    pg8_frag At[4], B0[2], B1[2]; const int scw_ = g.sc_w, scx_ = g.sc_x;
    const char* cA = (const char*)g.A + (size_t)cur.pm * tstep; const char* cB = (const char*)g.Bt + (size_t)cur.pn * tstep + (cur.pm >= g.bsplit ? g.bstride : (size_t)0);
    S.a_ready(cur);
    if constexpr (SP2) {
        PG8_STAGE(PG8_SB(0, 0), cB, voffB); PG8_STAGE(PG8_SB(0, 1), cB + hstep, voffB); PG8_STAGE(PG8_SA(0, 0), cA, voffA); PG8_STAGE(PG8_SA(0, 1), cA + hstep, voffA);
        if (wr == 1) PG8_BAR;
        PG8_WAIT_V(2); PG8_BAR;
        PG8_STAGE(PG8_SB(1, 0), cB + kstep, voffB); PG8_STAGE(PG8_SA(1, 0), cA + kstep, voffA); PG8_STAGE(PG8_SB(1, 1), cB + hstep + kstep, voffB);
        PG8_WAIT_V(6); PG8_BAR;
    } else {
        PG8_STAGE(PG8_SB(0, 0), cB, voffB); PG8_STAGE(PG8_SA(0, 0), cA, voffA); PG8_STAGE(PG8_SB(0, 1), cB + hstep, voffB); PG8_STAGE(PG8_SA(0, 1), cA + hstep, voffA);
        if (wr == 1) PG8_BAR;
        PG8_WAIT_V(4); PG8_BAR;
        PG8_STAGE(PG8_SB(1, 0), cB + kstep, voffB); PG8_STAGE(PG8_SA(1, 0), cA + kstep, voffA); PG8_STAGE(PG8_SB(1, 1), cB + hstep + kstep, voffB);
        PG8_WAIT_V(6); PG8_BAR;
    }
    for (;;) {
        const bool has_next = S.next(ui + 1, nxt);
        const char* nA = has_next ? (const char*)g.A + (size_t)nxt.pm * tstep : cA; const char* nB = has_next ? (const char*)g.Bt + (size_t)nxt.pn * tstep + (nxt.pm >= g.bsplit ? g.bstride : (size_t)0) : cB;
        _Pragma("unroll 1") for (int t = 0; t < nt; t += 2) {
            const bool last = (t == nt - 2);
            const char* a1 = cA + (size_t)(t + 1) * kstep;
            const char* a2 = last ? nA : cA + (size_t)(t + 2) * kstep; const char* b2 = last ? nB : cB + (size_t)(t + 2) * kstep;
            const char* a3 = a2 + kstep; const char* b3 = b2 + kstep;
            if (last && has_next) S.a_ready(nxt);
            if constexpr (SP2) {
            PG8_LDB(B0, 0, 0); PG8_LDB(B1, 0, 1); PG8_SCHED; PG8_LDA(At, 0, 0); PG8_STAGE(PG8_SA(1, 1), a1 + hstep, voffA);
            PG8_WAIT_V(8); PG8_WAIT_L(0); PG8_BAR; PG8_MMA(0, 0, At, B0); PG8_MMA(0, 1, At, B1); PG8_BAR; PG8_SCHED;
            PG8_LDA(At, 0, 1); PG8_STAGE(PG8_SB(0, 0), b2, voffB); PG8_STAGE(PG8_SB(0, 1), b2 + hstep, voffB); PG8_STAGE(PG8_SA(0, 0), a2, voffA);
            PG8_WAIT_V(8); PG8_WAIT_L(0); PG8_BAR; PG8_MMA(1, 0, At, B0); PG8_MMA(1, 1, At, B1); PG8_BAR; PG8_SCHED;
            PG8_LDB(B0, 1, 0); PG8_LDB(B1, 1, 1); PG8_SCHED; PG8_LDA(At, 1, 0); PG8_STAGE(PG8_SA(0, 1), a2 + hstep, voffA);
            PG8_WAIT_V(8); PG8_WAIT_L(0); PG8_BAR; PG8_MMA(0, 0, At, B0); PG8_MMA(0, 1, At, B1); PG8_BAR; PG8_SCHED;
            PG8_LDA(At, 1, 1); PG8_STAGE(PG8_SB(1, 0), b3, voffB); PG8_STAGE(PG8_SB(1, 1), b3 + hstep, voffB); PG8_STAGE(PG8_SA(1, 0), a3, voffA);
            PG8_WAIT_V(8); PG8_WAIT_L(0); PG8_BAR; PG8_MMA(1, 0, At, B0); PG8_MMA(1, 1, At, B1); PG8_BAR; PG8_SCHED;
            } else {
            PG8_LDB(B0, 0, 0); PG8_SCHED; PG8_LDA(At, 0, 0); PG8_STAGE(PG8_SA(1, 1), a1 + hstep, voffA);
            PG8_WAIT_L(8); PG8_BAR; PG8_WAIT_L(0); PG8_MMA(0, 0, At, B0); PG8_BAR; PG8_SCHED;
            PG8_LDB(B1, 0, 1); PG8_STAGE(PG8_SB(0, 0), b2, voffB);
            PG8_BAR; PG8_WAIT_L(0); PG8_MMA(0, 1, At, B1); PG8_BAR;
            PG8_LDA(At, 0, 1); PG8_STAGE(PG8_SA(0, 0), a2, voffA);
            PG8_BAR; PG8_WAIT_L(0); PG8_MMA(1, 0, At, B0); PG8_BAR; PG8_SCHED;
            PG8_STAGE(PG8_SB(0, 1), b2 + hstep, voffB);
            PG8_WAIT_V(6); PG8_BAR; PG8_MMA(1, 1, At, B1); PG8_BAR;
            PG8_LDB(B0, 1, 0); PG8_SCHED; PG8_LDA(At, 1, 0); PG8_STAGE(PG8_SA(0, 1), a2 + hstep, voffA);
            PG8_WAIT_L(8); PG8_BAR; PG8_WAIT_L(0); PG8_MMA(0, 0, At, B0); PG8_BAR; PG8_SCHED;
            PG8_LDB(B1, 1, 1); PG8_STAGE(PG8_SB(1, 0), b3, voffB);
            PG8_BAR; PG8_WAIT_L(0); PG8_MMA(0, 1, At, B1); PG8_BAR;
            PG8_LDA(At, 1, 1); PG8_STAGE(PG8_SA(1, 0), a3, voffA);
            PG8_BAR; PG8_WAIT_L(0); PG8_MMA(1, 0, At, B0); PG8_BAR; PG8_SCHED;
            PG8_STAGE(PG8_SB(1, 1), b3 + hstep, voffB);
            PG8_WAIT_V(6); PG8_BAR; PG8_MMA(1, 1, At, B1); PG8_BAR;
            }
        }
        if constexpr (ALIGN_EPI) { if (wr == 0) PG8_BAR; }
        if constexpr (FP8) {
            asm volatile("s_nop 15\n\ts_nop 15" ::: "memory");
#pragma unroll
            for (int a = 0; a < 2; ++a)
#pragma unroll
                for (int b = 0; b < 2; ++b)
#pragma unroll
                    for (int m = 0; m < 4; ++m)
#pragma unroll
                        for (int n = 0; n < 2; ++n) asm volatile("" : "+v"(acc[a][b][m][n]));
        }
        if constexpr (!Epi::AFTER_DRAIN) { E(acc, cur, wr, wc, fr, fq); S.done(cur); }
        if (!has_next) break;
#pragma unroll
        for (int a = 0; a < 2; ++a)
#pragma unroll
            for (int b = 0; b < 2; ++b)
#pragma unroll
                for (int m = 0; m < 4; ++m)
#pragma unroll
                    for (int n = 0; n < 2; ++n) acc[a][b][m][n] = (f32x4){0.f, 0.f, 0.f, 0.f};
        cur = nxt; cA = nA; cB = nB; ++ui;
        if constexpr (ALIGN_EPI) { if (wr == 1) PG8_BAR; }
    }
    PG8_WAIT_V(0);
    if constexpr (!ALIGN_EPI) { if (wr == 0) PG8_BAR; }
    PG8_BAR;
    if constexpr (Epi::AFTER_DRAIN) { E.fused(acc, cur, wr, wc, fr, fq, lds, wid, lane); S.done(cur); }
#undef PG8_SA
#undef PG8_SB
#undef PG8_STAGE
#undef PG8_LDA
#undef PG8_LDB
#undef PG8_MMA
#undef PG8_H0
#undef PG8_H1
#undef PG8_WAIT_V
#undef PG8_WAIT_L
#undef PG8_BAR
#undef PG8_SCHED
}
}
#define GAS __attribute__((address_space(1)))
#define LAS __attribute__((address_space(3)))
typedef unsigned short bf16;
typedef unsigned v4u __attribute__((ext_vector_type(4)));
typedef float f32x4 __attribute__((ext_vector_type(4)));
typedef short bf16x8 __attribute__((ext_vector_type(8)));
typedef GAS unsigned gu32;
typedef GAS unsigned long long gu64;
#define RLX_AGENT __ATOMIC_RELAXED, __HIP_MEMORY_SCOPE_AGENT
#define LDS_WAIT() asm volatile("s_waitcnt lgkmcnt(0)" ::: "memory")
#define VM_WAIT() asm volatile("s_waitcnt vmcnt(0)" ::: "memory")
__device__ __forceinline__ unsigned long long rt() { return __builtin_amdgcn_s_memrealtime(); }
__device__ __forceinline__ unsigned f2bf(float f) { unsigned u = __builtin_bit_cast(unsigned, f); return (u + 0x7fffu + ((u >> 16) & 1u)) >> 16; }
__device__ __forceinline__ unsigned pk2(float lo, float hi) { return f2bf(lo) | (f2bf(hi) << 16); }
#define XB_TMO      128
#define XB_XCNT(j)  (256  + 64 * (j))
#define XB_XSUB(j)  (1280 + 64 * (j))
#define XB_XGEN(j)  (2304 + 64 * (j))
#define XB_TOP      3328
#define XB_TOPGEN   3392
#define XCD_BAR_WORDS 3456
#define XB_SPIN_CAP (1u << 18)

__device__ __forceinline__ unsigned xb_ld(unsigned* p)              { return __hip_atomic_load(p, __ATOMIC_RELAXED, __HIP_MEMORY_SCOPE_AGENT); }
__device__ __forceinline__ unsigned xb_add(unsigned* p, unsigned v) { return __hip_atomic_fetch_add(p, v, __ATOMIC_RELAXED, __HIP_MEMORY_SCOPE_AGENT); }
__device__ __forceinline__ unsigned xb_xcc_id() { return (unsigned)__builtin_amdgcn_s_getreg((3 << 11) | 20) & 0xFu; }
#define XB_SPIN(cond, bar) do { unsigned _sp = 0; while (cond) { __builtin_amdgcn_s_sleep(1); \
    if ((++_sp & 255u) == 0u) { if (xb_ld(&(bar)[XB_TMO])) break; if (_sp > XB_SPIN_CAP) { atomicAdd(&(bar)[XB_TMO], 1u); break; } } } } while (0)

struct XcdBarrier {
    unsigned* bar; unsigned x;
    volatile LAS unsigned* st;
};

__device__ __forceinline__ XcdBarrier xcd_barrier_post(unsigned* bar, volatile LAS unsigned* st) {
    XcdBarrier b; b.bar = bar; b.x = xb_xcc_id(); b.st = st;
    if (threadIdx.x == 0) (void)xb_add(&bar[XB_XCNT(b.x)], 1u);
    return b;
}
__device__ __forceinline__ void xcd_barrier_complete(unsigned* bar, unsigned x, unsigned& nloc, unsigned& nx) {
    const unsigned G = gridDim.x * gridDim.y * gridDim.z;
    unsigned sum, cnt, mine, sp = 0u;
    for (;;) {
        sum = 0u; cnt = 0u; mine = 0u;
#pragma unroll
        for (unsigned j = 0; j < 16; ++j) { const unsigned c = xb_ld(&bar[XB_XCNT(j)]); sum += c; cnt += (c > 0u) ? 1u : 0u; mine = (j == x) ? c : mine; }
        if (sum == G) break;
        __builtin_amdgcn_s_sleep(1);
        if ((++sp & 255u) == 0u) { if (xb_ld(&bar[XB_TMO])) break; if (sp > XB_SPIN_CAP) { atomicAdd(&bar[XB_TMO], 1u); break; } }
    }
    nloc = mine > 0u ? mine : 1u; nx = cnt > 0u ? cnt : 1u;
}

__device__ __forceinline__ void xcd_barrier(const XcdBarrier& b) {
    asm volatile("s_waitcnt vmcnt(0)" ::: "memory");
    __syncthreads();
    if (threadIdx.x == 0) {
        unsigned* bar = b.bar;
        __builtin_amdgcn_s_waitcnt(0);
        unsigned nloc = b.st[0], nx = b.st[1];
        if (nloc == 0u) { xcd_barrier_complete(bar, b.x, nloc, nx); b.st[0] = nloc; b.st[1] = nx; }
        const unsigned old = xb_add(&bar[XB_XSUB(b.x)], 1u);
        const unsigned gen = old / nloc;
        if (old + 1u == (gen + 1u) * nloc) {
            __builtin_amdgcn_fence(__ATOMIC_RELEASE, "agent");
            asm volatile("s_waitcnt vmcnt(0)" ::: "memory");
            const unsigned og = xb_add(&bar[XB_TOP], 1u);
            const unsigned tg = og / nx;
            if (og + 1u == (tg + 1u) * nx) xb_add(&bar[XB_TOPGEN], 1u);
            else XB_SPIN(xb_ld(&bar[XB_TOPGEN]) == tg, bar);
            __builtin_amdgcn_fence(__ATOMIC_ACQUIRE, "agent");
            xb_add(&bar[XB_XGEN(b.x)], 1u);
            asm volatile("s_waitcnt vmcnt(0)" ::: "memory");
        } else {
            XB_SPIN(xb_ld(&bar[XB_XGEN(b.x)]) == gen, bar);
            __builtin_amdgcn_fence(__ATOMIC_ACQUIRE, "agent");
            asm volatile("s_waitcnt vmcnt(0)" ::: "memory");
        }
    }
    __syncthreads();
}
constexpr int NWAVES = 8, NTHREADS = 512;
constexpr int TT = 16384, DM = 1024, SEQ = 8192, NIN = 1280, NQD = 2048, NEXP = 16384;
constexpr float DN_ALPHA = 1.189207115002721f;
constexpr float LN_EPS = 1e-5f;
constexpr float LOG2E = 1.4426950408889634f;
constexpr float QSCALE = 0.125f * LOG2E;

constexpr size_t MiB = 1u << 20;
constexpr size_t WS_CTL = 0, CTL_ZERO_BYTES = 64 * 1024;
constexpr size_t WS_MODP = 1 * MiB;
constexpr size_t WS_MOD = 1 * MiB + 896 * 1024;
constexpr size_t WS_ROPE = 2 * MiB;
constexpr size_t WS_WIN = 248 * MiB;
constexpr size_t WS_BIAS = 4 * MiB;
constexpr size_t WS_K1 = 6 * MiB + 512 * 1024, WS_K2 = WS_K1 + 32 * 1024;
constexpr size_t WS_WOUT = 7 * MiB;
constexpr size_t WS_WPQ = 9 * MiB;
constexpr size_t WS_SU = 13 * MiB, WS_SV = 13 * MiB + 65536;
constexpr size_t WS_U = 16 * MiB, WS_V = 32 * MiB;
constexpr size_t WS_H2Q = 48 * MiB, WS_SH = 13 * MiB + 131072;
constexpr size_t WS_XN8 = 64 * MiB;
constexpr size_t WS_XN = 80 * MiB;
constexpr size_t WS_MIX = 112 * MiB;
constexpr size_t WS_PE = 80 * MiB, WS_PG = 84 * MiB;
constexpr size_t WS_PROJ = 112 * MiB;
constexpr size_t WS_A2 = 152 * MiB;
constexpr size_t WS_X1 = 184 * MiB, WS_H2 = 216 * MiB;
constexpr size_t WS_Q = 112 * MiB;
constexpr size_t WS_END = 253 * MiB;
constexpr int CW_MODCNT = 1024;
constexpr int CW_BAR = 4096;

constexpr int RING_BYTES = 131072, LDSCTL_OFF = RING_BYTES, MISC_OFF = LDSCTL_OFF + 320, LDS_BYTES = 147456;

typedef float f32x16 __attribute__((ext_vector_type(16)));
typedef float f32x2 __attribute__((ext_vector_type(2)));
typedef unsigned u32x2 __attribute__((ext_vector_type(2)));
typedef unsigned u32x4 __attribute__((ext_vector_type(4)));
typedef __bf16 bf16x2_t __attribute__((ext_vector_type(2)));
struct Frame {
    LAS unsigned char* lds;
    int tid, lane, wave, vcu, G;
    const float *x, *c, *w_ada, *b_ada, *w_in, *sinks, *w_pool, *pool_scale, *w_out, *ln1_g, *ln1_b, *w_pq, *k1, *k2, *pu, *pv, *ln2_g, *ln2_b;
    float* out; unsigned char* ws;
};
__device__ __forceinline__ float wave_sum(float v) {
#pragma unroll
    for (int o = 1; o < 64; o <<= 1) v += __shfl_xor(v, o);
    return v;
}
__device__ __forceinline__ float bf_lo(unsigned u) { return __uint_as_float(u << 16); }
__device__ __forceinline__ float bf_hi(unsigned u) { return __uint_as_float(u & 0xffff0000u); }
__device__ __forceinline__ float bf2f(bf16 b) { return __uint_as_float((unsigned)b << 16); }
__device__ __forceinline__ unsigned fp8x4(float a, float b, float c, float d) { int pk = __builtin_amdgcn_cvt_pk_fp8_f32(a, b, 0, false); pk = __builtin_amdgcn_cvt_pk_fp8_f32(c, d, pk, true); return (unsigned)pk; }

template <int MODE, bool OUT8 = false>
__device__ __forceinline__ void transpose_item(const float* W, int ldw, bf16* WT, int ldt, int k0, int n0, LAS float* scr, int lane, const LAS float* ksc = nullptr, float oscale = 1.0f) {
    int nsrc = n0 + (lane & 31);
    if (MODE == 1 && nsrc < 640) { const int hd = nsrc >> 6, w = nsrc & 63; nsrc = hd * 64 + (w >> 1) + 32 * (w & 1); }
    float wv[32];
#pragma unroll
    for (int i = 0; i < 32; ++i) wv[i] = W[(size_t)(k0 + 2 * i + (lane >> 5)) * ldw + nsrc];
#pragma unroll
    for (int i = 0; i < 32; ++i) { const int kk = 2 * i + (lane >> 5); float w_ = wv[i]; if (MODE == 1) w_ *= ksc[k0 + kk]; scr[kk * 33 + (lane & 31)] = w_; }
    LDS_WAIT(); asm volatile("" ::: "memory");
    const int c = lane & 7;
#pragma unroll
    for (int j = 0; j < 4; ++j) { const int n = (lane >> 3) + 8 * j; const LAS float* s = scr + (8 * c) * 33 + n;
        if (OUT8) { u32x2 o8; o8.x = fp8x4(s[0 * 33] * oscale, s[1 * 33] * oscale, s[2 * 33] * oscale, s[3 * 33] * oscale); o8.y = fp8x4(s[4 * 33] * oscale, s[5 * 33] * oscale, s[6 * 33] * oscale, s[7 * 33] * oscale);
            *(u32x2*)((unsigned char*)WT + (size_t)(n0 + n) * ldt + k0 + 8 * c) = o8; }
        else { v4u o; o.x = pk2(s[0 * 33], s[1 * 33]); o.y = pk2(s[2 * 33], s[3 * 33]); o.z = pk2(s[4 * 33], s[5 * 33]); o.w = pk2(s[6 * 33], s[7 * 33]);
            *(GAS v4u*)(WT + (size_t)(n0 + n) * ldt + k0 + 8 * c) = o; } }
    LDS_WAIT(); asm volatile("" ::: "memory");
}
__device__ __forceinline__ void sincos_d(double a, float& s, float& c) {
    const double TWO_PI = 6.283185307179586476925, PI = 3.141592653589793238462643;
    double r = a - TWO_PI * rint(a / TWO_PI);
    double sg = 1.0;
    if (r > 0.5 * PI) { r = PI - r; sg = -1.0; } else if (r < -0.5 * PI) { r = -PI - r; sg = -1.0; }
    const double r2 = r * r;
    double sp = -1.0 / 121645100408832000.0;
    sp = sp * r2 + 1.0 / 355687428096000.0; sp = sp * r2 - 1.0 / 1307674368000.0; sp = sp * r2 + 1.0 / 6227020800.0; sp = sp * r2 - 1.0 / 39916800.0;
    sp = sp * r2 + 1.0 / 362880.0; sp = sp * r2 - 1.0 / 5040.0; sp = sp * r2 + 1.0 / 120.0; sp = sp * r2 - 1.0 / 6.0; sp = sp * r2 + 1.0;
    double cp = 1.0 / 6402373705728000.0;
    cp = cp * r2 - 1.0 / 20922789888000.0; cp = cp * r2 + 1.0 / 87178291200.0; cp = cp * r2 - 1.0 / 479001600.0; cp = cp * r2 + 1.0 / 3628800.0;
    cp = cp * r2 - 1.0 / 40320.0; cp = cp * r2 + 1.0 / 720.0; cp = cp * r2 - 1.0 / 24.0; cp = cp * r2 + 0.5; cp = 1.0 - cp * r2;
    s = (float)(sp * r); c = (float)(sg * cp);
}
__device__ __forceinline__ void p1_win(Frame& F);
__device__ __forceinline__ void p0_prologue(Frame& F, int parts = 0xff) {
    LAS float* scr = (LAS float*)(F.lds + F.wave * 16384);
    const int gw = F.vcu * NWAVES + F.wave, NGW = F.G * NWAVES, lane = F.lane;
    if ((parts & 1) && (int)blockIdx.x < 192) { const int gb = (int)blockIdx.x, chunk = gb % 96, kh = gb / 96, col = chunk * 64 + lane, kbase = kh * 512 + F.wave * 64; float a0 = 0.f, a1 = 0.f;
        LAS float* sl = (LAS float*)(F.lds + F.wave * 16384 + 8448);
        { const int k = kbase + lane; const float c0 = F.c[k], c1 = F.c[DM + k]; sl[lane] = c0 / (1.f + __expf(-c0)); sl[64 + lane] = c1 / (1.f + __expf(-c1)); }
        LDS_WAIT(); asm volatile("" ::: "memory");
        { float w[64];
#pragma unroll
            for (int u = 0; u < 64; ++u) w[u] = F.w_ada[(size_t)(kbase + u) * 6144 + col];
#pragma unroll
            for (int u = 0; u < 64; ++u) { a0 += sl[u] * w[u]; a1 += sl[64 + u] * w[u]; } }
        LAS float* red = (LAS float*)(F.lds + F.wave * 16384 + 12288); red[lane] = a0; red[64 + lane] = a1;
        __syncthreads();
        if (F.tid < 128) { const int bb = F.tid >> 6, l = F.tid & 63; float sacc = kh == 0 ? F.b_ada[chunk * 64 + l] : 0.f;
#pragma unroll
            for (int w = 0; w < 8; ++w) sacc += ((const LAS float*)(F.lds + w * 16384 + 12288))[bb * 64 + l];
            ((float*)(F.ws + WS_MODP))[(kh * 2 + bb) * 6144 + chunk * 64 + l] = sacc; }
        asm volatile("s_waitcnt vmcnt(0)" ::: "memory"); __syncthreads();
        if (F.tid == 0) { __builtin_amdgcn_fence(__ATOMIC_RELEASE, "agent"); asm volatile("s_waitcnt vmcnt(0)" ::: "memory");
            __hip_atomic_fetch_add((unsigned*)(F.ws + WS_CTL) + CW_MODCNT, 1u, __ATOMIC_RELAXED, __HIP_MEMORY_SCOPE_AGENT); } }
    if (parts & 2) { float* rope = (float*)(F.ws + WS_ROPE);
      for (int e = gw * 64 + lane; e < SEQ * 32; e += NGW * 64) { const int pos = e >> 5, i = e & 31;
          const float freq = powf(10000.0f, -(float)i / 32.0f); const float ang = (float)pos * freq; float s, c; sincos_d((double)ang, s, c);
          rope[2 * e] = c; rope[2 * e + 1] = s; } }
    if (parts & 4) { constexpr int I_PQ = 16 * 64, I_OUT = 8 * 32;
      for (int it = NGW - 1 - gw; it < I_PQ + I_OUT; it += NGW) { int r = it;
          if (r < I_PQ) { transpose_item<0>(F.w_pq, NQD, (bf16*)(F.ws + WS_WPQ), DM, 64 * (r / 64), 32 * (r % 64), scr, lane); continue; } r -= I_PQ;
          transpose_item<0, true>(F.w_out, DM, (bf16*)(F.ws + WS_WOUT), DM, 64 * (r / 32), 32 * (r % 32), scr, lane, nullptr, 64.0f); } }
    if (parts & 8) { unsigned char* wout_t = F.ws + WS_WOUT;
      for (int it = gw; it < 4 * 2 * 128; it += NGW) { const int g = it >> 8, ch = (it >> 7) & 1, n0 = (it & 127) * 8, cidx = ch * 64 + lane;
          const float* wo = F.w_out + (size_t)(512 + g * 128) * DM + n0; const float* ps = F.pool_scale + g * 128;
#pragma unroll
          for (int i = 0; i < 4; ++i) { const int f4 = lane + 64 * i, e = f4 >> 1, hf = f4 & 1; const f32x4 o = *(const f32x4*)(wo + (size_t)e * DM + 4 * hf) * ps[e]; *(LAS f32x4*)(scr + e * 8 + 4 * hf) = o; }
          float acc[8];
#pragma unroll
          for (int i = 0; i < 8; ++i) acc[i] = 0.f;
          const float* wp = F.w_pool + ((size_t)(g * 128 + cidx)) * 128;
          LDS_WAIT(); asm volatile("" ::: "memory");
#pragma unroll 1
          for (int e0 = 0; e0 < 128; e0 += 64) { f32x4 wv[16];
#pragma unroll
              for (int q = 0; q < 16; ++q) wv[q] = *(const f32x4*)(wp + e0 + 4 * q);
#pragma unroll
              for (int q = 0; q < 16; ++q)
#pragma unroll
                  for (int ee = 0; ee < 4; ++ee) { const float w = wv[q][ee]; const f32x4 o0 = *(const LAS f32x4*)(scr + (e0 + 4 * q + ee) * 8), o1 = *(const LAS f32x4*)(scr + (e0 + 4 * q + ee) * 8 + 4);
                      acc[0] += w * o0[0]; acc[1] += w * o0[1]; acc[2] += w * o0[2]; acc[3] += w * o0[3]; acc[4] += w * o1[0]; acc[5] += w * o1[1]; acc[6] += w * o1[2]; acc[7] += w * o1[3]; } }
#pragma unroll
          for (int i = 0; i < 8; ++i) wout_t[(size_t)(n0 + i) * DM + 512 + g * 128 + cidx] = (unsigned char)(fp8x4(acc[i] * 64.0f, 0.f, 0.f, 0.f) & 0xffu);
          LDS_WAIT(); asm volatile("" ::: "memory"); } }
    if (parts & 16) { bf16* k1b = (bf16*)(F.ws + WS_K1); bf16* k2b = (bf16*)(F.ws + WS_K2);
      for (int e = gw * 64 + lane; e < 128 * 128; e += NGW * 64) { k1b[e] = (bf16)f2bf(F.k1[e]); k2b[e] = (bf16)f2bf(F.k2[e]); } }
    if (parts & 32) { bf16* xn = (bf16*)(F.ws + WS_XN); const int rpw = TT / NGW;
      for (int m = gw * rpw; m < gw * rpw + rpw; m += 4) { f32x4 v[4][4];
#pragma unroll
          for (int q = 0; q < 4; ++q)
#pragma unroll
              for (int j = 0; j < 4; ++j) v[q][j] = *(const f32x4*)(F.x + (size_t)(m + q) * DM + 256 * j + 4 * lane);
#pragma unroll
          for (int q = 0; q < 4; ++q)
#pragma unroll
              for (int j = 0; j < 4; ++j) { u32x2 o; o.x = pk2(v[q][j][0], v[q][j][1]); o.y = pk2(v[q][j][2], v[q][j][3]); *(u32x2*)(xn + (size_t)(m + q) * DM + 256 * j + 4 * lane) = o;
                  *(unsigned*)(F.ws + WS_XN8 + (size_t)(m + q) * DM + 256 * j + 4 * lane) = fp8x4(v[q][j][0], v[q][j][1], v[q][j][2], v[q][j][3]); } } }
    if (parts & 64) {
        __syncthreads();
        if (F.tid == 0) { unsigned sp = 0; const unsigned* cnt = (const unsigned*)(F.ws + WS_CTL) + CW_MODCNT;
            while (__hip_atomic_load(cnt, __ATOMIC_RELAXED, __HIP_MEMORY_SCOPE_AGENT) < 192u) { __builtin_amdgcn_s_sleep(2); if (++sp > (1u << 22)) break; }
            __builtin_amdgcn_fence(__ATOMIC_ACQUIRE, "agent"); asm volatile("s_waitcnt vmcnt(0)" ::: "memory"); }
        __syncthreads();
        p1_win(F);
    }
}
__device__ __forceinline__ void tb_load4(Frame& F, int base, int r1, f32x4 (&dst)[4][4]) {
#pragma unroll
    for (int q = 0; q < 4; ++q) { const int it = (base + q < r1) ? base + q : r1 - 1; const int tb = it >= NEXP, e = it - tb * NEXP; const float* src = (tb ? F.pv : F.pu) + (size_t)e * DM;
#pragma unroll
        for (int j = 0; j < 4; ++j) dst[q][j] = *(const f32x4*)(src + 256 * j + 4 * F.lane); }
}
__device__ __forceinline__ void tb_proc4(Frame& F, int base, int r1, const f32x4 (&v)[4][4]) {
    const int lane = F.lane; float* su = (float*)(F.ws + WS_SU); float* sv = (float*)(F.ws + WS_SV); float am[4];
#pragma unroll
    for (int q = 0; q < 4; ++q) { float a = 0.f;
#pragma unroll
        for (int j = 0; j < 4; ++j) a = fmaxf(a, fmaxf(fmaxf(fabsf(v[q][j][0]), fabsf(v[q][j][1])), fmaxf(fabsf(v[q][j][2]), fabsf(v[q][j][3])))); am[q] = a; }
#pragma unroll
    for (int o = 1; o < 64; o <<= 1) {
#pragma unroll
        for (int q = 0; q < 4; ++q) am[q] = fmaxf(am[q], __shfl_xor(am[q], o)); }
#pragma unroll
    for (int q = 0; q < 4; ++q) { const int it = (base + q < r1) ? base + q : r1 - 1; const int tb = it >= NEXP, e = it - tb * NEXP; float a = am[q]; if (a == 0.f) a = 1.f;
        unsigned w[4];
        if (!tb) { const float inv = 127.0f / a;
#pragma unroll
            for (int j = 0; j < 4; ++j) { const int q0 = (int)rintf(v[q][j][0] * inv), q1 = (int)rintf(v[q][j][1] * inv), q2 = (int)rintf(v[q][j][2] * inv), q3 = (int)rintf(v[q][j][3] * inv);
                w[j] = (unsigned)(q0 & 255) | ((unsigned)(q1 & 255) << 8) | ((unsigned)(q2 & 255) << 16) | ((unsigned)(q3 & 255) << 24); }
            *(v4u*)(F.ws + WS_U + (size_t)e * DM + 16 * lane) = (v4u){w[0], w[1], w[2], w[3]}; if (lane == 0) su[e] = a * (1.0f / 127.0f);
        } else { const float inv = 256.0f / a;
#pragma unroll
            for (int j = 0; j < 4; ++j) { int pk = __builtin_amdgcn_cvt_pk_bf8_f32(v[q][j][0] * inv, v[q][j][1] * inv, 0, false); pk = __builtin_amdgcn_cvt_pk_bf8_f32(v[q][j][2] * inv, v[q][j][3] * inv, pk, true); w[j] = (unsigned)pk; }
            *(v4u*)(F.ws + WS_V + (size_t)e * DM + 16 * lane) = (v4u){w[0], w[1], w[2], w[3]}; if (lane == 0) sv[e] = a * (1.0f / 256.0f); } }
}
__device__ __forceinline__ void p2_tables(Frame& F, int cw, int ncw, int row_lo, int row_hi) {
    const int per = (row_hi - row_lo + ncw - 1) / ncw, r0 = row_lo + cw * per, r1 = (r0 + per) < row_hi ? (r0 + per) : row_hi;
    if (r0 >= r1) return;
    f32x4 va[4][4], vb[4][4];
    tb_load4(F, r0, r1, va);
    for (int it0 = r0; it0 < r1; it0 += 8) {
        if (it0 + 4 < r1) tb_load4(F, it0 + 4, r1, vb);
        tb_proc4(F, it0, r1, va);
        if (it0 + 4 < r1) { if (it0 + 8 < r1) tb_load4(F, it0 + 8, r1, va); tb_proc4(F, it0 + 4, r1, vb); }
    }
}
__device__ __forceinline__ void p1_win(Frame& F) {
    const float* mp = (const float*)(F.ws + WS_MODP);
    if (F.vcu < 48 && F.tid < 256) { const int e = F.vcu * 256 + F.tid; ((float*)(F.ws + WS_MOD))[e] = mp[e] + mp[2 * 6144 + e]; }
    LAS float* sc = (LAS float*)F.lds; LAS float* sh = sc + 2048;
    for (int i = F.tid; i < 2048; i += NTHREADS) { const int b = i >> 10, k = i & 1023; sc[i] = 1.f + mp[b * 6144 + 1024 + k] + mp[(2 + b) * 6144 + 1024 + k]; sh[i] = mp[b * 6144 + k] + mp[(2 + b) * 6144 + k]; }
    __syncthreads();
    const int lane = F.lane;
    if (F.vcu < 40) { const int b = F.vcu / 20, n = (F.vcu % 20) * 64 + lane; int nsrc = n; if (n < 640) { const int hd = n >> 6, w = n & 63; nsrc = hd * 64 + (w >> 1) + 32 * (w & 1); }
        float a = 0.f;
#pragma unroll 1
        for (int kb = 0; kb < 128; kb += 64) { float w[64];
#pragma unroll
            for (int u = 0; u < 64; ++u) w[u] = F.w_in[(size_t)(F.wave * 128 + kb + u) * NIN + nsrc];
#pragma unroll
            for (int u = 0; u < 64; ++u) a += sh[b * 1024 + F.wave * 128 + kb + u] * w[u]; }
        LAS float* red = (LAS float*)(F.lds + 16384); red[F.wave * 64 + lane] = a;
        __syncthreads();
        if (F.tid < 64) { float sacc = 0.f;
#pragma unroll
            for (int w = 0; w < 8; ++w) sacc += red[w * 64 + F.tid];
            ((float*)(F.ws + WS_BIAS))[b * NIN + (F.vcu % 20) * 64 + F.tid] = sacc; } }
    LAS float* scr = (LAS float*)(F.lds + 32768 + F.wave * 8448);
    const int gw = F.vcu * NWAVES + F.wave, NGW = F.G * NWAVES;
    for (int it = gw; it < 2 * 640; it += NGW) { const int b = it / 640, r = it % 640;
        transpose_item<1, true>(F.w_in, NIN, (bf16*)(F.ws + WS_WIN + (size_t)b * NIN * DM), DM, 64 * (r / 40), 32 * (r % 40), scr, lane, sc + b * 1024, 64.0f); }
    __syncthreads();
}
constexpr int KS_STRIDE = 144, VT_STRIDE = 520, KS_BYTES = 256 * KS_STRIDE, VT_BYTES = 64 * VT_STRIDE;
__device__ __forceinline__ void p3_attn_unit(Frame& F, int unit) {
    const int b = unit >> 7, kvh = (unit >> 6) & 1, n = unit & 63;
    const bf16* proj = (const bf16*)(F.ws + WS_PROJ); unsigned char* a2 = F.ws + WS_A2;
    LAS unsigned char* Ks = F.lds; LAS unsigned char* Vt = F.lds + KS_BYTES;
    const int tid = F.tid, lane = F.lane, wave = F.wave, r32 = lane & 31, h = lane >> 5;
    const size_t tok0 = (size_t)b * SEQ + (size_t)n * 128;
#pragma unroll
    for (int i = 0; i < 4; ++i) { const int ci = tid + NTHREADS * i, row = ci >> 3, ch = ci & 7; const bool valid = (n > 0) || (row >= 128);
        const size_t tk = tok0 - 128 + row;
        v4u kv = (v4u){0u, 0u, 0u, 0u}, vv = (v4u){0u, 0u, 0u, 0u};
        if (valid) { kv = *(const v4u*)(proj + tk * NIN + 512 + kvh * 64 + ch * 8); vv = *(const v4u*)(proj + tk * NIN + 640 + kvh * 64 + ch * 8); }
        *(LAS v4u*)(Ks + row * KS_STRIDE + ch * 16) = kv;
        LAS bf16* vt = (LAS bf16*)(Vt + (ch * 8) * VT_STRIDE) + row;
        vt[0 * (VT_STRIDE / 2)] = (bf16)(vv.x & 0xffff); vt[1 * (VT_STRIDE / 2)] = (bf16)(vv.x >> 16); vt[2 * (VT_STRIDE / 2)] = (bf16)(vv.y & 0xffff); vt[3 * (VT_STRIDE / 2)] = (bf16)(vv.y >> 16);
        vt[4 * (VT_STRIDE / 2)] = (bf16)(vv.z & 0xffff); vt[5 * (VT_STRIDE / 2)] = (bf16)(vv.z >> 16); vt[6 * (VT_STRIDE / 2)] = (bf16)(vv.w & 0xffff); vt[7 * (VT_STRIDE / 2)] = (bf16)(vv.w >> 16); }
    __syncthreads();
    const int g = wave >> 1, hq = kvh * 4 + g; const float sink2 = F.sinks[hq] * LOG2E;
#pragma unroll 1
    for (int qt = 0; qt < 2; ++qt) {
        const int qi0 = (wave & 1) * 64 + qt * 32, t0 = qi0 >> 5; const size_t tokq = tok0 + qi0 + r32;
        bf16x8 qf[4];
#pragma unroll
        for (int s = 0; s < 4; ++s) qf[s] = *(const bf16x8*)(proj + tokq * NIN + hq * 64 + 16 * s + 8 * h);
        f32x16 sc[5];
#pragma unroll
        for (int kt = 0; kt < 5; ++kt) { sc[kt] = (f32x16){};
#pragma unroll
            for (int s = 0; s < 4; ++s) { const bf16x8 kf = *(const LAS bf16x8*)(Ks + (32 * (t0 + kt) + r32) * KS_STRIDE + (16 * s + 8 * h) * 2);
                sc[kt] = __builtin_amdgcn_mfma_f32_32x32x16_bf16(kf, qf[s], sc[kt], 0, 0, 0); } }
        const int qi = qi0 + r32; float m = sink2;
#pragma unroll
        for (int kt = 0; kt < 5; ++kt)
#pragma unroll
            for (int r = 0; r < 16; ++r) { const int sidx = 32 * (t0 + kt) + (r & 3) + 8 * (r >> 2) + 4 * h; const int rel = qi + 128 - sidx;
                const bool ok = (rel >= 0) && (rel < 128) && ((n > 0) || (sidx >= 128));
                const float v = ok ? sc[kt][r] : -INFINITY; sc[kt][r] = v; m = fmaxf(m, v); }
        m = fmaxf(m, __shfl_xor(m, 32));
        float l = 0.f;
#pragma unroll
        for (int kt = 0; kt < 5; ++kt)
#pragma unroll
            for (int r = 0; r < 16; ++r) { const float p = __builtin_amdgcn_exp2f(sc[kt][r] - m); sc[kt][r] = p; l += p; }
        l += __shfl_xor(l, 32); l += __builtin_amdgcn_exp2f(sink2 - m);
        f32x16 o[2]; o[0] = (f32x16){}; o[1] = (f32x16){};
#pragma unroll
        for (int kt = 0; kt < 5; ++kt)
#pragma unroll
            for (int s2 = 0; s2 < 2; ++s2) {
                u32x4 pw; pw.x = pg8::cvt_pk_bf16(sc[kt][8 * s2 + 0], sc[kt][8 * s2 + 1]); pw.y = pg8::cvt_pk_bf16(sc[kt][8 * s2 + 2], sc[kt][8 * s2 + 3]);
                pw.z = pg8::cvt_pk_bf16(sc[kt][8 * s2 + 4], sc[kt][8 * s2 + 5]); pw.w = pg8::cvt_pk_bf16(sc[kt][8 * s2 + 6], sc[kt][8 * s2 + 7]);
                const bf16x8 pf = __builtin_bit_cast(bf16x8, pw);
#pragma unroll
                for (int dt = 0; dt < 2; ++dt) { const LAS unsigned char* vp = Vt + (dt * 32 + r32) * VT_STRIDE + (32 * (t0 + kt) + 16 * s2 + 4 * h) * 2;
                    const u32x2 lo = *(const LAS u32x2*)vp, hi = *(const LAS u32x2*)(vp + 16);
                    const u32x4 vw = (u32x4){lo.x, lo.y, hi.x, hi.y};
                    o[dt] = __builtin_amdgcn_mfma_f32_32x32x16_bf16(__builtin_bit_cast(bf16x8, vw), pf, o[dt], 0, 0, 0); } }
        const float inv = 16.0f / l;
#pragma unroll
        for (int dt = 0; dt < 2; ++dt)
#pragma unroll
            for (int rg = 0; rg < 4; ++rg) { const int d0 = dt * 32 + 8 * rg + 4 * h;
                *(unsigned*)(a2 + tokq * DM + hq * 64 + d0) = fp8x4(o[dt][4 * rg + 0] * inv, o[dt][4 * rg + 1] * inv, o[dt][4 * rg + 2] * inv, o[dt][4 * rg + 3] * inv); }
    }
    __syncthreads();
}
__device__ __forceinline__ void p3_pool_unit(Frame& F, int unit) {
    const bf16* proj = (const bf16*)(F.ws + WS_PROJ); unsigned char* a2 = F.ws + WS_A2;
    const int cp = F.tid & 255, half = F.tid >> 8, gi = cp >> 6, w = 2 << gi;
    const int tstart = unit * 64 + half * 32, s0 = tstart & (SEQ - 1);
    const bf16* pc = proj + 768 + 2 * cp;
    unsigned u[48];
#pragma unroll
    for (int i = 0; i < 48; ++i) { const int s = s0 - 16 + i; u[i] = (s >= 0) ? *(const unsigned*)(pc + (size_t)(tstart - 16 + i) * NIN) : 0u; }
    float w0 = 0.f, w1 = 0.f;
#pragma unroll
    for (int j = 1; j <= 16; ++j) if (j <= w) { w0 += bf_lo(u[16 - j]); w1 += bf_hi(u[16 - j]); }
#pragma unroll
    for (int i = 0; i < 32; ++i) { const int s = s0 + i; const float p0 = bf_lo(u[16 + i]), p1 = bf_hi(u[16 + i]);
        const unsigned uo = (w == 2) ? u[14 + i] : (w == 4) ? u[12 + i] : (w == 8) ? u[8 + i] : u[i];
        w0 += p0 - bf_lo(uo); w1 += p1 - bf_hi(uo);
        const float rc = 1.0f / (float)((s + 1) < w ? (s + 1) : w);
        *(unsigned short*)(a2 + (size_t)(tstart + i) * DM + 512 + 2 * cp) = (unsigned short)(fp8x4((w0 * rc - p0) * 16.0f, (w1 * rc - p1) * 16.0f, 0.f, 0.f) & 0xffffu); }
}
__device__ __forceinline__ void p5_ln1(Frame& F) {
    const float* mod = (const float*)(F.ws + WS_MOD); const bf16* mix = (const bf16*)(F.ws + WS_MIX); const bf16* xn = (const bf16*)(F.ws + WS_XN);
    bf16* x1 = (bf16*)(F.ws + WS_X1); bf16* h2 = (bf16*)(F.ws + WS_H2); unsigned char* h2q = F.ws + WS_H2Q; float* shp = (float*)(F.ws + WS_SH);
    const int gw = F.vcu * NWAVES + F.wave, lane = F.lane; const int rows_per_wave = TT / (F.G * NWAVES);
    const int row0 = gw * rows_per_wave, b = row0 >> 13;
    f32x4 g1[4], lg[4], lb[4], s2[4], h2s[4];
#pragma unroll
    for (int j = 0; j < 4; ++j) { const int d = 256 * j + 4 * lane;
        g1[j] = *(const f32x4*)(mod + b * 6144 + 2048 + d) + 1.0f; lg[j] = *(const f32x4*)(F.ln1_g + d); lb[j] = *(const f32x4*)(F.ln1_b + d);
        s2[j] = *(const f32x4*)(mod + b * 6144 + 4096 + d) + 1.0f; h2s[j] = *(const f32x4*)(mod + b * 6144 + 3072 + d); }
    for (int r = 0; r < rows_per_wave; r += 2) {
        u32x2 xw[2][4]; u32x2 mv[2][4];
#pragma unroll
        for (int q = 0; q < 2; ++q)
#pragma unroll
            for (int j = 0; j < 4; ++j) { const size_t m = (size_t)(row0 + r + q); const int d = 256 * j + 4 * lane; xw[q][j] = *(const u32x2*)(xn + m * DM + d); mv[q][j] = *(const u32x2*)(mix + m * DM + d); }
#pragma unroll
        for (int q = 0; q < 2; ++q) { const size_t m = (size_t)(row0 + r + q);
        f32x4 v[4]; float s = 0.f;
#pragma unroll
        for (int j = 0; j < 4; ++j) {
            const f32x4 mf = (f32x4){bf_lo(mv[q][j].x), bf_hi(mv[q][j].x), bf_lo(mv[q][j].y), bf_hi(mv[q][j].y)};
            const f32x4 xf = (f32x4){bf_lo(xw[q][j].x), bf_hi(xw[q][j].x), bf_lo(xw[q][j].y), bf_hi(xw[q][j].y)};
            v[j] = xf * DN_ALPHA + g1[j] * mf; s += (v[j][0] + v[j][1]) + (v[j][2] + v[j][3]); }
        const float mean = wave_sum(s) * (1.f / DM); float qq = 0.f;
#pragma unroll
        for (int j = 0; j < 4; ++j) { v[j] = v[j] - mean; qq += (v[j][0] * v[j][0] + v[j][1] * v[j][1]) + (v[j][2] * v[j][2] + v[j][3] * v[j][3]); }
        const float rstd = 1.0f / sqrtf(wave_sum(qq) * (1.f / DM) + LN_EPS);
        f32x4 hh[4]; float am = 0.f;
#pragma unroll
        for (int j = 0; j < 4; ++j) { const int d = 256 * j + 4 * lane; const f32x4 y = v[j] * rstd * lg[j] + lb[j]; hh[j] = y * s2[j] + h2s[j];
            u32x2 o; o.x = pk2(y[0], y[1]); o.y = pk2(y[2], y[3]); *(u32x2*)(x1 + m * DM + d) = o;
            u32x2 p; p.x = pk2(hh[j][0], hh[j][1]); p.y = pk2(hh[j][2], hh[j][3]); *(u32x2*)(h2 + m * DM + d) = p;
            hh[j] = (f32x4){bf_lo(p.x), bf_hi(p.x), bf_lo(p.y), bf_hi(p.y)};
            am = fmaxf(am, fmaxf(fmaxf(fabsf(hh[j][0]), fabsf(hh[j][1])), fmaxf(fabsf(hh[j][2]), fabsf(hh[j][3])))); }
#pragma unroll
        for (int o = 1; o < 64; o <<= 1) am = fmaxf(am, __shfl_xor(am, o));
        if (am == 0.f) am = 1.f;
        const float inv = 127.0f / am; unsigned w[4];
#pragma unroll
        for (int j = 0; j < 4; ++j) { const int q0 = (int)rintf(hh[j][0] * inv), q1 = (int)rintf(hh[j][1] * inv), q2 = (int)rintf(hh[j][2] * inv), q3 = (int)rintf(hh[j][3] * inv);
            w[j] = (unsigned)(q0 & 255) | ((unsigned)(q1 & 255) << 8) | ((unsigned)(q2 & 255) << 16) | ((unsigned)(q3 & 255) << 24); }
        *(v4u*)(h2q + m * DM + 16 * lane) = (v4u){w[0], w[1], w[2], w[3]}; if (lane == 0) shp[m] = am * (1.0f / 127.0f); } }
}
constexpr int KR_STRIDE = 272, KR_BYTES = 128 * KR_STRIDE;
#define INS16(a, v) do { _Pragma("unroll") for (int _i = 15; _i >= 1; --_i) a[_i] = __builtin_amdgcn_fmed3f(a[_i - 1], a[_i], (v)); a[0] = fmaxf(a[0], (v)); } while (0)
#define BITONIC16(a) do { _Pragma("unroll") for (int _st = 8; _st >= 1; _st >>= 1) { _Pragma("unroll") for (int _i = 0; _i < 16; ++_i) if ((_i & _st) == 0) { const float _x = a[_i], _y = a[_i + _st]; a[_i] = fmaxf(_x, _y); a[_i + _st] = fminf(_x, _y); } } } while (0)
__device__ __forceinline__ void p7_route(Frame& F) {
    const bf16* q = (const bf16*)(F.ws + WS_Q); unsigned short* pe = (unsigned short*)(F.ws + WS_PE); float* pg = (float*)(F.ws + WS_PG);
    const int tid = F.tid, lane = F.lane, wave = F.wave, r32 = lane & 31, h = lane >> 5;
    { const bf16* k1b = (const bf16*)(F.ws + WS_K1);
      for (int ci = tid; ci < 2 * 128 * 16; ci += NTHREADS) { const int side = ci >> 11, row = (ci >> 4) & 127, ch = ci & 15;
          *(LAS v4u*)(F.lds + side * KR_BYTES + row * KR_STRIDE + ch * 16) = *(const v4u*)(k1b + (size_t)side * 16384 + row * 128 + ch * 8); } }
    __syncthreads();
    LAS unsigned char* scr = F.lds + 2 * KR_BYTES + wave * 2048 + lane * 32;
    pg8::StaticOrder S; S.init(TT, NQD, F.G, (int)blockIdx.x); pg8::Unit u;
    for (int ui = 0; S.next(ui, u); ++ui) {
        const int head = u.pn; const size_t tok = (size_t)u.pm * 256 + wave * 32 + r32;
        float vv[2][16];
#pragma unroll
        for (int side = 0; side < 2; ++side) {
            const bf16* qb = q + tok * NQD + head * 256 + side * 128;
            bf16x8 qf[8];
#pragma unroll
            for (int s = 0; s < 8; ++s) qf[s] = *(const bf16x8*)(qb + 16 * s + 8 * h);
            float a[16];
#pragma unroll
            for (int i = 0; i < 16; ++i) a[i] = -INFINITY;
#pragma unroll
            for (int kt = 0; kt < 4; ++kt) { f32x16 acc = (f32x16){};
#pragma unroll
                for (int s = 0; s < 8; ++s) { const bf16x8 kf = *(const LAS bf16x8*)(F.lds + side * KR_BYTES + (32 * kt + r32) * KR_STRIDE + (16 * s + 8 * h) * 2);
                    acc = __builtin_amdgcn_mfma_f32_32x32x16_bf16(kf, qf[s], acc, 0, 0, 0); }
#pragma unroll
                for (int r = 0; r < 16; ++r) { const unsigned key = (unsigned)(32 * kt + (r & 3) + 8 * (r >> 2)) | ((unsigned)h << 2);
                    const float v = __uint_as_float((__float_as_uint(acc[r]) & 0xFFFFFF80u) | key); INS16(a, v); }
                __builtin_amdgcn_sched_barrier(0); }
            float c[16];
#pragma unroll
            for (int i = 0; i < 16; ++i) c[i] = __shfl_xor(a[15 - i], 32);
#pragma unroll
            for (int i = 0; i < 16; ++i) c[i] = fmaxf(a[i], c[i]);
            BITONIC16(c);
#pragma unroll
            for (int i = 0; i < 16; ++i) vv[side][i] = c[i];
        }
        { v4u w1, w2;
#define PK4(L, b) ((__float_as_uint(L[b]) & 0x7Fu) | ((__float_as_uint(L[b + 1]) & 0x7Fu) << 8) | ((__float_as_uint(L[b + 2]) & 0x7Fu) << 16) | ((__float_as_uint(L[b + 3]) & 0x7Fu) << 24))
          w1.x = PK4(vv[0], 0); w1.y = PK4(vv[0], 4); w1.z = PK4(vv[0], 8); w1.w = PK4(vv[0], 12);
          w2.x = PK4(vv[1], 0); w2.y = PK4(vv[1], 4); w2.z = PK4(vv[1], 8); w2.w = PK4(vv[1], 12);
#undef PK4
          *(LAS v4u*)scr = w1; *(LAS v4u*)(scr + 16) = w2; }
        float c1[16], c2[16], top[16];
#pragma unroll
        for (int i = 0; i < 16; ++i) { c1[i] = __uint_as_float(__float_as_uint(vv[0][i]) & 0xFFFFFF80u); c2[i] = __uint_as_float(__float_as_uint(vv[1][i]) & 0xFFFFFF80u); top[i] = -INFINITY; }
#pragma unroll
        for (int ia = 0; ia < 16; ++ia)
#pragma unroll
            for (int ib = 0; ib < 16; ++ib) if ((ia + 1) * (ib + 1) <= 16) {
                const float sm = c1[ia] + c2[ib]; const float v = __uint_as_float((__float_as_uint(sm) & 0xFFFFFF00u) | (unsigned)(ia * 16 + ib)); INS16(top, v); }
        float ex[16], den = 0.f;
#pragma unroll
        for (int i = 0; i < 16; ++i) { ex[i] = __expf(top[i] - top[0]); den += ex[i]; }
        const float rden = 1.0f / den;
        LDS_WAIT();
        unsigned short ev[8]; float gv[8];
#pragma unroll
        for (int j = 0; j < 8; ++j) { const float t = h ? top[8 + j] : top[j]; const float e = h ? ex[8 + j] : ex[j];
            const unsigned code = __float_as_uint(t) & 0xFFu; const unsigned i1 = *(const LAS unsigned char*)(scr + (code >> 4)), i2 = *(const LAS unsigned char*)(scr + 16 + (code & 15u));
            ev[j] = (unsigned short)(i1 * 128u + i2); gv[j] = e * rden; }
        v4u ew; ew.x = ev[0] | ((unsigned)ev[1] << 16); ew.y = ev[2] | ((unsigned)ev[3] << 16); ew.z = ev[4] | ((unsigned)ev[5] << 16); ew.w = ev[6] | ((unsigned)ev[7] << 16);
        *(v4u*)(pe + tok * 128 + head * 16 + 8 * h) = ew;
        *(f32x4*)(pg + tok * 128 + head * 16 + 8 * h) = (f32x4){gv[0], gv[1], gv[2], gv[3]};
        *(f32x4*)(pg + tok * 128 + head * 16 + 8 * h + 4) = (f32x4){gv[4], gv[5], gv[6], gv[7]};
        LDS_WAIT();
    }
    __syncthreads();
}
__device__ __forceinline__ float gelu_erf(float v) {
    const float d = fabsf(v) * 0.2316418882f + 1.0f, t = __builtin_amdgcn_rcpf(d);
    float q = t * 0.5307027145f + (-0.7265760135f); q = q * t + 0.7107068705f; q = q * t + (-0.142248368f); q = q * t + 0.127414796f; q = q * t;
    const float e = __builtin_amdgcn_exp2f(v * v * (-0.72134752044f)), m = v * (q * e);
    return v < 0.f ? m : v - m; }
#ifndef NPART
#define NPART 8
#endif
constexpr int TPW = 8, NSWEEP = 1;
constexpr int PSHIFT = (NPART == 32) ? 9 : (NPART == 8) ? 11 : (NPART == 16) ? 10 : (NPART == 4) ? 12 : (NPART == 2) ? 13 : 14;
__device__ __forceinline__ void p8_peer(Frame& F, unsigned emask = 0xffffu, int skip = 0) {
    const float* mod = (const float*)(F.ws + WS_MOD);
    const bf16* x1 = (const bf16*)(F.ws + WS_X1); const bf16* h2 = (const bf16*)(F.ws + WS_H2);
    const unsigned char* ut = F.ws + WS_U; const unsigned char* vt = F.ws + WS_V;
    const float* su = (const float*)(F.ws + WS_SU); const float* sv = (const float*)(F.ws + WS_SV);
    const unsigned* pe = (const unsigned*)(F.ws + WS_PE); const float* pg = (const float*)(F.ws + WS_PG);
    const int gw = F.vcu * NWAVES + F.wave;
    const int b3 = (F.lane >> 3) & 1;
#pragma unroll 1
    for (int sweep = 0; sweep < NSWEEP; ++sweep) {
    const int t0 = (gw * NSWEEP + sweep) * TPW, b = t0 >> 13;
    int lane = F.lane; asm volatile("" : "+v"(lane));
    unsigned hq[TPW][4]; float shs[TPW]; unsigned es[TPW]; float gs[TPW][2]; int offv[TPW];
    unsigned pe2v[TPW]; f32x2 pg2v[TPW];
#pragma unroll
    for (int tt = 0; tt < TPW; ++tt) { const size_t t = (size_t)(t0 + tt);
        const u32x4 hw = *(const u32x4*)(F.ws + WS_H2Q + t * DM + 16 * lane); hq[tt][0] = hw.x; hq[tt][1] = hw.y; hq[tt][2] = hw.z; hq[tt][3] = hw.w; shs[tt] = ((const float*)(F.ws + WS_SH))[t];
        pe2v[tt] = pe[t * 64 + lane]; pg2v[tt] = *(const f32x2*)(pg + t * 128 + 2 * lane); }
#pragma unroll
    for (int tt = 0; tt < TPW; ++tt) { LAS unsigned* scr = (LAS unsigned*)(F.lds + (F.wave * TPW + tt) * 1024);
        const unsigned pe2 = pe2v[tt]; const f32x2 pg2 = pg2v[tt];
        const unsigned elo = pe2 & emask, ehi = (pe2 >> 16) & emask; const int plo = (int)(elo >> PSHIFT), phi = (int)(ehi >> PSHIFT);
        int base = 0, poslo = 0, poshi = 0, ov = 0;
#pragma unroll
        for (int r = 0; r < NPART; ++r) { const unsigned long long mlo = __ballot(plo == r), mhi = __ballot(phi == r);
            const int clo = __popcll(mlo), chi = __popcll(mhi);
            const int rlo = (int)__builtin_amdgcn_mbcnt_hi((unsigned)(mlo >> 32), __builtin_amdgcn_mbcnt_lo((unsigned)mlo, 0u));
            const int rhi = (int)__builtin_amdgcn_mbcnt_hi((unsigned)(mhi >> 32), __builtin_amdgcn_mbcnt_lo((unsigned)mhi, 0u));
            if (plo == r) poslo = base + rlo; if (phi == r) poshi = base + clo + rhi;
            base += clo + chi; if (lane == r + 1) ov = base; }
        offv[tt] = ov;
        scr[2 * poslo] = elo; scr[2 * poslo + 1] = __float_as_uint(pg2.x); scr[2 * poshi] = ehi; scr[2 * poshi + 1] = __float_as_uint(pg2.y); }
    LDS_WAIT();
#pragma unroll
    for (int tt = 0; tt < TPW; ++tt) { const LAS unsigned* scr = (const LAS unsigned*)(F.lds + (F.wave * TPW + tt) * 1024);
        const u32x4 sr = *(const LAS u32x4*)(scr + 4 * lane);
        es[tt] = sr.x | (sr.z << 16); gs[tt][0] = __uint_as_float(sr.y); gs[tt][1] = __uint_as_float(sr.w); }
    LDS_WAIT();
#define P8_ISSUE(buf, tbl, tok, bb) do { _Pragma("unroll") for (int k2 = 0; k2 < 4; ++k2) { const unsigned ew = (unsigned)__builtin_amdgcn_readlane((int)es[tok], 4 * (bb) + k2); \
        buf[2 * k2] = *(const u32x4*)((tbl) + (size_t)(ew & 0xffffu) * DM + 16 * lane); buf[2 * k2 + 1] = *(const u32x4*)((tbl) + (size_t)(ew >> 16) * DM + 16 * lane); } } while (0)
    int hidv[TPW][2];
#pragma unroll
    for (int tt = 0; tt < TPW; ++tt) { hidv[tt][0] = 0; hidv[tt][1] = 0; }
    {
        u32x4 bufA[8], bufB[8];
#define P8_DOTS(buf, tok, bb) do { int p[8]; \
            _Pragma("unroll") for (int kk = 0; kk < 8; ++kk) { int s_ = __builtin_amdgcn_sdot4((int)buf[kk].x, (int)hq[tok][0], 0, false); s_ = __builtin_amdgcn_sdot4((int)buf[kk].y, (int)hq[tok][1], s_, false); \
                s_ = __builtin_amdgcn_sdot4((int)buf[kk].z, (int)hq[tok][2], s_, false); s_ = __builtin_amdgcn_sdot4((int)buf[kk].w, (int)hq[tok][3], s_, false); p[kk] = s_; } \
            int q4[4], q2[2], q1; \
            _Pragma("unroll") for (int i = 0; i < 4; ++i) { auto r_ = __builtin_amdgcn_permlane32_swap((unsigned)p[i], (unsigned)p[i + 4], false, false); q4[i] = (int)(r_[0] + r_[1]); } \
            _Pragma("unroll") for (int i = 0; i < 2; ++i) { auto r_ = __builtin_amdgcn_permlane16_swap((unsigned)q4[i], (unsigned)q4[i + 2], false, false); q2[i] = (int)(r_[0] + r_[1]); } \
            { const int keep = b3 ? q2[1] : q2[0], send = b3 ? q2[0] : q2[1]; q1 = keep + __builtin_amdgcn_update_dpp(0, send, 0x128, 0xF, 0xF, true); } \
            q1 += __builtin_amdgcn_update_dpp(0, q1, 0xB1, 0xF, 0xF, true); q1 += __builtin_amdgcn_update_dpp(0, q1, 0x4E, 0xF, 0xF, true); q1 += __builtin_amdgcn_update_dpp(0, q1, 0x141, 0xF, 0xF, true); \
            const int i2_ = (lane & 3) * 2; const int v0_ = __builtin_amdgcn_ds_bpermute(i2_ << 5, q1), v1_ = __builtin_amdgcn_ds_bpermute((i2_ + 1) << 5, q1); \
            if ((lane >> 2) == (bb)) { hidv[tok][0] = v0_; hidv[tok][1] = v1_; } } while (0)
        int cur[TPW];
#pragma unroll
        for (int tt = 0; tt < TPW; ++tt) cur[tt] = 0;
#define P8_STEP_A(tt_, bufX, bufY, r_) { const int end_ = __builtin_amdgcn_readlane(offv[tt_], (r_) + 1); \
            { constexpr int tn_ = ((tt_) + 1) % TPW; const int rn_ = (r_) + ((tt_) + 1) / TPW; \
              if (rn_ < NPART && cur[tn_] < __builtin_amdgcn_readlane(offv[tn_], rn_ + 1)) P8_ISSUE(bufY, ut, tn_, cur[tn_] >> 3); } \
            __builtin_amdgcn_sched_barrier(0); \
            bool pre_ = true; \
            while (cur[tt_] < end_) { if (!pre_) P8_ISSUE(bufX, ut, tt_, cur[tt_] >> 3); pre_ = false; P8_DOTS(bufX, tt_, cur[tt_] >> 3); cur[tt_] += 8; } }
        if ((skip & 1) == 0) {
        if (0 < __builtin_amdgcn_readlane(offv[0], 1)) P8_ISSUE(bufA, ut, 0, 0);
#pragma unroll 1
        for (int r = 0; r < NPART; ++r) {
            P8_STEP_A(0, bufA, bufB, r) P8_STEP_A(1, bufB, bufA, r) P8_STEP_A(2, bufA, bufB, r) P8_STEP_A(3, bufB, bufA, r)
            P8_STEP_A(4, bufA, bufB, r) P8_STEP_A(5, bufB, bufA, r) P8_STEP_A(6, bufA, bufB, r) P8_STEP_A(7, bufB, bufA, r)
        } }
#undef P8_STEP_A
#undef P8_DOTS
    }
    { float su0[TPW], su1[TPW], sv0[TPW], sv1[TPW];
#pragma unroll
      for (int tt = 0; tt < TPW; ++tt) { const unsigned e0 = es[tt] & 0xffffu, e1 = es[tt] >> 16; su0[tt] = su[e0]; su1[tt] = su[e1]; sv0[tt] = sv[e0]; sv1[tt] = sv[e1]; }
#pragma unroll
      for (int tt = 0; tt < TPW; ++tt) {
        gs[tt][0] = gelu_erf((float)hidv[tt][0] * (shs[tt] * su0[tt])) * gs[tt][0] * sv0[tt];
        gs[tt][1] = gelu_erf((float)hidv[tt][1] * (shs[tt] * su1[tt])) * gs[tt][1] * sv1[tt]; } }
    typedef _Float16 f16x2 __attribute__((ext_vector_type(2)));
    f16x2 yh[TPW][8];
#pragma unroll
    for (int tt = 0; tt < TPW; ++tt) {
#pragma unroll
        for (int i = 0; i < 8; ++i) yh[tt][i] = (f16x2){(_Float16)0.f, (_Float16)0.f}; }
    {
        u32x4 bufA[8], bufB[8];
#define BF8ACC(tok, a, word, j) { const unsigned _w = (word); const unsigned _h02 = __builtin_amdgcn_perm(0u, _w, 0x020c000cu), _h13 = __builtin_amdgcn_perm(0u, _w, 0x030c010cu); \
                          yh[tok][2 * (j)] = __builtin_elementwise_fma(__builtin_bit_cast(f16x2, _h02), (a), yh[tok][2 * (j)]); yh[tok][2 * (j) + 1] = __builtin_elementwise_fma(__builtin_bit_cast(f16x2, _h13), (a), yh[tok][2 * (j) + 1]); }
#define P8_ACC(buf, tok, bb) do { _Pragma("unroll") for (int k2 = 0; k2 < 4; ++k2) { \
            const _Float16 h0_ = (_Float16)__int_as_float(__builtin_amdgcn_readlane(__float_as_int(gs[tok][0]), 4 * (bb) + k2)), h1_ = (_Float16)__int_as_float(__builtin_amdgcn_readlane(__float_as_int(gs[tok][1]), 4 * (bb) + k2)); \
            const f16x2 a0_ = (f16x2){h0_, h0_}, a1_ = (f16x2){h1_, h1_}; \
            BF8ACC(tok, a0_, buf[2 * k2].x, 0) BF8ACC(tok, a0_, buf[2 * k2].y, 1) BF8ACC(tok, a0_, buf[2 * k2].z, 2) BF8ACC(tok, a0_, buf[2 * k2].w, 3) \
            BF8ACC(tok, a1_, buf[2 * k2 + 1].x, 0) BF8ACC(tok, a1_, buf[2 * k2 + 1].y, 1) BF8ACC(tok, a1_, buf[2 * k2 + 1].z, 2) BF8ACC(tok, a1_, buf[2 * k2 + 1].w, 3) __builtin_amdgcn_sched_barrier(0); } } while (0)
        int cur[TPW];
#pragma unroll
        for (int tt = 0; tt < TPW; ++tt) cur[tt] = 0;
#define P8_STEP_B(tt_, bufX, bufY, r_) { const int end_ = __builtin_amdgcn_readlane(offv[tt_], (r_) + 1); \
            { constexpr int tn_ = ((tt_) + 1) % TPW; const int rn_ = (r_) + ((tt_) + 1) / TPW; \
              if (rn_ < NPART && cur[tn_] < __builtin_amdgcn_readlane(offv[tn_], rn_ + 1)) P8_ISSUE(bufY, vt, tn_, cur[tn_] >> 3); } \
            __builtin_amdgcn_sched_barrier(0); \
            bool pre_ = true; \
            while (cur[tt_] < end_) { if (!pre_) P8_ISSUE(bufX, vt, tt_, cur[tt_] >> 3); pre_ = false; P8_ACC(bufX, tt_, cur[tt_] >> 3); cur[tt_] += 8; } }
        if ((skip & 2) == 0) {
        if (0 < __builtin_amdgcn_readlane(offv[0], 1)) P8_ISSUE(bufA, vt, 0, 0);
#pragma unroll 1
        for (int r = 0; r < NPART; ++r) {
            P8_STEP_B(0, bufA, bufB, r) P8_STEP_B(1, bufB, bufA, r) P8_STEP_B(2, bufA, bufB, r) P8_STEP_B(3, bufB, bufA, r)
            P8_STEP_B(4, bufA, bufB, r) P8_STEP_B(5, bufB, bufA, r) P8_STEP_B(6, bufA, bufB, r) P8_STEP_B(7, bufB, bufA, r)
        } }
#undef P8_STEP_B
#undef P8_ACC
#undef BF8ACC
    }
#undef P8_ISSUE
    u32x2 xw[TPW][4]; f32x4 g2v[4], lgv[4], lbv[4];
#pragma unroll
    for (int tt = 0; tt < TPW; ++tt)
#pragma unroll
        for (int j = 0; j < 4; ++j) xw[tt][j] = *(const u32x2*)(x1 + (size_t)(t0 + tt) * DM + 256 * j + 4 * lane);
#pragma unroll
    for (int j = 0; j < 4; ++j) { const int d = 256 * j + 4 * lane; g2v[j] = *(const f32x4*)(mod + b * 6144 + 5120 + d) + 1.0f; lgv[j] = *(const f32x4*)(F.ln2_g + d); lbv[j] = *(const f32x4*)(F.ln2_b + d); }
#pragma unroll
    for (int tt = 0; tt < TPW; ++tt) { const size_t t = (size_t)(t0 + tt);
        f32x4 v[4]; float s = 0.f;
#pragma unroll
        for (int j = 0; j < 4; ++j) { const u32x2 xv = xw[tt][j];
            const f32x4 xf = (f32x4){bf_lo(xv.x), bf_hi(xv.x), bf_lo(xv.y), bf_hi(xv.y)}; const f32x4 yy = (f32x4){(float)yh[tt][2 * j].x, (float)yh[tt][2 * j + 1].x, (float)yh[tt][2 * j].y, (float)yh[tt][2 * j + 1].y};
            v[j] = xf * DN_ALPHA + g2v[j] * yy; s += (v[j][0] + v[j][1]) + (v[j][2] + v[j][3]); }
        const float mean = wave_sum(s) * (1.f / DM); float qq = 0.f;
#pragma unroll
        for (int j = 0; j < 4; ++j) { v[j] = v[j] - mean; qq += (v[j][0] * v[j][0] + v[j][1] * v[j][1]) + (v[j][2] * v[j][2] + v[j][3] * v[j][3]); }
        const float rstd = 1.0f / sqrtf(wave_sum(qq) * (1.f / DM) + LN_EPS);
#pragma unroll
        for (int j = 0; j < 4; ++j) { const int d = 256 * j + 4 * lane;
            *(f32x4*)(F.out + t * DM + d) = v[j] * rstd * lgv[j] + lbv[j]; } }
    }
}
#ifndef PROBE_PARTS
#define PROBE_PARTS 0xff
#endif
#ifndef MK_N_LAUNCHES
#define MK_N_LAUNCHES 1
#endif
constexpr int N_PHASES = 9;
struct Args { const float* in[18]; float* out; unsigned char* ws; int ph_lo, ph_hi, p0_parts, pad; };
__global__ void __launch_bounds__(NTHREADS, 2) fwd_kernel(Args args) {
    extern __shared__ __attribute__((aligned(16))) unsigned char lds[];
    Frame F;
    F.lds = (LAS unsigned char*)lds;
    F.tid = threadIdx.x; F.lane = F.tid & 63; F.wave = __builtin_amdgcn_readfirstlane(F.tid >> 6);
    F.G = gridDim.x; { const int bx = blockIdx.x; F.vcu = (F.G % 8 == 0) ? (bx % 8) * (F.G / 8) + bx / 8 : bx; }
    F.x = args.in[0]; F.c = args.in[1]; F.w_ada = args.in[2]; F.b_ada = args.in[3]; F.w_in = args.in[4]; F.sinks = args.in[5]; F.w_pool = args.in[6]; F.pool_scale = args.in[7];
    F.w_out = args.in[8]; F.ln1_g = args.in[9]; F.ln1_b = args.in[10]; F.w_pq = args.in[11]; F.k1 = args.in[12]; F.k2 = args.in[13]; F.pu = args.in[14]; F.pv = args.in[15];
    F.ln2_g = args.in[16]; F.ln2_b = args.in[17]; F.out = args.out; F.ws = args.ws;
    volatile LAS unsigned* MISC = (volatile LAS unsigned*)(F.lds + MISC_OFF);
    for (int u = F.tid; u < (LDS_BYTES - LDSCTL_OFF) / 4; u += NTHREADS) ((LAS unsigned*)(F.lds + LDSCTL_OFF))[u] = 0u;
    __syncthreads();
    const int lo = args.ph_lo, hi = args.ph_hi;
    XcdBarrier bar; bar.bar = (unsigned*)(F.ws + WS_CTL) + CW_BAR; bar.x = 0; bar.st = nullptr;
    if (hi - lo > 1) bar = xcd_barrier_post((unsigned*)(F.ws + WS_CTL) + CW_BAR, MISC + 8);
#ifndef PH_MASK
#define PH_MASK 0x1ff
#endif
#define IN(k) (((PH_MASK >> (k)) & 1) && lo <= (k) && (k) < hi)
#define SEAM(k) do { if (IN(k) && IN((k) + 1)) xcd_barrier(bar); } while (0)
#ifndef REP_MASK
#define REP_MASK 0
#endif
#ifndef REP_CNT
#define REP_CNT 4
#endif
#define REPS(k) (((REP_MASK >> (k)) & 1) * REP_CNT)
#define PHASE_NS(k, ...) if (IN(k)) { _Pragma("unroll 1") for (int _r = 0; _r <= REPS(k); ++_r) { __VA_ARGS__; if (_r < REPS(k)) xcd_barrier(bar); } }
#define PHASE(k, ...) if (IN(k)) { _Pragma("unroll 1") for (int _r = 0; _r <= REPS(k); ++_r) { __VA_ARGS__; if (_r < REPS(k)) xcd_barrier(bar); } } SEAM(k)
#ifndef P0_SUB
#define P0_SUB 0xff
#endif
    PHASE(0, p0_prologue(F, args.p0_parts));
    PHASE(2, { pg8::Gemm g{(const pg8::bf16_t*)(F.ws + WS_XN8), (const pg8::bf16_t*)(F.ws + WS_WIN), TT, NIN, DM / 2, 32, (size_t)NIN * DM, 0x79797979, 0x7F7F7F7F};    pg8::StaticOrder S; S.init(TT, NIN, F.G, (int)blockIdx.x);
            pg8::EpiRope E{(pg8::bf16_t*)(F.ws + WS_PROJ), NIN, (const float*)(F.ws + WS_ROPE), QSCALE, (const float*)(F.ws + WS_BIAS)};
            pg8::gemm_phase<pg8::EpiRope, pg8::StaticOrder, true, true, true>(F.lds, g, S, E);
            if ((args.p0_parts & 0x80) && (int)blockIdx.x >= 320 - F.G) p2_tables(F, ((int)blockIdx.x - (320 - F.G)) * NWAVES + F.wave, (2 * F.G - 320) * NWAVES, 0, 2 * NEXP); });
    PHASE(3, { for (int u = F.vcu; u < 256; u += F.G) p3_attn_unit(F, u);
               for (int u = F.vcu; u < 256; u += F.G) p3_pool_unit(F, u); });
    PHASE(4, { pg8::Gemm g{(const pg8::bf16_t*)(F.ws + WS_A2), (const pg8::bf16_t*)(F.ws + WS_WOUT), TT, DM, DM / 2, 1 << 30, 0, 0x79797979, 0x7B7B7B7B}; pg8::StaticOrder S; S.init(TT, DM, F.G, (int)blockIdx.x);
            pg8::EpiPlain E{(pg8::bf16_t*)(F.ws + WS_MIX), DM};
            pg8::gemm_phase<pg8::EpiPlain, pg8::StaticOrder, true, true, true>(F.lds, g, S, E); });
    PHASE(5, p5_ln1(F));
    PHASE_NS(6, { pg8::Gemm g{(const pg8::bf16_t*)(F.ws + WS_H2), (const pg8::bf16_t*)(F.ws + WS_WPQ), TT, NQD, DM, 1 << 30, 0, 0, 0}; pg8::StaticOrder S; S.init(TT, NQD, F.G, (int)blockIdx.x);
            pg8::EpiPlain E{(pg8::bf16_t*)(F.ws + WS_Q), NQD};
            pg8::gemm_phase<pg8::EpiPlain, pg8::StaticOrder, true, true>(F.lds, g, S, E); });
    if (IN(6) && IN(7)) { asm volatile("s_waitcnt vmcnt(0)" ::: "memory"); __syncthreads(); }
    PHASE(7, p7_route(F));
#ifndef P8_FAKE
#define P8_FAKE 0xffffu
#endif
#ifndef P8_SKIP
#define P8_SKIP 0
#endif
    PHASE(8, p8_peer(F, _r == REPS(8) ? 0xffffu : P8_FAKE, _r == REPS(8) ? 0 : P8_SKIP));
#undef IN
#undef SEAM
}

extern "C" void kernel_launch(void* const* d_in, const int* in_sizes, int n_in, void* d_out, int out_size, void* d_ws, size_t ws_size, hipStream_t stream) {
    static int grid = 0;
    if (grid == 0) {
        if (n_in != 18 || out_size != TT * DM || ws_size < WS_END) { fprintf(stderr, "kernel_launch: unexpected shapes (n_in %d out %d ws %zu)\n", n_in, out_size, ws_size); grid = -1; return; }
        int dev = 0, cus = 0, per_cu = 0;
        if (hipGetDevice(&dev) != hipSuccess || hipDeviceGetAttribute(&cus, hipDeviceAttributeMultiprocessorCount, dev) != hipSuccess) { grid = -1; return; }
        if (hipFuncSetAttribute((const void*)fwd_kernel, hipFuncAttributeMaxDynamicSharedMemorySize, LDS_BYTES) != hipSuccess) { fprintf(stderr, "kernel_launch: hipFuncSetAttribute failed\n"); grid = -1; return; }
        if (hipOccupancyMaxActiveBlocksPerMultiprocessor(&per_cu, (const void*)fwd_kernel, NTHREADS, LDS_BYTES) != hipSuccess || per_cu < 1) { fprintf(stderr, "kernel_launch: occupancy query says %d blocks per CU\n", per_cu); }
        (void)hipGetLastError();
        grid = cus;
        if (grid != 256) fprintf(stderr, "kernel_launch: built for 256 CUs, got %d\n", grid);
    }
    if (grid < 0) return;
    (void)hipMemsetAsync((char*)d_ws + WS_CTL, 0, CTL_ZERO_BYTES, stream);
    Args a{};
    for (int i = 0; i < 18; ++i) a.in[i] = (const float*)d_in[i];
    a.out = (float*)d_out; a.ws = (unsigned char*)d_ws; a.p0_parts = 0xff;
#if MK_N_LAUNCHES == 1
    a.ph_lo = 0; a.ph_hi = N_PHASES;
    hipLaunchKernelGGL(fwd_kernel, dim3(grid), dim3(NTHREADS), LDS_BYTES, stream, a);
#ifdef PROBE_PHASE
    for (int i = 0; i < PROBE_N; ++i) { a.ph_lo = PROBE_PHASE; a.ph_hi = PROBE_PHASE + 1; a.p0_parts = PROBE_PARTS; hipLaunchKernelGGL(fwd_kernel, dim3(grid), dim3(NTHREADS), LDS_BYTES, stream, a); }
#endif
#else
    for (int p = 0; p < N_PHASES; ++p) { a.ph_lo = p; a.ph_hi = p + 1; hipLaunchKernelGGL(fwd_kernel, dim3(grid), dim3(NTHREADS), LDS_BYTES, stream, a); }
#endif
}
```

```cpp
#include <hip/hip_runtime.h>
#include <cstdio>
#include <cstdint>
#include <cmath>
namespace pg8 {
#define PG8_LAS __attribute__((address_space(3)))
typedef unsigned short bf16_t;
typedef short bf16x8 __attribute__((ext_vector_type(8)));
typedef float f32x4 __attribute__((ext_vector_type(4)));
typedef unsigned u32x4 __attribute__((ext_vector_type(4)));
constexpr int BM = 256, BK = 64, HALF = 128, HTB = HALF * BK * 2  , STAGE_BYTES = 8 * HTB, NXCD = 8, WGM = 8;

__host__ __device__ __forceinline__ int lds_byte(int r, int c) { const int st = (r >> 4) * 2 + (c >> 5), rr = r & 15, cc = c & 31, ob = rr * 64 + cc * 2; return st * 1024 + (ob ^ (((ob >> 9) & 1) << 5)); }
__host__ __device__ __forceinline__ void stage_rc(int b, int& R, int& C) { const int st = b / 1024, sb = b % 1024, swz = sb ^ (((sb >> 9) & 1) << 5); R = (st >> 1) * 16 + swz / 64; C = (st & 1) * 32 + (swz % 64) / 2; }
__host__ __device__ __forceinline__ int perm32(int rho) { const int n = rho >> 4, i = rho & 15; return 8 * (i >> 2) + 4 * n + (i & 3); }

struct Unit { int pm, pn; };
struct Gemm { const bf16_t* A; const bf16_t* Bt; int M, N, K; int bsplit; size_t bstride; int sc_w, sc_x; };

struct StaticOrder {
    int nM, nN, nwg, G, c;
    __host__ __device__ void init(int M, int N, int G_, int c_) { nM = M / BM; nN = N / BM; nwg = nM * nN; G = G_; c = c_; }
    __host__ __device__ bool next(int i, Unit& u) const {
        const long L = (long)i * G + c; if (L >= nwg) return false;
        int wgid = (int)L; { const int q = nwg / NXCD, r = nwg % NXCD, xcd = wgid % NXCD, off = wgid / NXCD; wgid = (xcd < r ? xcd * (q + 1) : r * (q + 1) + (xcd - r) * q) + off; }
        const int nig = WGM * nN, gid = wgid / nig, fm = gid * WGM, gsz = (nM - fm) < WGM ? (nM - fm) : WGM;
        u.pm = fm + ((wgid % nig) % gsz); u.pn = (wgid % nig) / gsz; return true;
    }
    __device__ __forceinline__ void a_ready(const Unit&) const {}
    __device__ __forceinline__ void done(const Unit&) const {}
};

__device__ __forceinline__ unsigned cvt_pk_bf16(float lo, float hi) { unsigned r; asm volatile("v_cvt_pk_bf16_f32 %0, %1, %2" : "=v"(r) : "v"(lo), "v"(hi)); return r; }

struct EpiPlain {
    static constexpr bool PERM = true, AFTER_DRAIN = false;
    bf16_t* O; int ldc;
    __device__ __forceinline__ void operator()(const f32x4 (&acc)[2][2][4][2], const Unit& u, int wr, int wc, int fr, int fq) const {
        const int row0 = u.pm * BM + wr * 64 + fr; const int col0 = u.pn * BM + wc * 32 + 8 * fq;
#pragma unroll
        for (int ai = 0; ai < 2; ++ai)
#pragma unroll
            for (int m = 0; m < 4; ++m) { bf16_t* rowp = O + (size_t)(row0 + ai * HALF + m * 16) * ldc + col0;
#pragma unroll
                for (int bj = 0; bj < 2; ++bj) { const f32x4 v0 = acc[ai][bj][m][0], v1 = acc[ai][bj][m][1];
                    u32x4 w; w.x = cvt_pk_bf16(v0[0], v0[1]); w.y = cvt_pk_bf16(v0[2], v0[3]); w.z = cvt_pk_bf16(v1[0], v1[1]); w.w = cvt_pk_bf16(v1[2], v1[3]);
                    *(u32x4*)(rowp + bj * HALF) = w; } }
    }
};
struct EpiRope {
    static constexpr bool PERM = true, AFTER_DRAIN = false;
    bf16_t* O; int ldc; const float* rope; float qscale; const float* bias;
    __device__ __forceinline__ void operator()(const f32x4 (&acc)[2][2][4][2], const Unit& u, int wr, int wc, int fr, int fq) const {
        const int row0 = u.pm * BM + wr * 64 + fr; const int col0 = u.pn * BM + wc * 32 + 8 * fq;
#pragma unroll
        for (int ai = 0; ai < 2; ++ai)
#pragma unroll
            for (int m = 0; m < 4; ++m) { const int row = row0 + ai * HALF + m * 16; bf16_t* rowp = O + (size_t)row * ldc + col0; const int pos = row & 8191;
#pragma unroll
                for (int bj = 0; bj < 2; ++bj) { const float* bp = bias + (size_t)(row >> 13) * ldc + col0 + bj * HALF;
                    f32x4 v0 = acc[ai][bj][m][0] + *(const f32x4*)bp, v1 = acc[ai][bj][m][1] + *(const f32x4*)(bp + 4);
                    const int colt = u.pn * BM + bj * HALF;
                    if (colt < 640) {
                        const int c = col0 + bj * HALF, ib = (c & 63) >> 1;
                        const f32x4 cs0 = *(const f32x4*)(rope + ((size_t)pos * 32 + ib) * 2), cs1 = *(const f32x4*)(rope + ((size_t)pos * 32 + ib) * 2 + 4);
                        const float sc = colt < 512 ? qscale : 1.0f;
                        f32x4 r0, r1;
                        r0[0] = (v0[0] * cs0[0] - v0[1] * cs0[1]) * sc; r0[1] = (v0[1] * cs0[0] + v0[0] * cs0[1]) * sc;
                        r0[2] = (v0[2] * cs0[2] - v0[3] * cs0[3]) * sc; r0[3] = (v0[3] * cs0[2] + v0[2] * cs0[3]) * sc;
                        r1[0] = (v1[0] * cs1[0] - v1[1] * cs1[1]) * sc; r1[1] = (v1[1] * cs1[0] + v1[0] * cs1[1]) * sc;
                        r1[2] = (v1[2] * cs1[2] - v1[3] * cs1[3]) * sc; r1[3] = (v1[3] * cs1[2] + v1[2] * cs1[3]) * sc;
                        v0 = r0; v1 = r1;
                    }
                    u32x4 w; w.x = cvt_pk_bf16(v0[0], v0[1]); w.y = cvt_pk_bf16(v0[2], v0[3]); w.z = cvt_pk_bf16(v1[0], v1[1]); w.w = cvt_pk_bf16(v1[2], v1[3]);
                    *(u32x4*)(rowp + bj * HALF) = w; } }
    }
};

template <class Epi, class Sched, bool ALIGN_EPI = false, bool SP2 = false, bool FP8 = false>
__device__ __forceinline__ void gemm_phase(PG8_LAS unsigned char* lds, const Gemm g, const Sched& S, const Epi& E) {
    typedef int pg8_i32x4 __attribute__((ext_vector_type(4))); typedef int pg8_frag __attribute__((ext_vector_type(8)));
    const int tid = threadIdx.x, wid = __builtin_amdgcn_readfirstlane(tid >> 6), lane = tid & 63, wr = wid >> 2, wc = wid & 3, fr = lane & 15, fq = lane >> 4;
    const int K = g.K, nt = K / BK;
    unsigned voffA[2], voffB[2];
#pragma unroll
    for (int i = 0; i < 2; ++i) { int R, C; stage_rc(tid * 16 + i * 8192, R, C); const int Rb = Epi::PERM ? ((R & ~31) + perm32(R & 31)) : R;
        voffA[i] = (unsigned)(R * K + C) * 2u; voffB[i] = (unsigned)(Rb * K + C) * 2u; }
    const size_t kstep = (size_t)(BK * 2);
    const size_t hstep = (size_t)HALF * K * 2;
    const size_t tstep = 2 * hstep;
    const unsigned ldsw = (unsigned)wid * 1024u;
    const int aoff = lds_byte(wr * 64 + fr, fq * 8), boff = lds_byte(wc * 32 + fr, fq * 8);
#define PG8_SA(b, h) (((b) * 2 + (h)) * HTB)
#define PG8_SB(b, h) ((4 + (b) * 2 + (h)) * HTB)
#define PG8_STAGE(bufoff, gbase, voff) do { _Pragma("unroll") for (int _i = 0; _i < 2; ++_i) \
        __builtin_amdgcn_global_load_lds((const unsigned*)((const char*)(gbase) + (voff)[_i]), (PG8_LAS unsigned*)(lds + (bufoff) + ldsw + _i * 8192), 16, 0, 0); } while (0)
#define PG8_LDA(dst, b, h) do { _Pragma("unroll") for (int m = 0; m < 4; ++m) { const pg8_i32x4 l0_ = *(const PG8_LAS pg8_i32x4*)(lds + PG8_SA(b, h) + aoff + m * 2048), l1_ = *(const PG8_LAS pg8_i32x4*)(lds + PG8_SA(b, h) + aoff + m * 2048 + 1024); dst[m] = __builtin_shufflevector(l0_, l1_, 0, 1, 2, 3, 4, 5, 6, 7); } } while (0)
#define PG8_LDB(dst, b, h) do { _Pragma("unroll") for (int n = 0; n < 2; ++n) { const pg8_i32x4 l0_ = *(const PG8_LAS pg8_i32x4*)(lds + PG8_SB(b, h) + boff + n * 2048), l1_ = *(const PG8_LAS pg8_i32x4*)(lds + PG8_SB(b, h) + boff + n * 2048 + 1024); dst[n] = __builtin_shufflevector(l0_, l1_, 0, 1, 2, 3, 4, 5, 6, 7); } } while (0)
#define PG8_H0(f) __builtin_bit_cast(bf16x8, __builtin_shufflevector((f), (f), 0, 1, 2, 3))
#define PG8_H1(f) __builtin_bit_cast(bf16x8, __builtin_shufflevector((f), (f), 4, 5, 6, 7))
#define PG8_MMA(ai, bj, At, Bt) do { __builtin_amdgcn_s_setprio(1); \
        if constexpr (FP8) { _Pragma("unroll") for (int m = 0; m < 4; ++m) _Pragma("unroll") for (int n = 0; n < 2; ++n) \
            asm volatile("v_mfma_scale_f32_16x16x128_f8f6f4 %0, %1, %2, %0, %3, %4 op_sel_hi:[0,0,0]" : "+v"(acc[ai][bj][m][n]) : "v"(Bt[n]), "v"(At[m]), "v"(scw_), "v"(scx_)); } \
        else { _Pragma("unroll") for (int m = 0; m < 4; ++m) _Pragma("unroll") for (int n = 0; n < 2; ++n) { \
            acc[ai][bj][m][n] = __builtin_amdgcn_mfma_f32_16x16x32_bf16(PG8_H0(Bt[n]), PG8_H0(At[m]), acc[ai][bj][m][n], 0, 0, 0); \
            acc[ai][bj][m][n] = __builtin_amdgcn_mfma_f32_16x16x32_bf16(PG8_H1(Bt[n]), PG8_H1(At[m]), acc[ai][bj][m][n], 0, 0, 0); } } \
        __builtin_amdgcn_s_setprio(0); } while (0)
#define PG8_WAIT_V(n) asm volatile("s_waitcnt vmcnt(" #n ")" ::: "memory")
#define PG8_WAIT_L(n) asm volatile("s_waitcnt lgkmcnt(" #n ")" ::: "memory")
#define PG8_BAR __builtin_amdgcn_s_barrier()
#define PG8_SCHED __builtin_amdgcn_sched_barrier(0)
    Unit cur, nxt; int ui = 0;
    if (!S.next(0, cur)) return;
    f32x4 acc[2][2][4][2];
#pragma unroll
    for (int a = 0; a < 2; ++a)
#pragma unroll
        for (int b = 0; b < 2; ++b)
#pragma unroll
            for (int m = 0; m < 4; ++m)
#pragma unroll
                for (int n = 0; n < 2; ++n) acc[a][b][m][n] = (f32x4){0.f, 0.f, 0.f, 0.f};
    pg8_frag At[4], B0[2], B1[2]; const int scw_ = g.sc_w, scx_ = g.sc_x;
    const char* cA = (const char*)g.A + (size_t)cur.pm * tstep; const char* cB = (const char*)g.Bt + (size_t)cur.pn * tstep + (cur.pm >= g.bsplit ? g.bstride : (size_t)0);
    S.a_ready(cur);
    if constexpr (SP2) {
        PG8_STAGE(PG8_SB(0, 0), cB, voffB); PG8_STAGE(PG8_SB(0, 1), cB + hstep, voffB); PG8_STAGE(PG8_SA(0, 0), cA, voffA); PG8_STAGE(PG8_SA(0, 1), cA + hstep, voffA);
        if (wr == 1) PG8_BAR;
        PG8_WAIT_V(2); PG8_BAR;
        PG8_STAGE(PG8_SB(1, 0), cB + kstep, voffB); PG8_STAGE(PG8_SA(1, 0), cA + kstep, voffA); PG8_STAGE(PG8_SB(1, 1), cB + hstep + kstep, voffB);
        PG8_WAIT_V(6); PG8_BAR;
    } else {
        PG8_STAGE(PG8_SB(0, 0), cB, voffB); PG8_STAGE(PG8_SA(0, 0), cA, voffA); PG8_STAGE(PG8_SB(0, 1), cB + hstep, voffB); PG8_STAGE(PG8_SA(0, 1), cA + hstep, voffA);
        if (wr == 1) PG8_BAR;
        PG8_WAIT_V(4); PG8_BAR;
        PG8_STAGE(PG8_SB(1, 0), cB + kstep, voffB); PG8_STAGE(PG8_SA(1, 0), cA + kstep, voffA); PG8_STAGE(PG8_SB(1, 1), cB + hstep + kstep, voffB);
        PG8_WAIT_V(6); PG8_BAR;
    }
    for (;;) {
        const bool has_next = S.next(ui + 1, nxt);
        const char* nA = has_next ? (const char*)g.A + (size_t)nxt.pm * tstep : cA; const char* nB = has_next ? (const char*)g.Bt + (size_t)nxt.pn * tstep + (nxt.pm >= g.bsplit ? g.bstride : (size_t)0) : cB;
        _Pragma("unroll 1") for (int t = 0; t < nt; t += 2) {
            const bool last = (t == nt - 2);
            const char* a1 = cA + (size_t)(t + 1) * kstep;
            const char* a2 = last ? nA : cA + (size_t)(t + 2) * kstep; const char* b2 = last ? nB : cB + (size_t)(t + 2) * kstep;
            const char* a3 = a2 + kstep; const char* b3 = b2 + kstep;
            if (last && has_next) S.a_ready(nxt);
            if constexpr (SP2) {
            PG8_LDB(B0, 0, 0); PG8_LDB(B1, 0, 1); PG8_SCHED; PG8_LDA(At, 0, 0); PG8_STAGE(PG8_SA(1, 1), a1 + hstep, voffA);
            PG8_WAIT_V(8); PG8_WAIT_L(0); PG8_BAR; PG8_MMA(0, 0, At, B0); PG8_MMA(0, 1, At, B1); PG8_BAR; PG8_SCHED;
            PG8_LDA(At, 0, 1); PG8_STAGE(PG8_SB(0, 0), b2, voffB); PG8_STAGE(PG8_SB(0, 1), b2 + hstep, voffB); PG8_STAGE(PG8_SA(0, 0), a2, voffA);
            PG8_WAIT_V(8); PG8_WAIT_L(0); PG8_BAR; PG8_MMA(1, 0, At, B0); PG8_MMA(1, 1, At, B1); PG8_BAR; PG8_SCHED;
            PG8_LDB(B0, 1, 0); PG8_LDB(B1, 1, 1); PG8_SCHED; PG8_LDA(At, 1, 0); PG8_STAGE(PG8_SA(0, 1), a2 + hstep, voffA);
            PG8_WAIT_V(8); PG8_WAIT_L(0); PG8_BAR; PG8_MMA(0, 0, At, B0); PG8_MMA(0, 1, At, B1); PG8_BAR; PG8_SCHED;
            PG8_LDA(At, 1, 1); PG8_STAGE(PG8_SB(1, 0), b3, voffB); PG8_STAGE(PG8_SB(1, 1), b3 + hstep, voffB); PG8_STAGE(PG8_SA(1, 0), a3, voffA);
            PG8_WAIT_V(8); PG8_WAIT_L(0); PG8_BAR; PG8_MMA(1, 0, At, B0); PG8_MMA(1, 1, At, B1); PG8_BAR; PG8_SCHED;
            } else {
            PG8_LDB(B0, 0, 0); PG8_SCHED; PG8_LDA(At, 0, 0); PG8_STAGE(PG8_SA(1, 1), a1 + hstep, voffA);
            PG8_WAIT_L(8); PG8_BAR; PG8_WAIT_L(0); PG8_MMA(0, 0, At, B0); PG8_BAR; PG8_SCHED;
            PG8_LDB(B1, 0, 1); PG8_STAGE(PG8_SB(0, 0), b2, voffB);
            PG8_BAR; PG8_WAIT_L(0); PG8_MMA(0, 1, At, B1); PG8_BAR;
            PG8_LDA(At, 0, 1); PG8_STAGE(PG8_SA(0, 0), a2, voffA);
            PG8_BAR; PG8_WAIT_L(0); PG8_MMA(1, 0, At, B0); PG8_BAR; PG8_SCHED;
            PG8_STAGE(PG8_SB(0, 1), b2 + hstep, voffB);
            PG8_WAIT_V(6); PG8_BAR; PG8_MMA(1, 1, At, B1); PG8_BAR;
            PG8_LDB(B0, 1, 0); PG8_SCHED; PG8_LDA(At, 1, 0); PG8_STAGE(PG8_SA(0, 1), a2 + hstep, voffA);
            PG8_WAIT_L(8); PG8_BAR; PG8_WAIT_L(0); PG8_MMA(0, 0, At, B0); PG8_BAR; PG8_SCHED;
            PG8_LDB(B1, 1, 1); PG8_STAGE(PG8_SB(1, 0), b3, voffB);
            PG8_BAR; PG8_WAIT_L(0); PG8_MMA(0, 1, At, B1); PG8_BAR;
            PG8_LDA(At, 1, 1); PG8_STAGE(PG8_SA(1, 0), a3, voffA);
            PG8_BAR; PG8_WAIT_L(0); PG8_MMA(1, 0, At, B0); PG8_BAR; PG8_SCHED;
            PG8_STAGE(PG8_SB(1, 1), b3 + hstep, voffB);
            PG8_WAIT_V(6); PG8_BAR; PG8_MMA(1, 1, At, B1); PG8_BAR;
            }
        }
        if constexpr (ALIGN_EPI) { if (wr == 0) PG8_BAR; }
        if constexpr (FP8) {
            asm volatile("s_nop 15\n\ts_nop 15" ::: "memory");
#pragma unroll
            for (int a = 0; a < 2; ++a)
#pragma unroll
                for (int b = 0; b < 2; ++b)
#pragma unroll
                    for (int m = 0; m < 4; ++m)
#pragma unroll
                        for (int n = 0; n < 2; ++n) asm volatile("" : "+v"(acc[a][b][m][n]));
        }
        if constexpr (!Epi::AFTER_DRAIN) { E(acc, cur, wr, wc, fr, fq); S.done(cur); }
        if (!has_next) break;
#pragma unroll
        for (int a = 0; a < 2; ++a)
#pragma unroll
            for (int b = 0; b < 2; ++b)
#pragma unroll
                for (int m = 0; m < 4; ++m)
#pragma unroll
                    for (int n = 0; n < 2; ++n) acc[a][b][m][n] = (f32x4){0.f, 0.f, 0.f, 0.f};
        cur = nxt; cA = nA; cB = nB; ++ui;
        if constexpr (ALIGN_EPI) { if (wr == 1) PG8_BAR; }
    }
    PG8_WAIT_V(0);
    if constexpr (!ALIGN_EPI) { if (wr == 0) PG8_BAR; }
    PG8_BAR;
    if constexpr (Epi::AFTER_DRAIN) { E.fused(acc, cur, wr, wc, fr, fq, lds, wid, lane); S.done(cur); }
#undef PG8_SA
#undef PG8_SB
#undef PG8_STAGE
#undef PG8_LDA
#undef PG8_LDB
#undef PG8_MMA
#undef PG8_H0
#undef PG8_H1
#undef PG8_WAIT_V
#undef PG8_WAIT_L
#undef PG8_BAR
#undef PG8_SCHED
}
}
#define GAS __attribute__((address_space(1)))
#define LAS __attribute__((address_space(3)))
typedef unsigned short bf16;
typedef unsigned v4u __attribute__((ext_vector_type(4)));
typedef float f32x4 __attribute__((ext_vector_type(4)));
typedef short bf16x8 __attribute__((ext_vector_type(8)));
typedef GAS unsigned gu32;
typedef GAS unsigned long long gu64;
#define RLX_AGENT __ATOMIC_RELAXED, __HIP_MEMORY_SCOPE_AGENT
#define LDS_WAIT() asm volatile("s_waitcnt lgkmcnt(0)" ::: "memory")
#define VM_WAIT() asm volatile("s_waitcnt vmcnt(0)" ::: "memory")
__device__ __forceinline__ unsigned long long rt() { return __builtin_amdgcn_s_memrealtime(); }
__device__ __forceinline__ unsigned f2bf(float f) { unsigned u = __builtin_bit_cast(unsigned, f); return (u + 0x7fffu + ((u >> 16) & 1u)) >> 16; }
__device__ __forceinline__ unsigned pk2(float lo, float hi) { return f2bf(lo) | (f2bf(hi) << 16); }
#define XB_TMO      128
#define XB_XCNT(j)  (256  + 64 * (j))
#define XB_XSUB(j)  (1280 + 64 * (j))
#define XB_XGEN(j)  (2304 + 64 * (j))
#define XB_TOP      3328
#define XB_TOPGEN   3392
#define XCD_BAR_WORDS 3456
#define XB_SPIN_CAP (1u << 18)

__device__ __forceinline__ unsigned xb_ld(unsigned* p)              { return __hip_atomic_load(p, __ATOMIC_RELAXED, __HIP_MEMORY_SCOPE_AGENT); }
__device__ __forceinline__ unsigned xb_add(unsigned* p, unsigned v) { return __hip_atomic_fetch_add(p, v, __ATOMIC_RELAXED, __HIP_MEMORY_SCOPE_AGENT); }
__device__ __forceinline__ unsigned xb_xcc_id() { return (unsigned)__builtin_amdgcn_s_getreg((3 << 11) | 20) & 0xFu; }
#define XB_SPIN(cond, bar) do { unsigned _sp = 0; while (cond) { __builtin_amdgcn_s_sleep(1); \
    if ((++_sp & 255u) == 0u) { if (xb_ld(&(bar)[XB_TMO])) break; if (_sp > XB_SPIN_CAP) { atomicAdd(&(bar)[XB_TMO], 1u); break; } } } } while (0)

struct XcdBarrier {
    unsigned* bar; unsigned x;
    volatile LAS unsigned* st;
};

__device__ __forceinline__ XcdBarrier xcd_barrier_post(unsigned* bar, volatile LAS unsigned* st) {
    XcdBarrier b; b.bar = bar; b.x = xb_xcc_id(); b.st = st;
    if (threadIdx.x == 0) (void)xb_add(&bar[XB_XCNT(b.x)], 1u);
    return b;
}
__device__ __forceinline__ void xcd_barrier_complete(unsigned* bar, unsigned x, unsigned& nloc, unsigned& nx) {
    const unsigned G = gridDim.x * gridDim.y * gridDim.z;
    unsigned sum, cnt, mine, sp = 0u;
    for (;;) {
        sum = 0u; cnt = 0u; mine = 0u;
#pragma unroll
        for (unsigned j = 0; j < 16; ++j) { const unsigned c = xb_ld(&bar[XB_XCNT(j)]); sum += c; cnt += (c > 0u) ? 1u : 0u; mine = (j == x) ? c : mine; }
        if (sum == G) break;
        __builtin_amdgcn_s_sleep(1);
        if ((++sp & 255u) == 0u) { if (xb_ld(&bar[XB_TMO])) break; if (sp > XB_SPIN_CAP) { atomicAdd(&bar[XB_TMO], 1u); break; } }
    }
    nloc = mine > 0u ? mine : 1u; nx = cnt > 0u ? cnt : 1u;
}

__device__ __forceinline__ void xcd_barrier(const XcdBarrier& b) {
    asm volatile("s_waitcnt vmcnt(0)" ::: "memory");
    __syncthreads();
    if (threadIdx.x == 0) {
        unsigned* bar = b.bar;
        __builtin_amdgcn_s_waitcnt(0);
        unsigned nloc = b.st[0], nx = b.st[1];
        if (nloc == 0u) { xcd_barrier_complete(bar, b.x, nloc, nx); b.st[0] = nloc; b.st[1] = nx; }
        const unsigned old = xb_add(&bar[XB_XSUB(b.x)], 1u);
        const unsigned gen = old / nloc;
        if (old + 1u == (gen + 1u) * nloc) {
            __builtin_amdgcn_fence(__ATOMIC_RELEASE, "agent");
            asm volatile("s_waitcnt vmcnt(0)" ::: "memory");
            const unsigned og = xb_add(&bar[XB_TOP], 1u);
            const unsigned tg = og / nx;
            if (og + 1u == (tg + 1u) * nx) xb_add(&bar[XB_TOPGEN], 1u);
            else XB_SPIN(xb_ld(&bar[XB_TOPGEN]) == tg, bar);
            __builtin_amdgcn_fence(__ATOMIC_ACQUIRE, "agent");
            xb_add(&bar[XB_XGEN(b.x)], 1u);
            asm volatile("s_waitcnt vmcnt(0)" ::: "memory");
        } else {
            XB_SPIN(xb_ld(&bar[XB_XGEN(b.x)]) == gen, bar);
            __builtin_amdgcn_fence(__ATOMIC_ACQUIRE, "agent");
            asm volatile("s_waitcnt vmcnt(0)" ::: "memory");
        }
    }
    __syncthreads();
}
constexpr int NWAVES = 8, NTHREADS = 512;
constexpr int TT = 16384, DM = 1024, SEQ = 8192, NIN = 1280, NQD = 2048, NEXP = 16384;
constexpr float DN_ALPHA = 1.189207115002721f;
constexpr float LN_EPS = 1e-5f;
constexpr float LOG2E = 1.4426950408889634f;
constexpr float QSCALE = 0.125f * LOG2E;

constexpr size_t MiB = 1u << 20;
constexpr size_t WS_CTL = 0, CTL_ZERO_BYTES = 64 * 1024;
constexpr size_t WS_MODP = 1 * MiB;
constexpr size_t WS_MOD = 1 * MiB + 896 * 1024;
constexpr size_t WS_ROPE = 2 * MiB;
constexpr size_t WS_WIN = 248 * MiB;
constexpr size_t WS_BIAS = 4 * MiB;
constexpr size_t WS_K1 = 6 * MiB + 512 * 1024, WS_K2 = WS_K1 + 32 * 1024;
constexpr size_t WS_WOUT = 7 * MiB;
constexpr size_t WS_WPQ = 9 * MiB;
constexpr size_t WS_SU = 13 * MiB, WS_SV = 13 * MiB + 65536;
constexpr size_t WS_U = 16 * MiB, WS_V = 32 * MiB;
constexpr size_t WS_H2Q = 48 * MiB, WS_SH = 13 * MiB + 131072;
constexpr size_t WS_XN8 = 64 * MiB;
constexpr size_t WS_XN = 80 * MiB;
constexpr size_t WS_MIX = 112 * MiB;
constexpr size_t WS_PE = 80 * MiB, WS_PG = 84 * MiB;
constexpr size_t WS_PROJ = 112 * MiB;
constexpr size_t WS_A2 = 152 * MiB;
constexpr size_t WS_X1 = 184 * MiB, WS_H2 = 216 * MiB;
constexpr size_t WS_Q = 112 * MiB;
constexpr size_t WS_END = 253 * MiB;
constexpr int CW_MODCNT = 1024;
constexpr int CW_BAR = 4096;

constexpr int RING_BYTES = 131072, LDSCTL_OFF = RING_BYTES, MISC_OFF = LDSCTL_OFF + 320, LDS_BYTES = 147456;

typedef float f32x16 __attribute__((ext_vector_type(16)));
typedef float f32x2 __attribute__((ext_vector_type(2)));
typedef unsigned u32x2 __attribute__((ext_vector_type(2)));
typedef unsigned u32x4 __attribute__((ext_vector_type(4)));
typedef __bf16 bf16x2_t __attribute__((ext_vector_type(2)));
struct Frame {
    LAS unsigned char* lds;
    int tid, lane, wave, vcu, G;
    const float *x, *c, *w_ada, *b_ada, *w_in, *sinks, *w_pool, *pool_scale, *w_out, *ln1_g, *ln1_b, *w_pq, *k1, *k2, *pu, *pv, *ln2_g, *ln2_b;
    float* out; unsigned char* ws;
};
__device__ __forceinline__ float wave_sum(float v) {
#pragma unroll
    for (int o = 1; o < 64; o <<= 1) v += __shfl_xor(v, o);
    return v;
}
__device__ __forceinline__ float bf_lo(unsigned u) { return __uint_as_float(u << 16); }
__device__ __forceinline__ float bf_hi(unsigned u) { return __uint_as_float(u & 0xffff0000u); }
__device__ __forceinline__ float bf2f(bf16 b) { return __uint_as_float((unsigned)b << 16); }
__device__ __forceinline__ unsigned fp8x4(float a, float b, float c, float d) { int pk = __builtin_amdgcn_cvt_pk_fp8_f32(a, b, 0, false); pk = __builtin_amdgcn_cvt_pk_fp8_f32(c, d, pk, true); return (unsigned)pk; }

template <int MODE, bool OUT8 = false>
__device__ __forceinline__ void transpose_item(const float* W, int ldw, bf16* WT, int ldt, int k0, int n0, LAS float* scr, int lane, const LAS float* ksc = nullptr, float oscale = 1.0f) {
    int nsrc = n0 + (lane & 31);
    if (MODE == 1 && nsrc < 640) { const int hd = nsrc >> 6, w = nsrc & 63; nsrc = hd * 64 + (w >> 1) + 32 * (w & 1); }
    float wv[32];
#pragma unroll
    for (int i = 0; i < 32; ++i) wv[i] = W[(size_t)(k0 + 2 * i + (lane >> 5)) * ldw + nsrc];
#pragma unroll
    for (int i = 0; i < 32; ++i) { const int kk = 2 * i + (lane >> 5); float w_ = wv[i]; if (MODE == 1) w_ *= ksc[k0 + kk]; scr[kk * 33 + (lane & 31)] = w_; }
    LDS_WAIT(); asm volatile("" ::: "memory");
    const int c = lane & 7;
#pragma unroll
    for (int j = 0; j < 4; ++j) { const int n = (lane >> 3) + 8 * j; const LAS float* s = scr + (8 * c) * 33 + n;
        if (OUT8) { u32x2 o8; o8.x = fp8x4(s[0 * 33] * oscale, s[1 * 33] * oscale, s[2 * 33] * oscale, s[3 * 33] * oscale); o8.y = fp8x4(s[4 * 33] * oscale, s[5 * 33] * oscale, s[6 * 33] * oscale, s[7 * 33] * oscale);
            *(u32x2*)((unsigned char*)WT + (size_t)(n0 + n) * ldt + k0 + 8 * c) = o8; }
        else { v4u o; o.x = pk2(s[0 * 33], s[1 * 33]); o.y = pk2(s[2 * 33], s[3 * 33]); o.z = pk2(s[4 * 33], s[5 * 33]); o.w = pk2(s[6 * 33], s[7 * 33]);
            *(GAS v4u*)(WT + (size_t)(n0 + n) * ldt + k0 + 8 * c) = o; } }
    LDS_WAIT(); asm volatile("" ::: "memory");
}
__device__ __forceinline__ void sincos_d(double a, float& s, float& c) {
    const double TWO_PI = 6.283185307179586476925, PI = 3.141592653589793238462643;
    double r = a - TWO_PI * rint(a / TWO_PI);
    double sg = 1.0;
    if (r > 0.5 * PI) { r = PI - r; sg = -1.0; } else if (r < -0.5 * PI) { r = -PI - r; sg = -1.0; }
    const double r2 = r * r;
    double sp = -1.0 / 121645100408832000.0;
    sp = sp * r2 + 1.0 / 355687428096000.0; sp = sp * r2 - 1.0 / 1307674368000.0; sp = sp * r2 + 1.0 / 6227020800.0; sp = sp * r2 - 1.0 / 39916800.0;
    sp = sp * r2 + 1.0 / 362880.0; sp = sp * r2 - 1.0 / 5040.0; sp = sp * r2 + 1.0 / 120.0; sp = sp * r2 - 1.0 / 6.0; sp = sp * r2 + 1.0;
    double cp = 1.0 / 6402373705728000.0;
    cp = cp * r2 - 1.0 / 20922789888000.0; cp = cp * r2 + 1.0 / 87178291200.0; cp = cp * r2 - 1.0 / 479001600.0; cp = cp * r2 + 1.0 / 3628800.0;
    cp = cp * r2 - 1.0 / 40320.0; cp = cp * r2 + 1.0 / 720.0; cp = cp * r2 - 1.0 / 24.0; cp = cp * r2 + 0.5; cp = 1.0 - cp * r2;
    s = (float)(sp * r); c = (float)(sg * cp);
}
__device__ __forceinline__ void p1_win(Frame& F);
__device__ __forceinline__ void p0_prologue(Frame& F, int parts = 0xff) {
    LAS float* scr = (LAS float*)(F.lds + F.wave * 16384);
    const int gw = F.vcu * NWAVES + F.wave, NGW = F.G * NWAVES, lane = F.lane;
    if ((parts & 1) && (int)blockIdx.x < 192) { const int gb = (int)blockIdx.x, chunk = gb % 96, kh = gb / 96, col = chunk * 64 + lane, kbase = kh * 512 + F.wave * 64; float a0 = 0.f, a1 = 0.f;
        LAS float* sl = (LAS float*)(F.lds + F.wave * 16384 + 8448);
        { const int k = kbase + lane; const float c0 = F.c[k], c1 = F.c[DM + k]; sl[lane] = c0 / (1.f + __expf(-c0)); sl[64 + lane] = c1 / (1.f + __expf(-c1)); }
        LDS_WAIT(); asm volatile("" ::: "memory");
        { float w[64];
#pragma unroll
            for (int u = 0; u < 64; ++u) w[u] = F.w_ada[(size_t)(kbase + u) * 6144 + col];
#pragma unroll
            for (int u = 0; u < 64; ++u) { a0 += sl[u] * w[u]; a1 += sl[64 + u] * w[u]; } }
        LAS float* red = (LAS float*)(F.lds + F.wave * 16384 + 12288); red[lane] = a0; red[64 + lane] = a1;
        __syncthreads();
        if (F.tid < 128) { const int bb = F.tid >> 6, l = F.tid & 63; float sacc = kh == 0 ? F.b_ada[chunk * 64 + l] : 0.f;
#pragma unroll
            for (int w = 0; w < 8; ++w) sacc += ((const LAS float*)(F.lds + w * 16384 + 12288))[bb * 64 + l];
            ((float*)(F.ws + WS_MODP))[(kh * 2 + bb) * 6144 + chunk * 64 + l] = sacc; }
        asm volatile("s_waitcnt vmcnt(0)" ::: "memory"); __syncthreads();
        if (F.tid == 0) { __builtin_amdgcn_fence(__ATOMIC_RELEASE, "agent"); asm volatile("s_waitcnt vmcnt(0)" ::: "memory");
            __hip_atomic_fetch_add((unsigned*)(F.ws + WS_CTL) + CW_MODCNT, 1u, __ATOMIC_RELAXED, __HIP_MEMORY_SCOPE_AGENT); } }
    if (parts & 2) { float* rope = (float*)(F.ws + WS_ROPE);
      for (int e = gw * 64 + lane; e < SEQ * 32; e += NGW * 64) { const int pos = e >> 5, i = e & 31;
          const float freq = powf(10000.0f, -(float)i / 32.0f); const float ang = (float)pos * freq; float s, c; sincos_d((double)ang, s, c);
          rope[2 * e] = c; rope[2 * e + 1] = s; } }
    if (parts & 4) { constexpr int I_PQ = 16 * 64, I_OUT = 8 * 32;
      for (int it = NGW - 1 - gw; it < I_PQ + I_OUT; it += NGW) { int r = it;
          if (r < I_PQ) { transpose_item<0>(F.w_pq, NQD, (bf16*)(F.ws + WS_WPQ), DM, 64 * (r / 64), 32 * (r % 64), scr, lane); continue; } r -= I_PQ;
          transpose_item<0, true>(F.w_out, DM, (bf16*)(F.ws + WS_WOUT), DM, 64 * (r / 32), 32 * (r % 32), scr, lane, nullptr, 64.0f); } }
    if (parts & 8) { unsigned char* wout_t = F.ws + WS_WOUT;
      for (int it = gw; it < 4 * 2 * 128; it += NGW) { const int g = it >> 8, ch = (it >> 7) & 1, n0 = (it & 127) * 8, cidx = ch * 64 + lane;
          const float* wo = F.w_out + (size_t)(512 + g * 128) * DM + n0; const float* ps = F.pool_scale + g * 128;
#pragma unroll
          for (int i = 0; i < 4; ++i) { const int f4 = lane + 64 * i, e = f4 >> 1, hf = f4 & 1; const f32x4 o = *(const f32x4*)(wo + (size_t)e * DM + 4 * hf) * ps[e]; *(LAS f32x4*)(scr + e * 8 + 4 * hf) = o; }
          float acc[8];
#pragma unroll
          for (int i = 0; i < 8; ++i) acc[i] = 0.f;
          const float* wp = F.w_pool + ((size_t)(g * 128 + cidx)) * 128;
          LDS_WAIT(); asm volatile("" ::: "memory");
#pragma unroll 1
          for (int e0 = 0; e0 < 128; e0 += 64) { f32x4 wv[16];
#pragma unroll
              for (int q = 0; q < 16; ++q) wv[q] = *(const f32x4*)(wp + e0 + 4 * q);
#pragma unroll
              for (int q = 0; q < 16; ++q)
#pragma unroll
                  for (int ee = 0; ee < 4; ++ee) { const float w = wv[q][ee]; const f32x4 o0 = *(const LAS f32x4*)(scr + (e0 + 4 * q + ee) * 8), o1 = *(const LAS f32x4*)(scr + (e0 + 4 * q + ee) * 8 + 4);
                      acc[0] += w * o0[0]; acc[1] += w * o0[1]; acc[2] += w * o0[2]; acc[3] += w * o0[3]; acc[4] += w * o1[0]; acc[5] += w * o1[1]; acc[6] += w * o1[2]; acc[7] += w * o1[3]; } }
#pragma unroll
          for (int i = 0; i < 8; ++i) wout_t[(size_t)(n0 + i) * DM + 512 + g * 128 + cidx] = (unsigned char)(fp8x4(acc[i] * 64.0f, 0.f, 0.f, 0.f) & 0xffu);
          LDS_WAIT(); asm volatile("" ::: "memory"); } }
    if (parts & 16) { bf16* k1b = (bf16*)(F.ws + WS_K1); bf16* k2b = (bf16*)(F.ws + WS_K2);
      for (int e = gw * 64 + lane; e < 128 * 128; e += NGW * 64) { k1b[e] = (bf16)f2bf(F.k1[e]); k2b[e] = (bf16)f2bf(F.k2[e]); } }
    if (parts & 32) { bf16* xn = (bf16*)(F.ws + WS_XN); const int rpw = TT / NGW;
      for (int m = gw * rpw; m < gw * rpw + rpw; m += 4) { f32x4 v[4][4];
#pragma unroll
          for (int q = 0; q < 4; ++q)
#pragma unroll
              for (int j = 0; j < 4; ++j) v[q][j] = *(const f32x4*)(F.x + (size_t)(m + q) * DM + 256 * j + 4 * lane);
#pragma unroll
          for (int q = 0; q < 4; ++q)
#pragma unroll
              for (int j = 0; j < 4; ++j) { u32x2 o; o.x = pk2(v[q][j][0], v[q][j][1]); o.y = pk2(v[q][j][2], v[q][j][3]); *(u32x2*)(xn + (size_t)(m + q) * DM + 256 * j + 4 * lane) = o;
                  *(unsigned*)(F.ws + WS_XN8 + (size_t)(m + q) * DM + 256 * j + 4 * lane) = fp8x4(v[q][j][0], v[q][j][1], v[q][j][2], v[q][j][3]); } } }
    if (parts & 64) {
        __syncthreads();
        if (F.tid == 0) { unsigned sp = 0; const unsigned* cnt = (const unsigned*)(F.ws + WS_CTL) + CW_MODCNT;
            while (__hip_atomic_load(cnt, __ATOMIC_RELAXED, __HIP_MEMORY_SCOPE_AGENT) < 192u) { __builtin_amdgcn_s_sleep(2); if (++sp > (1u << 22)) break; }
            __builtin_amdgcn_fence(__ATOMIC_ACQUIRE, "agent"); asm volatile("s_waitcnt vmcnt(0)" ::: "memory"); }
        __syncthreads();
        p1_win(F);
    }
}
__device__ __forceinline__ void tb_load4(Frame& F, int base, int r1, f32x4 (&dst)[4][4]) {
#pragma unroll
    for (int q = 0; q < 4; ++q) { const int it = (base + q < r1) ? base + q : r1 - 1; const int tb = it >= NEXP, e = it - tb * NEXP; const float* src = (tb ? F.pv : F.pu) + (size_t)e * DM;
#pragma unroll
        for (int j = 0; j < 4; ++j) dst[q][j] = *(const f32x4*)(src + 256 * j + 4 * F.lane); }
}
__device__ __forceinline__ void tb_proc4(Frame& F, int base, int r1, const f32x4 (&v)[4][4]) {
    const int lane = F.lane; float* su = (float*)(F.ws + WS_SU); float* sv = (float*)(F.ws + WS_SV); float am[4];
#pragma unroll
    for (int q = 0; q < 4; ++q) { float a = 0.f;
#pragma unroll
        for (int j = 0; j < 4; ++j) a = fmaxf(a, fmaxf(fmaxf(fabsf(v[q][j][0]), fabsf(v[q][j][1])), fmaxf(fabsf(v[q][j][2]), fabsf(v[q][j][3])))); am[q] = a; }
#pragma unroll
    for (int o = 1; o < 64; o <<= 1) {
#pragma unroll
        for (int q = 0; q < 4; ++q) am[q] = fmaxf(am[q], __shfl_xor(am[q], o)); }
#pragma unroll
    for (int q = 0; q < 4; ++q) { const int it = (base + q < r1) ? base + q : r1 - 1; const int tb = it >= NEXP, e = it - tb * NEXP; float a = am[q]; if (a == 0.f) a = 1.f;
        unsigned w[4];
        if (!tb) { const float inv = 127.0f / a;
#pragma unroll
            for (int j = 0; j < 4; ++j) { const int q0 = (int)rintf(v[q][j][0] * inv), q1 = (int)rintf(v[q][j][1] * inv), q2 = (int)rintf(v[q][j][2] * inv), q3 = (int)rintf(v[q][j][3] * inv);
                w[j] = (unsigned)(q0 & 255) | ((unsigned)(q1 & 255) << 8) | ((unsigned)(q2 & 255) << 16) | ((unsigned)(q3 & 255) << 24); }
            *(v4u*)(F.ws + WS_U + (size_t)e * DM + 16 * lane) = (v4u){w[0], w[1], w[2], w[3]}; if (lane == 0) su[e] = a * (1.0f / 127.0f);
        } else { const float inv = 256.0f / a;
#pragma unroll
            for (int j = 0; j < 4; ++j) { unsigned wv = 0u, g = 0u;
#pragma unroll
                for (int i = 0; i < 4; ++i) { const float t = v[q][j][i] * inv; const unsigned short hb = __builtin_bit_cast(unsigned short, (_Float16)t);
                    const int m = (int)(hb & 0x7fffu); int h7 = (m - (int)g + 128) >> 8; h7 = h7 < 0 ? 0 : (h7 > 0x7B ? 0x7B : h7);
                    const unsigned byte = (unsigned)h7 | ((hb >> 8) & 0x80u); wv |= byte << (8 * i); g = byte; }
                w[j] = wv; }
            *(v4u*)(F.ws + WS_V + (size_t)e * DM + 16 * lane) = (v4u){w[0], w[1], w[2], w[3]}; if (lane == 0) sv[e] = a * (1.0f / 256.0f); } }
}
__device__ __forceinline__ void p2_tables(Frame& F, int cw, int ncw, int row_lo, int row_hi) {
    const int per = (row_hi - row_lo + ncw - 1) / ncw, r0 = row_lo + cw * per, r1 = (r0 + per) < row_hi ? (r0 + per) : row_hi;
    if (r0 >= r1) return;
    f32x4 va[4][4], vb[4][4];
    tb_load4(F, r0, r1, va);
    for (int it0 = r0; it0 < r1; it0 += 8) {
        if (it0 + 4 < r1) tb_load4(F, it0 + 4, r1, vb);
        tb_proc4(F, it0, r1, va);
        if (it0 + 4 < r1) { if (it0 + 8 < r1) tb_load4(F, it0 + 8, r1, va); tb_proc4(F, it0 + 4, r1, vb); }
    }
}
__device__ __forceinline__ void p1_win(Frame& F) {
    const float* mp = (const float*)(F.ws + WS_MODP);
    if (F.vcu < 48 && F.tid < 256) { const int e = F.vcu * 256 + F.tid; ((float*)(F.ws + WS_MOD))[e] = mp[e] + mp[2 * 6144 + e]; }
    LAS float* sc = (LAS float*)F.lds; LAS float* sh = sc + 2048;
    for (int i = F.tid; i < 2048; i += NTHREADS) { const int b = i >> 10, k = i & 1023; sc[i] = 1.f + mp[b * 6144 + 1024 + k] + mp[(2 + b) * 6144 + 1024 + k]; sh[i] = mp[b * 6144 + k] + mp[(2 + b) * 6144 + k]; }
    __syncthreads();
    const int lane = F.lane;
    if (F.vcu < 40) { const int b = F.vcu / 20, n = (F.vcu % 20) * 64 + lane; int nsrc = n; if (n < 640) { const int hd = n >> 6, w = n & 63; nsrc = hd * 64 + (w >> 1) + 32 * (w & 1); }
        float a = 0.f;
#pragma unroll 1
        for (int kb = 0; kb < 128; kb += 64) { float w[64];
#pragma unroll
            for (int u = 0; u < 64; ++u) w[u] = F.w_in[(size_t)(F.wave * 128 + kb + u) * NIN + nsrc];
#pragma unroll
            for (int u = 0; u < 64; ++u) a += sh[b * 1024 + F.wave * 128 + kb + u] * w[u]; }
        LAS float* red = (LAS float*)(F.lds + 16384); red[F.wave * 64 + lane] = a;
        __syncthreads();
        if (F.tid < 64) { float sacc = 0.f;
#pragma unroll
            for (int w = 0; w < 8; ++w) sacc += red[w * 64 + F.tid];
            ((float*)(F.ws + WS_BIAS))[b * NIN + (F.vcu % 20) * 64 + F.tid] = sacc; } }
    LAS float* scr = (LAS float*)(F.lds + 32768 + F.wave * 8448);
    const int gw = F.vcu * NWAVES + F.wave, NGW = F.G * NWAVES;
    for (int it = gw; it < 2 * 640; it += NGW) { const int b = it / 640, r = it % 640;
        transpose_item<1, true>(F.w_in, NIN, (bf16*)(F.ws + WS_WIN + (size_t)b * NIN * DM), DM, 64 * (r / 40), 32 * (r % 40), scr, lane, sc + b * 1024, 64.0f); }
    __syncthreads();
}
constexpr int KS_STRIDE = 144, VT_STRIDE = 520, KS_BYTES = 256 * KS_STRIDE, VT_BYTES = 64 * VT_STRIDE;
__device__ __forceinline__ void p3_attn_unit(Frame& F, int unit) {
    const int b = unit >> 7, kvh = (unit >> 6) & 1, n = unit & 63;
    const bf16* proj = (const bf16*)(F.ws + WS_PROJ); unsigned char* a2 = F.ws + WS_A2;
    LAS unsigned char* Ks = F.lds; LAS unsigned char* Vt = F.lds + KS_BYTES;
    const int tid = F.tid, lane = F.lane, wave = F.wave, r32 = lane & 31, h = lane >> 5;
    const size_t tok0 = (size_t)b * SEQ + (size_t)n * 128;
#pragma unroll
    for (int i = 0; i < 4; ++i) { const int ci = tid + NTHREADS * i, row = ci >> 3, ch = ci & 7; const bool valid = (n > 0) || (row >= 128);
        const size_t tk = tok0 - 128 + row;
        v4u kv = (v4u){0u, 0u, 0u, 0u}, vv = (v4u){0u, 0u, 0u, 0u};
        if (valid) { kv = *(const v4u*)(proj + tk * NIN + 512 + kvh * 64 + ch * 8); vv = *(const v4u*)(proj + tk * NIN + 640 + kvh * 64 + ch * 8); }
        *(LAS v4u*)(Ks + row * KS_STRIDE + ch * 16) = kv;
        LAS bf16* vt = (LAS bf16*)(Vt + (ch * 8) * VT_STRIDE) + row;
        vt[0 * (VT_STRIDE / 2)] = (bf16)(vv.x & 0xffff); vt[1 * (VT_STRIDE / 2)] = (bf16)(vv.x >> 16); vt[2 * (VT_STRIDE / 2)] = (bf16)(vv.y & 0xffff); vt[3 * (VT_STRIDE / 2)] = (bf16)(vv.y >> 16);
        vt[4 * (VT_STRIDE / 2)] = (bf16)(vv.z & 0xffff); vt[5 * (VT_STRIDE / 2)] = (bf16)(vv.z >> 16); vt[6 * (VT_STRIDE / 2)] = (bf16)(vv.w & 0xffff); vt[7 * (VT_STRIDE / 2)] = (bf16)(vv.w >> 16); }
    __syncthreads();
    const int g = wave >> 1, hq = kvh * 4 + g; const float sink2 = F.sinks[hq] * LOG2E;
#pragma unroll 1
    for (int qt = 0; qt < 2; ++qt) {
        const int qi0 = (wave & 1) * 64 + qt * 32, t0 = qi0 >> 5; const size_t tokq = tok0 + qi0 + r32;
        bf16x8 qf[4];
#pragma unroll
        for (int s = 0; s < 4; ++s) qf[s] = *(const bf16x8*)(proj + tokq * NIN + hq * 64 + 16 * s + 8 * h);
        f32x16 sc[5];
#pragma unroll
        for (int kt = 0; kt < 5; ++kt) { sc[kt] = (f32x16){};
#pragma unroll
            for (int s = 0; s < 4; ++s) { const bf16x8 kf = *(const LAS bf16x8*)(Ks + (32 * (t0 + kt) + r32) * KS_STRIDE + (16 * s + 8 * h) * 2);
                sc[kt] = __builtin_amdgcn_mfma_f32_32x32x16_bf16(kf, qf[s], sc[kt], 0, 0, 0); } }
        const int qi = qi0 + r32; float m = sink2;
#pragma unroll
        for (int kt = 0; kt < 5; ++kt)
#pragma unroll
            for (int r = 0; r < 16; ++r) { const int sidx = 32 * (t0 + kt) + (r & 3) + 8 * (r >> 2) + 4 * h; const int rel = qi + 128 - sidx;
                const bool ok = (rel >= 0) && (rel < 128) && ((n > 0) || (sidx >= 128));
                const float v = ok ? sc[kt][r] : -INFINITY; sc[kt][r] = v; m = fmaxf(m, v); }
        m = fmaxf(m, __shfl_xor(m, 32));
        float l = 0.f;
#pragma unroll
        for (int kt = 0; kt < 5; ++kt)
#pragma unroll
            for (int r = 0; r < 16; ++r) { const float p = __builtin_amdgcn_exp2f(sc[kt][r] - m); sc[kt][r] = p; l += p; }
        l += __shfl_xor(l, 32); l += __builtin_amdgcn_exp2f(sink2 - m);
        f32x16 o[2]; o[0] = (f32x16){}; o[1] = (f32x16){};
#pragma unroll
        for (int kt = 0; kt < 5; ++kt)
#pragma unroll
            for (int s2 = 0; s2 < 2; ++s2) {
                u32x4 pw; pw.x = pg8::cvt_pk_bf16(sc[kt][8 * s2 + 0], sc[kt][8 * s2 + 1]); pw.y = pg8::cvt_pk_bf16(sc[kt][8 * s2 + 2], sc[kt][8 * s2 + 3]);
                pw.z = pg8::cvt_pk_bf16(sc[kt][8 * s2 + 4], sc[kt][8 * s2 + 5]); pw.w = pg8::cvt_pk_bf16(sc[kt][8 * s2 + 6], sc[kt][8 * s2 + 7]);
                const bf16x8 pf = __builtin_bit_cast(bf16x8, pw);
#pragma unroll
                for (int dt = 0; dt < 2; ++dt) { const LAS unsigned char* vp = Vt + (dt * 32 + r32) * VT_STRIDE + (32 * (t0 + kt) + 16 * s2 + 4 * h) * 2;
                    const u32x2 lo = *(const LAS u32x2*)vp, hi = *(const LAS u32x2*)(vp + 16);
                    const u32x4 vw = (u32x4){lo.x, lo.y, hi.x, hi.y};
                    o[dt] = __builtin_amdgcn_mfma_f32_32x32x16_bf16(__builtin_bit_cast(bf16x8, vw), pf, o[dt], 0, 0, 0); } }
        const float inv = 16.0f / l;
#pragma unroll
        for (int dt = 0; dt < 2; ++dt)
#pragma unroll
            for (int rg = 0; rg < 4; ++rg) { const int d0 = dt * 32 + 8 * rg + 4 * h;
                *(unsigned*)(a2 + tokq * DM + hq * 64 + d0) = fp8x4(o[dt][4 * rg + 0] * inv, o[dt][4 * rg + 1] * inv, o[dt][4 * rg + 2] * inv, o[dt][4 * rg + 3] * inv); }
    }
    __syncthreads();
}
__device__ __forceinline__ void p3_pool_unit(Frame& F, int unit) {
    const bf16* proj = (const bf16*)(F.ws + WS_PROJ); unsigned char* a2 = F.ws + WS_A2;
    const int cp = F.tid & 255, half = F.tid >> 8, gi = cp >> 6, w = 2 << gi;
    const int tstart = unit * 64 + half * 32, s0 = tstart & (SEQ - 1);
    const bf16* pc = proj + 768 + 2 * cp;
    unsigned u[48];
#pragma unroll
    for (int i = 0; i < 48; ++i) { const int s = s0 - 16 + i; u[i] = (s >= 0) ? *(const unsigned*)(pc + (size_t)(tstart - 16 + i) * NIN) : 0u; }
    float w0 = 0.f, w1 = 0.f;
#pragma unroll
    for (int j = 1; j <= 16; ++j) if (j <= w) { w0 += bf_lo(u[16 - j]); w1 += bf_hi(u[16 - j]); }
#pragma unroll
    for (int i = 0; i < 32; ++i) { const int s = s0 + i; const float p0 = bf_lo(u[16 + i]), p1 = bf_hi(u[16 + i]);
        const unsigned uo = (w == 2) ? u[14 + i] : (w == 4) ? u[12 + i] : (w == 8) ? u[8 + i] : u[i];
        w0 += p0 - bf_lo(uo); w1 += p1 - bf_hi(uo);
        const float rc = 1.0f / (float)((s + 1) < w ? (s + 1) : w);
        *(unsigned short*)(a2 + (size_t)(tstart + i) * DM + 512 + 2 * cp) = (unsigned short)(fp8x4((w0 * rc - p0) * 16.0f, (w1 * rc - p1) * 16.0f, 0.f, 0.f) & 0xffffu); }
}
__device__ __forceinline__ void p5_ln1(Frame& F) {
    const float* mod = (const float*)(F.ws + WS_MOD); const bf16* mix = (const bf16*)(F.ws + WS_MIX); const bf16* xn = (const bf16*)(F.ws + WS_XN);
    bf16* x1 = (bf16*)(F.ws + WS_X1); bf16* h2 = (bf16*)(F.ws + WS_H2); unsigned char* h2q = F.ws + WS_H2Q; float* shp = (float*)(F.ws + WS_SH);
    const int gw = F.vcu * NWAVES + F.wave, lane = F.lane; const int rows_per_wave = TT / (F.G * NWAVES);
    const int row0 = gw * rows_per_wave, b = row0 >> 13;
    f32x4 g1[4], lg[4], lb[4], s2[4], h2s[4];
#pragma unroll
    for (int j = 0; j < 4; ++j) { const int d = 256 * j + 4 * lane;
        g1[j] = *(const f32x4*)(mod + b * 6144 + 2048 + d) + 1.0f; lg[j] = *(const f32x4*)(F.ln1_g + d); lb[j] = *(const f32x4*)(F.ln1_b + d);
        s2[j] = *(const f32x4*)(mod + b * 6144 + 4096 + d) + 1.0f; h2s[j] = *(const f32x4*)(mod + b * 6144 + 3072 + d); }
    for (int r = 0; r < rows_per_wave; r += 2) {
        u32x2 xw[2][4]; u32x2 mv[2][4];
#pragma unroll
        for (int q = 0; q < 2; ++q)
#pragma unroll
            for (int j = 0; j < 4; ++j) { const size_t m = (size_t)(row0 + r + q); const int d = 256 * j + 4 * lane; xw[q][j] = *(const u32x2*)(xn + m * DM + d); mv[q][j] = *(const u32x2*)(mix + m * DM + d); }
#pragma unroll
        for (int q = 0; q < 2; ++q) { const size_t m = (size_t)(row0 + r + q);
        f32x4 v[4]; float s = 0.f;
#pragma unroll
        for (int j = 0; j < 4; ++j) {
            const f32x4 mf = (f32x4){bf_lo(mv[q][j].x), bf_hi(mv[q][j].x), bf_lo(mv[q][j].y), bf_hi(mv[q][j].y)};
            const f32x4 xf = (f32x4){bf_lo(xw[q][j].x), bf_hi(xw[q][j].x), bf_lo(xw[q][j].y), bf_hi(xw[q][j].y)};
            v[j] = xf * DN_ALPHA + g1[j] * mf; s += (v[j][0] + v[j][1]) + (v[j][2] + v[j][3]); }
        const float mean = wave_sum(s) * (1.f / DM); float qq = 0.f;
#pragma unroll
        for (int j = 0; j < 4; ++j) { v[j] = v[j] - mean; qq += (v[j][0] * v[j][0] + v[j][1] * v[j][1]) + (v[j][2] * v[j][2] + v[j][3] * v[j][3]); }
        const float rstd = 1.0f / sqrtf(wave_sum(qq) * (1.f / DM) + LN_EPS);
        f32x4 hh[4]; float am = 0.f;
#pragma unroll
        for (int j = 0; j < 4; ++j) { const int d = 256 * j + 4 * lane; const f32x4 y = v[j] * rstd * lg[j] + lb[j]; hh[j] = y * s2[j] + h2s[j];
            u32x2 o; o.x = pk2(y[0], y[1]); o.y = pk2(y[2], y[3]); *(u32x2*)(x1 + m * DM + d) = o;
            u32x2 p; p.x = pk2(hh[j][0], hh[j][1]); p.y = pk2(hh[j][2], hh[j][3]); *(u32x2*)(h2 + m * DM + d) = p;
            hh[j] = (f32x4){bf_lo(p.x), bf_hi(p.x), bf_lo(p.y), bf_hi(p.y)};
            am = fmaxf(am, fmaxf(fmaxf(fabsf(hh[j][0]), fabsf(hh[j][1])), fmaxf(fabsf(hh[j][2]), fabsf(hh[j][3])))); }
#pragma unroll
        for (int o = 1; o < 64; o <<= 1) am = fmaxf(am, __shfl_xor(am, o));
        if (am == 0.f) am = 1.f;
        const float inv = 127.0f / am; unsigned w[4];
#pragma unroll
        for (int j = 0; j < 4; ++j) { const int q0 = (int)rintf(hh[j][0] * inv), q1 = (int)rintf(hh[j][1] * inv), q2 = (int)rintf(hh[j][2] * inv), q3 = (int)rintf(hh[j][3] * inv);
            w[j] = (unsigned)(q0 & 255) | ((unsigned)(q1 & 255) << 8) | ((unsigned)(q2 & 255) << 16) | ((unsigned)(q3 & 255) << 24); }
        *(v4u*)(h2q + m * DM + 16 * lane) = (v4u){w[0], w[1], w[2], w[3]}; if (lane == 0) shp[m] = am * (1.0f / 127.0f); } }
}
constexpr int KR_STRIDE = 272, KR_BYTES = 128 * KR_STRIDE;
#define INS16(a, v) do { _Pragma("unroll") for (int _i = 15; _i >= 1; --_i) a[_i] = __builtin_amdgcn_fmed3f(a[_i - 1], a[_i], (v)); a[0] = fmaxf(a[0], (v)); } while (0)
#define BITONIC16(a) do { _Pragma("unroll") for (int _st = 8; _st >= 1; _st >>= 1) { _Pragma("unroll") for (int _i = 0; _i < 16; ++_i) if ((_i & _st) == 0) { const float _x = a[_i], _y = a[_i + _st]; a[_i] = fmaxf(_x, _y); a[_i + _st] = fminf(_x, _y); } } } while (0)
__device__ __forceinline__ void p7_route(Frame& F) {
    const bf16* q = (const bf16*)(F.ws + WS_Q); unsigned short* pe = (unsigned short*)(F.ws + WS_PE); float* pg = (float*)(F.ws + WS_PG);
    const int tid = F.tid, lane = F.lane, wave = F.wave, r32 = lane & 31, h = lane >> 5;
    { const bf16* k1b = (const bf16*)(F.ws + WS_K1);
      for (int ci = tid; ci < 2 * 128 * 16; ci += NTHREADS) { const int side = ci >> 11, row = (ci >> 4) & 127, ch = ci & 15;
          *(LAS v4u*)(F.lds + side * KR_BYTES + row * KR_STRIDE + ch * 16) = *(const v4u*)(k1b + (size_t)side * 16384 + row * 128 + ch * 8); } }
    __syncthreads();
    LAS unsigned char* scr = F.lds + 2 * KR_BYTES + wave * 2048 + lane * 32;
    pg8::StaticOrder S; S.init(TT, NQD, F.G, (int)blockIdx.x); pg8::Unit u;
    for (int ui = 0; S.next(ui, u); ++ui) {
        const int head = u.pn; const size_t tok = (size_t)u.pm * 256 + wave * 32 + r32;
        float vv[2][16];
#pragma unroll
        for (int side = 0; side < 2; ++side) {
            const bf16* qb = q + tok * NQD + head * 256 + side * 128;
            bf16x8 qf[8];
#pragma unroll
            for (int s = 0; s < 8; ++s) qf[s] = *(const bf16x8*)(qb + 16 * s + 8 * h);
            float a[16];
#pragma unroll
            for (int i = 0; i < 16; ++i) a[i] = -INFINITY;
#pragma unroll
            for (int kt = 0; kt < 4; ++kt) { f32x16 acc = (f32x16){};
#pragma unroll
                for (int s = 0; s < 8; ++s) { const bf16x8 kf = *(const LAS bf16x8*)(F.lds + side * KR_BYTES + (32 * kt + r32) * KR_STRIDE + (16 * s + 8 * h) * 2);
                    acc = __builtin_amdgcn_mfma_f32_32x32x16_bf16(kf, qf[s], acc, 0, 0, 0); }
#pragma unroll
                for (int r = 0; r < 16; ++r) { const unsigned key = (unsigned)(32 * kt + (r & 3) + 8 * (r >> 2)) | ((unsigned)h << 2);
                    const float v = __uint_as_float((__float_as_uint(acc[r]) & 0xFFFFFF80u) | key); INS16(a, v); }
                __builtin_amdgcn_sched_barrier(0); }
            float c[16];
#pragma unroll
            for (int i = 0; i < 16; ++i) c[i] = __shfl_xor(a[15 - i], 32);
#pragma unroll
            for (int i = 0; i < 16; ++i) c[i] = fmaxf(a[i], c[i]);
            BITONIC16(c);
#pragma unroll
            for (int i = 0; i < 16; ++i) vv[side][i] = c[i];
        }
        { v4u w1, w2;
#define PK4(L, b) ((__float_as_uint(L[b]) & 0x7Fu) | ((__float_as_uint(L[b + 1]) & 0x7Fu) << 8) | ((__float_as_uint(L[b + 2]) & 0x7Fu) << 16) | ((__float_as_uint(L[b + 3]) & 0x7Fu) << 24))
          w1.x = PK4(vv[0], 0); w1.y = PK4(vv[0], 4); w1.z = PK4(vv[0], 8); w1.w = PK4(vv[0], 12);
          w2.x = PK4(vv[1], 0); w2.y = PK4(vv[1], 4); w2.z = PK4(vv[1], 8); w2.w = PK4(vv[1], 12);
#undef PK4
          *(LAS v4u*)scr = w1; *(LAS v4u*)(scr + 16) = w2; }
        float c1[16], c2[16], top[16];
#pragma unroll
        for (int i = 0; i < 16; ++i) { c1[i] = __uint_as_float(__float_as_uint(vv[0][i]) & 0xFFFFFF80u); c2[i] = __uint_as_float(__float_as_uint(vv[1][i]) & 0xFFFFFF80u); top[i] = -INFINITY; }
#pragma unroll
        for (int ia = 0; ia < 16; ++ia)
#pragma unroll
            for (int ib = 0; ib < 16; ++ib) if ((ia + 1) * (ib + 1) <= 16) {
                const float sm = c1[ia] + c2[ib]; const float v = __uint_as_float((__float_as_uint(sm) & 0xFFFFFF00u) | (unsigned)(ia * 16 + ib)); INS16(top, v); }
        float ex[16], den = 0.f;
#pragma unroll
        for (int i = 0; i < 16; ++i) { ex[i] = __expf(top[i] - top[0]); den += ex[i]; }
        const float rden = 1.0f / den;
        LDS_WAIT();
        unsigned short ev[8]; float gv[8];
#pragma unroll
        for (int j = 0; j < 8; ++j) { const float t = h ? top[8 + j] : top[j]; const float e = h ? ex[8 + j] : ex[j];
            const unsigned code = __float_as_uint(t) & 0xFFu; const unsigned i1 = *(const LAS unsigned char*)(scr + (code >> 4)), i2 = *(const LAS unsigned char*)(scr + 16 + (code & 15u));
            ev[j] = (unsigned short)(i1 * 128u + i2); gv[j] = e * rden; }
        v4u ew; ew.x = ev[0] | ((unsigned)ev[1] << 16); ew.y = ev[2] | ((unsigned)ev[3] << 16); ew.z = ev[4] | ((unsigned)ev[5] << 16); ew.w = ev[6] | ((unsigned)ev[7] << 16);
        *(v4u*)(pe + tok * 128 + head * 16 + 8 * h) = ew;
        *(f32x4*)(pg + tok * 128 + head * 16 + 8 * h) = (f32x4){gv[0], gv[1], gv[2], gv[3]};
        *(f32x4*)(pg + tok * 128 + head * 16 + 8 * h + 4) = (f32x4){gv[4], gv[5], gv[6], gv[7]};
        LDS_WAIT();
    }
    __syncthreads();
}
__device__ __forceinline__ float gelu_erf(float v) {
    const float d = fabsf(v) * 0.2316418882f + 1.0f, t = __builtin_amdgcn_rcpf(d);
    float q = t * 0.5307027145f + (-0.7265760135f); q = q * t + 0.7107068705f; q = q * t + (-0.142248368f); q = q * t + 0.127414796f; q = q * t;
    const float e = __builtin_amdgcn_exp2f(v * v * (-0.72134752044f)), m = v * (q * e);
    return v < 0.f ? m : v - m; }
#ifndef NPART
#define NPART 8
#endif
constexpr int TPW = 8, NSWEEP = 1;
constexpr int PSHIFT = (NPART == 32) ? 9 : (NPART == 8) ? 11 : (NPART == 16) ? 10 : (NPART == 4) ? 12 : (NPART == 2) ? 13 : 14;
__device__ __forceinline__ void p8_peer(Frame& F, unsigned emask = 0xffffu, int skip = 0) {
    const float* mod = (const float*)(F.ws + WS_MOD);
    const bf16* x1 = (const bf16*)(F.ws + WS_X1); const bf16* h2 = (const bf16*)(F.ws + WS_H2);
    const float* su = (const float*)(F.ws + WS_SU); const float* sv = (const float*)(F.ws + WS_SV);
    const unsigned* pe = (const unsigned*)(F.ws + WS_PE); const float* pg = (const float*)(F.ws + WS_PG);
    const int gw = F.vcu * NWAVES + F.wave;
    const int b3 = (F.lane >> 3) & 1;
#pragma unroll 1
    for (int sweep = 0; sweep < NSWEEP; ++sweep) {
    const int t0 = (gw * NSWEEP + sweep) * TPW, b = t0 >> 13;
    int lane = F.lane; asm volatile("" : "+v"(lane));
    unsigned hq[TPW][4]; float shs[TPW]; unsigned es[TPW]; float gs[TPW][2]; int offv[TPW];
    unsigned pe2v[TPW]; f32x2 pg2v[TPW];
#pragma unroll
    for (int tt = 0; tt < TPW; ++tt) { const size_t t = (size_t)(t0 + tt);
        const u32x4 hw = *(const u32x4*)(F.ws + WS_H2Q + t * DM + 16 * lane); hq[tt][0] = hw.x; hq[tt][1] = hw.y; hq[tt][2] = hw.z; hq[tt][3] = hw.w; shs[tt] = ((const float*)(F.ws + WS_SH))[t];
        pe2v[tt] = pe[t * 64 + lane]; pg2v[tt] = *(const f32x2*)(pg + t * 128 + 2 * lane); }
#pragma unroll
    for (int tt = 0; tt < TPW; ++tt) { LAS unsigned* scr = (LAS unsigned*)(F.lds + (F.wave * TPW + tt) * 1024);
        const unsigned pe2 = pe2v[tt]; const f32x2 pg2 = pg2v[tt];
        const unsigned elo = pe2 & emask, ehi = (pe2 >> 16) & emask; const int plo = (int)(elo >> PSHIFT), phi = (int)(ehi >> PSHIFT);
        int base = 0, poslo = 0, poshi = 0, ov = 0;
#pragma unroll
        for (int r = 0; r < NPART; ++r) { const unsigned long long mlo = __ballot(plo == r), mhi = __ballot(phi == r);
            const int clo = __popcll(mlo), chi = __popcll(mhi);
            const int rlo = (int)__builtin_amdgcn_mbcnt_hi((unsigned)(mlo >> 32), __builtin_amdgcn_mbcnt_lo((unsigned)mlo, 0u));
            const int rhi = (int)__builtin_amdgcn_mbcnt_hi((unsigned)(mhi >> 32), __builtin_amdgcn_mbcnt_lo((unsigned)mhi, 0u));
            if (plo == r) poslo = base + rlo; if (phi == r) poshi = base + clo + rhi;
            base += clo + chi; if (lane == r + 1) ov = base; }
        offv[tt] = ov;
        scr[2 * poslo] = elo; scr[2 * poslo + 1] = __float_as_uint(pg2.x); scr[2 * poshi] = ehi; scr[2 * poshi + 1] = __float_as_uint(pg2.y); }
    LDS_WAIT();
#pragma unroll
    for (int tt = 0; tt < TPW; ++tt) { const LAS unsigned* scr = (const LAS unsigned*)(F.lds + (F.wave * TPW + tt) * 1024);
        const u32x4 sr = *(const LAS u32x4*)(scr + 4 * lane);
        es[tt] = sr.x | (sr.z << 16); gs[tt][0] = __uint_as_float(sr.y); gs[tt][1] = __uint_as_float(sr.w); }
    LDS_WAIT();
    const __amdgpu_buffer_rsrc_t ut_rs = __builtin_amdgcn_make_buffer_rsrc((void*)(F.ws + WS_U), 0, NEXP * DM, 0x00020000), vt_rs = __builtin_amdgcn_make_buffer_rsrc((void*)(F.ws + WS_V), 0, NEXP * DM, 0x00020000);
    const int voff16 = 16 * lane;
#define ut ut_rs
#define vt vt_rs
#define P8_ISSUE(buf, tbl, tok, bb) do { _Pragma("unroll") for (int k2 = 0; k2 < 4; ++k2) { const unsigned ew = (unsigned)__builtin_amdgcn_readlane((int)es[tok], 4 * (bb) + k2); \
        buf[2 * k2] = __builtin_amdgcn_raw_buffer_load_b128((tbl), voff16, (int)((ew & 0xffffu) << 10), 0); buf[2 * k2 + 1] = __builtin_amdgcn_raw_buffer_load_b128((tbl), voff16, (int)((ew >> 16) << 10), 0); } } while (0)
    int hidv[TPW][2];
#pragma unroll
    for (int tt = 0; tt < TPW; ++tt) { hidv[tt][0] = 0; hidv[tt][1] = 0; }
    {
        u32x4 bufA[8], bufB[8];
#define P8_DOTS(buf, tok, bb) do { int p[8]; \
            _Pragma("unroll") for (int kk = 0; kk < 8; ++kk) { int s_ = __builtin_amdgcn_sdot4((int)buf[kk].x, (int)hq[tok][0], 0, false); s_ = __builtin_amdgcn_sdot4((int)buf[kk].y, (int)hq[tok][1], s_, false); \
                s_ = __builtin_amdgcn_sdot4((int)buf[kk].z, (int)hq[tok][2], s_, false); s_ = __builtin_amdgcn_sdot4((int)buf[kk].w, (int)hq[tok][3], s_, false); p[kk] = s_; } \
            int q4[4], q2[2], q1; \
            _Pragma("unroll") for (int i = 0; i < 4; ++i) { auto r_ = __builtin_amdgcn_permlane32_swap((unsigned)p[i], (unsigned)p[i + 4], false, false); q4[i] = (int)(r_[0] + r_[1]); } \
            _Pragma("unroll") for (int i = 0; i < 2; ++i) { auto r_ = __builtin_amdgcn_permlane16_swap((unsigned)q4[i], (unsigned)q4[i + 2], false, false); q2[i] = (int)(r_[0] + r_[1]); } \
            { const int keep = b3 ? q2[1] : q2[0], send = b3 ? q2[0] : q2[1]; q1 = keep + __builtin_amdgcn_update_dpp(0, send, 0x128, 0xF, 0xF, true); } \
            q1 += __builtin_amdgcn_update_dpp(0, q1, 0xB1, 0xF, 0xF, true); q1 += __builtin_amdgcn_update_dpp(0, q1, 0x4E, 0xF, 0xF, true); q1 += __builtin_amdgcn_update_dpp(0, q1, 0x141, 0xF, 0xF, true); \
            const int i2_ = (lane & 3) * 2; const int v0_ = __builtin_amdgcn_ds_bpermute(i2_ << 5, q1), v1_ = __builtin_amdgcn_ds_bpermute((i2_ + 1) << 5, q1); \
            if ((lane >> 2) == (bb)) { hidv[tok][0] = v0_; hidv[tok][1] = v1_; } } while (0)
        int cur[TPW];
#pragma unroll
        for (int tt = 0; tt < TPW; ++tt) cur[tt] = 0;
#define P8_STEP_A(tt_, bufX, bufY, r_) { const int end_ = __builtin_amdgcn_readlane(offv[tt_], (r_) + 1); \
            { constexpr int tn_ = ((tt_) + 1) % TPW; const int rn_ = (r_) + ((tt_) + 1) / TPW; \
              if (rn_ < NPART && cur[tn_] < __builtin_amdgcn_readlane(offv[tn_], rn_ + 1)) P8_ISSUE(bufY, ut, tn_, cur[tn_] >> 3); } \
            __builtin_amdgcn_sched_barrier(0); \
            bool pre_ = true; \
            while (cur[tt_] < end_) { if (!pre_) P8_ISSUE(bufX, ut, tt_, cur[tt_] >> 3); pre_ = false; P8_DOTS(bufX, tt_, cur[tt_] >> 3); cur[tt_] += 8; } }
        if ((skip & 1) == 0) {
        if (0 < __builtin_amdgcn_readlane(offv[0], 1)) P8_ISSUE(bufA, ut, 0, 0);
#pragma unroll 1
        for (int r = 0; r < NPART; ++r) {
            P8_STEP_A(0, bufA, bufB, r) P8_STEP_A(1, bufB, bufA, r) P8_STEP_A(2, bufA, bufB, r) P8_STEP_A(3, bufB, bufA, r)
            P8_STEP_A(4, bufA, bufB, r) P8_STEP_A(5, bufB, bufA, r) P8_STEP_A(6, bufA, bufB, r) P8_STEP_A(7, bufB, bufA, r)
        } }
#undef P8_STEP_A
#undef P8_DOTS
    }
    { float su0[TPW], su1[TPW], sv0[TPW], sv1[TPW];
#pragma unroll
      for (int tt = 0; tt < TPW; ++tt) { const unsigned e0 = es[tt] & 0xffffu, e1 = es[tt] >> 16; su0[tt] = su[e0]; su1[tt] = su[e1]; sv0[tt] = sv[e0]; sv1[tt] = sv[e1]; }
#pragma unroll
      for (int tt = 0; tt < TPW; ++tt) {
        gs[tt][0] = gelu_erf((float)hidv[tt][0] * (shs[tt] * su0[tt])) * gs[tt][0] * sv0[tt];
        gs[tt][1] = gelu_erf((float)hidv[tt][1] * (shs[tt] * su1[tt])) * gs[tt][1] * sv1[tt]; } }
    typedef _Float16 f16x2 __attribute__((ext_vector_type(2)));
    f16x2 yh[TPW][8];
#pragma unroll
    for (int tt = 0; tt < TPW; ++tt) {
#pragma unroll
        for (int i = 0; i < 8; ++i) yh[tt][i] = (f16x2){(_Float16)0.f, (_Float16)0.f}; }
    {
        u32x4 bufA[8], bufB[8];
#define BF8ACC(tok, a, word, j) { const unsigned _w = (word); const unsigned _h02 = _w << 8;     \
                          yh[tok][2 * (j)] = __builtin_elementwise_fma(__builtin_bit_cast(f16x2, _h02), (a), yh[tok][2 * (j)]); yh[tok][2 * (j) + 1] = __builtin_elementwise_fma(__builtin_bit_cast(f16x2, _w), (a), yh[tok][2 * (j) + 1]); }
#define P8_ACC(buf, tok, bb) do { _Pragma("unroll") for (int k2 = 0; k2 < 4; ++k2) { \
            const _Float16 h0_ = (_Float16)__int_as_float(__builtin_amdgcn_readlane(__float_as_int(gs[tok][0]), 4 * (bb) + k2)), h1_ = (_Float16)__int_as_float(__builtin_amdgcn_readlane(__float_as_int(gs[tok][1]), 4 * (bb) + k2)); \
            const f16x2 a0_ = (f16x2){h0_, h0_}, a1_ = (f16x2){h1_, h1_}; \
            BF8ACC(tok, a0_, buf[2 * k2].x, 0) BF8ACC(tok, a0_, buf[2 * k2].y, 1) BF8ACC(tok, a0_, buf[2 * k2].z, 2) BF8ACC(tok, a0_, buf[2 * k2].w, 3) \
            BF8ACC(tok, a1_, buf[2 * k2 + 1].x, 0) BF8ACC(tok, a1_, buf[2 * k2 + 1].y, 1) BF8ACC(tok, a1_, buf[2 * k2 + 1].z, 2) BF8ACC(tok, a1_, buf[2 * k2 + 1].w, 3) __builtin_amdgcn_sched_barrier(0); } } while (0)
        int cur[TPW];
#pragma unroll
        for (int tt = 0; tt < TPW; ++tt) cur[tt] = 0;
#define P8_STEP_B(tt_, bufX, bufY, r_) { const int end_ = __builtin_amdgcn_readlane(offv[tt_], (r_) + 1); \
            { constexpr int tn_ = ((tt_) + 1) % TPW; const int rn_ = (r_) + ((tt_) + 1) / TPW; \
              if (rn_ < NPART && cur[tn_] < __builtin_amdgcn_readlane(offv[tn_], rn_ + 1)) P8_ISSUE(bufY, vt, tn_, cur[tn_] >> 3); } \
            __builtin_amdgcn_sched_barrier(0); \
            bool pre_ = true; \
            while (cur[tt_] < end_) { if (!pre_) P8_ISSUE(bufX, vt, tt_, cur[tt_] >> 3); pre_ = false; P8_ACC(bufX, tt_, cur[tt_] >> 3); cur[tt_] += 8; } }
        if ((skip & 2) == 0) {
        if (0 < __builtin_amdgcn_readlane(offv[0], 1)) P8_ISSUE(bufA, vt, 0, 0);
#pragma unroll 1
        for (int r = 0; r < NPART; ++r) {
            P8_STEP_B(0, bufA, bufB, r) P8_STEP_B(1, bufB, bufA, r) P8_STEP_B(2, bufA, bufB, r) P8_STEP_B(3, bufB, bufA, r)
            P8_STEP_B(4, bufA, bufB, r) P8_STEP_B(5, bufB, bufA, r) P8_STEP_B(6, bufA, bufB, r) P8_STEP_B(7, bufB, bufA, r)
        } }
#undef P8_STEP_B
#undef P8_ACC
#undef BF8ACC
    }
#undef P8_ISSUE
#undef ut
#undef vt
    u32x2 xw[TPW][4]; f32x4 g2v[4], lgv[4], lbv[4];
#pragma unroll
    for (int tt = 0; tt < TPW; ++tt)
#pragma unroll
        for (int j = 0; j < 4; ++j) xw[tt][j] = *(const u32x2*)(x1 + (size_t)(t0 + tt) * DM + 256 * j + 4 * lane);
#pragma unroll
    for (int j = 0; j < 4; ++j) { const int d = 256 * j + 4 * lane; g2v[j] = *(const f32x4*)(mod + b * 6144 + 5120 + d) + 1.0f; lgv[j] = *(const f32x4*)(F.ln2_g + d); lbv[j] = *(const f32x4*)(F.ln2_b + d); }
#pragma unroll
    for (int tt = 0; tt < TPW; ++tt) { const size_t t = (size_t)(t0 + tt);
        f32x4 v[4]; float s = 0.f;
#pragma unroll
        for (int j = 0; j < 4; ++j) { const u32x2 xv = xw[tt][j];
            const f32x4 xf = (f32x4){bf_lo(xv.x), bf_hi(xv.x), bf_lo(xv.y), bf_hi(xv.y)}; const f32x4 yy = (f32x4){(float)yh[tt][2 * j].x, (float)yh[tt][2 * j + 1].x, (float)yh[tt][2 * j].y, (float)yh[tt][2 * j + 1].y};
            v[j] = xf * DN_ALPHA + g2v[j] * yy; s += (v[j][0] + v[j][1]) + (v[j][2] + v[j][3]); }
        const float mean = wave_sum(s) * (1.f / DM); float qq = 0.f;
#pragma unroll
        for (int j = 0; j < 4; ++j) { v[j] = v[j] - mean; qq += (v[j][0] * v[j][0] + v[j][1] * v[j][1]) + (v[j][2] * v[j][2] + v[j][3] * v[j][3]); }
        const float rstd = 1.0f / sqrtf(wave_sum(qq) * (1.f / DM) + LN_EPS);
#pragma unroll
        for (int j = 0; j < 4; ++j) { const int d = 256 * j + 4 * lane;
            *(f32x4*)(F.out + t * DM + d) = v[j] * rstd * lgv[j] + lbv[j]; } }
    }
}
#ifndef PROBE_PARTS
#define PROBE_PARTS 0xff
#endif
#ifndef MK_N_LAUNCHES
#define MK_N_LAUNCHES 1
#endif
constexpr int N_PHASES = 9;
struct Args { const float* in[18]; float* out; unsigned char* ws; int ph_lo, ph_hi, p0_parts, pad; };
__global__ void __launch_bounds__(NTHREADS, 2) fwd_kernel(Args args) {
    extern __shared__ __attribute__((aligned(16))) unsigned char lds[];
    Frame F;
    F.lds = (LAS unsigned char*)lds;
    F.tid = threadIdx.x; F.lane = F.tid & 63; F.wave = __builtin_amdgcn_readfirstlane(F.tid >> 6);
    F.G = gridDim.x; { const int bx = blockIdx.x; F.vcu = (F.G % 8 == 0) ? (bx % 8) * (F.G / 8) + bx / 8 : bx; }
    F.x = args.in[0]; F.c = args.in[1]; F.w_ada = args.in[2]; F.b_ada = args.in[3]; F.w_in = args.in[4]; F.sinks = args.in[5]; F.w_pool = args.in[6]; F.pool_scale = args.in[7];
    F.w_out = args.in[8]; F.ln1_g = args.in[9]; F.ln1_b = args.in[10]; F.w_pq = args.in[11]; F.k1 = args.in[12]; F.k2 = args.in[13]; F.pu = args.in[14]; F.pv = args.in[15];
    F.ln2_g = args.in[16]; F.ln2_b = args.in[17]; F.out = args.out; F.ws = args.ws;
    volatile LAS unsigned* MISC = (volatile LAS unsigned*)(F.lds + MISC_OFF);
    for (int u = F.tid; u < (LDS_BYTES - LDSCTL_OFF) / 4; u += NTHREADS) ((LAS unsigned*)(F.lds + LDSCTL_OFF))[u] = 0u;
    __syncthreads();
    const int lo = args.ph_lo, hi = args.ph_hi;
    XcdBarrier bar; bar.bar = (unsigned*)(F.ws + WS_CTL) + CW_BAR; bar.x = 0; bar.st = nullptr;
    if (hi - lo > 1) bar = xcd_barrier_post((unsigned*)(F.ws + WS_CTL) + CW_BAR, MISC + 8);
#ifndef PH_MASK
#define PH_MASK 0x1ff
#endif
#define IN(k) (((PH_MASK >> (k)) & 1) && lo <= (k) && (k) < hi)
#define SEAM(k) do { if (IN(k) && IN((k) + 1)) xcd_barrier(bar); } while (0)
#ifndef REP_MASK
#define REP_MASK 0
#endif
#ifndef REP_CNT
#define REP_CNT 4
#endif
#define REPS(k) (((REP_MASK >> (k)) & 1) * REP_CNT)
#define PHASE_NS(k, ...) if (IN(k)) { _Pragma("unroll 1") for (int _r = 0; _r <= REPS(k); ++_r) { __VA_ARGS__; if (_r < REPS(k)) xcd_barrier(bar); } }
#define PHASE(k, ...) if (IN(k)) { _Pragma("unroll 1") for (int _r = 0; _r <= REPS(k); ++_r) { __VA_ARGS__; if (_r < REPS(k)) xcd_barrier(bar); } } SEAM(k)
#ifndef P0_SUB
#define P0_SUB 0xff
#endif
    PHASE(0, p0_prologue(F, args.p0_parts));
    PHASE(2, { pg8::Gemm g{(const pg8::bf16_t*)(F.ws + WS_XN8), (const pg8::bf16_t*)(F.ws + WS_WIN), TT, NIN, DM / 2, 32, (size_t)NIN * DM, 0x79797979, 0x7F7F7F7F};    pg8::StaticOrder S; S.init(TT, NIN, F.G, (int)blockIdx.x);
            pg8::EpiRope E{(pg8::bf16_t*)(F.ws + WS_PROJ), NIN, (const float*)(F.ws + WS_ROPE), QSCALE, (const float*)(F.ws + WS_BIAS)};
            pg8::gemm_phase<pg8::EpiRope, pg8::StaticOrder, true, true, true>(F.lds, g, S, E);
            if ((args.p0_parts & 0x80) && (int)blockIdx.x >= 320 - F.G) p2_tables(F, ((int)blockIdx.x - (320 - F.G)) * NWAVES + F.wave, (2 * F.G - 320) * NWAVES, 0, 2 * NEXP); });
    PHASE(3, { for (int u = F.vcu; u < 256; u += F.G) p3_attn_unit(F, u);
               for (int u = F.vcu; u < 256; u += F.G) p3_pool_unit(F, u); });
    PHASE(4, { pg8::Gemm g{(const pg8::bf16_t*)(F.ws + WS_A2), (const pg8::bf16_t*)(F.ws + WS_WOUT), TT, DM, DM / 2, 1 << 30, 0, 0x79797979, 0x7B7B7B7B}; pg8::StaticOrder S; S.init(TT, DM, F.G, (int)blockIdx.x);
            pg8::EpiPlain E{(pg8::bf16_t*)(F.ws + WS_MIX), DM};
            pg8::gemm_phase<pg8::EpiPlain, pg8::StaticOrder, true, true, true>(F.lds, g, S, E); });
    PHASE(5, p5_ln1(F));
    PHASE_NS(6, { pg8::Gemm g{(const pg8::bf16_t*)(F.ws + WS_H2), (const pg8::bf16_t*)(F.ws + WS_WPQ), TT, NQD, DM, 1 << 30, 0, 0, 0}; pg8::StaticOrder S; S.init(TT, NQD, F.G, (int)blockIdx.x);
            pg8::EpiPlain E{(pg8::bf16_t*)(F.ws + WS_Q), NQD};
            pg8::gemm_phase<pg8::EpiPlain, pg8::StaticOrder, true, true>(F.lds, g, S, E); });
    if (IN(6) && IN(7)) { asm volatile("s_waitcnt vmcnt(0)" ::: "memory"); __syncthreads(); }
    PHASE(7, p7_route(F));
#ifndef P8_FAKE
#define P8_FAKE 0xffffu
#endif
#ifndef P8_SKIP
#define P8_SKIP 0
#endif
    PHASE(8, p8_peer(F, _r == REPS(8) ? 0xffffu : P8_FAKE, _r == REPS(8) ? 0 : P8_SKIP));
#undef IN
#undef SEAM
}

extern "C" void kernel_launch(void* const* d_in, const int* in_sizes, int n_in, void* d_out, int out_size, void* d_ws, size_t ws_size, hipStream_t stream) {
    static int grid = 0;
    if (grid == 0) {
        if (n_in != 18 || out_size != TT * DM || ws_size < WS_END) { fprintf(stderr, "kernel_launch: unexpected shapes (n_in %d out %d ws %zu)\n", n_in, out_size, ws_size); grid = -1; return; }
        int dev = 0, cus = 0, per_cu = 0;
        if (hipGetDevice(&dev) != hipSuccess || hipDeviceGetAttribute(&cus, hipDeviceAttributeMultiprocessorCount, dev) != hipSuccess) { grid = -1; return; }
        if (hipFuncSetAttribute((const void*)fwd_kernel, hipFuncAttributeMaxDynamicSharedMemorySize, LDS_BYTES) != hipSuccess) { fprintf(stderr, "kernel_launch: hipFuncSetAttribute failed\n"); grid = -1; return; }
        if (hipOccupancyMaxActiveBlocksPerMultiprocessor(&per_cu, (const void*)fwd_kernel, NTHREADS, LDS_BYTES) != hipSuccess || per_cu < 1) { fprintf(stderr, "kernel_launch: occupancy query says %d blocks per CU\n", per_cu); }
        (void)hipGetLastError();
        grid = cus;
        if (grid != 256) fprintf(stderr, "kernel_launch: built for 256 CUs, got %d\n", grid);
    }
    if (grid < 0) return;
    (void)hipMemsetAsync((char*)d_ws + WS_CTL, 0, CTL_ZERO_BYTES, stream);
    Args a{};
    for (int i = 0; i < 18; ++i) a.in[i] = (const float*)d_in[i];
    a.out = (float*)d_out; a.ws = (unsigned char*)d_ws; a.p0_parts = 0xff;
#if MK_N_LAUNCHES == 1
    a.ph_lo = 0; a.ph_hi = N_PHASES;
    hipLaunchKernelGGL(fwd_kernel, dim3(grid), dim3(NTHREADS), LDS_BYTES, stream, a);
#ifdef PROBE_PHASE
    for (int i = 0; i < PROBE_N; ++i) { a.ph_lo = PROBE_PHASE; a.ph_hi = PROBE_PHASE + 1; a.p0_parts = PROBE_PARTS; hipLaunchKernelGGL(fwd_kernel, dim3(grid), dim3(NTHREADS), LDS_BYTES, stream, a); }
#endif
#else
    for (int p = 0; p < N_PHASES; ++p) { a.ph_lo = p; a.ph_hi = p + 1; hipLaunchKernelGGL(fwd_kernel, dim3(grid), dim3(NTHREADS), LDS_BYTES, stream, a); }
#endif
}
```

```cpp
#include <hip/hip_runtime.h>
#include <cstdio>
#include <cstdint>
#include <cmath>
namespace pg8 {
#define PG8_LAS __attribute__((address_space(3)))
typedef unsigned short bf16_t;
typedef short bf16x8 __attribute__((ext_vector_type(8)));
typedef float f32x4 __attribute__((ext_vector_type(4)));
typedef unsigned u32x4 __attribute__((ext_vector_type(4)));
constexpr int BM = 256, BK = 64, HALF = 128, HTB = HALF * BK * 2  , STAGE_BYTES = 8 * HTB, NXCD = 8, WGM = 8;

__host__ __device__ __forceinline__ int lds_byte(int r, int c) { const int st = (r >> 4) * 2 + (c >> 5), rr = r & 15, cc = c & 31, ob = rr * 64 + cc * 2; return st * 1024 + (ob ^ (((ob >> 9) & 1) << 5)); }
__host__ __device__ __forceinline__ void stage_rc(int b, int& R, int& C) { const int st = b / 1024, sb = b % 1024, swz = sb ^ (((sb >> 9) & 1) << 5); R = (st >> 1) * 16 + swz / 64; C = (st & 1) * 32 + (swz % 64) / 2; }
__host__ __device__ __forceinline__ int perm32(int rho) { const int n = rho >> 4, i = rho & 15; return 8 * (i >> 2) + 4 * n + (i & 3); }

struct Unit { int pm, pn; };
struct Gemm { const bf16_t* A; const bf16_t* Bt; int M, N, K; int bsplit; size_t bstride; int sc_w, sc_x; };

struct StaticOrder {
    int nM, nN, nwg, G, c;
    __host__ __device__ void init(int M, int N, int G_, int c_) { nM = M / BM; nN = N / BM; nwg = nM * nN; G = G_; c = c_; }
    __host__ __device__ bool next(int i, Unit& u) const {
        const long L = (long)i * G + c; if (L >= nwg) return false;
        int wgid = (int)L; { const int q = nwg / NXCD, r = nwg % NXCD, xcd = wgid % NXCD, off = wgid / NXCD; wgid = (xcd < r ? xcd * (q + 1) : r * (q + 1) + (xcd - r) * q) + off; }
        const int nig = WGM * nN, gid = wgid / nig, fm = gid * WGM, gsz = (nM - fm) < WGM ? (nM - fm) : WGM;
        u.pm = fm + ((wgid % nig) % gsz); u.pn = (wgid % nig) / gsz; return true;
    }
    __device__ __forceinline__ void a_ready(const Unit&) const {}
    __device__ __forceinline__ void done(const Unit&) const {}
};

__device__ __forceinline__ unsigned cvt_pk_bf16(float lo, float hi) { unsigned r; asm volatile("v_cvt_pk_bf16_f32 %0, %1, %2" : "=v"(r) : "v"(lo), "v"(hi)); return r; }

struct EpiPlain {
    static constexpr bool PERM = true, AFTER_DRAIN = false;
    bf16_t* O; int ldc;
    __device__ __forceinline__ void operator()(const f32x4 (&acc)[2][2][4][2], const Unit& u, int wr, int wc, int fr, int fq) const {
        const int row0 = u.pm * BM + wr * 64 + fr; const int col0 = u.pn * BM + wc * 32 + 8 * fq;
#pragma unroll
        for (int ai = 0; ai < 2; ++ai)
#pragma unroll
            for (int m = 0; m < 4; ++m) { bf16_t* rowp = O + (size_t)(row0 + ai * HALF + m * 16) * ldc + col0;
#pragma unroll
                for (int bj = 0; bj < 2; ++bj) { const f32x4 v0 = acc[ai][bj][m][0], v1 = acc[ai][bj][m][1];
                    u32x4 w; w.x = cvt_pk_bf16(v0[0], v0[1]); w.y = cvt_pk_bf16(v0[2], v0[3]); w.z = cvt_pk_bf16(v1[0], v1[1]); w.w = cvt_pk_bf16(v1[2], v1[3]);
                    *(u32x4*)(rowp + bj * HALF) = w; } }
    }
};
struct EpiRope {
    static constexpr bool PERM = true, AFTER_DRAIN = false;
    bf16_t* O; int ldc; const float* rope; float qscale; const float* bias;
    __device__ __forceinline__ void operator()(const f32x4 (&acc)[2][2][4][2], const Unit& u, int wr, int wc, int fr, int fq) const {
        const int row0 = u.pm * BM + wr * 64 + fr; const int col0 = u.pn * BM + wc * 32 + 8 * fq;
#pragma unroll
        for (int ai = 0; ai < 2; ++ai)
#pragma unroll
            for (int m = 0; m < 4; ++m) { const int row = row0 + ai * HALF + m * 16; bf16_t* rowp = O + (size_t)row * ldc + col0; const int pos = row & 8191;
#pragma unroll
                for (int bj = 0; bj < 2; ++bj) { const float* bp = bias + (size_t)(row >> 13) * ldc + col0 + bj * HALF;
                    f32x4 v0 = acc[ai][bj][m][0] + *(const f32x4*)bp, v1 = acc[ai][bj][m][1] + *(const f32x4*)(bp + 4);
                    const int colt = u.pn * BM + bj * HALF;
                    if (colt < 640) {
                        const int c = col0 + bj * HALF, ib = (c & 63) >> 1;
                        const f32x4 cs0 = *(const f32x4*)(rope + ((size_t)pos * 32 + ib) * 2), cs1 = *(const f32x4*)(rope + ((size_t)pos * 32 + ib) * 2 + 4);
                        const float sc = colt < 512 ? qscale : 1.0f;
                        f32x4 r0, r1;
                        r0[0] = (v0[0] * cs0[0] - v0[1] * cs0[1]) * sc; r0[1] = (v0[1] * cs0[0] + v0[0] * cs0[1]) * sc;
                        r0[2] = (v0[2] * cs0[2] - v0[3] * cs0[3]) * sc; r0[3] = (v0[3] * cs0[2] + v0[2] * cs0[3]) * sc;
                        r1[0] = (v1[0] * cs1[0] - v1[1] * cs1[1]) * sc; r1[1] = (v1[1] * cs1[0] + v1[0] * cs1[1]) * sc;
                        r1[2] = (v1[2] * cs1[2] - v1[3] * cs1[3]) * sc; r1[3] = (v1[3] * cs1[2] + v1[2] * cs1[3]) * sc;
                        v0 = r0; v1 = r1;
                    }
                    u32x4 w; w.x = cvt_pk_bf16(v0[0], v0[1]); w.y = cvt_pk_bf16(v0[2], v0[3]); w.z = cvt_pk_bf16(v1[0], v1[1]); w.w = cvt_pk_bf16(v1[2], v1[3]);
                    *(u32x4*)(rowp + bj * HALF) = w; } }
    }
};

template <class Epi, class Sched, bool ALIGN_EPI = false, bool SP2 = false, bool FP8 = false>
__device__ __forceinline__ void gemm_phase(PG8_LAS unsigned char* lds, const Gemm g, const Sched& S, const Epi& E) {
    typedef int pg8_i32x4 __attribute__((ext_vector_type(4))); typedef int pg8_frag __attribute__((ext_vector_type(8)));
    const int tid = threadIdx.x, wid = __builtin_amdgcn_readfirstlane(tid >> 6), lane = tid & 63, wr = wid >> 2, wc = wid & 3, fr = lane & 15, fq = lane >> 4;
    const int K = g.K, nt = K / BK;
    unsigned voffA[2], voffB[2];
#pragma unroll
    for (int i = 0; i < 2; ++i) { int R, C; stage_rc(tid * 16 + i * 8192, R, C); const int Rb = Epi::PERM ? ((R & ~31) + perm32(R & 31)) : R;
        voffA[i] = (unsigned)(R * K + C) * 2u; voffB[i] = (unsigned)(Rb * K + C) * 2u; }
    const size_t kstep = (size_t)(BK * 2);
    const size_t hstep = (size_t)HALF * K * 2;
    const size_t tstep = 2 * hstep;
    const unsigned ldsw = (unsigned)wid * 1024u;
    const int aoff = lds_byte(wr * 64 + fr, fq * 8), boff = lds_byte(wc * 32 + fr, fq * 8);
#define PG8_SA(b, h) (((b) * 2 + (h)) * HTB)
#define PG8_SB(b, h) ((4 + (b) * 2 + (h)) * HTB)
#define PG8_STAGE(bufoff, gbase, voff) do { _Pragma("unroll") for (int _i = 0; _i < 2; ++_i) \
        __builtin_amdgcn_global_load_lds((const unsigned*)((const char*)(gbase) + (voff)[_i]), (PG8_LAS unsigned*)(lds + (bufoff) + ldsw + _i * 8192), 16, 0, 0); } while (0)
#define PG8_LDA(dst, b, h) do { _Pragma("unroll") for (int m = 0; m < 4; ++m) { const pg8_i32x4 l0_ = *(const PG8_LAS pg8_i32x4*)(lds + PG8_SA(b, h) + aoff + m * 2048), l1_ = *(const PG8_LAS pg8_i32x4*)(lds + PG8_SA(b, h) + aoff + m * 2048 + 1024); dst[m] = __builtin_shufflevector(l0_, l1_, 0, 1, 2, 3, 4, 5, 6, 7); } } while (0)
#define PG8_LDB(dst, b, h) do { _Pragma("unroll") for (int n = 0; n < 2; ++n) { const pg8_i32x4 l0_ = *(const PG8_LAS pg8_i32x4*)(lds + PG8_SB(b, h) + boff + n * 2048), l1_ = *(const PG8_LAS pg8_i32x4*)(lds + PG8_SB(b, h) + boff + n * 2048 + 1024); dst[n] = __builtin_shufflevector(l0_, l1_, 0, 1, 2, 3, 4, 5, 6, 7); } } while (0)
#define PG8_H0(f) __builtin_bit_cast(bf16x8, __builtin_shufflevector((f), (f), 0, 1, 2, 3))
#define PG8_H1(f) __builtin_bit_cast(bf16x8, __builtin_shufflevector((f), (f), 4, 5, 6, 7))
#define PG8_MMA(ai, bj, At, Bt) do { __builtin_amdgcn_s_setprio(1); \
        if constexpr (FP8) { _Pragma("unroll") for (int m = 0; m < 4; ++m) _Pragma("unroll") for (int n = 0; n < 2; ++n) \
            asm volatile("v_mfma_scale_f32_16x16x128_f8f6f4 %0, %1, %2, %0, %3, %4 op_sel_hi:[0,0,0]" : "+v"(acc[ai][bj][m][n]) : "v"(Bt[n]), "v"(At[m]), "v"(scw_), "v"(scx_)); } \
        else { _Pragma("unroll") for (int m = 0; m < 4; ++m) _Pragma("unroll") for (int n = 0; n < 2; ++n) { \
            acc[ai][bj][m][n] = __builtin_amdgcn_mfma_f32_16x16x32_bf16(PG8_H0(Bt[n]), PG8_H0(At[m]), acc[ai][bj][m][n], 0, 0, 0); \
            acc[ai][bj][m][n] = __builtin_amdgcn_mfma_f32_16x16x32_bf16(PG8_H1(Bt[n]), PG8_H1(At[m]), acc[ai][bj][m][n], 0, 0, 0); } } \
        __builtin_amdgcn_s_setprio(0); } while (0)
#define PG8_WAIT_V(n) asm volatile("s_waitcnt vmcnt(" #n ")" ::: "memory")
#define PG8_WAIT_L(n) asm volatile("s_waitcnt lgkmcnt(" #n ")" ::: "memory")
#define PG8_BAR __builtin_amdgcn_s_barrier()
#define PG8_SCHED __builtin_amdgcn_sched_barrier(0)
    Unit cur, nxt; int ui = 0;
    if (!S.next(0, cur)) return;
    f32x4 acc[2][2][4][2];
#pragma unroll
    for (int a = 0; a < 2; ++a)
#pragma unroll
        for (int b = 0; b < 2; ++b)
#pragma unroll
            for (int m = 0; m < 4; ++m)
#pragma unroll
                for (int n = 0; n < 2; ++n) acc[a][b][m][n] = (f32x4){0.f, 0.f, 0.f, 0.f};
    pg8_frag At[4], B0[2], B1[2]; const int scw_ = g.sc_w, scx_ = g.sc_x;
    const char* cA = (const char*)g.A + (size_t)cur.pm * tstep; const char* cB = (const char*)g.Bt + (size_t)cur.pn * tstep + (cur.pm >= g.bsplit ? g.bstride : (size_t)0);
    S.a_ready(cur);
    if constexpr (SP2) {
        PG8_STAGE(PG8_SB(0, 0), cB, voffB); PG8_STAGE(PG8_SB(0, 1), cB + hstep, voffB); PG8_STAGE(PG8_SA(0, 0), cA, voffA); PG8_STAGE(PG8_SA(0, 1), cA + hstep, voffA);
        if (wr == 1) PG8_BAR;
        PG8_WAIT_V(2); PG8_BAR;
        PG8_STAGE(PG8_SB(1, 0), cB + kstep, voffB); PG8_STAGE(PG8_SA(1, 0), cA + kstep, voffA); PG8_STAGE(PG8_SB(1, 1), cB + hstep + kstep, voffB);
        PG8_WAIT_V(6); PG8_BAR;
    } else {
        PG8_STAGE(PG8_SB(0, 0), cB, voffB); PG8_STAGE(PG8_SA(0, 0), cA, voffA); PG8_STAGE(PG8_SB(0, 1), cB + hstep, voffB); PG8_STAGE(PG8_SA(0, 1), cA + hstep, voffA);
        if (wr == 1) PG8_BAR;
        PG8_WAIT_V(4); PG8_BAR;
        PG8_STAGE(PG8_SB(1, 0), cB + kstep, voffB); PG8_STAGE(PG8_SA(1, 0), cA + kstep, voffA); PG8_STAGE(PG8_SB(1, 1), cB + hstep + kstep, voffB);
        PG8_WAIT_V(6); PG8_BAR;
    }
    for (;;) {
        const bool has_next = S.next(ui + 1, nxt);
        const char* nA = has_next ? (const char*)g.A + (size_t)nxt.pm * tstep : cA; const char* nB = has_next ? (const char*)g.Bt + (size_t)nxt.pn * tstep + (nxt.pm >= g.bsplit ? g.bstride : (size_t)0) : cB;
        _Pragma("unroll 1") for (int t = 0; t < nt; t += 2) {
            const bool last = (t == nt - 2);
            const char* a1 = cA + (size_t)(t + 1) * kstep;
            const char* a2 = last ? nA : cA + (size_t)(t + 2) * kstep; const char* b2 = last ? nB : cB + (size_t)(t + 2) * kstep;
            const char* a3 = a2 + kstep; const char* b3 = b2 + kstep;
            if (last && has_next) S.a_ready(nxt);
            if constexpr (SP2) {
            PG8_LDB(B0, 0, 0); PG8_LDB(B1, 0, 1); PG8_SCHED; PG8_LDA(At, 0, 0); PG8_STAGE(PG8_SA(1, 1), a1 + hstep, voffA);
            PG8_WAIT_V(8); PG8_WAIT_L(0); PG8_BAR; PG8_MMA(0, 0, At, B0); PG8_MMA(0, 1, At, B1); PG8_BAR; PG8_SCHED;
            PG8_LDA(At, 0, 1); PG8_STAGE(PG8_SB(0, 0), b2, voffB); PG8_STAGE(PG8_SB(0, 1), b2 + hstep, voffB); PG8_STAGE(PG8_SA(0, 0), a2, voffA);
            PG8_WAIT_V(8); PG8_WAIT_L(0); PG8_BAR; PG8_MMA(1, 0, At, B0); PG8_MMA(1, 1, At, B1); PG8_BAR; PG8_SCHED;
            PG8_LDB(B0, 1, 0); PG8_LDB(B1, 1, 1); PG8_SCHED; PG8_LDA(At, 1, 0); PG8_STAGE(PG8_SA(0, 1), a2 + hstep, voffA);
            PG8_WAIT_V(8); PG8_WAIT_L(0); PG8_BAR; PG8_MMA(0, 0, At, B0); PG8_MMA(0, 1, At, B1); PG8_BAR; PG8_SCHED;
            PG8_LDA(At, 1, 1); PG8_STAGE(PG8_SB(1, 0), b3, voffB); PG8_STAGE(PG8_SB(1, 1), b3 + hstep, voffB); PG8_STAGE(PG8_SA(1, 0), a3, voffA);
            PG8_WAIT_V(8); PG8_WAIT_L(0); PG8_BAR; PG8_MMA(1, 0, At, B0); PG8_MMA(1, 1, At, B1); PG8_BAR; PG8_SCHED;
            } else {
            PG8_LDB(B0, 0, 0); PG8_SCHED; PG8_LDA(At, 0, 0); PG8_STAGE(PG8_SA(1, 1), a1 + hstep, voffA);
            PG8_WAIT_L(8); PG8_BAR; PG8_WAIT_L(0); PG8_MMA(0, 0, At, B0); PG8_BAR; PG8_SCHED;
            PG8_LDB(B1, 0, 1); PG8_STAGE(PG8_SB(0, 0), b2, voffB);
            PG8_BAR; PG8_WAIT_L(0); PG8_MMA(0, 1, At, B1); PG8_BAR;
            PG8_LDA(At, 0, 1); PG8_STAGE(PG8_SA(0, 0), a2, voffA);
            PG8_BAR; PG8_WAIT_L(0); PG8_MMA(1, 0, At, B0); PG8_BAR; PG8_SCHED;
            PG8_STAGE(PG8_SB(0, 1), b2 + hstep, voffB);
            PG8_WAIT_V(6); PG8_BAR; PG8_MMA(1, 1, At, B1); PG8_BAR;
            PG8_LDB(B0, 1, 0); PG8_SCHED; PG8_LDA(At, 1, 0); PG8_STAGE(PG8_SA(0, 1), a2 + hstep, voffA);
            PG8_WAIT_L(8); PG8_BAR; PG8_WAIT_L(0); PG8_MMA(0, 0, At, B0); PG8_BAR; PG8_SCHED;
            PG8_LDB(B1, 1, 1); PG8_STAGE(PG8_SB(1, 0), b3, voffB);
            PG8_BAR; PG8_WAIT_L(0); PG8_MMA(0, 1, At, B1); PG8_BAR;
            PG8_LDA(At, 1, 1); PG8_STAGE(PG8_SA(1, 0), a3, voffA);
            PG8_BAR; PG8_WAIT_L(0); PG8_MMA(1, 0, At, B0); PG8_BAR; PG8_SCHED;
            PG8_STAGE(PG8_SB(1, 1), b3 + hstep, voffB);
            PG8_WAIT_V(6); PG8_BAR; PG8_MMA(1, 1, At, B1); PG8_BAR;
            }
        }
        if constexpr (ALIGN_EPI) { if (wr == 0) PG8_BAR; }
        if constexpr (FP8) {
            asm volatile("s_nop 15\n\ts_nop 15" ::: "memory");
#pragma unroll
            for (int a = 0; a < 2; ++a)
#pragma unroll
                for (int b = 0; b < 2; ++b)
#pragma unroll
                    for (int m = 0; m < 4; ++m)
#pragma unroll
                        for (int n = 0; n < 2; ++n) asm volatile("" : "+v"(acc[a][b][m][n]));
        }
        if constexpr (!Epi::AFTER_DRAIN) { E(acc, cur, wr, wc, fr, fq); S.done(cur); }
        if (!has_next) break;
#pragma unroll
        for (int a = 0; a < 2; ++a)
#pragma unroll
            for (int b = 0; b < 2; ++b)
#pragma unroll
                for (int m = 0; m < 4; ++m)
#pragma unroll
                    for (int n = 0; n < 2; ++n) acc[a][b][m][n] = (f32x4){0.f, 0.f, 0.f, 0.f};
        cur = nxt; cA = nA; cB = nB; ++ui;
        if constexpr (ALIGN_EPI) { if (wr == 1) PG8_BAR; }
    }
    PG8_WAIT_V(0);
    if constexpr (!ALIGN_EPI) { if (wr == 0) PG8_BAR; }
    PG8_BAR;
    if constexpr (Epi::AFTER_DRAIN) { E.fused(acc, cur, wr, wc, fr, fq, lds, wid, lane); S.done(cur); }
#undef PG8_SA
#undef PG8_SB
#undef PG8_STAGE
#undef PG8_LDA
#undef PG8_LDB
#undef PG8_MMA
#undef PG8_H0
#undef PG8_H1
#undef PG8_WAIT_V
#undef PG8_WAIT_L
#undef PG8_BAR
#undef PG8_SCHED
}
}
#define GAS __attribute__((address_space(1)))
#define LAS __attribute__((address_space(3)))
typedef unsigned short bf16;
typedef unsigned v4u __attribute__((ext_vector_type(4)));
typedef float f32x4 __attribute__((ext_vector_type(4)));
typedef short bf16x8 __attribute__((ext_vector_type(8)));
typedef GAS unsigned gu32;
typedef GAS unsigned long long gu64;
#define RLX_AGENT __ATOMIC_RELAXED, __HIP_MEMORY_SCOPE_AGENT
#define LDS_WAIT() asm volatile("s_waitcnt lgkmcnt(0)" ::: "memory")
#define VM_WAIT() asm volatile("s_waitcnt vmcnt(0)" ::: "memory")
__device__ __forceinline__ unsigned long long rt() { return __builtin_amdgcn_s_memrealtime(); }
__device__ __forceinline__ unsigned f2bf(float f) { unsigned u = __builtin_bit_cast(unsigned, f); return (u + 0x7fffu + ((u >> 16) & 1u)) >> 16; }
__device__ __forceinline__ unsigned pk2(float lo, float hi) { return f2bf(lo) | (f2bf(hi) << 16); }
#define XB_TMO      128
#define XB_XCNT(j)  (256  + 64 * (j))
#define XB_XSUB(j)  (1280 + 64 * (j))
#define XB_XGEN(j)  (2304 + 64 * (j))
#define XB_TOP      3328
#define XB_TOPGEN   3392
#define XCD_BAR_WORDS 3456
#define XB_SPIN_CAP (1u << 18)

__device__ __forceinline__ unsigned xb_ld(unsigned* p)              { return __hip_atomic_load(p, __ATOMIC_RELAXED, __HIP_MEMORY_SCOPE_AGENT); }
__device__ __forceinline__ unsigned xb_add(unsigned* p, unsigned v) { return __hip_atomic_fetch_add(p, v, __ATOMIC_RELAXED, __HIP_MEMORY_SCOPE_AGENT); }
__device__ __forceinline__ unsigned xb_xcc_id() { return (unsigned)__builtin_amdgcn_s_getreg((3 << 11) | 20) & 0xFu; }
#define XB_SPIN(cond, bar) do { unsigned _sp = 0; while (cond) { __builtin_amdgcn_s_sleep(1); \
    if ((++_sp & 255u) == 0u) { if (xb_ld(&(bar)[XB_TMO])) break; if (_sp > XB_SPIN_CAP) { atomicAdd(&(bar)[XB_TMO], 1u); break; } } } } while (0)

struct XcdBarrier {
    unsigned* bar; unsigned x;
    volatile LAS unsigned* st;
};

__device__ __forceinline__ XcdBarrier xcd_barrier_post(unsigned* bar, volatile LAS unsigned* st) {
    XcdBarrier b; b.bar = bar; b.x = xb_xcc_id(); b.st = st;
    if (threadIdx.x == 0) (void)xb_add(&bar[XB_XCNT(b.x)], 1u);
    return b;
}
__device__ __forceinline__ void xcd_barrier_complete(unsigned* bar, unsigned x, unsigned& nloc, unsigned& nx) {
    const unsigned G = gridDim.x * gridDim.y * gridDim.z;
    unsigned sum, cnt, mine, sp = 0u;
    for (;;) {
        sum = 0u; cnt = 0u; mine = 0u;
#pragma unroll
        for (unsigned j = 0; j < 16; ++j) { const unsigned c = xb_ld(&bar[XB_XCNT(j)]); sum += c; cnt += (c > 0u) ? 1u : 0u; mine = (j == x) ? c : mine; }
        if (sum == G) break;
        __builtin_amdgcn_s_sleep(1);
        if ((++sp & 255u) == 0u) { if (xb_ld(&bar[XB_TMO])) break; if (sp > XB_SPIN_CAP) { atomicAdd(&bar[XB_TMO], 1u); break; } }
    }
    nloc = mine > 0u ? mine : 1u; nx = cnt > 0u ? cnt : 1u;
}

__device__ __forceinline__ void xcd_barrier(const XcdBarrier& b) {
    asm volatile("s_waitcnt vmcnt(0)" ::: "memory");
    __syncthreads();
    if (threadIdx.x == 0) {
        unsigned* bar = b.bar;
        __builtin_amdgcn_s_waitcnt(0);
        unsigned nloc = b.st[0], nx = b.st[1];
        if (nloc == 0u) { xcd_barrier_complete(bar, b.x, nloc, nx); b.st[0] = nloc; b.st[1] = nx; }
        const unsigned old = xb_add(&bar[XB_XSUB(b.x)], 1u);
        const unsigned gen = old / nloc;
        if (old + 1u == (gen + 1u) * nloc) {
            __builtin_amdgcn_fence(__ATOMIC_RELEASE, "agent");
            asm volatile("s_waitcnt vmcnt(0)" ::: "memory");
            const unsigned og = xb_add(&bar[XB_TOP], 1u);
            const unsigned tg = og / nx;
            if (og + 1u == (tg + 1u) * nx) xb_add(&bar[XB_TOPGEN], 1u);
            else XB_SPIN(xb_ld(&bar[XB_TOPGEN]) == tg, bar);
            __builtin_amdgcn_fence(__ATOMIC_ACQUIRE, "agent");
            xb_add(&bar[XB_XGEN(b.x)], 1u);
            asm volatile("s_waitcnt vmcnt(0)" ::: "memory");
        } else {
            XB_SPIN(xb_ld(&bar[XB_XGEN(b.x)]) == gen, bar);
            __builtin_amdgcn_fence(__ATOMIC_ACQUIRE, "agent");
            asm volatile("s_waitcnt vmcnt(0)" ::: "memory");
        }
    }
    __syncthreads();
}
constexpr int NWAVES = 8, NTHREADS = 512;
constexpr int TT = 16384, DM = 1024, SEQ = 8192, NIN = 1280, NQD = 2048, NEXP = 16384;
constexpr float DN_ALPHA = 1.189207115002721f;
constexpr float LN_EPS = 1e-5f;
constexpr float LOG2E = 1.4426950408889634f;
constexpr float QSCALE = 0.125f * LOG2E;

constexpr size_t MiB = 1u << 20;
constexpr size_t WS_CTL = 0, CTL_ZERO_BYTES = 64 * 1024;
constexpr size_t WS_MODP = 1 * MiB;
constexpr size_t WS_MOD = 1 * MiB + 896 * 1024;
constexpr size_t WS_ROPE = 2 * MiB;
constexpr size_t WS_WIN = 248 * MiB;
constexpr size_t WS_BIAS = 4 * MiB;
constexpr size_t WS_K1 = 6 * MiB + 512 * 1024, WS_K2 = WS_K1 + 32 * 1024;
constexpr size_t WS_WOUT = 7 * MiB;
constexpr size_t WS_WPQ = 9 * MiB;
constexpr size_t WS_SU = 13 * MiB, WS_SV = 13 * MiB + 65536;
constexpr size_t WS_U = 16 * MiB, WS_V = 32 * MiB;
constexpr size_t WS_H2Q = 48 * MiB, WS_SH = 13 * MiB + 131072;
constexpr size_t WS_XN8 = 64 * MiB;
constexpr size_t WS_XN = 80 * MiB;
constexpr size_t WS_MIX = 112 * MiB;
constexpr size_t WS_PE = 80 * MiB, WS_PG = 84 * MiB;
constexpr size_t WS_PROJ = 112 * MiB;
constexpr size_t WS_A2 = 152 * MiB;
constexpr size_t WS_X1 = 184 * MiB, WS_H2 = 216 * MiB;
constexpr size_t WS_Q = 112 * MiB;
constexpr size_t WS_END = 253 * MiB;
constexpr int CW_MODCNT = 1024;
constexpr int CW_BAR = 4096;

constexpr int RING_BYTES = 131072, LDSCTL_OFF = RING_BYTES, MISC_OFF = LDSCTL_OFF + 320, LDS_BYTES = 147456;

typedef float f32x16 __attribute__((ext_vector_type(16)));
typedef float f32x2 __attribute__((ext_vector_type(2)));
typedef unsigned u32x2 __attribute__((ext_vector_type(2)));
typedef unsigned u32x4 __attribute__((ext_vector_type(4)));
typedef __bf16 bf16x2_t __attribute__((ext_vector_type(2)));
struct Frame {
    LAS unsigned char* lds;
    int tid, lane, wave, vcu, G;
    const float *x, *c, *w_ada, *b_ada, *w_in, *sinks, *w_pool, *pool_scale, *w_out, *ln1_g, *ln1_b, *w_pq, *k1, *k2, *pu, *pv, *ln2_g, *ln2_b;
    float* out; unsigned char* ws;
};
__device__ __forceinline__ float wave_sum(float v) {
#pragma unroll
    for (int o = 1; o < 64; o <<= 1) v += __shfl_xor(v, o);
    return v;
}
__device__ __forceinline__ float bf_lo(unsigned u) { return __uint_as_float(u << 16); }
__device__ __forceinline__ float bf_hi(unsigned u) { return __uint_as_float(u & 0xffff0000u); }
__device__ __forceinline__ float bf2f(bf16 b) { return __uint_as_float((unsigned)b << 16); }
__device__ __forceinline__ unsigned fp8x4(float a, float b, float c, float d) { int pk = __builtin_amdgcn_cvt_pk_fp8_f32(a, b, 0, false); pk = __builtin_amdgcn_cvt_pk_fp8_f32(c, d, pk, true); return (unsigned)pk; }

template <int MODE, bool OUT8 = false>
__device__ __forceinline__ void transpose_item(const float* W, int ldw, bf16* WT, int ldt, int k0, int n0, LAS float* scr, int lane, const LAS float* ksc = nullptr, float oscale = 1.0f) {
    int nsrc = n0 + (lane & 31);
    if (MODE == 1 && nsrc < 640) { const int hd = nsrc >> 6, w = nsrc & 63; nsrc = hd * 64 + (w >> 1) + 32 * (w & 1); }
    float wv[32];
#pragma unroll
    for (int i = 0; i < 32; ++i) wv[i] = W[(size_t)(k0 + 2 * i + (lane >> 5)) * ldw + nsrc];
#pragma unroll
    for (int i = 0; i < 32; ++i) { const int kk = 2 * i + (lane >> 5); float w_ = wv[i]; if (MODE == 1) w_ *= ksc[k0 + kk]; scr[kk * 33 + (lane & 31)] = w_; }
    LDS_WAIT(); asm volatile("" ::: "memory");
    const int c = lane & 7;
#pragma unroll
    for (int j = 0; j < 4; ++j) { const int n = (lane >> 3) + 8 * j; const LAS float* s = scr + (8 * c) * 33 + n;
        if (OUT8) { u32x2 o8; o8.x = fp8x4(s[0 * 33] * oscale, s[1 * 33] * oscale, s[2 * 33] * oscale, s[3 * 33] * oscale); o8.y = fp8x4(s[4 * 33] * oscale, s[5 * 33] * oscale, s[6 * 33] * oscale, s[7 * 33] * oscale);
            *(u32x2*)((unsigned char*)WT + (size_t)(n0 + n) * ldt + k0 + 8 * c) = o8; }
        else { v4u o; o.x = pk2(s[0 * 33], s[1 * 33]); o.y = pk2(s[2 * 33], s[3 * 33]); o.z = pk2(s[4 * 33], s[5 * 33]); o.w = pk2(s[6 * 33], s[7 * 33]);
            *(GAS v4u*)(WT + (size_t)(n0 + n) * ldt + k0 + 8 * c) = o; } }
    LDS_WAIT(); asm volatile("" ::: "memory");
}
__device__ __forceinline__ void sincos_d(double a, float& s, float& c) {
    const double TWO_PI = 6.283185307179586476925, PI = 3.141592653589793238462643;
    double r = a - TWO_PI * rint(a / TWO_PI);
    double sg = 1.0;
    if (r > 0.5 * PI) { r = PI - r; sg = -1.0; } else if (r < -0.5 * PI) { r = -PI - r; sg = -1.0; }
    const double r2 = r * r;
    double sp = -1.0 / 121645100408832000.0;
    sp = sp * r2 + 1.0 / 355687428096000.0; sp = sp * r2 - 1.0 / 1307674368000.0; sp = sp * r2 + 1.0 / 6227020800.0; sp = sp * r2 - 1.0 / 39916800.0;
    sp = sp * r2 + 1.0 / 362880.0; sp = sp * r2 - 1.0 / 5040.0; sp = sp * r2 + 1.0 / 120.0; sp = sp * r2 - 1.0 / 6.0; sp = sp * r2 + 1.0;
    double cp = 1.0 / 6402373705728000.0;
    cp = cp * r2 - 1.0 / 20922789888000.0; cp = cp * r2 + 1.0 / 87178291200.0; cp = cp * r2 - 1.0 / 479001600.0; cp = cp * r2 + 1.0 / 3628800.0;
    cp = cp * r2 - 1.0 / 40320.0; cp = cp * r2 + 1.0 / 720.0; cp = cp * r2 - 1.0 / 24.0; cp = cp * r2 + 0.5; cp = 1.0 - cp * r2;
    s = (float)(sp * r); c = (float)(sg * cp);
}
__device__ __forceinline__ void p1_win(Frame& F);
__device__ __forceinline__ void p0_prologue(Frame& F, int parts = 0xff) {
    LAS float* scr = (LAS float*)(F.lds + F.wave * 16384);
    const int gw = F.vcu * NWAVES + F.wave, NGW = F.G * NWAVES, lane = F.lane;
    if ((parts & 1) && (int)blockIdx.x < 192) { const int gb = (int)blockIdx.x, chunk = gb % 96, kh = gb / 96, col = chunk * 64 + lane, kbase = kh * 512 + F.wave * 64; float a0 = 0.f, a1 = 0.f;
        LAS float* sl = (LAS float*)(F.lds + F.wave * 16384 + 8448);
        { const int k = kbase + lane; const float c0 = F.c[k], c1 = F.c[DM + k]; sl[lane] = c0 / (1.f + __expf(-c0)); sl[64 + lane] = c1 / (1.f + __expf(-c1)); }
        LDS_WAIT(); asm volatile("" ::: "memory");
        { float w[64];
#pragma unroll
            for (int u = 0; u < 64; ++u) w[u] = F.w_ada[(size_t)(kbase + u) * 6144 + col];
#pragma unroll
            for (int u = 0; u < 64; ++u) { a0 += sl[u] * w[u]; a1 += sl[64 + u] * w[u]; } }
        LAS float* red = (LAS float*)(F.lds + F.wave * 16384 + 12288); red[lane] = a0; red[64 + lane] = a1;
        __syncthreads();
        if (F.tid < 128) { const int bb = F.tid >> 6, l = F.tid & 63; float sacc = kh == 0 ? F.b_ada[chunk * 64 + l] : 0.f;
#pragma unroll
            for (int w = 0; w < 8; ++w) sacc += ((const LAS float*)(F.lds + w * 16384 + 12288))[bb * 64 + l];
            ((float*)(F.ws + WS_MODP))[(kh * 2 + bb) * 6144 + chunk * 64 + l] = sacc; }
        asm volatile("s_waitcnt vmcnt(0)" ::: "memory"); __syncthreads();
        if (F.tid == 0) { __builtin_amdgcn_fence(__ATOMIC_RELEASE, "agent"); asm volatile("s_waitcnt vmcnt(0)" ::: "memory");
            __hip_atomic_fetch_add((unsigned*)(F.ws + WS_CTL) + CW_MODCNT, 1u, __ATOMIC_RELAXED, __HIP_MEMORY_SCOPE_AGENT); } }
    if (parts & 2) { float* rope = (float*)(F.ws + WS_ROPE);
      for (int e = gw * 64 + lane; e < SEQ * 32; e += NGW * 64) { const int pos = e >> 5, i = e & 31;
          const float freq = powf(10000.0f, -(float)i / 32.0f); const float ang = (float)pos * freq; float s, c; sincos_d((double)ang, s, c);
          rope[2 * e] = c; rope[2 * e + 1] = s; } }
    if (parts & 4) { constexpr int I_PQ = 16 * 64, I_OUT = 8 * 32;
      for (int it = NGW - 1 - gw; it < I_PQ + I_OUT; it += NGW) { int r = it;
          if (r < I_PQ) { transpose_item<0>(F.w_pq, NQD, (bf16*)(F.ws + WS_WPQ), DM, 64 * (r / 64), 32 * (r % 64), scr, lane); continue; } r -= I_PQ;
          transpose_item<0, true>(F.w_out, DM, (bf16*)(F.ws + WS_WOUT), DM, 64 * (r / 32), 32 * (r % 32), scr, lane, nullptr, 64.0f); } }
    if (parts & 8) { unsigned char* wout_t = F.ws + WS_WOUT;
      for (int it = gw; it < 4 * 2 * 128; it += NGW) { const int g = it >> 8, ch = (it >> 7) & 1, n0 = (it & 127) * 8, cidx = ch * 64 + lane;
          const float* wo = F.w_out + (size_t)(512 + g * 128) * DM + n0; const float* ps = F.pool_scale + g * 128;
#pragma unroll
          for (int i = 0; i < 4; ++i) { const int f4 = lane + 64 * i, e = f4 >> 1, hf = f4 & 1; const f32x4 o = *(const f32x4*)(wo + (size_t)e * DM + 4 * hf) * ps[e]; *(LAS f32x4*)(scr + e * 8 + 4 * hf) = o; }
          float acc[8];
#pragma unroll
          for (int i = 0; i < 8; ++i) acc[i] = 0.f;
          const float* wp = F.w_pool + ((size_t)(g * 128 + cidx)) * 128;
          LDS_WAIT(); asm volatile("" ::: "memory");
#pragma unroll 1
          for (int e0 = 0; e0 < 128; e0 += 64) { f32x4 wv[16];
#pragma unroll
              for (int q = 0; q < 16; ++q) wv[q] = *(const f32x4*)(wp + e0 + 4 * q);
#pragma unroll
              for (int q = 0; q < 16; ++q)
#pragma unroll
                  for (int ee = 0; ee < 4; ++ee) { const float w = wv[q][ee]; const f32x4 o0 = *(const LAS f32x4*)(scr + (e0 + 4 * q + ee) * 8), o1 = *(const LAS f32x4*)(scr + (e0 + 4 * q + ee) * 8 + 4);
                      acc[0] += w * o0[0]; acc[1] += w * o0[1]; acc[2] += w * o0[2]; acc[3] += w * o0[3]; acc[4] += w * o1[0]; acc[5] += w * o1[1]; acc[6] += w * o1[2]; acc[7] += w * o1[3]; } }
#pragma unroll
          for (int i = 0; i < 8; ++i) wout_t[(size_t)(n0 + i) * DM + 512 + g * 128 + cidx] = (unsigned char)(fp8x4(acc[i] * 64.0f, 0.f, 0.f, 0.f) & 0xffu);
          LDS_WAIT(); asm volatile("" ::: "memory"); } }
    if (parts & 16) { bf16* k1b = (bf16*)(F.ws + WS_K1); bf16* k2b = (bf16*)(F.ws + WS_K2);
      for (int e = gw * 64 + lane; e < 128 * 128; e += NGW * 64) { k1b[e] = (bf16)f2bf(F.k1[e]); k2b[e] = (bf16)f2bf(F.k2[e]); } }
    if (parts & 32) { bf16* xn = (bf16*)(F.ws + WS_XN); const int rpw = TT / NGW;
      for (int m = gw * rpw; m < gw * rpw + rpw; m += 4) { f32x4 v[4][4];
#pragma unroll
          for (int q = 0; q < 4; ++q)
#pragma unroll
              for (int j = 0; j < 4; ++j) v[q][j] = *(const f32x4*)(F.x + (size_t)(m + q) * DM + 256 * j + 4 * lane);
#pragma unroll
          for (int q = 0; q < 4; ++q)
#pragma unroll
              for (int j = 0; j < 4; ++j) { u32x2 o; o.x = pk2(v[q][j][0], v[q][j][1]); o.y = pk2(v[q][j][2], v[q][j][3]); *(u32x2*)(xn + (size_t)(m + q) * DM + 256 * j + 4 * lane) = o;
                  *(unsigned*)(F.ws + WS_XN8 + (size_t)(m + q) * DM + 256 * j + 4 * lane) = fp8x4(v[q][j][0], v[q][j][1], v[q][j][2], v[q][j][3]); } } }
    if (parts & 64) {
        __syncthreads();
        if (F.tid == 0) { unsigned sp = 0; const unsigned* cnt = (const unsigned*)(F.ws + WS_CTL) + CW_MODCNT;
            while (__hip_atomic_load(cnt, __ATOMIC_RELAXED, __HIP_MEMORY_SCOPE_AGENT) < 192u) { __builtin_amdgcn_s_sleep(2); if (++sp > (1u << 22)) break; }
            __builtin_amdgcn_fence(__ATOMIC_ACQUIRE, "agent"); asm volatile("s_waitcnt vmcnt(0)" ::: "memory"); }
        __syncthreads();
        p1_win(F);
    }
}
__device__ __forceinline__ void tb_load4(Frame& F, int base, int r1, f32x4 (&dst)[4][4]) {
#pragma unroll
    for (int q = 0; q < 4; ++q) { const int it = (base + q < r1) ? base + q : r1 - 1; const int tb = it >= NEXP, e = it - tb * NEXP; const float* src = (tb ? F.pv : F.pu) + (size_t)e * DM;
#pragma unroll
        for (int j = 0; j < 4; ++j) dst[q][j] = *(const f32x4*)(src + 256 * j + 4 * F.lane); }
}
__device__ __forceinline__ void tb_proc4(Frame& F, int base, int r1, const f32x4 (&v)[4][4]) {
    const int lane = F.lane; float* su = (float*)(F.ws + WS_SU); float* sv = (float*)(F.ws + WS_SV); float am[4];
#pragma unroll
    for (int q = 0; q < 4; ++q) { float a = 0.f;
#pragma unroll
        for (int j = 0; j < 4; ++j) a = fmaxf(a, fmaxf(fmaxf(fabsf(v[q][j][0]), fabsf(v[q][j][1])), fmaxf(fabsf(v[q][j][2]), fabsf(v[q][j][3])))); am[q] = a; }
#pragma unroll
    for (int o = 1; o < 64; o <<= 1) {
#pragma unroll
        for (int q = 0; q < 4; ++q) am[q] = fmaxf(am[q], __shfl_xor(am[q], o)); }
#pragma unroll
    for (int q = 0; q < 4; ++q) { const int it = (base + q < r1) ? base + q : r1 - 1; const int tb = it >= NEXP, e = it - tb * NEXP; float a = am[q]; if (a == 0.f) a = 1.f;
        unsigned w[4];
        if (!tb) { const float inv = 127.0f / a;
#pragma unroll
            for (int j = 0; j < 4; ++j) { const int q0 = (int)rintf(v[q][j][0] * inv), q1 = (int)rintf(v[q][j][1] * inv), q2 = (int)rintf(v[q][j][2] * inv), q3 = (int)rintf(v[q][j][3] * inv);
                w[j] = (unsigned)(q0 & 255) | ((unsigned)(q1 & 255) << 8) | ((unsigned)(q2 & 255) << 16) | ((unsigned)(q3 & 255) << 24); }
            *(v4u*)(F.ws + WS_U + (size_t)e * DM + 16 * lane) = (v4u){w[0], w[1], w[2], w[3]}; if (lane == 0) su[e] = a * (1.0f / 127.0f);
        } else { const float inv = 256.0f / a;
#pragma unroll
            for (int j = 0; j < 4; ++j) { unsigned wv = 0u, g = 0u;
#pragma unroll
                for (int i = 0; i < 4; ++i) { const float t = v[q][j][i] * inv; const unsigned short hb = __builtin_bit_cast(unsigned short, (_Float16)t);
                    const int m = (int)(hb & 0x7fffu); int h7 = (m - (int)g + 128) >> 8; h7 = h7 < 0 ? 0 : (h7 > 0x7B ? 0x7B : h7);
                    const unsigned byte = (unsigned)h7 | ((hb >> 8) & 0x80u); wv |= byte << (8 * i); g = byte; }
                w[j] = wv; }
            *(v4u*)(F.ws + WS_V + (size_t)e * DM + 16 * lane) = (v4u){w[0], w[1], w[2], w[3]}; if (lane == 0) sv[e] = a * (1.0f / 256.0f); } }
}
__device__ __forceinline__ void p2_tables(Frame& F, int cw, int ncw, int row_lo, int row_hi) {
    const int per = (row_hi - row_lo + ncw - 1) / ncw, r0 = row_lo + cw * per, r1 = (r0 + per) < row_hi ? (r0 + per) : row_hi;
    if (r0 >= r1) return;
    f32x4 va[4][4], vb[4][4];
    tb_load4(F, r0, r1, va);
    for (int it0 = r0; it0 < r1; it0 += 8) {
        if (it0 + 4 < r1) tb_load4(F, it0 + 4, r1, vb);
        tb_proc4(F, it0, r1, va);
        if (it0 + 4 < r1) { if (it0 + 8 < r1) tb_load4(F, it0 + 8, r1, va); tb_proc4(F, it0 + 4, r1, vb); }
    }
}
__device__ __forceinline__ void p1_win(Frame& F) {
    const float* mp = (const float*)(F.ws + WS_MODP);
    if (F.vcu < 48 && F.tid < 256) { const int e = F.vcu * 256 + F.tid; ((float*)(F.ws + WS_MOD))[e] = mp[e] + mp[2 * 6144 + e]; }
    LAS float* sc = (LAS float*)F.lds; LAS float* sh = sc + 2048;
    for (int i = F.tid; i < 2048; i += NTHREADS) { const int b = i >> 10, k = i & 1023; sc[i] = 1.f + mp[b * 6144 + 1024 + k] + mp[(2 + b) * 6144 + 1024 + k]; sh[i] = mp[b * 6144 + k] + mp[(2 + b) * 6144 + k]; }
    __syncthreads();
    const int lane = F.lane;
    if (F.vcu < 40) { const int b = F.vcu / 20, n = (F.vcu % 20) * 64 + lane; int nsrc = n; if (n < 640) { const int hd = n >> 6, w = n & 63; nsrc = hd * 64 + (w >> 1) + 32 * (w & 1); }
        float a = 0.f;
#pragma unroll 1
        for (int kb = 0; kb < 128; kb += 64) { float w[64];
#pragma unroll
            for (int u = 0; u < 64; ++u) w[u] = F.w_in[(size_t)(F.wave * 128 + kb + u) * NIN + nsrc];
#pragma unroll
            for (int u = 0; u < 64; ++u) a += sh[b * 1024 + F.wave * 128 + kb + u] * w[u]; }
        LAS float* red = (LAS float*)(F.lds + 16384); red[F.wave * 64 + lane] = a;
        __syncthreads();
        if (F.tid < 64) { float sacc = 0.f;
#pragma unroll
            for (int w = 0; w < 8; ++w) sacc += red[w * 64 + F.tid];
            ((float*)(F.ws + WS_BIAS))[b * NIN + (F.vcu % 20) * 64 + F.tid] = sacc; } }
    LAS float* scr = (LAS float*)(F.lds + 32768 + F.wave * 8448);
    const int gw = F.vcu * NWAVES + F.wave, NGW = F.G * NWAVES;
    for (int it = gw; it < 2 * 640; it += NGW) { const int b = it / 640, r = it % 640;
        transpose_item<1, true>(F.w_in, NIN, (bf16*)(F.ws + WS_WIN + (size_t)b * NIN * DM), DM, 64 * (r / 40), 32 * (r % 40), scr, lane, sc + b * 1024, 64.0f); }
    __syncthreads();
}
constexpr int KS_STRIDE = 144, VT_STRIDE = 520, KS_BYTES = 256 * KS_STRIDE, VT_BYTES = 64 * VT_STRIDE;
__device__ __forceinline__ void p3_attn_unit(Frame& F, int unit) {
    const int b = unit >> 7, kvh = (unit >> 6) & 1, n = unit & 63;
    const bf16* proj = (const bf16*)(F.ws + WS_PROJ); unsigned char* a2 = F.ws + WS_A2;
    LAS unsigned char* Ks = F.lds; LAS unsigned char* Vt = F.lds + KS_BYTES;
    const int tid = F.tid, lane = F.lane, wave = F.wave, r32 = lane & 31, h = lane >> 5;
    const size_t tok0 = (size_t)b * SEQ + (size_t)n * 128;
#pragma unroll
    for (int i = 0; i < 4; ++i) { const int ci = tid + NTHREADS * i, row = ci >> 3, ch = ci & 7; const bool valid = (n > 0) || (row >= 128);
        const size_t tk = tok0 - 128 + row;
        v4u kv = (v4u){0u, 0u, 0u, 0u}, vv = (v4u){0u, 0u, 0u, 0u};
        if (valid) { kv = *(const v4u*)(proj + tk * NIN + 512 + kvh * 64 + ch * 8); vv = *(const v4u*)(proj + tk * NIN + 640 + kvh * 64 + ch * 8); }
        *(LAS v4u*)(Ks + row * KS_STRIDE + ch * 16) = kv;
        LAS bf16* vt = (LAS bf16*)(Vt + (ch * 8) * VT_STRIDE) + row;
        vt[0 * (VT_STRIDE / 2)] = (bf16)(vv.x & 0xffff); vt[1 * (VT_STRIDE / 2)] = (bf16)(vv.x >> 16); vt[2 * (VT_STRIDE / 2)] = (bf16)(vv.y & 0xffff); vt[3 * (VT_STRIDE / 2)] = (bf16)(vv.y >> 16);
        vt[4 * (VT_STRIDE / 2)] = (bf16)(vv.z & 0xffff); vt[5 * (VT_STRIDE / 2)] = (bf16)(vv.z >> 16); vt[6 * (VT_STRIDE / 2)] = (bf16)(vv.w & 0xffff); vt[7 * (VT_STRIDE / 2)] = (bf16)(vv.w >> 16); }
    __syncthreads();
    const int g = wave >> 1, hq = kvh * 4 + g; const float sink2 = F.sinks[hq] * LOG2E;
#pragma unroll 1
    for (int qt = 0; qt < 2; ++qt) {
        const int qi0 = (wave & 1) * 64 + qt * 32, t0 = qi0 >> 5; const size_t tokq = tok0 + qi0 + r32;
        bf16x8 qf[4];
#pragma unroll
        for (int s = 0; s < 4; ++s) qf[s] = *(const bf16x8*)(proj + tokq * NIN + hq * 64 + 16 * s + 8 * h);
        f32x16 sc[5];
#pragma unroll
        for (int kt = 0; kt < 5; ++kt) { sc[kt] = (f32x16){};
#pragma unroll
            for (int s = 0; s < 4; ++s) { const bf16x8 kf = *(const LAS bf16x8*)(Ks + (32 * (t0 + kt) + r32) * KS_STRIDE + (16 * s + 8 * h) * 2);
                sc[kt] = __builtin_amdgcn_mfma_f32_32x32x16_bf16(kf, qf[s], sc[kt], 0, 0, 0); } }
        const int qi = qi0 + r32; float m = sink2;
#pragma unroll
        for (int kt = 0; kt < 5; ++kt)
#pragma unroll
            for (int r = 0; r < 16; ++r) { const int sidx = 32 * (t0 + kt) + (r & 3) + 8 * (r >> 2) + 4 * h; const int rel = qi + 128 - sidx;
                const bool ok = (rel >= 0) && (rel < 128) && ((n > 0) || (sidx >= 128));
                const float v = ok ? sc[kt][r] : -INFINITY; sc[kt][r] = v; m = fmaxf(m, v); }
        m = fmaxf(m, __shfl_xor(m, 32));
        float l = 0.f;
#pragma unroll
        for (int kt = 0; kt < 5; ++kt)
#pragma unroll
            for (int r = 0; r < 16; ++r) { const float p = __builtin_amdgcn_exp2f(sc[kt][r] - m); sc[kt][r] = p; l += p; }
        l += __shfl_xor(l, 32); l += __builtin_amdgcn_exp2f(sink2 - m);
        f32x16 o[2]; o[0] = (f32x16){}; o[1] = (f32x16){};
#pragma unroll
        for (int kt = 0; kt < 5; ++kt)
#pragma unroll
            for (int s2 = 0; s2 < 2; ++s2) {
                u32x4 pw; pw.x = pg8::cvt_pk_bf16(sc[kt][8 * s2 + 0], sc[kt][8 * s2 + 1]); pw.y = pg8::cvt_pk_bf16(sc[kt][8 * s2 + 2], sc[kt][8 * s2 + 3]);
                pw.z = pg8::cvt_pk_bf16(sc[kt][8 * s2 + 4], sc[kt][8 * s2 + 5]); pw.w = pg8::cvt_pk_bf16(sc[kt][8 * s2 + 6], sc[kt][8 * s2 + 7]);
                const bf16x8 pf = __builtin_bit_cast(bf16x8, pw);
#pragma unroll
                for (int dt = 0; dt < 2; ++dt) { const LAS unsigned char* vp = Vt + (dt * 32 + r32) * VT_STRIDE + (32 * (t0 + kt) + 16 * s2 + 4 * h) * 2;
                    const u32x2 lo = *(const LAS u32x2*)vp, hi = *(const LAS u32x2*)(vp + 16);
                    const u32x4 vw = (u32x4){lo.x, lo.y, hi.x, hi.y};
                    o[dt] = __builtin_amdgcn_mfma_f32_32x32x16_bf16(__builtin_bit_cast(bf16x8, vw), pf, o[dt], 0, 0, 0); } }
        const float inv = 16.0f / l;
#pragma unroll
        for (int dt = 0; dt < 2; ++dt)
#pragma unroll
            for (int rg = 0; rg < 4; ++rg) { const int d0 = dt * 32 + 8 * rg + 4 * h;
                *(unsigned*)(a2 + tokq * DM + hq * 64 + d0) = fp8x4(o[dt][4 * rg + 0] * inv, o[dt][4 * rg + 1] * inv, o[dt][4 * rg + 2] * inv, o[dt][4 * rg + 3] * inv); }
    }
    __syncthreads();
}
__device__ __forceinline__ void p3_pool_unit(Frame& F, int unit) {
    const bf16* proj = (const bf16*)(F.ws + WS_PROJ); unsigned char* a2 = F.ws + WS_A2;
    const int cp = F.tid & 255, half = F.tid >> 8, gi = cp >> 6, w = 2 << gi;
    const int tstart = unit * 64 + half * 32, s0 = tstart & (SEQ - 1);
    const bf16* pc = proj + 768 + 2 * cp;
    unsigned u[48];
#pragma unroll
    for (int i = 0; i < 48; ++i) { const int s = s0 - 16 + i; u[i] = (s >= 0) ? *(const unsigned*)(pc + (size_t)(tstart - 16 + i) * NIN) : 0u; }
    float w0 = 0.f, w1 = 0.f;
#pragma unroll
    for (int j = 1; j <= 16; ++j) if (j <= w) { w0 += bf_lo(u[16 - j]); w1 += bf_hi(u[16 - j]); }
#pragma unroll
    for (int i = 0; i < 32; ++i) { const int s = s0 + i; const float p0 = bf_lo(u[16 + i]), p1 = bf_hi(u[16 + i]);
        const unsigned uo = (w == 2) ? u[14 + i] : (w == 4) ? u[12 + i] : (w == 8) ? u[8 + i] : u[i];
        w0 += p0 - bf_lo(uo); w1 += p1 - bf_hi(uo);
        const float rc = 1.0f / (float)((s + 1) < w ? (s + 1) : w);
        *(unsigned short*)(a2 + (size_t)(tstart + i) * DM + 512 + 2 * cp) = (unsigned short)(fp8x4((w0 * rc - p0) * 16.0f, (w1 * rc - p1) * 16.0f, 0.f, 0.f) & 0xffffu); }
}
__device__ __forceinline__ void p5_ln1(Frame& F) {
    const float* mod = (const float*)(F.ws + WS_MOD); const bf16* mix = (const bf16*)(F.ws + WS_MIX); const bf16* xn = (const bf16*)(F.ws + WS_XN);
    bf16* x1 = (bf16*)(F.ws + WS_X1); bf16* h2 = (bf16*)(F.ws + WS_H2); unsigned char* h2q = F.ws + WS_H2Q; float* shp = (float*)(F.ws + WS_SH);
    const int gw = F.vcu * NWAVES + F.wave, lane = F.lane; const int rows_per_wave = TT / (F.G * NWAVES);
    const int row0 = gw * rows_per_wave, b = row0 >> 13;
    f32x4 g1[4], lg[4], lb[4], s2[4], h2s[4];
#pragma unroll
    for (int j = 0; j < 4; ++j) { const int d = 256 * j + 4 * lane;
        g1[j] = *(const f32x4*)(mod + b * 6144 + 2048 + d) + 1.0f; lg[j] = *(const f32x4*)(F.ln1_g + d); lb[j] = *(const f32x4*)(F.ln1_b + d);
        s2[j] = *(const f32x4*)(mod + b * 6144 + 4096 + d) + 1.0f; h2s[j] = *(const f32x4*)(mod + b * 6144 + 3072 + d); }
    for (int r = 0; r < rows_per_wave; r += 2) {
        u32x2 xw[2][4]; u32x2 mv[2][4];
#pragma unroll
        for (int q = 0; q < 2; ++q)
#pragma unroll
            for (int j = 0; j < 4; ++j) { const size_t m = (size_t)(row0 + r + q); const int d = 256 * j + 4 * lane; xw[q][j] = *(const u32x2*)(xn + m * DM + d); mv[q][j] = *(const u32x2*)(mix + m * DM + d); }
#pragma unroll
        for (int q = 0; q < 2; ++q) { const size_t m = (size_t)(row0 + r + q);
        f32x4 v[4]; float s = 0.f;
#pragma unroll
        for (int j = 0; j < 4; ++j) {
            const f32x4 mf = (f32x4){bf_lo(mv[q][j].x), bf_hi(mv[q][j].x), bf_lo(mv[q][j].y), bf_hi(mv[q][j].y)};
            const f32x4 xf = (f32x4){bf_lo(xw[q][j].x), bf_hi(xw[q][j].x), bf_lo(xw[q][j].y), bf_hi(xw[q][j].y)};
            v[j] = xf * DN_ALPHA + g1[j] * mf; s += (v[j][0] + v[j][1]) + (v[j][2] + v[j][3]); }
        const float mean = wave_sum(s) * (1.f / DM); float qq = 0.f;
#pragma unroll
        for (int j = 0; j < 4; ++j) { v[j] = v[j] - mean; qq += (v[j][0] * v[j][0] + v[j][1] * v[j][1]) + (v[j][2] * v[j][2] + v[j][3] * v[j][3]); }
        const float rstd = 1.0f / sqrtf(wave_sum(qq) * (1.f / DM) + LN_EPS);
        f32x4 hh[4]; float am = 0.f;
#pragma unroll
        for (int j = 0; j < 4; ++j) { const int d = 256 * j + 4 * lane; const f32x4 y = v[j] * rstd * lg[j] + lb[j]; hh[j] = y * s2[j] + h2s[j];
            u32x2 o; o.x = pk2(y[0], y[1]); o.y = pk2(y[2], y[3]); *(u32x2*)(x1 + m * DM + d) = o;
            u32x2 p; p.x = pk2(hh[j][0], hh[j][1]); p.y = pk2(hh[j][2], hh[j][3]); *(u32x2*)(h2 + m * DM + d) = p;
            hh[j] = (f32x4){bf_lo(p.x), bf_hi(p.x), bf_lo(p.y), bf_hi(p.y)};
            am = fmaxf(am, fmaxf(fmaxf(fabsf(hh[j][0]), fabsf(hh[j][1])), fmaxf(fabsf(hh[j][2]), fabsf(hh[j][3])))); }
#pragma unroll
        for (int o = 1; o < 64; o <<= 1) am = fmaxf(am, __shfl_xor(am, o));
        if (am == 0.f) am = 1.f;
        const float inv = 127.0f / am; unsigned w[4];
#pragma unroll
        for (int j = 0; j < 4; ++j) { const int q0 = (int)rintf(hh[j][0] * inv), q1 = (int)rintf(hh[j][1] * inv), q2 = (int)rintf(hh[j][2] * inv), q3 = (int)rintf(hh[j][3] * inv);
            w[j] = (unsigned)(q0 & 255) | ((unsigned)(q1 & 255) << 8) | ((unsigned)(q2 & 255) << 16) | ((unsigned)(q3 & 255) << 24); }
        *(v4u*)(h2q + m * DM + 16 * lane) = (v4u){w[0], w[1], w[2], w[3]}; if (lane == 0) shp[m] = am * (1.0f / 127.0f); } }
}
constexpr int KR_STRIDE = 272, KR_BYTES = 128 * KR_STRIDE;
#define FMAX1(x, y) __builtin_amdgcn_fmed3f((x), (y), INFINITY)
#define FMIN1(x, y) __builtin_amdgcn_fmed3f((x), (y), -INFINITY)
#define INS16(a, v) do { _Pragma("unroll") for (int _i = 15; _i >= 1; --_i) a[_i] = __builtin_amdgcn_fmed3f(a[_i - 1], a[_i], (v)); a[0] = FMAX1(a[0], (v)); } while (0)
#define CEX(a, i, j) do { const float _x = a[i], _y = a[j]; a[i] = FMAX1(_x, _y); a[j] = FMIN1(_x, _y); } while (0)
#define SORT16(a) do { _Pragma("unroll") for (int _p = 1; _p < 16; _p <<= 1) { _Pragma("unroll") for (int _k = _p; _k >= 1; _k >>= 1) { _Pragma("unroll") for (int _j = _k % _p; _j <= 15 - _k; _j += 2 * _k) { \
        _Pragma("unroll") for (int _i = 0; _i < _k; ++_i) { if (_i + _j + _k <= 15 && (_i + _j) / (2 * _p) == (_i + _j + _k) / (2 * _p)) CEX(a, _i + _j, _i + _j + _k); } } } } } while (0)
#define MERGE16(a, b) do { _Pragma("unroll") for (int _i = 0; _i < 16; ++_i) a[_i] = FMAX1(a[_i], b[15 - _i]); BITONIC16(a); } while (0)
#define BITONIC16(a) do { _Pragma("unroll") for (int _st = 8; _st >= 1; _st >>= 1) { _Pragma("unroll") for (int _i = 0; _i < 16; ++_i) if ((_i & _st) == 0) { const float _x = a[_i], _y = a[_i + _st]; a[_i] = FMAX1(_x, _y); a[_i + _st] = FMIN1(_x, _y); } } } while (0)
__device__ __forceinline__ void p7_route(Frame& F) {
    const bf16* q = (const bf16*)(F.ws + WS_Q); unsigned short* pe = (unsigned short*)(F.ws + WS_PE); float* pg = (float*)(F.ws + WS_PG);
    const int tid = F.tid, lane = F.lane, wave = F.wave, r32 = lane & 31, h = lane >> 5;
    { const bf16* k1b = (const bf16*)(F.ws + WS_K1);
      for (int ci = tid; ci < 2 * 128 * 16; ci += NTHREADS) { const int side = ci >> 11, row = (ci >> 4) & 127, ch = ci & 15;
          *(LAS v4u*)(F.lds + side * KR_BYTES + row * KR_STRIDE + ch * 16) = *(const v4u*)(k1b + (size_t)side * 16384 + row * 128 + ch * 8); } }
    __syncthreads();
    LAS unsigned char* scr = F.lds + 2 * KR_BYTES + wave * 2048 + lane * 32;
    pg8::StaticOrder S; S.init(TT, NQD, F.G, (int)blockIdx.x); pg8::Unit u;
    for (int ui = 0; S.next(ui, u); ++ui) {
        const int head = u.pn; const size_t tok = (size_t)u.pm * 256 + wave * 32 + r32;
        float vv[2][16];
#pragma unroll
        for (int side = 0; side < 2; ++side) {
            const bf16* qb = q + tok * NQD + head * 256 + side * 128;
            bf16x8 qf[8];
#pragma unroll
            for (int s = 0; s < 8; ++s) qf[s] = *(const bf16x8*)(qb + 16 * s + 8 * h);
            float a[16];
#pragma unroll
            for (int kt = 0; kt < 4; ++kt) { f32x16 acc = (f32x16){};
#pragma unroll
                for (int s = 0; s < 8; ++s) { const bf16x8 kf = *(const LAS bf16x8*)(F.lds + side * KR_BYTES + (32 * kt + r32) * KR_STRIDE + (16 * s + 8 * h) * 2);
                    acc = __builtin_amdgcn_mfma_f32_32x32x16_bf16(kf, qf[s], acc, 0, 0, 0); }
                float t[16];
#pragma unroll
                for (int r = 0; r < 16; ++r) { const unsigned key = (unsigned)(32 * kt + (r & 3) + 8 * (r >> 2)) | ((unsigned)h << 2);
                    t[r] = __uint_as_float((__float_as_uint(acc[r]) & 0xFFFFFF80u) | key); }
                SORT16(t);
                if (kt == 0) {
#pragma unroll
                    for (int r = 0; r < 16; ++r) a[r] = t[r];
                } else MERGE16(a, t);
                __builtin_amdgcn_sched_barrier(0); }
            float c[16];
#pragma unroll
            for (int i = 0; i < 16; ++i) c[i] = __shfl_xor(a[15 - i], 32);
#pragma unroll
            for (int i = 0; i < 16; ++i) c[i] = FMAX1(a[i], c[i]);
            BITONIC16(c);
#pragma unroll
            for (int i = 0; i < 16; ++i) vv[side][i] = c[i];
        }
        { v4u w1, w2;
#define PK4(L, b) ((__float_as_uint(L[b]) & 0x7Fu) | ((__float_as_uint(L[b + 1]) & 0x7Fu) << 8) | ((__float_as_uint(L[b + 2]) & 0x7Fu) << 16) | ((__float_as_uint(L[b + 3]) & 0x7Fu) << 24))
          w1.x = PK4(vv[0], 0); w1.y = PK4(vv[0], 4); w1.z = PK4(vv[0], 8); w1.w = PK4(vv[0], 12);
          w2.x = PK4(vv[1], 0); w2.y = PK4(vv[1], 4); w2.z = PK4(vv[1], 8); w2.w = PK4(vv[1], 12);
#undef PK4
          *(LAS v4u*)scr = w1; *(LAS v4u*)(scr + 16) = w2; }
        float c1[16], c2[16], top[16];
#pragma unroll
        for (int i = 0; i < 16; ++i) { c1[i] = __uint_as_float(__float_as_uint(vv[0][i]) & 0xFFFFFF80u); c2[i] = __uint_as_float(__float_as_uint(vv[1][i]) & 0xFFFFFF80u); top[i] = -INFINITY; }
        { int cnt = 0; float pend = 0.f; unsigned pcode = 0u;
#pragma unroll
          for (int ia = 0; ia < 16; ++ia)
#pragma unroll
            for (int ib = 0; ib < 16; ++ib) if ((ia + 1) * (ib + 1) <= 16) {
                const float sm = c1[ia] + c2[ib]; const unsigned code = (unsigned)(ia * 16 + ib);
                if ((cnt & 1) == 0) { pend = sm; pcode = code; }
                else { const float vs = h ? sm : pend; const unsigned cd = h ? code : pcode; const float v = __uint_as_float((__float_as_uint(vs) & 0xFFFFFF00u) | cd); INS16(top, v); }
                ++cnt; }
          float ot[16];
#pragma unroll
          for (int i = 0; i < 16; ++i) ot[i] = __shfl_xor(top[15 - i], 32);
#pragma unroll
          for (int i = 0; i < 16; ++i) top[i] = FMAX1(top[i], ot[i]);
          BITONIC16(top); }
        float ex[16], den = 0.f;
#pragma unroll
        for (int i = 0; i < 16; ++i) { ex[i] = __expf(top[i] - top[0]); den += ex[i]; }
        const float rden = 1.0f / den;
        LDS_WAIT();
        unsigned short ev[8]; float gv[8];
#pragma unroll
        for (int j = 0; j < 8; ++j) { const float t = h ? top[8 + j] : top[j]; const float e = h ? ex[8 + j] : ex[j];
            const unsigned code = __float_as_uint(t) & 0xFFu; const unsigned i1 = *(const LAS unsigned char*)(scr + (code >> 4)), i2 = *(const LAS unsigned char*)(scr + 16 + (code & 15u));
            ev[j] = (unsigned short)(i1 * 128u + i2); gv[j] = e * rden; }
        v4u ew; ew.x = ev[0] | ((unsigned)ev[1] << 16); ew.y = ev[2] | ((unsigned)ev[3] << 16); ew.z = ev[4] | ((unsigned)ev[5] << 16); ew.w = ev[6] | ((unsigned)ev[7] << 16);
        *(v4u*)(pe + tok * 128 + head * 16 + 8 * h) = ew;
        *(f32x4*)(pg + tok * 128 + head * 16 + 8 * h) = (f32x4){gv[0], gv[1], gv[2], gv[3]};
        *(f32x4*)(pg + tok * 128 + head * 16 + 8 * h + 4) = (f32x4){gv[4], gv[5], gv[6], gv[7]};
        LDS_WAIT();
    }
    __syncthreads();
}
__device__ __forceinline__ float gelu_erf(float v) {
    const float d = fabsf(v) * 0.2316418882f + 1.0f, t = __builtin_amdgcn_rcpf(d);
    float q = t * 0.5307027145f + (-0.7265760135f); q = q * t + 0.7107068705f; q = q * t + (-0.142248368f); q = q * t + 0.127414796f; q = q * t;
    const float e = __builtin_amdgcn_exp2f(v * v * (-0.72134752044f)), m = v * (q * e);
    return v < 0.f ? m : v - m; }
#ifndef NPART
#define NPART 8
#endif
constexpr int TPW = 8, NSWEEP = 1;
constexpr int PSHIFT = (NPART == 32) ? 9 : (NPART == 8) ? 11 : (NPART == 16) ? 10 : (NPART == 4) ? 12 : (NPART == 2) ? 13 : 14;
__device__ __forceinline__ void p8_peer(Frame& F, unsigned emask = 0xffffu, int skip = 0) {
    const float* mod = (const float*)(F.ws + WS_MOD);
    const bf16* x1 = (const bf16*)(F.ws + WS_X1); const bf16* h2 = (const bf16*)(F.ws + WS_H2);
    const float* su = (const float*)(F.ws + WS_SU); const float* sv = (const float*)(F.ws + WS_SV);
    const unsigned* pe = (const unsigned*)(F.ws + WS_PE); const float* pg = (const float*)(F.ws + WS_PG);
    const int gw = F.vcu * NWAVES + F.wave;
    const int b3 = (F.lane >> 3) & 1;
#pragma unroll 1
    for (int sweep = 0; sweep < NSWEEP; ++sweep) {
    const int t0 = (gw * NSWEEP + sweep) * TPW, b = t0 >> 13;
    int lane = F.lane; asm volatile("" : "+v"(lane));
    unsigned hq[TPW][4]; float shs[TPW]; unsigned es[TPW]; float gs[TPW][2]; int offv[TPW];
    unsigned pe2v[TPW]; f32x2 pg2v[TPW];
#pragma unroll
    for (int tt = 0; tt < TPW; ++tt) { const size_t t = (size_t)(t0 + tt);
        const u32x4 hw = *(const u32x4*)(F.ws + WS_H2Q + t * DM + 16 * lane); hq[tt][0] = hw.x; hq[tt][1] = hw.y; hq[tt][2] = hw.z; hq[tt][3] = hw.w; shs[tt] = ((const float*)(F.ws + WS_SH))[t];
        pe2v[tt] = pe[t * 64 + lane]; pg2v[tt] = *(const f32x2*)(pg + t * 128 + 2 * lane); }
#pragma unroll
    for (int tt = 0; tt < TPW; ++tt) { LAS unsigned* scr = (LAS unsigned*)(F.lds + (F.wave * TPW + tt) * 1024);
        const unsigned pe2 = pe2v[tt]; const f32x2 pg2 = pg2v[tt];
        const unsigned elo = pe2 & emask, ehi = (pe2 >> 16) & emask; const int plo = (int)(elo >> PSHIFT), phi = (int)(ehi >> PSHIFT);
        int base = 0, poslo = 0, poshi = 0, ov = 0;
#pragma unroll
        for (int r = 0; r < NPART; ++r) { const unsigned long long mlo = __ballot(plo == r), mhi = __ballot(phi == r);
            const int clo = __popcll(mlo), chi = __popcll(mhi);
            const int rlo = (int)__builtin_amdgcn_mbcnt_hi((unsigned)(mlo >> 32), __builtin_amdgcn_mbcnt_lo((unsigned)mlo, 0u));
            const int rhi = (int)__builtin_amdgcn_mbcnt_hi((unsigned)(mhi >> 32), __builtin_amdgcn_mbcnt_lo((unsigned)mhi, 0u));
            if (plo == r) poslo = base + rlo; if (phi == r) poshi = base + clo + rhi;
            base += clo + chi; if (lane == r + 1) ov = base; }
        offv[tt] = ov;
        scr[2 * poslo] = elo; scr[2 * poslo + 1] = __float_as_uint(pg2.x); scr[2 * poshi] = ehi; scr[2 * poshi + 1] = __float_as_uint(pg2.y); }
    LDS_WAIT();
#pragma unroll
    for (int tt = 0; tt < TPW; ++tt) { const LAS unsigned* scr = (const LAS unsigned*)(F.lds + (F.wave * TPW + tt) * 1024);
        const u32x4 sr = *(const LAS u32x4*)(scr + 4 * lane);
        es[tt] = sr.x | (sr.z << 16); gs[tt][0] = __uint_as_float(sr.y); gs[tt][1] = __uint_as_float(sr.w); }
    LDS_WAIT();
    const __amdgpu_buffer_rsrc_t ut_rs = __builtin_amdgcn_make_buffer_rsrc((void*)(F.ws + WS_U), 0, NEXP * DM, 0x00020000), vt_rs = __builtin_amdgcn_make_buffer_rsrc((void*)(F.ws + WS_V), 0, NEXP * DM, 0x00020000);
    const int voff16 = 16 * lane;
#define ut ut_rs
#define vt vt_rs
#define P8_ISSUE(buf, tbl, tok, bb) do { _Pragma("unroll") for (int k2 = 0; k2 < 4; ++k2) { const unsigned ew = (unsigned)__builtin_amdgcn_readlane((int)es[tok], 4 * (bb) + k2); \
        buf[2 * k2] = __builtin_amdgcn_raw_buffer_load_b128((tbl), voff16, (int)((ew & 0xffffu) << 10), 0); buf[2 * k2 + 1] = __builtin_amdgcn_raw_buffer_load_b128((tbl), voff16, (int)((ew >> 16) << 10), 0); } } while (0)
    int hidv[TPW][2];
#pragma unroll
    for (int tt = 0; tt < TPW; ++tt) { hidv[tt][0] = 0; hidv[tt][1] = 0; }
    {
        u32x4 bufA[8], bufB[8];
#define P8_DOTS(buf, tok, bb) do { int p[8]; \
            _Pragma("unroll") for (int kk = 0; kk < 8; ++kk) { int s_ = __builtin_amdgcn_sdot4((int)buf[kk].x, (int)hq[tok][0], 0, false); s_ = __builtin_amdgcn_sdot4((int)buf[kk].y, (int)hq[tok][1], s_, false); \
                s_ = __builtin_amdgcn_sdot4((int)buf[kk].z, (int)hq[tok][2], s_, false); s_ = __builtin_amdgcn_sdot4((int)buf[kk].w, (int)hq[tok][3], s_, false); p[kk] = s_; } \
            int q4[4], q2[2], q1; \
            _Pragma("unroll") for (int i = 0; i < 4; ++i) { auto r_ = __builtin_amdgcn_permlane32_swap((unsigned)p[i], (unsigned)p[i + 4], false, false); q4[i] = (int)(r_[0] + r_[1]); } \
            _Pragma("unroll") for (int i = 0; i < 2; ++i) { auto r_ = __builtin_amdgcn_permlane16_swap((unsigned)q4[i], (unsigned)q4[i + 2], false, false); q2[i] = (int)(r_[0] + r_[1]); } \
            { const int keep = b3 ? q2[1] : q2[0], send = b3 ? q2[0] : q2[1]; q1 = keep + __builtin_amdgcn_update_dpp(0, send, 0x128, 0xF, 0xF, true); } \
            q1 += __builtin_amdgcn_update_dpp(0, q1, 0xB1, 0xF, 0xF, true); q1 += __builtin_amdgcn_update_dpp(0, q1, 0x4E, 0xF, 0xF, true); q1 += __builtin_amdgcn_update_dpp(0, q1, 0x141, 0xF, 0xF, true); \
            const int i2_ = (lane & 3) * 2; const int v0_ = __builtin_amdgcn_ds_bpermute(i2_ << 5, q1), v1_ = __builtin_amdgcn_ds_bpermute((i2_ + 1) << 5, q1); \
            if ((lane >> 2) == (bb)) { hidv[tok][0] = v0_; hidv[tok][1] = v1_; } } while (0)
        int cur[TPW];
#pragma unroll
        for (int tt = 0; tt < TPW; ++tt) cur[tt] = 0;
#define P8_STEP_A(tt_, bufX, bufY, r_) { const int end_ = __builtin_amdgcn_readlane(offv[tt_], (r_) + 1); \
            { constexpr int tn_ = ((tt_) + 1) % TPW; const int rn_ = (r_) + ((tt_) + 1) / TPW; \
              if (rn_ < NPART && cur[tn_] < __builtin_amdgcn_readlane(offv[tn_], rn_ + 1)) P8_ISSUE(bufY, ut, tn_, cur[tn_] >> 3); } \
            __builtin_amdgcn_sched_barrier(0); \
            bool pre_ = true; \
            while (cur[tt_] < end_) { if (!pre_) P8_ISSUE(bufX, ut, tt_, cur[tt_] >> 3); pre_ = false; P8_DOTS(bufX, tt_, cur[tt_] >> 3); cur[tt_] += 8; } }
        if ((skip & 1) == 0) {
        if (0 < __builtin_amdgcn_readlane(offv[0], 1)) P8_ISSUE(bufA, ut, 0, 0);
#pragma unroll 1
        for (int r = 0; r < NPART; ++r) {
            P8_STEP_A(0, bufA, bufB, r) P8_STEP_A(1, bufB, bufA, r) P8_STEP_A(2, bufA, bufB, r) P8_STEP_A(3, bufB, bufA, r)
            P8_STEP_A(4, bufA, bufB, r) P8_STEP_A(5, bufB, bufA, r) P8_STEP_A(6, bufA, bufB, r) P8_STEP_A(7, bufB, bufA, r)
        } }
#undef P8_STEP_A
#undef P8_DOTS
    }
    { float su0[TPW], su1[TPW], sv0[TPW], sv1[TPW];
#pragma unroll
      for (int tt = 0; tt < TPW; ++tt) { const unsigned e0 = es[tt] & 0xffffu, e1 = es[tt] >> 16; su0[tt] = su[e0]; su1[tt] = su[e1]; sv0[tt] = sv[e0]; sv1[tt] = sv[e1]; }
#pragma unroll
      for (int tt = 0; tt < TPW; ++tt) {
        gs[tt][0] = gelu_erf((float)hidv[tt][0] * (shs[tt] * su0[tt])) * gs[tt][0] * sv0[tt];
        gs[tt][1] = gelu_erf((float)hidv[tt][1] * (shs[tt] * su1[tt])) * gs[tt][1] * sv1[tt]; } }
    typedef _Float16 f16x2 __attribute__((ext_vector_type(2)));
    unsigned gsh[TPW];
#pragma unroll
    for (int tt = 0; tt < TPW; ++tt) gsh[tt] = __builtin_bit_cast(unsigned, (f16x2){(_Float16)gs[tt][0], (_Float16)gs[tt][1]});
    f16x2 yh[TPW][8];
#pragma unroll
    for (int tt = 0; tt < TPW; ++tt) {
#pragma unroll
        for (int i = 0; i < 8; ++i) yh[tt][i] = (f16x2){(_Float16)0.f, (_Float16)0.f}; }
    {
        u32x4 bufA[8], bufB[8];
#define BF8ACC(tok, a, word, j) { const unsigned _w = (word); const unsigned _h02 = _w << 8;     \
                          yh[tok][2 * (j)] = __builtin_elementwise_fma(__builtin_bit_cast(f16x2, _h02), (a), yh[tok][2 * (j)]); yh[tok][2 * (j) + 1] = __builtin_elementwise_fma(__builtin_bit_cast(f16x2, _w), (a), yh[tok][2 * (j) + 1]); }
#define P8_ACC(buf, tok, bb) do { _Pragma("unroll") for (int k2 = 0; k2 < 4; ++k2) { \
            const f16x2 hh_ = __builtin_bit_cast(f16x2, __builtin_amdgcn_readlane((int)gsh[tok], 4 * (bb) + k2)); \
            const f16x2 a0_ = (f16x2){hh_.x, hh_.x}, a1_ = (f16x2){hh_.y, hh_.y}; \
            BF8ACC(tok, a0_, buf[2 * k2].x, 0) BF8ACC(tok, a0_, buf[2 * k2].y, 1) BF8ACC(tok, a0_, buf[2 * k2].z, 2) BF8ACC(tok, a0_, buf[2 * k2].w, 3) \
            BF8ACC(tok, a1_, buf[2 * k2 + 1].x, 0) BF8ACC(tok, a1_, buf[2 * k2 + 1].y, 1) BF8ACC(tok, a1_, buf[2 * k2 + 1].z, 2) BF8ACC(tok, a1_, buf[2 * k2 + 1].w, 3) __builtin_amdgcn_sched_barrier(0); } } while (0)
        int cur[TPW];
#pragma unroll
        for (int tt = 0; tt < TPW; ++tt) cur[tt] = 0;
#define P8_STEP_B(tt_, bufX, bufY, r_) { const int end_ = __builtin_amdgcn_readlane(offv[tt_], (r_) + 1); \
            { constexpr int tn_ = ((tt_) + 1) % TPW; const int rn_ = (r_) + ((tt_) + 1) / TPW; \
              if (rn_ < NPART && cur[tn_] < __builtin_amdgcn_readlane(offv[tn_], rn_ + 1)) P8_ISSUE(bufY, vt, tn_, cur[tn_] >> 3); } \
            __builtin_amdgcn_sched_barrier(0); \
            bool pre_ = true; \
            while (cur[tt_] < end_) { if (!pre_) P8_ISSUE(bufX, vt, tt_, cur[tt_] >> 3); pre_ = false; P8_ACC(bufX, tt_, cur[tt_] >> 3); cur[tt_] += 8; } }
        if ((skip & 2) == 0) {
        if (0 < __builtin_amdgcn_readlane(offv[0], 1)) P8_ISSUE(bufA, vt, 0, 0);
#pragma unroll 1
        for (int r = 0; r < NPART; ++r) {
            P8_STEP_B(0, bufA, bufB, r) P8_STEP_B(1, bufB, bufA, r) P8_STEP_B(2, bufA, bufB, r) P8_STEP_B(3, bufB, bufA, r)
            P8_STEP_B(4, bufA, bufB, r) P8_STEP_B(5, bufB, bufA, r) P8_STEP_B(6, bufA, bufB, r) P8_STEP_B(7, bufB, bufA, r)
        } }
#undef P8_STEP_B
#undef P8_ACC
#undef BF8ACC
    }
#undef P8_ISSUE
#undef ut
#undef vt
    u32x2 xw[TPW][4]; f32x4 g2v[4], lgv[4], lbv[4];
#pragma unroll
    for (int tt = 0; tt < TPW; ++tt)
#pragma unroll
        for (int j = 0; j < 4; ++j) xw[tt][j] = *(const u32x2*)(x1 + (size_t)(t0 + tt) * DM + 256 * j + 4 * lane);
#pragma unroll
    for (int j = 0; j < 4; ++j) { const int d = 256 * j + 4 * lane; g2v[j] = *(const f32x4*)(mod + b * 6144 + 5120 + d) + 1.0f; lgv[j] = *(const f32x4*)(F.ln2_g + d); lbv[j] = *(const f32x4*)(F.ln2_b + d); }
#pragma unroll
    for (int tt = 0; tt < TPW; ++tt) { const size_t t = (size_t)(t0 + tt);
        f32x4 v[4]; float s = 0.f;
#pragma unroll
        for (int j = 0; j < 4; ++j) { const u32x2 xv = xw[tt][j];
            const f32x4 xf = (f32x4){bf_lo(xv.x), bf_hi(xv.x), bf_lo(xv.y), bf_hi(xv.y)}; const f32x4 yy = (f32x4){(float)yh[tt][2 * j].x, (float)yh[tt][2 * j + 1].x, (float)yh[tt][2 * j].y, (float)yh[tt][2 * j + 1].y};
            v[j] = xf * DN_ALPHA + g2v[j] * yy; s += (v[j][0] + v[j][1]) + (v[j][2] + v[j][3]); }
        const float mean = wave_sum(s) * (1.f / DM); float qq = 0.f;
#pragma unroll
        for (int j = 0; j < 4; ++j) { v[j] = v[j] - mean; qq += (v[j][0] * v[j][0] + v[j][1] * v[j][1]) + (v[j][2] * v[j][2] + v[j][3] * v[j][3]); }
        const float rstd = 1.0f / sqrtf(wave_sum(qq) * (1.f / DM) + LN_EPS);
#pragma unroll
        for (int j = 0; j < 4; ++j) { const int d = 256 * j + 4 * lane;
            *(f32x4*)(F.out + t * DM + d) = v[j] * rstd * lgv[j] + lbv[j]; } }
    }
}
#ifndef PROBE_PARTS
#define PROBE_PARTS 0xff
#endif
#ifndef MK_N_LAUNCHES
#define MK_N_LAUNCHES 1
#endif
constexpr int N_PHASES = 9;
struct Args { const float* in[18]; float* out; unsigned char* ws; int ph_lo, ph_hi, p0_parts, pad; };
__global__ void __launch_bounds__(NTHREADS, 2) fwd_kernel(Args args) {
    extern __shared__ __attribute__((aligned(16))) unsigned char lds[];
    Frame F;
    F.lds = (LAS unsigned char*)lds;
    F.tid = threadIdx.x; F.lane = F.tid & 63; F.wave = __builtin_amdgcn_readfirstlane(F.tid >> 6);
    F.G = gridDim.x; { const int bx = blockIdx.x; F.vcu = (F.G % 8 == 0) ? (bx % 8) * (F.G / 8) + bx / 8 : bx; }
    F.x = args.in[0]; F.c = args.in[1]; F.w_ada = args.in[2]; F.b_ada = args.in[3]; F.w_in = args.in[4]; F.sinks = args.in[5]; F.w_pool = args.in[6]; F.pool_scale = args.in[7];
    F.w_out = args.in[8]; F.ln1_g = args.in[9]; F.ln1_b = args.in[10]; F.w_pq = args.in[11]; F.k1 = args.in[12]; F.k2 = args.in[13]; F.pu = args.in[14]; F.pv = args.in[15];
    F.ln2_g = args.in[16]; F.ln2_b = args.in[17]; F.out = args.out; F.ws = args.ws;
    volatile LAS unsigned* MISC = (volatile LAS unsigned*)(F.lds + MISC_OFF);
    for (int u = F.tid; u < (LDS_BYTES - LDSCTL_OFF) / 4; u += NTHREADS) ((LAS unsigned*)(F.lds + LDSCTL_OFF))[u] = 0u;
    __syncthreads();
    const int lo = args.ph_lo, hi = args.ph_hi;
    XcdBarrier bar; bar.bar = (unsigned*)(F.ws + WS_CTL) + CW_BAR; bar.x = 0; bar.st = nullptr;
    if (hi - lo > 1) bar = xcd_barrier_post((unsigned*)(F.ws + WS_CTL) + CW_BAR, MISC + 8);
#ifndef PH_MASK
#define PH_MASK 0x1ff
#endif
#define IN(k) (((PH_MASK >> (k)) & 1) && lo <= (k) && (k) < hi)
#define SEAM(k) do { if (IN(k) && IN((k) + 1)) xcd_barrier(bar); } while (0)
#ifndef REP_MASK
#define REP_MASK 0
#endif
#ifndef REP_CNT
#define REP_CNT 4
#endif
#define REPS(k) (((REP_MASK >> (k)) & 1) * REP_CNT)
#define PHASE_NS(k, ...) if (IN(k)) { _Pragma("unroll 1") for (int _r = 0; _r <= REPS(k); ++_r) { __VA_ARGS__; if (_r < REPS(k)) xcd_barrier(bar); } }
#define PHASE(k, ...) if (IN(k)) { _Pragma("unroll 1") for (int _r = 0; _r <= REPS(k); ++_r) { __VA_ARGS__; if (_r < REPS(k)) xcd_barrier(bar); } } SEAM(k)
#ifndef P0_SUB
#define P0_SUB 0xff
#endif
    PHASE(0, p0_prologue(F, args.p0_parts));
    PHASE(2, { pg8::Gemm g{(const pg8::bf16_t*)(F.ws + WS_XN8), (const pg8::bf16_t*)(F.ws + WS_WIN), TT, NIN, DM / 2, 32, (size_t)NIN * DM, 0x79797979, 0x7F7F7F7F};    pg8::StaticOrder S; S.init(TT, NIN, F.G, (int)blockIdx.x);
            pg8::EpiRope E{(pg8::bf16_t*)(F.ws + WS_PROJ), NIN, (const float*)(F.ws + WS_ROPE), QSCALE, (const float*)(F.ws + WS_BIAS)};
            pg8::gemm_phase<pg8::EpiRope, pg8::StaticOrder, true, true, true>(F.lds, g, S, E);
            if ((args.p0_parts & 0x80) && (int)blockIdx.x >= 320 - F.G) p2_tables(F, ((int)blockIdx.x - (320 - F.G)) * NWAVES + F.wave, (2 * F.G - 320) * NWAVES, 0, 2 * NEXP); });
    PHASE(3, { for (int u = F.vcu; u < 256; u += F.G) p3_attn_unit(F, u);
               for (int u = F.vcu; u < 256; u += F.G) p3_pool_unit(F, u); });
    PHASE(4, { pg8::Gemm g{(const pg8::bf16_t*)(F.ws + WS_A2), (const pg8::bf16_t*)(F.ws + WS_WOUT), TT, DM, DM / 2, 1 << 30, 0, 0x79797979, 0x7B7B7B7B}; pg8::StaticOrder S; S.init(TT, DM, F.G, (int)blockIdx.x);
            pg8::EpiPlain E{(pg8::bf16_t*)(F.ws + WS_MIX), DM};
            pg8::gemm_phase<pg8::EpiPlain, pg8::StaticOrder, true, true, true>(F.lds, g, S, E); });
    PHASE(5, p5_ln1(F));
    PHASE_NS(6, { pg8::Gemm g{(const pg8::bf16_t*)(F.ws + WS_H2), (const pg8::bf16_t*)(F.ws + WS_WPQ), TT, NQD, DM, 1 << 30, 0, 0, 0}; pg8::StaticOrder S; S.init(TT, NQD, F.G, (int)blockIdx.x);
            pg8::EpiPlain E{(pg8::bf16_t*)(F.ws + WS_Q), NQD};
            pg8::gemm_phase<pg8::EpiPlain, pg8::StaticOrder, true, true>(F.lds, g, S, E); });
    if (IN(6) && IN(7)) { asm volatile("s_waitcnt vmcnt(0)" ::: "memory"); __syncthreads(); }
    PHASE(7, p7_route(F));
#ifndef P8_FAKE
#define P8_FAKE 0xffffu
#endif
#ifndef P8_SKIP
#define P8_SKIP 0
#endif
    PHASE(8, p8_peer(F, _r == REPS(8) ? 0xffffu : P8_FAKE, _r == REPS(8) ? 0 : P8_SKIP));
#undef IN
#undef SEAM
}

extern "C" void kernel_launch(void* const* d_in, const int* in_sizes, int n_in, void* d_out, int out_size, void* d_ws, size_t ws_size, hipStream_t stream) {
    static int grid = 0;
    if (grid == 0) {
        if (n_in != 18 || out_size != TT * DM || ws_size < WS_END) { fprintf(stderr, "kernel_launch: unexpected shapes (n_in %d out %d ws %zu)\n", n_in, out_size, ws_size); grid = -1; return; }
        int dev = 0, cus = 0, per_cu = 0;
        if (hipGetDevice(&dev) != hipSuccess || hipDeviceGetAttribute(&cus, hipDeviceAttributeMultiprocessorCount, dev) != hipSuccess) { grid = -1; return; }
        if (hipFuncSetAttribute((const void*)fwd_kernel, hipFuncAttributeMaxDynamicSharedMemorySize, LDS_BYTES) != hipSuccess) { fprintf(stderr, "kernel_launch: hipFuncSetAttribute failed\n"); grid = -1; return; }
        if (hipOccupancyMaxActiveBlocksPerMultiprocessor(&per_cu, (const void*)fwd_kernel, NTHREADS, LDS_BYTES) != hipSuccess || per_cu < 1) { fprintf(stderr, "kernel_launch: occupancy query says %d blocks per CU\n", per_cu); }
        (void)hipGetLastError();
        grid = cus;
        if (grid != 256) fprintf(stderr, "kernel_launch: built for 256 CUs, got %d\n", grid);
    }
    if (grid < 0) return;
    (void)hipMemsetAsync((char*)d_ws + WS_CTL, 0, CTL_ZERO_BYTES, stream);
    Args a{};
    for (int i = 0; i < 18; ++i) a.in[i] = (const float*)d_in[i];
    a.out = (float*)d_out; a.ws = (unsigned char*)d_ws; a.p0_parts = 0xff;
#if MK_N_LAUNCHES == 1
    a.ph_lo = 0; a.ph_hi = N_PHASES;
    hipLaunchKernelGGL(fwd_kernel, dim3(grid), dim3(NTHREADS), LDS_BYTES, stream, a);
#ifdef PROBE_PHASE
    for (int i = 0; i < PROBE_N; ++i) { a.ph_lo = PROBE_PHASE; a.ph_hi = PROBE_PHASE + 1; a.p0_parts = PROBE_PARTS; hipLaunchKernelGGL(fwd_kernel, dim3(grid), dim3(NTHREADS), LDS_BYTES, stream, a); }
#endif
#else
    for (int p = 0; p < N_PHASES; ++p) { a.ph_lo = p; a.ph_hi = p + 1; hipLaunchKernelGGL(fwd_kernel, dim3(grid), dim3(NTHREADS), LDS_BYTES, stream, a); }
#endif
}
```

```cpp
#include <hip/hip_runtime.h>
#include <cstdio>
#include <cstdint>
#include <cmath>
namespace pg8 {
#define PG8_LAS __attribute__((address_space(3)))
typedef unsigned short bf16_t;
typedef short bf16x8 __attribute__((ext_vector_type(8)));
typedef float f32x4 __attribute__((ext_vector_type(4)));
typedef unsigned u32x4 __attribute__((ext_vector_type(4)));
constexpr int BM = 256, BK = 64, HALF = 128, HTB = HALF * BK * 2  , STAGE_BYTES = 8 * HTB, NXCD = 8, WGM = 8;

__host__ __device__ __forceinline__ int lds_byte(int r, int c) { const int st = (r >> 4) * 2 + (c >> 5), rr = r & 15, cc = c & 31, ob = rr * 64 + cc * 2; return st * 1024 + (ob ^ (((ob >> 9) & 1) << 5)); }
__host__ __device__ __forceinline__ void stage_rc(int b, int& R, int& C) { const int st = b / 1024, sb = b % 1024, swz = sb ^ (((sb >> 9) & 1) << 5); R = (st >> 1) * 16 + swz / 64; C = (st & 1) * 32 + (swz % 64) / 2; }
__host__ __device__ __forceinline__ int perm32(int rho) { const int n = rho >> 4, i = rho & 15; return 8 * (i >> 2) + 4 * n + (i & 3); }

struct Unit { int pm, pn; };
struct Gemm { const bf16_t* A; const bf16_t* Bt; int M, N, K; int bsplit; size_t bstride; int sc_w, sc_x; };

struct StaticOrder {
    int nM, nN, nwg, G, c;
    __host__ __device__ void init(int M, int N, int G_, int c_) { nM = M / BM; nN = N / BM; nwg = nM * nN; G = G_; c = c_; }
    __host__ __device__ bool next(int i, Unit& u) const {
        const long L = (long)i * G + c; if (L >= nwg) return false;
        int wgid = (int)L; { const int q = nwg / NXCD, r = nwg % NXCD, xcd = wgid % NXCD, off = wgid / NXCD; wgid = (xcd < r ? xcd * (q + 1) : r * (q + 1) + (xcd - r) * q) + off; }
        const int nig = WGM * nN, gid = wgid / nig, fm = gid * WGM, gsz = (nM - fm) < WGM ? (nM - fm) : WGM;
        u.pm = fm + ((wgid % nig) % gsz); u.pn = (wgid % nig) / gsz; return true;
    }
    __device__ __forceinline__ void a_ready(const Unit&) const {}
    __device__ __forceinline__ void done(const Unit&) const {}
};

__device__ __forceinline__ unsigned cvt_pk_bf16(float lo, float hi) { unsigned r; asm volatile("v_cvt_pk_bf16_f32 %0, %1, %2" : "=v"(r) : "v"(lo), "v"(hi)); return r; }

struct EpiPlain {
    static constexpr bool PERM = true, AFTER_DRAIN = false;
    bf16_t* O; int ldc;
    __device__ __forceinline__ void operator()(const f32x4 (&acc)[2][2][4][2], const Unit& u, int wr, int wc, int fr, int fq) const {
        const int row0 = u.pm * BM + wr * 64 + fr; const int col0 = u.pn * BM + wc * 32 + 8 * fq;
#pragma unroll
        for (int ai = 0; ai < 2; ++ai)
#pragma unroll
            for (int m = 0; m < 4; ++m) { bf16_t* rowp = O + (size_t)(row0 + ai * HALF + m * 16) * ldc + col0;
#pragma unroll
                for (int bj = 0; bj < 2; ++bj) { const f32x4 v0 = acc[ai][bj][m][0], v1 = acc[ai][bj][m][1];
                    u32x4 w; w.x = cvt_pk_bf16(v0[0], v0[1]); w.y = cvt_pk_bf16(v0[2], v0[3]); w.z = cvt_pk_bf16(v1[0], v1[1]); w.w = cvt_pk_bf16(v1[2], v1[3]);
                    *(u32x4*)(rowp + bj * HALF) = w; } }
    }
};
struct EpiRope {
    static constexpr bool PERM = true, AFTER_DRAIN = false;
    bf16_t* O; int ldc; const float* rope; float qscale; const float* bias;
    __device__ __forceinline__ void operator()(const f32x4 (&acc)[2][2][4][2], const Unit& u, int wr, int wc, int fr, int fq) const {
        const int row0 = u.pm * BM + wr * 64 + fr; const int col0 = u.pn * BM + wc * 32 + 8 * fq;
#pragma unroll
        for (int ai = 0; ai < 2; ++ai)
#pragma unroll
            for (int m = 0; m < 4; ++m) { const int row = row0 + ai * HALF + m * 16; bf16_t* rowp = O + (size_t)row * ldc + col0; const int pos = row & 8191;
#pragma unroll
                for (int bj = 0; bj < 2; ++bj) { const float* bp = bias + (size_t)(row >> 13) * ldc + col0 + bj * HALF;
                    f32x4 v0 = acc[ai][bj][m][0] + *(const f32x4*)bp, v1 = acc[ai][bj][m][1] + *(const f32x4*)(bp + 4);
                    const int colt = u.pn * BM + bj * HALF;
                    if (colt < 640) {
                        const int c = col0 + bj * HALF, ib = (c & 63) >> 1;
                        const f32x4 cs0 = *(const f32x4*)(rope + ((size_t)pos * 32 + ib) * 2), cs1 = *(const f32x4*)(rope + ((size_t)pos * 32 + ib) * 2 + 4);
                        const float sc = colt < 512 ? qscale : 1.0f;
                        f32x4 r0, r1;
                        r0[0] = (v0[0] * cs0[0] - v0[1] * cs0[1]) * sc; r0[1] = (v0[1] * cs0[0] + v0[0] * cs0[1]) * sc;
                        r0[2] = (v0[2] * cs0[2] - v0[3] * cs0[3]) * sc; r0[3] = (v0[3] * cs0[2] + v0[2] * cs0[3]) * sc;
                        r1[0] = (v1[0] * cs1[0] - v1[1] * cs1[1]) * sc; r1[1] = (v1[1] * cs1[0] + v1[0] * cs1[1]) * sc;
                        r1[2] = (v1[2] * cs1[2] - v1[3] * cs1[3]) * sc; r1[3] = (v1[3] * cs1[2] + v1[2] * cs1[3]) * sc;
                        v0 = r0; v1 = r1;
                    }
                    u32x4 w; w.x = cvt_pk_bf16(v0[0], v0[1]); w.y = cvt_pk_bf16(v0[2], v0[3]); w.z = cvt_pk_bf16(v1[0], v1[1]); w.w = cvt_pk_bf16(v1[2], v1[3]);
                    *(u32x4*)(rowp + bj * HALF) = w; } }
    }
};

template <class Epi, class Sched, bool ALIGN_EPI = false, bool SP2 = false, bool FP8 = false>
__device__ __forceinline__ void gemm_phase(PG8_LAS unsigned char* lds, const Gemm g, const Sched& S, const Epi& E) {
    typedef int pg8_i32x4 __attribute__((ext_vector_type(4))); typedef int pg8_frag __attribute__((ext_vector_type(8)));
    const int tid = threadIdx.x, wid = __builtin_amdgcn_readfirstlane(tid >> 6), lane = tid & 63, wr = wid >> 2, wc = wid & 3, fr = lane & 15, fq = lane >> 4;
    const int K = g.K, nt = K / BK;
    unsigned voffA[2], voffB[2];
#pragma unroll
    for (int i = 0; i < 2; ++i) { int R, C; stage_rc(tid * 16 + i * 8192, R, C); const int Rb = Epi::PERM ? ((R & ~31) + perm32(R & 31)) : R;
        voffA[i] = (unsigned)(R * K + C) * 2u; voffB[i] = (unsigned)(Rb * K + C) * 2u; }
    const size_t kstep = (size_t)(BK * 2);
    const size_t hstep = (size_t)HALF * K * 2;
    const size_t tstep = 2 * hstep;
    const unsigned ldsw = (unsigned)wid * 1024u;
    const int aoff = lds_byte(wr * 64 + fr, fq * 8), boff = lds_byte(wc * 32 + fr, fq * 8);
#define PG8_SA(b, h) (((b) * 2 + (h)) * HTB)
#define PG8_SB(b, h) ((4 + (b) * 2 + (h)) * HTB)
#define PG8_STAGE(bufoff, gbase, voff) do { _Pragma("unroll") for (int _i = 0; _i < 2; ++_i) \
        __builtin_amdgcn_global_load_lds((const unsigned*)((const char*)(gbase) + (voff)[_i]), (PG8_LAS unsigned*)(lds + (bufoff) + ldsw + _i * 8192), 16, 0, 0); } while (0)
#define PG8_LDA(dst, b, h) do { _Pragma("unroll") for (int m = 0; m < 4; ++m) { const pg8_i32x4 l0_ = *(const PG8_LAS pg8_i32x4*)(lds + PG8_SA(b, h) + aoff + m * 2048), l1_ = *(const PG8_LAS pg8_i32x4*)(lds + PG8_SA(b, h) + aoff + m * 2048 + 1024); dst[m] = __builtin_shufflevector(l0_, l1_, 0, 1, 2, 3, 4, 5, 6, 7); } } while (0)
#define PG8_LDB(dst, b, h) do { _Pragma("unroll") for (int n = 0; n < 2; ++n) { const pg8_i32x4 l0_ = *(const PG8_LAS pg8_i32x4*)(lds + PG8_SB(b, h) + boff + n * 2048), l1_ = *(const PG8_LAS pg8_i32x4*)(lds + PG8_SB(b, h) + boff + n * 2048 + 1024); dst[n] = __builtin_shufflevector(l0_, l1_, 0, 1, 2, 3, 4, 5, 6, 7); } } while (0)
#define PG8_H0(f) __builtin_bit_cast(bf16x8, __builtin_shufflevector((f), (f), 0, 1, 2, 3))
#define PG8_H1(f) __builtin_bit_cast(bf16x8, __builtin_shufflevector((f), (f), 4, 5, 6, 7))
#define PG8_MMA(ai, bj, At, Bt) do { __builtin_amdgcn_s_setprio(1); \
        if constexpr (FP8) { _Pragma("unroll") for (int m = 0; m < 4; ++m) _Pragma("unroll") for (int n = 0; n < 2; ++n) \
            asm volatile("v_mfma_scale_f32_16x16x128_f8f6f4 %0, %1, %2, %0, %3, %4 op_sel_hi:[0,0,0]" : "+v"(acc[ai][bj][m][n]) : "v"(Bt[n]), "v"(At[m]), "v"(scw_), "v"(scx_)); } \
        else { _Pragma("unroll") for (int m = 0; m < 4; ++m) _Pragma("unroll") for (int n = 0; n < 2; ++n) { \
            acc[ai][bj][m][n] = __builtin_amdgcn_mfma_f32_16x16x32_bf16(PG8_H0(Bt[n]), PG8_H0(At[m]), acc[ai][bj][m][n], 0, 0, 0); \
            acc[ai][bj][m][n] = __builtin_amdgcn_mfma_f32_16x16x32_bf16(PG8_H1(Bt[n]), PG8_H1(At[m]), acc[ai][bj][m][n], 0, 0, 0); } } \
        __builtin_amdgcn_s_setprio(0); } while (0)
#define PG8_WAIT_V(n) asm volatile("s_waitcnt vmcnt(" #n ")" ::: "memory")
#define PG8_WAIT_L(n) asm volatile("s_waitcnt lgkmcnt(" #n ")" ::: "memory")
#define PG8_BAR __builtin_amdgcn_s_barrier()
#define PG8_SCHED __builtin_amdgcn_sched_barrier(0)
    Unit cur, nxt; int ui = 0;
    if (!S.next(0, cur)) return;
    f32x4 acc[2][2][4][2];
#pragma unroll
    for (int a = 0; a < 2; ++a)
#pragma unroll
        for (int b = 0; b < 2; ++b)
#pragma unroll
            for (int m = 0; m < 4; ++m)
#pragma unroll
                for (int n = 0; n < 2; ++n) acc[a][b][m][n] = (f32x4){0.f, 0.f, 0.f, 0.f};
    pg8_frag At[4], B0[2], B1[2]; const int scw_ = g.sc_w, scx_ = g.sc_x;
    const char* cA = (const char*)g.A + (size_t)cur.pm * tstep; const char* cB = (const char*)g.Bt + (size_t)cur.pn * tstep + (cur.pm >= g.bsplit ? g.bstride : (size_t)0);
    S.a_ready(cur);
    if constexpr (SP2) {
        PG8_STAGE(PG8_SB(0, 0), cB, voffB); PG8_STAGE(PG8_SB(0, 1), cB + hstep, voffB); PG8_STAGE(PG8_SA(0, 0), cA, voffA); PG8_STAGE(PG8_SA(0, 1), cA + hstep, voffA);
        if (wr == 1) PG8_BAR;
        PG8_WAIT_V(2); PG8_BAR;
        PG8_STAGE(PG8_SB(1, 0), cB + kstep, voffB); PG8_STAGE(PG8_SA(1, 0), cA + kstep, voffA); PG8_STAGE(PG8_SB(1, 1), cB + hstep + kstep, voffB);
        PG8_WAIT_V(6); PG8_BAR;
    } else {
        PG8_STAGE(PG8_SB(0, 0), cB, voffB); PG8_STAGE(PG8_SA(0, 0), cA, voffA); PG8_STAGE(PG8_SB(0, 1), cB + hstep, voffB); PG8_STAGE(PG8_SA(0, 1), cA + hstep, voffA);
        if (wr == 1) PG8_BAR;
        PG8_WAIT_V(4); PG8_BAR;
        PG8_STAGE(PG8_SB(1, 0), cB + kstep, voffB); PG8_STAGE(PG8_SA(1, 0), cA + kstep, voffA); PG8_STAGE(PG8_SB(1, 1), cB + hstep + kstep, voffB);
        PG8_WAIT_V(6); PG8_BAR;
    }
    for (;;) {
        const bool has_next = S.next(ui + 1, nxt);
        const char* nA = has_next ? (const char*)g.A + (size_t)nxt.pm * tstep : cA; const char* nB = has_next ? (const char*)g.Bt + (size_t)nxt.pn * tstep + (nxt.pm >= g.bsplit ? g.bstride : (size_t)0) : cB;
        _Pragma("unroll 1") for (int t = 0; t < nt; t += 2) {
            const bool last = (t == nt - 2);
            const char* a1 = cA + (size_t)(t + 1) * kstep;
            const char* a2 = last ? nA : cA + (size_t)(t + 2) * kstep; const char* b2 = last ? nB : cB + (size_t)(t + 2) * kstep;
            const char* a3 = a2 + kstep; const char* b3 = b2 + kstep;
            if (last && has_next) S.a_ready(nxt);
            if constexpr (SP2) {
            PG8_LDB(B0, 0, 0); PG8_LDB(B1, 0, 1); PG8_SCHED; PG8_LDA(At, 0, 0); PG8_STAGE(PG8_SA(1, 1), a1 + hstep, voffA);
            PG8_WAIT_V(8); PG8_WAIT_L(0); PG8_BAR; PG8_MMA(0, 0, At, B0); PG8_MMA(0, 1, At, B1); PG8_BAR; PG8_SCHED;
            PG8_LDA(At, 0, 1); PG8_STAGE(PG8_SB(0, 0), b2, voffB); PG8_STAGE(PG8_SB(0, 1), b2 + hstep, voffB); PG8_STAGE(PG8_SA(0, 0), a2, voffA);
            PG8_WAIT_V(8); PG8_WAIT_L(0); PG8_BAR; PG8_MMA(1, 0, At, B0); PG8_MMA(1, 1, At, B1); PG8_BAR; PG8_SCHED;
            PG8_LDB(B0, 1, 0); PG8_LDB(B1, 1, 1); PG8_SCHED; PG8_LDA(At, 1, 0); PG8_STAGE(PG8_SA(0, 1), a2 + hstep, voffA);
            PG8_WAIT_V(8); PG8_WAIT_L(0); PG8_BAR; PG8_MMA(0, 0, At, B0); PG8_MMA(0, 1, At, B1); PG8_BAR; PG8_SCHED;
            PG8_LDA(At, 1, 1); PG8_STAGE(PG8_SB(1, 0), b3, voffB); PG8_STAGE(PG8_SB(1, 1), b3 + hstep, voffB); PG8_STAGE(PG8_SA(1, 0), a3, voffA);
            PG8_WAIT_V(8); PG8_WAIT_L(0); PG8_BAR; PG8_MMA(1, 0, At, B0); PG8_MMA(1, 1, At, B1); PG8_BAR; PG8_SCHED;
            } else {
            PG8_LDB(B0, 0, 0); PG8_SCHED; PG8_LDA(At, 0, 0); PG8_STAGE(PG8_SA(1, 1), a1 + hstep, voffA);
            PG8_WAIT_L(8); PG8_BAR; PG8_WAIT_L(0); PG8_MMA(0, 0, At, B0); PG8_BAR; PG8_SCHED;
            PG8_LDB(B1, 0, 1); PG8_STAGE(PG8_SB(0, 0), b2, voffB);
            PG8_BAR; PG8_WAIT_L(0); PG8_MMA(0, 1, At, B1); PG8_BAR;
            PG8_LDA(At, 0, 1); PG8_STAGE(PG8_SA(0, 0), a2, voffA);
            PG8_BAR; PG8_WAIT_L(0); PG8_MMA(1, 0, At, B0); PG8_BAR; PG8_SCHED;
            PG8_STAGE(PG8_SB(0, 1), b2 + hstep, voffB);
            PG8_WAIT_V(6); PG8_BAR; PG8_MMA(1, 1, At, B1); PG8_BAR;
            PG8_LDB(B0, 1, 0); PG8_SCHED; PG8_LDA(At, 1, 0); PG8_STAGE(PG8_SA(0, 1), a2 + hstep, voffA);
            PG8_WAIT_L(8); PG8_BAR; PG8_WAIT_L(0); PG8_MMA(0, 0, At, B0); PG8_BAR; PG8_SCHED;
            PG8_LDB(B1, 1, 1); PG8_STAGE(PG8_SB(1, 0), b3, voffB);
            PG8_BAR; PG8_WAIT_L(0); PG8_MMA(0, 1, At, B1); PG8_BAR;
            PG8_LDA(At, 1, 1); PG8_STAGE(PG8_SA(1, 0), a3, voffA);
            PG8_BAR; PG8_WAIT_L(0); PG8_MMA(1, 0, At, B0); PG8_BAR; PG8_SCHED;
            PG8_STAGE(PG8_SB(1, 1), b3 + hstep, voffB);
            PG8_WAIT_V(6); PG8_BAR; PG8_MMA(1, 1, At, B1); PG8_BAR;
            }
        }
        if constexpr (ALIGN_EPI) { if (wr == 0) PG8_BAR; }
        if constexpr (FP8) {
            asm volatile("s_nop 15\n\ts_nop 15" ::: "memory");
#pragma unroll
            for (int a = 0; a < 2; ++a)
#pragma unroll
                for (int b = 0; b < 2; ++b)
#pragma unroll
                    for (int m = 0; m < 4; ++m)
#pragma unroll
                        for (int n = 0; n < 2; ++n) asm volatile("" : "+v"(acc[a][b][m][n]));
        }
        if constexpr (!Epi::AFTER_DRAIN) { E(acc, cur, wr, wc, fr, fq); S.done(cur); }
        if (!has_next) break;
#pragma unroll
        for (int a = 0; a < 2; ++a)
#pragma unroll
            for (int b = 0; b < 2; ++b)
#pragma unroll
                for (int m = 0; m < 4; ++m)
#pragma unroll
                    for (int n = 0; n < 2; ++n) acc[a][b][m][n] = (f32x4){0.f, 0.f, 0.f, 0.f};
        cur = nxt; cA = nA; cB = nB; ++ui;
        if constexpr (ALIGN_EPI) { if (wr == 1) PG8_BAR; }
    }
    PG8_WAIT_V(0);
    if constexpr (!ALIGN_EPI) { if (wr == 0) PG8_BAR; }
    PG8_BAR;
    if constexpr (Epi::AFTER_DRAIN) { E.fused(acc, cur, wr, wc, fr, fq, lds, wid, lane); S.done(cur); }
#undef PG8_SA
#undef PG8_SB
#undef PG8_STAGE
#undef PG8_LDA
#undef PG8_LDB
#undef PG8_MMA
#undef PG8_H0
#undef PG8_H1
#undef PG8_WAIT_V
#undef PG8_WAIT_L
#undef PG8_BAR
#undef PG8_SCHED
}
}
#define GAS __attribute__((address_space(1)))
#define LAS __attribute__((address_space(3)))
typedef unsigned short bf16;
typedef unsigned v4u __attribute__((ext_vector_type(4)));
typedef float f32x4 __attribute__((ext_vector_type(4)));
typedef short bf16x8 __attribute__((ext_vector_type(8)));
typedef GAS unsigned gu32;
typedef GAS unsigned long long gu64;
#define RLX_AGENT __ATOMIC_RELAXED, __HIP_MEMORY_SCOPE_AGENT
#define LDS_WAIT() asm volatile("s_waitcnt lgkmcnt(0)" ::: "memory")
#define VM_WAIT() asm volatile("s_waitcnt vmcnt(0)" ::: "memory")
__device__ __forceinline__ unsigned long long rt() { return __builtin_amdgcn_s_memrealtime(); }
__device__ __forceinline__ unsigned f2bf(float f) { unsigned u = __builtin_bit_cast(unsigned, f); return (u + 0x7fffu + ((u >> 16) & 1u)) >> 16; }
__device__ __forceinline__ unsigned pk2(float lo, float hi) { return f2bf(lo) | (f2bf(hi) << 16); }
#define XB_TMO      128
#define XB_XCNT(j)  (256  + 64 * (j))
#define XB_XSUB(j)  (1280 + 64 * (j))
#define XB_XGEN(j)  (2304 + 64 * (j))
#define XB_TOP      3328
#define XB_TOPGEN   3392
#define XCD_BAR_WORDS 3456
#define XB_SPIN_CAP (1u << 18)

__device__ __forceinline__ unsigned xb_ld(unsigned* p)              { return __hip_atomic_load(p, __ATOMIC_RELAXED, __HIP_MEMORY_SCOPE_AGENT); }
__device__ __forceinline__ unsigned xb_add(unsigned* p, unsigned v) { return __hip_atomic_fetch_add(p, v, __ATOMIC_RELAXED, __HIP_MEMORY_SCOPE_AGENT); }
__device__ __forceinline__ unsigned xb_xcc_id() { return (unsigned)__builtin_amdgcn_s_getreg((3 << 11) | 20) & 0xFu; }
#define XB_SPIN(cond, bar) do { unsigned _sp = 0; while (cond) { __builtin_amdgcn_s_sleep(1); \
    if ((++_sp & 255u) == 0u) { if (xb_ld(&(bar)[XB_TMO])) break; if (_sp > XB_SPIN_CAP) { atomicAdd(&(bar)[XB_TMO], 1u); break; } } } } while (0)

struct XcdBarrier {
    unsigned* bar; unsigned x;
    volatile LAS unsigned* st;
};

__device__ __forceinline__ XcdBarrier xcd_barrier_post(unsigned* bar, volatile LAS unsigned* st) {
    XcdBarrier b; b.bar = bar; b.x = xb_xcc_id(); b.st = st;
    if (threadIdx.x == 0) (void)xb_add(&bar[XB_XCNT(b.x)], 1u);
    return b;
}
__device__ __forceinline__ void xcd_barrier_complete(unsigned* bar, unsigned x, unsigned& nloc, unsigned& nx) {
    const unsigned G = gridDim.x * gridDim.y * gridDim.z;
    unsigned sum, cnt, mine, sp = 0u;
    for (;;) {
        sum = 0u; cnt = 0u; mine = 0u;
#pragma unroll
        for (unsigned j = 0; j < 16; ++j) { const unsigned c = xb_ld(&bar[XB_XCNT(j)]); sum += c; cnt += (c > 0u) ? 1u : 0u; mine = (j == x) ? c : mine; }
        if (sum == G) break;
        __builtin_amdgcn_s_sleep(1);
        if ((++sp & 255u) == 0u) { if (xb_ld(&bar[XB_TMO])) break; if (sp > XB_SPIN_CAP) { atomicAdd(&bar[XB_TMO], 1u); break; } }
    }
    nloc = mine > 0u ? mine : 1u; nx = cnt > 0u ? cnt : 1u;
}

__device__ __forceinline__ void xcd_barrier(const XcdBarrier& b) {
    asm volatile("s_waitcnt vmcnt(0)" ::: "memory");
    __syncthreads();
    if (threadIdx.x == 0) {
        unsigned* bar = b.bar;
        __builtin_amdgcn_s_waitcnt(0);
        unsigned nloc = b.st[0], nx = b.st[1];
        if (nloc == 0u) { xcd_barrier_complete(bar, b.x, nloc, nx); b.st[0] = nloc; b.st[1] = nx; }
        const unsigned old = xb_add(&bar[XB_XSUB(b.x)], 1u);
        const unsigned gen = old / nloc;
        if (old + 1u == (gen + 1u) * nloc) {
            __builtin_amdgcn_fence(__ATOMIC_RELEASE, "agent");
            asm volatile("s_waitcnt vmcnt(0)" ::: "memory");
            const unsigned og = xb_add(&bar[XB_TOP], 1u);
            const unsigned tg = og / nx;
            if (og + 1u == (tg + 1u) * nx) xb_add(&bar[XB_TOPGEN], 1u);
            else XB_SPIN(xb_ld(&bar[XB_TOPGEN]) == tg, bar);
            __builtin_amdgcn_fence(__ATOMIC_ACQUIRE, "agent");
            xb_add(&bar[XB_XGEN(b.x)], 1u);
            asm volatile("s_waitcnt vmcnt(0)" ::: "memory");
        } else {
            XB_SPIN(xb_ld(&bar[XB_XGEN(b.x)]) == gen, bar);
            __builtin_amdgcn_fence(__ATOMIC_ACQUIRE, "agent");
            asm volatile("s_waitcnt vmcnt(0)" ::: "memory");
        }
    }
    __syncthreads();
}
constexpr int NWAVES = 8, NTHREADS = 512;
constexpr int TT = 16384, DM = 1024, SEQ = 8192, NIN = 1280, NQD = 2048, NEXP = 16384;
constexpr float DN_ALPHA = 1.189207115002721f;
constexpr float LN_EPS = 1e-5f;
constexpr float LOG2E = 1.4426950408889634f;
constexpr float QSCALE = 0.125f * LOG2E;

constexpr size_t MiB = 1u << 20;
constexpr size_t WS_CTL = 0, CTL_ZERO_BYTES = 64 * 1024;
constexpr size_t WS_MODP = 1 * MiB;
constexpr size_t WS_MOD = 1 * MiB + 896 * 1024;
constexpr size_t WS_ROPE = 2 * MiB;
constexpr size_t WS_WIN = 248 * MiB;
constexpr size_t WS_BIAS = 4 * MiB;
constexpr size_t WS_K1 = 6 * MiB + 512 * 1024, WS_K2 = WS_K1 + 32 * 1024;
constexpr size_t WS_WOUT = 7 * MiB;
constexpr size_t WS_WPQ = 9 * MiB;
constexpr size_t WS_SU = 13 * MiB, WS_SV = 13 * MiB + 65536;
constexpr size_t WS_U = 16 * MiB, WS_V = 32 * MiB;
constexpr size_t WS_H2Q = 48 * MiB, WS_SH = 13 * MiB + 131072;
constexpr size_t WS_XN8 = 64 * MiB;
constexpr size_t WS_XN = 80 * MiB;
constexpr size_t WS_MIX = 112 * MiB;
constexpr size_t WS_PE = 80 * MiB, WS_PG = 84 * MiB;
constexpr size_t WS_PROJ = 112 * MiB;
constexpr size_t WS_A2 = 152 * MiB;
constexpr size_t WS_X1 = 184 * MiB, WS_H2 = 216 * MiB;
constexpr size_t WS_Q = 112 * MiB;
constexpr size_t WS_END = 253 * MiB;
constexpr int CW_MODCNT = 1024;
constexpr int CW_BAR = 4096;

constexpr int RING_BYTES = 131072, LDSCTL_OFF = RING_BYTES, MISC_OFF = LDSCTL_OFF + 320, LDS_BYTES = 147456;

typedef float f32x16 __attribute__((ext_vector_type(16)));
typedef float f32x2 __attribute__((ext_vector_type(2)));
typedef unsigned u32x2 __attribute__((ext_vector_type(2)));
typedef unsigned u32x4 __attribute__((ext_vector_type(4)));
typedef __bf16 bf16x2_t __attribute__((ext_vector_type(2)));
struct Frame {
    LAS unsigned char* lds;
    int tid, lane, wave, vcu, G;
    const float *x, *c, *w_ada, *b_ada, *w_in, *sinks, *w_pool, *pool_scale, *w_out, *ln1_g, *ln1_b, *w_pq, *k1, *k2, *pu, *pv, *ln2_g, *ln2_b;
    float* out; unsigned char* ws;
};
__device__ __forceinline__ float wave_sum(float v) {
#pragma unroll
    for (int o = 1; o < 64; o <<= 1) v += __shfl_xor(v, o);
    return v;
}
__device__ __forceinline__ float bf_lo(unsigned u) { return __uint_as_float(u << 16); }
__device__ __forceinline__ float bf_hi(unsigned u) { return __uint_as_float(u & 0xffff0000u); }
__device__ __forceinline__ float bf2f(bf16 b) { return __uint_as_float((unsigned)b << 16); }
__device__ __forceinline__ unsigned fp8x4(float a, float b, float c, float d) { int pk = __builtin_amdgcn_cvt_pk_fp8_f32(a, b, 0, false); pk = __builtin_amdgcn_cvt_pk_fp8_f32(c, d, pk, true); return (unsigned)pk; }

template <int MODE, bool OUT8 = false>
__device__ __forceinline__ void transpose_item(const float* W, int ldw, bf16* WT, int ldt, int k0, int n0, LAS float* scr, int lane, const LAS float* ksc = nullptr, float oscale = 1.0f) {
    int nsrc = n0 + (lane & 31);
    if (MODE == 1 && nsrc < 640) { const int hd = nsrc >> 6, w = nsrc & 63; nsrc = hd * 64 + (w >> 1) + 32 * (w & 1); }
    float wv[32];
#pragma unroll
    for (int i = 0; i < 32; ++i) wv[i] = W[(size_t)(k0 + 2 * i + (lane >> 5)) * ldw + nsrc];
#pragma unroll
    for (int i = 0; i < 32; ++i) { const int kk = 2 * i + (lane >> 5); float w_ = wv[i]; if (MODE == 1) w_ *= ksc[k0 + kk]; scr[kk * 33 + (lane & 31)] = w_; }
    LDS_WAIT(); asm volatile("" ::: "memory");
    const int c = lane & 7;
#pragma unroll
    for (int j = 0; j < 4; ++j) { const int n = (lane >> 3) + 8 * j; const LAS float* s = scr + (8 * c) * 33 + n;
        if (OUT8) { u32x2 o8; o8.x = fp8x4(s[0 * 33] * oscale, s[1 * 33] * oscale, s[2 * 33] * oscale, s[3 * 33] * oscale); o8.y = fp8x4(s[4 * 33] * oscale, s[5 * 33] * oscale, s[6 * 33] * oscale, s[7 * 33] * oscale);
            *(u32x2*)((unsigned char*)WT + (size_t)(n0 + n) * ldt + k0 + 8 * c) = o8; }
        else { v4u o; o.x = pk2(s[0 * 33], s[1 * 33]); o.y = pk2(s[2 * 33], s[3 * 33]); o.z = pk2(s[4 * 33], s[5 * 33]); o.w = pk2(s[6 * 33], s[7 * 33]);
            *(GAS v4u*)(WT + (size_t)(n0 + n) * ldt + k0 + 8 * c) = o; } }
    LDS_WAIT(); asm volatile("" ::: "memory");
}
__device__ __forceinline__ void sincos_d(double a, float& s, float& c) {
    const double TWO_PI = 6.283185307179586476925, PI = 3.141592653589793238462643;
    double r = a - TWO_PI * rint(a / TWO_PI);
    double sg = 1.0;
    if (r > 0.5 * PI) { r = PI - r; sg = -1.0; } else if (r < -0.5 * PI) { r = -PI - r; sg = -1.0; }
    const double r2 = r * r;
    double sp = -1.0 / 121645100408832000.0;
    sp = sp * r2 + 1.0 / 355687428096000.0; sp = sp * r2 - 1.0 / 1307674368000.0; sp = sp * r2 + 1.0 / 6227020800.0; sp = sp * r2 - 1.0 / 39916800.0;
    sp = sp * r2 + 1.0 / 362880.0; sp = sp * r2 - 1.0 / 5040.0; sp = sp * r2 + 1.0 / 120.0; sp = sp * r2 - 1.0 / 6.0; sp = sp * r2 + 1.0;
    double cp = 1.0 / 6402373705728000.0;
    cp = cp * r2 - 1.0 / 20922789888000.0; cp = cp * r2 + 1.0 / 87178291200.0; cp = cp * r2 - 1.0 / 479001600.0; cp = cp * r2 + 1.0 / 3628800.0;
    cp = cp * r2 - 1.0 / 40320.0; cp = cp * r2 + 1.0 / 720.0; cp = cp * r2 - 1.0 / 24.0; cp = cp * r2 + 0.5; cp = 1.0 - cp * r2;
    s = (float)(sp * r); c = (float)(sg * cp);
}
__device__ __forceinline__ void p1_win(Frame& F);
__device__ __forceinline__ void p0_prologue(Frame& F, int parts = 0xff) {
    LAS float* scr = (LAS float*)(F.lds + F.wave * 16384);
    const int gw = F.vcu * NWAVES + F.wave, NGW = F.G * NWAVES, lane = F.lane;
    if ((parts & 1) && (int)blockIdx.x < 192) { const int gb = (int)blockIdx.x, chunk = gb % 96, kh = gb / 96, col = chunk * 64 + lane, kbase = kh * 512 + F.wave * 64; float a0 = 0.f, a1 = 0.f;
        LAS float* sl = (LAS float*)(F.lds + F.wave * 16384 + 8448);
        { const int k = kbase + lane; const float c0 = F.c[k], c1 = F.c[DM + k]; sl[lane] = c0 / (1.f + __expf(-c0)); sl[64 + lane] = c1 / (1.f + __expf(-c1)); }
        LDS_WAIT(); asm volatile("" ::: "memory");
        { float w[64];
#pragma unroll
            for (int u = 0; u < 64; ++u) w[u] = F.w_ada[(size_t)(kbase + u) * 6144 + col];
#pragma unroll
            for (int u = 0; u < 64; ++u) { a0 += sl[u] * w[u]; a1 += sl[64 + u] * w[u]; } }
        LAS float* red = (LAS float*)(F.lds + F.wave * 16384 + 12288); red[lane] = a0; red[64 + lane] = a1;
        __syncthreads();
        if (F.tid < 128) { const int bb = F.tid >> 6, l = F.tid & 63; float sacc = kh == 0 ? F.b_ada[chunk * 64 + l] : 0.f;
#pragma unroll
            for (int w = 0; w < 8; ++w) sacc += ((const LAS float*)(F.lds + w * 16384 + 12288))[bb * 64 + l];
            ((float*)(F.ws + WS_MODP))[(kh * 2 + bb) * 6144 + chunk * 64 + l] = sacc; }
        asm volatile("s_waitcnt vmcnt(0)" ::: "memory"); __syncthreads();
        if (F.tid == 0) { __builtin_amdgcn_fence(__ATOMIC_RELEASE, "agent"); asm volatile("s_waitcnt vmcnt(0)" ::: "memory");
            __hip_atomic_fetch_add((unsigned*)(F.ws + WS_CTL) + CW_MODCNT, 1u, __ATOMIC_RELAXED, __HIP_MEMORY_SCOPE_AGENT); } }
    if (parts & 2) { float* rope = (float*)(F.ws + WS_ROPE);
      for (int e = gw * 64 + lane; e < SEQ * 32; e += NGW * 64) { const int pos = e >> 5, i = e & 31;
          const float freq = powf(10000.0f, -(float)i / 32.0f); const float ang = (float)pos * freq; float s, c; sincos_d((double)ang, s, c);
          rope[2 * e] = c; rope[2 * e + 1] = s; } }
    if (parts & 4) { constexpr int I_PQ = 16 * 64, I_OUT = 8 * 32;
      for (int it = NGW - 1 - gw; it < I_PQ + I_OUT; it += NGW) { int r = it;
          if (r < I_PQ) { transpose_item<0>(F.w_pq, NQD, (bf16*)(F.ws + WS_WPQ), DM, 64 * (r / 64), 32 * (r % 64), scr, lane); continue; } r -= I_PQ;
          transpose_item<0, true>(F.w_out, DM, (bf16*)(F.ws + WS_WOUT), DM, 64 * (r / 32), 32 * (r % 32), scr, lane, nullptr, 64.0f); } }
    if (parts & 8) { unsigned char* wout_t = F.ws + WS_WOUT;
      for (int it = gw; it < 4 * 2 * 128; it += NGW) { const int g = it >> 8, ch = (it >> 7) & 1, n0 = (it & 127) * 8, cidx = ch * 64 + lane;
          const float* wo = F.w_out + (size_t)(512 + g * 128) * DM + n0; const float* ps = F.pool_scale + g * 128;
#pragma unroll
          for (int i = 0; i < 4; ++i) { const int f4 = lane + 64 * i, e = f4 >> 1, hf = f4 & 1; const f32x4 o = *(const f32x4*)(wo + (size_t)e * DM + 4 * hf) * ps[e]; *(LAS f32x4*)(scr + e * 8 + 4 * hf) = o; }
          float acc[8];
#pragma unroll
          for (int i = 0; i < 8; ++i) acc[i] = 0.f;
          const float* wp = F.w_pool + ((size_t)(g * 128 + cidx)) * 128;
          LDS_WAIT(); asm volatile("" ::: "memory");
#pragma unroll 1
          for (int e0 = 0; e0 < 128; e0 += 64) { f32x4 wv[16];
#pragma unroll
              for (int q = 0; q < 16; ++q) wv[q] = *(const f32x4*)(wp + e0 + 4 * q);
#pragma unroll
              for (int q = 0; q < 16; ++q)
#pragma unroll
                  for (int ee = 0; ee < 4; ++ee) { const float w = wv[q][ee]; const f32x4 o0 = *(const LAS f32x4*)(scr + (e0 + 4 * q + ee) * 8), o1 = *(const LAS f32x4*)(scr + (e0 + 4 * q + ee) * 8 + 4);
                      acc[0] += w * o0[0]; acc[1] += w * o0[1]; acc[2] += w * o0[2]; acc[3] += w * o0[3]; acc[4] += w * o1[0]; acc[5] += w * o1[1]; acc[6] += w * o1[2]; acc[7] += w * o1[3]; } }
#pragma unroll
          for (int i = 0; i < 8; ++i) wout_t[(size_t)(n0 + i) * DM + 512 + g * 128 + cidx] = (unsigned char)(fp8x4(acc[i] * 64.0f, 0.f, 0.f, 0.f) & 0xffu);
          LDS_WAIT(); asm volatile("" ::: "memory"); } }
    if (parts & 16) { bf16* k1b = (bf16*)(F.ws + WS_K1); bf16* k2b = (bf16*)(F.ws + WS_K2);
      for (int e = gw * 64 + lane; e < 128 * 128; e += NGW * 64) { k1b[e] = (bf16)f2bf(F.k1[e]); k2b[e] = (bf16)f2bf(F.k2[e]); } }
    if (parts & 32) { bf16* xn = (bf16*)(F.ws + WS_XN); const int rpw = TT / NGW;
      for (int m = gw * rpw; m < gw * rpw + rpw; m += 4) { f32x4 v[4][4];
#pragma unroll
          for (int q = 0; q < 4; ++q)
#pragma unroll
              for (int j = 0; j < 4; ++j) v[q][j] = *(const f32x4*)(F.x + (size_t)(m + q) * DM + 256 * j + 4 * lane);
#pragma unroll
          for (int q = 0; q < 4; ++q)
#pragma unroll
              for (int j = 0; j < 4; ++j) { u32x2 o; o.x = pk2(v[q][j][0], v[q][j][1]); o.y = pk2(v[q][j][2], v[q][j][3]); *(u32x2*)(xn + (size_t)(m + q) * DM + 256 * j + 4 * lane) = o;
                  *(unsigned*)(F.ws + WS_XN8 + (size_t)(m + q) * DM + 256 * j + 4 * lane) = fp8x4(v[q][j][0], v[q][j][1], v[q][j][2], v[q][j][3]); } } }
    if (parts & 64) {
        __syncthreads();
        if (F.tid == 0) { unsigned sp = 0; const unsigned* cnt = (const unsigned*)(F.ws + WS_CTL) + CW_MODCNT;
            while (__hip_atomic_load(cnt, __ATOMIC_RELAXED, __HIP_MEMORY_SCOPE_AGENT) < 192u) { __builtin_amdgcn_s_sleep(2); if (++sp > (1u << 22)) break; }
            __builtin_amdgcn_fence(__ATOMIC_ACQUIRE, "agent"); asm volatile("s_waitcnt vmcnt(0)" ::: "memory"); }
        __syncthreads();
        p1_win(F);
    }
}
__device__ __forceinline__ void tb_load4(Frame& F, int base, int r1, f32x4 (&dst)[4][4]) {
#pragma unroll
    for (int q = 0; q < 4; ++q) { const int it = (base + q < r1) ? base + q : r1 - 1; const int tb = it >= NEXP, e = it - tb * NEXP; const float* src = (tb ? F.pv : F.pu) + (size_t)e * DM;
#pragma unroll
        for (int j = 0; j < 4; ++j) dst[q][j] = *(const f32x4*)(src + 256 * j + 4 * F.lane); }
}
__device__ __forceinline__ void tb_proc4(Frame& F, int base, int r1, const f32x4 (&v)[4][4]) {
    const int lane = F.lane; float* su = (float*)(F.ws + WS_SU); float* sv = (float*)(F.ws + WS_SV); float am[4];
#pragma unroll
    for (int q = 0; q < 4; ++q) { float a = 0.f;
#pragma unroll
        for (int j = 0; j < 4; ++j) a = fmaxf(a, fmaxf(fmaxf(fabsf(v[q][j][0]), fabsf(v[q][j][1])), fmaxf(fabsf(v[q][j][2]), fabsf(v[q][j][3])))); am[q] = a; }
#pragma unroll
    for (int o = 1; o < 64; o <<= 1) {
#pragma unroll
        for (int q = 0; q < 4; ++q) am[q] = fmaxf(am[q], __shfl_xor(am[q], o)); }
#pragma unroll
    for (int q = 0; q < 4; ++q) { const int it = (base + q < r1) ? base + q : r1 - 1; const int tb = it >= NEXP, e = it - tb * NEXP; float a = am[q]; if (a == 0.f) a = 1.f;
        unsigned w[4];
        if (!tb) { const float inv = 127.0f / a;
#pragma unroll
            for (int j = 0; j < 4; ++j) { const int q0 = (int)rintf(v[q][j][0] * inv), q1 = (int)rintf(v[q][j][1] * inv), q2 = (int)rintf(v[q][j][2] * inv), q3 = (int)rintf(v[q][j][3] * inv);
                w[j] = (unsigned)(q0 & 255) | ((unsigned)(q1 & 255) << 8) | ((unsigned)(q2 & 255) << 16) | ((unsigned)(q3 & 255) << 24); }
            *(v4u*)(F.ws + WS_U + (size_t)e * DM + 16 * lane) = (v4u){w[0], w[1], w[2], w[3]}; if (lane == 0) su[e] = a * (1.0f / 127.0f);
        } else { const float inv = 256.0f / a;
#pragma unroll
            for (int j = 0; j < 4; ++j) { unsigned wv = 0u, g = 0u;
#pragma unroll
                for (int i = 0; i < 4; ++i) { const float t = v[q][j][i] * inv; const unsigned short hb = __builtin_bit_cast(unsigned short, (_Float16)t);
                    const int m = (int)(hb & 0x7fffu); int h7 = (m - (int)g + 128) >> 8; h7 = h7 < 0 ? 0 : (h7 > 0x7B ? 0x7B : h7);
                    const unsigned byte = (unsigned)h7 | ((hb >> 8) & 0x80u); wv |= byte << (8 * i); g = byte; }
                w[j] = wv; }
            *(v4u*)(F.ws + WS_V + (size_t)e * DM + 16 * lane) = (v4u){w[0], w[1], w[2], w[3]}; if (lane == 0) sv[e] = a * (1.0f / 256.0f); } }
}
__device__ __forceinline__ void p2_tables(Frame& F, int cw, int ncw, int row_lo, int row_hi) {
    const int per = (row_hi - row_lo + ncw - 1) / ncw, r0 = row_lo + cw * per, r1 = (r0 + per) < row_hi ? (r0 + per) : row_hi;
    if (r0 >= r1) return;
    f32x4 va[4][4], vb[4][4];
    tb_load4(F, r0, r1, va);
    for (int it0 = r0; it0 < r1; it0 += 8) {
        if (it0 + 4 < r1) tb_load4(F, it0 + 4, r1, vb);
        tb_proc4(F, it0, r1, va);
        if (it0 + 4 < r1) { if (it0 + 8 < r1) tb_load4(F, it0 + 8, r1, va); tb_proc4(F, it0 + 4, r1, vb); }
    }
}
__device__ __forceinline__ void p1_win(Frame& F) {
    const float* mp = (const float*)(F.ws + WS_MODP);
    if (F.vcu < 48 && F.tid < 256) { const int e = F.vcu * 256 + F.tid; ((float*)(F.ws + WS_MOD))[e] = mp[e] + mp[2 * 6144 + e]; }
    LAS float* sc = (LAS float*)F.lds; LAS float* sh = sc + 2048;
    for (int i = F.tid; i < 2048; i += NTHREADS) { const int b = i >> 10, k = i & 1023; sc[i] = 1.f + mp[b * 6144 + 1024 + k] + mp[(2 + b) * 6144 + 1024 + k]; sh[i] = mp[b * 6144 + k] + mp[(2 + b) * 6144 + k]; }
    __syncthreads();
    const int lane = F.lane;
    if (F.vcu < 40) { const int b = F.vcu / 20, n = (F.vcu % 20) * 64 + lane; int nsrc = n; if (n < 640) { const int hd = n >> 6, w = n & 63; nsrc = hd * 64 + (w >> 1) + 32 * (w & 1); }
        float a = 0.f;
#pragma unroll 1
        for (int kb = 0; kb < 128; kb += 64) { float w[64];
#pragma unroll
            for (int u = 0; u < 64; ++u) w[u] = F.w_in[(size_t)(F.wave * 128 + kb + u) * NIN + nsrc];
#pragma unroll
            for (int u = 0; u < 64; ++u) a += sh[b * 1024 + F.wave * 128 + kb + u] * w[u]; }
        LAS float* red = (LAS float*)(F.lds + 16384); red[F.wave * 64 + lane] = a;
        __syncthreads();
        if (F.tid < 64) { float sacc = 0.f;
#pragma unroll
            for (int w = 0; w < 8; ++w) sacc += red[w * 64 + F.tid];
            ((float*)(F.ws + WS_BIAS))[b * NIN + (F.vcu % 20) * 64 + F.tid] = sacc; } }
    LAS float* scr = (LAS float*)(F.lds + 32768 + F.wave * 8448);
    const int gw = F.vcu * NWAVES + F.wave, NGW = F.G * NWAVES;
    for (int it = gw; it < 2 * 640; it += NGW) { const int b = it / 640, r = it % 640;
        transpose_item<1, true>(F.w_in, NIN, (bf16*)(F.ws + WS_WIN + (size_t)b * NIN * DM), DM, 64 * (r / 40), 32 * (r % 40), scr, lane, sc + b * 1024, 64.0f); }
    __syncthreads();
}
constexpr int KS_STRIDE = 144, VT_STRIDE = 520, KS_BYTES = 256 * KS_STRIDE, VT_BYTES = 64 * VT_STRIDE;
struct KvRegs { v4u k[4], v[4]; };
__device__ __forceinline__ void p3_attn_kvload(Frame& F, int unit, KvRegs& R) {
    const int b = unit >> 7, kvh = (unit >> 6) & 1, n = unit & 63; const bf16* proj = (const bf16*)(F.ws + WS_PROJ);
    const size_t tok0 = (size_t)b * SEQ + (size_t)n * 128;
#pragma unroll
    for (int i = 0; i < 4; ++i) { const int ci = F.tid + NTHREADS * i, row = ci >> 3, ch = ci & 7; const bool valid = (n > 0) || (row >= 128); const size_t tk = tok0 - 128 + row;
        R.k[i] = (v4u){0u, 0u, 0u, 0u}; R.v[i] = (v4u){0u, 0u, 0u, 0u};
        if (valid) { R.k[i] = *(const v4u*)(proj + tk * NIN + 512 + kvh * 64 + ch * 8); R.v[i] = *(const v4u*)(proj + tk * NIN + 640 + kvh * 64 + ch * 8); } }
}
__device__ __forceinline__ void p3_attn_unit(Frame& F, int unit, const KvRegs& R) {
    const int b = unit >> 7, kvh = (unit >> 6) & 1, n = unit & 63;
    const bf16* proj = (const bf16*)(F.ws + WS_PROJ); unsigned char* a2 = F.ws + WS_A2;
    LAS unsigned char* Ks = F.lds; LAS unsigned char* Vt = F.lds + KS_BYTES;
    const int tid = F.tid, lane = F.lane, wave = F.wave, r32 = lane & 31, h = lane >> 5;
    const size_t tok0 = (size_t)b * SEQ + (size_t)n * 128;
#pragma unroll
    for (int i = 0; i < 4; ++i) { const int ci = tid + NTHREADS * i, row = ci >> 3, ch = ci & 7;
        const v4u kv = R.k[i], vv = R.v[i];
        *(LAS v4u*)(Ks + row * KS_STRIDE + ch * 16) = kv;
        LAS bf16* vt = (LAS bf16*)(Vt + (ch * 8) * VT_STRIDE) + row;
        vt[0 * (VT_STRIDE / 2)] = (bf16)(vv.x & 0xffff); vt[1 * (VT_STRIDE / 2)] = (bf16)(vv.x >> 16); vt[2 * (VT_STRIDE / 2)] = (bf16)(vv.y & 0xffff); vt[3 * (VT_STRIDE / 2)] = (bf16)(vv.y >> 16);
        vt[4 * (VT_STRIDE / 2)] = (bf16)(vv.z & 0xffff); vt[5 * (VT_STRIDE / 2)] = (bf16)(vv.z >> 16); vt[6 * (VT_STRIDE / 2)] = (bf16)(vv.w & 0xffff); vt[7 * (VT_STRIDE / 2)] = (bf16)(vv.w >> 16); }
    __syncthreads();
    const int g = wave >> 1, hq = kvh * 4 + g; const float sink2 = F.sinks[hq] * LOG2E;
#pragma unroll 1
    for (int qt = 0; qt < 2; ++qt) {
        const int qi0 = (wave & 1) * 64 + qt * 32, t0 = qi0 >> 5; const size_t tokq = tok0 + qi0 + r32;
        bf16x8 qf[4];
#pragma unroll
        for (int s = 0; s < 4; ++s) qf[s] = *(const bf16x8*)(proj + tokq * NIN + hq * 64 + 16 * s + 8 * h);
        f32x16 sc[5];
#pragma unroll
        for (int kt = 0; kt < 5; ++kt) { sc[kt] = (f32x16){};
#pragma unroll
            for (int s = 0; s < 4; ++s) { const bf16x8 kf = *(const LAS bf16x8*)(Ks + (32 * (t0 + kt) + r32) * KS_STRIDE + (16 * s + 8 * h) * 2);
                sc[kt] = __builtin_amdgcn_mfma_f32_32x32x16_bf16(kf, qf[s], sc[kt], 0, 0, 0); } }
        const int qi = qi0 + r32; float m = sink2;
#pragma unroll
        for (int kt = 0; kt < 5; ++kt)
#pragma unroll
            for (int r = 0; r < 16; ++r) { const int sidx = 32 * (t0 + kt) + (r & 3) + 8 * (r >> 2) + 4 * h; const int rel = qi + 128 - sidx;
                const bool ok = (rel >= 0) && (rel < 128) && ((n > 0) || (sidx >= 128));
                const float v = ok ? sc[kt][r] : -INFINITY; sc[kt][r] = v; m = fmaxf(m, v); }
        m = fmaxf(m, __shfl_xor(m, 32));
        float l = 0.f;
#pragma unroll
        for (int kt = 0; kt < 5; ++kt)
#pragma unroll
            for (int r = 0; r < 16; ++r) { const float p = __builtin_amdgcn_exp2f(sc[kt][r] - m); sc[kt][r] = p; l += p; }
        l += __shfl_xor(l, 32); l += __builtin_amdgcn_exp2f(sink2 - m);
        f32x16 o[2]; o[0] = (f32x16){}; o[1] = (f32x16){};
#pragma unroll
        for (int kt = 0; kt < 5; ++kt)
#pragma unroll
            for (int s2 = 0; s2 < 2; ++s2) {
                u32x4 pw; pw.x = pg8::cvt_pk_bf16(sc[kt][8 * s2 + 0], sc[kt][8 * s2 + 1]); pw.y = pg8::cvt_pk_bf16(sc[kt][8 * s2 + 2], sc[kt][8 * s2 + 3]);
                pw.z = pg8::cvt_pk_bf16(sc[kt][8 * s2 + 4], sc[kt][8 * s2 + 5]); pw.w = pg8::cvt_pk_bf16(sc[kt][8 * s2 + 6], sc[kt][8 * s2 + 7]);
                const bf16x8 pf = __builtin_bit_cast(bf16x8, pw);
#pragma unroll
                for (int dt = 0; dt < 2; ++dt) { const LAS unsigned char* vp = Vt + (dt * 32 + r32) * VT_STRIDE + (32 * (t0 + kt) + 16 * s2 + 4 * h) * 2;
                    const u32x2 lo = *(const LAS u32x2*)vp, hi = *(const LAS u32x2*)(vp + 16);
                    const u32x4 vw = (u32x4){lo.x, lo.y, hi.x, hi.y};
                    o[dt] = __builtin_amdgcn_mfma_f32_32x32x16_bf16(__builtin_bit_cast(bf16x8, vw), pf, o[dt], 0, 0, 0); } }
        const float inv = 16.0f / l;
#pragma unroll
        for (int dt = 0; dt < 2; ++dt)
#pragma unroll
            for (int rg = 0; rg < 4; ++rg) { const int d0 = dt * 32 + 8 * rg + 4 * h;
                *(unsigned*)(a2 + tokq * DM + hq * 64 + d0) = fp8x4(o[dt][4 * rg + 0] * inv, o[dt][4 * rg + 1] * inv, o[dt][4 * rg + 2] * inv, o[dt][4 * rg + 3] * inv); }
    }
    __syncthreads();
}
struct PoolRegs { unsigned u[48]; };
__device__ __forceinline__ void p3_pool_load(Frame& F, int unit, PoolRegs& R) {
    const bf16* proj = (const bf16*)(F.ws + WS_PROJ);
    const int cp = F.tid & 255, half = F.tid >> 8;
    const int tstart = unit * 64 + half * 32, s0 = tstart & (SEQ - 1);
    const bf16* pc = proj + 768 + 2 * cp;
#pragma unroll
    for (int i = 0; i < 48; ++i) { const int s = s0 - 16 + i; R.u[i] = (s >= 0) ? *(const unsigned*)(pc + (size_t)(tstart - 16 + i) * NIN) : 0u; }
}
__device__ __forceinline__ void p3_pool_compute(Frame& F, int unit, const PoolRegs& R) {
    unsigned char* a2 = F.ws + WS_A2;
    const int cp = F.tid & 255, half = F.tid >> 8, gi = cp >> 6, w = 2 << gi;
    const int tstart = unit * 64 + half * 32, s0 = tstart & (SEQ - 1);
    const unsigned (&u)[48] = R.u;
    float w0 = 0.f, w1 = 0.f;
#pragma unroll
    for (int j = 1; j <= 16; ++j) if (j <= w) { w0 += bf_lo(u[16 - j]); w1 += bf_hi(u[16 - j]); }
#pragma unroll
    for (int i = 0; i < 32; ++i) { const int s = s0 + i; const float p0 = bf_lo(u[16 + i]), p1 = bf_hi(u[16 + i]);
        const unsigned uo = (w == 2) ? u[14 + i] : (w == 4) ? u[12 + i] : (w == 8) ? u[8 + i] : u[i];
        w0 += p0 - bf_lo(uo); w1 += p1 - bf_hi(uo);
        const float rc = 1.0f / (float)((s + 1) < w ? (s + 1) : w);
        *(unsigned short*)(a2 + (size_t)(tstart + i) * DM + 512 + 2 * cp) = (unsigned short)(fp8x4((w0 * rc - p0) * 16.0f, (w1 * rc - p1) * 16.0f, 0.f, 0.f) & 0xffffu); }
}
__device__ __forceinline__ void p5_ln1(Frame& F) {
    const float* mod = (const float*)(F.ws + WS_MOD); const bf16* mix = (const bf16*)(F.ws + WS_MIX); const bf16* xn = (const bf16*)(F.ws + WS_XN);
    bf16* x1 = (bf16*)(F.ws + WS_X1); bf16* h2 = (bf16*)(F.ws + WS_H2); unsigned char* h2q = F.ws + WS_H2Q; float* shp = (float*)(F.ws + WS_SH);
    const int gw = F.vcu * NWAVES + F.wave, lane = F.lane; const int rows_per_wave = TT / (F.G * NWAVES);
    const int row0 = gw * rows_per_wave, b = row0 >> 13;
    f32x4 g1[4], lg[4], lb[4], s2[4], h2s[4];
#pragma unroll
    for (int j = 0; j < 4; ++j) { const int d = 256 * j + 4 * lane;
        g1[j] = *(const f32x4*)(mod + b * 6144 + 2048 + d) + 1.0f; lg[j] = *(const f32x4*)(F.ln1_g + d); lb[j] = *(const f32x4*)(F.ln1_b + d);
        s2[j] = *(const f32x4*)(mod + b * 6144 + 4096 + d) + 1.0f; h2s[j] = *(const f32x4*)(mod + b * 6144 + 3072 + d); }
    for (int r = 0; r < rows_per_wave; r += 2) {
        u32x2 xw[2][4]; u32x2 mv[2][4];
#pragma unroll
        for (int q = 0; q < 2; ++q)
#pragma unroll
            for (int j = 0; j < 4; ++j) { const size_t m = (size_t)(row0 + r + q); const int d = 256 * j + 4 * lane; xw[q][j] = *(const u32x2*)(xn + m * DM + d); mv[q][j] = *(const u32x2*)(mix + m * DM + d); }
#pragma unroll
        for (int q = 0; q < 2; ++q) { const size_t m = (size_t)(row0 + r + q);
        f32x4 v[4]; float s = 0.f;
#pragma unroll
        for (int j = 0; j < 4; ++j) {
            const f32x4 mf = (f32x4){bf_lo(mv[q][j].x), bf_hi(mv[q][j].x), bf_lo(mv[q][j].y), bf_hi(mv[q][j].y)};
            const f32x4 xf = (f32x4){bf_lo(xw[q][j].x), bf_hi(xw[q][j].x), bf_lo(xw[q][j].y), bf_hi(xw[q][j].y)};
            v[j] = xf * DN_ALPHA + g1[j] * mf; s += (v[j][0] + v[j][1]) + (v[j][2] + v[j][3]); }
        const float mean = wave_sum(s) * (1.f / DM); float qq = 0.f;
#pragma unroll
        for (int j = 0; j < 4; ++j) { v[j] = v[j] - mean; qq += (v[j][0] * v[j][0] + v[j][1] * v[j][1]) + (v[j][2] * v[j][2] + v[j][3] * v[j][3]); }
        const float rstd = 1.0f / sqrtf(wave_sum(qq) * (1.f / DM) + LN_EPS);
        f32x4 hh[4]; float am = 0.f;
#pragma unroll
        for (int j = 0; j < 4; ++j) { const int d = 256 * j + 4 * lane; const f32x4 y = v[j] * rstd * lg[j] + lb[j]; hh[j] = y * s2[j] + h2s[j];
            u32x2 o; o.x = pk2(y[0], y[1]); o.y = pk2(y[2], y[3]); *(u32x2*)(x1 + m * DM + d) = o;
            u32x2 p; p.x = pk2(hh[j][0], hh[j][1]); p.y = pk2(hh[j][2], hh[j][3]); *(u32x2*)(h2 + m * DM + d) = p;
            hh[j] = (f32x4){bf_lo(p.x), bf_hi(p.x), bf_lo(p.y), bf_hi(p.y)};
            am = fmaxf(am, fmaxf(fmaxf(fabsf(hh[j][0]), fabsf(hh[j][1])), fmaxf(fabsf(hh[j][2]), fabsf(hh[j][3])))); }
#pragma unroll
        for (int o = 1; o < 64; o <<= 1) am = fmaxf(am, __shfl_xor(am, o));
        if (am == 0.f) am = 1.f;
        const float inv = 127.0f / am; unsigned w[4];
#pragma unroll
        for (int j = 0; j < 4; ++j) { const int q0 = (int)rintf(hh[j][0] * inv), q1 = (int)rintf(hh[j][1] * inv), q2 = (int)rintf(hh[j][2] * inv), q3 = (int)rintf(hh[j][3] * inv);
            w[j] = (unsigned)(q0 & 255) | ((unsigned)(q1 & 255) << 8) | ((unsigned)(q2 & 255) << 16) | ((unsigned)(q3 & 255) << 24); }
        *(v4u*)(h2q + m * DM + 16 * lane) = (v4u){w[0], w[1], w[2], w[3]}; if (lane == 0) shp[m] = am * (1.0f / 127.0f); } }
}
constexpr int KR_STRIDE = 272, KR_BYTES = 128 * KR_STRIDE;
#define FMAX1(x, y) __builtin_amdgcn_fmed3f((x), (y), INFINITY)
#define FMIN1(x, y) __builtin_amdgcn_fmed3f((x), (y), -INFINITY)
#define INS16(a, v) do { _Pragma("unroll") for (int _i = 15; _i >= 1; --_i) a[_i] = __builtin_amdgcn_fmed3f(a[_i - 1], a[_i], (v)); a[0] = FMAX1(a[0], (v)); } while (0)
#define CEX(a, i, j) do { const float _x = a[i], _y = a[j]; a[i] = FMAX1(_x, _y); a[j] = FMIN1(_x, _y); } while (0)
#define SORT16(a) do { _Pragma("unroll") for (int _p = 1; _p < 16; _p <<= 1) { _Pragma("unroll") for (int _k = _p; _k >= 1; _k >>= 1) { _Pragma("unroll") for (int _j = _k % _p; _j <= 15 - _k; _j += 2 * _k) { \
        _Pragma("unroll") for (int _i = 0; _i < _k; ++_i) { if (_i + _j + _k <= 15 && (_i + _j) / (2 * _p) == (_i + _j + _k) / (2 * _p)) CEX(a, _i + _j, _i + _j + _k); } } } } } while (0)
#define MERGE16(a, b) do { _Pragma("unroll") for (int _i = 0; _i < 16; ++_i) a[_i] = FMAX1(a[_i], b[15 - _i]); BITONIC16(a); } while (0)
#define BITONIC16(a) do { _Pragma("unroll") for (int _st = 8; _st >= 1; _st >>= 1) { _Pragma("unroll") for (int _i = 0; _i < 16; ++_i) if ((_i & _st) == 0) { const float _x = a[_i], _y = a[_i + _st]; a[_i] = FMAX1(_x, _y); a[_i + _st] = FMIN1(_x, _y); } } } while (0)
__device__ __forceinline__ void p7_route(Frame& F) {
    const bf16* q = (const bf16*)(F.ws + WS_Q); unsigned short* pe = (unsigned short*)(F.ws + WS_PE); float* pg = (float*)(F.ws + WS_PG);
    const int tid = F.tid, lane = F.lane, wave = F.wave, r32 = lane & 31, h = lane >> 5;
    { const bf16* k1b = (const bf16*)(F.ws + WS_K1);
      for (int ci = tid; ci < 2 * 128 * 16; ci += NTHREADS) { const int side = ci >> 11, row = (ci >> 4) & 127, ch = ci & 15;
          *(LAS v4u*)(F.lds + side * KR_BYTES + row * KR_STRIDE + ch * 16) = *(const v4u*)(k1b + (size_t)side * 16384 + row * 128 + ch * 8); } }
    __syncthreads();
    LAS unsigned char* scr = F.lds + 2 * KR_BYTES + wave * 2048 + lane * 32;
    pg8::StaticOrder S; S.init(TT, NQD, F.G, (int)blockIdx.x); pg8::Unit u;
    for (int ui = 0; S.next(ui, u); ++ui) {
        const int head = u.pn; const size_t tok = (size_t)u.pm * 256 + wave * 32 + r32;
        float vv[2][16];
#pragma unroll
        for (int side = 0; side < 2; ++side) {
            const bf16* qb = q + tok * NQD + head * 256 + side * 128;
            bf16x8 qf[8];
#pragma unroll
            for (int s = 0; s < 8; ++s) qf[s] = *(const bf16x8*)(qb + 16 * s + 8 * h);
            float a[16];
#pragma unroll
            for (int kt = 0; kt < 4; ++kt) { f32x16 acc = (f32x16){};
#pragma unroll
                for (int s = 0; s < 8; ++s) { const bf16x8 kf = *(const LAS bf16x8*)(F.lds + side * KR_BYTES + (32 * kt + r32) * KR_STRIDE + (16 * s + 8 * h) * 2);
                    acc = __builtin_amdgcn_mfma_f32_32x32x16_bf16(kf, qf[s], acc, 0, 0, 0); }
                float t[16];
#pragma unroll
                for (int r = 0; r < 16; ++r) { const unsigned key = (unsigned)(32 * kt + (r & 3) + 8 * (r >> 2)) | ((unsigned)h << 2);
                    t[r] = __uint_as_float((__float_as_uint(acc[r]) & 0xFFFFFF80u) | key); }
                SORT16(t);
                if (kt == 0) {
#pragma unroll
                    for (int r = 0; r < 16; ++r) a[r] = t[r];
                } else MERGE16(a, t);
                __builtin_amdgcn_sched_barrier(0); }
            float c[16];
#pragma unroll
            for (int i = 0; i < 16; ++i) c[i] = __shfl_xor(a[15 - i], 32);
#pragma unroll
            for (int i = 0; i < 16; ++i) c[i] = FMAX1(a[i], c[i]);
            BITONIC16(c);
#pragma unroll
            for (int i = 0; i < 16; ++i) vv[side][i] = c[i];
        }
        { v4u w1, w2;
#define PK4(L, b) ((__float_as_uint(L[b]) & 0x7Fu) | ((__float_as_uint(L[b + 1]) & 0x7Fu) << 8) | ((__float_as_uint(L[b + 2]) & 0x7Fu) << 16) | ((__float_as_uint(L[b + 3]) & 0x7Fu) << 24))
          w1.x = PK4(vv[0], 0); w1.y = PK4(vv[0], 4); w1.z = PK4(vv[0], 8); w1.w = PK4(vv[0], 12);
          w2.x = PK4(vv[1], 0); w2.y = PK4(vv[1], 4); w2.z = PK4(vv[1], 8); w2.w = PK4(vv[1], 12);
#undef PK4
          *(LAS v4u*)scr = w1; *(LAS v4u*)(scr + 16) = w2; }
        float c1[16], c2[16], top[16];
#pragma unroll
        for (int i = 0; i < 16; ++i) { c1[i] = __uint_as_float(__float_as_uint(vv[0][i]) & 0xFFFFFF80u); c2[i] = __uint_as_float(__float_as_uint(vv[1][i]) & 0xFFFFFF80u); top[i] = -INFINITY; }
        { int cnt = 0; float pend = 0.f; unsigned pcode = 0u;
#pragma unroll
          for (int ia = 0; ia < 16; ++ia)
#pragma unroll
            for (int ib = 0; ib < 16; ++ib) if ((ia + 1) * (ib + 1) <= 16) {
                const float sm = c1[ia] + c2[ib]; const unsigned code = (unsigned)(ia * 16 + ib);
                if ((cnt & 1) == 0) { pend = sm; pcode = code; }
                else { const float vs = h ? sm : pend; const unsigned cd = h ? code : pcode; const float v = __uint_as_float((__float_as_uint(vs) & 0xFFFFFF00u) | cd); INS16(top, v); }
                ++cnt; }
          float ot[16];
#pragma unroll
          for (int i = 0; i < 16; ++i) ot[i] = __shfl_xor(top[15 - i], 32);
#pragma unroll
          for (int i = 0; i < 16; ++i) top[i] = FMAX1(top[i], ot[i]);
          BITONIC16(top); }
        float ex[16], den = 0.f;
#pragma unroll
        for (int i = 0; i < 16; ++i) { ex[i] = __expf(top[i] - top[0]); den += ex[i]; }
        const float rden = 1.0f / den;
        LDS_WAIT();
        unsigned short ev[8]; float gv[8];
#pragma unroll
        for (int j = 0; j < 8; ++j) { const float t = h ? top[8 + j] : top[j]; const float e = h ? ex[8 + j] : ex[j];
            const unsigned code = __float_as_uint(t) & 0xFFu; const unsigned i1 = *(const LAS unsigned char*)(scr + (code >> 4)), i2 = *(const LAS unsigned char*)(scr + 16 + (code & 15u));
            ev[j] = (unsigned short)(i1 * 128u + i2); gv[j] = e * rden; }
        v4u ew; ew.x = ev[0] | ((unsigned)ev[1] << 16); ew.y = ev[2] | ((unsigned)ev[3] << 16); ew.z = ev[4] | ((unsigned)ev[5] << 16); ew.w = ev[6] | ((unsigned)ev[7] << 16);
        *(v4u*)(pe + tok * 128 + head * 16 + 8 * h) = ew;
        *(f32x4*)(pg + tok * 128 + head * 16 + 8 * h) = (f32x4){gv[0], gv[1], gv[2], gv[3]};
        *(f32x4*)(pg + tok * 128 + head * 16 + 8 * h + 4) = (f32x4){gv[4], gv[5], gv[6], gv[7]};
        LDS_WAIT();
    }
    __syncthreads();
}
__device__ __forceinline__ float gelu_erf(float v) {
    const float d = fabsf(v) * 0.2316418882f + 1.0f, t = __builtin_amdgcn_rcpf(d);
    float q = t * 0.5307027145f + (-0.7265760135f); q = q * t + 0.7107068705f; q = q * t + (-0.142248368f); q = q * t + 0.127414796f; q = q * t;
    const float e = __builtin_amdgcn_exp2f(v * v * (-0.72134752044f)), m = v * (q * e);
    return v < 0.f ? m : v - m; }
#ifndef NPART
#define NPART 8
#endif
constexpr int TPW = 8, NSWEEP = 1;
constexpr int PSHIFT = (NPART == 32) ? 9 : (NPART == 8) ? 11 : (NPART == 16) ? 10 : (NPART == 4) ? 12 : (NPART == 2) ? 13 : 14;
__device__ __forceinline__ void p8_peer(Frame& F, unsigned emask = 0xffffu, int skip = 0) {
    const float* mod = (const float*)(F.ws + WS_MOD);
    const bf16* x1 = (const bf16*)(F.ws + WS_X1); const bf16* h2 = (const bf16*)(F.ws + WS_H2);
    const float* su = (const float*)(F.ws + WS_SU); const float* sv = (const float*)(F.ws + WS_SV);
    const unsigned* pe = (const unsigned*)(F.ws + WS_PE); const float* pg = (const float*)(F.ws + WS_PG);
    const int gw = F.vcu * NWAVES + F.wave;
    const int b3 = (F.lane >> 3) & 1;
#pragma unroll 1
    for (int sweep = 0; sweep < NSWEEP; ++sweep) {
    const int t0 = (gw * NSWEEP + sweep) * TPW, b = t0 >> 13;
    int lane = F.lane; asm volatile("" : "+v"(lane));
    unsigned hq[TPW][4]; float shs[TPW]; unsigned es[TPW]; float gs[TPW][2]; int offv[TPW];
    unsigned pe2v[TPW]; f32x2 pg2v[TPW];
#pragma unroll
    for (int tt = 0; tt < TPW; ++tt) { const size_t t = (size_t)(t0 + tt);
        const u32x4 hw = *(const u32x4*)(F.ws + WS_H2Q + t * DM + 16 * lane); hq[tt][0] = hw.x; hq[tt][1] = hw.y; hq[tt][2] = hw.z; hq[tt][3] = hw.w; shs[tt] = ((const float*)(F.ws + WS_SH))[t];
        pe2v[tt] = pe[t * 64 + lane]; pg2v[tt] = *(const f32x2*)(pg + t * 128 + 2 * lane); }
#pragma unroll
    for (int tt = 0; tt < TPW; ++tt) { LAS unsigned* scr = (LAS unsigned*)(F.lds + (F.wave * TPW + tt) * 1024);
        const unsigned pe2 = pe2v[tt]; const f32x2 pg2 = pg2v[tt];
        const unsigned elo = pe2 & emask, ehi = (pe2 >> 16) & emask; const int plo = (int)(elo >> PSHIFT), phi = (int)(ehi >> PSHIFT);
        int base = 0, poslo = 0, poshi = 0, ov = 0;
#pragma unroll
        for (int r = 0; r < NPART; ++r) { const unsigned long long mlo = __ballot(plo == r), mhi = __ballot(phi == r);
            const int clo = __popcll(mlo), chi = __popcll(mhi);
            const int rlo = (int)__builtin_amdgcn_mbcnt_hi((unsigned)(mlo >> 32), __builtin_amdgcn_mbcnt_lo((unsigned)mlo, 0u));
            const int rhi = (int)__builtin_amdgcn_mbcnt_hi((unsigned)(mhi >> 32), __builtin_amdgcn_mbcnt_lo((unsigned)mhi, 0u));
            if (plo == r) poslo = base + rlo; if (phi == r) poshi = base + clo + rhi;
            base += clo + chi; if (lane == r + 1) ov = base; }
        offv[tt] = ov;
        scr[2 * poslo] = elo; scr[2 * poslo + 1] = __float_as_uint(pg2.x); scr[2 * poshi] = ehi; scr[2 * poshi + 1] = __float_as_uint(pg2.y); }
    LDS_WAIT();
#pragma unroll
    for (int tt = 0; tt < TPW; ++tt) { const LAS unsigned* scr = (const LAS unsigned*)(F.lds + (F.wave * TPW + tt) * 1024);
        const u32x4 sr = *(const LAS u32x4*)(scr + 4 * lane);
        es[tt] = sr.x | (sr.z << 16); gs[tt][0] = __uint_as_float(sr.y); gs[tt][1] = __uint_as_float(sr.w); }
    LDS_WAIT();
    const __amdgpu_buffer_rsrc_t ut_rs = __builtin_amdgcn_make_buffer_rsrc((void*)(F.ws + WS_U), 0, NEXP * DM, 0x00020000), vt_rs = __builtin_amdgcn_make_buffer_rsrc((void*)(F.ws + WS_V), 0, NEXP * DM, 0x00020000);
    const int voff16 = 16 * lane;
#define ut ut_rs
#define vt vt_rs
#define P8_ISSUE(buf, tbl, tok, bb) do { _Pragma("unroll") for (int k2 = 0; k2 < 4; ++k2) { const unsigned ew = (unsigned)__builtin_amdgcn_readlane((int)es[tok], 4 * (bb) + k2); \
        buf[2 * k2] = __builtin_amdgcn_raw_buffer_load_b128((tbl), voff16, (int)((ew & 0xffffu) << 10), 0); buf[2 * k2 + 1] = __builtin_amdgcn_raw_buffer_load_b128((tbl), voff16, (int)((ew >> 16) << 10), 0); } } while (0)
    int hidv[TPW][2];
#pragma unroll
    for (int tt = 0; tt < TPW; ++tt) { hidv[tt][0] = 0; hidv[tt][1] = 0; }
    {
        u32x4 bufA[8], bufB[8];
#define P8_DOTS(buf, tok, bb) do { int p[8]; \
            _Pragma("unroll") for (int kk = 0; kk < 8; ++kk) { int s_ = __builtin_amdgcn_sdot4((int)buf[kk].x, (int)hq[tok][0], 0, false); s_ = __builtin_amdgcn_sdot4((int)buf[kk].y, (int)hq[tok][1], s_, false); \
                s_ = __builtin_amdgcn_sdot4((int)buf[kk].z, (int)hq[tok][2], s_, false); s_ = __builtin_amdgcn_sdot4((int)buf[kk].w, (int)hq[tok][3], s_, false); p[kk] = s_; } \
            int q4[4], q2[2], q1; \
            _Pragma("unroll") for (int i = 0; i < 4; ++i) { auto r_ = __builtin_amdgcn_permlane32_swap((unsigned)p[i], (unsigned)p[i + 4], false, false); q4[i] = (int)(r_[0] + r_[1]); } \
            _Pragma("unroll") for (int i = 0; i < 2; ++i) { auto r_ = __builtin_amdgcn_permlane16_swap((unsigned)q4[i], (unsigned)q4[i + 2], false, false); q2[i] = (int)(r_[0] + r_[1]); } \
            { const int keep = b3 ? q2[1] : q2[0], send = b3 ? q2[0] : q2[1]; q1 = keep + __builtin_amdgcn_update_dpp(0, send, 0x128, 0xF, 0xF, true); } \
            q1 += __builtin_amdgcn_update_dpp(0, q1, 0xB1, 0xF, 0xF, true); q1 += __builtin_amdgcn_update_dpp(0, q1, 0x4E, 0xF, 0xF, true); q1 += __builtin_amdgcn_update_dpp(0, q1, 0x141, 0xF, 0xF, true); \
            const int i2_ = (lane & 3) * 2; const int v0_ = __builtin_amdgcn_ds_bpermute(i2_ << 5, q1), v1_ = __builtin_amdgcn_ds_bpermute((i2_ + 1) << 5, q1); \
            if ((lane >> 2) == (bb)) { hidv[tok][0] = v0_; hidv[tok][1] = v1_; } } while (0)
        int cur[TPW];
#pragma unroll
        for (int tt = 0; tt < TPW; ++tt) cur[tt] = 0;
#define P8_STEP_A(tt_, bufX, bufY, r_) { const int end_ = __builtin_amdgcn_readlane(offv[tt_], (r_) + 1); \
            { constexpr int tn_ = ((tt_) + 1) % TPW; const int rn_ = (r_) + ((tt_) + 1) / TPW; \
              if (rn_ < NPART && cur[tn_] < __builtin_amdgcn_readlane(offv[tn_], rn_ + 1)) P8_ISSUE(bufY, ut, tn_, cur[tn_] >> 3); } \
            __builtin_amdgcn_sched_barrier(0); \
            bool pre_ = true; \
            while (cur[tt_] < end_) { if (!pre_) P8_ISSUE(bufX, ut, tt_, cur[tt_] >> 3); pre_ = false; P8_DOTS(bufX, tt_, cur[tt_] >> 3); cur[tt_] += 8; } }
        if ((skip & 1) == 0) {
        if (0 < __builtin_amdgcn_readlane(offv[0], 1)) P8_ISSUE(bufA, ut, 0, 0);
#pragma unroll 1
        for (int r = 0; r < NPART; ++r) {
            P8_STEP_A(0, bufA, bufB, r) P8_STEP_A(1, bufB, bufA, r) P8_STEP_A(2, bufA, bufB, r) P8_STEP_A(3, bufB, bufA, r)
            P8_STEP_A(4, bufA, bufB, r) P8_STEP_A(5, bufB, bufA, r) P8_STEP_A(6, bufA, bufB, r) P8_STEP_A(7, bufB, bufA, r)
        } }
#undef P8_STEP_A
#undef P8_DOTS
    }
    { float su0[TPW], su1[TPW], sv0[TPW], sv1[TPW];
#pragma unroll
      for (int tt = 0; tt < TPW; ++tt) { const unsigned e0 = es[tt] & 0xffffu, e1 = es[tt] >> 16; su0[tt] = su[e0]; su1[tt] = su[e1]; sv0[tt] = sv[e0]; sv1[tt] = sv[e1]; }
#pragma unroll
      for (int tt = 0; tt < TPW; ++tt) {
        gs[tt][0] = gelu_erf((float)hidv[tt][0] * (shs[tt] * su0[tt])) * gs[tt][0] * sv0[tt];
        gs[tt][1] = gelu_erf((float)hidv[tt][1] * (shs[tt] * su1[tt])) * gs[tt][1] * sv1[tt]; } }
    typedef _Float16 f16x2 __attribute__((ext_vector_type(2)));
    unsigned gsh[TPW];
#pragma unroll
    for (int tt = 0; tt < TPW; ++tt) gsh[tt] = __builtin_bit_cast(unsigned, (f16x2){(_Float16)gs[tt][0], (_Float16)gs[tt][1]});
    f16x2 yh[TPW][8];
#pragma unroll
    for (int tt = 0; tt < TPW; ++tt) {
#pragma unroll
        for (int i = 0; i < 8; ++i) yh[tt][i] = (f16x2){(_Float16)0.f, (_Float16)0.f}; }
    {
        u32x4 bufA[8], bufB[8];
#define P8_PICK(tok, a, wv) { const unsigned x0_ = (wv).x, x1_ = (wv).y, x2_ = (wv).z, x3_ = (wv).w;     \
            unsigned s0_ = x0_ << 8, s1_ = x1_ << 8, s2_ = x2_ << 8, s3_ = x3_ << 8; asm volatile("" : "+v"(s0_), "+v"(s1_), "+v"(s2_), "+v"(s3_)); \
            yh[tok][1] = __builtin_elementwise_fma(__builtin_bit_cast(f16x2, x0_), (a), yh[tok][1]); yh[tok][3] = __builtin_elementwise_fma(__builtin_bit_cast(f16x2, x1_), (a), yh[tok][3]); \
            yh[tok][5] = __builtin_elementwise_fma(__builtin_bit_cast(f16x2, x2_), (a), yh[tok][5]); yh[tok][7] = __builtin_elementwise_fma(__builtin_bit_cast(f16x2, x3_), (a), yh[tok][7]); \
            yh[tok][0] = __builtin_elementwise_fma(__builtin_bit_cast(f16x2, s0_), (a), yh[tok][0]); yh[tok][2] = __builtin_elementwise_fma(__builtin_bit_cast(f16x2, s1_), (a), yh[tok][2]); \
            yh[tok][4] = __builtin_elementwise_fma(__builtin_bit_cast(f16x2, s2_), (a), yh[tok][4]); yh[tok][6] = __builtin_elementwise_fma(__builtin_bit_cast(f16x2, s3_), (a), yh[tok][6]); }
#define P8_ACC(buf, tok, bb) do { _Pragma("unroll") for (int k2 = 0; k2 < 4; ++k2) { \
            const f16x2 hh_ = __builtin_bit_cast(f16x2, __builtin_amdgcn_readlane((int)gsh[tok], 4 * (bb) + k2)); \
            const f16x2 a0_ = (f16x2){hh_.x, hh_.x}, a1_ = (f16x2){hh_.y, hh_.y}; \
            { const u32x4 w0_ = buf[2 * k2]; P8_PICK(tok, a0_, w0_) } \
            { const u32x4 w1_ = buf[2 * k2 + 1]; P8_PICK(tok, a1_, w1_) } __builtin_amdgcn_sched_barrier(0); } } while (0)
        int cur[TPW];
#pragma unroll
        for (int tt = 0; tt < TPW; ++tt) cur[tt] = 0;
#define P8_STEP_B(tt_, bufX, bufY, r_) { const int end_ = __builtin_amdgcn_readlane(offv[tt_], (r_) + 1); \
            { constexpr int tn_ = ((tt_) + 1) % TPW; const int rn_ = (r_) + ((tt_) + 1) / TPW; \
              if (rn_ < NPART && cur[tn_] < __builtin_amdgcn_readlane(offv[tn_], rn_ + 1)) P8_ISSUE(bufY, vt, tn_, cur[tn_] >> 3); } \
            __builtin_amdgcn_sched_barrier(0); \
            bool pre_ = true; \
            while (cur[tt_] < end_) { if (!pre_) P8_ISSUE(bufX, vt, tt_, cur[tt_] >> 3); pre_ = false; P8_ACC(bufX, tt_, cur[tt_] >> 3); cur[tt_] += 8; } }
        if ((skip & 2) == 0) {
        if (0 < __builtin_amdgcn_readlane(offv[0], 1)) P8_ISSUE(bufA, vt, 0, 0);
#pragma unroll 1
        for (int r = 0; r < NPART; ++r) {
            P8_STEP_B(0, bufA, bufB, r) P8_STEP_B(1, bufB, bufA, r) P8_STEP_B(2, bufA, bufB, r) P8_STEP_B(3, bufB, bufA, r)
            P8_STEP_B(4, bufA, bufB, r) P8_STEP_B(5, bufB, bufA, r) P8_STEP_B(6, bufA, bufB, r) P8_STEP_B(7, bufB, bufA, r)
        } }
#undef P8_STEP_B
#undef P8_ACC
#undef P8_PICK
    }
#undef P8_ISSUE
#undef ut
#undef vt
    u32x2 xw[TPW][4]; f32x4 g2v[4], lgv[4], lbv[4];
#pragma unroll
    for (int tt = 0; tt < TPW; ++tt)
#pragma unroll
        for (int j = 0; j < 4; ++j) xw[tt][j] = *(const u32x2*)(x1 + (size_t)(t0 + tt) * DM + 256 * j + 4 * lane);
#pragma unroll
    for (int j = 0; j < 4; ++j) { const int d = 256 * j + 4 * lane; g2v[j] = *(const f32x4*)(mod + b * 6144 + 5120 + d) + 1.0f; lgv[j] = *(const f32x4*)(F.ln2_g + d); lbv[j] = *(const f32x4*)(F.ln2_b + d); }
#pragma unroll
    for (int tt = 0; tt < TPW; ++tt) { const size_t t = (size_t)(t0 + tt);
        f32x4 v[4]; float s = 0.f;
#pragma unroll
        for (int j = 0; j < 4; ++j) { const u32x2 xv = xw[tt][j];
            const f32x4 xf = (f32x4){bf_lo(xv.x), bf_hi(xv.x), bf_lo(xv.y), bf_hi(xv.y)}; const f32x4 yy = (f32x4){(float)yh[tt][2 * j].x, (float)yh[tt][2 * j + 1].x, (float)yh[tt][2 * j].y, (float)yh[tt][2 * j + 1].y};
            v[j] = xf * DN_ALPHA + g2v[j] * yy; s += (v[j][0] + v[j][1]) + (v[j][2] + v[j][3]); }
        const float mean = wave_sum(s) * (1.f / DM); float qq = 0.f;
#pragma unroll
        for (int j = 0; j < 4; ++j) { v[j] = v[j] - mean; qq += (v[j][0] * v[j][0] + v[j][1] * v[j][1]) + (v[j][2] * v[j][2] + v[j][3] * v[j][3]); }
        const float rstd = 1.0f / sqrtf(wave_sum(qq) * (1.f / DM) + LN_EPS);
#pragma unroll
        for (int j = 0; j < 4; ++j) { const int d = 256 * j + 4 * lane;
            *(f32x4*)(F.out + t * DM + d) = v[j] * rstd * lgv[j] + lbv[j]; } }
    }
}
#ifndef PROBE_PARTS
#define PROBE_PARTS 0xff
#endif
#ifndef MK_N_LAUNCHES
#define MK_N_LAUNCHES 1
#endif
constexpr int N_PHASES = 9;
struct Args { const float* in[18]; float* out; unsigned char* ws; int ph_lo, ph_hi, p0_parts, pad; };
__global__ void __launch_bounds__(NTHREADS, 2) fwd_kernel(Args args) {
    extern __shared__ __attribute__((aligned(16))) unsigned char lds[];
    Frame F;
    F.lds = (LAS unsigned char*)lds;
    F.tid = threadIdx.x; F.lane = F.tid & 63; F.wave = __builtin_amdgcn_readfirstlane(F.tid >> 6);
    F.G = gridDim.x; { const int bx = blockIdx.x; F.vcu = (F.G % 8 == 0) ? (bx % 8) * (F.G / 8) + bx / 8 : bx; }
    F.x = args.in[0]; F.c = args.in[1]; F.w_ada = args.in[2]; F.b_ada = args.in[3]; F.w_in = args.in[4]; F.sinks = args.in[5]; F.w_pool = args.in[6]; F.pool_scale = args.in[7];
    F.w_out = args.in[8]; F.ln1_g = args.in[9]; F.ln1_b = args.in[10]; F.w_pq = args.in[11]; F.k1 = args.in[12]; F.k2 = args.in[13]; F.pu = args.in[14]; F.pv = args.in[15];
    F.ln2_g = args.in[16]; F.ln2_b = args.in[17]; F.out = args.out; F.ws = args.ws;
    volatile LAS unsigned* MISC = (volatile LAS unsigned*)(F.lds + MISC_OFF);
    for (int u = F.tid; u < (LDS_BYTES - LDSCTL_OFF) / 4; u += NTHREADS) ((LAS unsigned*)(F.lds + LDSCTL_OFF))[u] = 0u;
    __syncthreads();
    const int lo = args.ph_lo, hi = args.ph_hi;
    XcdBarrier bar; bar.bar = (unsigned*)(F.ws + WS_CTL) + CW_BAR; bar.x = 0; bar.st = nullptr;
    if (hi - lo > 1) bar = xcd_barrier_post((unsigned*)(F.ws + WS_CTL) + CW_BAR, MISC + 8);
#ifndef PH_MASK
#define PH_MASK 0x1ff
#endif
#define IN(k) (((PH_MASK >> (k)) & 1) && lo <= (k) && (k) < hi)
#define SEAM(k) do { if (IN(k) && IN((k) + 1)) xcd_barrier(bar); } while (0)
#ifndef REP_MASK
#define REP_MASK 0
#endif
#ifndef REP_CNT
#define REP_CNT 4
#endif
#define REPS(k) (((REP_MASK >> (k)) & 1) * REP_CNT)
#define PHASE_NS(k, ...) if (IN(k)) { _Pragma("unroll 1") for (int _r = 0; _r <= REPS(k); ++_r) { __VA_ARGS__; if (_r < REPS(k)) xcd_barrier(bar); } }
#define PHASE(k, ...) if (IN(k)) { _Pragma("unroll 1") for (int _r = 0; _r <= REPS(k); ++_r) { __VA_ARGS__; if (_r < REPS(k)) xcd_barrier(bar); } } SEAM(k)
#ifndef P0_SUB
#define P0_SUB 0xff
#endif
    PHASE(0, p0_prologue(F, args.p0_parts));
    PHASE(2, { pg8::Gemm g{(const pg8::bf16_t*)(F.ws + WS_XN8), (const pg8::bf16_t*)(F.ws + WS_WIN), TT, NIN, DM / 2, 32, (size_t)NIN * DM, 0x79797979, 0x7F7F7F7F};    pg8::StaticOrder S; S.init(TT, NIN, F.G, (int)blockIdx.x);
            pg8::EpiRope E{(pg8::bf16_t*)(F.ws + WS_PROJ), NIN, (const float*)(F.ws + WS_ROPE), QSCALE, (const float*)(F.ws + WS_BIAS)};
            pg8::gemm_phase<pg8::EpiRope, pg8::StaticOrder, true, true, true>(F.lds, g, S, E);
            if ((args.p0_parts & 0x80) && (int)blockIdx.x >= 320 - F.G) p2_tables(F, ((int)blockIdx.x - (320 - F.G)) * NWAVES + F.wave, (2 * F.G - 320) * NWAVES, 0, 2 * NEXP); });
    PHASE(3, { for (int u = F.vcu; u < 256; u += F.G) { PoolRegs pr; KvRegs kv; p3_pool_load(F, u, pr); p3_attn_kvload(F, u, kv); p3_pool_compute(F, u, pr); p3_attn_unit(F, u, kv); } });
    PHASE(4, { pg8::Gemm g{(const pg8::bf16_t*)(F.ws + WS_A2), (const pg8::bf16_t*)(F.ws + WS_WOUT), TT, DM, DM / 2, 1 << 30, 0, 0x79797979, 0x7B7B7B7B}; pg8::StaticOrder S; S.init(TT, DM, F.G, (int)blockIdx.x);
            pg8::EpiPlain E{(pg8::bf16_t*)(F.ws + WS_MIX), DM};
            pg8::gemm_phase<pg8::EpiPlain, pg8::StaticOrder, true, true, true>(F.lds, g, S, E); });
    PHASE(5, p5_ln1(F));
    PHASE_NS(6, { pg8::Gemm g{(const pg8::bf16_t*)(F.ws + WS_H2), (const pg8::bf16_t*)(F.ws + WS_WPQ), TT, NQD, DM, 1 << 30, 0, 0, 0}; pg8::StaticOrder S; S.init(TT, NQD, F.G, (int)blockIdx.x);
            pg8::EpiPlain E{(pg8::bf16_t*)(F.ws + WS_Q), NQD};
            pg8::gemm_phase<pg8::EpiPlain, pg8::StaticOrder, true, true>(F.lds, g, S, E); });
    if (IN(6) && IN(7)) { asm volatile("s_waitcnt vmcnt(0)" ::: "memory"); __syncthreads(); }
    PHASE(7, p7_route(F));
#ifndef P8_FAKE
#define P8_FAKE 0xffffu
#endif
#ifndef P8_SKIP
#define P8_SKIP 0
#endif
    PHASE(8, p8_peer(F, _r == REPS(8) ? 0xffffu : P8_FAKE, _r == REPS(8) ? 0 : P8_SKIP));
#undef IN
#undef SEAM
}

extern "C" void kernel_launch(void* const* d_in, const int* in_sizes, int n_in, void* d_out, int out_size, void* d_ws, size_t ws_size, hipStream_t stream) {
    static int grid = 0;
    if (grid == 0) {
        if (n_in != 18 || out_size != TT * DM || ws_size < WS_END) { fprintf(stderr, "kernel_launch: unexpected shapes (n_in %d out %d ws %zu)\n", n_in, out_size, ws_size); grid = -1; return; }
        int dev = 0, cus = 0, per_cu = 0;
        if (hipGetDevice(&dev) != hipSuccess || hipDeviceGetAttribute(&cus, hipDeviceAttributeMultiprocessorCount, dev) != hipSuccess) { grid = -1; return; }
        if (hipFuncSetAttribute((const void*)fwd_kernel, hipFuncAttributeMaxDynamicSharedMemorySize, LDS_BYTES) != hipSuccess) { fprintf(stderr, "kernel_launch: hipFuncSetAttribute failed\n"); grid = -1; return; }
        if (hipOccupancyMaxActiveBlocksPerMultiprocessor(&per_cu, (const void*)fwd_kernel, NTHREADS, LDS_BYTES) != hipSuccess || per_cu < 1) { fprintf(stderr, "kernel_launch: occupancy query says %d blocks per CU\n", per_cu); }
        (void)hipGetLastError();
        grid = cus;
        if (grid != 256) fprintf(stderr, "kernel_launch: built for 256 CUs, got %d\n", grid);
    }
    if (grid < 0) return;
    (void)hipMemsetAsync((char*)d_ws + WS_CTL, 0, CTL_ZERO_BYTES, stream);
    Args a{};
    for (int i = 0; i < 18; ++i) a.in[i] = (const float*)d_in[i];
    a.out = (float*)d_out; a.ws = (unsigned char*)d_ws; a.p0_parts = 0xff;
#if MK_N_LAUNCHES == 1
    a.ph_lo = 0; a.ph_hi = N_PHASES;
    hipLaunchKernelGGL(fwd_kernel, dim3(grid), dim3(NTHREADS), LDS_BYTES, stream, a);
#ifdef PROBE_PHASE
    for (int i = 0; i < PROBE_N; ++i) { a.ph_lo = PROBE_PHASE; a.ph_hi = PROBE_PHASE + 1; a.p0_parts = PROBE_PARTS; hipLaunchKernelGGL(fwd_kernel, dim3(grid), dim3(NTHREADS), LDS_BYTES, stream, a); }
#endif
#else
    for (int p = 0; p < N_PHASES; ++p) { a.ph_lo = p; a.ph_hi = p + 1; hipLaunchKernelGGL(fwd_kernel, dim3(grid), dim3(NTHREADS), LDS_BYTES, stream, a); }
#endif
}
```

```cpp
#include <hip/hip_runtime.h>
#include <cstdio>
#include <cstdint>
#include <cmath>
namespace pg8 {
#define PG8_LAS __attribute__((address_space(3)))
typedef unsigned short bf16_t;
typedef short bf16x8 __attribute__((ext_vector_type(8)));
typedef float f32x4 __attribute__((ext_vector_type(4)));
typedef unsigned u32x4 __attribute__((ext_vector_type(4)));
constexpr int BM = 256, BK = 64, HALF = 128, HTB = HALF * BK * 2  , STAGE_BYTES = 8 * HTB, NXCD = 8, WGM = 8;

__host__ __device__ __forceinline__ int lds_byte(int r, int c) { const int st = (r >> 4) * 2 + (c >> 5), rr = r & 15, cc = c & 31, ob = rr * 64 + cc * 2; return st * 1024 + (ob ^ (((ob >> 9) & 1) << 5)); }
__host__ __device__ __forceinline__ void stage_rc(int b, int& R, int& C) { const int st = b / 1024, sb = b % 1024, swz = sb ^ (((sb >> 9) & 1) << 5); R = (st >> 1) * 16 + swz / 64; C = (st & 1) * 32 + (swz % 64) / 2; }
__host__ __device__ __forceinline__ int perm32(int rho) { const int n = rho >> 4, i = rho & 15; return 8 * (i >> 2) + 4 * n + (i & 3); }

struct Unit { int pm, pn; };
struct Gemm { const bf16_t* A; const bf16_t* Bt; int M, N, K; int bsplit; size_t bstride; int sc_w, sc_x; };

struct StaticOrder {
    int nM, nN, nwg, G, c;
    __host__ __device__ void init(int M, int N, int G_, int c_) { nM = M / BM; nN = N / BM; nwg = nM * nN; G = G_; c = c_; }
    __host__ __device__ bool next(int i, Unit& u) const {
        const long L = (long)i * G + c; if (L >= nwg) return false;
        int wgid = (int)L; { const int q = nwg / NXCD, r = nwg % NXCD, xcd = wgid % NXCD, off = wgid / NXCD; wgid = (xcd < r ? xcd * (q + 1) : r * (q + 1) + (xcd - r) * q) + off; }
        const int nig = WGM * nN, gid = wgid / nig, fm = gid * WGM, gsz = (nM - fm) < WGM ? (nM - fm) : WGM;
        u.pm = fm + ((wgid % nig) % gsz); u.pn = (wgid % nig) / gsz; return true;
    }
    __device__ __forceinline__ void a_ready(const Unit&) const {}
    __device__ __forceinline__ void done(const Unit&) const {}
};

__device__ __forceinline__ unsigned cvt_pk_bf16(float lo, float hi) { unsigned r; asm volatile("v_cvt_pk_bf16_f32 %0, %1, %2" : "=v"(r) : "v"(lo), "v"(hi)); return r; }

struct EpiPlain {
    static constexpr bool PERM = true, AFTER_DRAIN = false;
    bf16_t* O; int ldc;
    __device__ __forceinline__ void operator()(const f32x4 (&acc)[2][2][4][2], const Unit& u, int wr, int wc, int fr, int fq) const {
        const int row0 = u.pm * BM + wr * 64 + fr; const int col0 = u.pn * BM + wc * 32 + 8 * fq;
#pragma unroll
        for (int ai = 0; ai < 2; ++ai)
#pragma unroll
            for (int m = 0; m < 4; ++m) { bf16_t* rowp = O + (size_t)(row0 + ai * HALF + m * 16) * ldc + col0;
#pragma unroll
                for (int bj = 0; bj < 2; ++bj) { const f32x4 v0 = acc[ai][bj][m][0], v1 = acc[ai][bj][m][1];
                    u32x4 w; w.x = cvt_pk_bf16(v0[0], v0[1]); w.y = cvt_pk_bf16(v0[2], v0[3]); w.z = cvt_pk_bf16(v1[0], v1[1]); w.w = cvt_pk_bf16(v1[2], v1[3]);
                    *(u32x4*)(rowp + bj * HALF) = w; } }
    }
};
struct EpiRope {
    static constexpr bool PERM = true, AFTER_DRAIN = false;
    bf16_t* O; int ldc; const float* rope; float qscale; const float* bias;
    __device__ __forceinline__ void operator()(const f32x4 (&acc)[2][2][4][2], const Unit& u, int wr, int wc, int fr, int fq) const {
        const int row0 = u.pm * BM + wr * 64 + fr; const int col0 = u.pn * BM + wc * 32 + 8 * fq;
#pragma unroll
        for (int ai = 0; ai < 2; ++ai)
#pragma unroll
            for (int m = 0; m < 4; ++m) { const int row = row0 + ai * HALF + m * 16; bf16_t* rowp = O + (size_t)row * ldc + col0; const int pos = row & 8191;
#pragma unroll
                for (int bj = 0; bj < 2; ++bj) { const float* bp = bias + (size_t)(row >> 13) * ldc + col0 + bj * HALF;
                    f32x4 v0 = acc[ai][bj][m][0] + *(const f32x4*)bp, v1 = acc[ai][bj][m][1] + *(const f32x4*)(bp + 4);
                    const int colt = u.pn * BM + bj * HALF;
                    if (colt < 640) {
                        const int c = col0 + bj * HALF, ib = (c & 63) >> 1;
                        const f32x4 cs0 = *(const f32x4*)(rope + ((size_t)pos * 32 + ib) * 2), cs1 = *(const f32x4*)(rope + ((size_t)pos * 32 + ib) * 2 + 4);
                        const float sc = colt < 512 ? qscale : 1.0f;
                        f32x4 r0, r1;
                        r0[0] = (v0[0] * cs0[0] - v0[1] * cs0[1]) * sc; r0[1] = (v0[1] * cs0[0] + v0[0] * cs0[1]) * sc;
                        r0[2] = (v0[2] * cs0[2] - v0[3] * cs0[3]) * sc; r0[3] = (v0[3] * cs0[2] + v0[2] * cs0[3]) * sc;
                        r1[0] = (v1[0] * cs1[0] - v1[1] * cs1[1]) * sc; r1[1] = (v1[1] * cs1[0] + v1[0] * cs1[1]) * sc;
                        r1[2] = (v1[2] * cs1[2] - v1[3] * cs1[3]) * sc; r1[3] = (v1[3] * cs1[2] + v1[2] * cs1[3]) * sc;
                        v0 = r0; v1 = r1;
                    }
                    u32x4 w; w.x = cvt_pk_bf16(v0[0], v0[1]); w.y = cvt_pk_bf16(v0[2], v0[3]); w.z = cvt_pk_bf16(v1[0], v1[1]); w.w = cvt_pk_bf16(v1[2], v1[3]);
                    *(u32x4*)(rowp + bj * HALF) = w; } }
    }
};

struct EpiQ8 {
    static constexpr bool PERM = true, AFTER_DRAIN = false;
    bf16_t* O; int ldc; const float* rs; const float* cs;
    __device__ __forceinline__ void operator()(const f32x4 (&acc)[2][2][4][2], const Unit& u, int wr, int wc, int fr, int fq) const {
        typedef int i32x4_ __attribute__((ext_vector_type(4)));
        const int row0 = u.pm * BM + wr * 64 + fr; const int col0 = u.pn * BM + wc * 32 + 8 * fq;
        f32x4 cv[2][2];
#pragma unroll
        for (int bj = 0; bj < 2; ++bj) { cv[bj][0] = *(const f32x4*)(cs + col0 + bj * HALF); cv[bj][1] = *(const f32x4*)(cs + col0 + bj * HALF + 4); }
#pragma unroll
        for (int ai = 0; ai < 2; ++ai)
#pragma unroll
            for (int m = 0; m < 4; ++m) { const int row = row0 + ai * HALF + m * 16; bf16_t* rowp = O + (size_t)row * ldc + col0; const float rsc = rs[row];
#pragma unroll
                for (int bj = 0; bj < 2; ++bj) { const i32x4_ i0 = __builtin_bit_cast(i32x4_, acc[ai][bj][m][0]), i1 = __builtin_bit_cast(i32x4_, acc[ai][bj][m][1]);
                    const f32x4 v0 = __builtin_convertvector(i0, f32x4) * rsc * cv[bj][0], v1 = __builtin_convertvector(i1, f32x4) * rsc * cv[bj][1];
                    u32x4 w; w.x = cvt_pk_bf16(v0[0], v0[1]); w.y = cvt_pk_bf16(v0[2], v0[3]); w.z = cvt_pk_bf16(v1[0], v1[1]); w.w = cvt_pk_bf16(v1[2], v1[3]);
                    *(u32x4*)(rowp + bj * HALF) = w; } }
    }
};

template <class Epi, class Sched, bool ALIGN_EPI = false, bool SP2 = false, int MODE = 0>
__device__ __forceinline__ void gemm_phase(PG8_LAS unsigned char* lds, const Gemm g, const Sched& S, const Epi& E) {
    typedef int pg8_i32x4 __attribute__((ext_vector_type(4))); typedef int pg8_frag __attribute__((ext_vector_type(8)));
    const int tid = threadIdx.x, wid = __builtin_amdgcn_readfirstlane(tid >> 6), lane = tid & 63, wr = wid >> 2, wc = wid & 3, fr = lane & 15, fq = lane >> 4;
    const int K = g.K, nt = K / BK;
    unsigned voffA[2], voffB[2];
#pragma unroll
    for (int i = 0; i < 2; ++i) { int R, C; stage_rc(tid * 16 + i * 8192, R, C); const int Rb = Epi::PERM ? ((R & ~31) + perm32(R & 31)) : R;
        voffA[i] = (unsigned)(R * K + C) * 2u; voffB[i] = (unsigned)(Rb * K + C) * 2u; }
    const size_t kstep = (size_t)(BK * 2);
    const size_t hstep = (size_t)HALF * K * 2;
    const size_t tstep = 2 * hstep;
    const unsigned ldsw = (unsigned)wid * 1024u;
    const int aoff = lds_byte(wr * 64 + fr, fq * 8), boff = lds_byte(wc * 32 + fr, fq * 8);
#define PG8_SA(b, h) (((b) * 2 + (h)) * HTB)
#define PG8_SB(b, h) ((4 + (b) * 2 + (h)) * HTB)
#define PG8_STAGE(bufoff, gbase, voff) do { _Pragma("unroll") for (int _i = 0; _i < 2; ++_i) \
        __builtin_amdgcn_global_load_lds((const unsigned*)((const char*)(gbase) + (voff)[_i]), (PG8_LAS unsigned*)(lds + (bufoff) + ldsw + _i * 8192), 16, 0, 0); } while (0)
#define PG8_LDA(dst, b, h) do { _Pragma("unroll") for (int m = 0; m < 4; ++m) { const pg8_i32x4 l0_ = *(const PG8_LAS pg8_i32x4*)(lds + PG8_SA(b, h) + aoff + m * 2048), l1_ = *(const PG8_LAS pg8_i32x4*)(lds + PG8_SA(b, h) + aoff + m * 2048 + 1024); dst[m] = __builtin_shufflevector(l0_, l1_, 0, 1, 2, 3, 4, 5, 6, 7); } } while (0)
#define PG8_LDB(dst, b, h) do { _Pragma("unroll") for (int n = 0; n < 2; ++n) { const pg8_i32x4 l0_ = *(const PG8_LAS pg8_i32x4*)(lds + PG8_SB(b, h) + boff + n * 2048), l1_ = *(const PG8_LAS pg8_i32x4*)(lds + PG8_SB(b, h) + boff + n * 2048 + 1024); dst[n] = __builtin_shufflevector(l0_, l1_, 0, 1, 2, 3, 4, 5, 6, 7); } } while (0)
#define PG8_H0(f) __builtin_bit_cast(bf16x8, __builtin_shufflevector((f), (f), 0, 1, 2, 3))
#define PG8_H1(f) __builtin_bit_cast(bf16x8, __builtin_shufflevector((f), (f), 4, 5, 6, 7))
#define PG8_MMA(ai, bj, At, Bt) do { __builtin_amdgcn_s_setprio(1); \
        if constexpr (MODE == 2) { _Pragma("unroll") for (int m = 0; m < 4; ++m) _Pragma("unroll") for (int n = 0; n < 2; ++n) { \
            pg8_i32x4 c_ = __builtin_bit_cast(pg8_i32x4, acc[ai][bj][m][n]); \
            c_ = __builtin_amdgcn_mfma_i32_16x16x64_i8(__builtin_bit_cast(pg8_i32x4, PG8_H0(Bt[n])), __builtin_bit_cast(pg8_i32x4, PG8_H0(At[m])), c_, 0, 0, 0); \
            c_ = __builtin_amdgcn_mfma_i32_16x16x64_i8(__builtin_bit_cast(pg8_i32x4, PG8_H1(Bt[n])), __builtin_bit_cast(pg8_i32x4, PG8_H1(At[m])), c_, 0, 0, 0); \
            acc[ai][bj][m][n] = __builtin_bit_cast(f32x4, c_); } } \
        else if constexpr (MODE == 1) { _Pragma("unroll") for (int m = 0; m < 4; ++m) _Pragma("unroll") for (int n = 0; n < 2; ++n) \
            asm volatile("v_mfma_scale_f32_16x16x128_f8f6f4 %0, %1, %2, %0, %3, %4 op_sel_hi:[0,0,0]" : "+v"(acc[ai][bj][m][n]) : "v"(Bt[n]), "v"(At[m]), "v"(scw_), "v"(scx_)); } \
        else { _Pragma("unroll") for (int m = 0; m < 4; ++m) _Pragma("unroll") for (int n = 0; n < 2; ++n) { \
            acc[ai][bj][m][n] = __builtin_amdgcn_mfma_f32_16x16x32_bf16(PG8_H0(Bt[n]), PG8_H0(At[m]), acc[ai][bj][m][n], 0, 0, 0); \
            acc[ai][bj][m][n] = __builtin_amdgcn_mfma_f32_16x16x32_bf16(PG8_H1(Bt[n]), PG8_H1(At[m]), acc[ai][bj][m][n], 0, 0, 0); } } \
        __builtin_amdgcn_s_setprio(0); } while (0)
#define PG8_WAIT_V(n) asm volatile("s_waitcnt vmcnt(" #n ")" ::: "memory")
#define PG8_WAIT_L(n) asm volatile("s_waitcnt lgkmcnt(" #n ")" ::: "memory")
#define PG8_BAR __builtin_amdgcn_s_barrier()
#define PG8_SCHED __builtin_amdgcn_sched_barrier(0)
    Unit cur, nxt; int ui = 0;
    if (!S.next(0, cur)) return;
    f32x4 acc[2][2][4][2];
#pragma unroll
    for (int a = 0; a < 2; ++a)
#pragma unroll
        for (int b = 0; b < 2; ++b)
#pragma unroll
            for (int m = 0; m < 4; ++m)
#pragma unroll
                for (int n = 0; n < 2; ++n) acc[a][b][m][n] = (f32x4){0.f, 0.f, 0.f, 0.f};
    pg8_frag At[4], B0[2], B1[2]; const int scw_ = g.sc_w, scx_ = g.sc_x;
    const char* cA = (const char*)g.A + (size_t)cur.pm * tstep; const char* cB = (const char*)g.Bt + (size_t)cur.pn * tstep + (cur.pm >= g.bsplit ? g.bstride : (size_t)0);
    S.a_ready(cur);
    if constexpr (SP2) {
        PG8_STAGE(PG8_SB(0, 0), cB, voffB); PG8_STAGE(PG8_SB(0, 1), cB + hstep, voffB); PG8_STAGE(PG8_SA(0, 0), cA, voffA); PG8_STAGE(PG8_SA(0, 1), cA + hstep, voffA);
        if (wr == 1) PG8_BAR;
        PG8_WAIT_V(2); PG8_BAR;
        PG8_STAGE(PG8_SB(1, 0), cB + kstep, voffB); PG8_STAGE(PG8_SA(1, 0), cA + kstep, voffA); PG8_STAGE(PG8_SB(1, 1), cB + hstep + kstep, voffB);
        PG8_WAIT_V(6); PG8_BAR;
    } else {
        PG8_STAGE(PG8_SB(0, 0), cB, voffB); PG8_STAGE(PG8_SA(0, 0), cA, voffA); PG8_STAGE(PG8_SB(0, 1), cB + hstep, voffB); PG8_STAGE(PG8_SA(0, 1), cA + hstep, voffA);
        if (wr == 1) PG8_BAR;
        PG8_WAIT_V(4); PG8_BAR;
        PG8_STAGE(PG8_SB(1, 0), cB + kstep, voffB); PG8_STAGE(PG8_SA(1, 0), cA + kstep, voffA); PG8_STAGE(PG8_SB(1, 1), cB + hstep + kstep, voffB);
        PG8_WAIT_V(6); PG8_BAR;
    }
    for (;;) {
        const bool has_next = S.next(ui + 1, nxt);
        const char* nA = has_next ? (const char*)g.A + (size_t)nxt.pm * tstep : cA; const char* nB = has_next ? (const char*)g.Bt + (size_t)nxt.pn * tstep + (nxt.pm >= g.bsplit ? g.bstride : (size_t)0) : cB;
        _Pragma("unroll 1") for (int t = 0; t < nt; t += 2) {
            const bool last = (t == nt - 2);
            const char* a1 = cA + (size_t)(t + 1) * kstep;
            const char* a2 = last ? nA : cA + (size_t)(t + 2) * kstep; const char* b2 = last ? nB : cB + (size_t)(t + 2) * kstep;
            const char* a3 = a2 + kstep; const char* b3 = b2 + kstep;
            if (last && has_next) S.a_ready(nxt);
            if constexpr (SP2) {
            PG8_LDB(B0, 0, 0); PG8_LDB(B1, 0, 1); PG8_SCHED; PG8_LDA(At, 0, 0); PG8_STAGE(PG8_SA(1, 1), a1 + hstep, voffA);
            PG8_WAIT_V(8); PG8_WAIT_L(0); PG8_BAR; PG8_MMA(0, 0, At, B0); PG8_MMA(0, 1, At, B1); PG8_BAR; PG8_SCHED;
            PG8_LDA(At, 0, 1); PG8_STAGE(PG8_SB(0, 0), b2, voffB); PG8_STAGE(PG8_SB(0, 1), b2 + hstep, voffB); PG8_STAGE(PG8_SA(0, 0), a2, voffA);
            PG8_WAIT_V(8); PG8_WAIT_L(0); PG8_BAR; PG8_MMA(1, 0, At, B0); PG8_MMA(1, 1, At, B1); PG8_BAR; PG8_SCHED;
            PG8_LDB(B0, 1, 0); PG8_LDB(B1, 1, 1); PG8_SCHED; PG8_LDA(At, 1, 0); PG8_STAGE(PG8_SA(0, 1), a2 + hstep, voffA);
            PG8_WAIT_V(8); PG8_WAIT_L(0); PG8_BAR; PG8_MMA(0, 0, At, B0); PG8_MMA(0, 1, At, B1); PG8_BAR; PG8_SCHED;
            PG8_LDA(At, 1, 1); PG8_STAGE(PG8_SB(1, 0), b3, voffB); PG8_STAGE(PG8_SB(1, 1), b3 + hstep, voffB); PG8_STAGE(PG8_SA(1, 0), a3, voffA);
            PG8_WAIT_V(8); PG8_WAIT_L(0); PG8_BAR; PG8_MMA(1, 0, At, B0); PG8_MMA(1, 1, At, B1); PG8_BAR; PG8_SCHED;
            } else {
            PG8_LDB(B0, 0, 0); PG8_SCHED; PG8_LDA(At, 0, 0); PG8_STAGE(PG8_SA(1, 1), a1 + hstep, voffA);
            PG8_WAIT_L(8); PG8_BAR; PG8_WAIT_L(0); PG8_MMA(0, 0, At, B0); PG8_BAR; PG8_SCHED;
            PG8_LDB(B1, 0, 1); PG8_STAGE(PG8_SB(0, 0), b2, voffB);
            PG8_BAR; PG8_WAIT_L(0); PG8_MMA(0, 1, At, B1); PG8_BAR;
            PG8_LDA(At, 0, 1); PG8_STAGE(PG8_SA(0, 0), a2, voffA);
            PG8_BAR; PG8_WAIT_L(0); PG8_MMA(1, 0, At, B0); PG8_BAR; PG8_SCHED;
            PG8_STAGE(PG8_SB(0, 1), b2 + hstep, voffB);
            PG8_WAIT_V(6); PG8_BAR; PG8_MMA(1, 1, At, B1); PG8_BAR;
            PG8_LDB(B0, 1, 0); PG8_SCHED; PG8_LDA(At, 1, 0); PG8_STAGE(PG8_SA(0, 1), a2 + hstep, voffA);
            PG8_WAIT_L(8); PG8_BAR; PG8_WAIT_L(0); PG8_MMA(0, 0, At, B0); PG8_BAR; PG8_SCHED;
            PG8_LDB(B1, 1, 1); PG8_STAGE(PG8_SB(1, 0), b3, voffB);
            PG8_BAR; PG8_WAIT_L(0); PG8_MMA(0, 1, At, B1); PG8_BAR;
            PG8_LDA(At, 1, 1); PG8_STAGE(PG8_SA(1, 0), a3, voffA);
            PG8_BAR; PG8_WAIT_L(0); PG8_MMA(1, 0, At, B0); PG8_BAR; PG8_SCHED;
            PG8_STAGE(PG8_SB(1, 1), b3 + hstep, voffB);
            PG8_WAIT_V(6); PG8_BAR; PG8_MMA(1, 1, At, B1); PG8_BAR;
            }
        }
        if constexpr (ALIGN_EPI) { if (wr == 0) PG8_BAR; }
        if constexpr (MODE == 1) {
            asm volatile("s_nop 15\n\ts_nop 15" ::: "memory");
#pragma unroll
            for (int a = 0; a < 2; ++a)
#pragma unroll
                for (int b = 0; b < 2; ++b)
#pragma unroll
                    for (int m = 0; m < 4; ++m)
#pragma unroll
                        for (int n = 0; n < 2; ++n) asm volatile("" : "+v"(acc[a][b][m][n]));
        }
        if constexpr (!Epi::AFTER_DRAIN) { E(acc, cur, wr, wc, fr, fq); S.done(cur); }
        if (!has_next) break;
#pragma unroll
        for (int a = 0; a < 2; ++a)
#pragma unroll
            for (int b = 0; b < 2; ++b)
#pragma unroll
                for (int m = 0; m < 4; ++m)
#pragma unroll
                    for (int n = 0; n < 2; ++n) acc[a][b][m][n] = (f32x4){0.f, 0.f, 0.f, 0.f};
        cur = nxt; cA = nA; cB = nB; ++ui;
        if constexpr (ALIGN_EPI) { if (wr == 1) PG8_BAR; }
    }
    PG8_WAIT_V(0);
    if constexpr (!ALIGN_EPI) { if (wr == 0) PG8_BAR; }
    PG8_BAR;
    if constexpr (Epi::AFTER_DRAIN) { E.fused(acc, cur, wr, wc, fr, fq, lds, wid, lane); S.done(cur); }
#undef PG8_SA
#undef PG8_SB
#undef PG8_STAGE
#undef PG8_LDA
#undef PG8_LDB
#undef PG8_MMA
#undef PG8_H0
#undef PG8_H1
#undef PG8_WAIT_V
#undef PG8_WAIT_L
#undef PG8_BAR
#undef PG8_SCHED
}
}
#define GAS __attribute__((address_space(1)))
#define LAS __attribute__((address_space(3)))
typedef unsigned short bf16;
typedef unsigned v4u __attribute__((ext_vector_type(4)));
typedef float f32x4 __attribute__((ext_vector_type(4)));
typedef short bf16x8 __attribute__((ext_vector_type(8)));
typedef GAS unsigned gu32;
typedef GAS unsigned long long gu64;
#define RLX_AGENT __ATOMIC_RELAXED, __HIP_MEMORY_SCOPE_AGENT
#define LDS_WAIT() asm volatile("s_waitcnt lgkmcnt(0)" ::: "memory")
#define VM_WAIT() asm volatile("s_waitcnt vmcnt(0)" ::: "memory")
__device__ __forceinline__ unsigned long long rt() { return __builtin_amdgcn_s_memrealtime(); }
__device__ __forceinline__ unsigned f2bf(float f) { unsigned u = __builtin_bit_cast(unsigned, f); return (u + 0x7fffu + ((u >> 16) & 1u)) >> 16; }
__device__ __forceinline__ unsigned pk2(float lo, float hi) { return f2bf(lo) | (f2bf(hi) << 16); }
#define XB_TMO      128
#define XB_XCNT(j)  (256  + 64 * (j))
#define XB_XSUB(j)  (1280 + 64 * (j))
#define XB_XGEN(j)  (2304 + 64 * (j))
#define XB_TOP      3328
#define XB_TOPGEN   3392
#define XCD_BAR_WORDS 3456
#define XB_SPIN_CAP (1u << 18)

__device__ __forceinline__ unsigned xb_ld(unsigned* p)              { return __hip_atomic_load(p, __ATOMIC_RELAXED, __HIP_MEMORY_SCOPE_AGENT); }
__device__ __forceinline__ unsigned xb_add(unsigned* p, unsigned v) { return __hip_atomic_fetch_add(p, v, __ATOMIC_RELAXED, __HIP_MEMORY_SCOPE_AGENT); }
__device__ __forceinline__ unsigned xb_xcc_id() { return (unsigned)__builtin_amdgcn_s_getreg((3 << 11) | 20) & 0xFu; }
#define XB_SPIN(cond, bar) do { unsigned _sp = 0; while (cond) { __builtin_amdgcn_s_sleep(1); \
    if ((++_sp & 255u) == 0u) { if (xb_ld(&(bar)[XB_TMO])) break; if (_sp > XB_SPIN_CAP) { atomicAdd(&(bar)[XB_TMO], 1u); break; } } } } while (0)

struct XcdBarrier {
    unsigned* bar; unsigned x;
    volatile LAS unsigned* st;
};

__device__ __forceinline__ XcdBarrier xcd_barrier_post(unsigned* bar, volatile LAS unsigned* st) {
    XcdBarrier b; b.bar = bar; b.x = xb_xcc_id(); b.st = st;
    if (threadIdx.x == 0) (void)xb_add(&bar[XB_XCNT(b.x)], 1u);
    return b;
}
__device__ __forceinline__ void xcd_barrier_complete(unsigned* bar, unsigned x, unsigned& nloc, unsigned& nx) {
    const unsigned G = gridDim.x * gridDim.y * gridDim.z;
    unsigned sum, cnt, mine, sp = 0u;
    for (;;) {
        sum = 0u; cnt = 0u; mine = 0u;
#pragma unroll
        for (unsigned j = 0; j < 16; ++j) { const unsigned c = xb_ld(&bar[XB_XCNT(j)]); sum += c; cnt += (c > 0u) ? 1u : 0u; mine = (j == x) ? c : mine; }
        if (sum == G) break;
        __builtin_amdgcn_s_sleep(1);
        if ((++sp & 255u) == 0u) { if (xb_ld(&bar[XB_TMO])) break; if (sp > XB_SPIN_CAP) { atomicAdd(&bar[XB_TMO], 1u); break; } }
    }
    nloc = mine > 0u ? mine : 1u; nx = cnt > 0u ? cnt : 1u;
}

__device__ __forceinline__ void xcd_barrier(const XcdBarrier& b) {
    asm volatile("s_waitcnt vmcnt(0)" ::: "memory");
    __syncthreads();
    if (threadIdx.x == 0) {
        unsigned* bar = b.bar;
        __builtin_amdgcn_s_waitcnt(0);
        unsigned nloc = b.st[0], nx = b.st[1];
        if (nloc == 0u) { xcd_barrier_complete(bar, b.x, nloc, nx); b.st[0] = nloc; b.st[1] = nx; }
        const unsigned old = xb_add(&bar[XB_XSUB(b.x)], 1u);
        const unsigned gen = old / nloc;
        if (old + 1u == (gen + 1u) * nloc) {
            __builtin_amdgcn_fence(__ATOMIC_RELEASE, "agent");
            asm volatile("s_waitcnt vmcnt(0)" ::: "memory");
            const unsigned og = xb_add(&bar[XB_TOP], 1u);
            const unsigned tg = og / nx;
            if (og + 1u == (tg + 1u) * nx) xb_add(&bar[XB_TOPGEN], 1u);
            else XB_SPIN(xb_ld(&bar[XB_TOPGEN]) == tg, bar);
            __builtin_amdgcn_fence(__ATOMIC_ACQUIRE, "agent");
            xb_add(&bar[XB_XGEN(b.x)], 1u);
            asm volatile("s_waitcnt vmcnt(0)" ::: "memory");
        } else {
            XB_SPIN(xb_ld(&bar[XB_XGEN(b.x)]) == gen, bar);
            __builtin_amdgcn_fence(__ATOMIC_ACQUIRE, "agent");
            asm volatile("s_waitcnt vmcnt(0)" ::: "memory");
        }
    }
    __syncthreads();
}
constexpr int NWAVES = 8, NTHREADS = 512;
constexpr int TT = 16384, DM = 1024, SEQ = 8192, NIN = 1280, NQD = 2048, NEXP = 16384;
constexpr float DN_ALPHA = 1.189207115002721f;
constexpr float LN_EPS = 1e-5f;
constexpr float LOG2E = 1.4426950408889634f;
constexpr float QSCALE = 0.125f * LOG2E;

constexpr size_t MiB = 1u << 20;
constexpr size_t WS_CTL = 0, CTL_ZERO_BYTES = 64 * 1024;
constexpr size_t WS_MODP = 1 * MiB;
constexpr size_t WS_MOD = 1 * MiB + 896 * 1024;
constexpr size_t WS_ROPE = 2 * MiB;
constexpr size_t WS_WIN = 248 * MiB;
constexpr size_t WS_BIAS = 4 * MiB;
constexpr size_t WS_K1 = 6 * MiB + 512 * 1024, WS_K2 = WS_K1 + 32 * 1024;
constexpr size_t WS_WOUT = 7 * MiB;
constexpr size_t WS_WPQ = 9 * MiB;
constexpr size_t WS_SWQ = 13 * MiB + 262144;
constexpr size_t WS_SU = 13 * MiB, WS_SV = 13 * MiB + 65536;
constexpr size_t WS_U = 16 * MiB, WS_V = 32 * MiB;
constexpr size_t WS_H2Q = 48 * MiB, WS_SH = 13 * MiB + 131072;
constexpr size_t WS_XN8 = 64 * MiB;
constexpr size_t WS_XN = 80 * MiB;
constexpr size_t WS_MIX = 112 * MiB;
constexpr size_t WS_PE = 80 * MiB, WS_PG = 84 * MiB;
constexpr size_t WS_PROJ = 112 * MiB;
constexpr size_t WS_A2 = 152 * MiB;
constexpr size_t WS_X1 = 184 * MiB, WS_H2 = 216 * MiB;
constexpr size_t WS_Q = 112 * MiB;
constexpr size_t WS_END = 253 * MiB;
constexpr int CW_MODCNT = 1024;
constexpr int CW_BAR = 4096;

constexpr int RING_BYTES = 131072, LDSCTL_OFF = RING_BYTES, MISC_OFF = LDSCTL_OFF + 320, LDS_BYTES = 147456;

typedef float f32x16 __attribute__((ext_vector_type(16)));
typedef float f32x2 __attribute__((ext_vector_type(2)));
typedef unsigned u32x2 __attribute__((ext_vector_type(2)));
typedef unsigned u32x4 __attribute__((ext_vector_type(4)));
typedef __bf16 bf16x2_t __attribute__((ext_vector_type(2)));
struct Frame {
    LAS unsigned char* lds;
    int tid, lane, wave, vcu, G;
    const float *x, *c, *w_ada, *b_ada, *w_in, *sinks, *w_pool, *pool_scale, *w_out, *ln1_g, *ln1_b, *w_pq, *k1, *k2, *pu, *pv, *ln2_g, *ln2_b;
    float* out; unsigned char* ws;
};
__device__ __forceinline__ float wave_sum(float v) {
#pragma unroll
    for (int o = 1; o < 64; o <<= 1) v += __shfl_xor(v, o);
    return v;
}
__device__ __forceinline__ float bf_lo(unsigned u) { return __uint_as_float(u << 16); }
__device__ __forceinline__ float bf_hi(unsigned u) { return __uint_as_float(u & 0xffff0000u); }
__device__ __forceinline__ float bf2f(bf16 b) { return __uint_as_float((unsigned)b << 16); }
__device__ __forceinline__ unsigned fp8x4(float a, float b, float c, float d) { int pk = __builtin_amdgcn_cvt_pk_fp8_f32(a, b, 0, false); pk = __builtin_amdgcn_cvt_pk_fp8_f32(c, d, pk, true); return (unsigned)pk; }

template <int MODE, bool OUT8 = false>
__device__ __forceinline__ void transpose_item(const float* W, int ldw, bf16* WT, int ldt, int k0, int n0, LAS float* scr, int lane, const LAS float* ksc = nullptr, float oscale = 1.0f) {
    int nsrc = n0 + (lane & 31);
    if (MODE == 1 && nsrc < 640) { const int hd = nsrc >> 6, w = nsrc & 63; nsrc = hd * 64 + (w >> 1) + 32 * (w & 1); }
    float wv[32];
#pragma unroll
    for (int i = 0; i < 32; ++i) wv[i] = W[(size_t)(k0 + 2 * i + (lane >> 5)) * ldw + nsrc];
#pragma unroll
    for (int i = 0; i < 32; ++i) { const int kk = 2 * i + (lane >> 5); float w_ = wv[i]; if (MODE == 1) w_ *= ksc[k0 + kk]; scr[kk * 33 + (lane & 31)] = w_; }
    LDS_WAIT(); asm volatile("" ::: "memory");
    const int c = lane & 7;
#pragma unroll
    for (int j = 0; j < 4; ++j) { const int n = (lane >> 3) + 8 * j; const LAS float* s = scr + (8 * c) * 33 + n;
        if (OUT8) { u32x2 o8; o8.x = fp8x4(s[0 * 33] * oscale, s[1 * 33] * oscale, s[2 * 33] * oscale, s[3 * 33] * oscale); o8.y = fp8x4(s[4 * 33] * oscale, s[5 * 33] * oscale, s[6 * 33] * oscale, s[7 * 33] * oscale);
            *(u32x2*)((unsigned char*)WT + (size_t)(n0 + n) * ldt + k0 + 8 * c) = o8; }
        else { v4u o; o.x = pk2(s[0 * 33], s[1 * 33]); o.y = pk2(s[2 * 33], s[3 * 33]); o.z = pk2(s[4 * 33], s[5 * 33]); o.w = pk2(s[6 * 33], s[7 * 33]);
            *(GAS v4u*)(WT + (size_t)(n0 + n) * ldt + k0 + 8 * c) = o; } }
    LDS_WAIT(); asm volatile("" ::: "memory");
}
__device__ __forceinline__ void transpose_item_q8(const float* W, int ldw, unsigned char* WT, int k0, int n0, LAS float* scr, int lane, const float* inv) {
    const int nsrc = n0 + (lane & 31);
    float wv[32];
#pragma unroll
    for (int i = 0; i < 32; ++i) wv[i] = W[(size_t)(k0 + 2 * i + (lane >> 5)) * ldw + nsrc];
#pragma unroll
    for (int i = 0; i < 32; ++i) scr[(2 * i + (lane >> 5)) * 33 + (lane & 31)] = wv[i];
    LDS_WAIT(); asm volatile("" ::: "memory");
    const int c = lane & 7;
#pragma unroll
    for (int j = 0; j < 4; ++j) { const int n = (lane >> 3) + 8 * j; const LAS float* s = scr + (8 * c) * 33 + n; const float iv = inv[n0 + n];
        unsigned w[2];
#pragma unroll
        for (int hf = 0; hf < 2; ++hf) { unsigned o = 0u;
#pragma unroll
            for (int e = 0; e < 4; ++e) { int q = (int)rintf(s[(4 * hf + e) * 33] * iv); q = q < -127 ? -127 : (q > 127 ? 127 : q); o |= (unsigned)(q & 255) << (8 * e); }
            w[hf] = o; }
        const int d0 = k0 + 8 * c, jq = d0 >> 8, l0 = (d0 & 255) >> 2;
        unsigned char* rowp = WT + (size_t)(n0 + n) * DM;
        *(unsigned*)(rowp + 16 * l0 + 4 * jq) = w[0]; *(unsigned*)(rowp + 16 * (l0 + 1) + 4 * jq) = w[1]; }
    LDS_WAIT(); asm volatile("" ::: "memory");
}
__device__ __forceinline__ void sincos_d(double a, float& s, float& c) {
    const double TWO_PI = 6.283185307179586476925, PI = 3.141592653589793238462643;
    double r = a - TWO_PI * rint(a / TWO_PI);
    double sg = 1.0;
    if (r > 0.5 * PI) { r = PI - r; sg = -1.0; } else if (r < -0.5 * PI) { r = -PI - r; sg = -1.0; }
    const double r2 = r * r;
    double sp = -1.0 / 121645100408832000.0;
    sp = sp * r2 + 1.0 / 355687428096000.0; sp = sp * r2 - 1.0 / 1307674368000.0; sp = sp * r2 + 1.0 / 6227020800.0; sp = sp * r2 - 1.0 / 39916800.0;
    sp = sp * r2 + 1.0 / 362880.0; sp = sp * r2 - 1.0 / 5040.0; sp = sp * r2 + 1.0 / 120.0; sp = sp * r2 - 1.0 / 6.0; sp = sp * r2 + 1.0;
    double cp = 1.0 / 6402373705728000.0;
    cp = cp * r2 - 1.0 / 20922789888000.0; cp = cp * r2 + 1.0 / 87178291200.0; cp = cp * r2 - 1.0 / 479001600.0; cp = cp * r2 + 1.0 / 3628800.0;
    cp = cp * r2 - 1.0 / 40320.0; cp = cp * r2 + 1.0 / 720.0; cp = cp * r2 - 1.0 / 24.0; cp = cp * r2 + 0.5; cp = 1.0 - cp * r2;
    s = (float)(sp * r); c = (float)(sg * cp);
}
__device__ __forceinline__ void p1_win(Frame& F);
__device__ __forceinline__ void p0_prologue(Frame& F, int parts = 0xff) {
    LAS float* scr = (LAS float*)(F.lds + F.wave * 16384);
    const int gw = F.vcu * NWAVES + F.wave, NGW = F.G * NWAVES, lane = F.lane;
    if ((parts & 1) && (int)blockIdx.x < 192) { const int gb = (int)blockIdx.x, chunk = gb % 96, kh = gb / 96, col = chunk * 64 + lane, kbase = kh * 512 + F.wave * 64; float a0 = 0.f, a1 = 0.f;
        LAS float* sl = (LAS float*)(F.lds + F.wave * 16384 + 8448);
        { const int k = kbase + lane; const float c0 = F.c[k], c1 = F.c[DM + k]; sl[lane] = c0 / (1.f + __expf(-c0)); sl[64 + lane] = c1 / (1.f + __expf(-c1)); }
        LDS_WAIT(); asm volatile("" ::: "memory");
        { float w[64];
#pragma unroll
            for (int u = 0; u < 64; ++u) w[u] = F.w_ada[(size_t)(kbase + u) * 6144 + col];
#pragma unroll
            for (int u = 0; u < 64; ++u) { a0 += sl[u] * w[u]; a1 += sl[64 + u] * w[u]; } }
        LAS float* red = (LAS float*)(F.lds + F.wave * 16384 + 12288); red[lane] = a0; red[64 + lane] = a1;
        __syncthreads();
        if (F.tid < 128) { const int bb = F.tid >> 6, l = F.tid & 63; float sacc = kh == 0 ? F.b_ada[chunk * 64 + l] : 0.f;
#pragma unroll
            for (int w = 0; w < 8; ++w) sacc += ((const LAS float*)(F.lds + w * 16384 + 12288))[bb * 64 + l];
            ((float*)(F.ws + WS_MODP))[(kh * 2 + bb) * 6144 + chunk * 64 + l] = sacc; }
        asm volatile("s_waitcnt vmcnt(0)" ::: "memory"); __syncthreads();
        if (F.tid == 0) { __builtin_amdgcn_fence(__ATOMIC_RELEASE, "agent"); asm volatile("s_waitcnt vmcnt(0)" ::: "memory");
            __hip_atomic_fetch_add((unsigned*)(F.ws + WS_CTL) + CW_MODCNT, 1u, __ATOMIC_RELAXED, __HIP_MEMORY_SCOPE_AGENT); } }
    if ((parts & 1) && (int)blockIdx.x >= 192 && (int)blockIdx.x < 224) { const int chunk = (int)blockIdx.x - 192, col = chunk * 64 + lane; float am = 0.f;
#pragma unroll 1
        for (int kb = 0; kb < 128; kb += 64) { float w[64];
#pragma unroll
            for (int u = 0; u < 64; ++u) w[u] = F.w_pq[(size_t)(F.wave * 128 + kb + u) * NQD + col];
#pragma unroll
            for (int u = 0; u < 64; ++u) am = fmaxf(am, fabsf(w[u])); }
        LAS float* red = (LAS float*)(F.lds + F.wave * 16384 + 12288); red[lane] = am;
        __syncthreads();
        if (F.tid < 64) { float a = 0.f;
#pragma unroll
            for (int w = 0; w < 8; ++w) a = fmaxf(a, ((const LAS float*)(F.lds + w * 16384 + 12288))[F.tid]);
            if (a == 0.f) a = 1.f;
            ((float*)(F.ws + WS_SWQ))[chunk * 64 + F.tid] = a * (1.0f / 127.0f); ((float*)(F.ws + WS_SWQ))[NQD + chunk * 64 + F.tid] = 127.0f / a; }
        asm volatile("s_waitcnt vmcnt(0)" ::: "memory"); __syncthreads();
        if (F.tid == 0) { __builtin_amdgcn_fence(__ATOMIC_RELEASE, "agent"); asm volatile("s_waitcnt vmcnt(0)" ::: "memory");
            __hip_atomic_fetch_add((unsigned*)(F.ws + WS_CTL) + CW_MODCNT, 1u, __ATOMIC_RELAXED, __HIP_MEMORY_SCOPE_AGENT); } }
    if (parts & 2) { float* rope = (float*)(F.ws + WS_ROPE);
      for (int e = gw * 64 + lane; e < SEQ * 32; e += NGW * 64) { const int pos = e >> 5, i = e & 31;
          const float freq = powf(10000.0f, -(float)i / 32.0f); const float ang = (float)pos * freq; float s, c; sincos_d((double)ang, s, c);
          rope[2 * e] = c; rope[2 * e + 1] = s; } }
    if (parts & 4) { constexpr int I_OUT = 8 * 32;
      for (int it = NGW - 1 - gw; it < I_OUT; it += NGW) { const int r = it;
          transpose_item<0, true>(F.w_out, DM, (bf16*)(F.ws + WS_WOUT), DM, 64 * (r / 32), 32 * (r % 32), scr, lane, nullptr, 64.0f); } }
    if (parts & 8) { unsigned char* wout_t = F.ws + WS_WOUT;
      for (int it = gw; it < 4 * 2 * 128; it += NGW) { const int g = it >> 8, ch = (it >> 7) & 1, n0 = (it & 127) * 8, cidx = ch * 64 + lane;
          const float* wo = F.w_out + (size_t)(512 + g * 128) * DM + n0; const float* ps = F.pool_scale + g * 128;
#pragma unroll
          for (int i = 0; i < 4; ++i) { const int f4 = lane + 64 * i, e = f4 >> 1, hf = f4 & 1; const f32x4 o = *(const f32x4*)(wo + (size_t)e * DM + 4 * hf) * ps[e]; *(LAS f32x4*)(scr + e * 8 + 4 * hf) = o; }
          float acc[8];
#pragma unroll
          for (int i = 0; i < 8; ++i) acc[i] = 0.f;
          const float* wp = F.w_pool + ((size_t)(g * 128 + cidx)) * 128;
          LDS_WAIT(); asm volatile("" ::: "memory");
#pragma unroll 1
          for (int e0 = 0; e0 < 128; e0 += 64) { f32x4 wv[16];
#pragma unroll
              for (int q = 0; q < 16; ++q) wv[q] = *(const f32x4*)(wp + e0 + 4 * q);
#pragma unroll
              for (int q = 0; q < 16; ++q)
#pragma unroll
                  for (int ee = 0; ee < 4; ++ee) { const float w = wv[q][ee]; const f32x4 o0 = *(const LAS f32x4*)(scr + (e0 + 4 * q + ee) * 8), o1 = *(const LAS f32x4*)(scr + (e0 + 4 * q + ee) * 8 + 4);
                      acc[0] += w * o0[0]; acc[1] += w * o0[1]; acc[2] += w * o0[2]; acc[3] += w * o0[3]; acc[4] += w * o1[0]; acc[5] += w * o1[1]; acc[6] += w * o1[2]; acc[7] += w * o1[3]; } }
#pragma unroll
          for (int i = 0; i < 8; ++i) wout_t[(size_t)(n0 + i) * DM + 512 + g * 128 + cidx] = (unsigned char)(fp8x4(acc[i] * 64.0f, 0.f, 0.f, 0.f) & 0xffu);
          LDS_WAIT(); asm volatile("" ::: "memory"); } }
    if (parts & 16) { bf16* k1b = (bf16*)(F.ws + WS_K1); bf16* k2b = (bf16*)(F.ws + WS_K2);
      for (int e = gw * 64 + lane; e < 128 * 128; e += NGW * 64) { k1b[e] = (bf16)f2bf(F.k1[e]); k2b[e] = (bf16)f2bf(F.k2[e]); } }
    if (parts & 32) { bf16* xn = (bf16*)(F.ws + WS_XN); const int rpw = TT / NGW;
      for (int m = gw * rpw; m < gw * rpw + rpw; m += 4) { f32x4 v[4][4];
#pragma unroll
          for (int q = 0; q < 4; ++q)
#pragma unroll
              for (int j = 0; j < 4; ++j) v[q][j] = *(const f32x4*)(F.x + (size_t)(m + q) * DM + 256 * j + 4 * lane);
#pragma unroll
          for (int q = 0; q < 4; ++q)
#pragma unroll
              for (int j = 0; j < 4; ++j) { u32x2 o; o.x = pk2(v[q][j][0], v[q][j][1]); o.y = pk2(v[q][j][2], v[q][j][3]); *(u32x2*)(xn + (size_t)(m + q) * DM + 256 * j + 4 * lane) = o;
                  *(unsigned*)(F.ws + WS_XN8 + (size_t)(m + q) * DM + 256 * j + 4 * lane) = fp8x4(v[q][j][0], v[q][j][1], v[q][j][2], v[q][j][3]); } } }
    if (parts & 64) {
        __syncthreads();
        if (F.tid == 0) { unsigned sp = 0; const unsigned* cnt = (const unsigned*)(F.ws + WS_CTL) + CW_MODCNT;
            while (__hip_atomic_load(cnt, __ATOMIC_RELAXED, __HIP_MEMORY_SCOPE_AGENT) < 224u) { __builtin_amdgcn_s_sleep(2); if (++sp > (1u << 22)) break; }
            __builtin_amdgcn_fence(__ATOMIC_ACQUIRE, "agent"); asm volatile("s_waitcnt vmcnt(0)" ::: "memory"); }
        __syncthreads();
        p1_win(F);
    }
}
__device__ __forceinline__ void tb_load4(Frame& F, int base, int r1, f32x4 (&dst)[4][4]) {
#pragma unroll
    for (int q = 0; q < 4; ++q) { const int it = (base + q < r1) ? base + q : r1 - 1; const int tb = it >= NEXP, e = it - tb * NEXP; const float* src = (tb ? F.pv : F.pu) + (size_t)e * DM;
#pragma unroll
        for (int j = 0; j < 4; ++j) dst[q][j] = *(const f32x4*)(src + 256 * j + 4 * F.lane); }
}
__device__ __forceinline__ void tb_proc4(Frame& F, int base, int r1, const f32x4 (&v)[4][4]) {
    const int lane = F.lane; float* su = (float*)(F.ws + WS_SU); float* sv = (float*)(F.ws + WS_SV); float am[4];
#pragma unroll
    for (int q = 0; q < 4; ++q) { float a = 0.f;
#pragma unroll
        for (int j = 0; j < 4; ++j) a = fmaxf(a, fmaxf(fmaxf(fabsf(v[q][j][0]), fabsf(v[q][j][1])), fmaxf(fabsf(v[q][j][2]), fabsf(v[q][j][3])))); am[q] = a; }
#pragma unroll
    for (int o = 1; o < 64; o <<= 1) {
#pragma unroll
        for (int q = 0; q < 4; ++q) am[q] = fmaxf(am[q], __shfl_xor(am[q], o)); }
#pragma unroll
    for (int q = 0; q < 4; ++q) { const int it = (base + q < r1) ? base + q : r1 - 1; const int tb = it >= NEXP, e = it - tb * NEXP; float a = am[q]; if (a == 0.f) a = 1.f;
        unsigned w[4];
        if (!tb) { const float inv = 127.0f / a;
#pragma unroll
            for (int j = 0; j < 4; ++j) { const int q0 = (int)rintf(v[q][j][0] * inv), q1 = (int)rintf(v[q][j][1] * inv), q2 = (int)rintf(v[q][j][2] * inv), q3 = (int)rintf(v[q][j][3] * inv);
                w[j] = (unsigned)(q0 & 255) | ((unsigned)(q1 & 255) << 8) | ((unsigned)(q2 & 255) << 16) | ((unsigned)(q3 & 255) << 24); }
            *(v4u*)(F.ws + WS_U + (size_t)e * DM + 16 * lane) = (v4u){w[0], w[1], w[2], w[3]}; if (lane == 0) su[e] = a * (1.0f / 127.0f);
        } else { const float inv = 256.0f / a;
#pragma unroll
            for (int j = 0; j < 4; ++j) { unsigned wv = 0u, g = 0u;
#pragma unroll
                for (int i = 0; i < 4; ++i) { const float t = v[q][j][i] * inv; const unsigned short hb = __builtin_bit_cast(unsigned short, (_Float16)t);
                    const int m = (int)(hb & 0x7fffu); int h7 = (m - (int)g + 128) >> 8; h7 = h7 < 0 ? 0 : (h7 > 0x7B ? 0x7B : h7);
                    const unsigned byte = (unsigned)h7 | ((hb >> 8) & 0x80u); wv |= byte << (8 * i); g = byte; }
                w[j] = wv; }
            *(v4u*)(F.ws + WS_V + (size_t)e * DM + 16 * lane) = (v4u){w[0], w[1], w[2], w[3]}; if (lane == 0) sv[e] = a * (1.0f / 256.0f); } }
}
__device__ __forceinline__ void p2_tables(Frame& F, int cw, int ncw, int row_lo, int row_hi) {
    const int per = (row_hi - row_lo + ncw - 1) / ncw, r0 = row_lo + cw * per, r1 = (r0 + per) < row_hi ? (r0 + per) : row_hi;
    if (r0 >= r1) return;
    f32x4 va[4][4], vb[4][4];
    tb_load4(F, r0, r1, va);
    for (int it0 = r0; it0 < r1; it0 += 8) {
        if (it0 + 4 < r1) tb_load4(F, it0 + 4, r1, vb);
        tb_proc4(F, it0, r1, va);
        if (it0 + 4 < r1) { if (it0 + 8 < r1) tb_load4(F, it0 + 8, r1, va); tb_proc4(F, it0 + 4, r1, vb); }
    }
}
__device__ __forceinline__ void p1_win(Frame& F) {
    const float* mp = (const float*)(F.ws + WS_MODP);
    if (F.vcu < 48 && F.tid < 256) { const int e = F.vcu * 256 + F.tid; ((float*)(F.ws + WS_MOD))[e] = mp[e] + mp[2 * 6144 + e]; }
    LAS float* sc = (LAS float*)F.lds; LAS float* sh = sc + 2048;
    for (int i = F.tid; i < 2048; i += NTHREADS) { const int b = i >> 10, k = i & 1023; sc[i] = 1.f + mp[b * 6144 + 1024 + k] + mp[(2 + b) * 6144 + 1024 + k]; sh[i] = mp[b * 6144 + k] + mp[(2 + b) * 6144 + k]; }
    __syncthreads();
    const int lane = F.lane;
    if (F.vcu < 40) { const int b = F.vcu / 20, n = (F.vcu % 20) * 64 + lane; int nsrc = n; if (n < 640) { const int hd = n >> 6, w = n & 63; nsrc = hd * 64 + (w >> 1) + 32 * (w & 1); }
        float a = 0.f;
#pragma unroll 1
        for (int kb = 0; kb < 128; kb += 64) { float w[64];
#pragma unroll
            for (int u = 0; u < 64; ++u) w[u] = F.w_in[(size_t)(F.wave * 128 + kb + u) * NIN + nsrc];
#pragma unroll
            for (int u = 0; u < 64; ++u) a += sh[b * 1024 + F.wave * 128 + kb + u] * w[u]; }
        LAS float* red = (LAS float*)(F.lds + 16384); red[F.wave * 64 + lane] = a;
        __syncthreads();
        if (F.tid < 64) { float sacc = 0.f;
#pragma unroll
            for (int w = 0; w < 8; ++w) sacc += red[w * 64 + F.tid];
            ((float*)(F.ws + WS_BIAS))[b * NIN + (F.vcu % 20) * 64 + F.tid] = sacc; } }
    LAS float* scr = (LAS float*)(F.lds + 32768 + F.wave * 8448);
    const int gw = F.vcu * NWAVES + F.wave, NGW = F.G * NWAVES;
    for (int it = gw; it < 2 * 640; it += NGW) { const int b = it / 640, r = it % 640;
        transpose_item<1, true>(F.w_in, NIN, (bf16*)(F.ws + WS_WIN + (size_t)b * NIN * DM), DM, 64 * (r / 40), 32 * (r % 40), scr, lane, sc + b * 1024, 64.0f); }
    for (int it = NGW - 1 - gw; it < 16 * 64; it += NGW)
        transpose_item_q8(F.w_pq, NQD, F.ws + WS_WPQ, 64 * (it / 64), 32 * (it % 64), scr, lane, (const float*)(F.ws + WS_SWQ) + NQD);
    __syncthreads();
}
constexpr int KS_STRIDE = 144, VT_STRIDE = 520, KS_BYTES = 256 * KS_STRIDE, VT_BYTES = 64 * VT_STRIDE;
struct KvRegs { v4u k[4], v[4]; };
__device__ __forceinline__ void p3_attn_kvload(Frame& F, int unit, KvRegs& R) {
    const int b = unit >> 7, kvh = (unit >> 6) & 1, n = unit & 63; const bf16* proj = (const bf16*)(F.ws + WS_PROJ);
    const size_t tok0 = (size_t)b * SEQ + (size_t)n * 128;
#pragma unroll
    for (int i = 0; i < 4; ++i) { const int ci = F.tid + NTHREADS * i, row = ci >> 3, ch = ci & 7; const bool valid = (n > 0) || (row >= 128); const size_t tk = tok0 - 128 + row;
        R.k[i] = (v4u){0u, 0u, 0u, 0u}; R.v[i] = (v4u){0u, 0u, 0u, 0u};
        if (valid) { R.k[i] = *(const v4u*)(proj + tk * NIN + 512 + kvh * 64 + ch * 8); R.v[i] = *(const v4u*)(proj + tk * NIN + 640 + kvh * 64 + ch * 8); } }
}
__device__ __forceinline__ void p3_attn_unit(Frame& F, int unit, const KvRegs& R) {
    const int b = unit >> 7, kvh = (unit >> 6) & 1, n = unit & 63;
    const bf16* proj = (const bf16*)(F.ws + WS_PROJ); unsigned char* a2 = F.ws + WS_A2;
    LAS unsigned char* Ks = F.lds; LAS unsigned char* Vt = F.lds + KS_BYTES;
    const int tid = F.tid, lane = F.lane, wave = F.wave, r32 = lane & 31, h = lane >> 5;
    const size_t tok0 = (size_t)b * SEQ + (size_t)n * 128;
#pragma unroll
    for (int i = 0; i < 4; ++i) { const int ci = tid + NTHREADS * i, row = ci >> 3, ch = ci & 7;
        const v4u kv = R.k[i], vv = R.v[i];
        *(LAS v4u*)(Ks + row * KS_STRIDE + ch * 16) = kv;
        LAS bf16* vt = (LAS bf16*)(Vt + (ch * 8) * VT_STRIDE) + row;
        vt[0 * (VT_STRIDE / 2)] = (bf16)(vv.x & 0xffff); vt[1 * (VT_STRIDE / 2)] = (bf16)(vv.x >> 16); vt[2 * (VT_STRIDE / 2)] = (bf16)(vv.y & 0xffff); vt[3 * (VT_STRIDE / 2)] = (bf16)(vv.y >> 16);
        vt[4 * (VT_STRIDE / 2)] = (bf16)(vv.z & 0xffff); vt[5 * (VT_STRIDE / 2)] = (bf16)(vv.z >> 16); vt[6 * (VT_STRIDE / 2)] = (bf16)(vv.w & 0xffff); vt[7 * (VT_STRIDE / 2)] = (bf16)(vv.w >> 16); }
    __syncthreads();
    const int g = wave >> 1, hq = kvh * 4 + g; const float sink2 = F.sinks[hq] * LOG2E;
#pragma unroll 1
    for (int qt = 0; qt < 2; ++qt) {
        const int qi0 = (wave & 1) * 64 + qt * 32, t0 = qi0 >> 5; const size_t tokq = tok0 + qi0 + r32;
        bf16x8 qf[4];
#pragma unroll
        for (int s = 0; s < 4; ++s) qf[s] = *(const bf16x8*)(proj + tokq * NIN + hq * 64 + 16 * s + 8 * h);
        f32x16 sc[5];
#pragma unroll
        for (int kt = 0; kt < 5; ++kt) { sc[kt] = (f32x16){};
#pragma unroll
            for (int s = 0; s < 4; ++s) { const bf16x8 kf = *(const LAS bf16x8*)(Ks + (32 * (t0 + kt) + r32) * KS_STRIDE + (16 * s + 8 * h) * 2);
                sc[kt] = __builtin_amdgcn_mfma_f32_32x32x16_bf16(kf, qf[s], sc[kt], 0, 0, 0); } }
        const int qi = qi0 + r32; float m = sink2;
#pragma unroll
        for (int kt = 0; kt < 5; ++kt)
#pragma unroll
            for (int r = 0; r < 16; ++r) { const int sidx = 32 * (t0 + kt) + (r & 3) + 8 * (r >> 2) + 4 * h; const int rel = qi + 128 - sidx;
                const bool ok = (rel >= 0) && (rel < 128) && ((n > 0) || (sidx >= 128));
                const float v = ok ? sc[kt][r] : -INFINITY; sc[kt][r] = v; m = fmaxf(m, v); }
        m = fmaxf(m, __shfl_xor(m, 32));
        float l = 0.f;
#pragma unroll
        for (int kt = 0; kt < 5; ++kt)
#pragma unroll
            for (int r = 0; r < 16; ++r) { const float p = __builtin_amdgcn_exp2f(sc[kt][r] - m); sc[kt][r] = p; l += p; }
        l += __shfl_xor(l, 32); l += __builtin_amdgcn_exp2f(sink2 - m);
        f32x16 o[2]; o[0] = (f32x16){}; o[1] = (f32x16){};
#pragma unroll
        for (int kt = 0; kt < 5; ++kt)
#pragma unroll
            for (int s2 = 0; s2 < 2; ++s2) {
                u32x4 pw; pw.x = pg8::cvt_pk_bf16(sc[kt][8 * s2 + 0], sc[kt][8 * s2 + 1]); pw.y = pg8::cvt_pk_bf16(sc[kt][8 * s2 + 2], sc[kt][8 * s2 + 3]);
                pw.z = pg8::cvt_pk_bf16(sc[kt][8 * s2 + 4], sc[kt][8 * s2 + 5]); pw.w = pg8::cvt_pk_bf16(sc[kt][8 * s2 + 6], sc[kt][8 * s2 + 7]);
                const bf16x8 pf = __builtin_bit_cast(bf16x8, pw);
#pragma unroll
                for (int dt = 0; dt < 2; ++dt) { const LAS unsigned char* vp = Vt + (dt * 32 + r32) * VT_STRIDE + (32 * (t0 + kt) + 16 * s2 + 4 * h) * 2;
                    const u32x2 lo = *(const LAS u32x2*)vp, hi = *(const LAS u32x2*)(vp + 16);
                    const u32x4 vw = (u32x4){lo.x, lo.y, hi.x, hi.y};
                    o[dt] = __builtin_amdgcn_mfma_f32_32x32x16_bf16(__builtin_bit_cast(bf16x8, vw), pf, o[dt], 0, 0, 0); } }
        const float inv = 16.0f / l;
#pragma unroll
        for (int dt = 0; dt < 2; ++dt)
#pragma unroll
            for (int rg = 0; rg < 4; ++rg) { const int d0 = dt * 32 + 8 * rg + 4 * h;
                *(unsigned*)(a2 + tokq * DM + hq * 64 + d0) = fp8x4(o[dt][4 * rg + 0] * inv, o[dt][4 * rg + 1] * inv, o[dt][4 * rg + 2] * inv, o[dt][4 * rg + 3] * inv); }
    }
    __syncthreads();
}
struct PoolRegs { unsigned u[48]; };
__device__ __forceinline__ void p3_pool_load(Frame& F, int unit, PoolRegs& R) {
    const bf16* proj = (const bf16*)(F.ws + WS_PROJ);
    const int cp = F.tid & 255, half = F.tid >> 8;
    const int tstart = unit * 64 + half * 32, s0 = tstart & (SEQ - 1);
    const bf16* pc = proj + 768 + 2 * cp;
#pragma unroll
    for (int i = 0; i < 48; ++i) { const int s = s0 - 16 + i; R.u[i] = (s >= 0) ? *(const unsigned*)(pc + (size_t)(tstart - 16 + i) * NIN) : 0u; }
}
__device__ __forceinline__ void p3_pool_compute(Frame& F, int unit, const PoolRegs& R) {
    unsigned char* a2 = F.ws + WS_A2;
    const int cp = F.tid & 255, half = F.tid >> 8, gi = cp >> 6, w = 2 << gi;
    const int tstart = unit * 64 + half * 32, s0 = tstart & (SEQ - 1);
    const unsigned (&u)[48] = R.u;
    float w0 = 0.f, w1 = 0.f;
#pragma unroll
    for (int j = 1; j <= 16; ++j) if (j <= w) { w0 += bf_lo(u[16 - j]); w1 += bf_hi(u[16 - j]); }
#pragma unroll
    for (int i = 0; i < 32; ++i) { const int s = s0 + i; const float p0 = bf_lo(u[16 + i]), p1 = bf_hi(u[16 + i]);
        const unsigned uo = (w == 2) ? u[14 + i] : (w == 4) ? u[12 + i] : (w == 8) ? u[8 + i] : u[i];
        w0 += p0 - bf_lo(uo); w1 += p1 - bf_hi(uo);
        const float rc = 1.0f / (float)((s + 1) < w ? (s + 1) : w);
        *(unsigned short*)(a2 + (size_t)(tstart + i) * DM + 512 + 2 * cp) = (unsigned short)(fp8x4((w0 * rc - p0) * 16.0f, (w1 * rc - p1) * 16.0f, 0.f, 0.f) & 0xffffu); }
}
__device__ __forceinline__ void p5_ln1(Frame& F) {
    const float* mod = (const float*)(F.ws + WS_MOD); const bf16* mix = (const bf16*)(F.ws + WS_MIX); const bf16* xn = (const bf16*)(F.ws + WS_XN);
    bf16* x1 = (bf16*)(F.ws + WS_X1); bf16* h2 = (bf16*)(F.ws + WS_H2); unsigned char* h2q = F.ws + WS_H2Q; float* shp = (float*)(F.ws + WS_SH);
    const int gw = F.vcu * NWAVES + F.wave, lane = F.lane; const int rows_per_wave = TT / (F.G * NWAVES);
    const int row0 = gw * rows_per_wave, b = row0 >> 13;
    f32x4 g1[4], lg[4], lb[4], s2[4], h2s[4];
#pragma unroll
    for (int j = 0; j < 4; ++j) { const int d = 256 * j + 4 * lane;
        g1[j] = *(const f32x4*)(mod + b * 6144 + 2048 + d) + 1.0f; lg[j] = *(const f32x4*)(F.ln1_g + d); lb[j] = *(const f32x4*)(F.ln1_b + d);
        s2[j] = *(const f32x4*)(mod + b * 6144 + 4096 + d) + 1.0f; h2s[j] = *(const f32x4*)(mod + b * 6144 + 3072 + d); }
    for (int r = 0; r < rows_per_wave; r += 2) {
        u32x2 xw[2][4]; u32x2 mv[2][4];
#pragma unroll
        for (int q = 0; q < 2; ++q)
#pragma unroll
            for (int j = 0; j < 4; ++j) { const size_t m = (size_t)(row0 + r + q); const int d = 256 * j + 4 * lane; xw[q][j] = *(const u32x2*)(xn + m * DM + d); mv[q][j] = *(const u32x2*)(mix + m * DM + d); }
#pragma unroll
        for (int q = 0; q < 2; ++q) { const size_t m = (size_t)(row0 + r + q);
        f32x4 v[4]; float s = 0.f;
#pragma unroll
        for (int j = 0; j < 4; ++j) {
            const f32x4 mf = (f32x4){bf_lo(mv[q][j].x), bf_hi(mv[q][j].x), bf_lo(mv[q][j].y), bf_hi(mv[q][j].y)};
            const f32x4 xf = (f32x4){bf_lo(xw[q][j].x), bf_hi(xw[q][j].x), bf_lo(xw[q][j].y), bf_hi(xw[q][j].y)};
            v[j] = xf * DN_ALPHA + g1[j] * mf; s += (v[j][0] + v[j][1]) + (v[j][2] + v[j][3]); }
        const float mean = wave_sum(s) * (1.f / DM); float qq = 0.f;
#pragma unroll
        for (int j = 0; j < 4; ++j) { v[j] = v[j] - mean; qq += (v[j][0] * v[j][0] + v[j][1] * v[j][1]) + (v[j][2] * v[j][2] + v[j][3] * v[j][3]); }
        const float rstd = 1.0f / sqrtf(wave_sum(qq) * (1.f / DM) + LN_EPS);
        f32x4 hh[4]; float am = 0.f;
#pragma unroll
        for (int j = 0; j < 4; ++j) { const int d = 256 * j + 4 * lane; const f32x4 y = v[j] * rstd * lg[j] + lb[j]; hh[j] = y * s2[j] + h2s[j];
            u32x2 o; o.x = pk2(y[0], y[1]); o.y = pk2(y[2], y[3]); *(u32x2*)(x1 + m * DM + d) = o;
            am = fmaxf(am, fmaxf(fmaxf(fabsf(hh[j][0]), fabsf(hh[j][1])), fmaxf(fabsf(hh[j][2]), fabsf(hh[j][3])))); }
#pragma unroll
        for (int o = 1; o < 64; o <<= 1) am = fmaxf(am, __shfl_xor(am, o));
        if (am == 0.f) am = 1.f;
        const float inv = 127.0f / am; unsigned w[4];
#pragma unroll
        for (int j = 0; j < 4; ++j) { const int q0 = (int)rintf(hh[j][0] * inv), q1 = (int)rintf(hh[j][1] * inv), q2 = (int)rintf(hh[j][2] * inv), q3 = (int)rintf(hh[j][3] * inv);
            w[j] = (unsigned)(q0 & 255) | ((unsigned)(q1 & 255) << 8) | ((unsigned)(q2 & 255) << 16) | ((unsigned)(q3 & 255) << 24); }
        *(v4u*)(h2q + m * DM + 16 * lane) = (v4u){w[0], w[1], w[2], w[3]}; if (lane == 0) shp[m] = am * (1.0f / 127.0f); } }
}
constexpr int KR_STRIDE = 272, KR_BYTES = 128 * KR_STRIDE;
#define FMAX1(x, y) __builtin_amdgcn_fmed3f((x), (y), INFINITY)
#define FMIN1(x, y) __builtin_amdgcn_fmed3f((x), (y), -INFINITY)
#define INS16(a, v) do { _Pragma("unroll") for (int _i = 15; _i >= 1; --_i) a[_i] = __builtin_amdgcn_fmed3f(a[_i - 1], a[_i], (v)); a[0] = FMAX1(a[0], (v)); } while (0)
#define CEX(a, i, j) do { const float _x = a[i], _y = a[j]; a[i] = FMAX1(_x, _y); a[j] = FMIN1(_x, _y); } while (0)
#define SORT16(a) do { _Pragma("unroll") for (int _p = 1; _p < 16; _p <<= 1) { _Pragma("unroll") for (int _k = _p; _k >= 1; _k >>= 1) { _Pragma("unroll") for (int _j = _k % _p; _j <= 15 - _k; _j += 2 * _k) { \
        _Pragma("unroll") for (int _i = 0; _i < _k; ++_i) { if (_i + _j + _k <= 15 && (_i + _j) / (2 * _p) == (_i + _j + _k) / (2 * _p)) CEX(a, _i + _j, _i + _j + _k); } } } } } while (0)
#define MERGE16(a, b) do { _Pragma("unroll") for (int _i = 0; _i < 16; ++_i) a[_i] = FMAX1(a[_i], b[15 - _i]); BITONIC16(a); } while (0)
#define BITONIC16(a) do { _Pragma("unroll") for (int _st = 8; _st >= 1; _st >>= 1) { _Pragma("unroll") for (int _i = 0; _i < 16; ++_i) if ((_i & _st) == 0) { const float _x = a[_i], _y = a[_i + _st]; a[_i] = FMAX1(_x, _y); a[_i + _st] = FMIN1(_x, _y); } } } while (0)
__device__ __forceinline__ void p7_route(Frame& F) {
    const bf16* q = (const bf16*)(F.ws + WS_Q); unsigned short* pe = (unsigned short*)(F.ws + WS_PE); float* pg = (float*)(F.ws + WS_PG);
    const int tid = F.tid, lane = F.lane, wave = F.wave, r32 = lane & 31, h = lane >> 5;
    { const bf16* k1b = (const bf16*)(F.ws + WS_K1);
      for (int ci = tid; ci < 2 * 128 * 16; ci += NTHREADS) { const int side = ci >> 11, row = (ci >> 4) & 127, ch = ci & 15;
          *(LAS v4u*)(F.lds + side * KR_BYTES + row * KR_STRIDE + ch * 16) = *(const v4u*)(k1b + (size_t)side * 16384 + row * 128 + ch * 8); } }
    __syncthreads();
    LAS unsigned char* scr = F.lds + 2 * KR_BYTES + wave * 2048 + lane * 32;
    pg8::StaticOrder S; S.init(TT, NQD, F.G, (int)blockIdx.x); pg8::Unit u;
    for (int ui = 0; S.next(ui, u); ++ui) {
        const int head = u.pn; const size_t tok = (size_t)u.pm * 256 + wave * 32 + r32;
        float vv[2][16];
#pragma unroll
        for (int side = 0; side < 2; ++side) {
            const bf16* qb = q + tok * NQD + head * 256 + side * 128;
            bf16x8 qf[8];
#pragma unroll
            for (int s = 0; s < 8; ++s) qf[s] = *(const bf16x8*)(qb + 16 * s + 8 * h);
            float a[16];
#pragma unroll
            for (int kt = 0; kt < 4; ++kt) { f32x16 acc = (f32x16){};
#pragma unroll
                for (int s = 0; s < 8; ++s) { const bf16x8 kf = *(const LAS bf16x8*)(F.lds + side * KR_BYTES + (32 * kt + r32) * KR_STRIDE + (16 * s + 8 * h) * 2);
                    acc = __builtin_amdgcn_mfma_f32_32x32x16_bf16(kf, qf[s], acc, 0, 0, 0); }
                float t[16];
#pragma unroll
                for (int r = 0; r < 16; ++r) { const unsigned key = (unsigned)(32 * kt + (r & 3) + 8 * (r >> 2)) | ((unsigned)h << 2);
                    t[r] = __uint_as_float((__float_as_uint(acc[r]) & 0xFFFFFF80u) | key); }
                SORT16(t);
                if (kt == 0) {
#pragma unroll
                    for (int r = 0; r < 16; ++r) a[r] = t[r];
                } else MERGE16(a, t);
                __builtin_amdgcn_sched_barrier(0); }
            float c[16];
#pragma unroll
            for (int i = 0; i < 16; ++i) c[i] = __shfl_xor(a[15 - i], 32);
#pragma unroll
            for (int i = 0; i < 16; ++i) c[i] = FMAX1(a[i], c[i]);
            BITONIC16(c);
#pragma unroll
            for (int i = 0; i < 16; ++i) vv[side][i] = c[i];
        }
        { v4u w1, w2;
#define PK4(L, b) ((__float_as_uint(L[b]) & 0x7Fu) | ((__float_as_uint(L[b + 1]) & 0x7Fu) << 8) | ((__float_as_uint(L[b + 2]) & 0x7Fu) << 16) | ((__float_as_uint(L[b + 3]) & 0x7Fu) << 24))
          w1.x = PK4(vv[0], 0); w1.y = PK4(vv[0], 4); w1.z = PK4(vv[0], 8); w1.w = PK4(vv[0], 12);
          w2.x = PK4(vv[1], 0); w2.y = PK4(vv[1], 4); w2.z = PK4(vv[1], 8); w2.w = PK4(vv[1], 12);
#undef PK4
          *(LAS v4u*)scr = w1; *(LAS v4u*)(scr + 16) = w2; }
        float c1[16], c2[16], top[16];
#pragma unroll
        for (int i = 0; i < 16; ++i) { c1[i] = __uint_as_float(__float_as_uint(vv[0][i]) & 0xFFFFFF80u); c2[i] = __uint_as_float(__float_as_uint(vv[1][i]) & 0xFFFFFF80u); top[i] = -INFINITY; }
        { int cnt = 0; float pend = 0.f; unsigned pcode = 0u;
#pragma unroll
          for (int ia = 0; ia < 16; ++ia)
#pragma unroll
            for (int ib = 0; ib < 16; ++ib) if ((ia + 1) * (ib + 1) <= 16) {
                const float sm = c1[ia] + c2[ib]; const unsigned code = (unsigned)(ia * 16 + ib);
                if ((cnt & 1) == 0) { pend = sm; pcode = code; }
                else { const float vs = h ? sm : pend; const unsigned cd = h ? code : pcode; const float v = __uint_as_float((__float_as_uint(vs) & 0xFFFFFF00u) | cd); INS16(top, v); }
                ++cnt; }
          float ot[16];
#pragma unroll
          for (int i = 0; i < 16; ++i) ot[i] = __shfl_xor(top[15 - i], 32);
#pragma unroll
          for (int i = 0; i < 16; ++i) top[i] = FMAX1(top[i], ot[i]);
          BITONIC16(top); }
        float ex[16], den = 0.f;
#pragma unroll
        for (int i = 0; i < 16; ++i) { ex[i] = __expf(top[i] - top[0]); den += ex[i]; }
        const float rden = 1.0f / den;
        LDS_WAIT();
        unsigned short ev[8]; float gv[8];
#pragma unroll
        for (int j = 0; j < 8; ++j) { const float t = h ? top[8 + j] : top[j]; const float e = h ? ex[8 + j] : ex[j];
            const unsigned code = __float_as_uint(t) & 0xFFu; const unsigned i1 = *(const LAS unsigned char*)(scr + (code >> 4)), i2 = *(const LAS unsigned char*)(scr + 16 + (code & 15u));
            ev[j] = (unsigned short)(i1 * 128u + i2); gv[j] = e * rden; }
        v4u ew; ew.x = ev[0] | ((unsigned)ev[1] << 16); ew.y = ev[2] | ((unsigned)ev[3] << 16); ew.z = ev[4] | ((unsigned)ev[5] << 16); ew.w = ev[6] | ((unsigned)ev[7] << 16);
        *(v4u*)(pe + tok * 128 + head * 16 + 8 * h) = ew;
        *(f32x4*)(pg + tok * 128 + head * 16 + 8 * h) = (f32x4){gv[0], gv[1], gv[2], gv[3]};
        *(f32x4*)(pg + tok * 128 + head * 16 + 8 * h + 4) = (f32x4){gv[4], gv[5], gv[6], gv[7]};
        LDS_WAIT();
    }
    __syncthreads();
}
__device__ __forceinline__ float gelu_erf(float v) {
    const float d = fabsf(v) * 0.2316418882f + 1.0f, t = __builtin_amdgcn_rcpf(d);
    float q = t * 0.5307027145f + (-0.7265760135f); q = q * t + 0.7107068705f; q = q * t + (-0.142248368f); q = q * t + 0.127414796f; q = q * t;
    const float e = __builtin_amdgcn_exp2f(v * v * (-0.72134752044f)), m = v * (q * e);
    return v < 0.f ? m : v - m; }
#ifndef NPART
#define NPART 8
#endif
constexpr int TPW = 8, NSWEEP = 1;
constexpr int PSHIFT = (NPART == 32) ? 9 : (NPART == 8) ? 11 : (NPART == 16) ? 10 : (NPART == 4) ? 12 : (NPART == 2) ? 13 : 14;
__device__ __forceinline__ void p8_peer(Frame& F, unsigned emask = 0xffffu, int skip = 0) {
    const float* mod = (const float*)(F.ws + WS_MOD);
    const bf16* x1 = (const bf16*)(F.ws + WS_X1); const bf16* h2 = (const bf16*)(F.ws + WS_H2);
    const float* su = (const float*)(F.ws + WS_SU); const float* sv = (const float*)(F.ws + WS_SV);
    const unsigned* pe = (const unsigned*)(F.ws + WS_PE); const float* pg = (const float*)(F.ws + WS_PG);
    const int gw = F.vcu * NWAVES + F.wave;
    const int b3 = (F.lane >> 3) & 1;
#pragma unroll 1
    for (int sweep = 0; sweep < NSWEEP; ++sweep) {
    const int t0 = (gw * NSWEEP + sweep) * TPW, b = t0 >> 13;
    int lane = F.lane; asm volatile("" : "+v"(lane));
    unsigned hq[TPW][4]; float shs[TPW]; unsigned es[TPW]; float gs[TPW][2]; int offv[TPW];
    unsigned pe2v[TPW]; f32x2 pg2v[TPW];
#pragma unroll
    for (int tt = 0; tt < TPW; ++tt) { const size_t t = (size_t)(t0 + tt);
        const u32x4 hw = *(const u32x4*)(F.ws + WS_H2Q + t * DM + 16 * lane); hq[tt][0] = hw.x; hq[tt][1] = hw.y; hq[tt][2] = hw.z; hq[tt][3] = hw.w; shs[tt] = ((const float*)(F.ws + WS_SH))[t];
        pe2v[tt] = pe[t * 64 + lane]; pg2v[tt] = *(const f32x2*)(pg + t * 128 + 2 * lane); }
#pragma unroll
    for (int tt = 0; tt < TPW; ++tt) { LAS unsigned* scr = (LAS unsigned*)(F.lds + (F.wave * TPW + tt) * 1024);
        const unsigned pe2 = pe2v[tt]; const f32x2 pg2 = pg2v[tt];
        const unsigned elo = pe2 & emask, ehi = (pe2 >> 16) & emask; const int plo = (int)(elo >> PSHIFT), phi = (int)(ehi >> PSHIFT);
        int base = 0, poslo = 0, poshi = 0, ov = 0;
#pragma unroll
        for (int r = 0; r < NPART; ++r) { const unsigned long long mlo = __ballot(plo == r), mhi = __ballot(phi == r);
            const int clo = __popcll(mlo), chi = __popcll(mhi);
            const int rlo = (int)__builtin_amdgcn_mbcnt_hi((unsigned)(mlo >> 32), __builtin_amdgcn_mbcnt_lo((unsigned)mlo, 0u));
            const int rhi = (int)__builtin_amdgcn_mbcnt_hi((unsigned)(mhi >> 32), __builtin_amdgcn_mbcnt_lo((unsigned)mhi, 0u));
            if (plo == r) poslo = base + rlo; if (phi == r) poshi = base + clo + rhi;
            base += clo + chi; if (lane == r + 1) ov = base; }
        offv[tt] = ov;
        scr[2 * poslo] = elo; scr[2 * poslo + 1] = __float_as_uint(pg2.x); scr[2 * poshi] = ehi; scr[2 * poshi + 1] = __float_as_uint(pg2.y); }
    LDS_WAIT();
#pragma unroll
    for (int tt = 0; tt < TPW; ++tt) { const LAS unsigned* scr = (const LAS unsigned*)(F.lds + (F.wave * TPW + tt) * 1024);
        const u32x4 sr = *(const LAS u32x4*)(scr + 4 * lane);
        es[tt] = sr.x | (sr.z << 16); gs[tt][0] = __uint_as_float(sr.y); gs[tt][1] = __uint_as_float(sr.w); }
    LDS_WAIT();
    const __amdgpu_buffer_rsrc_t ut_rs = __builtin_amdgcn_make_buffer_rsrc((void*)(F.ws + WS_U), 0, NEXP * DM, 0x00020000), vt_rs = __builtin_amdgcn_make_buffer_rsrc((void*)(F.ws + WS_V), 0, NEXP * DM, 0x00020000);
    const int voff16 = 16 * lane;
#define ut ut_rs
#define vt vt_rs
#define P8_ISSUE(buf, tbl, tok, bb) do { _Pragma("unroll") for (int k2 = 0; k2 < 4; ++k2) { const unsigned ew = (unsigned)__builtin_amdgcn_readlane((int)es[tok], 4 * (bb) + k2); \
        buf[2 * k2] = __builtin_amdgcn_raw_buffer_load_b128((tbl), voff16, (int)((ew & 0xffffu) << 10), 0); buf[2 * k2 + 1] = __builtin_amdgcn_raw_buffer_load_b128((tbl), voff16, (int)((ew >> 16) << 10), 0); } } while (0)
    int hidv[TPW][2];
#pragma unroll
    for (int tt = 0; tt < TPW; ++tt) { hidv[tt][0] = 0; hidv[tt][1] = 0; }
    {
        u32x4 bufA[8], bufB[8];
#define P8_DOTS(buf, tok, bb) do { int p[8]; \
            _Pragma("unroll") for (int kk = 0; kk < 8; ++kk) { int s_ = __builtin_amdgcn_sdot4((int)buf[kk].x, (int)hq[tok][0], 0, false); s_ = __builtin_amdgcn_sdot4((int)buf[kk].y, (int)hq[tok][1], s_, false); \
                s_ = __builtin_amdgcn_sdot4((int)buf[kk].z, (int)hq[tok][2], s_, false); s_ = __builtin_amdgcn_sdot4((int)buf[kk].w, (int)hq[tok][3], s_, false); p[kk] = s_; } \
            int q4[4], q2[2], q1; \
            _Pragma("unroll") for (int i = 0; i < 4; ++i) { auto r_ = __builtin_amdgcn_permlane32_swap((unsigned)p[i], (unsigned)p[i + 4], false, false); q4[i] = (int)(r_[0] + r_[1]); } \
            _Pragma("unroll") for (int i = 0; i < 2; ++i) { auto r_ = __builtin_amdgcn_permlane16_swap((unsigned)q4[i], (unsigned)q4[i + 2], false, false); q2[i] = (int)(r_[0] + r_[1]); } \
            { const int keep = b3 ? q2[1] : q2[0], send = b3 ? q2[0] : q2[1]; q1 = keep + __builtin_amdgcn_update_dpp(0, send, 0x128, 0xF, 0xF, true); } \
            q1 += __builtin_amdgcn_update_dpp(0, q1, 0xB1, 0xF, 0xF, true); q1 += __builtin_amdgcn_update_dpp(0, q1, 0x4E, 0xF, 0xF, true); q1 += __builtin_amdgcn_update_dpp(0, q1, 0x141, 0xF, 0xF, true); \
            const int i2_ = (lane & 3) * 2; const int v0_ = __builtin_amdgcn_ds_bpermute(i2_ << 5, q1), v1_ = __builtin_amdgcn_ds_bpermute((i2_ + 1) << 5, q1); \
            if ((lane >> 2) == (bb)) { hidv[tok][0] = v0_; hidv[tok][1] = v1_; } } while (0)
        int cur[TPW];
#pragma unroll
        for (int tt = 0; tt < TPW; ++tt) cur[tt] = 0;
#define P8_STEP_A(tt_, bufX, bufY, r_) { const int end_ = __builtin_amdgcn_readlane(offv[tt_], (r_) + 1); \
            { constexpr int tn_ = ((tt_) + 1) % TPW; const int rn_ = (r_) + ((tt_) + 1) / TPW; \
              if (rn_ < NPART && cur[tn_] < __builtin_amdgcn_readlane(offv[tn_], rn_ + 1)) P8_ISSUE(bufY, ut, tn_, cur[tn_] >> 3); } \
            __builtin_amdgcn_sched_barrier(0); \
            bool pre_ = true; \
            while (cur[tt_] < end_) { if (!pre_) P8_ISSUE(bufX, ut, tt_, cur[tt_] >> 3); pre_ = false; P8_DOTS(bufX, tt_, cur[tt_] >> 3); cur[tt_] += 8; } }
        if ((skip & 1) == 0) {
        if (0 < __builtin_amdgcn_readlane(offv[0], 1)) P8_ISSUE(bufA, ut, 0, 0);
#pragma unroll 1
        for (int r = 0; r < NPART; ++r) {
            P8_STEP_A(0, bufA, bufB, r) P8_STEP_A(1, bufB, bufA, r) P8_STEP_A(2, bufA, bufB, r) P8_STEP_A(3, bufB, bufA, r)
            P8_STEP_A(4, bufA, bufB, r) P8_STEP_A(5, bufB, bufA, r) P8_STEP_A(6, bufA, bufB, r) P8_STEP_A(7, bufB, bufA, r)
        } }
#undef P8_STEP_A
#undef P8_DOTS
    }
    { float su0[TPW], su1[TPW], sv0[TPW], sv1[TPW];
#pragma unroll
      for (int tt = 0; tt < TPW; ++tt) { const unsigned e0 = es[tt] & 0xffffu, e1 = es[tt] >> 16; su0[tt] = su[e0]; su1[tt] = su[e1]; sv0[tt] = sv[e0]; sv1[tt] = sv[e1]; }
#pragma unroll
      for (int tt = 0; tt < TPW; ++tt) {
        gs[tt][0] = gelu_erf((float)hidv[tt][0] * (shs[tt] * su0[tt])) * gs[tt][0] * sv0[tt];
        gs[tt][1] = gelu_erf((float)hidv[tt][1] * (shs[tt] * su1[tt])) * gs[tt][1] * sv1[tt]; } }
    typedef _Float16 f16x2 __attribute__((ext_vector_type(2)));
    unsigned gsh[TPW];
#pragma unroll
    for (int tt = 0; tt < TPW; ++tt) gsh[tt] = __builtin_bit_cast(unsigned, (f16x2){(_Float16)gs[tt][0], (_Float16)gs[tt][1]});
    f16x2 yh[TPW][8];
#pragma unroll
    for (int tt = 0; tt < TPW; ++tt) {
#pragma unroll
        for (int i = 0; i < 8; ++i) yh[tt][i] = (f16x2){(_Float16)0.f, (_Float16)0.f}; }
    {
        u32x4 bufA[8], bufB[8];
#define P8_PICK(tok, a, wv) { const unsigned x0_ = (wv).x, x1_ = (wv).y, x2_ = (wv).z, x3_ = (wv).w;     \
            unsigned s0_ = x0_ << 8, s1_ = x1_ << 8, s2_ = x2_ << 8, s3_ = x3_ << 8; asm volatile("" : "+v"(s0_), "+v"(s1_), "+v"(s2_), "+v"(s3_)); \
            yh[tok][1] = __builtin_elementwise_fma(__builtin_bit_cast(f16x2, x0_), (a), yh[tok][1]); yh[tok][3] = __builtin_elementwise_fma(__builtin_bit_cast(f16x2, x1_), (a), yh[tok][3]); \
            yh[tok][5] = __builtin_elementwise_fma(__builtin_bit_cast(f16x2, x2_), (a), yh[tok][5]); yh[tok][7] = __builtin_elementwise_fma(__builtin_bit_cast(f16x2, x3_), (a), yh[tok][7]); \
            yh[tok][0] = __builtin_elementwise_fma(__builtin_bit_cast(f16x2, s0_), (a), yh[tok][0]); yh[tok][2] = __builtin_elementwise_fma(__builtin_bit_cast(f16x2, s1_), (a), yh[tok][2]); \
            yh[tok][4] = __builtin_elementwise_fma(__builtin_bit_cast(f16x2, s2_), (a), yh[tok][4]); yh[tok][6] = __builtin_elementwise_fma(__builtin_bit_cast(f16x2, s3_), (a), yh[tok][6]); }
#define P8_ACC(buf, tok, bb) do { _Pragma("unroll") for (int k2 = 0; k2 < 4; ++k2) { \
            const f16x2 hh_ = __builtin_bit_cast(f16x2, __builtin_amdgcn_readlane((int)gsh[tok], 4 * (bb) + k2)); \
            const f16x2 a0_ = (f16x2){hh_.x, hh_.x}, a1_ = (f16x2){hh_.y, hh_.y}; \
            { const u32x4 w0_ = buf[2 * k2]; P8_PICK(tok, a0_, w0_) } \
            { const u32x4 w1_ = buf[2 * k2 + 1]; P8_PICK(tok, a1_, w1_) } __builtin_amdgcn_sched_barrier(0); } } while (0)
        int cur[TPW];
#pragma unroll
        for (int tt = 0; tt < TPW; ++tt) cur[tt] = 0;
#define P8_STEP_B(tt_, bufX, bufY, r_) { const int end_ = __builtin_amdgcn_readlane(offv[tt_], (r_) + 1); \
            { constexpr int tn_ = ((tt_) + 1) % TPW; const int rn_ = (r_) + ((tt_) + 1) / TPW; \
              if (rn_ < NPART && cur[tn_] < __builtin_amdgcn_readlane(offv[tn_], rn_ + 1)) P8_ISSUE(bufY, vt, tn_, cur[tn_] >> 3); } \
            __builtin_amdgcn_sched_barrier(0); \
            bool pre_ = true; \
            while (cur[tt_] < end_) { if (!pre_) P8_ISSUE(bufX, vt, tt_, cur[tt_] >> 3); pre_ = false; P8_ACC(bufX, tt_, cur[tt_] >> 3); cur[tt_] += 8; } }
        if ((skip & 2) == 0) {
        if (0 < __builtin_amdgcn_readlane(offv[0], 1)) P8_ISSUE(bufA, vt, 0, 0);
#pragma unroll 1
        for (int r = 0; r < NPART; ++r) {
            P8_STEP_B(0, bufA, bufB, r) P8_STEP_B(1, bufB, bufA, r) P8_STEP_B(2, bufA, bufB, r) P8_STEP_B(3, bufB, bufA, r)
            P8_STEP_B(4, bufA, bufB, r) P8_STEP_B(5, bufB, bufA, r) P8_STEP_B(6, bufA, bufB, r) P8_STEP_B(7, bufB, bufA, r)
        } }
#undef P8_STEP_B
#undef P8_ACC
#undef P8_PICK
    }
#undef P8_ISSUE
#undef ut
#undef vt
    u32x2 xw[TPW][4]; f32x4 g2v[4], lgv[4], lbv[4];
#pragma unroll
    for (int tt = 0; tt < TPW; ++tt)
#pragma unroll
        for (int j = 0; j < 4; ++j) xw[tt][j] = *(const u32x2*)(x1 + (size_t)(t0 + tt) * DM + 256 * j + 4 * lane);
#pragma unroll
    for (int j = 0; j < 4; ++j) { const int d = 256 * j + 4 * lane; g2v[j] = *(const f32x4*)(mod + b * 6144 + 5120 + d) + 1.0f; lgv[j] = *(const f32x4*)(F.ln2_g + d); lbv[j] = *(const f32x4*)(F.ln2_b + d); }
#pragma unroll
    for (int tt = 0; tt < TPW; ++tt) { const size_t t = (size_t)(t0 + tt);
        f32x4 v[4]; float s = 0.f;
#pragma unroll
        for (int j = 0; j < 4; ++j) { const u32x2 xv = xw[tt][j];
            const f32x4 xf = (f32x4){bf_lo(xv.x), bf_hi(xv.x), bf_lo(xv.y), bf_hi(xv.y)}; const f32x4 yy = (f32x4){(float)yh[tt][2 * j].x, (float)yh[tt][2 * j + 1].x, (float)yh[tt][2 * j].y, (float)yh[tt][2 * j + 1].y};
            v[j] = xf * DN_ALPHA + g2v[j] * yy; s += (v[j][0] + v[j][1]) + (v[j][2] + v[j][3]); }
        const float mean = wave_sum(s) * (1.f / DM); float qq = 0.f;
#pragma unroll
        for (int j = 0; j < 4; ++j) { v[j] = v[j] - mean; qq += (v[j][0] * v[j][0] + v[j][1] * v[j][1]) + (v[j][2] * v[j][2] + v[j][3] * v[j][3]); }
        const float rstd = 1.0f / sqrtf(wave_sum(qq) * (1.f / DM) + LN_EPS);
#pragma unroll
        for (int j = 0; j < 4; ++j) { const int d = 256 * j + 4 * lane;
            *(f32x4*)(F.out + t * DM + d) = v[j] * rstd * lgv[j] + lbv[j]; } }
    }
}
#ifndef PROBE_PARTS
#define PROBE_PARTS 0xff
#endif
#ifndef MK_N_LAUNCHES
#define MK_N_LAUNCHES 1
#endif
constexpr int N_PHASES = 9;
struct Args { const float* in[18]; float* out; unsigned char* ws; int ph_lo, ph_hi, p0_parts, pad; };
__global__ void __launch_bounds__(NTHREADS, 2) fwd_kernel(Args args) {
    extern __shared__ __attribute__((aligned(16))) unsigned char lds[];
    Frame F;
    F.lds = (LAS unsigned char*)lds;
    F.tid = threadIdx.x; F.lane = F.tid & 63; F.wave = __builtin_amdgcn_readfirstlane(F.tid >> 6);
    F.G = gridDim.x; { const int bx = blockIdx.x; F.vcu = (F.G % 8 == 0) ? (bx % 8) * (F.G / 8) + bx / 8 : bx; }
    F.x = args.in[0]; F.c = args.in[1]; F.w_ada = args.in[2]; F.b_ada = args.in[3]; F.w_in = args.in[4]; F.sinks = args.in[5]; F.w_pool = args.in[6]; F.pool_scale = args.in[7];
    F.w_out = args.in[8]; F.ln1_g = args.in[9]; F.ln1_b = args.in[10]; F.w_pq = args.in[11]; F.k1 = args.in[12]; F.k2 = args.in[13]; F.pu = args.in[14]; F.pv = args.in[15];
    F.ln2_g = args.in[16]; F.ln2_b = args.in[17]; F.out = args.out; F.ws = args.ws;
    volatile LAS unsigned* MISC = (volatile LAS unsigned*)(F.lds + MISC_OFF);
    for (int u = F.tid; u < (LDS_BYTES - LDSCTL_OFF) / 4; u += NTHREADS) ((LAS unsigned*)(F.lds + LDSCTL_OFF))[u] = 0u;
    __syncthreads();
    const int lo = args.ph_lo, hi = args.ph_hi;
    XcdBarrier bar; bar.bar = (unsigned*)(F.ws + WS_CTL) + CW_BAR; bar.x = 0; bar.st = nullptr;
    if (hi - lo > 1) bar = xcd_barrier_post((unsigned*)(F.ws + WS_CTL) + CW_BAR, MISC + 8);
#ifndef PH_MASK
#define PH_MASK 0x1ff
#endif
#define IN(k) (((PH_MASK >> (k)) & 1) && lo <= (k) && (k) < hi)
#define SEAM(k) do { if (IN(k) && IN((k) + 1)) xcd_barrier(bar); } while (0)
#ifndef REP_MASK
#define REP_MASK 0
#endif
#ifndef REP_CNT
#define REP_CNT 4
#endif
#define REPS(k) (((REP_MASK >> (k)) & 1) * REP_CNT)
#define PHASE_NS(k, ...) if (IN(k)) { _Pragma("unroll 1") for (int _r = 0; _r <= REPS(k); ++_r) { __VA_ARGS__; if (_r < REPS(k)) xcd_barrier(bar); } }
#define PHASE(k, ...) if (IN(k)) { _Pragma("unroll 1") for (int _r = 0; _r <= REPS(k); ++_r) { __VA_ARGS__; if (_r < REPS(k)) xcd_barrier(bar); } } SEAM(k)
#ifndef P0_SUB
#define P0_SUB 0xff
#endif
    PHASE(0, p0_prologue(F, args.p0_parts));
    PHASE(2, { pg8::Gemm g{(const pg8::bf16_t*)(F.ws + WS_XN8), (const pg8::bf16_t*)(F.ws + WS_WIN), TT, NIN, DM / 2, 32, (size_t)NIN * DM, 0x79797979, 0x7F7F7F7F};    pg8::StaticOrder S; S.init(TT, NIN, F.G, (int)blockIdx.x);
            pg8::EpiRope E{(pg8::bf16_t*)(F.ws + WS_PROJ), NIN, (const float*)(F.ws + WS_ROPE), QSCALE, (const float*)(F.ws + WS_BIAS)};
            pg8::gemm_phase<pg8::EpiRope, pg8::StaticOrder, true, true, true>(F.lds, g, S, E);
            if ((args.p0_parts & 0x80) && (int)blockIdx.x >= 320 - F.G) p2_tables(F, ((int)blockIdx.x - (320 - F.G)) * NWAVES + F.wave, (2 * F.G - 320) * NWAVES, 0, 2 * NEXP); });
    PHASE(3, { for (int u = F.vcu; u < 256; u += F.G) { PoolRegs pr; KvRegs kv; p3_pool_load(F, u, pr); p3_attn_kvload(F, u, kv); p3_pool_compute(F, u, pr); p3_attn_unit(F, u, kv); } });
    PHASE(4, { pg8::Gemm g{(const pg8::bf16_t*)(F.ws + WS_A2), (const pg8::bf16_t*)(F.ws + WS_WOUT), TT, DM, DM / 2, 1 << 30, 0, 0x79797979, 0x7B7B7B7B}; pg8::StaticOrder S; S.init(TT, DM, F.G, (int)blockIdx.x);
            pg8::EpiPlain E{(pg8::bf16_t*)(F.ws + WS_MIX), DM};
            pg8::gemm_phase<pg8::EpiPlain, pg8::StaticOrder, true, true, true>(F.lds, g, S, E); });
    PHASE(5, p5_ln1(F));
    PHASE_NS(6, { pg8::Gemm g{(const pg8::bf16_t*)(F.ws + WS_H2Q), (const pg8::bf16_t*)(F.ws + WS_WPQ), TT, NQD, DM / 2, 1 << 30, 0, 0, 0}; pg8::StaticOrder S; S.init(TT, NQD, F.G, (int)blockIdx.x);
            pg8::EpiQ8 E{(pg8::bf16_t*)(F.ws + WS_Q), NQD, (const float*)(F.ws + WS_SH), (const float*)(F.ws + WS_SWQ)};
            pg8::gemm_phase<pg8::EpiQ8, pg8::StaticOrder, true, true, 2>(F.lds, g, S, E); });
    if (IN(6) && IN(7)) { asm volatile("s_waitcnt vmcnt(0)" ::: "memory"); __syncthreads(); }
    PHASE(7, p7_route(F));
#ifndef P8_FAKE
#define P8_FAKE 0xffffu
#endif
#ifndef P8_SKIP
#define P8_SKIP 0
#endif
    PHASE(8, p8_peer(F, _r == REPS(8) ? 0xffffu : P8_FAKE, _r == REPS(8) ? 0 : P8_SKIP));
#ifdef BAR_PROBE
    for (int i = 0; i < BAR_PROBE; ++i) xcd_barrier(bar);
#endif
#undef IN
#undef SEAM
}

extern "C" void kernel_launch(void* const* d_in, const int* in_sizes, int n_in, void* d_out, int out_size, void* d_ws, size_t ws_size, hipStream_t stream) {
    static int grid = 0;
    if (grid == 0) {
        if (n_in != 18 || out_size != TT * DM || ws_size < WS_END) { fprintf(stderr, "kernel_launch: unexpected shapes (n_in %d out %d ws %zu)\n", n_in, out_size, ws_size); grid = -1; return; }
        int dev = 0, cus = 0, per_cu = 0;
        if (hipGetDevice(&dev) != hipSuccess || hipDeviceGetAttribute(&cus, hipDeviceAttributeMultiprocessorCount, dev) != hipSuccess) { grid = -1; return; }
        if (hipFuncSetAttribute((const void*)fwd_kernel, hipFuncAttributeMaxDynamicSharedMemorySize, LDS_BYTES) != hipSuccess) { fprintf(stderr, "kernel_launch: hipFuncSetAttribute failed\n"); grid = -1; return; }
        if (hipOccupancyMaxActiveBlocksPerMultiprocessor(&per_cu, (const void*)fwd_kernel, NTHREADS, LDS_BYTES) != hipSuccess || per_cu < 1) { fprintf(stderr, "kernel_launch: occupancy query says %d blocks per CU\n", per_cu); }
        (void)hipGetLastError();
        grid = cus;
        if (grid != 256) fprintf(stderr, "kernel_launch: built for 256 CUs, got %d\n", grid);
    }
    if (grid < 0) return;
    (void)hipMemsetAsync((char*)d_ws + WS_CTL, 0, CTL_ZERO_BYTES, stream);
    Args a{};
    for (int i = 0; i < 18; ++i) a.in[i] = (const float*)d_in[i];
    a.out = (float*)d_out; a.ws = (unsigned char*)d_ws; a.p0_parts = 0xff;
#if MK_N_LAUNCHES == 1
    a.ph_lo = 0; a.ph_hi = N_PHASES;
    hipLaunchKernelGGL(fwd_kernel, dim3(grid), dim3(NTHREADS), LDS_BYTES, stream, a);
#ifdef PROBE_PHASE
    for (int i = 0; i < PROBE_N; ++i) { a.ph_lo = PROBE_PHASE; a.ph_hi = PROBE_PHASE + 1; a.p0_parts = PROBE_PARTS; hipLaunchKernelGGL(fwd_kernel, dim3(grid), dim3(NTHREADS), LDS_BYTES, stream, a); }
#endif
#else
    for (int p = 0; p < N_PHASES; ++p) { a.ph_lo = p; a.ph_hi = p + 1; hipLaunchKernelGGL(fwd_kernel, dim3(grid), dim3(NTHREADS), LDS_BYTES, stream, a); }
#endif
}
```

```cpp
#include <hip/hip_runtime.h>
#include <cstdio>
#include <cstdint>
#include <cmath>
namespace pg8 {
#define PG8_LAS __attribute__((address_space(3)))
typedef unsigned short bf16_t;
typedef short bf16x8 __attribute__((ext_vector_type(8)));
typedef float f32x4 __attribute__((ext_vector_type(4)));
typedef unsigned u32x4 __attribute__((ext_vector_type(4)));
constexpr int BM = 256, BK = 64, HALF = 128, HTB = HALF * BK * 2  , STAGE_BYTES = 8 * HTB, NXCD = 8, WGM = 8;

__host__ __device__ __forceinline__ int lds_byte(int r, int c) { const int st = (r >> 4) * 2 + (c >> 5), rr = r & 15, cc = c & 31, ob = rr * 64 + cc * 2; return st * 1024 + (ob ^ (((ob >> 9) & 1) << 5)); }
__host__ __device__ __forceinline__ void stage_rc(int b, int& R, int& C) { const int st = b / 1024, sb = b % 1024, swz = sb ^ (((sb >> 9) & 1) << 5); R = (st >> 1) * 16 + swz / 64; C = (st & 1) * 32 + (swz % 64) / 2; }
__host__ __device__ __forceinline__ int perm32(int rho) { const int n = rho >> 4, i = rho & 15; return 8 * (i >> 2) + 4 * n + (i & 3); }

struct Unit { int pm, pn; };
struct Gemm { const bf16_t* A; const bf16_t* Bt; int M, N, K; int bsplit; size_t bstride; int sc_w, sc_x; };

struct StaticOrder {
    int nM, nN, nwg, G, c;
    __host__ __device__ void init(int M, int N, int G_, int c_) { nM = M / BM; nN = N / BM; nwg = nM * nN; G = G_; c = c_; }
    __host__ __device__ bool next(int i, Unit& u) const {
        const long L = (long)i * G + c; if (L >= nwg) return false;
        int wgid = (int)L; { const int q = nwg / NXCD, r = nwg % NXCD, xcd = wgid % NXCD, off = wgid / NXCD; wgid = (xcd < r ? xcd * (q + 1) : r * (q + 1) + (xcd - r) * q) + off; }
        const int nig = WGM * nN, gid = wgid / nig, fm = gid * WGM, gsz = (nM - fm) < WGM ? (nM - fm) : WGM;
        u.pm = fm + ((wgid % nig) % gsz); u.pn = (wgid % nig) / gsz; return true;
    }
    __device__ __forceinline__ void a_ready(const Unit&) const {}
    __device__ __forceinline__ void done(const Unit&) const {}
};

__device__ __forceinline__ unsigned cvt_pk_bf16(float lo, float hi) { unsigned r; asm volatile("v_cvt_pk_bf16_f32 %0, %1, %2" : "=v"(r) : "v"(lo), "v"(hi)); return r; }

struct EpiPlain {
    static constexpr bool PERM = true, AFTER_DRAIN = false;
    unsigned char* O; int ldc; float scale;
    __device__ __forceinline__ void operator()(const f32x4 (&acc)[2][2][4][2], const Unit& u, int wr, int wc, int fr, int fq) const {
        const int row0 = u.pm * BM + wr * 64 + fr; const int col0 = u.pn * BM + wc * 32 + 8 * fq;
#pragma unroll
        for (int ai = 0; ai < 2; ++ai)
#pragma unroll
            for (int m = 0; m < 4; ++m) { unsigned char* rowp = O + (size_t)(row0 + ai * HALF + m * 16) * ldc + col0;
#pragma unroll
                for (int bj = 0; bj < 2; ++bj) { const f32x4 v0 = acc[ai][bj][m][0] * scale, v1 = acc[ai][bj][m][1] * scale;
                    int p0 = __builtin_amdgcn_cvt_pk_fp8_f32(v0[0], v0[1], 0, false); p0 = __builtin_amdgcn_cvt_pk_fp8_f32(v0[2], v0[3], p0, true);
                    int p1 = __builtin_amdgcn_cvt_pk_fp8_f32(v1[0], v1[1], 0, false); p1 = __builtin_amdgcn_cvt_pk_fp8_f32(v1[2], v1[3], p1, true);
                    typedef unsigned u32x2_ __attribute__((ext_vector_type(2)));
                    *(u32x2_*)(rowp + bj * HALF) = (u32x2_){(unsigned)p0, (unsigned)p1}; } }
    }
};
struct EpiRope {
    static constexpr bool PERM = true, AFTER_DRAIN = false;
    bf16_t* O; int ldc; const float* rope; float qscale; const float* bias;
    __device__ __forceinline__ void operator()(const f32x4 (&acc)[2][2][4][2], const Unit& u, int wr, int wc, int fr, int fq) const {
        const int row0 = u.pm * BM + wr * 64 + fr; const int col0 = u.pn * BM + wc * 32 + 8 * fq;
#pragma unroll
        for (int ai = 0; ai < 2; ++ai)
#pragma unroll
            for (int m = 0; m < 4; ++m) { const int row = row0 + ai * HALF + m * 16; bf16_t* rowp = O + (size_t)row * ldc + col0; const int pos = row & 8191;
#pragma unroll
                for (int bj = 0; bj < 2; ++bj) { const float* bp = bias + (size_t)(row >> 13) * ldc + col0 + bj * HALF;
                    f32x4 v0 = acc[ai][bj][m][0] + *(const f32x4*)bp, v1 = acc[ai][bj][m][1] + *(const f32x4*)(bp + 4);
                    const int colt = u.pn * BM + bj * HALF;
                    if (colt < 640) {
                        const int c = col0 + bj * HALF, ib = (c & 63) >> 1;
                        const f32x4 cs0 = *(const f32x4*)(rope + ((size_t)pos * 32 + ib) * 2), cs1 = *(const f32x4*)(rope + ((size_t)pos * 32 + ib) * 2 + 4);
                        const float sc = colt < 512 ? qscale : 1.0f;
                        f32x4 r0, r1;
                        r0[0] = (v0[0] * cs0[0] - v0[1] * cs0[1]) * sc; r0[1] = (v0[1] * cs0[0] + v0[0] * cs0[1]) * sc;
                        r0[2] = (v0[2] * cs0[2] - v0[3] * cs0[3]) * sc; r0[3] = (v0[3] * cs0[2] + v0[2] * cs0[3]) * sc;
                        r1[0] = (v1[0] * cs1[0] - v1[1] * cs1[1]) * sc; r1[1] = (v1[1] * cs1[0] + v1[0] * cs1[1]) * sc;
                        r1[2] = (v1[2] * cs1[2] - v1[3] * cs1[3]) * sc; r1[3] = (v1[3] * cs1[2] + v1[2] * cs1[3]) * sc;
                        v0 = r0; v1 = r1;
                    }
                    u32x4 w; w.x = cvt_pk_bf16(v0[0], v0[1]); w.y = cvt_pk_bf16(v0[2], v0[3]); w.z = cvt_pk_bf16(v1[0], v1[1]); w.w = cvt_pk_bf16(v1[2], v1[3]);
                    *(u32x4*)(rowp + bj * HALF) = w; } }
    }
};

struct EpiQ8 {
    static constexpr bool PERM = true, AFTER_DRAIN = false;
    bf16_t* O; int ldc; const float* rs; const float* cs;
    __device__ __forceinline__ void operator()(const f32x4 (&acc)[2][2][4][2], const Unit& u, int wr, int wc, int fr, int fq) const {
        typedef int i32x4_ __attribute__((ext_vector_type(4)));
        const int row0 = u.pm * BM + wr * 64 + fr; const int col0 = u.pn * BM + wc * 32 + 8 * fq;
        f32x4 cv[2][2];
#pragma unroll
        for (int bj = 0; bj < 2; ++bj) { cv[bj][0] = *(const f32x4*)(cs + col0 + bj * HALF); cv[bj][1] = *(const f32x4*)(cs + col0 + bj * HALF + 4); }
#pragma unroll
        for (int ai = 0; ai < 2; ++ai)
#pragma unroll
            for (int m = 0; m < 4; ++m) { const int row = row0 + ai * HALF + m * 16; bf16_t* rowp = O + (size_t)row * ldc + col0; const float rsc = rs[row];
#pragma unroll
                for (int bj = 0; bj < 2; ++bj) { const i32x4_ i0 = __builtin_bit_cast(i32x4_, acc[ai][bj][m][0]), i1 = __builtin_bit_cast(i32x4_, acc[ai][bj][m][1]);
                    const f32x4 v0 = __builtin_convertvector(i0, f32x4) * rsc * cv[bj][0], v1 = __builtin_convertvector(i1, f32x4) * rsc * cv[bj][1];
                    u32x4 w; w.x = cvt_pk_bf16(v0[0], v0[1]); w.y = cvt_pk_bf16(v0[2], v0[3]); w.z = cvt_pk_bf16(v1[0], v1[1]); w.w = cvt_pk_bf16(v1[2], v1[3]);
                    *(u32x4*)(rowp + bj * HALF) = w; } }
    }
};

template <class Epi, class Sched, bool ALIGN_EPI = false, bool SP2 = false, int MODE = 0>
__device__ __forceinline__ void gemm_phase(PG8_LAS unsigned char* lds, const Gemm g, const Sched& S, const Epi& E) {
    typedef int pg8_i32x4 __attribute__((ext_vector_type(4))); typedef int pg8_frag __attribute__((ext_vector_type(8)));
    const int tid = threadIdx.x, wid = __builtin_amdgcn_readfirstlane(tid >> 6), lane = tid & 63, wr = wid >> 2, wc = wid & 3, fr = lane & 15, fq = lane >> 4;
    const int K = g.K, nt = K / BK;
    unsigned voffA[2], voffB[2];
#pragma unroll
    for (int i = 0; i < 2; ++i) { int R, C; stage_rc(tid * 16 + i * 8192, R, C); const int Rb = Epi::PERM ? ((R & ~31) + perm32(R & 31)) : R;
        voffA[i] = (unsigned)(R * K + C) * 2u; voffB[i] = (unsigned)(Rb * K + C) * 2u; }
    const size_t kstep = (size_t)(BK * 2);
    const size_t hstep = (size_t)HALF * K * 2;
    const size_t tstep = 2 * hstep;
    const unsigned ldsw = (unsigned)wid * 1024u;
    const int aoff = lds_byte(wr * 64 + fr, fq * 8), boff = lds_byte(wc * 32 + fr, fq * 8);
#define PG8_SA(b, h) (((b) * 2 + (h)) * HTB)
#define PG8_SB(b, h) ((4 + (b) * 2 + (h)) * HTB)
#define PG8_STAGE(bufoff, gbase, voff) do { _Pragma("unroll") for (int _i = 0; _i < 2; ++_i) \
        __builtin_amdgcn_global_load_lds((const unsigned*)((const char*)(gbase) + (voff)[_i]), (PG8_LAS unsigned*)(lds + (bufoff) + ldsw + _i * 8192), 16, 0, 0); } while (0)
#define PG8_LDA(dst, b, h) do { _Pragma("unroll") for (int m = 0; m < 4; ++m) { const pg8_i32x4 l0_ = *(const PG8_LAS pg8_i32x4*)(lds + PG8_SA(b, h) + aoff + m * 2048), l1_ = *(const PG8_LAS pg8_i32x4*)(lds + PG8_SA(b, h) + aoff + m * 2048 + 1024); dst[m] = __builtin_shufflevector(l0_, l1_, 0, 1, 2, 3, 4, 5, 6, 7); } } while (0)
#define PG8_LDB(dst, b, h) do { _Pragma("unroll") for (int n = 0; n < 2; ++n) { const pg8_i32x4 l0_ = *(const PG8_LAS pg8_i32x4*)(lds + PG8_SB(b, h) + boff + n * 2048), l1_ = *(const PG8_LAS pg8_i32x4*)(lds + PG8_SB(b, h) + boff + n * 2048 + 1024); dst[n] = __builtin_shufflevector(l0_, l1_, 0, 1, 2, 3, 4, 5, 6, 7); } } while (0)
#define PG8_H0(f) __builtin_bit_cast(bf16x8, __builtin_shufflevector((f), (f), 0, 1, 2, 3))
#define PG8_H1(f) __builtin_bit_cast(bf16x8, __builtin_shufflevector((f), (f), 4, 5, 6, 7))
#define PG8_MMA(ai, bj, At, Bt) do { __builtin_amdgcn_s_setprio(1); \
        if constexpr (MODE == 2) { _Pragma("unroll") for (int m = 0; m < 4; ++m) _Pragma("unroll") for (int n = 0; n < 2; ++n) { \
            pg8_i32x4 c_ = __builtin_bit_cast(pg8_i32x4, acc[ai][bj][m][n]); \
            c_ = __builtin_amdgcn_mfma_i32_16x16x64_i8(__builtin_bit_cast(pg8_i32x4, PG8_H0(Bt[n])), __builtin_bit_cast(pg8_i32x4, PG8_H0(At[m])), c_, 0, 0, 0); \
            c_ = __builtin_amdgcn_mfma_i32_16x16x64_i8(__builtin_bit_cast(pg8_i32x4, PG8_H1(Bt[n])), __builtin_bit_cast(pg8_i32x4, PG8_H1(At[m])), c_, 0, 0, 0); \
            acc[ai][bj][m][n] = __builtin_bit_cast(f32x4, c_); } } \
        else if constexpr (MODE == 1) { _Pragma("unroll") for (int m = 0; m < 4; ++m) _Pragma("unroll") for (int n = 0; n < 2; ++n) \
            asm volatile("v_mfma_scale_f32_16x16x128_f8f6f4 %0, %1, %2, %0, %3, %4 op_sel_hi:[0,0,0]" : "+v"(acc[ai][bj][m][n]) : "v"(Bt[n]), "v"(At[m]), "v"(scw_), "v"(scx_)); } \
        else { _Pragma("unroll") for (int m = 0; m < 4; ++m) _Pragma("unroll") for (int n = 0; n < 2; ++n) { \
            acc[ai][bj][m][n] = __builtin_amdgcn_mfma_f32_16x16x32_bf16(PG8_H0(Bt[n]), PG8_H0(At[m]), acc[ai][bj][m][n], 0, 0, 0); \
            acc[ai][bj][m][n] = __builtin_amdgcn_mfma_f32_16x16x32_bf16(PG8_H1(Bt[n]), PG8_H1(At[m]), acc[ai][bj][m][n], 0, 0, 0); } } \
        __builtin_amdgcn_s_setprio(0); } while (0)
#define PG8_WAIT_V(n) asm volatile("s_waitcnt vmcnt(" #n ")" ::: "memory")
#define PG8_WAIT_L(n) asm volatile("s_waitcnt lgkmcnt(" #n ")" ::: "memory")
#define PG8_BAR __builtin_amdgcn_s_barrier()
#define PG8_SCHED __builtin_amdgcn_sched_barrier(0)
    Unit cur, nxt; int ui = 0;
    if (!S.next(0, cur)) return;
    f32x4 acc[2][2][4][2];
#pragma unroll
    for (int a = 0; a < 2; ++a)
#pragma unroll
        for (int b = 0; b < 2; ++b)
#pragma unroll
            for (int m = 0; m < 4; ++m)
#pragma unroll
                for (int n = 0; n < 2; ++n) acc[a][b][m][n] = (f32x4){0.f, 0.f, 0.f, 0.f};
    pg8_frag At[4], B0[2], B1[2]; const int scw_ = g.sc_w, scx_ = g.sc_x;
    const char* cA = (const char*)g.A + (size_t)cur.pm * tstep; const char* cB = (const char*)g.Bt + (size_t)cur.pn * tstep + (cur.pm >= g.bsplit ? g.bstride : (size_t)0);
    S.a_ready(cur);
    if constexpr (SP2) {
        PG8_STAGE(PG8_SB(0, 0), cB, voffB); PG8_STAGE(PG8_SB(0, 1), cB + hstep, voffB); PG8_STAGE(PG8_SA(0, 0), cA, voffA); PG8_STAGE(PG8_SA(0, 1), cA + hstep, voffA);
        if (wr == 1) PG8_BAR;
        PG8_WAIT_V(2); PG8_BAR;
        PG8_STAGE(PG8_SB(1, 0), cB + kstep, voffB); PG8_STAGE(PG8_SA(1, 0), cA + kstep, voffA); PG8_STAGE(PG8_SB(1, 1), cB + hstep + kstep, voffB);
        PG8_WAIT_V(6); PG8_BAR;
    } else {
        PG8_STAGE(PG8_SB(0, 0), cB, voffB); PG8_STAGE(PG8_SA(0, 0), cA, voffA); PG8_STAGE(PG8_SB(0, 1), cB + hstep, voffB); PG8_STAGE(PG8_SA(0, 1), cA + hstep, voffA);
        if (wr == 1) PG8_BAR;
        PG8_WAIT_V(4); PG8_BAR;
        PG8_STAGE(PG8_SB(1, 0), cB + kstep, voffB); PG8_STAGE(PG8_SA(1, 0), cA + kstep, voffA); PG8_STAGE(PG8_SB(1, 1), cB + hstep + kstep, voffB);
        PG8_WAIT_V(6); PG8_BAR;
    }
    for (;;) {
        const bool has_next = S.next(ui + 1, nxt);
        const char* nA = has_next ? (const char*)g.A + (size_t)nxt.pm * tstep : cA; const char* nB = has_next ? (const char*)g.Bt + (size_t)nxt.pn * tstep + (nxt.pm >= g.bsplit ? g.bstride : (size_t)0) : cB;
        _Pragma("unroll 1") for (int t = 0; t < nt; t += 2) {
            const bool last = (t == nt - 2);
            const char* a1 = cA + (size_t)(t + 1) * kstep;
            const char* a2 = last ? nA : cA + (size_t)(t + 2) * kstep; const char* b2 = last ? nB : cB + (size_t)(t + 2) * kstep;
            const char* a3 = a2 + kstep; const char* b3 = b2 + kstep;
            if (last && has_next) S.a_ready(nxt);
            if constexpr (SP2) {
            PG8_LDB(B0, 0, 0); PG8_LDB(B1, 0, 1); PG8_SCHED; PG8_LDA(At, 0, 0); PG8_STAGE(PG8_SA(1, 1), a1 + hstep, voffA);
            PG8_WAIT_V(8); PG8_WAIT_L(0); PG8_BAR; PG8_MMA(0, 0, At, B0); PG8_MMA(0, 1, At, B1); PG8_BAR; PG8_SCHED;
            PG8_LDA(At, 0, 1); PG8_STAGE(PG8_SB(0, 0), b2, voffB); PG8_STAGE(PG8_SB(0, 1), b2 + hstep, voffB); PG8_STAGE(PG8_SA(0, 0), a2, voffA);
            PG8_WAIT_V(8); PG8_WAIT_L(0); PG8_BAR; PG8_MMA(1, 0, At, B0); PG8_MMA(1, 1, At, B1); PG8_BAR; PG8_SCHED;
            PG8_LDB(B0, 1, 0); PG8_LDB(B1, 1, 1); PG8_SCHED; PG8_LDA(At, 1, 0); PG8_STAGE(PG8_SA(0, 1), a2 + hstep, voffA);
            PG8_WAIT_V(8); PG8_WAIT_L(0); PG8_BAR; PG8_MMA(0, 0, At, B0); PG8_MMA(0, 1, At, B1); PG8_BAR; PG8_SCHED;
            PG8_LDA(At, 1, 1); PG8_STAGE(PG8_SB(1, 0), b3, voffB); PG8_STAGE(PG8_SB(1, 1), b3 + hstep, voffB); PG8_STAGE(PG8_SA(1, 0), a3, voffA);
            PG8_WAIT_V(8); PG8_WAIT_L(0); PG8_BAR; PG8_MMA(1, 0, At, B0); PG8_MMA(1, 1, At, B1); PG8_BAR; PG8_SCHED;
            } else {
            PG8_LDB(B0, 0, 0); PG8_SCHED; PG8_LDA(At, 0, 0); PG8_STAGE(PG8_SA(1, 1), a1 + hstep, voffA);
            PG8_WAIT_L(8); PG8_BAR; PG8_WAIT_L(0); PG8_MMA(0, 0, At, B0); PG8_BAR; PG8_SCHED;
            PG8_LDB(B1, 0, 1); PG8_STAGE(PG8_SB(0, 0), b2, voffB);
            PG8_BAR; PG8_WAIT_L(0); PG8_MMA(0, 1, At, B1); PG8_BAR;
            PG8_LDA(At, 0, 1); PG8_STAGE(PG8_SA(0, 0), a2, voffA);
            PG8_BAR; PG8_WAIT_L(0); PG8_MMA(1, 0, At, B0); PG8_BAR; PG8_SCHED;
            PG8_STAGE(PG8_SB(0, 1), b2 + hstep, voffB);
            PG8_WAIT_V(6); PG8_BAR; PG8_MMA(1, 1, At, B1); PG8_BAR;
            PG8_LDB(B0, 1, 0); PG8_SCHED; PG8_LDA(At, 1, 0); PG8_STAGE(PG8_SA(0, 1), a2 + hstep, voffA);
            PG8_WAIT_L(8); PG8_BAR; PG8_WAIT_L(0); PG8_MMA(0, 0, At, B0); PG8_BAR; PG8_SCHED;
            PG8_LDB(B1, 1, 1); PG8_STAGE(PG8_SB(1, 0), b3, voffB);
            PG8_BAR; PG8_WAIT_L(0); PG8_MMA(0, 1, At, B1); PG8_BAR;
            PG8_LDA(At, 1, 1); PG8_STAGE(PG8_SA(1, 0), a3, voffA);
            PG8_BAR; PG8_WAIT_L(0); PG8_MMA(1, 0, At, B0); PG8_BAR; PG8_SCHED;
            PG8_STAGE(PG8_SB(1, 1), b3 + hstep, voffB);
            PG8_WAIT_V(6); PG8_BAR; PG8_MMA(1, 1, At, B1); PG8_BAR;
            }
        }
        if constexpr (ALIGN_EPI) { if (wr == 0) PG8_BAR; }
        if constexpr (MODE == 1) {
            asm volatile("s_nop 15\n\ts_nop 15" ::: "memory");
#pragma unroll
            for (int a = 0; a < 2; ++a)
#pragma unroll
                for (int b = 0; b < 2; ++b)
#pragma unroll
                    for (int m = 0; m < 4; ++m)
#pragma unroll
                        for (int n = 0; n < 2; ++n) asm volatile("" : "+v"(acc[a][b][m][n]));
        }
        if constexpr (!Epi::AFTER_DRAIN) { E(acc, cur, wr, wc, fr, fq); S.done(cur); }
        if (!has_next) break;
#pragma unroll
        for (int a = 0; a < 2; ++a)
#pragma unroll
            for (int b = 0; b < 2; ++b)
#pragma unroll
                for (int m = 0; m < 4; ++m)
#pragma unroll
                    for (int n = 0; n < 2; ++n) acc[a][b][m][n] = (f32x4){0.f, 0.f, 0.f, 0.f};
        cur = nxt; cA = nA; cB = nB; ++ui;
        if constexpr (ALIGN_EPI) { if (wr == 1) PG8_BAR; }
    }
    PG8_WAIT_V(0);
    if constexpr (!ALIGN_EPI) { if (wr == 0) PG8_BAR; }
    PG8_BAR;
    if constexpr (Epi::AFTER_DRAIN) { E.fused(acc, cur, wr, wc, fr, fq, lds, wid, lane); S.done(cur); }
#undef PG8_SA
#undef PG8_SB
#undef PG8_STAGE
#undef PG8_LDA
#undef PG8_LDB
#undef PG8_MMA
#undef PG8_H0
#undef PG8_H1
#undef PG8_WAIT_V
#undef PG8_WAIT_L
#undef PG8_BAR
#undef PG8_SCHED
}
}
#define GAS __attribute__((address_space(1)))
#define LAS __attribute__((address_space(3)))
typedef unsigned short bf16;
typedef unsigned v4u __attribute__((ext_vector_type(4)));
typedef float f32x4 __attribute__((ext_vector_type(4)));
typedef short bf16x8 __attribute__((ext_vector_type(8)));
typedef GAS unsigned gu32;
typedef GAS unsigned long long gu64;
#define RLX_AGENT __ATOMIC_RELAXED, __HIP_MEMORY_SCOPE_AGENT
#define LDS_WAIT() asm volatile("s_waitcnt lgkmcnt(0)" ::: "memory")
#define VM_WAIT() asm volatile("s_waitcnt vmcnt(0)" ::: "memory")
__device__ __forceinline__ unsigned long long rt() { return __builtin_amdgcn_s_memrealtime(); }
__device__ __forceinline__ unsigned f2bf(float f) { unsigned u = __builtin_bit_cast(unsigned, f); return (u + 0x7fffu + ((u >> 16) & 1u)) >> 16; }
__device__ __forceinline__ unsigned pk2(float lo, float hi) { return f2bf(lo) | (f2bf(hi) << 16); }
#define XB_TMO      128
#define XB_XCNT(j)  (256  + 64 * (j))
#define XB_XSUB(j)  (1280 + 64 * (j))
#define XB_XGEN(j)  (2304 + 64 * (j))
#define XB_TOP      3328
#define XB_TOPGEN   3392
#define XCD_BAR_WORDS 3456
#define XB_SPIN_CAP (1u << 18)

__device__ __forceinline__ unsigned xb_ld(unsigned* p)              { return __hip_atomic_load(p, __ATOMIC_RELAXED, __HIP_MEMORY_SCOPE_AGENT); }
__device__ __forceinline__ unsigned xb_add(unsigned* p, unsigned v) { return __hip_atomic_fetch_add(p, v, __ATOMIC_RELAXED, __HIP_MEMORY_SCOPE_AGENT); }
__device__ __forceinline__ unsigned xb_xcc_id() { return (unsigned)__builtin_amdgcn_s_getreg((3 << 11) | 20) & 0xFu; }
#define XB_SPIN(cond, bar) do { unsigned _sp = 0; while (cond) { __builtin_amdgcn_s_sleep(1); \
    if ((++_sp & 255u) == 0u) { if (xb_ld(&(bar)[XB_TMO])) break; if (_sp > XB_SPIN_CAP) { atomicAdd(&(bar)[XB_TMO], 1u); break; } } } } while (0)

struct XcdBarrier {
    unsigned* bar; unsigned x;
    volatile LAS unsigned* st;
};

__device__ __forceinline__ XcdBarrier xcd_barrier_post(unsigned* bar, volatile LAS unsigned* st) {
    XcdBarrier b; b.bar = bar; b.x = xb_xcc_id(); b.st = st;
    if (threadIdx.x == 0) (void)xb_add(&bar[XB_XCNT(b.x)], 1u);
    return b;
}
__device__ __forceinline__ void xcd_barrier_complete(unsigned* bar, unsigned x, unsigned& nloc, unsigned& nx) {
    const unsigned G = gridDim.x * gridDim.y * gridDim.z;
    unsigned sum, cnt, mine, sp = 0u;
    for (;;) {
        sum = 0u; cnt = 0u; mine = 0u;
#pragma unroll
        for (unsigned j = 0; j < 16; ++j) { const unsigned c = xb_ld(&bar[XB_XCNT(j)]); sum += c; cnt += (c > 0u) ? 1u : 0u; mine = (j == x) ? c : mine; }
        if (sum == G) break;
        __builtin_amdgcn_s_sleep(1);
        if ((++sp & 255u) == 0u) { if (xb_ld(&bar[XB_TMO])) break; if (sp > XB_SPIN_CAP) { atomicAdd(&bar[XB_TMO], 1u); break; } }
    }
    nloc = mine > 0u ? mine : 1u; nx = cnt > 0u ? cnt : 1u;
}

__device__ __forceinline__ void xcd_barrier(const XcdBarrier& b) {
    asm volatile("s_waitcnt vmcnt(0)" ::: "memory");
    __syncthreads();
    if (threadIdx.x == 0) {
        unsigned* bar = b.bar;
        __builtin_amdgcn_s_waitcnt(0);
        unsigned nloc = b.st[0], nx = b.st[1];
        if (nloc == 0u) { xcd_barrier_complete(bar, b.x, nloc, nx); b.st[0] = nloc; b.st[1] = nx; }
        asm volatile("buffer_inv sc1" ::: "memory");
        const unsigned old = xb_add(&bar[XB_XSUB(b.x)], 1u);
        const unsigned gen = old / nloc;
        if (old + 1u == (gen + 1u) * nloc) {
            __builtin_amdgcn_fence(__ATOMIC_RELEASE, "agent");
            asm volatile("s_waitcnt vmcnt(0)" ::: "memory");
            const unsigned og = xb_add(&bar[XB_TOP], 1u);
            const unsigned tg = og / nx;
            if (og + 1u == (tg + 1u) * nx) xb_add(&bar[XB_TOPGEN], 1u);
            else XB_SPIN(xb_ld(&bar[XB_TOPGEN]) == tg, bar);
            xb_add(&bar[XB_XGEN(b.x)], 1u);
            asm volatile("s_waitcnt vmcnt(0)" ::: "memory");
        } else {
            XB_SPIN(xb_ld(&bar[XB_XGEN(b.x)]) == gen, bar);
            asm volatile("s_waitcnt vmcnt(0)" ::: "memory");
        }
    }
    __syncthreads();
}
__device__ __forceinline__ void grp_barrier(unsigned* cnt, unsigned target, unsigned* bar, bool light, unsigned* cnt2 = nullptr, unsigned target2 = 0u, bool noacq = false) {
    asm volatile("s_waitcnt vmcnt(0)" ::: "memory");
    __syncthreads();
    if (threadIdx.x == 0) {
        __builtin_amdgcn_s_waitcnt(0);
        if (!light) { __builtin_amdgcn_fence(__ATOMIC_RELEASE, "agent");
            asm volatile("s_waitcnt vmcnt(0)" ::: "memory"); }
        const bool acq = !(light && noacq);
        if (acq) asm volatile("buffer_inv sc1" ::: "memory");
        (void)xb_add(cnt, 1u);
        XB_SPIN(xb_ld(cnt) < target, bar);
        if (cnt2) XB_SPIN(xb_ld(cnt2) < target2, bar);
        if (acq) asm volatile("s_waitcnt vmcnt(0)" ::: "memory");
    }
    __syncthreads();
}
constexpr int NWAVES = 8, NTHREADS = 512;
constexpr int TT = 16384, DM = 1024, SEQ = 8192, NIN = 1280, NQD = 2048, NEXP = 16384;
constexpr float DN_ALPHA = 1.189207115002721f;
constexpr float LN_EPS = 1e-5f;
constexpr float MIX_SCALE = 8.0f;
constexpr float LOG2E = 1.4426950408889634f;
constexpr float QSCALE = 0.125f * LOG2E;

constexpr size_t MiB = 1u << 20;
constexpr size_t WS_CTL = 0, CTL_ZERO_BYTES = 64 * 1024;
constexpr size_t WS_MODP = 1 * MiB;
constexpr size_t WS_MOD = 1 * MiB + 896 * 1024;
constexpr size_t WS_ROPE = 2 * MiB;
constexpr size_t WS_WIN = 248 * MiB;
constexpr size_t WS_BIAS = 4 * MiB;
constexpr size_t WS_K1 = 6 * MiB + 512 * 1024, WS_K2 = WS_K1 + 32 * 1024;
constexpr size_t WS_WOUT = 7 * MiB;
constexpr size_t WS_WPQ = 9 * MiB;
constexpr size_t WS_SWQ = 13 * MiB + 262144;
constexpr size_t WS_SU = 13 * MiB, WS_SV = 13 * MiB + 65536;
constexpr size_t WS_U = 16 * MiB, WS_V = 32 * MiB;
constexpr size_t WS_H2Q = 48 * MiB, WS_SH = 13 * MiB + 131072, WS_SX = 13 * MiB + 393216, WS_SXN = 13 * MiB + 524288;
constexpr size_t WS_XN8 = 64 * MiB;
constexpr size_t WS_XN = 80 * MiB;
constexpr size_t WS_MIX = 64 * MiB;
constexpr size_t WS_PE = 248 * MiB  , WS_PG = 96 * MiB;
constexpr size_t WS_PROJ = 112 * MiB;
constexpr size_t WS_A2 = 152 * MiB;
constexpr size_t WS_X1 = 168 * MiB;
constexpr size_t WS_Q = 184 * MiB;
constexpr size_t WS_END = 253 * MiB;
constexpr int CW_MODCNT = 1024;
constexpr int CW_GRP = 8192;
constexpr int CW_TBL = 1088;
constexpr int TB_SPLIT = 12288;
constexpr int CW_BAR = 4096;

constexpr int RING_BYTES = 131072, LDSCTL_OFF = RING_BYTES, MISC_OFF = LDSCTL_OFF + 320, LDS_BYTES = 147456;

typedef float f32x16 __attribute__((ext_vector_type(16)));
typedef float f32x2 __attribute__((ext_vector_type(2)));
typedef unsigned u32x2 __attribute__((ext_vector_type(2)));
typedef unsigned u32x4 __attribute__((ext_vector_type(4)));
typedef __bf16 bf16x2_t __attribute__((ext_vector_type(2)));
struct Frame {
    LAS unsigned char* lds;
    int tid, lane, wave, vcu, gcu, G;
    const float *x, *c, *w_ada, *b_ada, *w_in, *sinks, *w_pool, *pool_scale, *w_out, *ln1_g, *ln1_b, *w_pq, *k1, *k2, *pu, *pv, *ln2_g, *ln2_b;
    float* out; unsigned char* ws;
};
#define DPPF(v_, ctrl_) __builtin_bit_cast(float, __builtin_amdgcn_update_dpp(0, __builtin_bit_cast(int, (v_)), (ctrl_), 0xF, 0xF, true))
__device__ __forceinline__ float wave_sum(float v) {
    v += DPPF(v, 0xB1); v += DPPF(v, 0x4E); v += DPPF(v, 0x141); v += DPPF(v, 0x140);
    { const unsigned u_ = __builtin_bit_cast(unsigned, v); auto r_ = __builtin_amdgcn_permlane16_swap(u_, u_, false, false); v = __builtin_bit_cast(float, (unsigned)r_[0]) + __builtin_bit_cast(float, (unsigned)r_[1]); }
    { const unsigned u_ = __builtin_bit_cast(unsigned, v); auto r_ = __builtin_amdgcn_permlane32_swap(u_, u_, false, false); v = __builtin_bit_cast(float, (unsigned)r_[0]) + __builtin_bit_cast(float, (unsigned)r_[1]); }
    return v; }
__device__ __forceinline__ float wave_max(float v) {
    v = fmaxf(v, DPPF(v, 0xB1)); v = fmaxf(v, DPPF(v, 0x4E)); v = fmaxf(v, DPPF(v, 0x141)); v = fmaxf(v, DPPF(v, 0x140));
    { const unsigned u_ = __builtin_bit_cast(unsigned, v); auto r_ = __builtin_amdgcn_permlane16_swap(u_, u_, false, false); v = fmaxf(__builtin_bit_cast(float, (unsigned)r_[0]), __builtin_bit_cast(float, (unsigned)r_[1])); }
    { const unsigned u_ = __builtin_bit_cast(unsigned, v); auto r_ = __builtin_amdgcn_permlane32_swap(u_, u_, false, false); v = fmaxf(__builtin_bit_cast(float, (unsigned)r_[0]), __builtin_bit_cast(float, (unsigned)r_[1])); }
    return v; }
__device__ __forceinline__ float bf_lo(unsigned u) { return __uint_as_float(u << 16); }
__device__ __forceinline__ float bf_hi(unsigned u) { return __uint_as_float(u & 0xffff0000u); }
__device__ __forceinline__ float bf2f(bf16 b) { return __uint_as_float((unsigned)b << 16); }
__device__ __forceinline__ unsigned q8x4(float a, float b, float c, float d, float scale, float magic) {
    const unsigned y0 = __builtin_bit_cast(unsigned, __builtin_fmaf(a, scale, magic)), y1 = __builtin_bit_cast(unsigned, __builtin_fmaf(b, scale, magic)),
                   y2 = __builtin_bit_cast(unsigned, __builtin_fmaf(c, scale, magic)), y3 = __builtin_bit_cast(unsigned, __builtin_fmaf(d, scale, magic));
    const unsigned t01 = __builtin_amdgcn_perm(y1, y0, 0x0c0c0400u), t23 = __builtin_amdgcn_perm(y3, y2, 0x0c0c0400u);
    return __builtin_amdgcn_perm(t23, t01, 0x05040100u); }
constexpr float Q8_MAGIC = 12582912.0f;
__device__ __forceinline__ void st_wt_f32(float* p, float v) { asm volatile("global_store_dword %0, %1, off sc0 sc1" :: "v"(p), "v"(v) : "memory"); }
__device__ __forceinline__ unsigned fp8x4(float a, float b, float c, float d) { int pk = __builtin_amdgcn_cvt_pk_fp8_f32(a, b, 0, false); pk = __builtin_amdgcn_cvt_pk_fp8_f32(c, d, pk, true); return (unsigned)pk; }

template <int MODE, bool OUT8 = false>
__device__ __forceinline__ void transpose_item(const float* W, int ldw, bf16* WT, int ldt, int k0, int n0, LAS float* scr, int lane, const LAS float* ksc = nullptr, float oscale = 1.0f) {
    int nsrc = n0 + (lane & 31);
    if (MODE == 1 && nsrc < 640) { const int hd = nsrc >> 6, w = nsrc & 63; nsrc = hd * 64 + (w >> 1) + 32 * (w & 1); }
    float wv[32];
#pragma unroll
    for (int i = 0; i < 32; ++i) wv[i] = W[(size_t)(k0 + 2 * i + (lane >> 5)) * ldw + nsrc];
    __builtin_amdgcn_sched_barrier(0);
#pragma unroll
    for (int i = 0; i < 32; ++i) { const int kk = 2 * i + (lane >> 5); float w_ = wv[i]; if (MODE == 1) w_ *= ksc[k0 + kk]; scr[kk * 33 + (lane & 31)] = w_; }
    LDS_WAIT(); asm volatile("" ::: "memory");
    const int c = lane & 7;
#pragma unroll
    for (int j = 0; j < 4; ++j) { const int n = (lane >> 3) + 8 * j; const LAS float* s = scr + (8 * c) * 33 + n;
        if (OUT8) { u32x2 o8; o8.x = fp8x4(s[0 * 33] * oscale, s[1 * 33] * oscale, s[2 * 33] * oscale, s[3 * 33] * oscale); o8.y = fp8x4(s[4 * 33] * oscale, s[5 * 33] * oscale, s[6 * 33] * oscale, s[7 * 33] * oscale);
            *(u32x2*)((unsigned char*)WT + (size_t)(n0 + n) * ldt + k0 + 8 * c) = o8; }
        else { v4u o; o.x = pk2(s[0 * 33], s[1 * 33]); o.y = pk2(s[2 * 33], s[3 * 33]); o.z = pk2(s[4 * 33], s[5 * 33]); o.w = pk2(s[6 * 33], s[7 * 33]);
            *(GAS v4u*)(WT + (size_t)(n0 + n) * ldt + k0 + 8 * c) = o; } }
    LDS_WAIT(); asm volatile("" ::: "memory");
}
__device__ __forceinline__ void transpose_item_q8(const float* W, int ldw, unsigned char* WT, int k0, int n0, LAS float* scr, int lane, const float* inv) {
    const int nsrc = n0 + (lane & 31);
    float wv[32];
#pragma unroll
    for (int i = 0; i < 32; ++i) wv[i] = W[(size_t)(k0 + 2 * i + (lane >> 5)) * ldw + nsrc];
    __builtin_amdgcn_sched_barrier(0);
#pragma unroll
    for (int i = 0; i < 32; ++i) scr[(2 * i + (lane >> 5)) * 33 + (lane & 31)] = wv[i];
    LDS_WAIT(); asm volatile("" ::: "memory");
    const int c = lane & 7;
#pragma unroll
    for (int j = 0; j < 4; ++j) { const int n = (lane >> 3) + 8 * j; const LAS float* s = scr + (8 * c) * 33 + n; const float iv = inv[n0 + n];
        unsigned w[2];
#pragma unroll
        for (int hf = 0; hf < 2; ++hf) { unsigned o = 0u;
#pragma unroll
            for (int e = 0; e < 4; ++e) { int q = (int)rintf(s[(4 * hf + e) * 33] * iv); q = q < -127 ? -127 : (q > 127 ? 127 : q); o |= (unsigned)(q & 255) << (8 * e); }
            w[hf] = o; }
        const int d0 = k0 + 8 * c, jq = d0 >> 8, l0 = (d0 & 255) >> 2;
        unsigned char* rowp = WT + (size_t)(n0 + n) * DM;
        *(unsigned*)(rowp + 16 * l0 + 4 * jq) = w[0]; *(unsigned*)(rowp + 16 * (l0 + 1) + 4 * jq) = w[1]; }
    LDS_WAIT(); asm volatile("" ::: "memory");
}
__device__ __forceinline__ void rope_sincos(int pos, int i, float& s, float& c) {
    constexpr float GH[32] = {1.591796875e-01f, 1.193237305e-01f, 8.947753906e-02f, 6.713867188e-02f, 5.032348633e-02f, 3.775024414e-02f, 2.830505371e-02f, 2.122497559e-02f, 1.591491699e-02f, 1.193237305e-02f, 8.949279785e-03f, 6.710052490e-03f, 5.031585693e-03f, 3.774642944e-03f, 2.830505371e-03f, 2.122879028e-03f, 1.591682434e-03f, 1.193046570e-03f, 8.950233459e-04f, 6.713867188e-04f, 5.030632019e-04f, 3.774166107e-04f, 2.830028534e-04f, 2.121925354e-04f, 1.591444016e-04f, 1.193284988e-04f, 8.952617645e-05f, 6.711483002e-05f, 5.033612251e-05f, 3.772974014e-05f, 2.829730511e-05f, 2.121925354e-05f};
    constexpr float GL[32] = {-2.474440771e-05f, 2.563974340e-05f, 2.186254642e-05f, -2.358886923e-05f, 5.725776191e-06f, -8.659423656e-06f, -2.857880418e-06f, -1.322821163e-06f, 5.773169960e-07f, 2.563974249e-06f, 6.603757470e-07f, 1.455810320e-06f, 1.335517140e-06f, -4.844725936e-07f, -2.857880190e-07f, -5.137518428e-07f, -1.330031694e-07f, 4.471322939e-07f, -2.932985765e-08f, -2.358886917e-07f, 2.289191343e-07f, -7.635435617e-10f, 1.910491321e-08f, 4.399224807e-08f, 1.054154186e-08f, 2.087137041e-08f, -2.677484368e-08f, 2.529881304e-10f, -6.910408246e-09f, 1.184457421e-08f, 4.890723382e-09f, 4.399224540e-09f};
    const float p = (float)pos, th = p * GH[i], tl = p * GL[i];
    const float t = __builtin_amdgcn_fractf(__builtin_amdgcn_fractf(th) + tl);
    s = __builtin_amdgcn_sinf(t); c = __builtin_amdgcn_cosf(t); }
__device__ __forceinline__ void sincos_d(double a, float& s, float& c) {
    const double TWO_PI = 6.283185307179586476925, PI = 3.141592653589793238462643;
    double r = a - TWO_PI * rint(a / TWO_PI);
    double sg = 1.0;
    if (r > 0.5 * PI) { r = PI - r; sg = -1.0; } else if (r < -0.5 * PI) { r = -PI - r; sg = -1.0; }
    const double r2 = r * r;
    double sp = -1.0 / 121645100408832000.0;
    sp = sp * r2 + 1.0 / 355687428096000.0; sp = sp * r2 - 1.0 / 1307674368000.0; sp = sp * r2 + 1.0 / 6227020800.0; sp = sp * r2 - 1.0 / 39916800.0;
    sp = sp * r2 + 1.0 / 362880.0; sp = sp * r2 - 1.0 / 5040.0; sp = sp * r2 + 1.0 / 120.0; sp = sp * r2 - 1.0 / 6.0; sp = sp * r2 + 1.0;
    double cp = 1.0 / 6402373705728000.0;
    cp = cp * r2 - 1.0 / 20922789888000.0; cp = cp * r2 + 1.0 / 87178291200.0; cp = cp * r2 - 1.0 / 479001600.0; cp = cp * r2 + 1.0 / 3628800.0;
    cp = cp * r2 - 1.0 / 40320.0; cp = cp * r2 + 1.0 / 720.0; cp = cp * r2 - 1.0 / 24.0; cp = cp * r2 + 0.5; cp = 1.0 - cp * r2;
    s = (float)(sp * r); c = (float)(sg * cp);
}
__device__ __forceinline__ void p1_win(Frame& F);
__device__ __forceinline__ void p0_prologue(Frame& F, int parts, int gw, int NGW) {
    LAS float* scr = (LAS float*)(F.lds + F.wave * 16384);
    const int lane = F.lane;
    if ((parts & 1) && (int)blockIdx.x < 192) { const int gb = (int)blockIdx.x, chunk = gb % 96, kh = gb / 96, col = chunk * 64 + lane, kbase = kh * 512 + F.wave * 64; float a0 = 0.f, a1 = 0.f;
        LAS float* sl = (LAS float*)(F.lds + F.wave * 16384 + 8448);
        { const int k = kbase + lane; const float c0 = F.c[k], c1 = F.c[DM + k]; sl[lane] = c0 / (1.f + __expf(-c0)); sl[64 + lane] = c1 / (1.f + __expf(-c1)); }
        LDS_WAIT(); asm volatile("" ::: "memory");
        { float w[64];
#pragma unroll
            for (int u = 0; u < 64; ++u) w[u] = __builtin_nontemporal_load(F.w_ada + (size_t)(kbase + u) * 6144 + col);
            __builtin_amdgcn_sched_barrier(0);
#pragma unroll
            for (int u = 0; u < 64; ++u) { a0 += sl[u] * w[u]; a1 += sl[64 + u] * w[u]; } }
        LAS float* red = (LAS float*)(F.lds + F.wave * 16384 + 12288); red[lane] = a0; red[64 + lane] = a1;
        __syncthreads();
        if (F.tid < 128) { const int bb = F.tid >> 6, l = F.tid & 63; float sacc = kh == 0 ? F.b_ada[chunk * 64 + l] : 0.f;
#pragma unroll
            for (int w = 0; w < 8; ++w) sacc += ((const LAS float*)(F.lds + w * 16384 + 12288))[bb * 64 + l];
            st_wt_f32((float*)(F.ws + WS_MODP) + (kh * 2 + bb) * 6144 + chunk * 64 + l, sacc); }
        asm volatile("s_waitcnt vmcnt(0)" ::: "memory"); __syncthreads();
        if (F.tid == 0) {
            __hip_atomic_fetch_add((unsigned*)(F.ws + WS_CTL) + CW_MODCNT, 1u, __ATOMIC_RELAXED, __HIP_MEMORY_SCOPE_AGENT); } }
    if ((parts & 1) && (int)blockIdx.x >= 192 && (int)blockIdx.x < 224) { const int chunk = (int)blockIdx.x - 192, col = chunk * 64 + lane; float am = 0.f;
#pragma unroll 1
        for (int kb = 0; kb < 128; kb += 64) { float w[64];
#pragma unroll
            for (int u = 0; u < 64; ++u) w[u] = F.w_pq[(size_t)(F.wave * 128 + kb + u) * NQD + col];
            __builtin_amdgcn_sched_barrier(0);
#pragma unroll
            for (int u = 0; u < 64; ++u) am = fmaxf(am, fabsf(w[u])); }
        LAS float* red = (LAS float*)(F.lds + F.wave * 16384 + 12288); red[lane] = am;
        __syncthreads();
        if (F.tid < 64) { float a = 0.f;
#pragma unroll
            for (int w = 0; w < 8; ++w) a = fmaxf(a, ((const LAS float*)(F.lds + w * 16384 + 12288))[F.tid]);
            if (a == 0.f) a = 1.f;
            st_wt_f32((float*)(F.ws + WS_SWQ) + chunk * 64 + F.tid, a * (1.0f / 127.0f)); st_wt_f32((float*)(F.ws + WS_SWQ) + NQD + chunk * 64 + F.tid, 127.0f / a); }
        asm volatile("s_waitcnt vmcnt(0)" ::: "memory"); __syncthreads();
        if (F.tid == 0) {
            __hip_atomic_fetch_add((unsigned*)(F.ws + WS_CTL) + CW_MODCNT, 1u, __ATOMIC_RELAXED, __HIP_MEMORY_SCOPE_AGENT); } }
    if (parts & 2) { float* rope = (float*)(F.ws + WS_ROPE);
      for (int e = gw * 64 + lane; e < SEQ * 32; e += NGW * 64) { const int pos = e >> 5, i = e & 31;
          float s, c; rope_sincos(pos, i, s, c);
          rope[2 * e] = c; rope[2 * e + 1] = s; } }
    if (parts & 4) { constexpr int I_OUT = 8 * 32;
      for (int it = NGW - 1 - gw; it < I_OUT; it += NGW) { const int r = it;
          transpose_item<0, true>(F.w_out, DM, (bf16*)(F.ws + WS_WOUT), DM, 64 * (r / 32), 32 * (r % 32), scr, lane, nullptr, 64.0f); } }
    if (parts & 8) { unsigned char* wout_t = F.ws + WS_WOUT;
      for (int it = gw; it < 4 * 2 * 128; it += NGW) { const int g = it >> 8, ch = (it >> 7) & 1, n0 = (it & 127) * 8, cidx = ch * 64 + lane;
          const float* wo = F.w_out + (size_t)(512 + g * 128) * DM + n0; const float* ps = F.pool_scale + g * 128;
#pragma unroll
          for (int i = 0; i < 4; ++i) { const int f4 = lane + 64 * i, e = f4 >> 1, hf = f4 & 1; const f32x4 o = *(const f32x4*)(wo + (size_t)e * DM + 4 * hf) * ps[e]; *(LAS f32x4*)(scr + e * 8 + 4 * hf) = o; }
          float acc[8];
#pragma unroll
          for (int i = 0; i < 8; ++i) acc[i] = 0.f;
          const float* wp = F.w_pool + ((size_t)(g * 128 + cidx)) * 128;
          LDS_WAIT(); asm volatile("" ::: "memory");
#pragma unroll 1
          for (int e0 = 0; e0 < 128; e0 += 64) { f32x4 wv[16];
#pragma unroll
              for (int q = 0; q < 16; ++q) wv[q] = *(const f32x4*)(wp + e0 + 4 * q);
#pragma unroll
              for (int q = 0; q < 16; ++q)
#pragma unroll
                  for (int ee = 0; ee < 4; ++ee) { const float w = wv[q][ee]; const f32x4 o0 = *(const LAS f32x4*)(scr + (e0 + 4 * q + ee) * 8), o1 = *(const LAS f32x4*)(scr + (e0 + 4 * q + ee) * 8 + 4);
                      acc[0] += w * o0[0]; acc[1] += w * o0[1]; acc[2] += w * o0[2]; acc[3] += w * o0[3]; acc[4] += w * o1[0]; acc[5] += w * o1[1]; acc[6] += w * o1[2]; acc[7] += w * o1[3]; } }
#pragma unroll
          for (int i = 0; i < 8; ++i) wout_t[(size_t)(n0 + i) * DM + 512 + g * 128 + cidx] = (unsigned char)(fp8x4(acc[i] * 64.0f, 0.f, 0.f, 0.f) & 0xffu);
          LDS_WAIT(); asm volatile("" ::: "memory"); } }
    if (parts & 16) { bf16* k1b = (bf16*)(F.ws + WS_K1); bf16* k2b = (bf16*)(F.ws + WS_K2);
      for (int e = gw * 64 + lane; e < 128 * 128; e += NGW * 64) { k1b[e] = (bf16)f2bf(F.k1[e]); k2b[e] = (bf16)f2bf(F.k2[e]); } }
    if (parts & 128) { for (int it = gw; it < 16 * 64; it += NGW) transpose_item_q8(F.w_pq, NQD, F.ws + WS_WPQ, 64 * (it / 64), 32 * (it % 64), scr, lane, (const float*)(F.ws + WS_SWQ) + NQD); }
    if (parts & 32) { unsigned char* xnq = F.ws + WS_XN; const int rpw = TT / NGW;
      for (int m = gw * rpw; m < gw * rpw + rpw; m += 4) { f32x4 v[4][4];
#pragma unroll
          for (int q = 0; q < 4; ++q)
#pragma unroll
              for (int j = 0; j < 4; ++j) v[q][j] = __builtin_nontemporal_load((const f32x4*)(F.x + (size_t)(m + q) * DM + 256 * j + 4 * lane));
#pragma unroll
          for (int q = 0; q < 4; ++q)
#pragma unroll
              for (int j = 0; j < 4; ++j) *(unsigned*)(F.ws + WS_XN8 + (size_t)(m + q) * DM + 256 * j + 4 * lane) = fp8x4(v[q][j][0], v[q][j][1], v[q][j][2], v[q][j][3]);
          float ax[4];
#pragma unroll
          for (int q = 0; q < 4; ++q) { ax[q] = 0.f;
#pragma unroll
              for (int j = 0; j < 4; ++j) ax[q] = fmaxf(ax[q], fmaxf(fmaxf(fabsf(v[q][j][0]), fabsf(v[q][j][1])), fmaxf(fabsf(v[q][j][2]), fabsf(v[q][j][3])))); }
#pragma unroll
          for (int q = 0; q < 4; ++q) ax[q] = wave_max(ax[q]);
#pragma unroll
          for (int q = 0; q < 4; ++q) { if (ax[q] == 0.f) ax[q] = 1.f; const float iv = 127.0f * __builtin_amdgcn_rcpf(ax[q]); unsigned wx[4];
#pragma unroll
              for (int j = 0; j < 4; ++j) wx[j] = q8x4(v[q][j][0], v[q][j][1], v[q][j][2], v[q][j][3], iv, Q8_MAGIC + 128.0f);
              *(v4u*)(xnq + (size_t)(m + q) * DM + 16 * lane) = (v4u){wx[0], wx[1], wx[2], wx[3]}; if (lane == 0) ((float*)(F.ws + WS_SXN))[m + q] = ax[q] * (1.0f / 127.0f); } } }
    if (parts & 64) {
        __syncthreads();
        if (F.tid == 0) { unsigned sp = 0; const unsigned* cnt = (const unsigned*)(F.ws + WS_CTL) + CW_MODCNT;
            while (__hip_atomic_load(cnt, __ATOMIC_RELAXED, __HIP_MEMORY_SCOPE_AGENT) < 224u) { __builtin_amdgcn_s_sleep(2); if (++sp > (1u << 22)) break; }
            __builtin_amdgcn_fence(__ATOMIC_ACQUIRE, "agent"); asm volatile("s_waitcnt vmcnt(0)" ::: "memory"); }
        __syncthreads();
        p1_win(F);
    }
}
__device__ __forceinline__ void tb_load4(Frame& F, int base, int r1, f32x4 (&dst)[4][4]) {
#pragma unroll
    for (int q = 0; q < 4; ++q) { if (base + q >= r1) break;
        const int it = base + q; const int tb = it >= NEXP, e = it - tb * NEXP; const float* src = (tb ? F.pv : F.pu) + (size_t)e * DM;
#pragma unroll
        for (int j = 0; j < 4; ++j) dst[q][j] = __builtin_nontemporal_load((const f32x4*)(src + 256 * j + 4 * F.lane)); }
}
template <bool SC1> __device__ __forceinline__ void tb_store16(unsigned char* p, v4u w) { if constexpr (SC1) asm volatile("global_store_dwordx4 %0, %1, off sc0 sc1" :: "v"(p), "v"(w) : "memory"); else *(v4u*)p = w; }
template <bool SC1> __device__ __forceinline__ void tb_store4(float* p, float w) { if constexpr (SC1) asm volatile("global_store_dword %0, %1, off sc0 sc1" :: "v"(p), "v"(w) : "memory"); else *p = w; }
template <bool SC1> __device__ __forceinline__ void tb_proc4(Frame& F, int base, int r1, const f32x4 (&v)[4][4]) {
    const int lane = F.lane; float* su = (float*)(F.ws + WS_SU); float* sv = (float*)(F.ws + WS_SV); float am[4];
#pragma unroll
    for (int q = 0; q < 4; ++q) { float a = 0.f; if (base + q < r1) {
#pragma unroll
        for (int j = 0; j < 4; ++j) a = fmaxf(a, fmaxf(fmaxf(fabsf(v[q][j][0]), fabsf(v[q][j][1])), fmaxf(fabsf(v[q][j][2]), fabsf(v[q][j][3])))); } am[q] = a; }
#pragma unroll
    for (int q = 0; q < 4; ++q) if (base + q < r1) am[q] = wave_max(am[q]);
#pragma unroll
    for (int q = 0; q < 4; ++q) { if (base + q >= r1) break; const int it = base + q; const int tb = it >= NEXP, e = it - tb * NEXP; float a = am[q]; if (a == 0.f) a = 1.f;
        unsigned w[4];
        if (!tb) { const float inv = 127.0f * __builtin_amdgcn_rcpf(a);
#pragma unroll
            for (int j = 0; j < 4; ++j) w[j] = q8x4(v[q][j][0], v[q][j][1], v[q][j][2], v[q][j][3], inv, Q8_MAGIC);
            tb_store16<SC1>(F.ws + WS_U + (size_t)e * DM + 16 * lane, (v4u){w[0], w[1], w[2], w[3]}); if (lane == 0) { unsigned short* hp_ = (unsigned short*)su + 2 * e; const unsigned hv_ = f2bf(a * (1.0f / 127.0f)); asm volatile("global_store_short %0, %1, off sc0 sc1" :: "v"(hp_), "v"(hv_) : "memory"); }
        } else { const float inv = 256.0f * __builtin_amdgcn_rcpf(a);
#pragma unroll
            for (int j = 0; j < 4; ++j) { unsigned wv = 0u, g = 0u;
#pragma unroll
                for (int i = 0; i < 4; ++i) { const float t = v[q][j][i] * inv; const unsigned short hb = __builtin_bit_cast(unsigned short, (_Float16)t);
                    const int m = (int)(hb & 0x7fffu); int h7 = (m - (int)g + 128) >> 8; h7 = h7 < 0 ? 0 : (h7 > 0x7B ? 0x7B : h7);
                    const unsigned byte = (unsigned)h7 | ((hb >> 8) & 0x80u); wv |= byte << (8 * i); g = byte; }
                w[j] = wv; }
            tb_store16<SC1>(F.ws + WS_V + (size_t)e * DM + 16 * lane, (v4u){w[0], w[1], w[2], w[3]}); if (lane == 0) { unsigned short* hp_ = (unsigned short*)su + 2 * e + 1; const unsigned hv_ = f2bf(a * (1.0f / 256.0f)); asm volatile("global_store_short %0, %1, off sc0 sc1" :: "v"(hp_), "v"(hv_) : "memory"); } } }
}
template <bool SC1> __device__ __forceinline__ void p2_tables(Frame& F, int cw, int ncw, int row_lo, int row_hi) {
    const int per = (row_hi - row_lo + ncw - 1) / ncw, r0 = row_lo + cw * per, r1 = (r0 + per) < row_hi ? (r0 + per) : row_hi;
    if (r0 >= r1) return;
    f32x4 va[4][4], vb[4][4];
    tb_load4(F, r0, r1, va);
    for (int it0 = r0; it0 < r1; it0 += 8) {
        if (it0 + 4 < r1) tb_load4(F, it0 + 4, r1, vb);
        tb_proc4<SC1>(F, it0, r1, va);
        if (it0 + 4 < r1) { if (it0 + 8 < r1) tb_load4(F, it0 + 8, r1, va); tb_proc4<SC1>(F, it0 + 4, r1, vb); }
    }
}
__device__ __forceinline__ void p1_win(Frame& F) {
    const float* mp = (const float*)(F.ws + WS_MODP);
    if (F.vcu < 48 && F.tid < 256) { const int e = F.vcu * 256 + F.tid; ((float*)(F.ws + WS_MOD))[e] = mp[e] + mp[2 * 6144 + e]; }
    LAS float* sc = (LAS float*)F.lds; LAS float* sh = sc + 2048;
    for (int i = F.tid; i < 2048; i += NTHREADS) { const int b = i >> 10, k = i & 1023; sc[i] = 1.f + mp[b * 6144 + 1024 + k] + mp[(2 + b) * 6144 + 1024 + k]; sh[i] = mp[b * 6144 + k] + mp[(2 + b) * 6144 + k]; }
    __syncthreads();
    const int lane = F.lane;
    if (F.vcu < 40) { const int b = F.vcu / 20, n = (F.vcu % 20) * 64 + lane; int nsrc = n; if (n < 640) { const int hd = n >> 6, w = n & 63; nsrc = hd * 64 + (w >> 1) + 32 * (w & 1); }
        float a = 0.f;
#pragma unroll 1
        for (int kb = 0; kb < 128; kb += 64) { float w[64];
#pragma unroll
            for (int u = 0; u < 64; ++u) w[u] = F.w_in[(size_t)(F.wave * 128 + kb + u) * NIN + nsrc];
            __builtin_amdgcn_sched_barrier(0);
#pragma unroll
            for (int u = 0; u < 64; ++u) a += sh[b * 1024 + F.wave * 128 + kb + u] * w[u]; }
        LAS float* red = (LAS float*)(F.lds + 16384); red[F.wave * 64 + lane] = a;
        __syncthreads();
        if (F.tid < 64) { float sacc = 0.f;
#pragma unroll
            for (int w = 0; w < 8; ++w) sacc += red[w * 64 + F.tid];
            ((float*)(F.ws + WS_BIAS))[b * NIN + (F.vcu % 20) * 64 + F.tid] = sacc; } }
    LAS float* scr = (LAS float*)(F.lds + 32768 + F.wave * 8448);
    const int gw = F.vcu * NWAVES + F.wave, NGW = F.G * NWAVES;
    const bool skipb = NGW >= 40 * NWAVES + 2 * 640;
    if (!(skipb && gw < 40 * NWAVES))
    for (int it = skipb ? gw - 40 * NWAVES : gw; it < 2 * 640; it += NGW) { const int b = it / 640, r = it % 640;
        transpose_item<1, true>(F.w_in, NIN, (bf16*)(F.ws + WS_WIN + (size_t)b * NIN * DM), DM, 64 * (r / 40), 32 * (r % 40), scr, lane, sc + b * 1024, 64.0f); }
    __syncthreads();
}
constexpr int KS_STRIDE = 144, VT_STRIDE = 520, KS_BYTES = 256 * KS_STRIDE, VT_BYTES = 64 * VT_STRIDE;
struct KvRegs { v4u k[4], v[4]; };
__device__ __forceinline__ void p3_attn_kvload(Frame& F, int unit, KvRegs& R) {
    const int b = unit >> 7, kvh = (unit >> 6) & 1, n = unit & 63; const bf16* proj = (const bf16*)(F.ws + WS_PROJ);
    const size_t tok0 = (size_t)b * SEQ + (size_t)n * 128;
#pragma unroll
    for (int i = 0; i < 4; ++i) { const int ci = F.tid + NTHREADS * i, row = ci >> 3, ch = ci & 7; const bool valid = (n > 0) || (row >= 128); const size_t tk = tok0 - 128 + row;
        R.k[i] = (v4u){0u, 0u, 0u, 0u}; R.v[i] = (v4u){0u, 0u, 0u, 0u};
        if (valid) { R.k[i] = *(const v4u*)(proj + tk * NIN + 512 + kvh * 64 + ch * 8); R.v[i] = *(const v4u*)(proj + tk * NIN + 640 + kvh * 64 + ch * 8); } }
}
__device__ __forceinline__ void p3_attn_unit(Frame& F, int unit, const KvRegs& R) {
    const int b = unit >> 7, kvh = (unit >> 6) & 1, n = unit & 63;
    const bf16* proj = (const bf16*)(F.ws + WS_PROJ); unsigned char* a2 = F.ws + WS_A2;
    LAS unsigned char* Ks = F.lds; LAS unsigned char* Vt = F.lds + KS_BYTES;
    const int tid = F.tid, lane = F.lane, wave = F.wave, r32 = lane & 31, h = lane >> 5;
    const size_t tok0 = (size_t)b * SEQ + (size_t)n * 128;
#pragma unroll
    for (int i = 0; i < 4; ++i) { const int ci = tid + NTHREADS * i, row = ci >> 3, ch = ci & 7;
        const v4u kv = R.k[i], vv = R.v[i];
        *(LAS v4u*)(Ks + row * KS_STRIDE + ch * 16) = kv;
        LAS bf16* vt = (LAS bf16*)(Vt + (ch * 8) * VT_STRIDE) + row;
        vt[0 * (VT_STRIDE / 2)] = (bf16)(vv.x & 0xffff); vt[1 * (VT_STRIDE / 2)] = (bf16)(vv.x >> 16); vt[2 * (VT_STRIDE / 2)] = (bf16)(vv.y & 0xffff); vt[3 * (VT_STRIDE / 2)] = (bf16)(vv.y >> 16);
        vt[4 * (VT_STRIDE / 2)] = (bf16)(vv.z & 0xffff); vt[5 * (VT_STRIDE / 2)] = (bf16)(vv.z >> 16); vt[6 * (VT_STRIDE / 2)] = (bf16)(vv.w & 0xffff); vt[7 * (VT_STRIDE / 2)] = (bf16)(vv.w >> 16); }
    __syncthreads();
    const int g = wave >> 1, hq = kvh * 4 + g; const float sink2 = F.sinks[hq] * LOG2E;
#pragma unroll 1
    for (int qt = 0; qt < 2; ++qt) {
        const int qi0 = (wave & 1) * 64 + qt * 32, t0 = qi0 >> 5; const size_t tokq = tok0 + qi0 + r32;
        bf16x8 qf[4];
#pragma unroll
        for (int s = 0; s < 4; ++s) qf[s] = __builtin_nontemporal_load((const bf16x8*)(proj + tokq * NIN + hq * 64 + 16 * s + 8 * h));
        f32x16 sc[5];
#pragma unroll
        for (int kt = 0; kt < 5; ++kt) { sc[kt] = (f32x16){};
#pragma unroll
            for (int s = 0; s < 4; ++s) { const bf16x8 kf = *(const LAS bf16x8*)(Ks + (32 * (t0 + kt) + r32) * KS_STRIDE + (16 * s + 8 * h) * 2);
                sc[kt] = __builtin_amdgcn_mfma_f32_32x32x16_bf16(kf, qf[s], sc[kt], 0, 0, 0); } }
        const int qi = qi0 + r32; float m = sink2;
#pragma unroll
        for (int kt = 0; kt < 5; ++kt) { const bool dead = (n == 0) && (t0 + kt < 4);
            if (dead) {
#pragma unroll
                for (int r = 0; r < 16; ++r) sc[kt][r] = -INFINITY;
            } else {
#pragma unroll
                for (int r = 0; r < 16; ++r) { const int dk = (r & 3) + 8 * (r >> 2) + 4 * h;
                    float v = sc[kt][r];
                    if (kt == 0) v = (r32 < dk) ? v : -INFINITY;
                    if (kt == 4) v = (r32 >= dk) ? v : -INFINITY;
                    sc[kt][r] = v; m = fmaxf(m, v); } } }
        m = fmaxf(m, __shfl_xor(m, 32));
        float l = 0.f;
#pragma unroll
        for (int kt = 0; kt < 5; ++kt)
#pragma unroll
            for (int r = 0; r < 16; ++r) { const float p = __builtin_amdgcn_exp2f(sc[kt][r] - m); sc[kt][r] = p; l += p; }
        l += __shfl_xor(l, 32); l += __builtin_amdgcn_exp2f(sink2 - m);
        f32x16 o[2]; o[0] = (f32x16){}; o[1] = (f32x16){};
#pragma unroll
        for (int kt = 0; kt < 5; ++kt)
#pragma unroll
            for (int s2 = 0; s2 < 2; ++s2) {
                u32x4 pw; pw.x = pg8::cvt_pk_bf16(sc[kt][8 * s2 + 0], sc[kt][8 * s2 + 1]); pw.y = pg8::cvt_pk_bf16(sc[kt][8 * s2 + 2], sc[kt][8 * s2 + 3]);
                pw.z = pg8::cvt_pk_bf16(sc[kt][8 * s2 + 4], sc[kt][8 * s2 + 5]); pw.w = pg8::cvt_pk_bf16(sc[kt][8 * s2 + 6], sc[kt][8 * s2 + 7]);
                const bf16x8 pf = __builtin_bit_cast(bf16x8, pw);
#pragma unroll
                for (int dt = 0; dt < 2; ++dt) { const LAS unsigned char* vp = Vt + (dt * 32 + r32) * VT_STRIDE + (32 * (t0 + kt) + 16 * s2 + 4 * h) * 2;
                    const u32x2 lo = *(const LAS u32x2*)vp, hi = *(const LAS u32x2*)(vp + 16);
                    const u32x4 vw = (u32x4){lo.x, lo.y, hi.x, hi.y};
                    o[dt] = __builtin_amdgcn_mfma_f32_32x32x16_bf16(__builtin_bit_cast(bf16x8, vw), pf, o[dt], 0, 0, 0); } }
        const float inv = 16.0f * __builtin_amdgcn_rcpf(l);
#pragma unroll
        for (int dt = 0; dt < 2; ++dt)
#pragma unroll
            for (int rg = 0; rg < 4; ++rg) { const int d0 = dt * 32 + 8 * rg + 4 * h;
                *(unsigned*)(a2 + tokq * DM + hq * 64 + d0) = fp8x4(o[dt][4 * rg + 0] * inv, o[dt][4 * rg + 1] * inv, o[dt][4 * rg + 2] * inv, o[dt][4 * rg + 3] * inv); }
    }
    __syncthreads();
}
struct PoolRegs { unsigned u[48]; };
__device__ __forceinline__ void p3_pool_load(Frame& F, int unit, PoolRegs& R) {
    const bf16* proj = (const bf16*)(F.ws + WS_PROJ);
    const int cp = F.tid & 255, half = F.tid >> 8;
    const int tstart = unit * 64 + half * 32, s0 = tstart & (SEQ - 1);
    const bf16* pc = proj + 768 + 2 * cp;
#pragma unroll
    for (int i = 0; i < 48; ++i) { const int s = s0 - 16 + i; R.u[i] = (s >= 0) ? __builtin_nontemporal_load((const unsigned*)(pc + (size_t)(tstart - 16 + i) * NIN)) : 0u; }
}
__device__ __forceinline__ void p3_pool_compute(Frame& F, int unit, const PoolRegs& R) {
    unsigned char* a2 = F.ws + WS_A2;
    const int cp = F.tid & 255, half = F.tid >> 8, gi = cp >> 6, w = 2 << gi;
    const int tstart = unit * 64 + half * 32, s0 = tstart & (SEQ - 1);
    const unsigned (&u)[48] = R.u;
    float w0 = 0.f, w1 = 0.f;
#pragma unroll
    for (int j = 1; j <= 16; ++j) if (j <= w) { w0 += bf_lo(u[16 - j]); w1 += bf_hi(u[16 - j]); }
#pragma unroll
    for (int i = 0; i < 32; ++i) { const int s = s0 + i; const float p0 = bf_lo(u[16 + i]), p1 = bf_hi(u[16 + i]);
        const unsigned uo = (w == 2) ? u[14 + i] : (w == 4) ? u[12 + i] : (w == 8) ? u[8 + i] : u[i];
        w0 += p0 - bf_lo(uo); w1 += p1 - bf_hi(uo);
        const float rc = __builtin_amdgcn_rcpf((float)((s + 1) < w ? (s + 1) : w));
        *(unsigned short*)(a2 + (size_t)(tstart + i) * DM + 512 + 2 * cp) = (unsigned short)(fp8x4((w0 * rc - p0) * 16.0f, (w1 * rc - p1) * 16.0f, 0.f, 0.f) & 0xffffu); }
}
__device__ __forceinline__ void p5_ln1(Frame& F) {
    const float* mod = (const float*)(F.ws + WS_MOD); const unsigned char* mix = F.ws + WS_MIX;     const unsigned char* xnq = F.ws + WS_XN; const float* sxn = (const float*)(F.ws + WS_SXN);
    unsigned char* x1q = F.ws + WS_X1; float* sxp = (float*)(F.ws + WS_SX);     unsigned char* h2q = F.ws + WS_H2Q; float* shp = (float*)(F.ws + WS_SH);
    const int gw = F.gcu * NWAVES + F.wave, lane = F.lane; const int rows_per_wave = TT / (F.G * NWAVES);
    const int row0 = gw * rows_per_wave, b = row0 >> 13;
    f32x4 g1[4], lg[4], lb[4], s2[4], h2s[4];
#pragma unroll
    for (int j = 0; j < 4; ++j) { const int d = 256 * j + 4 * lane;
        g1[j] = (*(const f32x4*)(mod + b * 6144 + 2048 + d) + 1.0f) * (1.0f / MIX_SCALE); lg[j] = *(const f32x4*)(F.ln1_g + d); lb[j] = *(const f32x4*)(F.ln1_b + d);
        s2[j] = *(const f32x4*)(mod + b * 6144 + 4096 + d) + 1.0f; h2s[j] = *(const f32x4*)(mod + b * 6144 + 3072 + d); }
    for (int r = 0; r < rows_per_wave; r += 8) {
        v4u xw[8]; float sxa[8]; unsigned mv[8][4];
#pragma unroll
        for (int q = 0; q < 8; ++q)
#pragma unroll
            for (int j = 0; j < 4; ++j) { const size_t m = (size_t)(row0 + r + q); const int d = 256 * j + 4 * lane; if (j == 0) { xw[q] = __builtin_nontemporal_load((const v4u*)(xnq + m * DM + 16 * lane)); sxa[q] = sxn[m] * DN_ALPHA; } mv[q][j] = __builtin_nontemporal_load((const unsigned*)(mix + m * DM + d)); }
        __builtin_amdgcn_sched_barrier(0);
#pragma unroll
        for (int q = 0; q < 8; ++q) { const size_t m = (size_t)(row0 + r + q);
        f32x4 v[4]; float s = 0.f;
#pragma unroll
        for (int j = 0; j < 4; ++j) {
            const f32x2 m01 = __builtin_amdgcn_cvt_pk_f32_fp8((int)mv[q][j], false), m23 = __builtin_amdgcn_cvt_pk_f32_fp8((int)mv[q][j], true); const f32x4 mf = (f32x4){m01[0], m01[1], m23[0], m23[1]};
            const unsigned xv = j == 0 ? xw[q].x : j == 1 ? xw[q].y : j == 2 ? xw[q].z : xw[q].w;
            const f32x4 xf = (f32x4){(float)(xv & 255u), (float)((xv >> 8) & 255u), (float)((xv >> 16) & 255u), (float)(xv >> 24)};
            v[j] = xf * sxa[q] + (g1[j] * mf + sxa[q] * -128.0f); s += (v[j][0] + v[j][1]) + (v[j][2] + v[j][3]); }
        const float mean = wave_sum(s) * (1.f / DM); float qq = 0.f;
#pragma unroll
        for (int j = 0; j < 4; ++j) { v[j] = v[j] - mean; qq += (v[j][0] * v[j][0] + v[j][1] * v[j][1]) + (v[j][2] * v[j][2] + v[j][3] * v[j][3]); }
        const float rstd = __builtin_amdgcn_rsqf(wave_sum(qq) * (1.f / DM) + LN_EPS);
        f32x4 hh[4]; float am = 0.f, ax = 0.f;
#pragma unroll
        for (int j = 0; j < 4; ++j) { v[j] = v[j] * rstd * lg[j] + lb[j]; hh[j] = v[j] * s2[j] + h2s[j];
            ax = fmaxf(ax, fmaxf(fmaxf(fabsf(v[j][0]), fabsf(v[j][1])), fmaxf(fabsf(v[j][2]), fabsf(v[j][3]))));
            am = fmaxf(am, fmaxf(fmaxf(fabsf(hh[j][0]), fabsf(hh[j][1])), fmaxf(fabsf(hh[j][2]), fabsf(hh[j][3])))); }
        am = wave_max(am); ax = wave_max(ax);
        if (am == 0.f) am = 1.f; if (ax == 0.f) ax = 1.f;
        { const float ivx = 127.0f * __builtin_amdgcn_rcpf(ax); unsigned wx[4];
#pragma unroll
          for (int j = 0; j < 4; ++j) wx[j] = q8x4(v[j][0], v[j][1], v[j][2], v[j][3], ivx, Q8_MAGIC + 128.0f);
          *(v4u*)(x1q + m * DM + 16 * lane) = (v4u){wx[0], wx[1], wx[2], wx[3]}; if (lane == 0) sxp[m] = ax * (1.0f / 127.0f); }
        const float inv = 127.0f * __builtin_amdgcn_rcpf(am); unsigned w[4];
#pragma unroll
        for (int j = 0; j < 4; ++j) w[j] = q8x4(hh[j][0], hh[j][1], hh[j][2], hh[j][3], inv, Q8_MAGIC);
        *(v4u*)(h2q + m * DM + 16 * lane) = (v4u){w[0], w[1], w[2], w[3]}; if (lane == 0) shp[m] = am * (1.0f / 127.0f); } }
}
constexpr int KR_STRIDE = 272, KR_BYTES = 128 * KR_STRIDE;
__device__ __forceinline__ float amax_(float a, float b) { float r; asm("v_max_f32 %0, %1, %2" : "=v"(r) : "v"(a), "v"(b)); return r; }
__device__ __forceinline__ float amin_(float a, float b) { float r; asm("v_min_f32 %0, %1, %2" : "=v"(r) : "v"(a), "v"(b)); return r; }
#define FMAX1(x, y) amax_((x), (y))
#define FMIN1(x, y) amin_((x), (y))
#define INS16(a, v) do { _Pragma("unroll") for (int _i = 15; _i >= 1; --_i) a[_i] = __builtin_amdgcn_fmed3f(a[_i - 1], a[_i], (v)); a[0] = FMAX1(a[0], (v)); } while (0)
#define CEX(a, i, j) do { const float _x = a[i], _y = a[j]; a[i] = FMAX1(_x, _y); a[j] = FMIN1(_x, _y); } while (0)
#define SORT16(a) do { _Pragma("unroll") for (int _p = 1; _p < 16; _p <<= 1) { _Pragma("unroll") for (int _k = _p; _k >= 1; _k >>= 1) { _Pragma("unroll") for (int _j = _k % _p; _j <= 15 - _k; _j += 2 * _k) { \
        _Pragma("unroll") for (int _i = 0; _i < _k; ++_i) { if (_i + _j + _k <= 15 && (_i + _j) / (2 * _p) == (_i + _j + _k) / (2 * _p)) CEX(a, _i + _j, _i + _j + _k); } } } } } while (0)
#define MERGE16(a, b) do { _Pragma("unroll") for (int _i = 0; _i < 16; ++_i) a[_i] = FMAX1(a[_i], b[15 - _i]); BITONIC16(a); } while (0)
#define BITONIC16(a) do { _Pragma("unroll") for (int _st = 8; _st >= 1; _st >>= 1) { _Pragma("unroll") for (int _i = 0; _i < 16; ++_i) if ((_i & _st) == 0) { const float _x = a[_i], _y = a[_i + _st]; a[_i] = FMAX1(_x, _y); a[_i + _st] = FMIN1(_x, _y); } } } while (0)
__device__ __forceinline__ void p7_route(Frame& F) {
    const bf16* q = (const bf16*)(F.ws + WS_Q); unsigned short* pe = (unsigned short*)(F.ws + WS_PE); float* pg = (float*)(F.ws + WS_PG);
    const int tid = F.tid, lane = F.lane, wave = F.wave, r32 = lane & 31, h = lane >> 5;
    { const bf16* k1b = (const bf16*)(F.ws + WS_K1);
      for (int ci = tid; ci < 2 * 128 * 16; ci += NTHREADS) { const int side = ci >> 11, row = (ci >> 4) & 127, ch = ci & 15;
          *(LAS v4u*)(F.lds + side * KR_BYTES + row * KR_STRIDE + ch * 16) = *(const v4u*)(k1b + (size_t)side * 16384 + row * 128 + ch * 8); } }
    __syncthreads();
    LAS unsigned char* scr = F.lds + 2 * KR_BYTES + wave * 2048 + lane * 32;
    pg8::StaticOrder S; S.init(TT, NQD, F.G, (int)blockIdx.x); pg8::Unit u;
    for (int ui = 0; S.next(ui, u); ++ui) {
        const int head = u.pn; const size_t tok = (size_t)u.pm * 256 + wave * 32 + r32;
        float vv[2][16];
        bf16x8 qa[2][8];
#pragma unroll
        for (int side = 0; side < 2; ++side)
#pragma unroll
            for (int s = 0; s < 8; ++s) qa[side][s] = *(const bf16x8*)(q + tok * NQD + head * 256 + side * 128 + 16 * s + 8 * h);
        __builtin_amdgcn_sched_barrier(0);
#pragma unroll
        for (int side = 0; side < 2; ++side) {
            bf16x8 qf[8];
#pragma unroll
            for (int s = 0; s < 8; ++s) qf[s] = qa[side][s];
            float a[16];
#pragma unroll
            for (int kt = 0; kt < 4; ++kt) { f32x16 acc = (f32x16){};
#pragma unroll
                for (int s = 0; s < 8; ++s) { const bf16x8 kf = *(const LAS bf16x8*)(F.lds + side * KR_BYTES + (32 * kt + r32) * KR_STRIDE + (16 * s + 8 * h) * 2);
                    acc = __builtin_amdgcn_mfma_f32_32x32x16_bf16(kf, qf[s], acc, 0, 0, 0); }
                float t[16];
#pragma unroll
                for (int r = 0; r < 16; ++r) { const unsigned key = (unsigned)(32 * kt + (r & 3) + 8 * (r >> 2)) | ((unsigned)h << 2);
                    t[r] = __uint_as_float((__float_as_uint(acc[r]) & 0xFFFFFF80u) | key); }
                SORT16(t);
                if (kt == 0) {
#pragma unroll
                    for (int r = 0; r < 16; ++r) a[r] = t[r];
                } else MERGE16(a, t);
                __builtin_amdgcn_sched_barrier(0); }
            float c[16];
#pragma unroll
            for (int i = 0; i < 16; ++i) c[i] = __shfl_xor(a[15 - i], 32);
#pragma unroll
            for (int i = 0; i < 16; ++i) c[i] = FMAX1(a[i], c[i]);
            BITONIC16(c);
#pragma unroll
            for (int i = 0; i < 16; ++i) vv[side][i] = c[i];
        }
        { v4u w1, w2;
#define PK4(L, b) ((__float_as_uint(L[b]) & 0x7Fu) | ((__float_as_uint(L[b + 1]) & 0x7Fu) << 8) | ((__float_as_uint(L[b + 2]) & 0x7Fu) << 16) | ((__float_as_uint(L[b + 3]) & 0x7Fu) << 24))
          w1.x = PK4(vv[0], 0); w1.y = PK4(vv[0], 4); w1.z = PK4(vv[0], 8); w1.w = PK4(vv[0], 12);
          w2.x = PK4(vv[1], 0); w2.y = PK4(vv[1], 4); w2.z = PK4(vv[1], 8); w2.w = PK4(vv[1], 12);
#undef PK4
          *(LAS v4u*)scr = w1; *(LAS v4u*)(scr + 16) = w2; }
        float c1[16], c2[16], top[16];
#pragma unroll
        for (int i = 0; i < 16; ++i) { c1[i] = __uint_as_float(__float_as_uint(vv[0][i]) & 0xFFFFFF80u); c2[i] = __uint_as_float(__float_as_uint(vv[1][i]) & 0xFFFFFF80u); top[i] = -INFINITY; }
        { int cnt = 0; float pend = 0.f; unsigned pcode = 0u;
#pragma unroll
          for (int ia = 0; ia < 16; ++ia)
#pragma unroll
            for (int ib = 0; ib < 16; ++ib) if ((ia + 1) * (ib + 1) <= 16) {
                const float sm = c1[ia] + c2[ib]; const unsigned code = (unsigned)(ia * 16 + ib);
                if ((cnt & 1) == 0) { pend = sm; pcode = code; }
                else { const float vs = h ? sm : pend; const unsigned cd = h ? code : pcode; const float v = __uint_as_float((__float_as_uint(vs) & 0xFFFFFF00u) | cd); INS16(top, v); }
                ++cnt; }
          float ot[16];
#pragma unroll
          for (int i = 0; i < 16; ++i) ot[i] = __shfl_xor(top[15 - i], 32);
#pragma unroll
          for (int i = 0; i < 16; ++i) top[i] = FMAX1(top[i], ot[i]);
          BITONIC16(top); }
        float ex[16], den = 0.f;
#pragma unroll
        for (int i = 0; i < 16; ++i) { ex[i] = __expf(top[i] - top[0]); den += ex[i]; }
        const float rden = __builtin_amdgcn_rcpf(den);
        LDS_WAIT();
        unsigned short ev[8]; float gv[8];
#pragma unroll
        for (int j = 0; j < 8; ++j) { const float t = h ? top[8 + j] : top[j]; const float e = h ? ex[8 + j] : ex[j];
            const unsigned code = __float_as_uint(t) & 0xFFu; const unsigned i1 = *(const LAS unsigned char*)(scr + (code >> 4)), i2 = *(const LAS unsigned char*)(scr + 16 + (code & 15u));
            ev[j] = (unsigned short)(i1 * 128u + i2); gv[j] = e * rden; }
        v4u ew; ew.x = ev[0] | ((unsigned)ev[1] << 16); ew.y = ev[2] | ((unsigned)ev[3] << 16); ew.z = ev[4] | ((unsigned)ev[5] << 16); ew.w = ev[6] | ((unsigned)ev[7] << 16);
        *(v4u*)(pe + tok * 128 + head * 16 + 8 * h) = ew;
        *(f32x4*)(pg + tok * 128 + head * 16 + 8 * h) = (f32x4){gv[0], gv[1], gv[2], gv[3]};
        *(f32x4*)(pg + tok * 128 + head * 16 + 8 * h + 4) = (f32x4){gv[4], gv[5], gv[6], gv[7]};
        LDS_WAIT();
    }
    __syncthreads();
}
__device__ __forceinline__ float gelu_erf(float v) {
    const float d = fabsf(v) * 0.2316418882f + 1.0f, t = __builtin_amdgcn_rcpf(d);
    float q = t * 0.5307027145f + (-0.7265760135f); q = q * t + 0.7107068705f; q = q * t + (-0.142248368f); q = q * t + 0.127414796f; q = q * t;
    const float e = __builtin_amdgcn_exp2f(v * v * (-0.72134752044f)), m = v * (q * e);
    return v < 0.f ? m : v - m; }
#ifndef NPART
#define NPART 8
#endif
constexpr int TPW = 8, NSWEEP = 1;
constexpr int PSHIFT = (NPART == 32) ? 9 : (NPART == 8) ? 11 : (NPART == 16) ? 10 : (NPART == 4) ? 12 : (NPART == 2) ? 13 : 14;
__device__ __forceinline__ void p8_peer(Frame& F, unsigned emask = 0xffffu, int skip = 0) {
    const float* mod = (const float*)(F.ws + WS_MOD);
    const unsigned char* x1q = F.ws + WS_X1; const float* sxp = (const float*)(F.ws + WS_SX);
    const float* su = (const float*)(F.ws + WS_SU); const float* sv = (const float*)(F.ws + WS_SV);
    const unsigned* pe = (const unsigned*)(F.ws + WS_PE); const float* pg = (const float*)(F.ws + WS_PG);
    const int gw = F.gcu * NWAVES + F.wave;
    const int b3 = (F.lane >> 3) & 1;
#pragma unroll 1
    for (int sweep = 0; sweep < NSWEEP; ++sweep) {
    const int t0 = (gw * NSWEEP + sweep) * TPW, b = t0 >> 13;
    int lane = F.lane; asm volatile("" : "+v"(lane));
    unsigned hq[TPW][4]; float shs[TPW]; unsigned es[TPW]; float gs[TPW][2]; int offv[TPW];
    unsigned pe2v[TPW]; f32x2 pg2v[TPW];
#pragma unroll
    for (int tt = 0; tt < TPW; ++tt) { const size_t t = (size_t)(t0 + tt);
        const u32x4 hw = __builtin_nontemporal_load((const u32x4*)(F.ws + WS_H2Q + t * DM + 16 * lane)); hq[tt][0] = hw.x; hq[tt][1] = hw.y; hq[tt][2] = hw.z; hq[tt][3] = hw.w; shs[tt] = ((const float*)(F.ws + WS_SH))[t];
        pe2v[tt] = __builtin_nontemporal_load(pe + t * 64 + lane); pg2v[tt] = __builtin_nontemporal_load((const f32x2*)(pg + t * 128 + 2 * lane)); }
#pragma unroll
    for (int tt = 0; tt < TPW; ++tt) { LAS unsigned* scr = (LAS unsigned*)(F.lds + (F.wave * TPW + tt) * 1024);
        const unsigned pe2 = pe2v[tt]; const f32x2 pg2 = pg2v[tt];
        const unsigned elo = pe2 & emask, ehi = (pe2 >> 16) & emask; const int plo = (int)(elo >> PSHIFT), phi = (int)(ehi >> PSHIFT);
        int base = 0, poslo = 0, poshi = 0, ov = 0;
#pragma unroll
        for (int r = 0; r < NPART; ++r) { const unsigned long long mlo = __ballot(plo == r), mhi = __ballot(phi == r);
            const int clo = __popcll(mlo), chi = __popcll(mhi);
            const int rlo = (int)__builtin_amdgcn_mbcnt_hi((unsigned)(mlo >> 32), __builtin_amdgcn_mbcnt_lo((unsigned)mlo, 0u));
            const int rhi = (int)__builtin_amdgcn_mbcnt_hi((unsigned)(mhi >> 32), __builtin_amdgcn_mbcnt_lo((unsigned)mhi, 0u));
            if (plo == r) poslo = base + rlo; if (phi == r) poshi = base + clo + rhi;
            base += clo + chi; if (lane == r + 1) ov = base; }
        offv[tt] = ov;
        scr[2 * poslo] = elo; scr[2 * poslo + 1] = __float_as_uint(pg2.x); scr[2 * poshi] = ehi; scr[2 * poshi + 1] = __float_as_uint(pg2.y); }
    LDS_WAIT();
#pragma unroll
    for (int tt = 0; tt < TPW; ++tt) { const LAS unsigned* scr = (const LAS unsigned*)(F.lds + (F.wave * TPW + tt) * 1024);
        const u32x4 sr = *(const LAS u32x4*)(scr + 4 * lane);
        es[tt] = sr.x | (sr.z << 16); gs[tt][0] = __uint_as_float(sr.y); gs[tt][1] = __uint_as_float(sr.w); }
    LDS_WAIT();
    const __amdgpu_buffer_rsrc_t ut_rs = __builtin_amdgcn_make_buffer_rsrc((void*)(F.ws + WS_U), 0, NEXP * DM, 0x00020000), vt_rs = __builtin_amdgcn_make_buffer_rsrc((void*)(F.ws + WS_V), 0, NEXP * DM, 0x00020000);
    const int voff16 = 16 * lane;
#define ut ut_rs
#define vt vt_rs
#define P8_ISSUE(buf, tbl, tok, bb) do { _Pragma("unroll") for (int k2 = 0; k2 < 4; ++k2) { const unsigned ew = (unsigned)__builtin_amdgcn_readlane((int)es[tok], 4 * (bb) + k2); \
        buf[2 * k2] = __builtin_amdgcn_raw_buffer_load_b128((tbl), voff16, (int)((ew & 0xffffu) << 10), 0); buf[2 * k2 + 1] = __builtin_amdgcn_raw_buffer_load_b128((tbl), voff16, (int)((ew >> 16) << 10), 0); } } while (0)
    float su0[TPW], su1[TPW], sv0[TPW], sv1[TPW];
    __syncthreads();
    { const v4u* tsrc = (const v4u*)(F.ws + WS_SU); v4u tv[8];
#pragma unroll
      for (int i = 0; i < 8; ++i) tv[i] = tsrc[i * NTHREADS + F.tid];
#pragma unroll
      for (int i = 0; i < 8; ++i) *(LAS v4u*)(F.lds + (i * NTHREADS + F.tid) * 16) = tv[i]; }
    LDS_WAIT(); __syncthreads();
#pragma unroll
    for (int tt = 0; tt < TPW; ++tt) { const unsigned e0 = es[tt] & 0xffffu, e1 = es[tt] >> 16; const unsigned w0_ = *(const LAS unsigned*)(F.lds + 4 * e0), w1_ = *(const LAS unsigned*)(F.lds + 4 * e1);
        su0[tt] = bf_lo(w0_); sv0[tt] = bf_hi(w0_); su1[tt] = bf_lo(w1_); sv1[tt] = bf_hi(w1_); }
    int hidv[TPW][2];
#pragma unroll
    for (int tt = 0; tt < TPW; ++tt) { hidv[tt][0] = 0; hidv[tt][1] = 0; }
    {
        u32x4 bufA[8], bufB[8];
        LAS int* hidl = (LAS int*)(F.lds + 65536 + F.wave * 4096);
#define P8_DOTS(buf, tok, bb) do { int p[8]; \
            _Pragma("unroll") for (int kk = 0; kk < 8; ++kk) { int s_ = __builtin_amdgcn_sdot4((int)buf[kk].x, (int)hq[tok][0], 0, false); s_ = __builtin_amdgcn_sdot4((int)buf[kk].y, (int)hq[tok][1], s_, false); \
                s_ = __builtin_amdgcn_sdot4((int)buf[kk].z, (int)hq[tok][2], s_, false); s_ = __builtin_amdgcn_sdot4((int)buf[kk].w, (int)hq[tok][3], s_, false); p[kk] = s_; } \
            int q4[4], q2[2], q1; \
            _Pragma("unroll") for (int i = 0; i < 4; ++i) { auto r_ = __builtin_amdgcn_permlane32_swap((unsigned)p[i], (unsigned)p[i + 4], false, false); q4[i] = (int)(r_[0] + r_[1]); } \
            _Pragma("unroll") for (int i = 0; i < 2; ++i) { auto r_ = __builtin_amdgcn_permlane16_swap((unsigned)q4[i], (unsigned)q4[i + 2], false, false); q2[i] = (int)(r_[0] + r_[1]); } \
            { const int keep = b3 ? q2[1] : q2[0], send = b3 ? q2[0] : q2[1]; q1 = keep + __builtin_amdgcn_update_dpp(0, send, 0x128, 0xF, 0xF, true); } \
            q1 += __builtin_amdgcn_update_dpp(0, q1, 0xB1, 0xF, 0xF, true); q1 += __builtin_amdgcn_update_dpp(0, q1, 0x4E, 0xF, 0xF, true); q1 += __builtin_amdgcn_update_dpp(0, q1, 0x141, 0xF, 0xF, true); \
              \
            if ((lane & 7) == 0) hidl[(tok) * 128 + 8 * (bb) + (lane >> 3)] = q1; } while (0)
        int cur[TPW];
#pragma unroll
        for (int tt = 0; tt < TPW; ++tt) cur[tt] = 0;
#define P8_STEP_A(tt_, bufX, bufY, r_) { const int end_ = __builtin_amdgcn_readlane(offv[tt_], (r_) + 1); \
            while (cur[tt_] < end_) { P8_ISSUE(bufX, ut, tt_, cur[tt_] >> 3); P8_DOTS(bufX, tt_, cur[tt_] >> 3); cur[tt_] += 8; } }
        if ((skip & 1) == 0) {
#pragma unroll 1
        for (int r = 0; r < NPART; ++r) {
            P8_STEP_A(0, bufA, bufB, r) P8_STEP_A(1, bufB, bufA, r) P8_STEP_A(2, bufA, bufB, r) P8_STEP_A(3, bufB, bufA, r)
            P8_STEP_A(4, bufA, bufB, r) P8_STEP_A(5, bufB, bufA, r) P8_STEP_A(6, bufA, bufB, r) P8_STEP_A(7, bufB, bufA, r)
        } }
        LDS_WAIT();
#pragma unroll
        for (int tt = 0; tt < TPW; ++tt) { const u32x2 hv_ = *(const LAS u32x2*)(hidl + tt * 128 + 2 * lane); hidv[tt][0] = (int)hv_.x; hidv[tt][1] = (int)hv_.y; }
#undef P8_STEP_A
#undef P8_DOTS
    }
    {
#pragma unroll
      for (int tt = 0; tt < TPW; ++tt) {
        gs[tt][0] = gelu_erf((float)hidv[tt][0] * (shs[tt] * su0[tt])) * gs[tt][0] * sv0[tt];
        gs[tt][1] = gelu_erf((float)hidv[tt][1] * (shs[tt] * su1[tt])) * gs[tt][1] * sv1[tt]; } }
    u32x4 xw[TPW]; float sxa[TPW];
#pragma unroll
    for (int tt = 0; tt < TPW; ++tt) { xw[tt] = __builtin_nontemporal_load((const u32x4*)(x1q + (size_t)(t0 + tt) * DM + 16 * lane)); sxa[tt] = sxp[t0 + tt] * DN_ALPHA; }
    typedef _Float16 f16x2 __attribute__((ext_vector_type(2)));
    unsigned gsh[TPW];
#pragma unroll
    for (int tt = 0; tt < TPW; ++tt) gsh[tt] = __builtin_bit_cast(unsigned, (f16x2){(_Float16)gs[tt][0], (_Float16)gs[tt][1]});
    f16x2 yh[TPW][8];
#pragma unroll
    for (int tt = 0; tt < TPW; ++tt) {
#pragma unroll
        for (int i = 0; i < 8; ++i) yh[tt][i] = (f16x2){(_Float16)0.f, (_Float16)0.f}; }
    {
        u32x4 bufA[8], bufB[8];
#define P8_PICK(tok, a, wv) { const unsigned x0_ = (wv).x, x1_ = (wv).y, x2_ = (wv).z, x3_ = (wv).w;     \
            unsigned s0_ = x0_ << 8, s1_ = x1_ << 8, s2_ = x2_ << 8, s3_ = x3_ << 8; asm volatile("" : "+v"(s0_), "+v"(s1_), "+v"(s2_), "+v"(s3_)); \
            yh[tok][1] = __builtin_elementwise_fma(__builtin_bit_cast(f16x2, x0_), (a), yh[tok][1]); yh[tok][3] = __builtin_elementwise_fma(__builtin_bit_cast(f16x2, x1_), (a), yh[tok][3]); \
            yh[tok][5] = __builtin_elementwise_fma(__builtin_bit_cast(f16x2, x2_), (a), yh[tok][5]); yh[tok][7] = __builtin_elementwise_fma(__builtin_bit_cast(f16x2, x3_), (a), yh[tok][7]); \
            yh[tok][0] = __builtin_elementwise_fma(__builtin_bit_cast(f16x2, s0_), (a), yh[tok][0]); yh[tok][2] = __builtin_elementwise_fma(__builtin_bit_cast(f16x2, s1_), (a), yh[tok][2]); \
            yh[tok][4] = __builtin_elementwise_fma(__builtin_bit_cast(f16x2, s2_), (a), yh[tok][4]); yh[tok][6] = __builtin_elementwise_fma(__builtin_bit_cast(f16x2, s3_), (a), yh[tok][6]); }
#define P8_ACC(buf, tok, bb) do { _Pragma("unroll") for (int k2 = 0; k2 < 4; ++k2) { \
            const f16x2 hh_ = __builtin_bit_cast(f16x2, __builtin_amdgcn_readlane((int)gsh[tok], 4 * (bb) + k2)); \
            const f16x2 a0_ = (f16x2){hh_.x, hh_.x}, a1_ = (f16x2){hh_.y, hh_.y}; \
            { const u32x4 w0_ = buf[2 * k2]; P8_PICK(tok, a0_, w0_) } \
            { const u32x4 w1_ = buf[2 * k2 + 1]; P8_PICK(tok, a1_, w1_) } __builtin_amdgcn_sched_barrier(0); } } while (0)
        int cur[TPW];
#pragma unroll
        for (int tt = 0; tt < TPW; ++tt) cur[tt] = 0;
#define P8_STEP_B(tt_, bufX, bufY, r_) { const int end_ = __builtin_amdgcn_readlane(offv[tt_], (r_) + 1); \
            while (cur[tt_] < end_) { P8_ISSUE(bufX, vt, tt_, cur[tt_] >> 3); P8_ACC(bufX, tt_, cur[tt_] >> 3); cur[tt_] += 8; } }
        if ((skip & 2) == 0) {
#pragma unroll 1
        for (int r = 0; r < NPART; ++r) {
            P8_STEP_B(0, bufA, bufB, r) P8_STEP_B(1, bufB, bufA, r) P8_STEP_B(2, bufA, bufB, r) P8_STEP_B(3, bufB, bufA, r)
            P8_STEP_B(4, bufA, bufB, r) P8_STEP_B(5, bufB, bufA, r) P8_STEP_B(6, bufA, bufB, r) P8_STEP_B(7, bufB, bufA, r)
        } }
#undef P8_STEP_B
#undef P8_ACC
#undef P8_PICK
    }
#undef P8_ISSUE
#undef ut
#undef vt
    f32x4 g2v[4], lgv[4], lbv[4];
#pragma unroll
    for (int j = 0; j < 4; ++j) { const int d = 256 * j + 4 * lane; g2v[j] = *(const f32x4*)(mod + b * 6144 + 5120 + d) + 1.0f; lgv[j] = *(const f32x4*)(F.ln2_g + d); lbv[j] = *(const f32x4*)(F.ln2_b + d); }
#pragma unroll
    for (int tt = 0; tt < TPW; ++tt) { const size_t t = (size_t)(t0 + tt);
        f32x4 v[4]; float s = 0.f;
#pragma unroll
        for (int j = 0; j < 4; ++j) { const unsigned xv = j == 0 ? xw[tt].x : j == 1 ? xw[tt].y : j == 2 ? xw[tt].z : xw[tt].w;
            const f32x4 xf = (f32x4){(float)(xv & 255u), (float)((xv >> 8) & 255u), (float)((xv >> 16) & 255u), (float)(xv >> 24)}; const f32x4 yy = (f32x4){(float)yh[tt][2 * j].x, (float)yh[tt][2 * j + 1].x, (float)yh[tt][2 * j].y, (float)yh[tt][2 * j + 1].y};
            v[j] = xf * sxa[tt] + (g2v[j] * yy + sxa[tt] * -128.0f); s += (v[j][0] + v[j][1]) + (v[j][2] + v[j][3]); }
        const float mean = wave_sum(s) * (1.f / DM); float qq = 0.f;
#pragma unroll
        for (int j = 0; j < 4; ++j) { v[j] = v[j] - mean; qq += (v[j][0] * v[j][0] + v[j][1] * v[j][1]) + (v[j][2] * v[j][2] + v[j][3] * v[j][3]); }
        const float rstd = __builtin_amdgcn_rsqf(wave_sum(qq) * (1.f / DM) + LN_EPS);
#pragma unroll
        for (int j = 0; j < 4; ++j) { const int d = 256 * j + 4 * lane;
            __builtin_nontemporal_store(v[j] * rstd * lgv[j] + lbv[j], (f32x4*)(F.out + t * DM + d)); } }
    }
}
#ifndef PROBE_PARTS
#define PROBE_PARTS 0xff
#endif
#ifndef MK_N_LAUNCHES
#define MK_N_LAUNCHES 1
#endif
constexpr int N_PHASES = 9;
struct Args { const float* in[18]; float* out; unsigned char* ws; int ph_lo, ph_hi, p0_parts, pad; };
__global__ void __launch_bounds__(NTHREADS, 2) fwd_kernel(Args args) {
    extern __shared__ __attribute__((aligned(16))) unsigned char lds[];
    Frame F;
    F.lds = (LAS unsigned char*)lds;
    F.tid = threadIdx.x; F.lane = F.tid & 63; F.wave = __builtin_amdgcn_readfirstlane(F.tid >> 6);
    F.G = gridDim.x; { const int bx = blockIdx.x; F.vcu = (F.G % 8 == 0) ? (bx % 8) * (F.G / 8) + bx / 8 : bx; }
    const bool grp = (F.G == 256);
    const int grp_pm = 8 * (F.vcu >> 5) + (F.vcu & 7), grp_p = (F.vcu >> 3) & 3; F.gcu = grp ? 4 * grp_pm + grp_p : F.vcu; unsigned grp_n = 0;
    F.x = args.in[0]; F.c = args.in[1]; F.w_ada = args.in[2]; F.b_ada = args.in[3]; F.w_in = args.in[4]; F.sinks = args.in[5]; F.w_pool = args.in[6]; F.pool_scale = args.in[7];
    F.w_out = args.in[8]; F.ln1_g = args.in[9]; F.ln1_b = args.in[10]; F.w_pq = args.in[11]; F.k1 = args.in[12]; F.k2 = args.in[13]; F.pu = args.in[14]; F.pv = args.in[15];
    F.ln2_g = args.in[16]; F.ln2_b = args.in[17]; F.out = args.out; F.ws = args.ws;
    volatile LAS unsigned* MISC = (volatile LAS unsigned*)(F.lds + MISC_OFF);
    for (int u = F.tid; u < (LDS_BYTES - LDSCTL_OFF) / 4; u += NTHREADS) ((LAS unsigned*)(F.lds + LDSCTL_OFF))[u] = 0u;
    __syncthreads();
    const int lo = args.ph_lo, hi = args.ph_hi;
    XcdBarrier bar; bar.bar = (unsigned*)(F.ws + WS_CTL) + CW_BAR; bar.x = 0; bar.st = nullptr;
    if (hi - lo > 1) bar = xcd_barrier_post((unsigned*)(F.ws + WS_CTL) + CW_BAR, MISC + 8);
    unsigned* const grp_w = (unsigned*)(F.ws + WS_CTL) + CW_GRP + 64 * grp_pm;
    if (grp && hi - lo > 1 && F.tid == 0) { const unsigned xc = xb_xcc_id(); (void)__hip_atomic_fetch_max(grp_w + 16, xc + 1u, __ATOMIC_RELAXED, __HIP_MEMORY_SCOPE_AGENT); (void)__hip_atomic_fetch_max(grp_w + 32, 16u - xc, __ATOMIC_RELAXED, __HIP_MEMORY_SCOPE_AGENT); }
    bool grp_light = false;
    const bool tb_late = grp && lo == 0 && hi == N_PHASES;
#define TBL_SLOT(s_) do { if (tb_late && (grp_pm & 3) == (s_)) { p2_tables<true>(F, F.gcu * NWAVES + F.wave, 256 * NWAVES, TB_SPLIT, 2 * NEXP); asm volatile("s_waitcnt vmcnt(0)" ::: "memory"); __syncthreads(); \
        if (F.tid == 0) (void)xb_add((unsigned*)(F.ws + WS_CTL) + CW_TBL, 1u); } } while (0)
#ifndef PH_MASK
#define PH_MASK 0x1ff
#endif
#define IN(k) (((PH_MASK >> (k)) & 1) && lo <= (k) && (k) < hi)
#define SEAM(k) do { if (IN(k) && IN((k) + 1)) xcd_barrier(bar); } while (0)
#define GSEAM(k) do { if (IN(k) && IN((k) + 1)) { if (grp) { grp_n += 4u; grp_barrier(grp_w, grp_n, bar.bar, grp_light, nullptr, 0u, (k) == 4  ); } else xcd_barrier(bar); } } while (0)
#ifndef REP_MASK
#define REP_MASK 0
#endif
#ifndef REP_CNT
#define REP_CNT 4
#endif
#define REPS(k) (((REP_MASK >> (k)) & 1) * REP_CNT)
#define PHASE_NS(k, ...) if (IN(k)) { _Pragma("unroll 1") for (int _r = 0; _r <= REPS(k); ++_r) { __VA_ARGS__; if (_r < REPS(k)) xcd_barrier(bar); } }
#define PHASE_G(k, ...) if (IN(k)) { _Pragma("unroll 1") for (int _r = 0; _r <= REPS(k); ++_r) { __VA_ARGS__; if (_r < REPS(k)) xcd_barrier(bar); } } GSEAM(k)
#define PHASE(k, ...) if (IN(k)) { _Pragma("unroll 1") for (int _r = 0; _r <= REPS(k); ++_r) { __VA_ARGS__; if (_r < REPS(k)) xcd_barrier(bar); } } SEAM(k)
#ifndef P0_SUB
#define P0_SUB 0xff
#endif
    PHASE(0, p0_prologue(F, args.p0_parts & 0x63, F.vcu * NWAVES + F.wave, F.G * NWAVES));
    PHASE(2, { pg8::Gemm g{(const pg8::bf16_t*)(F.ws + WS_XN8), (const pg8::bf16_t*)(F.ws + WS_WIN), TT, NIN, DM / 2, 32, (size_t)NIN * DM, 0x79797979, 0x7F7F7F7F};    pg8::StaticOrder S; S.init(TT, NIN, F.G, (int)blockIdx.x);
            pg8::EpiRope E{(pg8::bf16_t*)(F.ws + WS_PROJ), NIN, (const float*)(F.ws + WS_ROPE), QSCALE, (const float*)(F.ws + WS_BIAS)};
            pg8::gemm_phase<pg8::EpiRope, pg8::StaticOrder, true, true, true>(F.lds, g, S, E);
            if ((args.p0_parts & 0x80) && (int)blockIdx.x >= 320 - F.G) p0_prologue(F, 0x9c, ((int)blockIdx.x - (320 - F.G)) * NWAVES + F.wave, (2 * F.G - 320) * NWAVES);
            if ((args.p0_parts & 0x80) && (int)blockIdx.x >= 320 - F.G) p2_tables<false>(F, ((int)blockIdx.x - (320 - F.G)) * NWAVES + F.wave, (2 * F.G - 320) * NWAVES, 0, tb_late ? TB_SPLIT : 2 * NEXP); });
    if (grp && IN(2) && IN(3)) {
        if (F.tid == 0) MISC[12] = (xb_ld(grp_w + 16) - 1u == 16u - xb_ld(grp_w + 32)) ? 1u : 0u;
        __syncthreads(); grp_light = __builtin_amdgcn_readfirstlane((int)MISC[12]) != 0; }
    TBL_SLOT(0);
    PHASE_G(3, { for (int u = F.gcu; u < 256; u += F.G) { const int ua = grp ? (u >> 7) * 128 + ((u >> 1) & 1) * 64 + 2 * ((u >> 2) & 31) + (u & 1) : u;
            PoolRegs pr; KvRegs kv; p3_pool_load(F, u, pr); p3_attn_kvload(F, ua, kv); p3_pool_compute(F, u, pr); p3_attn_unit(F, ua, kv); } });
    TBL_SLOT(1);
    PHASE_G(4, { pg8::Gemm g{(const pg8::bf16_t*)(F.ws + WS_A2), (const pg8::bf16_t*)(F.ws + WS_WOUT), TT, DM, DM / 2, 1 << 30, 0, 0x79797979, 0x7B7B7B7B}; pg8::StaticOrder S; S.init(TT, DM, F.G, (int)blockIdx.x);
            pg8::EpiPlain E{F.ws + WS_MIX, DM, MIX_SCALE};
            pg8::gemm_phase<pg8::EpiPlain, pg8::StaticOrder, true, true, true>(F.lds, g, S, E); });
    TBL_SLOT(2);
    PHASE_G(5, p5_ln1(F));
    TBL_SLOT(3);
    PHASE_NS(6, { pg8::Gemm g{(const pg8::bf16_t*)(F.ws + WS_H2Q), (const pg8::bf16_t*)(F.ws + WS_WPQ), TT, NQD, DM / 2, 1 << 30, 0, 0, 0}; pg8::StaticOrder S; S.init(TT, NQD, F.G, (int)blockIdx.x);
            pg8::EpiQ8 E{(pg8::bf16_t*)(F.ws + WS_Q), NQD, (const float*)(F.ws + WS_SH), (const float*)(F.ws + WS_SWQ)};
            pg8::gemm_phase<pg8::EpiQ8, pg8::StaticOrder, true, true, 2>(F.lds, g, S, E); });
    if (IN(6) && IN(7)) { asm volatile("s_waitcnt vmcnt(0)" ::: "memory"); __syncthreads(); }
    if (IN(7)) { p7_route(F); }
    if (IN(7) && IN(8)) { if (grp) { grp_n += 4u; grp_barrier(grp_w, grp_n, bar.bar, grp_light, tb_late ? (unsigned*)(F.ws + WS_CTL) + CW_TBL : nullptr, 256u); } else xcd_barrier(bar); }
#ifndef P8_FAKE
#define P8_FAKE 0xffffu
#endif
#ifndef P8_SKIP
#define P8_SKIP 0
#endif
    PHASE(8, p8_peer(F, _r == REPS(8) ? 0xffffu : P8_FAKE, _r == REPS(8) ? 0 : P8_SKIP));
#ifdef BAR_PROBE
    for (int i = 0; i < BAR_PROBE; ++i) xcd_barrier(bar);
#endif
#undef IN
#undef SEAM
}

extern "C" void kernel_launch(void* const* d_in, const int* in_sizes, int n_in, void* d_out, int out_size, void* d_ws, size_t ws_size, hipStream_t stream) {
    static int grid = 0;
    if (grid == 0) {
        if (n_in != 18 || out_size != TT * DM || ws_size < WS_END) { fprintf(stderr, "kernel_launch: unexpected shapes (n_in %d out %d ws %zu)\n", n_in, out_size, ws_size); grid = -1; return; }
        int dev = 0, cus = 0, per_cu = 0;
        if (hipGetDevice(&dev) != hipSuccess || hipDeviceGetAttribute(&cus, hipDeviceAttributeMultiprocessorCount, dev) != hipSuccess) { grid = -1; return; }
        if (hipFuncSetAttribute((const void*)fwd_kernel, hipFuncAttributeMaxDynamicSharedMemorySize, LDS_BYTES) != hipSuccess) { fprintf(stderr, "kernel_launch: hipFuncSetAttribute failed\n"); grid = -1; return; }
        if (hipOccupancyMaxActiveBlocksPerMultiprocessor(&per_cu, (const void*)fwd_kernel, NTHREADS, LDS_BYTES) != hipSuccess || per_cu < 1) { fprintf(stderr, "kernel_launch: occupancy query says %d blocks per CU\n", per_cu); }
        (void)hipGetLastError();
        grid = cus;
        if (grid != 256) fprintf(stderr, "kernel_launch: built for 256 CUs, got %d\n", grid);
    }
    if (grid < 0) return;
    (void)hipMemsetAsync((char*)d_ws + WS_CTL, 0, CTL_ZERO_BYTES, stream);
    Args a{};
    for (int i = 0; i < 18; ++i) a.in[i] = (const float*)d_in[i];
    a.out = (float*)d_out; a.ws = (unsigned char*)d_ws; a.p0_parts = 0xff;
#if MK_N_LAUNCHES == 1
    a.ph_lo = 0; a.ph_hi = N_PHASES;
    hipLaunchKernelGGL(fwd_kernel, dim3(grid), dim3(NTHREADS), LDS_BYTES, stream, a);
#ifdef PROBE_PHASE
    for (int i = 0; i < PROBE_N; ++i) { a.ph_lo = PROBE_PHASE; a.ph_hi = PROBE_PHASE + 1; a.p0_parts = PROBE_PARTS; hipLaunchKernelGGL(fwd_kernel, dim3(grid), dim3(NTHREADS), LDS_BYTES, stream, a); }
#endif
#else
    for (int p = 0; p < N_PHASES; ++p) { a.ph_lo = p; a.ph_hi = p + 1; hipLaunchKernelGGL(fwd_kernel, dim3(grid), dim3(NTHREADS), LDS_BYTES, stream, a); }
#endif
}
```
